# Optimizing an MI355X kernel written in HIP

```python
import jax, jax.numpy as jnp
from jax import lax
import numpy as np

D_MODEL = 1024
BATCH = 4
SEQ = 4096
DEPTH = 2

CHUNK = 64
N_MIXERS = 4
GROUP_W = D_MODEL // N_MIXERS
ATT_HEAD_DIM = 64
ATT_HEADS = GROUP_W // ATT_HEAD_DIM
ROPE_DIM = ATT_HEAD_DIM // 4
ROPE_THETA = 500000.0
IDX_HEADS = 4
IDX_DIM = 32
IDX_ROPE_DIM = IDX_DIM // 4
TOPK_MAX = 256
Q_BLOCK = 128
CONV_WIDTH = 31
CONV_GROUPS = 4
POOL_WINDOWS = (2, 4, 8, 16)
POOL_CH = GROUP_W // 4
SGU_CHUNK = 128
SGU_HEADS = 4
SGU_HEAD_W = GROUP_W // SGU_HEADS
N_EXP_GROUPS = 4
EXP_PER_GROUP = 8
N_EXPERTS = N_EXP_GROUPS * EXP_PER_GROUP
EXPERT_FF = 512
MOE_TOPK = 2
MOE_BLOCK = 128
EPS = 1e-6
IN_SPLITS = (GROUP_W, GROUP_W, GROUP_W, IDX_HEADS * IDX_DIM, IDX_DIM, IDX_HEADS, 2 * GROUP_W, GROUP_W, 2 * GROUP_W)
D_IN = 8 * GROUP_W + IDX_HEADS * IDX_DIM + IDX_DIM + IDX_HEADS

kernel_name = "hybrid_chunk_causal_parallel_heads_hmoe"


def _rms(x, g):
    xf = x.astype(jnp.float32)
    y = xf * lax.rsqrt(jnp.mean(xf * xf, axis=-1, keepdims=True) + EPS)
    return y.astype(x.dtype) * g


def _ln(x, g, b):
    xf = x.astype(jnp.float32)
    mu = jnp.mean(xf, axis=-1, keepdims=True)
    var = jnp.mean(jnp.square(xf - mu), axis=-1, keepdims=True)
    return ((xf - mu) * lax.rsqrt(var + EPS)).astype(x.dtype) * g + b


def _rope_tables(positions, rot_dim, dtype):
    half = rot_dim // 2
    inv = jnp.power(jnp.float32(ROPE_THETA), -2.0 * jnp.arange(half, dtype=jnp.float32) / rot_dim)
    ang = positions.astype(jnp.float32)[..., None] * inv
    return jnp.cos(ang).astype(dtype)[:, :, None, :], jnp.sin(ang).astype(dtype)[:, :, None, :]


def _partial_rope(x, cos, sin):
    half = cos.shape[-1]
    x1, x2, rest = x[..., :half], x[..., half:2 * half], x[..., 2 * half:]
    return jnp.concatenate([x1 * cos - x2 * sin, x2 * cos + x1 * sin, rest], axis=-1)


def _dsa_mixer(q, k, v, iq, ik, iw, cos_a, sin_a, cos_i, sin_i, q_norm, k_norm):
    B, S = q.shape[:2]
    q = _partial_rope(_rms(q.reshape(B, S, ATT_HEADS, ATT_HEAD_DIM), q_norm), cos_a, sin_a)
    k = _partial_rope(_rms(k.reshape(B, S, ATT_HEADS, ATT_HEAD_DIM), k_norm), cos_a, sin_a)
    v = v.reshape(B, S, ATT_HEADS, ATT_HEAD_DIM)
    iq = _partial_rope(iq.reshape(B, S, IDX_HEADS, IDX_DIM), cos_i, sin_i)
    ik = _partial_rope(ik[:, :, None, :], cos_i, sin_i)[:, :, 0, :]
    iw = iw * (IDX_HEADS ** -0.5)
    topk = min(TOPK_MAX, S // 4)
    n_blk = S // Q_BLOCK
    key_pos = jnp.arange(S)

    def to_blocks(a):
        return a.reshape(B, n_blk, Q_BLOCK, *a.shape[2:]).swapaxes(0, 1)

    def block(args):
        qb, iqb, iwb, bi = args
        q_pos = bi * Q_BLOCK + jnp.arange(Q_BLOCK)
        key_end = (q_pos // CHUNK + 1) * CHUNK
        admissible = key_pos[None, :] < key_end[:, None]
        dots = jnp.einsum('bqhd,bsd->bqhs', iqb, ik) * (IDX_DIM ** -0.5)
        score = jnp.einsum('bqhs,bqh->bqs', jax.nn.relu(dots), iwb).astype(jnp.float32)
        score = jnp.where(admissible[None], score, -jnp.inf)
        top_val, top_idx = lax.top_k(score, topk)
        valid = jnp.isfinite(top_val)
        k_sel = jax.vmap(lambda kb, ib: kb[ib])(k, top_idx)
        v_sel = jax.vmap(lambda vb, ib: vb[ib])(v, top_idx)
        logits = jnp.einsum('bqhd,bqkhd->bqhk', qb, k_sel).astype(jnp.float32) * (ATT_HEAD_DIM ** -0.5)
        logits = jnp.where(valid[:, :, None, :], logits, -jnp.inf)
        p = jax.nn.softmax(logits, axis=-1).astype(v.dtype)
        o = jnp.einsum('bqhk,bqkhd->bqhd', p, v_sel)
        return o.reshape(B, Q_BLOCK, GROUP_W)

    out = lax.map(block, (to_blocks(q), to_blocks(iq), to_blocks(iw), jnp.arange(n_blk)))
    return out.swapaxes(0, 1).reshape(B, S, GROUP_W)


def _conv_module(a, gate, conv_w, conv_b, ln_g, ln_b, pw_w, pw_b):
    B, S, C = a.shape
    y = a * jax.nn.sigmoid(gate)
    y = jnp.pad(y, ((0, 0), (CONV_WIDTH - 1, 0), (0, 0)))
    y = lax.conv_general_dilated(y, conv_w[:, None, :], window_strides=(1,), padding='VALID',
                                 dimension_numbers=('NWC', 'WIO', 'NWC'), feature_group_count=C) + conv_b
    y = _ln(y.reshape(B, S, CONV_GROUPS, C // CONV_GROUPS),
            ln_g.reshape(CONV_GROUPS, -1), ln_b.reshape(CONV_GROUPS, -1)).reshape(B, S, C)
    return jax.nn.silu(y) @ pw_w + pw_b


def _pool_mixer(p, pool_w, pool_b, pool_scale):
    B, S, C = p.shape
    pg = p.reshape(B, S, len(POOL_WINDOWS), POOL_CH)
    cs = lax.cumsum(pg.astype(jnp.float32), axis=1)
    count = jnp.arange(1, S + 1, dtype=jnp.float32)
    means = []
    for i, w in enumerate(POOL_WINDOWS):
        c_i = cs[:, :, i]
        prev = jnp.pad(c_i, ((0, 0), (w, 0), (0, 0)))[:, :S]
        means.append((c_i - prev) / jnp.minimum(count, w)[None, :, None])
    pooled = jnp.stack(means, axis=2).astype(p.dtype) - pg
    y = jnp.einsum('bsgc,gcd->bsgd', pooled, pool_w) + pool_b
    return y.reshape(B, S, C) * pool_scale


def _sgu_mixer(u, v, ln_g, ln_b, sgu_w, sgu_b):
    B, S, C = u.shape
    n = S // SGU_CHUNK
    vc = _ln(v, ln_g, ln_b).reshape(B, n, SGU_CHUNK, SGU_HEADS, SGU_HEAD_W)
    causal = jnp.tril(jnp.ones((SGU_CHUNK, SGU_CHUNK), dtype=bool))
    w = jnp.where(causal[None], sgu_w, 0)
    mixed = jnp.einsum('hts,bnshc->bnthc', w, vc) + sgu_b.T[None, None, :, :, None]
    return u * mixed.reshape(B, S, C)


def _hier_moe(h, w_rg, b_rg, w_re, b_re, w_gate, w_up, w_down):
    N, D = h.shape
    p_grp = jax.nn.softmax((h @ w_rg + b_rg).astype(jnp.float32), axis=-1)
    g_idx = jnp.argmax(p_grp, axis=-1).astype(jnp.int32)
    p_sel = jnp.take_along_axis(p_grp, g_idx[:, None], axis=1)
    e_logits = jnp.einsum('nd,dge->nge', h, w_re) + b_re
    e_logits = jnp.take_along_axis(e_logits, g_idx[:, None, None], axis=1)[:, 0].astype(jnp.float32)
    top_val, top_j = lax.top_k(e_logits, MOE_TOPK)
    gates = (p_sel * jax.nn.softmax(top_val, axis=-1)).astype(h.dtype)
    expert = g_idx[:, None] * EXP_PER_GROUP + top_j.astype(jnp.int32)
    M = N * MOE_TOPK
    e_flat = expert.reshape(-1)
    tok_flat = jnp.repeat(jnp.arange(N, dtype=jnp.int32), MOE_TOPK)
    g_flat = gates.reshape(-1)
    order = jnp.argsort(e_flat)
    e_s, tok_s, g_s = e_flat[order], tok_flat[order], g_flat[order]
    counts = jnp.zeros(N_EXPERTS, jnp.int32).at[e_flat].add(1)
    padded = (counts + MOE_BLOCK - 1) // MOE_BLOCK * MOE_BLOCK
    pad_end = jnp.cumsum(padded)
    pad_start = pad_end - padded
    start = jnp.cumsum(counts) - counts
    dest = pad_start[e_s] + jnp.arange(M, dtype=jnp.int32) - start[e_s]
    n_blocks = (M + N_EXPERTS * (MOE_BLOCK - 1) + MOE_BLOCK - 1) // MOE_BLOCK
    rows = n_blocks * MOE_BLOCK
    row_tok = jnp.zeros(rows, jnp.int32).at[dest].set(tok_s)
    row_gate = jnp.zeros(rows, h.dtype).at[dest].set(g_s)
    block_expert = jnp.minimum(
        jnp.searchsorted(pad_end, jnp.arange(n_blocks, dtype=jnp.int32) * MOE_BLOCK, side='right'),
        N_EXPERTS - 1)

    def expert_block(args):
        toks, gts, e = args
        xb = h[toks]
        hid = jax.nn.silu(xb @ w_gate[e]) * (xb @ w_up[e])
        return (hid @ w_down[e]) * gts[:, None]

    y_rows = lax.map(expert_block, (row_tok.reshape(n_blocks, MOE_BLOCK),
                                    row_gate.reshape(n_blocks, MOE_BLOCK), block_expert))
    return jnp.zeros_like(h).at[row_tok].add(y_rows.reshape(rows, D))


def setup_inputs(seed: int = 0) -> dict:
    key = jax.random.key(seed)
    it = iter(jax.random.split(key, 32))
    L, D, G, F = DEPTH, D_MODEL, GROUP_W, EXPERT_FF

    def nrm(shape, scale):
        return jax.random.normal(next(it), shape, jnp.float32) * scale

    def gain(shape):
        return 1.0 + 0.02 * jax.random.normal(next(it), shape, jnp.float32)

    x = nrm((BATCH, SEQ, D), 1.0)
    c = nrm((BATCH, D), 1.0)
    offset = jax.random.randint(next(it), (BATCH, 1), 0, 1024, dtype=jnp.int32)
    positions = (jnp.arange(SEQ, dtype=jnp.int32)[None, :] + offset).astype(jnp.int32)
    return {
        "x": x, "c": c, "positions": positions,
        "w_ada": nrm((L, D, 6 * D), D ** -0.5), "b_ada": nrm((L, 6 * D), 0.01),
        "norm1": gain((L, D)), "w_in": nrm((L, D, D_IN), D ** -0.5),
        "q_norm": gain((L, ATT_HEAD_DIM)), "k_norm": gain((L, ATT_HEAD_DIM)),
        "conv_w": nrm((L, CONV_WIDTH, G), CONV_WIDTH ** -0.5), "conv_b": nrm((L, G), 0.01),
        "conv_ln_g": gain((L, G)), "conv_ln_b": nrm((L, G), 0.01),
        "conv_pw_w": nrm((L, G, G), G ** -0.5), "conv_pw_b": nrm((L, G), 0.01),
        "pool_w": nrm((L, len(POOL_WINDOWS), POOL_CH, POOL_CH), POOL_CH ** -0.5),
        "pool_b": nrm((L, len(POOL_WINDOWS), POOL_CH), 0.01), "pool_scale": gain((L, G)),
        "sgu_ln_g": gain((L, G)), "sgu_ln_b": nrm((L, G), 0.01),
        "sgu_w": nrm((L, SGU_HEADS, SGU_CHUNK, SGU_CHUNK), SGU_CHUNK ** -0.5),
        "sgu_b": gain((L, SGU_HEADS, SGU_CHUNK)),
        "out_norm": gain((L, D)), "w_out": nrm((L, D, D), D ** -0.5),
        "norm2": gain((L, D)),
        "w_rg": nrm((L, D, N_EXP_GROUPS), D ** -0.5), "b_rg": nrm((L, N_EXP_GROUPS), 0.01),
        "w_re": nrm((L, D, N_EXP_GROUPS, EXP_PER_GROUP), D ** -0.5),
        "b_re": nrm((L, N_EXP_GROUPS, EXP_PER_GROUP), 0.01),
        "w_gate": nrm((L, N_EXPERTS, D, F), D ** -0.5), "w_up": nrm((L, N_EXPERTS, D, F), D ** -0.5),
        "w_down": nrm((L, N_EXPERTS, F, D), F ** -0.5),
    }


def reference(x, c, positions, w_ada, b_ada, norm1, w_in, q_norm, k_norm, conv_w, conv_b,
              conv_ln_g, conv_ln_b, conv_pw_w, conv_pw_b, pool_w, pool_b, pool_scale,
              sgu_ln_g, sgu_ln_b, sgu_w, sgu_b, out_norm, w_out, norm2, w_rg, b_rg, w_re, b_re,
              w_gate, w_up, w_down):
    B, S, D = x.shape
    split_points = np.cumsum(IN_SPLITS)[:-1].tolist()
    cos_a, sin_a = _rope_tables(positions, ROPE_DIM, x.dtype)
    cos_i, sin_i = _rope_tables(positions, IDX_ROPE_DIM, x.dtype)
    c_act = jax.nn.silu(c)
    for l in range(DEPTH):
        mod = c_act @ w_ada[l] + b_ada[l]
        shift1, scale1, gate1, shift2, scale2, gate2 = [m[:, None, :] for m in jnp.split(mod, 6, axis=-1)]
        h = _rms(x, norm1[l]) * (1 + scale1) + shift1
        proj = h @ w_in[l]
        qa, ka, va, iqa, ika, iwa, b_in, c_in, d_in = jnp.split(proj, split_points, axis=-1)
        b_a, b_g = jnp.split(b_in, 2, axis=-1)
        d_u, d_v = jnp.split(d_in, 2, axis=-1)
        o_a = _dsa_mixer(qa, ka, va, iqa, ika, iwa, cos_a, sin_a, cos_i, sin_i, q_norm[l], k_norm[l])
        o_b = _conv_module(b_a, b_g, conv_w[l], conv_b[l], conv_ln_g[l], conv_ln_b[l], conv_pw_w[l], conv_pw_b[l])
        o_c = _pool_mixer(c_in, pool_w[l], pool_b[l], pool_scale[l])
        o_d = _sgu_mixer(d_u, d_v, sgu_ln_g[l], sgu_ln_b[l], sgu_w[l], sgu_b[l])
        mix = jnp.concatenate([o_a, o_b, o_c, o_d], axis=-1).reshape(B, S, N_MIXERS, GROUP_W)
        mix = _rms(mix, out_norm[l].reshape(N_MIXERS, GROUP_W)).reshape(B, S, D)
        x = x + gate1 * (mix @ w_out[l])
        h2 = _rms(x, norm2[l]) * (1 + scale2) + shift2
        y = _hier_moe(h2.reshape(B * S, D), w_rg[l], b_rg[l], w_re[l], b_re[l], w_gate[l], w_up[l], w_down[l])
        x = x + gate2 * y.reshape(B, S, D)
    return x
```

```cpp
#include <hip/hip_runtime.h>
#include <stdint.h>
#include <stdio.h>

#define LAS __attribute__((address_space(3)))
typedef unsigned short bf16_t;
typedef short bf16x8 __attribute__((ext_vector_type(8)));
typedef float f32x4 __attribute__((ext_vector_type(4)));
typedef float f32x16 __attribute__((ext_vector_type(16)));
typedef unsigned u32x4 __attribute__((ext_vector_type(4)));
typedef unsigned u32x2 __attribute__((ext_vector_type(2)));

constexpr int Bn = 4, S = 4096, D = 1024, L = 2, NTOK = Bn * S, DIN = 2212, F = 512, NE = 32;
constexpr int NP = 2304;
constexpr int NK = 0, NV = 256, NIQ = 512, NIK = 640, NIW = 672, NBA = 768, NBG = 1024, NC = 1280, NDU = 1536, NDV = 1792, NQ = 2048;
constexpr float EPS = 1e-6f;
constexpr int NTHR = 512;
constexpr int SLOTS = 40960;

constexpr int LDS_BYTES = 163840, LDS_MISC = 147456;
constexpr int MISC_BAR = 0;
constexpr int MISC_CUM = 64;
constexpr int MISC_CNT = 64 + 160;

constexpr size_t al256c(size_t v) { return (v + 255) & ~(size_t)255; }
constexpr size_t WS_BAR = 0;
constexpr size_t WS_CNT = 16384;
constexpr size_t WS_ZERO_BYTES = 16384 + 32768;
constexpr size_t WS_MOD = WS_ZERO_BYTES;
constexpr size_t WS_ROPEA = WS_MOD + al256c((size_t)L * 4 * 6144 * 4);
constexpr size_t WS_ROPEI = WS_ROPEA + al256c((size_t)NTOK * 16 * 4);
constexpr size_t WS_LIST = WS_ROPEI + al256c((size_t)NTOK * 8 * 4);
constexpr size_t WS_LGATE = WS_LIST + al256c((size_t)NE * NTOK * 4);
constexpr size_t WS_TOKINFO = WS_LGATE + al256c((size_t)NE * NTOK * 4);
constexpr size_t WS_SGUW = WS_TOKINFO + al256c((size_t)NTOK * 16);
constexpr size_t WS_POOLT = WS_SGUW + al256c((size_t)L * 4 * 128 * 128 * 2);
constexpr size_t WS_WHL = WS_POOLT + al256c((size_t)L * 4 * 64 * 64 * 2);
constexpr size_t WS_RBIAS = WS_WHL + al256c((size_t)L * 2 * 48 * 1024 * 2);
constexpr size_t WS_SSQ = WS_RBIAS + al256c((size_t)L * 4 * 48 * 4);
constexpr size_t WS_WINT = WS_SSQ + al256c((size_t)L * NTOK * 4 * 4);
constexpr size_t WS_WOUTT = WS_WINT + al256c((size_t)L * NP * D * 2);
constexpr size_t WS_PWT = WS_WOUTT + al256c((size_t)L * D * D * 2);
constexpr size_t WS_WGUT = WS_PWT + al256c((size_t)L * 256 * 256 * 2);
constexpr size_t WS_WDT = WS_WGUT + al256c((size_t)L * NE * 1024 * 1024 * 2);
constexpr size_t WS_HA = WS_WDT + al256c((size_t)L * NE * 1024 * 512 * 2);
constexpr size_t WS_X1 = WS_HA + al256c((size_t)NTOK * D * 2);
constexpr size_t WS_R = WS_X1 + al256c((size_t)NTOK * D * 4);
constexpr size_t WS_PROJ = WS_R;
constexpr size_t WS_R2 = WS_PROJ + al256c((size_t)NTOK * NP * 2);
constexpr size_t WS_HID = WS_R;
constexpr size_t WS_Y = WS_HID + al256c((size_t)SLOTS * F * 2);

__device__ __forceinline__ unsigned cvt_pk_bf16(float lo, float hi) { unsigned r; asm volatile("v_cvt_pk_bf16_f32 %0, %1, %2" : "=v"(r) : "v"(lo), "v"(hi)); return r; }
__device__ __forceinline__ float bf2f(bf16_t v) { return __uint_as_float(((unsigned)v) << 16); }
__device__ __forceinline__ float bflo(unsigned w) { return __uint_as_float(w << 16); }
__device__ __forceinline__ float bfhi(unsigned w) { return __uint_as_float(w & 0xffff0000u); }
template <int CTRL> __device__ __forceinline__ float dpp_f(float v) { return __builtin_bit_cast(float, __builtin_amdgcn_update_dpp(0, __builtin_bit_cast(int, v), CTRL, 0xF, 0xF, true)); }
__device__ __forceinline__ float row_sum16(float v) {
    v += dpp_f<0xB1>(v);
    v += dpp_f<0x4E>(v);
    v += dpp_f<0x141>(v);
    v += dpp_f<0x140>(v);
    return v;
}
__device__ __forceinline__ float wave_sum(float v) {
    v = row_sum16(v);
    const float r0 = __builtin_bit_cast(float, __builtin_amdgcn_readlane(__builtin_bit_cast(int, v), 0)), r1 = __builtin_bit_cast(float, __builtin_amdgcn_readlane(__builtin_bit_cast(int, v), 16));
    const float r2 = __builtin_bit_cast(float, __builtin_amdgcn_readlane(__builtin_bit_cast(int, v), 32)), r3 = __builtin_bit_cast(float, __builtin_amdgcn_readlane(__builtin_bit_cast(int, v), 48));
    return (r0 + r1) + (r2 + r3);
}
__device__ __forceinline__ float wave_max(float v) {
#pragma unroll
    for (int o = 32; o >= 1; o >>= 1) v = fmaxf(v, __shfl_xor(v, o));
    return v;
}
__device__ __forceinline__ float silu_f(float v) { return v / (1.0f + expf(-v)); }
__device__ __forceinline__ float silu_fast(float v) { return v * __builtin_amdgcn_rcpf(1.0f + __expf(-v)); }
__device__ __forceinline__ float sigmoid_f(float v) { return 1.0f / (1.0f + expf(-v)); }
__device__ __forceinline__ float sigmoid_fast(float v) { return __builtin_amdgcn_rcpf(1.0f + __expf(-v)); }
__device__ __forceinline__ int opaque_tid() { int t = threadIdx.x; asm volatile("" : "+v"(t)); return t; }
__device__ __forceinline__ int ld_agent(const int* p) { return __hip_atomic_load(p, __ATOMIC_RELAXED, __HIP_MEMORY_SCOPE_AGENT); }

#define XB_TMO      128
#define XB_XCNT(j)  (256  + 64 * (j))
#define XB_XSUB(j)  (1280 + 64 * (j))
#define XB_XGEN(j)  (2304 + 64 * (j))
#define XB_TOP      3328
#define XB_TOPGEN   3392
#define XCD_BAR_WORDS 3456
#define XB_SPIN_CAP (1u << 18)
__device__ __forceinline__ unsigned xb_ld(unsigned* p)              { return __hip_atomic_load(p, __ATOMIC_RELAXED, __HIP_MEMORY_SCOPE_AGENT); }
__device__ __forceinline__ unsigned xb_add(unsigned* p, unsigned v) { return __hip_atomic_fetch_add(p, v, __ATOMIC_RELAXED, __HIP_MEMORY_SCOPE_AGENT); }
__device__ __forceinline__ unsigned xb_xcc_id() { return (unsigned)__builtin_amdgcn_s_getreg((3 << 11) | 20) & 0xFu; }
#define XB_SPIN(cond, bar) do { unsigned _sp = 0; while (cond) { __builtin_amdgcn_s_sleep(1); \
    if ((++_sp & 255u) == 0u) { if (xb_ld(&(bar)[XB_TMO])) break; if (_sp > XB_SPIN_CAP) { atomicAdd(&(bar)[XB_TMO], 1u); break; } } } } while (0)
struct XcdBarrier { unsigned* bar; unsigned x; volatile LAS unsigned* st; };
__device__ __forceinline__ XcdBarrier xcd_barrier_post(unsigned* bar, volatile LAS unsigned* st) {
    XcdBarrier b; b.bar = bar; b.x = xb_xcc_id(); b.st = st;
    if (threadIdx.x == 0) (void)xb_add(&bar[XB_XCNT(b.x)], 1u);
    return b;
}
__device__ __forceinline__ void xcd_barrier_complete(unsigned* bar, unsigned x, unsigned& nloc, unsigned& nx) {
    const unsigned G = gridDim.x * gridDim.y * gridDim.z;
    unsigned sum, cnt, mine, sp = 0u;
    for (;;) {
        sum = 0u; cnt = 0u; mine = 0u;
#pragma unroll
        for (unsigned j = 0; j < 16; ++j) { const unsigned c = xb_ld(&bar[XB_XCNT(j)]); sum += c; cnt += (c > 0u) ? 1u : 0u; mine = (j == x) ? c : mine; }
        if (sum == G) break;
        __builtin_amdgcn_s_sleep(1);
        if ((++sp & 255u) == 0u) { if (xb_ld(&bar[XB_TMO])) break; if (sp > XB_SPIN_CAP) { atomicAdd(&bar[XB_TMO], 1u); break; } }
    }
    nloc = mine > 0u ? mine : 1u; nx = cnt > 0u ? cnt : 1u;
}
__device__ __forceinline__ void xcd_barrier(const XcdBarrier& b) {
    asm volatile("s_waitcnt vmcnt(0)" ::: "memory");
    __syncthreads();
    if (threadIdx.x == 0) {
        unsigned* bar = b.bar;
        __builtin_amdgcn_s_waitcnt(0);
        unsigned nloc = b.st[0], nx = b.st[1];
        if (nloc == 0u) { xcd_barrier_complete(bar, b.x, nloc, nx); b.st[0] = nloc; b.st[1] = nx; }
        const unsigned old = xb_add(&bar[XB_XSUB(b.x)], 1u);
        const unsigned gen = old / nloc;
        if (old + 1u == (gen + 1u) * nloc) {
            __builtin_amdgcn_fence(__ATOMIC_RELEASE, "agent");
            asm volatile("s_waitcnt vmcnt(0)" ::: "memory");
            const unsigned og = xb_add(&bar[XB_TOP], 1u);
            const unsigned tg = og / nx;
            if (og + 1u == (tg + 1u) * nx) xb_add(&bar[XB_TOPGEN], 1u);
            else XB_SPIN(xb_ld(&bar[XB_TOPGEN]) == tg, bar);
            __builtin_amdgcn_fence(__ATOMIC_ACQUIRE, "agent");
            xb_add(&bar[XB_XGEN(b.x)], 1u);
            asm volatile("s_waitcnt vmcnt(0)" ::: "memory");
        } else {
            XB_SPIN(xb_ld(&bar[XB_XGEN(b.x)]) == gen, bar);
            __builtin_amdgcn_fence(__ATOMIC_ACQUIRE, "agent");
            asm volatile("s_waitcnt vmcnt(0)" ::: "memory");
        }
    }
    __syncthreads();
}

namespace pg8 {
constexpr int BM = 256, BK = 64, HALF = 128, HTB = HALF * BK * 2, STAGE_BYTES = 8 * HTB, NXCD = 8, WGM = 8;
__host__ __device__ __forceinline__ int lds_byte(int r, int c) { const int st = (r >> 4) * 2 + (c >> 5), rr = r & 15, cc = c & 31, ob = rr * 64 + cc * 2; return st * 1024 + (ob ^ (((ob >> 9) & 1) << 5)); }
__host__ __device__ __forceinline__ void stage_rc(int b, int& R, int& C) { const int st = b / 1024, sb = b % 1024, swz = sb ^ (((sb >> 9) & 1) << 5); R = (st >> 1) * 16 + swz / 64; C = (st & 1) * 32 + (swz % 64) / 2; }
__host__ __device__ __forceinline__ int perm32(int rho) { const int n = rho >> 4, i = rho & 15; return 8 * (i >> 2) + 4 * n + (i & 3); }

struct Unit { int pm, pn, e, mt, cnt; };

struct DenseOrder {
    const bf16_t* A; const bf16_t* Bt; int K;
    int nM, nN, nwg, G, c;
    __device__ void init(const bf16_t* A_, const bf16_t* Bt_, int M, int N, int K_, int G_, int c_) { A = A_; Bt = Bt_; K = K_; nM = M / BM; nN = N / BM; nwg = nM * nN; G = G_; c = c_; }
    __device__ bool next(int i, Unit& u) const {
        const long Lx = (long)i * G + c; if (Lx >= nwg) return false;
        int wgid = (int)Lx; { const int q = nwg / NXCD, r = nwg % NXCD, xcd = wgid % NXCD, off = wgid / NXCD; wgid = (xcd < r ? xcd * (q + 1) : r * (q + 1) + (xcd - r) * q) + off; }
        const int nig = WGM * nN, gid = wgid / nig, fm = gid * WGM, gsz = (nM - fm) < WGM ? (nM - fm) : WGM;
        u.pm = fm + ((wgid % nig) % gsz); u.pn = (wgid % nig) / gsz; u.e = 0; u.mt = 0; u.cnt = 0; return true;
    }
    __device__ __forceinline__ const char* a_base(const Unit& u) const { return (const char*)A + (size_t)u.pm * BM * K * 2; }
    __device__ __forceinline__ unsigned a_voff(const Unit&, int row, int C) const { return (unsigned)(row * K + C) * 2u; }
    __device__ __forceinline__ const char* b_base(const Unit& u) const { return (const char*)Bt + (size_t)u.pn * BM * K * 2; }
};
template <bool gather> struct MoeOrder {
    const bf16_t* A; const bf16_t* Bt; int K; size_t bstride;
    const int* list;
    const LAS int* cum; const LAS int* cnts;
    int G, c, nun;
    __device__ bool next(int i, Unit& u) const {
        const int Lx = i * G + c; if (Lx >= nun) return false;
        const int t = Lx >> 2; u.pn = Lx & 3; u.pm = t;
        int e = 0;
#pragma unroll 1
        for (int j = 1; j < NE; ++j) e += (cum[j] <= t) ? 1 : 0;
        u.e = e; u.mt = t - cum[e]; u.cnt = cnts[e]; return true;
    }
    __device__ __forceinline__ const char* a_base(const Unit& u) const { return gather ? (const char*)A : (const char*)A + (size_t)u.pm * BM * K * 2; }
    __device__ __forceinline__ unsigned a_voff(const Unit& u, int row, int C) const {
        if (gather) { const int pos = u.mt * BM + row; const int tok = (pos < u.cnt) ? list[(size_t)u.e * NTOK + pos] : 0; return (unsigned)(tok * K + C) * 2u; }
        return (unsigned)(row * K + C) * 2u;
    }
    __device__ __forceinline__ const char* b_base(const Unit& u) const { return (const char*)(Bt + (size_t)u.e * bstride) + (size_t)u.pn * BM * K * 2; }
};

struct EpiBf16 {
    static constexpr bool PERM = true;
    bf16_t* O; int ldc;
    __device__ __forceinline__ void operator()(const f32x4 (&acc)[2][2][4][2], const Unit& u, int wr, int wc, int fr, int fq) const {
        const int row0 = u.pm * BM + wr * 64 + fr, col0 = u.pn * BM + wc * 32 + 8 * fq;
#pragma unroll
        for (int ai = 0; ai < 2; ++ai)
#pragma unroll
            for (int m = 0; m < 4; ++m) { bf16_t* rowp = O + (size_t)(row0 + ai * HALF + m * 16) * ldc + col0;
#pragma unroll
                for (int bj = 0; bj < 2; ++bj) { const f32x4 v0 = acc[ai][bj][m][0], v1 = acc[ai][bj][m][1];
                    u32x4 w; w.x = cvt_pk_bf16(v0[0], v0[1]); w.y = cvt_pk_bf16(v0[2], v0[3]); w.z = cvt_pk_bf16(v1[0], v1[1]); w.w = cvt_pk_bf16(v1[2], v1[3]);
                    *(u32x4*)(rowp + bj * HALF) = w; } }
    }
};
struct EpiResid {
    static constexpr bool PERM = false;
    const float* X; float* C; const float* gate;
    const float* ssq;
    __device__ __forceinline__ void rowscale(f32x4 (&acc)[2][2][4][2], const Unit& u, int wr, int fr) const {
        int rbase = u.pm * BM + wr * 64 + fr;
        asm volatile("" : "+v"(rbase));
#pragma unroll
        for (int ai = 0; ai < 2; ++ai)
#pragma unroll
            for (int m = 0; m < 4; ++m) { const f32x4 sv = *(const f32x4*)(ssq + (size_t)(rbase + ai * HALF + m * 16) * 4); const float r = rsqrtf(((sv[0] + sv[1]) + (sv[2] + sv[3])) * (1.0f / 256.0f) + EPS);
#pragma unroll
                for (int bj = 0; bj < 2; ++bj)
#pragma unroll
                    for (int n = 0; n < 2; ++n) acc[ai][bj][m][n] *= r; }
    }
    __device__ __forceinline__ void operator()(const f32x4 (&acc)[2][2][4][2], const Unit& u, int wr, int wc, int fr, int fq) const {
        const int row0 = u.pm * BM + wr * 64 + fr, col0 = u.pn * BM + wc * 32 + 4 * fq;
        const float* gp = gate + (size_t)((u.pm * BM) / S) * 6144 + col0;
        f32x4 gv[2][2];
#pragma unroll
        for (int bj = 0; bj < 2; ++bj)
#pragma unroll
            for (int n = 0; n < 2; ++n) gv[bj][n] = *(const f32x4*)(gp + bj * HALF + n * 16);
#pragma unroll
        for (int ai = 0; ai < 2; ++ai)
#pragma unroll
            for (int m = 0; m < 4; ++m) { const size_t off = (size_t)(row0 + ai * HALF + m * 16) * D + col0;
#pragma unroll
                for (int bj = 0; bj < 2; ++bj)
#pragma unroll
                    for (int n = 0; n < 2; ++n) { const f32x4 xv = *(const f32x4*)(X + off + bj * HALF + n * 16); *(f32x4*)(C + off + bj * HALF + n * 16) = xv + gv[bj][n] * acc[ai][bj][m][n]; }
                asm volatile("" ::: "memory"); }
    }
};
struct EpiHid {
    static constexpr bool PERM = true;
    bf16_t* H;
    __device__ __forceinline__ void operator()(const f32x4 (&acc)[2][2][4][2], const Unit& u, int wr, int wc, int fr, int fq) const {
        const int row0 = u.pm * BM + wr * 64 + fr, col0 = u.pn * HALF + wc * 32 + 8 * fq;
#pragma unroll
        for (int ai = 0; ai < 2; ++ai)
#pragma unroll
            for (int m = 0; m < 4; ++m) { float h[8];
#pragma unroll
                for (int n = 0; n < 2; ++n)
#pragma unroll
                    for (int j = 0; j < 4; ++j) h[n * 4 + j] = silu_fast(acc[ai][0][m][n][j]) * acc[ai][1][m][n][j];
                u32x4 w; w.x = cvt_pk_bf16(h[0], h[1]); w.y = cvt_pk_bf16(h[2], h[3]); w.z = cvt_pk_bf16(h[4], h[5]); w.w = cvt_pk_bf16(h[6], h[7]);
                *(u32x4*)(H + (size_t)(row0 + ai * HALF + m * 16) * F + col0) = w; }
    }
};
struct EpiDown {
    static constexpr bool PERM = true;
    bf16_t* Y; const float* lgate;
    __device__ __forceinline__ void operator()(const f32x4 (&acc)[2][2][4][2], const Unit& u, int wr, int wc, int fr, int fq) const {
        const int rl0 = wr * 64 + fr, col0 = u.pn * BM + wc * 32 + 8 * fq;
        const float* gp = lgate + (size_t)u.e * NTOK + u.mt * BM;
#pragma unroll
        for (int ai = 0; ai < 2; ++ai)
#pragma unroll
            for (int m = 0; m < 4; ++m) { const int rl = rl0 + ai * HALF + m * 16; const float g = (u.mt * BM + rl < u.cnt) ? gp[rl] : 0.f;
                bf16_t* rowp = Y + (size_t)(u.pm * BM + rl) * D + col0;
#pragma unroll
                for (int bj = 0; bj < 2; ++bj) { const f32x4 v0 = acc[ai][bj][m][0] * g, v1 = acc[ai][bj][m][1] * g;
                    u32x4 w; w.x = cvt_pk_bf16(v0[0], v0[1]); w.y = cvt_pk_bf16(v0[2], v0[3]); w.z = cvt_pk_bf16(v1[0], v1[1]); w.w = cvt_pk_bf16(v1[2], v1[3]);
                    *(u32x4*)(rowp + bj * HALF) = w; } }
    }
};

template <class Epi, class Sched, bool RSC = false>
__device__ __forceinline__ void gemm_phase(LAS unsigned char* lds, const Sched& S, const Epi& E) {
    const int tid = opaque_tid(), wid = __builtin_amdgcn_readfirstlane(tid >> 6), lane = tid & 63, wr = wid >> 2, wc = wid & 3, fr = lane & 15, fq = lane >> 4;
    const int K = S.K, nt = K / BK;
    int Rr[2], Cc[2]; unsigned voffB[2];
#pragma unroll
    for (int i = 0; i < 2; ++i) { stage_rc(tid * 16 + i * 8192, Rr[i], Cc[i]); const int Rb = Epi::PERM ? ((Rr[i] & ~31) + perm32(Rr[i] & 31)) : Rr[i]; voffB[i] = (unsigned)(Rb * K + Cc[i]) * 2u; }
    const size_t kstep = (size_t)(BK * 2);
    const size_t hstep = (size_t)HALF * K * 2;
    const unsigned ldsw = (unsigned)wid * 1024u;
    const int aoff = lds_byte(wr * 64 + fr, fq * 8), boff = lds_byte(wc * 32 + fr, fq * 8);
#define PG8_SA(b, h) (((b) * 2 + (h)) * HTB)
#define PG8_SB(b, h) ((4 + (b) * 2 + (h)) * HTB)
#define PG8_STAGE(bufoff, gbase, voff) do { _Pragma("unroll") for (int _i = 0; _i < 2; ++_i) \
        __builtin_amdgcn_global_load_lds((const unsigned*)((const char*)(gbase) + (voff)[_i]), (LAS unsigned*)(lds + (bufoff) + ldsw + _i * 8192), 16, 0, 0); } while (0)
#define PG8_LDA(dst, b, h) do { _Pragma("unroll") for (int m = 0; m < 4; ++m) _Pragma("unroll") for (int k = 0; k < 2; ++k) dst[m][k] = *(const LAS bf16x8*)(lds + PG8_SA(b, h) + aoff + m * 2048 + k * 1024); } while (0)
#define PG8_LDB(dst, b, h) do { _Pragma("unroll") for (int n = 0; n < 2; ++n) _Pragma("unroll") for (int k = 0; k < 2; ++k) dst[n][k] = *(const LAS bf16x8*)(lds + PG8_SB(b, h) + boff + n * 2048 + k * 1024); } while (0)
#define PG8_MMA(ai, bj, At, Bt) do { __builtin_amdgcn_s_setprio(1); _Pragma("unroll") for (int m = 0; m < 4; ++m) _Pragma("unroll") for (int n = 0; n < 2; ++n) _Pragma("unroll") for (int k = 0; k < 2; ++k) \
        acc[ai][bj][m][n] = __builtin_amdgcn_mfma_f32_16x16x32_bf16(Bt[n][k], At[m][k], acc[ai][bj][m][n], 0, 0, 0); __builtin_amdgcn_s_setprio(0); } while (0)
#define PG8_WAIT_V(n) asm volatile("s_waitcnt vmcnt(" #n ")" ::: "memory")
#define PG8_WAIT_L(n) asm volatile("s_waitcnt lgkmcnt(" #n ")" ::: "memory")
#define PG8_BAR __builtin_amdgcn_s_barrier()
#define PG8_SCHED __builtin_amdgcn_sched_barrier(0)
    Unit cur, nxt; int ui = 0;
    if (!S.next(0, cur)) return;
    f32x4 acc[2][2][4][2];
#pragma unroll
    for (int a = 0; a < 2; ++a)
#pragma unroll
        for (int b = 0; b < 2; ++b)
#pragma unroll
            for (int m = 0; m < 4; ++m)
#pragma unroll
                for (int n = 0; n < 2; ++n) acc[a][b][m][n] = (f32x4){0.f, 0.f, 0.f, 0.f};
    bf16x8 At[4][2], B0[2][2], B1[2][2];
    unsigned vA0[2], vA1[2], vN0[2], vN1[2];
#pragma unroll
    for (int i = 0; i < 2; ++i) { vA0[i] = S.a_voff(cur, Rr[i], Cc[i]); vA1[i] = S.a_voff(cur, HALF + Rr[i], Cc[i]); }
    const char* cA = S.a_base(cur); const char* cB = S.b_base(cur);
    PG8_STAGE(PG8_SB(0, 0), cB, voffB); PG8_STAGE(PG8_SB(0, 1), cB + hstep, voffB); PG8_STAGE(PG8_SA(0, 0), cA, vA0); PG8_STAGE(PG8_SA(0, 1), cA, vA1);
    if (wr == 1) PG8_BAR;
    PG8_WAIT_V(2); PG8_BAR;
    PG8_STAGE(PG8_SB(1, 0), cB + kstep, voffB); PG8_STAGE(PG8_SA(1, 0), cA + kstep, vA0); PG8_STAGE(PG8_SB(1, 1), cB + hstep + kstep, voffB);
    PG8_WAIT_V(6); PG8_BAR;
    for (;;) {
        const bool has_next = S.next(ui + 1, nxt);
        const char* nA = has_next ? S.a_base(nxt) : cA; const char* nB = has_next ? S.b_base(nxt) : cB;
#pragma unroll
        for (int i = 0; i < 2; ++i) { vN0[i] = has_next ? S.a_voff(nxt, Rr[i], Cc[i]) : vA0[i]; vN1[i] = has_next ? S.a_voff(nxt, HALF + Rr[i], Cc[i]) : vA1[i]; }
        for (int t = 0; t < nt; t += 2) {
            const bool last = (t == nt - 2);
            if constexpr (RSC) { if (t == 4) E.rowscale(acc, cur, wr, fr); }
            const char* a1 = cA + (size_t)(t + 1) * kstep;
            const char* a2 = last ? nA : cA + (size_t)(t + 2) * kstep; const char* b2 = last ? nB : cB + (size_t)(t + 2) * kstep;
            const char* a3 = a2 + kstep; const char* b3 = b2 + kstep;
            unsigned w0[2], w1[2];
#pragma unroll
            for (int i = 0; i < 2; ++i) { w0[i] = last ? vN0[i] : vA0[i]; w1[i] = last ? vN1[i] : vA1[i]; }
            PG8_LDB(B0, 0, 0); PG8_LDB(B1, 0, 1); PG8_SCHED; PG8_LDA(At, 0, 0); PG8_STAGE(PG8_SA(1, 1), a1, vA1);
            PG8_WAIT_V(8); PG8_WAIT_L(0); PG8_BAR; PG8_MMA(0, 0, At, B0); PG8_MMA(0, 1, At, B1); PG8_BAR; PG8_SCHED;
            PG8_LDA(At, 0, 1); PG8_STAGE(PG8_SB(0, 0), b2, voffB); PG8_STAGE(PG8_SB(0, 1), b2 + hstep, voffB); PG8_STAGE(PG8_SA(0, 0), a2, w0);
            PG8_WAIT_V(8); PG8_WAIT_L(0); PG8_BAR; PG8_MMA(1, 0, At, B0); PG8_MMA(1, 1, At, B1); PG8_BAR; PG8_SCHED;
            PG8_LDB(B0, 1, 0); PG8_LDB(B1, 1, 1); PG8_SCHED; PG8_LDA(At, 1, 0); PG8_STAGE(PG8_SA(0, 1), a2, w1);
            PG8_WAIT_V(8); PG8_WAIT_L(0); PG8_BAR; PG8_MMA(0, 0, At, B0); PG8_MMA(0, 1, At, B1); PG8_BAR; PG8_SCHED;
            PG8_LDA(At, 1, 1); PG8_STAGE(PG8_SB(1, 0), b3, voffB); PG8_STAGE(PG8_SB(1, 1), b3 + hstep, voffB); PG8_STAGE(PG8_SA(1, 0), a3, w0);
            PG8_WAIT_V(8); PG8_WAIT_L(0); PG8_BAR; PG8_MMA(1, 0, At, B0); PG8_MMA(1, 1, At, B1); PG8_BAR; PG8_SCHED;
        }
        if (wr == 0) PG8_BAR;
        E(acc, cur, wr, wc, fr, fq);
        if (!has_next) break;
#pragma unroll
        for (int a = 0; a < 2; ++a)
#pragma unroll
            for (int b = 0; b < 2; ++b)
#pragma unroll
                for (int m = 0; m < 4; ++m)
#pragma unroll
                    for (int n = 0; n < 2; ++n) acc[a][b][m][n] = (f32x4){0.f, 0.f, 0.f, 0.f};
        cur = nxt; cA = nA; cB = nB; ++ui;
#pragma unroll
        for (int i = 0; i < 2; ++i) { vA0[i] = vN0[i]; vA1[i] = vN1[i]; }
        if (wr == 1) PG8_BAR;
    }
    PG8_WAIT_V(0);
    PG8_BAR;
#undef PG8_SA
#undef PG8_SB
#undef PG8_STAGE
#undef PG8_LDA
#undef PG8_LDB
#undef PG8_MMA
#undef PG8_WAIT_V
#undef PG8_WAIT_L
#undef PG8_BAR
#undef PG8_SCHED
}
}
struct Args { const void* in[32]; float* out; unsigned char* ws; int l_lo, l_hi, ph_lo, ph_hi, fused, pad; };
enum { PH_PRO = 0, PH_NORM0 = 1, PH_G1 = 2, PH_MIX = 3, PH_A1 = 4, PH_A2 = 5, PH_AN = 6, PH_G2 = 7, PH_ROUTE = 8, PH_UP = 9, PH_DOWN = 10, PH_COMB = 11, PH_END = 12 };

typedef const Args __attribute__((address_space(4))) KArgs;
__device__ __forceinline__ KArgs* kargs() { KArgs* p = (KArgs*)__builtin_amdgcn_kernarg_segment_ptr(); asm volatile("" : "+s"(p)); return p; }
#define IN_F(i) ((const float*)ka->in[i])
enum { I_X = 0, I_C, I_POS, I_WADA, I_BADA, I_NORM1, I_WIN, I_QN, I_KN, I_CONVW, I_CONVB, I_CLNG, I_CLNB, I_PWW, I_PWB, I_POOLW, I_POOLB, I_POOLS, I_SLNG, I_SLNB, I_SGUW, I_SGUB,
       I_ONORM, I_WOUT, I_NORM2, I_WRG, I_BRG, I_WRE, I_BRE, I_WG, I_WU, I_WD };

__device__ __forceinline__ void sincos_d(double a, double& s, double& c) {
    const double k = rint(a * 0.63661977236758134308);
    const double r = (a - k * 1.57079632679489655800) - k * 6.123233995736766036e-17;
    const double r2 = r * r;
    const double sp = r * (1.0 + r2 * (-1.0 / 6 + r2 * (1.0 / 120 + r2 * (-1.0 / 5040 + r2 * (1.0 / 362880 + r2 * (-1.0 / 39916800 + r2 * (1.0 / 6227020800.0)))))));
    const double cp = 1.0 + r2 * (-0.5 + r2 * (1.0 / 24 + r2 * (-1.0 / 720 + r2 * (1.0 / 40320 + r2 * (-1.0 / 3628800 + r2 * (1.0 / 479001600.0 + r2 * (-1.0 / 87178291200.0)))))));
    const int q = ((int)k) & 3;
    if (q == 0) { s = sp; c = cp; } else if (q == 1) { s = cp; c = -sp; } else if (q == 2) { s = -sp; c = -cp; } else { s = -cp; c = sp; }
}

__device__ __forceinline__ bf16_t f2bf_(float f) { return (bf16_t)(cvt_pk_bf16(f, 0.f) & 0xffffu); }
struct TItem { const float* src; int ld; int ncol; bf16_t* dst; int ldd; const float* rsc; };
constexpr int NT_WIN = L * 36 * 4, NT_WOUT = L * 16 * 4, NT_PW = L * 4, NT_WGU = L * NE * 16 * 4, NT_WD = L * NE * 16 * 2;
constexpr int NT_ALL = NT_WIN + NT_WOUT + NT_PW + NT_WGU + NT_WD;
__device__ __forceinline__ void decode_titem(int it, const Args& a, TItem& t) {
    KArgs* ka = kargs();
    unsigned char* ws = ka->ws;
    t.rsc = nullptr;
    if (it < NT_WIN) {
        const int l = it / 144, r = it % 144, n0 = (r >> 2) * 64, k0 = (r & 3) * 256;
        const int c0 = n0 < 768 ? n0 + 256 : (n0 < 2048 ? n0 + 164 : n0 - 2048);
        t.ncol = (n0 < 768) ? ((n0 + 64 <= 676) ? 64 : (n0 < 676 ? 676 - n0 : 0)) : 64;
        t.src = IN_F(I_WIN) + ((size_t)l * D + k0) * DIN + c0; t.ld = DIN;
        t.dst = (bf16_t*)(ws + WS_WINT) + ((size_t)l * NP + n0) * D + k0; t.ldd = D; return;
    }
    it -= NT_WIN;
    if (it < NT_WOUT) {
        const int l = it / 64, r = it % 64, n0 = (r >> 2) * 64, k0 = (r & 3) * 256;
        t.ncol = 64; t.src = IN_F(I_WOUT) + ((size_t)l * D + k0) * D + n0; t.ld = D; t.rsc = (k0 == 0) ? IN_F(I_ONORM) + l * D : nullptr;
        t.dst = (bf16_t*)(ws + WS_WOUTT) + ((size_t)l * D + n0) * D + k0; t.ldd = D; return;
    }
    it -= NT_WOUT;
    if (it < NT_PW) {
        const int l = it / 4, n0 = (it & 3) * 64;
        t.ncol = 64; t.src = IN_F(I_PWW) + (size_t)l * 65536 + n0; t.ld = 256;
        t.dst = (bf16_t*)(ws + WS_PWT) + ((size_t)l * 256 + n0) * 256; t.ldd = 256; return;
    }
    it -= NT_PW;
    if (it < NT_WGU) {
        const int le = it / 64, r = it % 64, n0 = (r >> 2) * 64, k0 = (r & 3) * 256;
        const int pn = n0 >> 8, rr = n0 & 255;
        const float* W = (rr < 128) ? IN_F(I_WG) : IN_F(I_WU);
        t.ncol = 64; t.src = W + ((size_t)le * D + k0) * F + pn * 128 + (rr & 127); t.ld = F;
        t.dst = (bf16_t*)(ws + WS_WGUT) + ((size_t)le * 1024 + n0) * D + k0; t.ldd = D; return;
    }
    it -= NT_WGU;
    {
        const int le = it / 32, r = it % 32, n0 = (r >> 1) * 64, k0 = (r & 1) * 256;
        t.ncol = 64; t.src = IN_F(I_WD) + ((size_t)le * F + k0) * D + n0; t.ld = D;
        t.dst = (bf16_t*)(ws + WS_WDT) + ((size_t)le * D + n0) * F + k0; t.ldd = F;
    }
}
__device__ __forceinline__ void titem_load(const TItem& t, int tid, float4 (&v)[8]) {
    const int c4 = tid & 15, r0 = tid >> 4;
#pragma unroll
    for (int i = 0; i < 8; ++i) v[i] = (c4 * 4 < t.ncol) ? *(const float4*)(t.src + (size_t)(r0 + 32 * i) * t.ld + c4 * 4) : make_float4(0.f, 0.f, 0.f, 0.f);
    if (t.rsc) {
#pragma unroll
        for (int i = 0; i < 8; ++i) { const float s = t.rsc[r0 + 32 * i]; v[i].x *= s; v[i].y *= s; v[i].z *= s; v[i].w *= s; }
    }
}
__device__ __forceinline__ void phase_prologue(const Args& a, LAS unsigned char* lds, int vcu, int G) {
    KArgs* ka = kargs();
    const int tid = opaque_tid(), wid = __builtin_amdgcn_readfirstlane(tid >> 6), lane = tid & 63;
    LAS float* T = (LAS float*)lds;
    LAS float* cs = (LAS float*)(lds + 66560);
    LAS float* red = (LAS float*)(lds + 66560 + 16384);
    unsigned char* ws = ka->ws;
    if (vcu < 192) {
        for (int i = tid; i < 4096; i += NTHR) cs[i] = silu_f(IN_F(I_C)[i]);
        __syncthreads();
        for (int it = vcu; it < 192; it += G) {
            const int l = it / 96, j0 = (it % 96) * 64;
            const float* wp = IN_F(I_WADA) + ((size_t)l * D + wid * 128) * 6144 + j0 + lane;
            float a0 = 0.f, a1 = 0.f, a2 = 0.f, a3 = 0.f;
#pragma unroll 32
            for (int k = 0; k < 128; ++k) { const float wv = wp[(size_t)k * 6144]; const int kk = wid * 128 + k; a0 += cs[kk] * wv; a1 += cs[1024 + kk] * wv; a2 += cs[2048 + kk] * wv; a3 += cs[3072 + kk] * wv; }
            red[(wid * 4 + 0) * 64 + lane] = a0; red[(wid * 4 + 1) * 64 + lane] = a1; red[(wid * 4 + 2) * 64 + lane] = a2; red[(wid * 4 + 3) * 64 + lane] = a3;
            __syncthreads();
            if (wid < 4) { float s = 0.f;
#pragma unroll
                for (int w = 0; w < 8; ++w) s += red[(w * 4 + wid) * 64 + lane];
                ((float*)(ws + WS_MOD))[((size_t)l * 4 + wid) * 6144 + j0 + lane] = s + IN_F(I_BADA)[l * 6144 + j0 + lane]; }
            __syncthreads();
        }
    }
    for (int i = vcu * NTHR + tid; i < NTOK; i += G * NTHR) {
        const float invA[8] = {1.0f, 0.1939227432012558f, 0.03760603070259094f, 0.007292664609849453f, 0.0014142135623842478f, 0.00027424818836152554f, 5.318296098266728e-05f, 1.0313386155758053e-05f};
        const float invI[4] = {1.0f, 0.03760603070259094f, 0.0014142135623842478f, 5.318296098266728e-05f};
        const float p = (float)((const int*)ka->in[I_POS])[i];
        float* ra = (float*)(ws + WS_ROPEA) + (size_t)i * 16; float* ri = (float*)(ws + WS_ROPEI) + (size_t)i * 8;
#pragma unroll
        for (int j = 0; j < 8; ++j) { const float ang = p * invA[j]; double s, c; sincos_d((double)ang, s, c); ra[j] = (float)c; ra[8 + j] = (float)s; }
#pragma unroll
        for (int j = 0; j < 4; ++j) { const float ang = p * invI[j]; double s, c; sincos_d((double)ang, s, c); ri[j] = (float)c; ri[4 + j] = (float)s; }
    }
    for (int i = vcu * NTHR + tid; i < L * 4 * 128 * 128; i += G * NTHR) { const int s = i & 127, t = (i >> 7) & 127; ((bf16_t*)(ws + WS_SGUW))[i] = (bf16_t)(cvt_pk_bf16(s <= t ? IN_F(I_SGUW)[i] : 0.f, 0.f) & 0xffffu); }
    for (int i = vcu * NTHR + tid; i < L * 4 * 64 * 64; i += G * NTHR) { const int c = i & 63, d = (i >> 6) & 63, lg = i >> 12; ((bf16_t*)(ws + WS_POOLT))[i] = (bf16_t)(cvt_pk_bf16(IN_F(I_POOLW)[((size_t)lg * 64 + c) * 64 + d], 0.f) & 0xffffu); }
    for (int i = vcu * NTHR + tid; i < L * 48 * 1024; i += G * NTHR) {
        const int k = i & 1023, n = (i >> 10) % 48, lg = i / (48 * 1024);
        const float w = (n < 4) ? IN_F(I_WRG)[((size_t)lg * D + k) * 4 + n] : (n < 36) ? IN_F(I_WRE)[((size_t)lg * D + k) * 32 + (n - 4)] : 0.f;
        const unsigned hi = cvt_pk_bf16(w, 0.f) & 0xffffu; const float lo = w - __uint_as_float(hi << 16);
        bf16_t* dst = (bf16_t*)(ws + WS_WHL) + (size_t)lg * 2 * 48 * 1024 + (size_t)n * 1024 + k;
        dst[0] = (bf16_t)hi; dst[48 * 1024] = f2bf_(lo);
    }
    int it = (G - 1 - vcu);
    bool have = it < NT_ALL;
    TItem cur; cur.src = nullptr; cur.ld = 0; cur.ncol = 0; cur.dst = nullptr; cur.ldd = 0; cur.rsc = nullptr;
    float4 v[8];
    if (have) { decode_titem(it, a, cur); titem_load(cur, tid, v); }
    while (have) {
        { const int c4 = tid & 15, r0 = tid >> 4;
#pragma unroll
          for (int i = 0; i < 8; ++i) { LAS float* tp = T + (r0 + 32 * i) * 65 + c4 * 4; tp[0] = v[i].x; tp[1] = v[i].y; tp[2] = v[i].z; tp[3] = v[i].w; } }
        __syncthreads();
        const int itn = it + G; const bool hn = itn < NT_ALL; TItem nx = cur;
        if (hn) { decode_titem(itn, a, nx); titem_load(nx, tid, v); }
        { const int n = tid >> 3, kq = tid & 7;
#pragma unroll
          for (int j = 0; j < 4; ++j) { const int kc = j * 8 + kq; float f[8];
#pragma unroll
              for (int jj = 0; jj < 8; ++jj) f[jj] = T[(kc * 8 + jj) * 65 + n];
              u32x4 w; w.x = cvt_pk_bf16(f[0], f[1]); w.y = cvt_pk_bf16(f[2], f[3]); w.z = cvt_pk_bf16(f[4], f[5]); w.w = cvt_pk_bf16(f[6], f[7]);
              *(u32x4*)(cur.dst + (size_t)n * cur.ldd + kc * 8) = w; } }
        __syncthreads();
        cur = nx; it = itn; have = hn;
    }
}

__device__ __forceinline__ void phase_norm(const float* __restrict__ xin, const float* g, const float* shift, const float* scale, bf16_t* __restrict__ out, int vcu, int G) {
    const int tid = opaque_tid(), wid = __builtin_amdgcn_readfirstlane(tid >> 6), lane = tid & 63;
    for (int rb = vcu * 8 + wid; rb < NTOK / 8; rb += G * 8) {
        const int row0 = rb * 8, b = row0 / S;
        float4 A[4], C[4];
#pragma unroll
        for (int i = 0; i < 4; ++i) { const int k = 256 * i + 4 * lane; const float4 gv = *(const float4*)(g + k), sc = *(const float4*)(scale + (size_t)b * 6144 + k); C[i] = *(const float4*)(shift + (size_t)b * 6144 + k);
            A[i] = make_float4(gv.x * (1.f + sc.x), gv.y * (1.f + sc.y), gv.z * (1.f + sc.z), gv.w * (1.f + sc.w)); }
#pragma unroll 4
        for (int rr = 0; rr < 8; ++rr) {
            const size_t ro = (size_t)(row0 + rr) * D;
            float4 x[4]; float ss = 0.f;
#pragma unroll
            for (int i = 0; i < 4; ++i) { x[i] = *(const float4*)(xin + ro + 256 * i + 4 * lane); ss += x[i].x * x[i].x + x[i].y * x[i].y + x[i].z * x[i].z + x[i].w * x[i].w; }
            const float r = rsqrtf(wave_sum(ss) * (1.0f / D) + EPS);
#pragma unroll
            for (int i = 0; i < 4; ++i) { u32x2 w; w.x = cvt_pk_bf16(x[i].x * r * A[i].x + C[i].x, x[i].y * r * A[i].y + C[i].y); w.y = cvt_pk_bf16(x[i].z * r * A[i].z + C[i].z, x[i].w * r * A[i].w + C[i].w);
                *(u32x2*)(out + ro + 256 * i + 4 * lane) = w; }
        }
    }
}

__device__ __forceinline__ f32x4 mfma16r(const bf16x8 a, const bf16x8 b, const f32x4 c) { return __builtin_amdgcn_mfma_f32_16x16x32_bf16(a, b, c, 0, 0, 0); }
__device__ __forceinline__ void phase_rbias(const Args& a, LAS unsigned char* lds, int vcu) {
    KArgs* ka = kargs();
    const int tid = opaque_tid();
    if (vcu >= L * 4) return;
    const int l = vcu >> 2, b = vcu & 3, n = tid & 63, kp = tid >> 6;
    const float* sh = (const float*)(ka->ws + WS_MOD) + ((size_t)l * 4 + b) * 6144 + 3072;
    LAS float* red = (LAS float*)lds;
    float s = 0.f;
    if (n < 36) for (int k = kp * 128; k < kp * 128 + 128; ++k) s += sh[k] * ((n < 4) ? IN_F(I_WRG)[((size_t)l * D + k) * 4 + n] : IN_F(I_WRE)[((size_t)l * D + k) * 32 + (n - 4)]);
    red[kp * 64 + n] = s;
    __syncthreads();
    if (tid < 48) { float t = 0.f;
        if (tid < 36) { for (int w = 0; w < 8; ++w) t += red[w * 64 + tid]; t += (tid < 4) ? IN_F(I_BRG)[l * 4 + tid] : IN_F(I_BRE)[l * 32 + tid - 4]; }
        ((float*)(ka->ws + WS_RBIAS))[((size_t)l * 4 + b) * 48 + tid] = t; }
}

__device__ __forceinline__ void phase_route(const Args& a, int l, LAS unsigned char* lds, int vcu, int G) {
    KArgs* ka = kargs();
    const int tid = opaque_tid(), wid = __builtin_amdgcn_readfirstlane(tid >> 6), lane = tid & 63, fr = lane & 15, kq = lane >> 4;
    unsigned char* ws = ka->ws;
    const float* x1 = (const float*)(ws + WS_X1);
    const float* mod = (const float*)(ws + WS_MOD) + (size_t)l * 4 * 6144;
    const float* g = IN_F(I_NORM2) + l * D; const float* shift = mod + 3072; const float* scale = mod + 4096;
    bf16_t* out = (bf16_t*)(ws + WS_HA);
    int* counts = (int*)(ws + WS_CNT) + l * NE * 64; int* list = (int*)(ws + WS_LIST); float* lgate = (float*)(ws + WS_LGATE); int* tokinfo = (int*)(ws + WS_TOKINFO);
    LAS int* lcnt = (LAS int*)(lds + LDS_MISC + 1024); LAS int* lbase = lcnt + 32; LAS int* rte = lbase + 32; LAS int* rtp = rte + 128; LAS int* rtt = rtp + 128; LAS float* rtg = (LAS float*)(rtt + 128);
#ifdef MK_ROUTE_PROBE
    if (a.pad) { counts = (int*)(ws + WS_CNT) + 4096 + l * NE * 64; unsigned char* sc = ws + ((size_t)440 << 20); out = (bf16_t*)sc; list = (int*)(sc + ((size_t)34 << 20)); lgate = (float*)(sc + ((size_t)37 << 20)); tokinfo = (int*)(sc + ((size_t)40 << 20)); }
#endif
    LAS float* part = (LAS float*)lds;
    LAS float* ssp = part + 8 * 16 * 48;
    LAS float* lgt = ssp + 8 * 16;
    LAS float* rrow = lgt + 16 * 48;
    const bf16_t* wh = (const bf16_t*)(ws + WS_WHL) + (size_t)l * 2 * 48 * 1024 + (size_t)fr * 1024 + 128 * wid + 8 * kq;
    for (int r0 = vcu * 64; r0 < NTOK; r0 += G * 64) {
        const int b = r0 / S;
        const float* rb = (const float*)(ws + WS_RBIAS) + ((size_t)l * 4 + b) * 48;
        if (tid < 32) lcnt[tid] = 0;
#pragma unroll 1
        for (int q4 = 0; q4 < 4; ++q4) {
            float t[4][8];
            f32x4 acc[3];
#pragma unroll
            for (int nt = 0; nt < 3; ++nt) acc[nt] = (f32x4){0.f, 0.f, 0.f, 0.f};
            float ss = 0.f;
            const int row = r0 + 16 * q4 + fr;
#pragma unroll
            for (int ks = 0; ks < 4; ++ks) {
                const int k0 = 128 * wid + 32 * ks + 8 * kq;
                const f32x4 g0 = *(const f32x4*)(g + k0), g1 = *(const f32x4*)(g + k0 + 4), s0 = *(const f32x4*)(scale + (size_t)b * 6144 + k0), s1 = *(const f32x4*)(scale + (size_t)b * 6144 + k0 + 4);
                const float Ac[8] = {g0[0] * (1.f + s0[0]), g0[1] * (1.f + s0[1]), g0[2] * (1.f + s0[2]), g0[3] * (1.f + s0[3]), g1[0] * (1.f + s1[0]), g1[1] * (1.f + s1[1]), g1[2] * (1.f + s1[2]), g1[3] * (1.f + s1[3])};
                const float* xp = x1 + (size_t)row * D + k0;
                const f32x4 v0 = *(const f32x4*)xp, v1 = *(const f32x4*)(xp + 4);
                const float v[8] = {v0[0], v0[1], v0[2], v0[3], v1[0], v1[1], v1[2], v1[3]};
                unsigned ph[4], pl[4];
#pragma unroll
                for (int j = 0; j < 8; ++j) { ss += v[j] * v[j]; t[ks][j] = v[j] * Ac[j]; }
#pragma unroll
                for (int j = 0; j < 4; ++j) { ph[j] = cvt_pk_bf16(t[ks][2 * j], t[ks][2 * j + 1]); pl[j] = cvt_pk_bf16(t[ks][2 * j] - bflo(ph[j]), t[ks][2 * j + 1] - bfhi(ph[j])); }
                const bf16x8 Ah = __builtin_bit_cast(bf16x8, (u32x4){ph[0], ph[1], ph[2], ph[3]}), Al = __builtin_bit_cast(bf16x8, (u32x4){pl[0], pl[1], pl[2], pl[3]});
#pragma unroll
                for (int nt = 0; nt < 3; ++nt) {
                    const bf16x8 Bh = *(const bf16x8*)(wh + (size_t)(16 * nt) * 1024 + 32 * ks), Bl = *(const bf16x8*)(wh + 48 * 1024 + (size_t)(16 * nt) * 1024 + 32 * ks);
                    acc[nt] = mfma16r(Ah, Bh, acc[nt]); acc[nt] = mfma16r(Al, Bh, acc[nt]); acc[nt] = mfma16r(Ah, Bl, acc[nt]);
                }
            }
            ss += __shfl_xor(ss, 16); ss += __shfl_xor(ss, 32);
            if (kq == 0) ssp[wid * 16 + fr] = ss;
#pragma unroll
            for (int nt = 0; nt < 3; ++nt)
#pragma unroll
                for (int r = 0; r < 4; ++r) part[(wid * 16 + 4 * kq + r) * 48 + 16 * nt + fr] = acc[nt][r];
            __syncthreads();
            for (int i = tid; i < 16 * 48; i += NTHR) { float s = 0.f;
#pragma unroll
                for (int w = 0; w < 8; ++w) s += part[w * 16 * 48 + i];
                lgt[i] = s; }
            if (tid < 16) { float s = 0.f;
#pragma unroll
                for (int w = 0; w < 8; ++w) s += ssp[w * 16 + tid];
                rrow[tid] = rsqrtf(s * (1.0f / D) + EPS); }
            __syncthreads();
            if (tid < 16) {
                const int tok = r0 + 16 * q4 + tid; const float r = rrow[tid];
                float ag[4];
#pragma unroll
                for (int j = 0; j < 4; ++j) ag[j] = r * lgt[tid * 48 + j] + rb[j];
                int gi = 0; float gm = ag[0];
#pragma unroll
                for (int j = 1; j < 4; ++j) if (ag[j] > gm) { gm = ag[j]; gi = j; }
                float den = 0.f;
#pragma unroll
                for (int j = 0; j < 4; ++j) den += expf(ag[j] - gm);
                const float p_sel = 1.0f / den;
                float el[8];
#pragma unroll
                for (int j = 0; j < 8; ++j) el[j] = r * lgt[tid * 48 + 4 + gi * 8 + j] + rb[4 + gi * 8 + j];
                int j0 = 0; float v0 = el[0];
#pragma unroll
                for (int j = 1; j < 8; ++j) if (el[j] > v0) { v0 = el[j]; j0 = j; }
                int j1 = 0; float v1 = -INFINITY;
#pragma unroll
                for (int j = 0; j < 8; ++j) if (j != j0 && el[j] > v1) { v1 = el[j]; j1 = j; }
                const float e1 = expf(v1 - v0);
                const float g0 = p_sel / (1.0f + e1), g1 = p_sel * e1 / (1.0f + e1);
                const int ex0 = gi * 8 + j0, ex1 = gi * 8 + j1, ai = (16 * q4 + tid) * 2;
                const int p0 = __hip_atomic_fetch_add(lcnt + ex0, 1, __ATOMIC_RELAXED, __HIP_MEMORY_SCOPE_WORKGROUP), p1 = __hip_atomic_fetch_add(lcnt + ex1, 1, __ATOMIC_RELAXED, __HIP_MEMORY_SCOPE_WORKGROUP);
                rte[ai] = ex0; rtp[ai] = p0; rtt[ai] = tok; rtg[ai] = g0;
                rte[ai + 1] = ex1; rtp[ai + 1] = p1; rtt[ai + 1] = tok; rtg[ai + 1] = g1;
            }
            {
                const float r = rrow[fr];
                bf16_t* op = out + (size_t)row * D + 128 * wid + 8 * kq;
#pragma unroll
                for (int ks = 0; ks < 4; ++ks) {
                    const float* cp = shift + (size_t)b * 6144 + 128 * wid + 32 * ks + 8 * kq;
                    const f32x4 c0 = *(const f32x4*)cp, c1 = *(const f32x4*)(cp + 4);
                    u32x4 w; w.x = cvt_pk_bf16(t[ks][0] * r + c0[0], t[ks][1] * r + c0[1]); w.y = cvt_pk_bf16(t[ks][2] * r + c0[2], t[ks][3] * r + c0[3]);
                    w.z = cvt_pk_bf16(t[ks][4] * r + c1[0], t[ks][5] * r + c1[1]); w.w = cvt_pk_bf16(t[ks][6] * r + c1[2], t[ks][7] * r + c1[3]);
                    *(u32x4*)(op + 32 * ks) = w;
                }
            }
            __syncthreads();
        }
        if (tid < 32) { const int c = lcnt[tid]; lbase[tid] = c ? atomicAdd(&counts[tid * 64], c) : 0; }
        __syncthreads();
        if (tid < 128) { const int e = rte[tid], pos = lbase[e] + rtp[tid], tk = rtt[tid];
            list[(size_t)e * NTOK + pos] = tk; lgate[(size_t)e * NTOK + pos] = rtg[tid];
            tokinfo[tk * 4 + (tid & 1) * 2] = e; tokinfo[tk * 4 + (tid & 1) * 2 + 1] = pos; }
        __syncthreads();
    }
}

__device__ __forceinline__ void moe_cum(const Args& a, int l, LAS unsigned char* lds) {
    KArgs* ka = kargs();
    LAS int* cum = (LAS int*)(lds + LDS_MISC + MISC_CUM); LAS int* cn = (LAS int*)(lds + LDS_MISC + MISC_CNT);
    const int* counts = (const int*)(ka->ws + WS_CNT) + l * NE * 64;
    const int tq = opaque_tid();
    if (tq < 33) { int s = 0; for (int j = 0; j < tq; ++j) s += (ld_agent(counts + j * 64) + 255) >> 8; cum[tq] = s; if (tq < 32) cn[tq] = ld_agent(counts + tq * 64); }
    __syncthreads();
}

__device__ __forceinline__ void phase_combine(const Args& a, int l, LAS unsigned char* lds, int vcu, int G) {
    KArgs* ka = kargs();
    const int tid = opaque_tid(), wid = __builtin_amdgcn_readfirstlane(tid >> 6), lane = tid & 63;
    unsigned char* ws = ka->ws;
    moe_cum(a, l, lds);
    const LAS int* cum = (const LAS int*)(lds + LDS_MISC + MISC_CUM);
    const float* __restrict__ x1 = (const float*)(ws + WS_X1);
    const float* mod = (const float*)(ws + WS_MOD) + (size_t)l * 4 * 6144;
    const float* gate2 = mod + 5120;
    const bf16_t* __restrict__ Y = (const bf16_t*)(ws + WS_Y);
    const int* __restrict__ tokinfo = (const int*)(ws + WS_TOKINFO);
    float* __restrict__ outp = ka->out;
    const bool nextl = (l + 1 < L);
    const float* modn = (const float*)(ws + WS_MOD) + (size_t)(nextl ? l + 1 : l) * 4 * 6144;
    const float* gn = IN_F(I_NORM1) + (nextl ? l + 1 : l) * D;
    bf16_t* __restrict__ hout = (bf16_t*)(ws + WS_HA);
    for (int rb = vcu * 8 + wid; rb < NTOK / 8; rb += G * 8) {
        const int row0 = rb * 8, b = row0 / S;
        float4 A[4], C[4], G2[4];
#pragma unroll
        for (int i = 0; i < 4; ++i) { const int k = 256 * i + 4 * lane; const float4 gv = *(const float4*)(gn + k), sc = *(const float4*)(modn + 1024 + (size_t)b * 6144 + k); C[i] = *(const float4*)(modn + (size_t)b * 6144 + k);
            A[i] = make_float4(gv.x * (1.f + sc.x), gv.y * (1.f + sc.y), gv.z * (1.f + sc.z), gv.w * (1.f + sc.w)); G2[i] = *(const float4*)(gate2 + (size_t)b * 6144 + k); }
#pragma unroll 4
        for (int rr = 0; rr < 8; ++rr) {
            const int tok = row0 + rr; const size_t ro = (size_t)tok * D;
            const int4 ti = *(const int4*)(tokinfo + tok * 4);
            const size_t s0 = (size_t)(cum[ti.x] * 256 + ti.y) * D, s1 = (size_t)(cum[ti.z] * 256 + ti.w) * D;
            float4 xo[4]; float ss = 0.f;
#pragma unroll
            for (int i = 0; i < 4; ++i) { const int k = 256 * i + 4 * lane; const float4 xv = *(const float4*)(x1 + ro + k); const u32x2 y0 = *(const u32x2*)(Y + s0 + k), y1 = *(const u32x2*)(Y + s1 + k);
                xo[i].x = xv.x + G2[i].x * (bflo(y0.x) + bflo(y1.x)); xo[i].y = xv.y + G2[i].y * (bfhi(y0.x) + bfhi(y1.x)); xo[i].z = xv.z + G2[i].z * (bflo(y0.y) + bflo(y1.y)); xo[i].w = xv.w + G2[i].w * (bfhi(y0.y) + bfhi(y1.y));
                *(float4*)(outp + ro + k) = xo[i]; ss += xo[i].x * xo[i].x + xo[i].y * xo[i].y + xo[i].z * xo[i].z + xo[i].w * xo[i].w; }
            if (nextl) {
                const float r = rsqrtf(wave_sum(ss) * (1.0f / D) + EPS);
#pragma unroll
                for (int i = 0; i < 4; ++i) { u32x2 w; w.x = cvt_pk_bf16(xo[i].x * r * A[i].x + C[i].x, xo[i].y * r * A[i].y + C[i].y); w.y = cvt_pk_bf16(xo[i].z * r * A[i].z + C[i].z, xo[i].w * r * A[i].w + C[i].w);
                    *(u32x2*)(hout + ro + 256 * i + 4 * lane) = w; }
            }
        }
    }
}
constexpr size_t WS_KN = WS_R2;
constexpr size_t WS_VT = WS_KN + al256c((size_t)NTOK * 256 * 2);
constexpr size_t WS_IKR = WS_VT + al256c((size_t)NTOK * 256 * 2);
constexpr size_t WS_MASK = WS_IKR + al256c((size_t)NTOK * 32 * 2);
constexpr size_t WS_OA = WS_MASK + al256c((size_t)NTOK * 128 * 4);
constexpr size_t WS_R3 = WS_OA + al256c((size_t)NTOK * 256 * 2);
constexpr size_t WS_MIXB = (WS_R3 > WS_Y + (size_t)SLOTS * D * 2 ? WS_R3 : WS_Y + al256c((size_t)SLOTS * D * 2));

__device__ __forceinline__ f32x4 mfma16(const bf16x8 a, const bf16x8 b, const f32x4 c) { return __builtin_amdgcn_mfma_f32_16x16x32_bf16(a, b, c, 0, 0, 0); }
__device__ __forceinline__ bf16_t f2bf(float f) { return (bf16_t)(cvt_pk_bf16(f, 0.f) & 0xffffu); }

__device__ __forceinline__ void rows_rms_store(const LAS float* YB, const float* gain, bf16_t* mixb, int tok0, int col0, int wid, int lane) {
    const f32x4 gv = *(const f32x4*)(gain + 4 * lane);
#pragma unroll 2
    for (int rr = 0; rr < 8; ++rr) {
        const int t = 8 * wid + rr;
        const f32x4 y = *(const LAS f32x4*)(YB + t * 260 + 4 * lane);
        const float ss = wave_sum(y[0] * y[0] + y[1] * y[1] + y[2] * y[2] + y[3] * y[3]);
        const float r = rsqrtf(ss * (1.0f / 256.0f) + EPS);
        u32x2 w; w.x = cvt_pk_bf16(y[0] * r * gv[0], y[1] * r * gv[1]); w.y = cvt_pk_bf16(y[2] * r * gv[2], y[3] * r * gv[3]);
        *(u32x2*)(mixb + (size_t)(tok0 + t) * D + col0 + 4 * lane) = w;
    }
}

__device__ __forceinline__ void item_pool(const Args& a, int l, int tile, LAS unsigned char* lds) {
    KArgs* ka = kargs();
    const int tid = opaque_tid(), wid = __builtin_amdgcn_readfirstlane(tid >> 6), lane = tid & 63;
    unsigned char* ws = ka->ws;
    const bf16_t* proj = (const bf16_t*)(ws + WS_PROJ);
    LAS bf16_t* P = (LAS bf16_t*)lds;
    LAS bf16_t* PA = (LAS bf16_t*)(lds + 40960);
    LAS float* YB = (LAS float*)(lds + 40960 + 33792);
    const int tok0 = tile * 64, b = tok0 / S, t0 = tok0 % S;
#pragma unroll
    for (int p = tid; p < 79 * 32; p += NTHR) {
        const int r = p >> 5, c8 = p & 31, t = t0 - 15 + r;
        u32x4 v = (u32x4){0u, 0u, 0u, 0u};
        if (t >= 0) v = *(const u32x4*)(proj + (size_t)(b * S + t) * NP + NC + c8 * 8);
        *(LAS u32x4*)(P + r * 256 + c8 * 8) = v;
    }
    __syncthreads();
    {
        const int c = tid & 255, half = tid >> 8, g = c >> 6, w = 2 << g, tt0 = half * 32;
        float run = 0.f;
        for (int jj = 1; jj < w; ++jj) run += bf2f(P[(15 + tt0 - jj) * 256 + c]);
        for (int i = 0; i < 32; ++i) {
            const int tt = tt0 + i, r = 15 + tt;
            const float pv = bf2f(P[r * 256 + c]);
            run += pv;
            const int tabs = t0 + tt, nn = (tabs + 1 < w) ? (tabs + 1) : w;
            PA[tt * 264 + c] = f2bf(run / (float)nn - pv);
            run -= bf2f(P[(r - w + 1) * 256 + c]);
        }
    }
    __syncthreads();
    {
        const int g = wid >> 1, mh = wid & 1, fr = lane & 15, fq = lane >> 4;
        const bf16_t* PT = (const bf16_t*)(ws + WS_POOLT) + (size_t)(l * 4 + g) * 64 * 64;
        f32x4 acc[2][4];
#pragma unroll
        for (int mi = 0; mi < 2; ++mi)
#pragma unroll
            for (int ni = 0; ni < 4; ++ni) acc[mi][ni] = (f32x4){0.f, 0.f, 0.f, 0.f};
#pragma unroll
        for (int ks = 0; ks < 2; ++ks) {
            bf16x8 A[2];
#pragma unroll
            for (int mi = 0; mi < 2; ++mi) A[mi] = *(const LAS bf16x8*)(PA + (16 * (2 * mh + mi) + fr) * 264 + g * 64 + 32 * ks + 8 * fq);
#pragma unroll
            for (int ni = 0; ni < 4; ++ni) { const bf16x8 Bf = *(const bf16x8*)(PT + (16 * ni + fr) * 64 + 32 * ks + 8 * fq);
#pragma unroll
                for (int mi = 0; mi < 2; ++mi) acc[mi][ni] = mfma16(A[mi], Bf, acc[mi][ni]); }
        }
        const float* pb = IN_F(I_POOLB) + l * 256; const float* ps = IN_F(I_POOLS) + l * 256;
#pragma unroll
        for (int ni = 0; ni < 4; ++ni) { const int d = g * 64 + 16 * ni + fr; const float bb = pb[d], sc = ps[d];
#pragma unroll
            for (int mi = 0; mi < 2; ++mi)
#pragma unroll
                for (int r = 0; r < 4; ++r) YB[(16 * (2 * mh + mi) + 4 * fq + r) * 260 + d] = (acc[mi][ni][r] + bb) * sc; }
    }
    __syncthreads();
    rows_rms_store(YB, IN_F(I_ONORM) + l * D + 512, (bf16_t*)(ws + WS_MIXB), tok0, 512, wid, lane);
    __syncthreads();
}

__device__ __forceinline__ void item_conv(const Args& a, int l, int tile, LAS unsigned char* lds) {
    KArgs* ka = kargs();
    const int tid = opaque_tid(), wid = __builtin_amdgcn_readfirstlane(tid >> 6), lane = tid & 63;
    unsigned char* ws = ka->ws;
    const bf16_t* proj = (const bf16_t*)(ws + WS_PROJ);
    LAS float* GL = (LAS float*)lds;
    LAS bf16_t* CA = (LAS bf16_t*)(lds + 96256);
    LAS float* YB = (LAS float*)lds;
    const int tok0 = tile * 64, b = tok0 / S, t0 = tok0 % S;
#pragma unroll
    for (int p = tid; p < 94 * 32; p += NTHR) {
        const int r = p >> 5, c8 = p & 31, t = t0 - 30 + r;
        f32x4 o0 = (f32x4){0.f, 0.f, 0.f, 0.f}, o1 = o0;
        if (t >= 0) {
            const bf16_t* pr = proj + (size_t)(b * S + t) * NP;
            const u32x4 av = *(const u32x4*)(pr + NBA + c8 * 8), gv = *(const u32x4*)(pr + NBG + c8 * 8);
            o0[0] = bflo(av.x) * sigmoid_fast(bflo(gv.x)); o0[1] = bfhi(av.x) * sigmoid_fast(bfhi(gv.x)); o0[2] = bflo(av.y) * sigmoid_fast(bflo(gv.y)); o0[3] = bfhi(av.y) * sigmoid_fast(bfhi(gv.y));
            o1[0] = bflo(av.z) * sigmoid_fast(bflo(gv.z)); o1[1] = bfhi(av.z) * sigmoid_fast(bfhi(gv.z)); o1[2] = bflo(av.w) * sigmoid_fast(bflo(gv.w)); o1[3] = bfhi(av.w) * sigmoid_fast(bfhi(gv.w));
        }
        *(LAS f32x4*)(GL + r * 256 + c8 * 8) = o0; *(LAS f32x4*)(GL + r * 256 + c8 * 8 + 4) = o1;
    }
    __syncthreads();
    {
        const int c = tid & 255, half = tid >> 8;
        float wv[31];
#pragma unroll
        for (int jj = 0; jj < 31; ++jj) wv[jj] = IN_F(I_CONVW)[((size_t)l * 31 + jj) * 256 + c];
        const float cb = IN_F(I_CONVB)[l * 256 + c];
        float yv[32];
#pragma unroll
        for (int ch = 0; ch < 8; ++ch) {
            const int tt = half * 32 + ch * 4;
            float x[34];
#pragma unroll
            for (int m2 = 0; m2 < 34; ++m2) x[m2] = GL[(tt + m2) * 256 + c];
#pragma unroll
            for (int i = 0; i < 4; ++i) {
                float y = cb;
#pragma unroll
                for (int jj = 0; jj < 31; ++jj) y += x[i + jj] * wv[jj];
                yv[ch * 4 + i] = y;
            }
        }
        __syncthreads();
#pragma unroll
        for (int i = 0; i < 32; ++i) YB[(half * 32 + i) * 260 + c] = yv[i];
    }
    __syncthreads();
    {
        const int t = tid >> 3, part = tid & 7;
        float y[32]; float s1 = 0.f;
#pragma unroll
        for (int i = 0; i < 8; ++i) { const f32x4 v = *(const LAS f32x4*)(YB + t * 260 + part * 32 + 4 * i); y[4 * i] = v[0]; y[4 * i + 1] = v[1]; y[4 * i + 2] = v[2]; y[4 * i + 3] = v[3]; s1 += (v[0] + v[1]) + (v[2] + v[3]); }
        s1 += dpp_f<0xB1>(s1);
        const float mu = s1 * (1.0f / 64.0f);
        float s2 = 0.f;
#pragma unroll
        for (int i = 0; i < 32; ++i) { y[i] -= mu; s2 += y[i] * y[i]; }
        s2 += dpp_f<0xB1>(s2);
        const float rs = rsqrtf(s2 * (1.0f / 64.0f) + EPS);
        const float* lng = IN_F(I_CLNG) + l * 256 + part * 32; const float* lnb = IN_F(I_CLNB) + l * 256 + part * 32;
#pragma unroll
        for (int i = 0; i < 4; ++i) {
            float o[8];
#pragma unroll
            for (int e = 0; e < 8; ++e) o[e] = silu_f(y[8 * i + e] * rs * lng[8 * i + e] + lnb[8 * i + e]);
            u32x4 w; w.x = cvt_pk_bf16(o[0], o[1]); w.y = cvt_pk_bf16(o[2], o[3]); w.z = cvt_pk_bf16(o[4], o[5]); w.w = cvt_pk_bf16(o[6], o[7]);
            *(LAS u32x4*)(CA + t * 264 + part * 32 + 8 * i) = w;
        }
    }
    __syncthreads();
    {
        const int fr = lane & 15, fq = lane >> 4;
        const bf16_t* PW = (const bf16_t*)(ws + WS_PWT) + (size_t)l * 65536;
        f32x4 acc[4][2];
#pragma unroll
        for (int mi = 0; mi < 4; ++mi)
#pragma unroll
            for (int ni = 0; ni < 2; ++ni) acc[mi][ni] = (f32x4){0.f, 0.f, 0.f, 0.f};
#pragma unroll 2
        for (int ks = 0; ks < 8; ++ks) {
            bf16x8 Bf[2];
#pragma unroll
            for (int ni = 0; ni < 2; ++ni) Bf[ni] = *(const bf16x8*)(PW + (size_t)(32 * wid + 16 * ni + fr) * 256 + 32 * ks + 8 * fq);
#pragma unroll
            for (int mi = 0; mi < 4; ++mi) { const bf16x8 Af = *(const LAS bf16x8*)(CA + (16 * mi + fr) * 264 + 32 * ks + 8 * fq);
#pragma unroll
                for (int ni = 0; ni < 2; ++ni) acc[mi][ni] = mfma16(Af, Bf[ni], acc[mi][ni]); }
        }
        const float* pwb = IN_F(I_PWB) + l * 256;
#pragma unroll
        for (int ni = 0; ni < 2; ++ni) { const int n = 32 * wid + 16 * ni + fr; const float bb = pwb[n];
#pragma unroll
            for (int mi = 0; mi < 4; ++mi)
#pragma unroll
                for (int r = 0; r < 4; ++r) YB[(16 * mi + 4 * fq + r) * 260 + n] = acc[mi][ni][r] + bb; }
    }
    __syncthreads();
    rows_rms_store(YB, IN_F(I_ONORM) + l * D + 256, (bf16_t*)(ws + WS_MIXB), tok0, 256, wid, lane);
    __syncthreads();
}

__device__ __forceinline__ void item_sgu(const Args& a, int l, int ch, LAS unsigned char* lds) {
    KArgs* ka = kargs();
    const int tid = opaque_tid(), wid = __builtin_amdgcn_readfirstlane(tid >> 6), lane = tid & 63;
    unsigned char* ws = ka->ws;
    const bf16_t* proj = (const bf16_t*)(ws + WS_PROJ);
    LAS bf16_t* VT = (LAS bf16_t*)lds;
    LAS bf16_t* OB = (LAS bf16_t*)(lds + 69632);
    const int tok0 = ch * 128;
    {
        const f32x4 lg = *(const f32x4*)(IN_F(I_SLNG) + l * 256 + 4 * lane), lb = *(const f32x4*)(IN_F(I_SLNB) + l * 256 + 4 * lane);
#pragma unroll 8
        for (int i = 0; i < 16; ++i) {
            const int s = 16 * wid + i;
            const u32x2 vv = *(const u32x2*)(proj + (size_t)(tok0 + s) * NP + NDV + 4 * lane);
            const float v0 = bflo(vv.x), v1 = bfhi(vv.x), v2 = bflo(vv.y), v3 = bfhi(vv.y);
            const float mu = wave_sum((v0 + v1) + (v2 + v3)) * (1.0f / 256.0f);
            const float d0 = v0 - mu, d1 = v1 - mu, d2 = v2 - mu, d3 = v3 - mu;
            const float rs = rsqrtf(wave_sum((d0 * d0 + d1 * d1) + (d2 * d2 + d3 * d3)) * (1.0f / 256.0f) + EPS);
            VT[(4 * lane + 0) * 136 + s] = f2bf(d0 * rs * lg[0] + lb[0]); VT[(4 * lane + 1) * 136 + s] = f2bf(d1 * rs * lg[1] + lb[1]);
            VT[(4 * lane + 2) * 136 + s] = f2bf(d2 * rs * lg[2] + lb[2]); VT[(4 * lane + 3) * 136 + s] = f2bf(d3 * rs * lg[3] + lb[3]);
        }
    }
    __syncthreads();
    {
        const int h = wid >> 1, np = wid & 1, fr = lane & 15, fq = lane >> 4;
        const bf16_t* W = (const bf16_t*)(ws + WS_SGUW) + (size_t)(l * 4 + h) * 128 * 128;
        const float* sb = IN_F(I_SGUB) + (l * 4 + h) * 128;
#pragma unroll 1
        for (int mi = 0; mi < 8; ++mi) {
            f32x4 acc[2] = {(f32x4){0.f, 0.f, 0.f, 0.f}, (f32x4){0.f, 0.f, 0.f, 0.f}};
            for (int ks = 0; ks <= (mi >> 1); ++ks) {
                const bf16x8 Af = *(const bf16x8*)(W + (size_t)(16 * mi + fr) * 128 + 32 * ks + 8 * fq);
#pragma unroll
                for (int ni = 0; ni < 2; ++ni) { const bf16x8 Bf = *(const LAS bf16x8*)(VT + (h * 64 + 32 * np + 16 * ni + fr) * 136 + 32 * ks + 8 * fq); acc[ni] = mfma16(Af, Bf, acc[ni]); }
            }
#pragma unroll
            for (int ni = 0; ni < 2; ++ni)
#pragma unroll
                for (int r = 0; r < 4; ++r) { const int t = 16 * mi + 4 * fq + r; OB[t * 264 + h * 64 + 32 * np + 16 * ni + fr] = f2bf(acc[ni][r] + sb[t]); }
        }
    }
    __syncthreads();
    {
        const f32x4 gv = *(const f32x4*)(IN_F(I_ONORM) + l * D + 768 + 4 * lane);
        bf16_t* mixb = (bf16_t*)(ws + WS_MIXB);
#pragma unroll 8
        for (int i = 0; i < 16; ++i) {
            const int t = 16 * wid + i;
            const u32x2 mv = *(const LAS u32x2*)(OB + t * 264 + 4 * lane);
            const u32x2 uv = *(const u32x2*)(proj + (size_t)(tok0 + t) * NP + NDU + 4 * lane);
            const float o0 = bflo(uv.x) * bflo(mv.x), o1 = bfhi(uv.x) * bfhi(mv.x), o2 = bflo(uv.y) * bflo(mv.y), o3 = bfhi(uv.y) * bfhi(mv.y);
            const float r = rsqrtf(wave_sum((o0 * o0 + o1 * o1) + (o2 * o2 + o3 * o3)) * (1.0f / 256.0f) + EPS);
            u32x2 w; w.x = cvt_pk_bf16(o0 * r * gv[0], o1 * r * gv[1]); w.y = cvt_pk_bf16(o2 * r * gv[2], o3 * r * gv[3]);
            *(u32x2*)(mixb + (size_t)(tok0 + t) * D + 768 + 4 * lane) = w;
        }
    }
    __syncthreads();
}

__device__ __forceinline__ void item_prepk(const Args& a, int l, int tile, LAS unsigned char* lds) {
    KArgs* ka = kargs();
    const int tid = opaque_tid(), wid = __builtin_amdgcn_readfirstlane(tid >> 6), lane = tid & 63;
    unsigned char* ws = ka->ws;
    const bf16_t* proj = (const bf16_t*)(ws + WS_PROJ);
    LAS bf16_t* VS = (LAS bf16_t*)lds;
    bf16_t* KN = (bf16_t*)(ws + WS_KN); bf16_t* VTg = (bf16_t*)(ws + WS_VT); bf16_t* IKR = (bf16_t*)(ws + WS_IKR);
    const float* ropeA = (const float*)(ws + WS_ROPEA); const float* ropeI = (const float*)(ws + WS_ROPEI);
    const int tok0 = tile * 64, b = tok0 / S, s0 = tok0 % S;
    const int li = lane & 15, head = lane >> 4;
    const f32x4 kg = *(const f32x4*)(IN_F(I_KN) + l * 64 + 4 * li);
#pragma unroll 4
    for (int i = 0; i < 8; ++i) {
        const int tl = 8 * wid + i, tok = tok0 + tl, s = s0 + tl;
        const bf16_t* pr = proj + (size_t)tok * NP;
        const u32x2 kv = *(const u32x2*)(pr + NK + 4 * lane);
        float k0 = bflo(kv.x), k1 = bfhi(kv.x), k2 = bflo(kv.y), k3 = bfhi(kv.y);
        float ss = (k0 * k0 + k1 * k1) + (k2 * k2 + k3 * k3);
        ss = row_sum16(ss);
        const float r = rsqrtf(ss * (1.0f / 64.0f) + EPS);
        k0 *= r * kg[0]; k1 *= r * kg[1]; k2 *= r * kg[2]; k3 *= r * kg[3];
        {
            const float p0 = __shfl_xor(k0, 2), p1 = __shfl_xor(k1, 2), p2 = __shfl_xor(k2, 2), p3 = __shfl_xor(k3, 2);
            if (li < 4) {
                const int dd = 4 * (li & 1);
                const f32x4 cs = *(const f32x4*)(ropeA + (size_t)tok * 16 + dd), sn = *(const f32x4*)(ropeA + (size_t)tok * 16 + 8 + dd);
                if (li < 2) { k0 = k0 * cs[0] - p0 * sn[0]; k1 = k1 * cs[1] - p1 * sn[1]; k2 = k2 * cs[2] - p2 * sn[2]; k3 = k3 * cs[3] - p3 * sn[3]; }
                else        { k0 = k0 * cs[0] + p0 * sn[0]; k1 = k1 * cs[1] + p1 * sn[1]; k2 = k2 * cs[2] + p2 * sn[2]; k3 = k3 * cs[3] + p3 * sn[3]; }
            }
        }
        u32x2 ko; ko.x = cvt_pk_bf16(k0, k1); ko.y = cvt_pk_bf16(k2, k3);
        *(u32x2*)(KN + ((size_t)((b * 4 + head) * 128 + (s >> 5)) * 32 + (s & 31)) * 64 + 4 * li) = ko;
        *(LAS u32x2*)(VS + tl * 256 + 4 * lane) = *(const u32x2*)(pr + NV + 4 * lane);
        if (lane < 8) {
            const u32x2 iv = *(const u32x2*)(pr + NIK + 4 * lane);
            float x0 = bflo(iv.x), x1 = bfhi(iv.x), x2 = bflo(iv.y), x3 = bfhi(iv.y);
            const float q0 = __shfl_xor(x0, 1), q1 = __shfl_xor(x1, 1), q2 = __shfl_xor(x2, 1), q3 = __shfl_xor(x3, 1);
            if (lane < 2) {
                const f32x4 cs = *(const f32x4*)(ropeI + (size_t)tok * 8), sn = *(const f32x4*)(ropeI + (size_t)tok * 8 + 4);
                if (lane == 0) { x0 = x0 * cs[0] - q0 * sn[0]; x1 = x1 * cs[1] - q1 * sn[1]; x2 = x2 * cs[2] - q2 * sn[2]; x3 = x3 * cs[3] - q3 * sn[3]; }
                else           { x0 = x0 * cs[0] + q0 * sn[0]; x1 = x1 * cs[1] + q1 * sn[1]; x2 = x2 * cs[2] + q2 * sn[2]; x3 = x3 * cs[3] + q3 * sn[3]; }
            }
            u32x2 io; io.x = cvt_pk_bf16(x0, x1); io.y = cvt_pk_bf16(x2, x3);
            *(u32x2*)(IKR + (size_t)tok * 32 + 4 * lane) = io;
        }
    }
    __syncthreads();
#pragma unroll
    for (int i = 0; i < 4; ++i) {
        const int p = tid + NTHR * i;
        const int h = p >> 9, ktl = (p >> 8) & 1, d = (p >> 2) & 63, part = p & 3;
        unsigned short e[8];
#pragma unroll
        for (int jj = 0; jj < 8; ++jj) { const int key = 4 * part + (jj & 3) + 16 * (jj >> 2); e[jj] = VS[(ktl * 32 + key) * 256 + h * 64 + d]; }
        u32x4 w; w.x = e[0] | ((unsigned)e[1] << 16); w.y = e[2] | ((unsigned)e[3] << 16); w.z = e[4] | ((unsigned)e[5] << 16); w.w = e[6] | ((unsigned)e[7] << 16);
        *(u32x4*)(VTg + ((size_t)((b * 4 + h) * 128 + (s0 >> 5) + ktl) * 64 + d) * 32 + 8 * part) = w;
    }
    __syncthreads();
}

__device__ __forceinline__ void phase_mix1(const Args& a, int l, LAS unsigned char* lds, int vcu, int G, int bx) {
    if (G == 256) {
        if (bx < 64) { item_conv(a, l, bx, lds); item_pool(a, l, bx, lds); }
        else {
            const int w = bx - 64;
            if (w < 128) item_sgu(a, l, w, lds);
            item_prepk(a, l, w, lds);
            item_conv(a, l, 64 + w, lds);
            if (w >= 128) item_prepk(a, l, 192 + (w - 128), lds);
            item_pool(a, l, 64 + w, lds);
        }
        return;
    }
    for (int it = vcu; it < 896; it += G) {
        if (it < 128) item_sgu(a, l, it, lds);
        else if (it < 384) item_conv(a, l, it - 128, lds);
        else if (it < 640) item_pool(a, l, it - 384, lds);
        else item_prepk(a, l, it - 640, lds);
    }
}
__device__ __forceinline__ f32x16 mfma32(const bf16x8 a, const bf16x8 b, const f32x16 c) { return __builtin_amdgcn_mfma_f32_32x32x16_bf16(a, b, c, 0, 0, 0); }
__device__ __forceinline__ unsigned mono_key(float f) { const unsigned u = __float_as_uint(f); return u ^ ((unsigned)((int)u >> 31) | 0x80000000u); }

__device__ __forceinline__ void a1_keys(const bf16x8 A0, const bf16x8 A1, const bf16x8 (&Bq)[4][2], const float (&cl)[4], unsigned (&key)[16]) {
    float sc[16];
#pragma unroll
    for (int r = 0; r < 16; ++r) sc[r] = 0.0f;
#pragma unroll
    for (int h = 0; h < 4; ++h) {
        f32x16 d;
#pragma unroll
        for (int r = 0; r < 16; ++r) d[r] = 0.f;
        d = mfma32(A0, Bq[h][0], d); d = mfma32(A1, Bq[h][1], d);
#pragma unroll
        for (int r = 0; r < 16; ++r) sc[r] += __builtin_amdgcn_fmed3f(d[r], 0.0f, cl[h]);
    }
#pragma unroll
    for (int r = 0; r < 16; ++r) key[r] = mono_key(sc[r]);
}

__device__ __forceinline__ unsigned wcode(unsigned key) {
    const int v = (int)(key >> 20);
    const int t = (key < 0x80000000u) ? (v < 1096 ? v : 1096) + 1901 : (v > 2999 ? v : 2999);
    const int c = t - 2864;
    return (unsigned)(c < 12 ? 12 : (c > 255 ? 255 : c));
}

#define A1_STREAM_BEGIN { \
    bf16x8 rA[4][2]; const int ntw_ = (nkt - wid + 7) >> 3; \
    _Pragma("unroll") for (int u_ = 0; u_ < 4; ++u_) { rA[u_][0] = Bq[0][0]; rA[u_][1] = Bq[0][0]; if (u_ < ntw_) { const size_t o_ = (size_t)(wid + 8 * u_) * 1024; rA[u_][0] = *(const bf16x8*)(ikl + o_); rA[u_][1] = *(const bf16x8*)(ikl + o_ + 16); } } \
    for (int i_ = 0; i_ < ntw_; i_ += 4) { \
        _Pragma("unroll") for (int u_ = 0; u_ < 4; ++u_) { if (i_ + u_ < ntw_) { \
            const bf16x8 cA0 = rA[u_][0], cA1 = rA[u_][1]; const int kt = wid + 8 * (i_ + u_); \
            if (i_ + u_ + 4 < ntw_) { const size_t o_ = (size_t)(kt + 32) * 1024; rA[u_][0] = *(const bf16x8*)(ikl + o_); rA[u_][1] = *(const bf16x8*)(ikl + o_ + 16); }
#define A1_STREAM_END } } } }

template <int KIND>
__device__ __forceinline__ void a1_pass(const bf16_t* ikl, int nkt, int wid, int q, int hh, const bf16x8 (&Bq)[4][2], const float (&cl)[4], LAS unsigned* hist, int sh, unsigned prefix, bool tieq, unsigned g16) {
    const unsigned dump = 256u * 32u + (unsigned)q;
    A1_STREAM_BEGIN
        unsigned key[16];
        a1_keys(cA0, cA1, Bq, cl, key);
#pragma unroll
        for (int r = 0; r < 16; ++r) {
            const int s = kt * 32 + (r & 3) + 8 * (r >> 2) + 4 * hh;
            unsigned digit; bool match;
            if (KIND == 0) { digit = key[r] >> 24; match = true; }
            else if (KIND == 1) { digit = (key[r] >> sh) & 255u; match = (key[r] >> (sh + 8)) == prefix; }
            else if (KIND == 2) { digit = 255u - (unsigned)(s >> 4); match = ((unsigned)tieq & (unsigned)(key[r] == prefix)) != 0u; }
            else if (KIND == 3) { digit = 15u - (unsigned)(s & 15); match = ((unsigned)tieq & (unsigned)(key[r] == prefix) & (unsigned)((unsigned)(s >> 4) == g16)) != 0u; }
            else { digit = wcode(key[r]); match = true; }
            const unsigned idx = match ? digit * 32u + (unsigned)q : dump;
            __hip_atomic_fetch_add(hist + idx, 1u, __ATOMIC_RELAXED, __HIP_MEMORY_SCOPE_WORKGROUP);
        }
    A1_STREAM_END
}

template <int MODE_CLASS>
__device__ __forceinline__ void a1_scan(LAS unsigned* hist, LAS unsigned* psum, LAS unsigned* qst, int tid, bool last) {
    const int sq = tid & 31, part = tid >> 5;
    const unsigned need = qst[32 + sq], pfx = qst[sq];
    unsigned local = 0u;
#pragma unroll
    for (int bb = 0; bb < 16; ++bb) local += hist[(16 * part + bb) * 32 + sq];
    psum[part * 32 + sq] = local;
    __syncthreads();
    unsigned above = 0u;
    for (int pp = part + 1; pp < 16; ++pp) above += psum[pp * 32 + sq];
    if (above < need && above + local >= need) {
        unsigned run = above;
        for (int bb = 15; bb >= 0; --bb) {
            const unsigned c = hist[(16 * part + bb) * 32 + sq];
            if (run + c >= need) {
                const unsigned bin = (unsigned)(16 * part + bb);
                if (MODE_CLASS == 0) { qst[sq] = (pfx << 8) | bin; qst[32 + sq] = need - run; qst[64 + sq] = c; if (last && need - run < c) qst[160] = 1u; }
                else if (MODE_CLASS == 1) { qst[128 + sq] = 255u - bin; qst[32 + sq] = need - run; qst[64 + sq] = 0xffffffffu; }
                else { qst[96 + sq] = qst[128 + sq] * 16u + (15u - bin); }
                break;
            }
            run += c;
        }
    }
}

constexpr int A1_CCAP = 32;
constexpr int A1_HIST = 0, A1_PSUM = 257 * 32, A1_QST = A1_PSUM + 16 * 32, A1_MBUF = A1_QST + 6 * 32 + 32, A1_TBUF = A1_MBUF + 32 * 128;
constexpr int A1_CAPL = 16, A1_LKEY = A1_MBUF + 32 * 128, A1_LIDX = A1_LKEY + 512 * A1_CAPL, A1_PCNT = A1_LIDX + 512 * A1_CAPL, A1_CAP = 200;
__device__ __forceinline__ void a1_tile(const Args& a, int l, int b, int j, LAS unsigned char* lds) {
    KArgs* ka = kargs();
    const int tid = opaque_tid(), wid = __builtin_amdgcn_readfirstlane(tid >> 6), lane = tid & 63, q = lane & 31, hh = lane >> 5;
    unsigned char* ws = ka->ws;
    const bf16_t* proj = (const bf16_t*)(ws + WS_PROJ);
    const bf16_t* ikr = (const bf16_t*)(ws + WS_IKR) + (size_t)b * S * 32;
    const bf16_t* ikl = ikr + (lane & 31) * 32 + 8 * (lane >> 5);
    unsigned* maskg = (unsigned*)(ws + WS_MASK);
    LAS unsigned* L = (LAS unsigned*)lds;
    LAS unsigned* hist = L + A1_HIST; LAS unsigned* psum = L + A1_PSUM; LAS unsigned* qst = L + A1_QST; LAS unsigned* mbuf = L + A1_MBUF; LAS unsigned* tbuf = L + A1_TBUF;
    LAS unsigned* ckey = L + A1_TBUF + 32 * 128; LAS unsigned* cidx = ckey + 32 * A1_CCAP; LAS unsigned* ccnt = cidx + 32 * A1_CCAP;
    LAS unsigned* lkey = L + A1_LKEY; LAS unsigned* lidx = L + A1_LIDX; LAS unsigned* pcnt = L + A1_PCNT;
    const int t0 = j * 32, n = (t0 / 64 + 1) * 64, nkt = n / 32, nw = ((t0 / 128) + 1) * 4;
    if (n <= 256) {
        for (int i = tid; i < 32 * nw; i += NTHR) { const int qq = i / nw, w = i % nw; maskg[(size_t)(b * S + t0 + qq) * 128 + w] = (w < nkt) ? 0xffffffffu : 0u; }
        return;
    }
    bf16x8 Bq[4][2]; float cl[4];
    {
        const int tok = b * S + t0 + q;
        const bf16_t* pr = proj + (size_t)tok * NP;
        const f32x4 cs = *(const f32x4*)((const float*)(ws + WS_ROPEI) + (size_t)tok * 8), sn = *(const f32x4*)((const float*)(ws + WS_ROPEI) + (size_t)tok * 8 + 4);
#pragma unroll
        for (int h = 0; h < 4; ++h) {
            const float wsc = bf2f(pr[NIW + h]) * (0.5f * 0.17677669529663687f);
            cl[h] = (wsc > 0.f) ? INFINITY : -INFINITY;
#pragma unroll
            for (int ks = 0; ks < 2; ++ks) {
                const u32x4 raw = *(const u32x4*)(pr + NIQ + h * 32 + 16 * ks + 8 * hh);
                float v[8] = {bflo(raw.x), bfhi(raw.x), bflo(raw.y), bfhi(raw.y), bflo(raw.z), bfhi(raw.z), bflo(raw.w), bfhi(raw.w)};
                if (ks == 0 && hh == 0) {
#pragma unroll
                    for (int i = 0; i < 4; ++i) { const float x1 = v[i], x2 = v[i + 4]; v[i] = x1 * cs[i] - x2 * sn[i]; v[i + 4] = x2 * cs[i] + x1 * sn[i]; }
                }
                u32x4 pk; pk.x = cvt_pk_bf16(v[0] * wsc, v[1] * wsc); pk.y = cvt_pk_bf16(v[2] * wsc, v[3] * wsc); pk.z = cvt_pk_bf16(v[4] * wsc, v[5] * wsc); pk.w = cvt_pk_bf16(v[6] * wsc, v[7] * wsc);
                Bq[h][ks] = __builtin_bit_cast(bf16x8, pk);
            }
        }
    }
    {
        if (tid < 32) { qst[tid] = 0u; qst[32 + tid] = 256u; qst[64 + tid] = 0u; qst[96 + tid] = 4095u; qst[128 + tid] = 0u; }
        if (tid == 32) qst[160] = 0u;
        if (tid == 33) qst[161] = 0u;
        __syncthreads();
        bool shortpath = false;
        for (int mode = 0; mode < 4; ++mode) {
            for (int i = tid; i < 257 * 32; i += NTHR) hist[i] = 0u;
            __syncthreads();
            const unsigned prefix = qst[q];
            const int sh = 24 - 8 * mode;
            if (mode == 0) a1_pass<0>(ikl, nkt, wid, q, hh, Bq, cl, hist, 0, 0u, false, 0u);
            else a1_pass<1>(ikl, nkt, wid, q, hh, Bq, cl, hist, sh, prefix, false, 0u);
            __syncthreads();
            a1_scan<0>(hist, psum, qst, tid, mode == 3);
            __syncthreads();
            if (mode == 1) {
                if (tid < 32) { ccnt[tid] = 0u; if (qst[64 + tid] > (unsigned)A1_CCAP) qst[161] = 1u; }
                __syncthreads();
                shortpath = qst[161] == 0u;
                if (shortpath) break;
            }
        }
        __syncthreads();
        if (shortpath) {
            const unsigned T16 = qst[q];
            A1_STREAM_BEGIN
                unsigned key[16];
                a1_keys(cA0, cA1, Bq, cl, key);
                unsigned wb = 0u;
#pragma unroll
                for (int r = 0; r < 16; ++r) {
                    const int row = (r & 3) + 8 * (r >> 2) + 4 * hh;
                    const unsigned k16 = key[r] >> 16;
                    wb |= (k16 > T16) ? (1u << row) : 0u;
                    if (k16 == T16) { const unsigned slot = __hip_atomic_fetch_add(ccnt + q, 1u, __ATOMIC_RELAXED, __HIP_MEMORY_SCOPE_WORKGROUP);
                        if (slot < (unsigned)A1_CCAP) { ckey[q * A1_CCAP + slot] = key[r]; cidx[q * A1_CCAP + slot] = (unsigned)(kt * 32 + row); } }
                }
                wb |= (unsigned)__shfl_xor((int)wb, 32);
                if (hh == 0) mbuf[q * 128 + kt] = wb;
            A1_STREAM_END
            __syncthreads();
            for (int pr2 = tid; pr2 < 32 * A1_CCAP; pr2 += NTHR) {
                const int qq = pr2 / A1_CCAP, slot = pr2 % A1_CCAP;
                const unsigned cn = qst[64 + qq], need = qst[32 + qq];
                if ((unsigned)slot < cn) {
                    const unsigned ki = ckey[qq * A1_CCAP + slot], si = cidx[qq * A1_CCAP + slot];
                    unsigned rank = 0u;
                    for (unsigned jx = 0; jx < cn; ++jx) { const unsigned kj = ckey[qq * A1_CCAP + jx], sj = cidx[qq * A1_CCAP + jx]; rank += (kj > ki || (kj == ki && sj < si)) ? 1u : 0u; }
                    if (rank < need) __hip_atomic_fetch_or(mbuf + qq * 128 + (si >> 5), 1u << (si & 31u), __ATOMIC_RELAXED, __HIP_MEMORY_SCOPE_WORKGROUP);
                }
            }
        } else
        {
            const unsigned T = qst[q];
            A1_STREAM_BEGIN
                unsigned key[16];
                a1_keys(cA0, cA1, Bq, cl, key);
                unsigned wb = 0u, tb = 0u;
#pragma unroll
                for (int r = 0; r < 16; ++r) {
                    const int row = (r & 3) + 8 * (r >> 2) + 4 * hh;
                    wb |= (key[r] > T) ? (1u << row) : 0u;
                    tb |= (key[r] == T) ? (1u << row) : 0u;
                }
                wb |= (unsigned)__shfl_xor((int)wb, 32); tb |= (unsigned)__shfl_xor((int)tb, 32);
                if (hh == 0) { mbuf[q * 128 + kt] = wb; tbuf[q * 128 + kt] = tb; }
            A1_STREAM_END
        }
        __syncthreads();
        if (!shortpath) for (int i = tid; i < 32 * nkt; i += NTHR) { const int qq = i / nkt, w = i % nkt; if (qst[32 + qq] >= qst[64 + qq]) mbuf[qq * 128 + w] |= tbuf[qq * 128 + w]; }
        if (!shortpath && tid < 32 && qst[32 + tid] < qst[64 + tid]) {
            unsigned rem = qst[32 + tid];
            for (int w = 0; w < nkt && rem; ++w) {
                unsigned t = tbuf[tid * 128 + w]; const unsigned c = (unsigned)__builtin_popcount(t);
                if (c <= rem) { mbuf[tid * 128 + w] |= t; rem -= c; }
                else { unsigned keep = 0u; for (; rem; --rem) { const unsigned low = t & (0u - t); keep |= low; t ^= low; } mbuf[tid * 128 + w] |= keep; }
            }
        }
    }
    __syncthreads();
    for (int i = tid; i < 32 * nw; i += NTHR) { const int qq = i / nw, w = i % nw; maskg[(size_t)(b * S + t0 + qq) * 128 + w] = (w < nkt) ? mbuf[qq * 128 + w] : 0u; }
    __syncthreads();
}
__device__ __forceinline__ void phase_a1(const Args& a, int l, LAS unsigned char* lds, int vcu, int G) {
    KArgs* ka = kargs();
    for (int it = vcu; it < 256; it += G) { const int b = it >> 6, jj = it & 63; a1_tile(a, l, b, 127 - jj, lds); a1_tile(a, l, b, jj, lds); }
}

__device__ __forceinline__ void a2_unit(const Args& a, int l, int b, int h, int blk, LAS unsigned char* lds) {
    KArgs* ka = kargs();
    const int tid = opaque_tid(), wid = __builtin_amdgcn_readfirstlane(tid >> 6), lane = tid & 63, fr = lane & 15, kq = lane >> 4;
    unsigned char* ws = ka->ws;
    const bf16_t* proj = (const bf16_t*)(ws + WS_PROJ);
    const char* KNb = (const char*)(ws + WS_KN) + (size_t)(b * 4 + h) * 128 * 4096;
    const char* VTb = (const char*)(ws + WS_VT) + (size_t)(b * 4 + h) * 128 * 4096;
    LAS unsigned char* Kb = lds;
    LAS unsigned char* Vb = lds + 16384;
    LAS float* Ob = (LAS float*)(lds + 32768) + wid * (16 * 68);
    const int nsteps = 2 * (blk + 1);
    const int tokq = b * S + blk * 128 + wid * 16 + fr;
    bf16x8 Qb[2]; float C2;
    {
        const float* qg = IN_F(I_QN) + l * 64; const float* kg = IN_F(I_KN) + l * 64;
        float gq = 0.f, gk = 0.f;
        for (int i = 0; i < 64; ++i) { gq = fmaxf(gq, fabsf(qg[i])); gk = fmaxf(gk, fabsf(kg[i])); }
        C2 = 8.0f * gq * gk * 1.4426950408889634f;
        const bf16_t* pr = proj + (size_t)tokq * NP + NQ + h * 64;
        float v[2][8]; float ss = 0.f;
#pragma unroll
        for (int ks = 0; ks < 2; ++ks) { const u32x4 raw = *(const u32x4*)(pr + 32 * ks + 8 * kq);
            v[ks][0] = bflo(raw.x); v[ks][1] = bfhi(raw.x); v[ks][2] = bflo(raw.y); v[ks][3] = bfhi(raw.y); v[ks][4] = bflo(raw.z); v[ks][5] = bfhi(raw.z); v[ks][6] = bflo(raw.w); v[ks][7] = bfhi(raw.w);
#pragma unroll
            for (int i = 0; i < 8; ++i) ss += v[ks][i] * v[ks][i]; }
        ss += __shfl_xor(ss, 16); ss += __shfl_xor(ss, 32);
        const float r = rsqrtf(ss * (1.0f / 64.0f) + EPS);
#pragma unroll
        for (int ks = 0; ks < 2; ++ks)
#pragma unroll
            for (int i = 0; i < 8; ++i) v[ks][i] *= r * qg[32 * ks + 8 * kq + i];
        {
            const float* ra = (const float*)(ws + WS_ROPEA) + (size_t)tokq * 16;
#pragma unroll
            for (int i = 0; i < 8; ++i) { const float pv = __shfl_xor(v[0][i], 16); const float c = ra[i], s = ra[8 + i];
                if (kq == 0) v[0][i] = v[0][i] * c - pv * s; else if (kq == 1) v[0][i] = v[0][i] * c + pv * s; }
        }
        const float qs = 0.125f * 1.4426950408889634f;
#pragma unroll
        for (int ks = 0; ks < 2; ++ks) { u32x4 pk; pk.x = cvt_pk_bf16(v[ks][0] * qs, v[ks][1] * qs); pk.y = cvt_pk_bf16(v[ks][2] * qs, v[ks][3] * qs); pk.z = cvt_pk_bf16(v[ks][4] * qs, v[ks][5] * qs); pk.w = cvt_pk_bf16(v[ks][6] * qs, v[ks][7] * qs);
            Qb[ks] = __builtin_bit_cast(bf16x8, pk); }
    }
    const unsigned* mrow = (const unsigned*)(ws + WS_MASK) + (size_t)tokq * 128;
    f32x4 O[4];
#pragma unroll
    for (int dt = 0; dt < 4; ++dt) O[dt] = (f32x4){0.f, 0.f, 0.f, 0.f};
    float lsum = 0.f;
    const int kkey = tid >> 3, kch = tid & 7, vsub = tid >> 8, vd = (tid >> 2) & 63, vch = tid & 3;
    const int klds = kkey * 128 + ((kch ^ (kkey & 7)) * 16), vlds = vsub * 4096 + vd * 64 + ((vch ^ ((vd >> 2) & 3)) * 16);
    u32x4 kr0, kr1, kr2, kr3, vr0, vr1, vr2, vr3; u32x2 mw0, mw1, mw2, mw3;
#define A2_LOAD(j, st_) do { kr##j = *(const u32x4*)(KNb + (size_t)(st_) * 8192 + (size_t)tid * 16); vr##j = *(const u32x4*)(VTb + (size_t)(st_) * 8192 + (size_t)tid * 16); mw##j = *(const u32x2*)(mrow + 2 * (st_)); } while (0)
    A2_LOAD(0, 0); A2_LOAD(1, 1);
    if (nsteps > 2) { A2_LOAD(2, 2); A2_LOAD(3, 3); } else { kr2 = kr0; vr2 = vr0; mw2 = mw0; kr3 = kr0; vr3 = vr0; mw3 = mw0; }
    __syncthreads();
#define A2_STEP(j, st_) do { \
        LAS unsigned char* Kc = Kb + ((st_) & 1) * 8192; LAS unsigned char* Vc = Vb + ((st_) & 1) * 8192; \
        *(LAS u32x4*)(Kc + klds) = kr##j; *(LAS u32x4*)(Vc + vlds) = vr##j; \
        const u32x2 mcur = mw##j; \
        __syncthreads(); \
        if ((st_) + 4 < nsteps) A2_LOAD(j, (st_) + 4); \
        _Pragma("unroll") for (int sub = 0; sub < 2; ++sub) { \
            const unsigned m = sub ? mcur.y : mcur.x; \
            f32x4 Sx[2]; \
            _Pragma("unroll") for (int tl = 0; tl < 2; ++tl) { \
                const int key = 32 * sub + 16 * tl + fr; \
                const bf16x8 A0 = *(const LAS bf16x8*)(Kc + key * 128 + (((0 + kq) ^ (key & 7)) * 16)); \
                const bf16x8 A1 = *(const LAS bf16x8*)(Kc + key * 128 + (((4 + kq) ^ (key & 7)) * 16)); \
                f32x4 z = (f32x4){0.f, 0.f, 0.f, 0.f}; \
                z = mfma16(A0, Qb[0], z); Sx[tl] = mfma16(A1, Qb[1], z); \
            } \
            float p[8]; \
            _Pragma("unroll") for (int r = 0; r < 4; ++r) { \
                const float e0 = __builtin_amdgcn_exp2f(Sx[0][r] - C2), e1 = __builtin_amdgcn_exp2f(Sx[1][r] - C2); \
                p[r] = ((m >> (4 * kq + r)) & 1u) ? e0 : 0.f; p[4 + r] = ((m >> (16 + 4 * kq + r)) & 1u) ? e1 : 0.f; \
            } \
            lsum += ((p[0] + p[1]) + (p[2] + p[3])) + ((p[4] + p[5]) + (p[6] + p[7])); \
            u32x4 pk; pk.x = cvt_pk_bf16(p[0], p[1]); pk.y = cvt_pk_bf16(p[2], p[3]); pk.z = cvt_pk_bf16(p[4], p[5]); pk.w = cvt_pk_bf16(p[6], p[7]); \
            const bf16x8 Pf = __builtin_bit_cast(bf16x8, pk); \
            _Pragma("unroll") for (int dt = 0; dt < 4; ++dt) { const int d = 16 * dt + fr; \
                const bf16x8 Av = *(const LAS bf16x8*)(Vc + sub * 4096 + d * 64 + ((kq ^ ((d >> 2) & 3)) * 16)); \
                O[dt] = mfma16(Av, Pf, O[dt]); } \
        } } while (0)
    for (int st = 0; st < nsteps; st += 4) {
        A2_STEP(0, st); A2_STEP(1, st + 1);
        if (st + 2 < nsteps) { A2_STEP(2, st + 2); A2_STEP(3, st + 3); }
    }
#undef A2_STEP
#undef A2_LOAD
    lsum += __shfl_xor(lsum, 16); lsum += __shfl_xor(lsum, 32);
    const float inv = 1.0f / lsum;
#pragma unroll
    for (int dt = 0; dt < 4; ++dt)
#pragma unroll
        for (int r = 0; r < 4; ++r) Ob[fr * 68 + 16 * dt + 4 * kq + r] = O[dt][r] * inv;
    __syncthreads();
    {
        const int qq = lane >> 2, dp = (lane & 3) * 16;
        const LAS float* src = Ob + qq * 68 + dp;
        float f[16]; float sq = 0.f;
#pragma unroll
        for (int i = 0; i < 4; ++i) { const f32x4 t = *(const LAS f32x4*)(src + 4 * i); f[4 * i] = t[0]; f[4 * i + 1] = t[1]; f[4 * i + 2] = t[2]; f[4 * i + 3] = t[3]; sq += (t[0] * t[0] + t[1] * t[1]) + (t[2] * t[2] + t[3] * t[3]); }
        u32x4 w0, w1; w0.x = cvt_pk_bf16(f[0], f[1]); w0.y = cvt_pk_bf16(f[2], f[3]); w0.z = cvt_pk_bf16(f[4], f[5]); w0.w = cvt_pk_bf16(f[6], f[7]);
        w1.x = cvt_pk_bf16(f[8], f[9]); w1.y = cvt_pk_bf16(f[10], f[11]); w1.z = cvt_pk_bf16(f[12], f[13]); w1.w = cvt_pk_bf16(f[14], f[15]);
        const int tok = b * S + blk * 128 + wid * 16 + qq;
        bf16_t* op = (bf16_t*)(ws + WS_MIXB) + (size_t)tok * D + h * 64 + dp;
        *(u32x4*)op = w0; *(u32x4*)(op + 8) = w1;
        sq += dpp_f<0xB1>(sq); sq += dpp_f<0x4E>(sq);
        if ((lane & 3) == 0) ((float*)(ws + WS_SSQ))[((size_t)l * NTOK + tok) * 4 + h] = sq;
    }
    __syncthreads();
}
__device__ __forceinline__ void phase_a2(const Args& a, int l, LAS unsigned char* lds, int vcu, int G) {
    KArgs* ka = kargs();
    for (int it = vcu; it < 256; it += G) { const int b = it >> 6, h = (it >> 4) & 3, jj = it & 15; a2_unit(a, l, b, h, 31 - jj, lds); a2_unit(a, l, b, h, jj, lds); }
}
__device__ __forceinline__ void phase_anorm(const Args& a, int l, int vcu, int G) {
    KArgs* ka = kargs();
    const int tid = opaque_tid(), wid = __builtin_amdgcn_readfirstlane(tid >> 6), lane = tid & 63;
    const bf16_t* oa = (const bf16_t*)(ka->ws + WS_OA); bf16_t* mixb = (bf16_t*)(ka->ws + WS_HA);
    const f32x4 gv = *(const f32x4*)(IN_F(I_ONORM) + l * D + 4 * lane);
    for (int tok = vcu * 8 + wid; tok < NTOK; tok += G * 8) {
        const u32x2 v = *(const u32x2*)(oa + (size_t)tok * 256 + 4 * lane);
        const float o0 = bflo(v.x), o1 = bfhi(v.x), o2 = bflo(v.y), o3 = bfhi(v.y);
        const float r = rsqrtf(wave_sum((o0 * o0 + o1 * o1) + (o2 * o2 + o3 * o3)) * (1.0f / 256.0f) + EPS);
        u32x2 w; w.x = cvt_pk_bf16(o0 * r * gv[0], o1 * r * gv[1]); w.y = cvt_pk_bf16(o2 * r * gv[2], o3 * r * gv[3]);
        *(u32x2*)(mixb + (size_t)tok * D + 4 * lane) = w;
    }
}
__global__ void __launch_bounds__(NTHR, 2) mk_fwd(Args a) {
    extern __shared__ __attribute__((aligned(16))) unsigned char lds_raw[];
    LAS unsigned char* lds = (LAS unsigned char*)lds_raw;
    const int tid = threadIdx.x, G = gridDim.x, bx = blockIdx.x;
    const int vcu = (G % 8 == 0) ? (bx % 8) * (G / 8) + bx / 8 : bx;
    if (tid < 64) ((LAS unsigned*)(lds + LDS_MISC))[tid] = 0u;
    __syncthreads();
    XcdBarrier bar; bar.bar = (unsigned*)(a.ws + WS_BAR); bar.x = 0; bar.st = nullptr;
    if (a.fused) bar = xcd_barrier_post((unsigned*)(a.ws + WS_BAR), (volatile LAS unsigned*)(lds + LDS_MISC + MISC_BAR));
#define GRID_BAR() do { if (a.fused) xcd_barrier(bar); } while (0)
#ifdef ONLY_PH
#define IN(k) ((k) == ONLY_PH && a.ph_lo <= (k) && (k) < a.ph_hi)
#else
#define IN(k) (a.ph_lo <= (k) && (k) < a.ph_hi)
#endif
    if (IN(PH_PRO)) { phase_prologue(a, lds, vcu, G); GRID_BAR(); }
    if (IN(PH_NORM0)) { KArgs* ka = kargs(); unsigned char* ws = ka->ws; float* modp = (float*)(ws + WS_MOD); phase_norm(IN_F(I_X), IN_F(I_NORM1), modp, modp + 1024, (bf16_t*)(ws + WS_HA), vcu, G); phase_rbias(a, lds, vcu); GRID_BAR(); }
    for (int l = a.l_lo; l < a.l_hi; ++l) {
        if (IN(PH_G1)) {
            KArgs* ka = kargs(); unsigned char* ws = ka->ws;
            pg8::DenseOrder S; S.init((const bf16_t*)(ws + WS_HA), (const bf16_t*)(ws + WS_WINT) + (size_t)l * NP * D, NTOK, (G == 256) ? NP - 256 : NP, D, G, bx);
            pg8::EpiBf16 E{(bf16_t*)(ws + WS_PROJ), NP};
            pg8::gemm_phase(lds, S, E);
            GRID_BAR();
        }
        if (IN(PH_MIX)) {
            if (G == 256 && bx < 64) {
                KArgs* ka = kargs(); unsigned char* ws = ka->ws;
                pg8::DenseOrder S; S.init((const bf16_t*)(ws + WS_HA), (const bf16_t*)(ws + WS_WINT) + (size_t)l * NP * D + (size_t)(NP - 256) * D, NTOK, 256, D, 64, bx);
                pg8::EpiBf16 E{(bf16_t*)(ws + WS_PROJ) + (NP - 256), NP};
                pg8::gemm_phase(lds, S, E);
            }
            phase_mix1(a, l, lds, vcu, G, bx); GRID_BAR();
        }
        if (IN(PH_A1)) { phase_a1(a, l, lds, vcu, G); GRID_BAR(); }
        if (IN(PH_A2)) { phase_a2(a, l, lds, vcu, G); GRID_BAR(); }
        if (IN(PH_G2)) {
            KArgs* ka = kargs(); unsigned char* ws = ka->ws; const float* xin = (l == 0) ? IN_F(I_X) : ka->out; const float* mod = (const float*)(ws + WS_MOD) + (size_t)l * 4 * 6144;
            pg8::DenseOrder S; S.init((const bf16_t*)(ws + WS_MIXB), (const bf16_t*)(ws + WS_WOUTT) + (size_t)l * D * D, NTOK, D, D, G, bx);
            pg8::EpiResid E{xin, (float*)(ws + WS_X1), mod + 2048, (const float*)(ws + WS_SSQ) + (size_t)l * NTOK * 4};
            pg8::gemm_phase<pg8::EpiResid, pg8::DenseOrder, true>(lds, S, E);
            GRID_BAR();
        }
        if (IN(PH_ROUTE)) { phase_route(a, l, lds, vcu, G); GRID_BAR(); }
        if (IN(PH_UP)) {
            KArgs* ka = kargs(); unsigned char* ws = ka->ws;
            moe_cum(a, l, lds);
            pg8::MoeOrder<true> S; S.A = (const bf16_t*)(ws + WS_HA); S.Bt = (const bf16_t*)(ws + WS_WGUT) + (size_t)l * NE * 1024 * 1024; S.K = D; S.bstride = (size_t)1024 * 1024;
            S.list = (const int*)(ws + WS_LIST); S.cum = (const LAS int*)(lds + LDS_MISC + MISC_CUM); S.cnts = (const LAS int*)(lds + LDS_MISC + MISC_CNT); S.G = G; S.c = vcu; S.nun = S.cum[32] * 4;
            pg8::EpiHid E{(bf16_t*)(ws + WS_HID)};
            pg8::gemm_phase(lds, S, E);
            GRID_BAR();
        }
        if (IN(PH_DOWN)) {
            KArgs* ka = kargs(); unsigned char* ws = ka->ws;
            moe_cum(a, l, lds);
            pg8::MoeOrder<false> S; S.A = (const bf16_t*)(ws + WS_HID); S.Bt = (const bf16_t*)(ws + WS_WDT) + (size_t)l * NE * 1024 * 512; S.K = F; S.bstride = (size_t)1024 * 512;
            S.list = nullptr; S.cum = (const LAS int*)(lds + LDS_MISC + MISC_CUM); S.cnts = (const LAS int*)(lds + LDS_MISC + MISC_CNT); S.G = G; S.c = vcu; S.nun = S.cum[32] * 4;
            pg8::EpiDown E{(bf16_t*)(ws + WS_Y), (const float*)(ws + WS_LGATE)};
            pg8::gemm_phase(lds, S, E);
            GRID_BAR();
        }
        if (IN(PH_COMB)) { phase_combine(a, l, lds, vcu, G); GRID_BAR(); }
    }
#undef IN
#undef GRID_BAR
}


static void launch_ph(const Args& base, int grid, int l_lo, int l_hi, int ph_lo, int ph_hi, int fused, hipStream_t stream) {
    Args a = base; a.l_lo = l_lo; a.l_hi = l_hi; a.ph_lo = ph_lo; a.ph_hi = ph_hi; a.fused = fused; a.pad = 0;
    hipLaunchKernelGGL(mk_fwd, dim3(grid), dim3(NTHR), LDS_BYTES, stream, a);
}

extern "C" void kernel_launch(void* const* d_in, const int* in_sizes, int n_in, void* d_out, int out_size, void* d_ws, size_t ws_size, hipStream_t stream) {
    static int grid = 0;
    if (grid == 0) {
        int dev = 0, cus = 0;
        if (hipGetDevice(&dev) != hipSuccess || hipDeviceGetAttribute(&cus, hipDeviceAttributeMultiprocessorCount, dev) != hipSuccess) { grid = -1; return; }
        if (hipFuncSetAttribute((const void*)mk_fwd, hipFuncAttributeMaxDynamicSharedMemorySize, LDS_BYTES) != hipSuccess) { fprintf(stderr, "hipFuncSetAttribute failed\n"); grid = -1; return; }
        (void)hipGetLastError();
        grid = cus;
    }
    if (grid < 0) return;
    unsigned char* ws = (unsigned char*)d_ws;
    (void)hipMemsetAsync(ws, 0, WS_ZERO_BYTES, stream);
    Args a{};
    for (int i = 0; i < 32; ++i) a.in[i] = d_in[i];
    a.out = (float*)d_out; a.ws = ws;
#ifdef MK_MULTI
    launch_ph(a, grid, 0, 0, PH_PRO, PH_PRO + 1, 0, stream);
#ifdef MK_REP
    if (MK_REP == PH_PRO) launch_ph(a, grid, 0, 0, PH_PRO, PH_PRO + 1, 0, stream);
#endif
    launch_ph(a, grid, 0, 0, PH_NORM0, PH_NORM0 + 1, 0, stream);
#ifdef MK_REP
    if (MK_REP == PH_NORM0) launch_ph(a, grid, 0, 0, PH_NORM0, PH_NORM0 + 1, 0, stream);
#endif
    for (int l = 0; l < L; ++l)
        for (int ph = PH_G1; ph < PH_END; ++ph) {
            launch_ph(a, grid, l, l + 1, ph, ph + 1, 0, stream);
#ifdef MK_REP
            if (ph == MK_REP) launch_ph(a, grid, l, l + 1, ph, ph + 1, 0, stream);
#endif
#ifdef MK_ROUTE_PROBE
            if (ph == PH_ROUTE) { Args a2 = a; a2.l_lo = l; a2.l_hi = l + 1; a2.ph_lo = ph; a2.ph_hi = ph + 1; a2.fused = 0; a2.pad = 1; hipLaunchKernelGGL(mk_fwd, dim3(grid), dim3(NTHR), LDS_BYTES, stream, a2); }
#endif
        }
#else
    launch_ph(a, grid, 0, L, PH_PRO, PH_END, 1, stream);
#endif
}
```

```cpp
#include <hip/hip_runtime.h>
#include <stdint.h>
#include <stdio.h>

#define LAS __attribute__((address_space(3)))
typedef unsigned short bf16_t;
typedef short bf16x8 __attribute__((ext_vector_type(8)));
typedef float f32x4 __attribute__((ext_vector_type(4)));
typedef float f32x16 __attribute__((ext_vector_type(16)));
typedef unsigned u32x4 __attribute__((ext_vector_type(4)));
typedef unsigned u32x2 __attribute__((ext_vector_type(2)));

constexpr int Bn = 4, S = 4096, D = 1024, L = 2, NTOK = Bn * S, DIN = 2212, F = 512, NE = 32;
constexpr int NP = 2304;
constexpr int NK = 0, NV = 256, NIQ = 512, NIK = 640, NIW = 672, NBA = 768, NBG = 1024, NC = 1280, NDU = 1536, NDV = 1792, NQ = 2048;
constexpr float EPS = 1e-6f;
constexpr int NTHR = 512;
constexpr int SLOTS = 40960;

constexpr int LDS_BYTES = 163840, LDS_MISC = 147456;
constexpr int MISC_BAR = 0;
constexpr int MISC_CUM = 64;
constexpr int MISC_CNT = 64 + 160;

constexpr size_t al256c(size_t v) { return (v + 255) & ~(size_t)255; }
constexpr size_t WS_BAR = 0;
constexpr size_t WS_CNT = 16384;
constexpr size_t WS_ZERO_BYTES = 16384 + 32768;
constexpr size_t WS_MOD = WS_ZERO_BYTES;
constexpr size_t WS_ROPEA = WS_MOD + al256c((size_t)L * 4 * 6144 * 4);
constexpr size_t WS_ROPEI = WS_ROPEA + al256c((size_t)NTOK * 16 * 4);
constexpr size_t WS_LIST = WS_ROPEI + al256c((size_t)NTOK * 8 * 4);
constexpr size_t WS_LGATE = WS_LIST + al256c((size_t)NE * NTOK * 4);
constexpr size_t WS_TOKINFO = WS_LGATE + al256c((size_t)NE * NTOK * 4);
constexpr size_t WS_SGUW = WS_TOKINFO + al256c((size_t)NTOK * 16);
constexpr size_t WS_POOLT = WS_SGUW + al256c((size_t)L * 4 * 128 * 128 * 2);
constexpr size_t WS_WHL = WS_POOLT + al256c((size_t)L * 4 * 64 * 64 * 2);
constexpr size_t WS_RBIAS = WS_WHL + al256c((size_t)L * 2 * 48 * 1024 * 2);
constexpr size_t WS_SSQ = WS_RBIAS + al256c((size_t)L * 4 * 48 * 4);
constexpr size_t WS_WINT = WS_SSQ + al256c((size_t)L * NTOK * 4 * 4);
constexpr size_t WS_WOUTT = WS_WINT + al256c((size_t)L * NP * D * 2);
constexpr size_t WS_PWT = WS_WOUTT + al256c((size_t)L * D * D * 2);
constexpr size_t WS_WGUT = WS_PWT + al256c((size_t)L * 256 * 256 * 2);
constexpr size_t WS_WDT = WS_WGUT + al256c((size_t)L * NE * 1024 * 1024 * 2);
constexpr size_t WS_HA = WS_WDT + al256c((size_t)L * NE * 1024 * 512 * 2);
constexpr size_t WS_X1 = WS_HA + al256c((size_t)NTOK * D * 2);
constexpr size_t WS_R = WS_X1 + al256c((size_t)NTOK * D * 4);
constexpr size_t WS_PROJ = WS_R;
constexpr size_t WS_R2 = WS_PROJ + al256c((size_t)NTOK * NP * 2);
constexpr size_t WS_HID = WS_R;
constexpr size_t WS_Y = WS_HID + al256c((size_t)SLOTS * F * 2);

__device__ __forceinline__ unsigned cvt_pk_bf16(float lo, float hi) { unsigned r; asm volatile("v_cvt_pk_bf16_f32 %0, %1, %2" : "=v"(r) : "v"(lo), "v"(hi)); return r; }
__device__ __forceinline__ float bf2f(bf16_t v) { return __uint_as_float(((unsigned)v) << 16); }
__device__ __forceinline__ float bflo(unsigned w) { return __uint_as_float(w << 16); }
__device__ __forceinline__ float bfhi(unsigned w) { return __uint_as_float(w & 0xffff0000u); }
template <int CTRL> __device__ __forceinline__ float dpp_f(float v) { return __builtin_bit_cast(float, __builtin_amdgcn_update_dpp(0, __builtin_bit_cast(int, v), CTRL, 0xF, 0xF, true)); }
__device__ __forceinline__ float row_sum16(float v) {
    v += dpp_f<0xB1>(v);
    v += dpp_f<0x4E>(v);
    v += dpp_f<0x141>(v);
    v += dpp_f<0x140>(v);
    return v;
}
__device__ __forceinline__ float wave_sum(float v) {
    v = row_sum16(v);
    const float r0 = __builtin_bit_cast(float, __builtin_amdgcn_readlane(__builtin_bit_cast(int, v), 0)), r1 = __builtin_bit_cast(float, __builtin_amdgcn_readlane(__builtin_bit_cast(int, v), 16));
    const float r2 = __builtin_bit_cast(float, __builtin_amdgcn_readlane(__builtin_bit_cast(int, v), 32)), r3 = __builtin_bit_cast(float, __builtin_amdgcn_readlane(__builtin_bit_cast(int, v), 48));
    return (r0 + r1) + (r2 + r3);
}
__device__ __forceinline__ float wave_max(float v) {
#pragma unroll
    for (int o = 32; o >= 1; o >>= 1) v = fmaxf(v, __shfl_xor(v, o));
    return v;
}
__device__ __forceinline__ float silu_f(float v) { return v / (1.0f + expf(-v)); }
__device__ __forceinline__ float silu_fast(float v) { return v * __builtin_amdgcn_rcpf(1.0f + __expf(-v)); }
__device__ __forceinline__ float sigmoid_f(float v) { return 1.0f / (1.0f + expf(-v)); }
__device__ __forceinline__ float sigmoid_fast(float v) { return __builtin_amdgcn_rcpf(1.0f + __expf(-v)); }
__device__ __forceinline__ int opaque_tid() { int t = threadIdx.x; asm volatile("" : "+v"(t)); return t; }
__device__ __forceinline__ int ld_agent(const int* p) { return __hip_atomic_load(p, __ATOMIC_RELAXED, __HIP_MEMORY_SCOPE_AGENT); }

#define XB_TMO      128
#define XB_XCNT(j)  (256  + 64 * (j))
#define XB_XSUB(j)  (1280 + 64 * (j))
#define XB_XGEN(j)  (2304 + 64 * (j))
#define XB_TOP      3328
#define XB_TOPGEN   3392
#define XCD_BAR_WORDS 3456
#define XB_SPIN_CAP (1u << 18)
__device__ __forceinline__ unsigned xb_ld(unsigned* p)              { return __hip_atomic_load(p, __ATOMIC_RELAXED, __HIP_MEMORY_SCOPE_AGENT); }
__device__ __forceinline__ unsigned xb_add(unsigned* p, unsigned v) { return __hip_atomic_fetch_add(p, v, __ATOMIC_RELAXED, __HIP_MEMORY_SCOPE_AGENT); }
__device__ __forceinline__ unsigned xb_xcc_id() { return (unsigned)__builtin_amdgcn_s_getreg((3 << 11) | 20) & 0xFu; }
#define XB_SPIN(cond, bar) do { unsigned _sp = 0; while (cond) { __builtin_amdgcn_s_sleep(1); \
    if ((++_sp & 255u) == 0u) { if (xb_ld(&(bar)[XB_TMO])) break; if (_sp > XB_SPIN_CAP) { atomicAdd(&(bar)[XB_TMO], 1u); break; } } } } while (0)
struct XcdBarrier { unsigned* bar; unsigned x; volatile LAS unsigned* st; };
__device__ __forceinline__ XcdBarrier xcd_barrier_post(unsigned* bar, volatile LAS unsigned* st) {
    XcdBarrier b; b.bar = bar; b.x = xb_xcc_id(); b.st = st;
    if (threadIdx.x == 0) (void)xb_add(&bar[XB_XCNT(b.x)], 1u);
    return b;
}
__device__ __forceinline__ void xcd_barrier_complete(unsigned* bar, unsigned x, unsigned& nloc, unsigned& nx) {
    const unsigned G = gridDim.x * gridDim.y * gridDim.z;
    unsigned sum, cnt, mine, sp = 0u;
    for (;;) {
        sum = 0u; cnt = 0u; mine = 0u;
#pragma unroll
        for (unsigned j = 0; j < 16; ++j) { const unsigned c = xb_ld(&bar[XB_XCNT(j)]); sum += c; cnt += (c > 0u) ? 1u : 0u; mine = (j == x) ? c : mine; }
        if (sum == G) break;
        __builtin_amdgcn_s_sleep(1);
        if ((++sp & 255u) == 0u) { if (xb_ld(&bar[XB_TMO])) break; if (sp > XB_SPIN_CAP) { atomicAdd(&bar[XB_TMO], 1u); break; } }
    }
    nloc = mine > 0u ? mine : 1u; nx = cnt > 0u ? cnt : 1u;
}
__device__ __forceinline__ void xcd_barrier(const XcdBarrier& b) {
    asm volatile("s_waitcnt vmcnt(0)" ::: "memory");
    __syncthreads();
    if (threadIdx.x == 0) {
        unsigned* bar = b.bar;
        __builtin_amdgcn_s_waitcnt(0);
        unsigned nloc = b.st[0], nx = b.st[1];
        if (nloc == 0u) { xcd_barrier_complete(bar, b.x, nloc, nx); b.st[0] = nloc; b.st[1] = nx; }
        const unsigned old = xb_add(&bar[XB_XSUB(b.x)], 1u);
        const unsigned gen = old / nloc;
        if (old + 1u == (gen + 1u) * nloc) {
            __builtin_amdgcn_fence(__ATOMIC_RELEASE, "agent");
            asm volatile("s_waitcnt vmcnt(0)" ::: "memory");
            const unsigned og = xb_add(&bar[XB_TOP], 1u);
            const unsigned tg = og / nx;
            if (og + 1u == (tg + 1u) * nx) xb_add(&bar[XB_TOPGEN], 1u);
            else XB_SPIN(xb_ld(&bar[XB_TOPGEN]) == tg, bar);
            __builtin_amdgcn_fence(__ATOMIC_ACQUIRE, "agent");
            xb_add(&bar[XB_XGEN(b.x)], 1u);
            asm volatile("s_waitcnt vmcnt(0)" ::: "memory");
        } else {
            XB_SPIN(xb_ld(&bar[XB_XGEN(b.x)]) == gen, bar);
            __builtin_amdgcn_fence(__ATOMIC_ACQUIRE, "agent");
            asm volatile("s_waitcnt vmcnt(0)" ::: "memory");
        }
    }
    __syncthreads();
}

namespace pg8 {
constexpr int BM = 256, BK = 64, HALF = 128, HTB = HALF * BK * 2, STAGE_BYTES = 8 * HTB, NXCD = 8, WGM = 8;
__host__ __device__ __forceinline__ int lds_byte(int r, int c) { const int st = (r >> 4) * 2 + (c >> 5), rr = r & 15, cc = c & 31, ob = rr * 64 + cc * 2; return st * 1024 + (ob ^ (((ob >> 9) & 1) << 5)); }
__host__ __device__ __forceinline__ void stage_rc(int b, int& R, int& C) { const int st = b / 1024, sb = b % 1024, swz = sb ^ (((sb >> 9) & 1) << 5); R = (st >> 1) * 16 + swz / 64; C = (st & 1) * 32 + (swz % 64) / 2; }
__host__ __device__ __forceinline__ int perm32(int rho) { const int n = rho >> 4, i = rho & 15; return 8 * (i >> 2) + 4 * n + (i & 3); }

struct Unit { int pm, pn, e, mt, cnt; };

struct DenseOrder {
    const bf16_t* A; const bf16_t* Bt; int K;
    int nM, nN, nwg, G, c;
    __device__ void init(const bf16_t* A_, const bf16_t* Bt_, int M, int N, int K_, int G_, int c_) { A = A_; Bt = Bt_; K = K_; nM = M / BM; nN = N / BM; nwg = nM * nN; G = G_; c = c_; }
    __device__ bool next(int i, Unit& u) const {
        const long Lx = (long)i * G + c; if (Lx >= nwg) return false;
        int wgid = (int)Lx; { const int q = nwg / NXCD, r = nwg % NXCD, xcd = wgid % NXCD, off = wgid / NXCD; wgid = (xcd < r ? xcd * (q + 1) : r * (q + 1) + (xcd - r) * q) + off; }
        const int nig = WGM * nN, gid = wgid / nig, fm = gid * WGM, gsz = (nM - fm) < WGM ? (nM - fm) : WGM;
        u.pm = fm + ((wgid % nig) % gsz); u.pn = (wgid % nig) / gsz; u.e = 0; u.mt = 0; u.cnt = 0; return true;
    }
    __device__ __forceinline__ const char* a_base(const Unit& u) const { return (const char*)A + (size_t)u.pm * BM * K * 2; }
    __device__ __forceinline__ unsigned a_voff(const Unit&, int row, int C) const { return (unsigned)(row * K + C) * 2u; }
    __device__ __forceinline__ const char* b_base(const Unit& u) const { return (const char*)Bt + (size_t)u.pn * BM * K * 2; }
};
template <bool gather> struct MoeOrder {
    const bf16_t* A; const bf16_t* Bt; int K; size_t bstride;
    const int* list;
    const LAS int* cum; const LAS int* cnts;
    int G, c, nun;
    __device__ bool next(int i, Unit& u) const {
        const int Lx = i * G + c; if (Lx >= nun) return false;
        const int t = Lx >> 2; u.pn = Lx & 3; u.pm = t;
        int e = 0;
#pragma unroll 1
        for (int j = 1; j < NE; ++j) e += (cum[j] <= t) ? 1 : 0;
        u.e = e; u.mt = t - cum[e]; u.cnt = cnts[e]; return true;
    }
    __device__ __forceinline__ const char* a_base(const Unit& u) const { return gather ? (const char*)A : (const char*)A + (size_t)u.pm * BM * K * 2; }
    __device__ __forceinline__ unsigned a_voff(const Unit& u, int row, int C) const {
        if (gather) { const int pos = u.mt * BM + row; const int tok = (pos < u.cnt) ? list[(size_t)u.e * NTOK + pos] : 0; return (unsigned)(tok * K + C) * 2u; }
        return (unsigned)(row * K + C) * 2u;
    }
    __device__ __forceinline__ const char* b_base(const Unit& u) const { return (const char*)(Bt + (size_t)u.e * bstride) + (size_t)u.pn * BM * K * 2; }
};

struct EpiBf16 {
    static constexpr bool PERM = true;
    bf16_t* O; int ldc;
    __device__ __forceinline__ void operator()(const f32x4 (&acc)[2][2][4][2], const Unit& u, int wr, int wc, int fr, int fq) const {
        const int row0 = u.pm * BM + wr * 64 + fr, col0 = u.pn * BM + wc * 32 + 8 * fq;
#pragma unroll
        for (int ai = 0; ai < 2; ++ai)
#pragma unroll
            for (int m = 0; m < 4; ++m) { bf16_t* rowp = O + (size_t)(row0 + ai * HALF + m * 16) * ldc + col0;
#pragma unroll
                for (int bj = 0; bj < 2; ++bj) { const f32x4 v0 = acc[ai][bj][m][0], v1 = acc[ai][bj][m][1];
                    u32x4 w; w.x = cvt_pk_bf16(v0[0], v0[1]); w.y = cvt_pk_bf16(v0[2], v0[3]); w.z = cvt_pk_bf16(v1[0], v1[1]); w.w = cvt_pk_bf16(v1[2], v1[3]);
                    *(u32x4*)(rowp + bj * HALF) = w; } }
    }
};
struct EpiResid {
    static constexpr bool PERM = true;
    const float* X; const bf16_t* Xb; bf16_t* C; const float* gate;
    const float* ssq;
    __device__ __forceinline__ void rowscale(f32x4 (&acc)[2][2][4][2], const Unit& u, int wr, int fr) const {
        int rbase = u.pm * BM + wr * 64 + fr;
        asm volatile("" : "+v"(rbase));
#pragma unroll
        for (int ai = 0; ai < 2; ++ai)
#pragma unroll
            for (int m = 0; m < 4; ++m) { const f32x4 sv = *(const f32x4*)(ssq + (size_t)(rbase + ai * HALF + m * 16) * 4); const float r = rsqrtf(((sv[0] + sv[1]) + (sv[2] + sv[3])) * (1.0f / 256.0f) + EPS);
#pragma unroll
                for (int bj = 0; bj < 2; ++bj)
#pragma unroll
                    for (int n = 0; n < 2; ++n) acc[ai][bj][m][n] *= r; }
    }
    __device__ __forceinline__ void operator()(const f32x4 (&acc)[2][2][4][2], const Unit& u, int wr, int wc, int fr, int fq) const {
        const int row0 = u.pm * BM + wr * 64 + fr, col0 = u.pn * BM + wc * 32 + 8 * fq;
        const float* gp = gate + (size_t)((u.pm * BM) / S) * 6144 + col0;
        f32x4 gv[2][2];
#pragma unroll
        for (int bj = 0; bj < 2; ++bj)
#pragma unroll
            for (int n = 0; n < 2; ++n) gv[bj][n] = *(const f32x4*)(gp + bj * HALF + n * 4);
#pragma unroll
        for (int ai = 0; ai < 2; ++ai)
#pragma unroll
            for (int m = 0; m < 4; ++m) { const size_t off = (size_t)(row0 + ai * HALF + m * 16) * D + col0;
#pragma unroll
                for (int bj = 0; bj < 2; ++bj) {
                    f32x4 x0, x1v;
                    if (Xb) { const u32x4 xw = *(const u32x4*)(Xb + off + bj * HALF); x0 = (f32x4){bflo(xw.x), bfhi(xw.x), bflo(xw.y), bfhi(xw.y)}; x1v = (f32x4){bflo(xw.z), bfhi(xw.z), bflo(xw.w), bfhi(xw.w)}; }
                    else { x0 = *(const f32x4*)(X + off + bj * HALF); x1v = *(const f32x4*)(X + off + bj * HALF + 4); }
                    const f32x4 o0 = x0 + gv[bj][0] * acc[ai][bj][m][0], o1 = x1v + gv[bj][1] * acc[ai][bj][m][1];
                    u32x4 w; w.x = cvt_pk_bf16(o0[0], o0[1]); w.y = cvt_pk_bf16(o0[2], o0[3]); w.z = cvt_pk_bf16(o1[0], o1[1]); w.w = cvt_pk_bf16(o1[2], o1[3]);
                    *(u32x4*)(C + off + bj * HALF) = w; }
                asm volatile("" ::: "memory"); }
    }
};
struct EpiHid {
    static constexpr bool PERM = true;
    bf16_t* H;
    __device__ __forceinline__ void operator()(const f32x4 (&acc)[2][2][4][2], const Unit& u, int wr, int wc, int fr, int fq) const {
        const int row0 = u.pm * BM + wr * 64 + fr, col0 = u.pn * HALF + wc * 32 + 8 * fq;
#pragma unroll
        for (int ai = 0; ai < 2; ++ai)
#pragma unroll
            for (int m = 0; m < 4; ++m) { float h[8];
#pragma unroll
                for (int n = 0; n < 2; ++n)
#pragma unroll
                    for (int j = 0; j < 4; ++j) h[n * 4 + j] = silu_fast(acc[ai][0][m][n][j]) * acc[ai][1][m][n][j];
                u32x4 w; w.x = cvt_pk_bf16(h[0], h[1]); w.y = cvt_pk_bf16(h[2], h[3]); w.z = cvt_pk_bf16(h[4], h[5]); w.w = cvt_pk_bf16(h[6], h[7]);
                *(u32x4*)(H + (size_t)(row0 + ai * HALF + m * 16) * F + col0) = w; }
    }
};
struct EpiDown {
    static constexpr bool PERM = true;
    bf16_t* Y; const float* lgate;
    __device__ __forceinline__ void operator()(const f32x4 (&acc)[2][2][4][2], const Unit& u, int wr, int wc, int fr, int fq) const {
        const int rl0 = wr * 64 + fr, col0 = u.pn * BM + wc * 32 + 8 * fq;
        const float* gp = lgate + (size_t)u.e * NTOK + u.mt * BM;
#pragma unroll
        for (int ai = 0; ai < 2; ++ai)
#pragma unroll
            for (int m = 0; m < 4; ++m) { const int rl = rl0 + ai * HALF + m * 16; const float g = (u.mt * BM + rl < u.cnt) ? gp[rl] : 0.f;
                bf16_t* rowp = Y + (size_t)(u.pm * BM + rl) * D + col0;
#pragma unroll
                for (int bj = 0; bj < 2; ++bj) { const f32x4 v0 = acc[ai][bj][m][0] * g, v1 = acc[ai][bj][m][1] * g;
                    u32x4 w; w.x = cvt_pk_bf16(v0[0], v0[1]); w.y = cvt_pk_bf16(v0[2], v0[3]); w.z = cvt_pk_bf16(v1[0], v1[1]); w.w = cvt_pk_bf16(v1[2], v1[3]);
                    *(u32x4*)(rowp + bj * HALF) = w; } }
    }
};

template <class Epi, class Sched, bool RSC = false>
__device__ __forceinline__ void gemm_phase(LAS unsigned char* lds, const Sched& S, const Epi& E) {
    const int tid = opaque_tid(), wid = __builtin_amdgcn_readfirstlane(tid >> 6), lane = tid & 63, wr = wid >> 2, wc = wid & 3, fr = lane & 15, fq = lane >> 4;
    const int K = S.K, nt = K / BK;
    int Rr[2], Cc[2]; unsigned voffB[2];
#pragma unroll
    for (int i = 0; i < 2; ++i) { stage_rc(tid * 16 + i * 8192, Rr[i], Cc[i]); const int Rb = Epi::PERM ? ((Rr[i] & ~31) + perm32(Rr[i] & 31)) : Rr[i]; voffB[i] = (unsigned)(Rb * K + Cc[i]) * 2u; }
    const size_t kstep = (size_t)(BK * 2);
    const size_t hstep = (size_t)HALF * K * 2;
    const unsigned ldsw = (unsigned)wid * 1024u;
    const int aoff = lds_byte(wr * 64 + fr, fq * 8), boff = lds_byte(wc * 32 + fr, fq * 8);
#define PG8_SA(b, h) (((b) * 2 + (h)) * HTB)
#define PG8_SB(b, h) ((4 + (b) * 2 + (h)) * HTB)
#define PG8_STAGE(bufoff, gbase, voff) do { _Pragma("unroll") for (int _i = 0; _i < 2; ++_i) \
        __builtin_amdgcn_global_load_lds((const unsigned*)((const char*)(gbase) + (voff)[_i]), (LAS unsigned*)(lds + (bufoff) + ldsw + _i * 8192), 16, 0, 0); } while (0)
#define PG8_LDA(dst, b, h) do { _Pragma("unroll") for (int m = 0; m < 4; ++m) _Pragma("unroll") for (int k = 0; k < 2; ++k) dst[m][k] = *(const LAS bf16x8*)(lds + PG8_SA(b, h) + aoff + m * 2048 + k * 1024); } while (0)
#define PG8_LDB(dst, b, h) do { _Pragma("unroll") for (int n = 0; n < 2; ++n) _Pragma("unroll") for (int k = 0; k < 2; ++k) dst[n][k] = *(const LAS bf16x8*)(lds + PG8_SB(b, h) + boff + n * 2048 + k * 1024); } while (0)
#define PG8_MMA(ai, bj, At, Bt) do { __builtin_amdgcn_s_setprio(1); _Pragma("unroll") for (int m = 0; m < 4; ++m) _Pragma("unroll") for (int n = 0; n < 2; ++n) _Pragma("unroll") for (int k = 0; k < 2; ++k) \
        acc[ai][bj][m][n] = __builtin_amdgcn_mfma_f32_16x16x32_bf16(Bt[n][k], At[m][k], acc[ai][bj][m][n], 0, 0, 0); __builtin_amdgcn_s_setprio(0); } while (0)
#define PG8_WAIT_V(n) asm volatile("s_waitcnt vmcnt(" #n ")" ::: "memory")
#define PG8_WAIT_L(n) asm volatile("s_waitcnt lgkmcnt(" #n ")" ::: "memory")
#define PG8_BAR __builtin_amdgcn_s_barrier()
#define PG8_SCHED __builtin_amdgcn_sched_barrier(0)
    Unit cur, nxt; int ui = 0;
    if (!S.next(0, cur)) return;
    f32x4 acc[2][2][4][2];
#pragma unroll
    for (int a = 0; a < 2; ++a)
#pragma unroll
        for (int b = 0; b < 2; ++b)
#pragma unroll
            for (int m = 0; m < 4; ++m)
#pragma unroll
                for (int n = 0; n < 2; ++n) acc[a][b][m][n] = (f32x4){0.f, 0.f, 0.f, 0.f};
    bf16x8 At[4][2], B0[2][2], B1[2][2];
    unsigned vA0[2], vA1[2], vN0[2], vN1[2];
#pragma unroll
    for (int i = 0; i < 2; ++i) { vA0[i] = S.a_voff(cur, Rr[i], Cc[i]); vA1[i] = S.a_voff(cur, HALF + Rr[i], Cc[i]); }
    const char* cA = S.a_base(cur); const char* cB = S.b_base(cur);
    PG8_STAGE(PG8_SB(0, 0), cB, voffB); PG8_STAGE(PG8_SB(0, 1), cB + hstep, voffB); PG8_STAGE(PG8_SA(0, 0), cA, vA0); PG8_STAGE(PG8_SA(0, 1), cA, vA1);
    if (wr == 1) PG8_BAR;
    PG8_WAIT_V(2); PG8_BAR;
    PG8_STAGE(PG8_SB(1, 0), cB + kstep, voffB); PG8_STAGE(PG8_SA(1, 0), cA + kstep, vA0); PG8_STAGE(PG8_SB(1, 1), cB + hstep + kstep, voffB);
    PG8_WAIT_V(6); PG8_BAR;
    for (;;) {
        const bool has_next = S.next(ui + 1, nxt);
        const char* nA = has_next ? S.a_base(nxt) : cA; const char* nB = has_next ? S.b_base(nxt) : cB;
#pragma unroll
        for (int i = 0; i < 2; ++i) { vN0[i] = has_next ? S.a_voff(nxt, Rr[i], Cc[i]) : vA0[i]; vN1[i] = has_next ? S.a_voff(nxt, HALF + Rr[i], Cc[i]) : vA1[i]; }
        for (int t = 0; t < nt; t += 2) {
            const bool last = (t == nt - 2);
            if constexpr (RSC) { if (t == 4) E.rowscale(acc, cur, wr, fr); }
            const char* a1 = cA + (size_t)(t + 1) * kstep;
            const char* a2 = last ? nA : cA + (size_t)(t + 2) * kstep; const char* b2 = last ? nB : cB + (size_t)(t + 2) * kstep;
            const char* a3 = a2 + kstep; const char* b3 = b2 + kstep;
            unsigned w0[2], w1[2];
#pragma unroll
            for (int i = 0; i < 2; ++i) { w0[i] = last ? vN0[i] : vA0[i]; w1[i] = last ? vN1[i] : vA1[i]; }
            PG8_LDB(B0, 0, 0); PG8_LDB(B1, 0, 1); PG8_SCHED; PG8_LDA(At, 0, 0); PG8_STAGE(PG8_SA(1, 1), a1, vA1);
            PG8_WAIT_V(8); PG8_WAIT_L(0); PG8_BAR; PG8_MMA(0, 0, At, B0); PG8_MMA(0, 1, At, B1); PG8_BAR; PG8_SCHED;
            PG8_LDA(At, 0, 1); PG8_STAGE(PG8_SB(0, 0), b2, voffB); PG8_STAGE(PG8_SB(0, 1), b2 + hstep, voffB); PG8_STAGE(PG8_SA(0, 0), a2, w0);
            PG8_WAIT_V(8); PG8_WAIT_L(0); PG8_BAR; PG8_MMA(1, 0, At, B0); PG8_MMA(1, 1, At, B1); PG8_BAR; PG8_SCHED;
            PG8_LDB(B0, 1, 0); PG8_LDB(B1, 1, 1); PG8_SCHED; PG8_LDA(At, 1, 0); PG8_STAGE(PG8_SA(0, 1), a2, w1);
            PG8_WAIT_V(8); PG8_WAIT_L(0); PG8_BAR; PG8_MMA(0, 0, At, B0); PG8_MMA(0, 1, At, B1); PG8_BAR; PG8_SCHED;
            PG8_LDA(At, 1, 1); PG8_STAGE(PG8_SB(1, 0), b3, voffB); PG8_STAGE(PG8_SB(1, 1), b3 + hstep, voffB); PG8_STAGE(PG8_SA(1, 0), a3, w0);
            PG8_WAIT_V(8); PG8_WAIT_L(0); PG8_BAR; PG8_MMA(1, 0, At, B0); PG8_MMA(1, 1, At, B1); PG8_BAR; PG8_SCHED;
        }
        if (wr == 0) PG8_BAR;
        E(acc, cur, wr, wc, fr, fq);
        if (!has_next) break;
#pragma unroll
        for (int a = 0; a < 2; ++a)
#pragma unroll
            for (int b = 0; b < 2; ++b)
#pragma unroll
                for (int m = 0; m < 4; ++m)
#pragma unroll
                    for (int n = 0; n < 2; ++n) acc[a][b][m][n] = (f32x4){0.f, 0.f, 0.f, 0.f};
        cur = nxt; cA = nA; cB = nB; ++ui;
#pragma unroll
        for (int i = 0; i < 2; ++i) { vA0[i] = vN0[i]; vA1[i] = vN1[i]; }
        if (wr == 1) PG8_BAR;
    }
    PG8_WAIT_V(0);
    PG8_BAR;
#undef PG8_SA
#undef PG8_SB
#undef PG8_STAGE
#undef PG8_LDA
#undef PG8_LDB
#undef PG8_MMA
#undef PG8_WAIT_V
#undef PG8_WAIT_L
#undef PG8_BAR
#undef PG8_SCHED
}
}
struct Args { const void* in[32]; float* out; unsigned char* ws; int l_lo, l_hi, ph_lo, ph_hi, fused, pad; };
enum { PH_PRO = 0, PH_NORM0 = 1, PH_G1 = 2, PH_MIX = 3, PH_A1 = 4, PH_A2 = 5, PH_AN = 6, PH_G2 = 7, PH_ROUTE = 8, PH_UP = 9, PH_DOWN = 10, PH_COMB = 11, PH_END = 12 };

typedef const Args __attribute__((address_space(4))) KArgs;
__device__ __forceinline__ KArgs* kargs() { KArgs* p = (KArgs*)__builtin_amdgcn_kernarg_segment_ptr(); asm volatile("" : "+s"(p)); return p; }
#define IN_F(i) ((const float*)ka->in[i])
enum { I_X = 0, I_C, I_POS, I_WADA, I_BADA, I_NORM1, I_WIN, I_QN, I_KN, I_CONVW, I_CONVB, I_CLNG, I_CLNB, I_PWW, I_PWB, I_POOLW, I_POOLB, I_POOLS, I_SLNG, I_SLNB, I_SGUW, I_SGUB,
       I_ONORM, I_WOUT, I_NORM2, I_WRG, I_BRG, I_WRE, I_BRE, I_WG, I_WU, I_WD };

__device__ __forceinline__ void sincos_d(double a, double& s, double& c) {
    const double k = rint(a * 0.63661977236758134308);
    const double r = (a - k * 1.57079632679489655800) - k * 6.123233995736766036e-17;
    const double r2 = r * r;
    const double sp = r * (1.0 + r2 * (-1.0 / 6 + r2 * (1.0 / 120 + r2 * (-1.0 / 5040 + r2 * (1.0 / 362880 + r2 * (-1.0 / 39916800 + r2 * (1.0 / 6227020800.0)))))));
    const double cp = 1.0 + r2 * (-0.5 + r2 * (1.0 / 24 + r2 * (-1.0 / 720 + r2 * (1.0 / 40320 + r2 * (-1.0 / 3628800 + r2 * (1.0 / 479001600.0 + r2 * (-1.0 / 87178291200.0)))))));
    const int q = ((int)k) & 3;
    if (q == 0) { s = sp; c = cp; } else if (q == 1) { s = cp; c = -sp; } else if (q == 2) { s = -sp; c = -cp; } else { s = -cp; c = sp; }
}

__device__ __forceinline__ bf16_t f2bf_(float f) { return (bf16_t)(cvt_pk_bf16(f, 0.f) & 0xffffu); }
struct TItem { const float* src; int ld; int ncol; bf16_t* dst; int ldd; const float* rsc; };
constexpr int NT_WIN = L * 36 * 4, NT_WOUT = L * 16 * 4, NT_PW = L * 4, NT_WGU = L * NE * 16 * 4, NT_WD = L * NE * 16 * 2;
constexpr int NT_ALL = NT_WIN + NT_WOUT + NT_PW + NT_WGU + NT_WD;
__device__ __forceinline__ void decode_titem(int it, const Args& a, TItem& t) {
    KArgs* ka = kargs();
    unsigned char* ws = ka->ws;
    t.rsc = nullptr;
    if (it < NT_WIN) {
        const int l = it / 144, r = it % 144, n0 = (r >> 2) * 64, k0 = (r & 3) * 256;
        const int c0 = n0 < 768 ? n0 + 256 : (n0 < 2048 ? n0 + 164 : n0 - 2048);
        t.ncol = (n0 < 768) ? ((n0 + 64 <= 676) ? 64 : (n0 < 676 ? 676 - n0 : 0)) : 64;
        t.src = IN_F(I_WIN) + ((size_t)l * D + k0) * DIN + c0; t.ld = DIN;
        t.dst = (bf16_t*)(ws + WS_WINT) + ((size_t)l * NP + n0) * D + k0; t.ldd = D; return;
    }
    it -= NT_WIN;
    if (it < NT_WOUT) {
        const int l = it / 64, r = it % 64, n0 = (r >> 2) * 64, k0 = (r & 3) * 256;
        t.ncol = 64; t.src = IN_F(I_WOUT) + ((size_t)l * D + k0) * D + n0; t.ld = D; t.rsc = (k0 == 0) ? IN_F(I_ONORM) + l * D : nullptr;
        t.dst = (bf16_t*)(ws + WS_WOUTT) + ((size_t)l * D + n0) * D + k0; t.ldd = D; return;
    }
    it -= NT_WOUT;
    if (it < NT_PW) {
        const int l = it / 4, n0 = (it & 3) * 64;
        t.ncol = 64; t.src = IN_F(I_PWW) + (size_t)l * 65536 + n0; t.ld = 256;
        t.dst = (bf16_t*)(ws + WS_PWT) + ((size_t)l * 256 + n0) * 256; t.ldd = 256; return;
    }
    it -= NT_PW;
    if (it < NT_WGU) {
        const int le = it / 64, r = it % 64, n0 = (r >> 2) * 64, k0 = (r & 3) * 256;
        const int pn = n0 >> 8, rr = n0 & 255;
        const float* W = (rr < 128) ? IN_F(I_WG) : IN_F(I_WU);
        t.ncol = 64; t.src = W + ((size_t)le * D + k0) * F + pn * 128 + (rr & 127); t.ld = F;
        t.dst = (bf16_t*)(ws + WS_WGUT) + ((size_t)le * 1024 + n0) * D + k0; t.ldd = D; return;
    }
    it -= NT_WGU;
    {
        const int le = it / 32, r = it % 32, n0 = (r >> 1) * 64, k0 = (r & 1) * 256;
        t.ncol = 64; t.src = IN_F(I_WD) + ((size_t)le * F + k0) * D + n0; t.ld = D;
        t.dst = (bf16_t*)(ws + WS_WDT) + ((size_t)le * D + n0) * F + k0; t.ldd = F;
    }
}
__device__ __forceinline__ void titem_load(const TItem& t, int tid, float4 (&v)[8]) {
    const int c4 = tid & 15, r0 = tid >> 4;
#pragma unroll
    for (int i = 0; i < 8; ++i) v[i] = (c4 * 4 < t.ncol) ? *(const float4*)(t.src + (size_t)(r0 + 32 * i) * t.ld + c4 * 4) : make_float4(0.f, 0.f, 0.f, 0.f);
    if (t.rsc) {
#pragma unroll
        for (int i = 0; i < 8; ++i) { const float s = t.rsc[r0 + 32 * i]; v[i].x *= s; v[i].y *= s; v[i].z *= s; v[i].w *= s; }
    }
}
__device__ __forceinline__ void phase_prologue(const Args& a, LAS unsigned char* lds, int vcu, int G) {
    KArgs* ka = kargs();
    const int tid = opaque_tid(), wid = __builtin_amdgcn_readfirstlane(tid >> 6), lane = tid & 63;
    LAS float* T = (LAS float*)lds;
    LAS float* cs = (LAS float*)(lds + 66560);
    LAS float* red = (LAS float*)(lds + 66560 + 16384);
    unsigned char* ws = ka->ws;
    if (vcu < 192) {
        for (int i = tid; i < 4096; i += NTHR) cs[i] = silu_f(IN_F(I_C)[i]);
        __syncthreads();
        for (int it = vcu; it < 192; it += G) {
            const int l = it / 96, j0 = (it % 96) * 64;
            const float* wp = IN_F(I_WADA) + ((size_t)l * D + wid * 128) * 6144 + j0 + lane;
            float a0 = 0.f, a1 = 0.f, a2 = 0.f, a3 = 0.f;
#pragma unroll 32
            for (int k = 0; k < 128; ++k) { const float wv = wp[(size_t)k * 6144]; const int kk = wid * 128 + k; a0 += cs[kk] * wv; a1 += cs[1024 + kk] * wv; a2 += cs[2048 + kk] * wv; a3 += cs[3072 + kk] * wv; }
            red[(wid * 4 + 0) * 64 + lane] = a0; red[(wid * 4 + 1) * 64 + lane] = a1; red[(wid * 4 + 2) * 64 + lane] = a2; red[(wid * 4 + 3) * 64 + lane] = a3;
            __syncthreads();
            if (wid < 4) { float s = 0.f;
#pragma unroll
                for (int w = 0; w < 8; ++w) s += red[(w * 4 + wid) * 64 + lane];
                ((float*)(ws + WS_MOD))[((size_t)l * 4 + wid) * 6144 + j0 + lane] = s + IN_F(I_BADA)[l * 6144 + j0 + lane]; }
            __syncthreads();
        }
    }
    for (int i = vcu * NTHR + tid; i < NTOK; i += G * NTHR) {
        const float invA[8] = {1.0f, 0.1939227432012558f, 0.03760603070259094f, 0.007292664609849453f, 0.0014142135623842478f, 0.00027424818836152554f, 5.318296098266728e-05f, 1.0313386155758053e-05f};
        const float invI[4] = {1.0f, 0.03760603070259094f, 0.0014142135623842478f, 5.318296098266728e-05f};
        const float p = (float)((const int*)ka->in[I_POS])[i];
        float* ra = (float*)(ws + WS_ROPEA) + (size_t)i * 16; float* ri = (float*)(ws + WS_ROPEI) + (size_t)i * 8;
#pragma unroll
        for (int j = 0; j < 8; ++j) { const float ang = p * invA[j]; double s, c; sincos_d((double)ang, s, c); ra[j] = (float)c; ra[8 + j] = (float)s; }
#pragma unroll
        for (int j = 0; j < 4; ++j) { const float ang = p * invI[j]; double s, c; sincos_d((double)ang, s, c); ri[j] = (float)c; ri[4 + j] = (float)s; }
    }
    for (int i = vcu * NTHR + tid; i < L * 4 * 128 * 128; i += G * NTHR) { const int s = i & 127, t = (i >> 7) & 127; ((bf16_t*)(ws + WS_SGUW))[i] = (bf16_t)(cvt_pk_bf16(s <= t ? IN_F(I_SGUW)[i] : 0.f, 0.f) & 0xffffu); }
    for (int i = vcu * NTHR + tid; i < L * 4 * 64 * 64; i += G * NTHR) { const int c = i & 63, d = (i >> 6) & 63, lg = i >> 12; ((bf16_t*)(ws + WS_POOLT))[i] = (bf16_t)(cvt_pk_bf16(IN_F(I_POOLW)[((size_t)lg * 64 + c) * 64 + d], 0.f) & 0xffffu); }
    for (int i = vcu * NTHR + tid; i < L * 48 * 1024; i += G * NTHR) {
        const int k = i & 1023, n = (i >> 10) % 48, lg = i / (48 * 1024);
        const float w = (n < 4) ? IN_F(I_WRG)[((size_t)lg * D + k) * 4 + n] : (n < 36) ? IN_F(I_WRE)[((size_t)lg * D + k) * 32 + (n - 4)] : 0.f;
        const unsigned hi = cvt_pk_bf16(w, 0.f) & 0xffffu; const float lo = w - __uint_as_float(hi << 16);
        bf16_t* dst = (bf16_t*)(ws + WS_WHL) + (size_t)lg * 2 * 48 * 1024 + (size_t)n * 1024 + k;
        dst[0] = (bf16_t)hi; dst[48 * 1024] = f2bf_(lo);
    }
    int it = (G - 1 - vcu);
    bool have = it < NT_ALL;
    TItem cur; cur.src = nullptr; cur.ld = 0; cur.ncol = 0; cur.dst = nullptr; cur.ldd = 0; cur.rsc = nullptr;
    float4 v[8];
    if (have) { decode_titem(it, a, cur); titem_load(cur, tid, v); }
    while (have) {
        { const int c4 = tid & 15, r0 = tid >> 4;
#pragma unroll
          for (int i = 0; i < 8; ++i) { LAS float* tp = T + (r0 + 32 * i) * 65 + c4 * 4; tp[0] = v[i].x; tp[1] = v[i].y; tp[2] = v[i].z; tp[3] = v[i].w; } }
        __syncthreads();
        const int itn = it + G; const bool hn = itn < NT_ALL; TItem nx = cur;
        if (hn) { decode_titem(itn, a, nx); titem_load(nx, tid, v); }
        { const int n = tid >> 3, kq = tid & 7;
#pragma unroll
          for (int j = 0; j < 4; ++j) { const int kc = j * 8 + kq; float f[8];
#pragma unroll
              for (int jj = 0; jj < 8; ++jj) f[jj] = T[(kc * 8 + jj) * 65 + n];
              u32x4 w; w.x = cvt_pk_bf16(f[0], f[1]); w.y = cvt_pk_bf16(f[2], f[3]); w.z = cvt_pk_bf16(f[4], f[5]); w.w = cvt_pk_bf16(f[6], f[7]);
              *(u32x4*)(cur.dst + (size_t)n * cur.ldd + kc * 8) = w; } }
        __syncthreads();
        cur = nx; it = itn; have = hn;
    }
}

__device__ __forceinline__ void phase_norm(const float* __restrict__ xin, const float* g, const float* shift, const float* scale, bf16_t* __restrict__ out, int vcu, int G) {
    const int tid = opaque_tid(), wid = __builtin_amdgcn_readfirstlane(tid >> 6), lane = tid & 63;
    for (int rb = vcu * 8 + wid; rb < NTOK / 8; rb += G * 8) {
        const int row0 = rb * 8, b = row0 / S;
        float4 A[4], C[4];
#pragma unroll
        for (int i = 0; i < 4; ++i) { const int k = 256 * i + 4 * lane; const float4 gv = *(const float4*)(g + k), sc = *(const float4*)(scale + (size_t)b * 6144 + k); C[i] = *(const float4*)(shift + (size_t)b * 6144 + k);
            A[i] = make_float4(gv.x * (1.f + sc.x), gv.y * (1.f + sc.y), gv.z * (1.f + sc.z), gv.w * (1.f + sc.w)); }
#pragma unroll 4
        for (int rr = 0; rr < 8; ++rr) {
            const size_t ro = (size_t)(row0 + rr) * D;
            float4 x[4]; float ss = 0.f;
#pragma unroll
            for (int i = 0; i < 4; ++i) { x[i] = *(const float4*)(xin + ro + 256 * i + 4 * lane); ss += x[i].x * x[i].x + x[i].y * x[i].y + x[i].z * x[i].z + x[i].w * x[i].w; }
            const float r = rsqrtf(wave_sum(ss) * (1.0f / D) + EPS);
#pragma unroll
            for (int i = 0; i < 4; ++i) { u32x2 w; w.x = cvt_pk_bf16(x[i].x * r * A[i].x + C[i].x, x[i].y * r * A[i].y + C[i].y); w.y = cvt_pk_bf16(x[i].z * r * A[i].z + C[i].z, x[i].w * r * A[i].w + C[i].w);
                *(u32x2*)(out + ro + 256 * i + 4 * lane) = w; }
        }
    }
}

__device__ __forceinline__ f32x4 mfma16r(const bf16x8 a, const bf16x8 b, const f32x4 c) { return __builtin_amdgcn_mfma_f32_16x16x32_bf16(a, b, c, 0, 0, 0); }
__device__ __forceinline__ void phase_rbias(const Args& a, LAS unsigned char* lds, int vcu) {
    KArgs* ka = kargs();
    const int tid = opaque_tid();
    if (vcu >= L * 4) return;
    const int l = vcu >> 2, b = vcu & 3, n = tid & 63, kp = tid >> 6;
    const float* sh = (const float*)(ka->ws + WS_MOD) + ((size_t)l * 4 + b) * 6144 + 3072;
    LAS float* red = (LAS float*)lds;
    float s = 0.f;
    if (n < 36) for (int k = kp * 128; k < kp * 128 + 128; ++k) s += sh[k] * ((n < 4) ? IN_F(I_WRG)[((size_t)l * D + k) * 4 + n] : IN_F(I_WRE)[((size_t)l * D + k) * 32 + (n - 4)]);
    red[kp * 64 + n] = s;
    __syncthreads();
    if (tid < 48) { float t = 0.f;
        if (tid < 36) { for (int w = 0; w < 8; ++w) t += red[w * 64 + tid]; t += (tid < 4) ? IN_F(I_BRG)[l * 4 + tid] : IN_F(I_BRE)[l * 32 + tid - 4]; }
        ((float*)(ka->ws + WS_RBIAS))[((size_t)l * 4 + b) * 48 + tid] = t; }
}

__device__ __forceinline__ void phase_route(const Args& a, int l, LAS unsigned char* lds, int vcu, int G) {
    KArgs* ka = kargs();
    const int tid = opaque_tid(), wid = __builtin_amdgcn_readfirstlane(tid >> 6), lane = tid & 63, fr = lane & 15, kq = lane >> 4;
    unsigned char* ws = ka->ws;
    const bf16_t* x1 = (const bf16_t*)(ws + WS_X1);
    const float* mod = (const float*)(ws + WS_MOD) + (size_t)l * 4 * 6144;
    const float* g = IN_F(I_NORM2) + l * D; const float* shift = mod + 3072; const float* scale = mod + 4096;
    bf16_t* out = (bf16_t*)(ws + WS_HA);
    int* counts = (int*)(ws + WS_CNT) + l * NE * 64; int* list = (int*)(ws + WS_LIST); float* lgate = (float*)(ws + WS_LGATE); int* tokinfo = (int*)(ws + WS_TOKINFO);
    LAS int* lcnt = (LAS int*)(lds + LDS_MISC + 1024); LAS int* lbase = lcnt + 32; LAS int* rte = lbase + 32; LAS int* rtp = rte + 128; LAS int* rtt = rtp + 128; LAS float* rtg = (LAS float*)(rtt + 128);
#ifdef MK_ROUTE_PROBE
    if (a.pad) { counts = (int*)(ws + WS_CNT) + 4096 + l * NE * 64; unsigned char* sc = ws + ((size_t)440 << 20); out = (bf16_t*)sc; list = (int*)(sc + ((size_t)34 << 20)); lgate = (float*)(sc + ((size_t)37 << 20)); tokinfo = (int*)(sc + ((size_t)40 << 20)); }
#endif
    LAS float* part = (LAS float*)lds;
    LAS float* ssp = part + 8 * 16 * 48;
    LAS float* lgt = ssp + 8 * 16;
    LAS float* rrow = lgt + 16 * 48;
    const bf16_t* wh = (const bf16_t*)(ws + WS_WHL) + (size_t)l * 2 * 48 * 1024 + (size_t)fr * 1024 + 128 * wid + 8 * kq;
    for (int r0 = vcu * 64; r0 < NTOK; r0 += G * 64) {
        const int b = r0 / S;
        const float* rb = (const float*)(ws + WS_RBIAS) + ((size_t)l * 4 + b) * 48;
        if (tid < 32) lcnt[tid] = 0;
#pragma unroll 1
        for (int q4 = 0; q4 < 4; ++q4) {
            float t[4][8];
            f32x4 acc[3];
#pragma unroll
            for (int nt = 0; nt < 3; ++nt) acc[nt] = (f32x4){0.f, 0.f, 0.f, 0.f};
            float ss = 0.f;
            const int row = r0 + 16 * q4 + fr;
#pragma unroll
            for (int ks = 0; ks < 4; ++ks) {
                const int k0 = 128 * wid + 32 * ks + 8 * kq;
                const f32x4 g0 = *(const f32x4*)(g + k0), g1 = *(const f32x4*)(g + k0 + 4), s0 = *(const f32x4*)(scale + (size_t)b * 6144 + k0), s1 = *(const f32x4*)(scale + (size_t)b * 6144 + k0 + 4);
                const float Ac[8] = {g0[0] * (1.f + s0[0]), g0[1] * (1.f + s0[1]), g0[2] * (1.f + s0[2]), g0[3] * (1.f + s0[3]), g1[0] * (1.f + s1[0]), g1[1] * (1.f + s1[1]), g1[2] * (1.f + s1[2]), g1[3] * (1.f + s1[3])};
                const u32x4 xw = *(const u32x4*)(x1 + (size_t)row * D + k0);
                const float v[8] = {bflo(xw.x), bfhi(xw.x), bflo(xw.y), bfhi(xw.y), bflo(xw.z), bfhi(xw.z), bflo(xw.w), bfhi(xw.w)};
                unsigned ph[4], pl[4];
#pragma unroll
                for (int j = 0; j < 8; ++j) { ss += v[j] * v[j]; t[ks][j] = v[j] * Ac[j]; }
#pragma unroll
                for (int j = 0; j < 4; ++j) { ph[j] = cvt_pk_bf16(t[ks][2 * j], t[ks][2 * j + 1]); pl[j] = cvt_pk_bf16(t[ks][2 * j] - bflo(ph[j]), t[ks][2 * j + 1] - bfhi(ph[j])); }
                const bf16x8 Ah = __builtin_bit_cast(bf16x8, (u32x4){ph[0], ph[1], ph[2], ph[3]}), Al = __builtin_bit_cast(bf16x8, (u32x4){pl[0], pl[1], pl[2], pl[3]});
#pragma unroll
                for (int nt = 0; nt < 3; ++nt) {
                    const bf16x8 Bh = *(const bf16x8*)(wh + (size_t)(16 * nt) * 1024 + 32 * ks), Bl = *(const bf16x8*)(wh + 48 * 1024 + (size_t)(16 * nt) * 1024 + 32 * ks);
                    acc[nt] = mfma16r(Ah, Bh, acc[nt]); acc[nt] = mfma16r(Al, Bh, acc[nt]); acc[nt] = mfma16r(Ah, Bl, acc[nt]);
                }
            }
            ss += __shfl_xor(ss, 16); ss += __shfl_xor(ss, 32);
            if (kq == 0) ssp[wid * 16 + fr] = ss;
#pragma unroll
            for (int nt = 0; nt < 3; ++nt)
#pragma unroll
                for (int r = 0; r < 4; ++r) part[(wid * 16 + 4 * kq + r) * 48 + 16 * nt + fr] = acc[nt][r];
            __syncthreads();
            for (int i = tid; i < 16 * 48; i += NTHR) { float s = 0.f;
#pragma unroll
                for (int w = 0; w < 8; ++w) s += part[w * 16 * 48 + i];
                lgt[i] = s; }
            if (tid < 16) { float s = 0.f;
#pragma unroll
                for (int w = 0; w < 8; ++w) s += ssp[w * 16 + tid];
                rrow[tid] = rsqrtf(s * (1.0f / D) + EPS); }
            __syncthreads();
            if (tid < 16) {
                const int tok = r0 + 16 * q4 + tid; const float r = rrow[tid];
                float ag[4];
#pragma unroll
                for (int j = 0; j < 4; ++j) ag[j] = r * lgt[tid * 48 + j] + rb[j];
                int gi = 0; float gm = ag[0];
#pragma unroll
                for (int j = 1; j < 4; ++j) if (ag[j] > gm) { gm = ag[j]; gi = j; }
                float den = 0.f;
#pragma unroll
                for (int j = 0; j < 4; ++j) den += expf(ag[j] - gm);
                const float p_sel = 1.0f / den;
                float el[8];
#pragma unroll
                for (int j = 0; j < 8; ++j) el[j] = r * lgt[tid * 48 + 4 + gi * 8 + j] + rb[4 + gi * 8 + j];
                int j0 = 0; float v0 = el[0];
#pragma unroll
                for (int j = 1; j < 8; ++j) if (el[j] > v0) { v0 = el[j]; j0 = j; }
                int j1 = 0; float v1 = -INFINITY;
#pragma unroll
                for (int j = 0; j < 8; ++j) if (j != j0 && el[j] > v1) { v1 = el[j]; j1 = j; }
                const float e1 = expf(v1 - v0);
                const float g0 = p_sel / (1.0f + e1), g1 = p_sel * e1 / (1.0f + e1);
                const int ex0 = gi * 8 + j0, ex1 = gi * 8 + j1, ai = (16 * q4 + tid) * 2;
                const int p0 = __hip_atomic_fetch_add(lcnt + ex0, 1, __ATOMIC_RELAXED, __HIP_MEMORY_SCOPE_WORKGROUP), p1 = __hip_atomic_fetch_add(lcnt + ex1, 1, __ATOMIC_RELAXED, __HIP_MEMORY_SCOPE_WORKGROUP);
                rte[ai] = ex0; rtp[ai] = p0; rtt[ai] = tok; rtg[ai] = g0;
                rte[ai + 1] = ex1; rtp[ai + 1] = p1; rtt[ai + 1] = tok; rtg[ai + 1] = g1;
            }
            {
                const float r = rrow[fr];
                bf16_t* op = out + (size_t)row * D + 128 * wid + 8 * kq;
#pragma unroll
                for (int ks = 0; ks < 4; ++ks) {
                    const float* cp = shift + (size_t)b * 6144 + 128 * wid + 32 * ks + 8 * kq;
                    const f32x4 c0 = *(const f32x4*)cp, c1 = *(const f32x4*)(cp + 4);
                    u32x4 w; w.x = cvt_pk_bf16(t[ks][0] * r + c0[0], t[ks][1] * r + c0[1]); w.y = cvt_pk_bf16(t[ks][2] * r + c0[2], t[ks][3] * r + c0[3]);
                    w.z = cvt_pk_bf16(t[ks][4] * r + c1[0], t[ks][5] * r + c1[1]); w.w = cvt_pk_bf16(t[ks][6] * r + c1[2], t[ks][7] * r + c1[3]);
                    *(u32x4*)(op + 32 * ks) = w;
                }
            }
            __syncthreads();
        }
        if (tid < 32) { const int c = lcnt[tid]; lbase[tid] = c ? atomicAdd(&counts[tid * 64], c) : 0; }
        __syncthreads();
        if (tid < 128) { const int e = rte[tid], pos = lbase[e] + rtp[tid], tk = rtt[tid];
            list[(size_t)e * NTOK + pos] = tk; lgate[(size_t)e * NTOK + pos] = rtg[tid];
            tokinfo[tk * 4 + (tid & 1) * 2] = e; tokinfo[tk * 4 + (tid & 1) * 2 + 1] = pos; }
        __syncthreads();
    }
}

__device__ __forceinline__ void moe_cum(const Args& a, int l, LAS unsigned char* lds) {
    KArgs* ka = kargs();
    LAS int* cum = (LAS int*)(lds + LDS_MISC + MISC_CUM); LAS int* cn = (LAS int*)(lds + LDS_MISC + MISC_CNT);
    const int* counts = (const int*)(ka->ws + WS_CNT) + l * NE * 64;
    const int tq = opaque_tid();
    if (tq < 33) { int s = 0; for (int j = 0; j < tq; ++j) s += (ld_agent(counts + j * 64) + 255) >> 8; cum[tq] = s; if (tq < 32) cn[tq] = ld_agent(counts + tq * 64); }
    __syncthreads();
}

__device__ __forceinline__ void phase_combine(const Args& a, int l, LAS unsigned char* lds, int vcu, int G) {
    KArgs* ka = kargs();
    const int tid = opaque_tid(), wid = __builtin_amdgcn_readfirstlane(tid >> 6), lane = tid & 63;
    unsigned char* ws = ka->ws;
    moe_cum(a, l, lds);
    const LAS int* cum = (const LAS int*)(lds + LDS_MISC + MISC_CUM);
    const bf16_t* __restrict__ x1 = (const bf16_t*)(ws + WS_X1);
    bf16_t* __restrict__ xnext = (bf16_t*)(ws + WS_X1) + (size_t)NTOK * D;
    const float* mod = (const float*)(ws + WS_MOD) + (size_t)l * 4 * 6144;
    const float* gate2 = mod + 5120;
    const bf16_t* __restrict__ Y = (const bf16_t*)(ws + WS_Y);
    const int* __restrict__ tokinfo = (const int*)(ws + WS_TOKINFO);
    float* __restrict__ outp = ka->out;
    const bool nextl = (l + 1 < L);
    const float* modn = (const float*)(ws + WS_MOD) + (size_t)(nextl ? l + 1 : l) * 4 * 6144;
    const float* gn = IN_F(I_NORM1) + (nextl ? l + 1 : l) * D;
    bf16_t* __restrict__ hout = (bf16_t*)(ws + WS_HA);
    for (int rb = vcu * 8 + wid; rb < NTOK / 8; rb += G * 8) {
        const int row0 = rb * 8, b = row0 / S;
        float4 A[4], C[4], G2[4];
#pragma unroll
        for (int i = 0; i < 4; ++i) { const int k = 256 * i + 4 * lane; const float4 gv = *(const float4*)(gn + k), sc = *(const float4*)(modn + 1024 + (size_t)b * 6144 + k); C[i] = *(const float4*)(modn + (size_t)b * 6144 + k);
            A[i] = make_float4(gv.x * (1.f + sc.x), gv.y * (1.f + sc.y), gv.z * (1.f + sc.z), gv.w * (1.f + sc.w)); G2[i] = *(const float4*)(gate2 + (size_t)b * 6144 + k); }
#pragma unroll 4
        for (int rr = 0; rr < 8; ++rr) {
            const int tok = row0 + rr; const size_t ro = (size_t)tok * D;
            const int4 ti = *(const int4*)(tokinfo + tok * 4);
            const size_t s0 = (size_t)(cum[ti.x] * 256 + ti.y) * D, s1 = (size_t)(cum[ti.z] * 256 + ti.w) * D;
            float4 xo[4]; float ss = 0.f;
#pragma unroll
            for (int i = 0; i < 4; ++i) { const int k = 256 * i + 4 * lane; const u32x2 xw = *(const u32x2*)(x1 + ro + k); const float4 xv = make_float4(bflo(xw.x), bfhi(xw.x), bflo(xw.y), bfhi(xw.y)); const u32x2 y0 = *(const u32x2*)(Y + s0 + k), y1 = *(const u32x2*)(Y + s1 + k);
                xo[i].x = xv.x + G2[i].x * (bflo(y0.x) + bflo(y1.x)); xo[i].y = xv.y + G2[i].y * (bfhi(y0.x) + bfhi(y1.x)); xo[i].z = xv.z + G2[i].z * (bflo(y0.y) + bflo(y1.y)); xo[i].w = xv.w + G2[i].w * (bfhi(y0.y) + bfhi(y1.y));
                if (nextl) { u32x2 xb; xb.x = cvt_pk_bf16(xo[i].x, xo[i].y); xb.y = cvt_pk_bf16(xo[i].z, xo[i].w); *(u32x2*)(xnext + ro + k) = xb; } else *(float4*)(outp + ro + k) = xo[i];
                ss += xo[i].x * xo[i].x + xo[i].y * xo[i].y + xo[i].z * xo[i].z + xo[i].w * xo[i].w; }
            if (nextl) {
                const float r = rsqrtf(wave_sum(ss) * (1.0f / D) + EPS);
#pragma unroll
                for (int i = 0; i < 4; ++i) { u32x2 w; w.x = cvt_pk_bf16(xo[i].x * r * A[i].x + C[i].x, xo[i].y * r * A[i].y + C[i].y); w.y = cvt_pk_bf16(xo[i].z * r * A[i].z + C[i].z, xo[i].w * r * A[i].w + C[i].w);
                    *(u32x2*)(hout + ro + 256 * i + 4 * lane) = w; }
            }
        }
    }
}
constexpr size_t WS_KN = WS_R2;
constexpr size_t WS_VT = WS_KN + al256c((size_t)NTOK * 256 * 2);
constexpr size_t WS_IKR = WS_VT + al256c((size_t)NTOK * 256 * 2);
constexpr size_t WS_MASK = WS_IKR + al256c((size_t)NTOK * 32 * 2);
constexpr size_t WS_OA = WS_MASK + al256c((size_t)NTOK * 128 * 4);
constexpr size_t WS_R3 = WS_OA + al256c((size_t)NTOK * 256 * 2);
constexpr size_t WS_MIXB = (WS_R3 > WS_Y + (size_t)SLOTS * D * 2 ? WS_R3 : WS_Y + al256c((size_t)SLOTS * D * 2));

__device__ __forceinline__ f32x4 mfma16(const bf16x8 a, const bf16x8 b, const f32x4 c) { return __builtin_amdgcn_mfma_f32_16x16x32_bf16(a, b, c, 0, 0, 0); }
__device__ __forceinline__ bf16_t f2bf(float f) { return (bf16_t)(cvt_pk_bf16(f, 0.f) & 0xffffu); }

__device__ __forceinline__ void rows_rms_store(const LAS float* YB, const float* gain, bf16_t* mixb, int tok0, int col0, int wid, int lane) {
    const f32x4 gv = *(const f32x4*)(gain + 4 * lane);
#pragma unroll 2
    for (int rr = 0; rr < 8; ++rr) {
        const int t = 8 * wid + rr;
        const f32x4 y = *(const LAS f32x4*)(YB + t * 260 + 4 * lane);
        const float ss = wave_sum(y[0] * y[0] + y[1] * y[1] + y[2] * y[2] + y[3] * y[3]);
        const float r = rsqrtf(ss * (1.0f / 256.0f) + EPS);
        u32x2 w; w.x = cvt_pk_bf16(y[0] * r * gv[0], y[1] * r * gv[1]); w.y = cvt_pk_bf16(y[2] * r * gv[2], y[3] * r * gv[3]);
        *(u32x2*)(mixb + (size_t)(tok0 + t) * D + col0 + 4 * lane) = w;
    }
}

__device__ __forceinline__ void item_pool(const Args& a, int l, int tile, LAS unsigned char* lds) {
    KArgs* ka = kargs();
    const int tid = opaque_tid(), wid = __builtin_amdgcn_readfirstlane(tid >> 6), lane = tid & 63;
    unsigned char* ws = ka->ws;
    const bf16_t* proj = (const bf16_t*)(ws + WS_PROJ);
    LAS bf16_t* P = (LAS bf16_t*)lds;
    LAS bf16_t* PA = (LAS bf16_t*)(lds + 40960);
    LAS float* YB = (LAS float*)(lds + 40960 + 33792);
    const int tok0 = tile * 64, b = tok0 / S, t0 = tok0 % S;
#pragma unroll
    for (int p = tid; p < 79 * 32; p += NTHR) {
        const int r = p >> 5, c8 = p & 31, t = t0 - 15 + r;
        u32x4 v = (u32x4){0u, 0u, 0u, 0u};
        if (t >= 0) v = *(const u32x4*)(proj + (size_t)(b * S + t) * NP + NC + c8 * 8);
        *(LAS u32x4*)(P + r * 256 + c8 * 8) = v;
    }
    __syncthreads();
    {
        const int c = tid & 255, half = tid >> 8, g = c >> 6, w = 2 << g, tt0 = half * 32;
        float run = 0.f;
        for (int jj = 1; jj < w; ++jj) run += bf2f(P[(15 + tt0 - jj) * 256 + c]);
        for (int i = 0; i < 32; ++i) {
            const int tt = tt0 + i, r = 15 + tt;
            const float pv = bf2f(P[r * 256 + c]);
            run += pv;
            const int tabs = t0 + tt, nn = (tabs + 1 < w) ? (tabs + 1) : w;
            PA[tt * 264 + c] = f2bf(run / (float)nn - pv);
            run -= bf2f(P[(r - w + 1) * 256 + c]);
        }
    }
    __syncthreads();
    {
        const int g = wid >> 1, mh = wid & 1, fr = lane & 15, fq = lane >> 4;
        const bf16_t* PT = (const bf16_t*)(ws + WS_POOLT) + (size_t)(l * 4 + g) * 64 * 64;
        f32x4 acc[2][4];
#pragma unroll
        for (int mi = 0; mi < 2; ++mi)
#pragma unroll
            for (int ni = 0; ni < 4; ++ni) acc[mi][ni] = (f32x4){0.f, 0.f, 0.f, 0.f};
#pragma unroll
        for (int ks = 0; ks < 2; ++ks) {
            bf16x8 A[2];
#pragma unroll
            for (int mi = 0; mi < 2; ++mi) A[mi] = *(const LAS bf16x8*)(PA + (16 * (2 * mh + mi) + fr) * 264 + g * 64 + 32 * ks + 8 * fq);
#pragma unroll
            for (int ni = 0; ni < 4; ++ni) { const bf16x8 Bf = *(const bf16x8*)(PT + (16 * ni + fr) * 64 + 32 * ks + 8 * fq);
#pragma unroll
                for (int mi = 0; mi < 2; ++mi) acc[mi][ni] = mfma16(A[mi], Bf, acc[mi][ni]); }
        }
        const float* pb = IN_F(I_POOLB) + l * 256; const float* ps = IN_F(I_POOLS) + l * 256;
#pragma unroll
        for (int ni = 0; ni < 4; ++ni) { const int d = g * 64 + 16 * ni + fr; const float bb = pb[d], sc = ps[d];
#pragma unroll
            for (int mi = 0; mi < 2; ++mi)
#pragma unroll
                for (int r = 0; r < 4; ++r) YB[(16 * (2 * mh + mi) + 4 * fq + r) * 260 + d] = (acc[mi][ni][r] + bb) * sc; }
    }
    __syncthreads();
    rows_rms_store(YB, IN_F(I_ONORM) + l * D + 512, (bf16_t*)(ws + WS_MIXB), tok0, 512, wid, lane);
    __syncthreads();
}

__device__ __forceinline__ void item_conv(const Args& a, int l, int tile, LAS unsigned char* lds) {
    KArgs* ka = kargs();
    const int tid = opaque_tid(), wid = __builtin_amdgcn_readfirstlane(tid >> 6), lane = tid & 63;
    unsigned char* ws = ka->ws;
    const bf16_t* proj = (const bf16_t*)(ws + WS_PROJ);
    LAS float* GL = (LAS float*)lds;
    LAS bf16_t* CA = (LAS bf16_t*)(lds + 96256);
    LAS float* YB = (LAS float*)lds;
    const int tok0 = tile * 64, b = tok0 / S, t0 = tok0 % S;
#pragma unroll
    for (int p = tid; p < 94 * 32; p += NTHR) {
        const int r = p >> 5, c8 = p & 31, t = t0 - 30 + r;
        f32x4 o0 = (f32x4){0.f, 0.f, 0.f, 0.f}, o1 = o0;
        if (t >= 0) {
            const bf16_t* pr = proj + (size_t)(b * S + t) * NP;
            const u32x4 av = *(const u32x4*)(pr + NBA + c8 * 8), gv = *(const u32x4*)(pr + NBG + c8 * 8);
            o0[0] = bflo(av.x) * sigmoid_fast(bflo(gv.x)); o0[1] = bfhi(av.x) * sigmoid_fast(bfhi(gv.x)); o0[2] = bflo(av.y) * sigmoid_fast(bflo(gv.y)); o0[3] = bfhi(av.y) * sigmoid_fast(bfhi(gv.y));
            o1[0] = bflo(av.z) * sigmoid_fast(bflo(gv.z)); o1[1] = bfhi(av.z) * sigmoid_fast(bfhi(gv.z)); o1[2] = bflo(av.w) * sigmoid_fast(bflo(gv.w)); o1[3] = bfhi(av.w) * sigmoid_fast(bfhi(gv.w));
        }
        *(LAS f32x4*)(GL + r * 256 + c8 * 8) = o0; *(LAS f32x4*)(GL + r * 256 + c8 * 8 + 4) = o1;
    }
    __syncthreads();
    {
        const int c = tid & 255, half = tid >> 8;
        float wv[31];
#pragma unroll
        for (int jj = 0; jj < 31; ++jj) wv[jj] = IN_F(I_CONVW)[((size_t)l * 31 + jj) * 256 + c];
        const float cb = IN_F(I_CONVB)[l * 256 + c];
        float yv[32];
#pragma unroll
        for (int ch = 0; ch < 8; ++ch) {
            const int tt = half * 32 + ch * 4;
            float x[34];
#pragma unroll
            for (int m2 = 0; m2 < 34; ++m2) x[m2] = GL[(tt + m2) * 256 + c];
#pragma unroll
            for (int i = 0; i < 4; ++i) {
                float y = cb;
#pragma unroll
                for (int jj = 0; jj < 31; ++jj) y += x[i + jj] * wv[jj];
                yv[ch * 4 + i] = y;
            }
        }
        __syncthreads();
#pragma unroll
        for (int i = 0; i < 32; ++i) YB[(half * 32 + i) * 260 + c] = yv[i];
    }
    __syncthreads();
    {
        const int t = tid >> 3, part = tid & 7;
        float y[32]; float s1 = 0.f;
#pragma unroll
        for (int i = 0; i < 8; ++i) { const f32x4 v = *(const LAS f32x4*)(YB + t * 260 + part * 32 + 4 * i); y[4 * i] = v[0]; y[4 * i + 1] = v[1]; y[4 * i + 2] = v[2]; y[4 * i + 3] = v[3]; s1 += (v[0] + v[1]) + (v[2] + v[3]); }
        s1 += dpp_f<0xB1>(s1);
        const float mu = s1 * (1.0f / 64.0f);
        float s2 = 0.f;
#pragma unroll
        for (int i = 0; i < 32; ++i) { y[i] -= mu; s2 += y[i] * y[i]; }
        s2 += dpp_f<0xB1>(s2);
        const float rs = rsqrtf(s2 * (1.0f / 64.0f) + EPS);
        const float* lng = IN_F(I_CLNG) + l * 256 + part * 32; const float* lnb = IN_F(I_CLNB) + l * 256 + part * 32;
#pragma unroll
        for (int i = 0; i < 4; ++i) {
            float o[8];
#pragma unroll
            for (int e = 0; e < 8; ++e) o[e] = silu_f(y[8 * i + e] * rs * lng[8 * i + e] + lnb[8 * i + e]);
            u32x4 w; w.x = cvt_pk_bf16(o[0], o[1]); w.y = cvt_pk_bf16(o[2], o[3]); w.z = cvt_pk_bf16(o[4], o[5]); w.w = cvt_pk_bf16(o[6], o[7]);
            *(LAS u32x4*)(CA + t * 264 + part * 32 + 8 * i) = w;
        }
    }
    __syncthreads();
    {
        const int fr = lane & 15, fq = lane >> 4;
        const bf16_t* PW = (const bf16_t*)(ws + WS_PWT) + (size_t)l * 65536;
        f32x4 acc[4][2];
#pragma unroll
        for (int mi = 0; mi < 4; ++mi)
#pragma unroll
            for (int ni = 0; ni < 2; ++ni) acc[mi][ni] = (f32x4){0.f, 0.f, 0.f, 0.f};
#pragma unroll 2
        for (int ks = 0; ks < 8; ++ks) {
            bf16x8 Bf[2];
#pragma unroll
            for (int ni = 0; ni < 2; ++ni) Bf[ni] = *(const bf16x8*)(PW + (size_t)(32 * wid + 16 * ni + fr) * 256 + 32 * ks + 8 * fq);
#pragma unroll
            for (int mi = 0; mi < 4; ++mi) { const bf16x8 Af = *(const LAS bf16x8*)(CA + (16 * mi + fr) * 264 + 32 * ks + 8 * fq);
#pragma unroll
                for (int ni = 0; ni < 2; ++ni) acc[mi][ni] = mfma16(Af, Bf[ni], acc[mi][ni]); }
        }
        const float* pwb = IN_F(I_PWB) + l * 256;
#pragma unroll
        for (int ni = 0; ni < 2; ++ni) { const int n = 32 * wid + 16 * ni + fr; const float bb = pwb[n];
#pragma unroll
            for (int mi = 0; mi < 4; ++mi)
#pragma unroll
                for (int r = 0; r < 4; ++r) YB[(16 * mi + 4 * fq + r) * 260 + n] = acc[mi][ni][r] + bb; }
    }
    __syncthreads();
    rows_rms_store(YB, IN_F(I_ONORM) + l * D + 256, (bf16_t*)(ws + WS_MIXB), tok0, 256, wid, lane);
    __syncthreads();
}

__device__ __forceinline__ void item_sgu(const Args& a, int l, int ch, LAS unsigned char* lds) {
    KArgs* ka = kargs();
    const int tid = opaque_tid(), wid = __builtin_amdgcn_readfirstlane(tid >> 6), lane = tid & 63;
    unsigned char* ws = ka->ws;
    const bf16_t* proj = (const bf16_t*)(ws + WS_PROJ);
    LAS bf16_t* VT = (LAS bf16_t*)lds;
    LAS bf16_t* OB = (LAS bf16_t*)(lds + 69632);
    const int tok0 = ch * 128;
    {
        const f32x4 lg = *(const f32x4*)(IN_F(I_SLNG) + l * 256 + 4 * lane), lb = *(const f32x4*)(IN_F(I_SLNB) + l * 256 + 4 * lane);
#pragma unroll 8
        for (int i = 0; i < 16; ++i) {
            const int s = 16 * wid + i;
            const u32x2 vv = *(const u32x2*)(proj + (size_t)(tok0 + s) * NP + NDV + 4 * lane);
            const float v0 = bflo(vv.x), v1 = bfhi(vv.x), v2 = bflo(vv.y), v3 = bfhi(vv.y);
            const float mu = wave_sum((v0 + v1) + (v2 + v3)) * (1.0f / 256.0f);
            const float d0 = v0 - mu, d1 = v1 - mu, d2 = v2 - mu, d3 = v3 - mu;
            const float rs = rsqrtf(wave_sum((d0 * d0 + d1 * d1) + (d2 * d2 + d3 * d3)) * (1.0f / 256.0f) + EPS);
            VT[(4 * lane + 0) * 136 + s] = f2bf(d0 * rs * lg[0] + lb[0]); VT[(4 * lane + 1) * 136 + s] = f2bf(d1 * rs * lg[1] + lb[1]);
            VT[(4 * lane + 2) * 136 + s] = f2bf(d2 * rs * lg[2] + lb[2]); VT[(4 * lane + 3) * 136 + s] = f2bf(d3 * rs * lg[3] + lb[3]);
        }
    }
    __syncthreads();
    {
        const int h = wid >> 1, np = wid & 1, fr = lane & 15, fq = lane >> 4;
        const bf16_t* W = (const bf16_t*)(ws + WS_SGUW) + (size_t)(l * 4 + h) * 128 * 128;
        const float* sb = IN_F(I_SGUB) + (l * 4 + h) * 128;
#pragma unroll 1
        for (int mi = 0; mi < 8; ++mi) {
            f32x4 acc[2] = {(f32x4){0.f, 0.f, 0.f, 0.f}, (f32x4){0.f, 0.f, 0.f, 0.f}};
            for (int ks = 0; ks <= (mi >> 1); ++ks) {
                const bf16x8 Af = *(const bf16x8*)(W + (size_t)(16 * mi + fr) * 128 + 32 * ks + 8 * fq);
#pragma unroll
                for (int ni = 0; ni < 2; ++ni) { const bf16x8 Bf = *(const LAS bf16x8*)(VT + (h * 64 + 32 * np + 16 * ni + fr) * 136 + 32 * ks + 8 * fq); acc[ni] = mfma16(Af, Bf, acc[ni]); }
            }
#pragma unroll
            for (int ni = 0; ni < 2; ++ni)
#pragma unroll
                for (int r = 0; r < 4; ++r) { const int t = 16 * mi + 4 * fq + r; OB[t * 264 + h * 64 + 32 * np + 16 * ni + fr] = f2bf(acc[ni][r] + sb[t]); }
        }
    }
    __syncthreads();
    {
        const f32x4 gv = *(const f32x4*)(IN_F(I_ONORM) + l * D + 768 + 4 * lane);
        bf16_t* mixb = (bf16_t*)(ws + WS_MIXB);
#pragma unroll 8
        for (int i = 0; i < 16; ++i) {
            const int t = 16 * wid + i;
            const u32x2 mv = *(const LAS u32x2*)(OB + t * 264 + 4 * lane);
            const u32x2 uv = *(const u32x2*)(proj + (size_t)(tok0 + t) * NP + NDU + 4 * lane);
            const float o0 = bflo(uv.x) * bflo(mv.x), o1 = bfhi(uv.x) * bfhi(mv.x), o2 = bflo(uv.y) * bflo(mv.y), o3 = bfhi(uv.y) * bfhi(mv.y);
            const float r = rsqrtf(wave_sum((o0 * o0 + o1 * o1) + (o2 * o2 + o3 * o3)) * (1.0f / 256.0f) + EPS);
            u32x2 w; w.x = cvt_pk_bf16(o0 * r * gv[0], o1 * r * gv[1]); w.y = cvt_pk_bf16(o2 * r * gv[2], o3 * r * gv[3]);
            *(u32x2*)(mixb + (size_t)(tok0 + t) * D + 768 + 4 * lane) = w;
        }
    }
    __syncthreads();
}

__device__ __forceinline__ void item_prepk(const Args& a, int l, int tile, LAS unsigned char* lds) {
    KArgs* ka = kargs();
    const int tid = opaque_tid(), wid = __builtin_amdgcn_readfirstlane(tid >> 6), lane = tid & 63;
    unsigned char* ws = ka->ws;
    const bf16_t* proj = (const bf16_t*)(ws + WS_PROJ);
    LAS bf16_t* VS = (LAS bf16_t*)lds;
    bf16_t* KN = (bf16_t*)(ws + WS_KN); bf16_t* VTg = (bf16_t*)(ws + WS_VT); bf16_t* IKR = (bf16_t*)(ws + WS_IKR);
    const float* ropeA = (const float*)(ws + WS_ROPEA); const float* ropeI = (const float*)(ws + WS_ROPEI);
    const int tok0 = tile * 64, b = tok0 / S, s0 = tok0 % S;
    const int li = lane & 15, head = lane >> 4;
    const f32x4 kg = *(const f32x4*)(IN_F(I_KN) + l * 64 + 4 * li);
#pragma unroll 4
    for (int i = 0; i < 8; ++i) {
        const int tl = 8 * wid + i, tok = tok0 + tl, s = s0 + tl;
        const bf16_t* pr = proj + (size_t)tok * NP;
        const u32x2 kv = *(const u32x2*)(pr + NK + 4 * lane);
        float k0 = bflo(kv.x), k1 = bfhi(kv.x), k2 = bflo(kv.y), k3 = bfhi(kv.y);
        float ss = (k0 * k0 + k1 * k1) + (k2 * k2 + k3 * k3);
        ss = row_sum16(ss);
        const float r = rsqrtf(ss * (1.0f / 64.0f) + EPS);
        k0 *= r * kg[0]; k1 *= r * kg[1]; k2 *= r * kg[2]; k3 *= r * kg[3];
        {
            const float p0 = __shfl_xor(k0, 2), p1 = __shfl_xor(k1, 2), p2 = __shfl_xor(k2, 2), p3 = __shfl_xor(k3, 2);
            if (li < 4) {
                const int dd = 4 * (li & 1);
                const f32x4 cs = *(const f32x4*)(ropeA + (size_t)tok * 16 + dd), sn = *(const f32x4*)(ropeA + (size_t)tok * 16 + 8 + dd);
                if (li < 2) { k0 = k0 * cs[0] - p0 * sn[0]; k1 = k1 * cs[1] - p1 * sn[1]; k2 = k2 * cs[2] - p2 * sn[2]; k3 = k3 * cs[3] - p3 * sn[3]; }
                else        { k0 = k0 * cs[0] + p0 * sn[0]; k1 = k1 * cs[1] + p1 * sn[1]; k2 = k2 * cs[2] + p2 * sn[2]; k3 = k3 * cs[3] + p3 * sn[3]; }
            }
        }
        u32x2 ko; ko.x = cvt_pk_bf16(k0, k1); ko.y = cvt_pk_bf16(k2, k3);
        *(u32x2*)(KN + ((size_t)((b * 4 + head) * 128 + (s >> 5)) * 32 + (s & 31)) * 64 + 4 * li) = ko;
        *(LAS u32x2*)(VS + tl * 256 + 4 * lane) = *(const u32x2*)(pr + NV + 4 * lane);
        if (lane < 8) {
            const u32x2 iv = *(const u32x2*)(pr + NIK + 4 * lane);
            float x0 = bflo(iv.x), x1 = bfhi(iv.x), x2 = bflo(iv.y), x3 = bfhi(iv.y);
            const float q0 = __shfl_xor(x0, 1), q1 = __shfl_xor(x1, 1), q2 = __shfl_xor(x2, 1), q3 = __shfl_xor(x3, 1);
            if (lane < 2) {
                const f32x4 cs = *(const f32x4*)(ropeI + (size_t)tok * 8), sn = *(const f32x4*)(ropeI + (size_t)tok * 8 + 4);
                if (lane == 0) { x0 = x0 * cs[0] - q0 * sn[0]; x1 = x1 * cs[1] - q1 * sn[1]; x2 = x2 * cs[2] - q2 * sn[2]; x3 = x3 * cs[3] - q3 * sn[3]; }
                else           { x0 = x0 * cs[0] + q0 * sn[0]; x1 = x1 * cs[1] + q1 * sn[1]; x2 = x2 * cs[2] + q2 * sn[2]; x3 = x3 * cs[3] + q3 * sn[3]; }
            }
            u32x2 io; io.x = cvt_pk_bf16(x0, x1); io.y = cvt_pk_bf16(x2, x3);
            *(u32x2*)(IKR + (size_t)tok * 32 + 4 * lane) = io;
        }
    }
    __syncthreads();
#pragma unroll
    for (int i = 0; i < 4; ++i) {
        const int p = tid + NTHR * i;
        const int h = p >> 9, ktl = (p >> 8) & 1, d = (p >> 2) & 63, part = p & 3;
        unsigned short e[8];
#pragma unroll
        for (int jj = 0; jj < 8; ++jj) { const int key = 4 * part + (jj & 3) + 16 * (jj >> 2); e[jj] = VS[(ktl * 32 + key) * 256 + h * 64 + d]; }
        u32x4 w; w.x = e[0] | ((unsigned)e[1] << 16); w.y = e[2] | ((unsigned)e[3] << 16); w.z = e[4] | ((unsigned)e[5] << 16); w.w = e[6] | ((unsigned)e[7] << 16);
        *(u32x4*)(VTg + ((size_t)((b * 4 + h) * 128 + (s0 >> 5) + ktl) * 64 + d) * 32 + 8 * part) = w;
    }
    __syncthreads();
}

__device__ __forceinline__ void phase_mix1(const Args& a, int l, LAS unsigned char* lds, int vcu, int G, int bx) {
    if (G == 256) {
        if (bx < 64) { item_conv(a, l, bx, lds); item_pool(a, l, bx, lds); }
        else {
            const int w = bx - 64;
            if (w < 128) item_sgu(a, l, w, lds);
            item_prepk(a, l, w, lds);
            item_conv(a, l, 64 + w, lds);
            if (w >= 128) item_prepk(a, l, 192 + (w - 128), lds);
            item_pool(a, l, 64 + w, lds);
        }
        return;
    }
    for (int it = vcu; it < 896; it += G) {
        if (it < 128) item_sgu(a, l, it, lds);
        else if (it < 384) item_conv(a, l, it - 128, lds);
        else if (it < 640) item_pool(a, l, it - 384, lds);
        else item_prepk(a, l, it - 640, lds);
    }
}
__device__ __forceinline__ f32x16 mfma32(const bf16x8 a, const bf16x8 b, const f32x16 c) { return __builtin_amdgcn_mfma_f32_32x32x16_bf16(a, b, c, 0, 0, 0); }
__device__ __forceinline__ unsigned mono_key(float f) { const unsigned u = __float_as_uint(f); return u ^ ((unsigned)((int)u >> 31) | 0x80000000u); }

__device__ __forceinline__ void a1_keys(const bf16x8 A0, const bf16x8 A1, const bf16x8 (&Bq)[4][2], const float (&cl)[4], unsigned (&key)[16]) {
    float sc[16];
#pragma unroll
    for (int r = 0; r < 16; ++r) sc[r] = 0.0f;
#pragma unroll
    for (int h = 0; h < 4; ++h) {
        f32x16 d;
#pragma unroll
        for (int r = 0; r < 16; ++r) d[r] = 0.f;
        d = mfma32(A0, Bq[h][0], d); d = mfma32(A1, Bq[h][1], d);
#pragma unroll
        for (int r = 0; r < 16; ++r) sc[r] += __builtin_amdgcn_fmed3f(d[r], 0.0f, cl[h]);
    }
#pragma unroll
    for (int r = 0; r < 16; ++r) key[r] = mono_key(sc[r]);
}

__device__ __forceinline__ unsigned wcode(unsigned key) {
    const int v = (int)(key >> 20);
    const int t = (key < 0x80000000u) ? (v < 1096 ? v : 1096) + 1901 : (v > 2999 ? v : 2999);
    const int c = t - 2864;
    return (unsigned)(c < 12 ? 12 : (c > 255 ? 255 : c));
}

#define A1_STREAM_BEGIN { \
    bf16x8 rA[4][2]; const int ntw_ = (nkt - wid + 7) >> 3; \
    _Pragma("unroll") for (int u_ = 0; u_ < 4; ++u_) { rA[u_][0] = Bq[0][0]; rA[u_][1] = Bq[0][0]; if (u_ < ntw_) { const size_t o_ = (size_t)(wid + 8 * u_) * 1024; rA[u_][0] = *(const bf16x8*)(ikl + o_); rA[u_][1] = *(const bf16x8*)(ikl + o_ + 16); } } \
    for (int i_ = 0; i_ < ntw_; i_ += 4) { \
        _Pragma("unroll") for (int u_ = 0; u_ < 4; ++u_) { if (i_ + u_ < ntw_) { \
            const bf16x8 cA0 = rA[u_][0], cA1 = rA[u_][1]; const int kt = wid + 8 * (i_ + u_); \
            if (i_ + u_ + 4 < ntw_) { const size_t o_ = (size_t)(kt + 32) * 1024; rA[u_][0] = *(const bf16x8*)(ikl + o_); rA[u_][1] = *(const bf16x8*)(ikl + o_ + 16); }
#define A1_STREAM_END } } } }

template <int KIND>
__device__ __forceinline__ void a1_pass(const bf16_t* ikl, int nkt, int wid, int q, int hh, const bf16x8 (&Bq)[4][2], const float (&cl)[4], LAS unsigned* hist, int sh, unsigned prefix, bool tieq, unsigned g16) {
    const unsigned dump = 256u * 32u + (unsigned)q;
    A1_STREAM_BEGIN
        unsigned key[16];
        a1_keys(cA0, cA1, Bq, cl, key);
#pragma unroll
        for (int r = 0; r < 16; ++r) {
            const int s = kt * 32 + (r & 3) + 8 * (r >> 2) + 4 * hh;
            unsigned digit; bool match;
            if (KIND == 0) { digit = key[r] >> 24; match = true; }
            else if (KIND == 1) { digit = (key[r] >> sh) & 255u; match = (key[r] >> (sh + 8)) == prefix; }
            else if (KIND == 2) { digit = 255u - (unsigned)(s >> 4); match = ((unsigned)tieq & (unsigned)(key[r] == prefix)) != 0u; }
            else if (KIND == 3) { digit = 15u - (unsigned)(s & 15); match = ((unsigned)tieq & (unsigned)(key[r] == prefix) & (unsigned)((unsigned)(s >> 4) == g16)) != 0u; }
            else { digit = wcode(key[r]); match = true; }
            const unsigned idx = match ? digit * 32u + (unsigned)q : dump;
            __hip_atomic_fetch_add(hist + idx, 1u, __ATOMIC_RELAXED, __HIP_MEMORY_SCOPE_WORKGROUP);
        }
    A1_STREAM_END
}

template <int MODE_CLASS>
__device__ __forceinline__ void a1_scan(LAS unsigned* hist, LAS unsigned* psum, LAS unsigned* qst, int tid, bool last) {
    const int sq = tid & 31, part = tid >> 5;
    const unsigned need = qst[32 + sq], pfx = qst[sq];
    unsigned local = 0u;
#pragma unroll
    for (int bb = 0; bb < 16; ++bb) local += hist[(16 * part + bb) * 32 + sq];
    psum[part * 32 + sq] = local;
    __syncthreads();
    unsigned above = 0u;
    for (int pp = part + 1; pp < 16; ++pp) above += psum[pp * 32 + sq];
    if (above < need && above + local >= need) {
        unsigned run = above;
        for (int bb = 15; bb >= 0; --bb) {
            const unsigned c = hist[(16 * part + bb) * 32 + sq];
            if (run + c >= need) {
                const unsigned bin = (unsigned)(16 * part + bb);
                if (MODE_CLASS == 0) { qst[sq] = (pfx << 8) | bin; qst[32 + sq] = need - run; qst[64 + sq] = c; if (last && need - run < c) qst[160] = 1u; }
                else if (MODE_CLASS == 1) { qst[128 + sq] = 255u - bin; qst[32 + sq] = need - run; qst[64 + sq] = 0xffffffffu; }
                else { qst[96 + sq] = qst[128 + sq] * 16u + (15u - bin); }
                break;
            }
            run += c;
        }
    }
}

constexpr int A1_HIST = 0, A1_PSUM = 257 * 32, A1_QST = A1_PSUM + 16 * 32, A1_MBUF = A1_QST + 6 * 32 + 32, A1_TBUF = A1_MBUF + 32 * 128;
constexpr int A1_CAPL = 16, A1_LKEY = A1_MBUF + 32 * 128, A1_LIDX = A1_LKEY + 512 * A1_CAPL, A1_PCNT = A1_LIDX + 512 * A1_CAPL, A1_CAP = 200;
__device__ __forceinline__ void a1_tile(const Args& a, int l, int b, int j, LAS unsigned char* lds) {
    KArgs* ka = kargs();
    const int tid = opaque_tid(), wid = __builtin_amdgcn_readfirstlane(tid >> 6), lane = tid & 63, q = lane & 31, hh = lane >> 5;
    unsigned char* ws = ka->ws;
    const bf16_t* proj = (const bf16_t*)(ws + WS_PROJ);
    const bf16_t* ikr = (const bf16_t*)(ws + WS_IKR) + (size_t)b * S * 32;
    const bf16_t* ikl = ikr + (lane & 31) * 32 + 8 * (lane >> 5);
    unsigned* maskg = (unsigned*)(ws + WS_MASK);
    LAS unsigned* L = (LAS unsigned*)lds;
    LAS unsigned* hist = L + A1_HIST; LAS unsigned* psum = L + A1_PSUM; LAS unsigned* qst = L + A1_QST; LAS unsigned* mbuf = L + A1_MBUF; LAS unsigned* tbuf = L + A1_TBUF;
    LAS unsigned* lkey = L + A1_LKEY; LAS unsigned* lidx = L + A1_LIDX; LAS unsigned* pcnt = L + A1_PCNT;
    const int t0 = j * 32, n = (t0 / 64 + 1) * 64, nkt = n / 32, nw = ((t0 / 128) + 1) * 4;
    if (n <= 256) {
        for (int i = tid; i < 32 * nw; i += NTHR) { const int qq = i / nw, w = i % nw; maskg[(size_t)(b * S + t0 + qq) * 128 + w] = (w < nkt) ? 0xffffffffu : 0u; }
        return;
    }
    bf16x8 Bq[4][2]; float cl[4];
    {
        const int tok = b * S + t0 + q;
        const bf16_t* pr = proj + (size_t)tok * NP;
        const f32x4 cs = *(const f32x4*)((const float*)(ws + WS_ROPEI) + (size_t)tok * 8), sn = *(const f32x4*)((const float*)(ws + WS_ROPEI) + (size_t)tok * 8 + 4);
#pragma unroll
        for (int h = 0; h < 4; ++h) {
            const float wsc = bf2f(pr[NIW + h]) * (0.5f * 0.17677669529663687f);
            cl[h] = (wsc > 0.f) ? INFINITY : -INFINITY;
#pragma unroll
            for (int ks = 0; ks < 2; ++ks) {
                const u32x4 raw = *(const u32x4*)(pr + NIQ + h * 32 + 16 * ks + 8 * hh);
                float v[8] = {bflo(raw.x), bfhi(raw.x), bflo(raw.y), bfhi(raw.y), bflo(raw.z), bfhi(raw.z), bflo(raw.w), bfhi(raw.w)};
                if (ks == 0 && hh == 0) {
#pragma unroll
                    for (int i = 0; i < 4; ++i) { const float x1 = v[i], x2 = v[i + 4]; v[i] = x1 * cs[i] - x2 * sn[i]; v[i + 4] = x2 * cs[i] + x1 * sn[i]; }
                }
                u32x4 pk; pk.x = cvt_pk_bf16(v[0] * wsc, v[1] * wsc); pk.y = cvt_pk_bf16(v[2] * wsc, v[3] * wsc); pk.z = cvt_pk_bf16(v[4] * wsc, v[5] * wsc); pk.w = cvt_pk_bf16(v[6] * wsc, v[7] * wsc);
                Bq[h][ks] = __builtin_bit_cast(bf16x8, pk);
            }
        }
    }
    {
        if (tid < 32) { qst[tid] = 0u; qst[32 + tid] = 256u; qst[64 + tid] = 0u; qst[96 + tid] = 4095u; qst[128 + tid] = 0u; }
        if (tid == 32) qst[160] = 0u;
        __syncthreads();
        for (int mode = 0; mode < 4; ++mode) {
            for (int i = tid; i < 257 * 32; i += NTHR) hist[i] = 0u;
            __syncthreads();
            const unsigned prefix = qst[q];
            const int sh = 24 - 8 * mode;
            if (mode == 0) a1_pass<0>(ikl, nkt, wid, q, hh, Bq, cl, hist, 0, 0u, false, 0u);
            else a1_pass<1>(ikl, nkt, wid, q, hh, Bq, cl, hist, sh, prefix, false, 0u);
            __syncthreads();
            a1_scan<0>(hist, psum, qst, tid, mode == 3);
            __syncthreads();
        }
        __syncthreads();
        {
            const unsigned T = qst[q];
            A1_STREAM_BEGIN
                unsigned key[16];
                a1_keys(cA0, cA1, Bq, cl, key);
                unsigned wb = 0u, tb = 0u;
#pragma unroll
                for (int r = 0; r < 16; ++r) {
                    const int row = (r & 3) + 8 * (r >> 2) + 4 * hh;
                    wb |= (key[r] > T) ? (1u << row) : 0u;
                    tb |= (key[r] == T) ? (1u << row) : 0u;
                }
                wb |= (unsigned)__shfl_xor((int)wb, 32); tb |= (unsigned)__shfl_xor((int)tb, 32);
                if (hh == 0) { mbuf[q * 128 + kt] = wb; tbuf[q * 128 + kt] = tb; }
            A1_STREAM_END
        }
        __syncthreads();
        for (int i = tid; i < 32 * nkt; i += NTHR) { const int qq = i / nkt, w = i % nkt; if (qst[32 + qq] >= qst[64 + qq]) mbuf[qq * 128 + w] |= tbuf[qq * 128 + w]; }
        if (tid < 32 && qst[32 + tid] < qst[64 + tid]) {
            unsigned rem = qst[32 + tid];
            for (int w = 0; w < nkt && rem; ++w) {
                unsigned t = tbuf[tid * 128 + w]; const unsigned c = (unsigned)__builtin_popcount(t);
                if (c <= rem) { mbuf[tid * 128 + w] |= t; rem -= c; }
                else { unsigned keep = 0u; for (; rem; --rem) { const unsigned low = t & (0u - t); keep |= low; t ^= low; } mbuf[tid * 128 + w] |= keep; }
            }
        }
    }
    __syncthreads();
    for (int i = tid; i < 32 * nw; i += NTHR) { const int qq = i / nw, w = i % nw; maskg[(size_t)(b * S + t0 + qq) * 128 + w] = (w < nkt) ? mbuf[qq * 128 + w] : 0u; }
    __syncthreads();
}
__device__ __forceinline__ void phase_a1(const Args& a, int l, LAS unsigned char* lds, int vcu, int G) {
    KArgs* ka = kargs();
    for (int it = vcu; it < 256; it += G) { const int b = it >> 6, jj = it & 63; a1_tile(a, l, b, 127 - jj, lds); a1_tile(a, l, b, jj, lds); }
}

__device__ __forceinline__ void a2_unit(const Args& a, int l, int b, int h, int blk, LAS unsigned char* lds) {
    KArgs* ka = kargs();
    const int tid = opaque_tid(), wid = __builtin_amdgcn_readfirstlane(tid >> 6), lane = tid & 63, fr = lane & 15, kq = lane >> 4;
    unsigned char* ws = ka->ws;
    const bf16_t* proj = (const bf16_t*)(ws + WS_PROJ);
    const char* KNb = (const char*)(ws + WS_KN) + (size_t)(b * 4 + h) * 128 * 4096;
    const char* VTb = (const char*)(ws + WS_VT) + (size_t)(b * 4 + h) * 128 * 4096;
    LAS unsigned char* Kb = lds;
    LAS unsigned char* Vb = lds + 16384;
    LAS float* Ob = (LAS float*)(lds + 32768) + wid * (16 * 68);
    const int nsteps = 2 * (blk + 1);
    const int tokq = b * S + blk * 128 + wid * 16 + fr;
    bf16x8 Qb[2]; float C2;
    {
        const float* qg = IN_F(I_QN) + l * 64; const float* kg = IN_F(I_KN) + l * 64;
        float gq = 0.f, gk = 0.f;
        for (int i = 0; i < 64; ++i) { gq = fmaxf(gq, fabsf(qg[i])); gk = fmaxf(gk, fabsf(kg[i])); }
        C2 = 8.0f * gq * gk * 1.4426950408889634f;
        const bf16_t* pr = proj + (size_t)tokq * NP + NQ + h * 64;
        float v[2][8]; float ss = 0.f;
#pragma unroll
        for (int ks = 0; ks < 2; ++ks) { const u32x4 raw = *(const u32x4*)(pr + 32 * ks + 8 * kq);
            v[ks][0] = bflo(raw.x); v[ks][1] = bfhi(raw.x); v[ks][2] = bflo(raw.y); v[ks][3] = bfhi(raw.y); v[ks][4] = bflo(raw.z); v[ks][5] = bfhi(raw.z); v[ks][6] = bflo(raw.w); v[ks][7] = bfhi(raw.w);
#pragma unroll
            for (int i = 0; i < 8; ++i) ss += v[ks][i] * v[ks][i]; }
        ss += __shfl_xor(ss, 16); ss += __shfl_xor(ss, 32);
        const float r = rsqrtf(ss * (1.0f / 64.0f) + EPS);
#pragma unroll
        for (int ks = 0; ks < 2; ++ks)
#pragma unroll
            for (int i = 0; i < 8; ++i) v[ks][i] *= r * qg[32 * ks + 8 * kq + i];
        {
            const float* ra = (const float*)(ws + WS_ROPEA) + (size_t)tokq * 16;
#pragma unroll
            for (int i = 0; i < 8; ++i) { const float pv = __shfl_xor(v[0][i], 16); const float c = ra[i], s = ra[8 + i];
                if (kq == 0) v[0][i] = v[0][i] * c - pv * s; else if (kq == 1) v[0][i] = v[0][i] * c + pv * s; }
        }
        const float qs = 0.125f * 1.4426950408889634f;
#pragma unroll
        for (int ks = 0; ks < 2; ++ks) { u32x4 pk; pk.x = cvt_pk_bf16(v[ks][0] * qs, v[ks][1] * qs); pk.y = cvt_pk_bf16(v[ks][2] * qs, v[ks][3] * qs); pk.z = cvt_pk_bf16(v[ks][4] * qs, v[ks][5] * qs); pk.w = cvt_pk_bf16(v[ks][6] * qs, v[ks][7] * qs);
            Qb[ks] = __builtin_bit_cast(bf16x8, pk); }
    }
    const unsigned* mrow = (const unsigned*)(ws + WS_MASK) + (size_t)tokq * 128;
    f32x4 O[4];
#pragma unroll
    for (int dt = 0; dt < 4; ++dt) O[dt] = (f32x4){0.f, 0.f, 0.f, 0.f};
    float lsum = 0.f;
    const int kkey = tid >> 3, kch = tid & 7, vsub = tid >> 8, vd = (tid >> 2) & 63, vch = tid & 3;
    const int klds = kkey * 128 + ((kch ^ (kkey & 7)) * 16), vlds = vsub * 4096 + vd * 64 + ((vch ^ ((vd >> 2) & 3)) * 16);
    u32x4 kr0, kr1, kr2, kr3, vr0, vr1, vr2, vr3; u32x2 mw0, mw1, mw2, mw3;
#define A2_LOAD(j, st_) do { kr##j = *(const u32x4*)(KNb + (size_t)(st_) * 8192 + (size_t)tid * 16); vr##j = *(const u32x4*)(VTb + (size_t)(st_) * 8192 + (size_t)tid * 16); mw##j = *(const u32x2*)(mrow + 2 * (st_)); } while (0)
    A2_LOAD(0, 0); A2_LOAD(1, 1);
    if (nsteps > 2) { A2_LOAD(2, 2); A2_LOAD(3, 3); } else { kr2 = kr0; vr2 = vr0; mw2 = mw0; kr3 = kr0; vr3 = vr0; mw3 = mw0; }
    __syncthreads();
#define A2_STEP(j, st_) do { \
        LAS unsigned char* Kc = Kb + ((st_) & 1) * 8192; LAS unsigned char* Vc = Vb + ((st_) & 1) * 8192; \
        *(LAS u32x4*)(Kc + klds) = kr##j; *(LAS u32x4*)(Vc + vlds) = vr##j; \
        const u32x2 mcur = mw##j; \
        __syncthreads(); \
        if ((st_) + 4 < nsteps) A2_LOAD(j, (st_) + 4); \
        _Pragma("unroll") for (int sub = 0; sub < 2; ++sub) { \
            const unsigned m = sub ? mcur.y : mcur.x; \
            f32x4 Sx[2]; \
            _Pragma("unroll") for (int tl = 0; tl < 2; ++tl) { \
                const int key = 32 * sub + 16 * tl + fr; \
                const bf16x8 A0 = *(const LAS bf16x8*)(Kc + key * 128 + (((0 + kq) ^ (key & 7)) * 16)); \
                const bf16x8 A1 = *(const LAS bf16x8*)(Kc + key * 128 + (((4 + kq) ^ (key & 7)) * 16)); \
                f32x4 z = (f32x4){0.f, 0.f, 0.f, 0.f}; \
                z = mfma16(A0, Qb[0], z); Sx[tl] = mfma16(A1, Qb[1], z); \
            } \
            float p[8]; \
            _Pragma("unroll") for (int r = 0; r < 4; ++r) { \
                const float e0 = __builtin_amdgcn_exp2f(Sx[0][r] - C2), e1 = __builtin_amdgcn_exp2f(Sx[1][r] - C2); \
                p[r] = ((m >> (4 * kq + r)) & 1u) ? e0 : 0.f; p[4 + r] = ((m >> (16 + 4 * kq + r)) & 1u) ? e1 : 0.f; \
            } \
            lsum += ((p[0] + p[1]) + (p[2] + p[3])) + ((p[4] + p[5]) + (p[6] + p[7])); \
            u32x4 pk; pk.x = cvt_pk_bf16(p[0], p[1]); pk.y = cvt_pk_bf16(p[2], p[3]); pk.z = cvt_pk_bf16(p[4], p[5]); pk.w = cvt_pk_bf16(p[6], p[7]); \
            const bf16x8 Pf = __builtin_bit_cast(bf16x8, pk); \
            _Pragma("unroll") for (int dt = 0; dt < 4; ++dt) { const int d = 16 * dt + fr; \
                const bf16x8 Av = *(const LAS bf16x8*)(Vc + sub * 4096 + d * 64 + ((kq ^ ((d >> 2) & 3)) * 16)); \
                O[dt] = mfma16(Av, Pf, O[dt]); } \
        } } while (0)
    for (int st = 0; st < nsteps; st += 4) {
        A2_STEP(0, st); A2_STEP(1, st + 1);
        if (st + 2 < nsteps) { A2_STEP(2, st + 2); A2_STEP(3, st + 3); }
    }
#undef A2_STEP
#undef A2_LOAD
    lsum += __shfl_xor(lsum, 16); lsum += __shfl_xor(lsum, 32);
    const float inv = 1.0f / lsum;
#pragma unroll
    for (int dt = 0; dt < 4; ++dt)
#pragma unroll
        for (int r = 0; r < 4; ++r) Ob[fr * 68 + 16 * dt + 4 * kq + r] = O[dt][r] * inv;
    __syncthreads();
    {
        const int qq = lane >> 2, dp = (lane & 3) * 16;
        const LAS float* src = Ob + qq * 68 + dp;
        float f[16]; float sq = 0.f;
#pragma unroll
        for (int i = 0; i < 4; ++i) { const f32x4 t = *(const LAS f32x4*)(src + 4 * i); f[4 * i] = t[0]; f[4 * i + 1] = t[1]; f[4 * i + 2] = t[2]; f[4 * i + 3] = t[3]; sq += (t[0] * t[0] + t[1] * t[1]) + (t[2] * t[2] + t[3] * t[3]); }
        u32x4 w0, w1; w0.x = cvt_pk_bf16(f[0], f[1]); w0.y = cvt_pk_bf16(f[2], f[3]); w0.z = cvt_pk_bf16(f[4], f[5]); w0.w = cvt_pk_bf16(f[6], f[7]);
        w1.x = cvt_pk_bf16(f[8], f[9]); w1.y = cvt_pk_bf16(f[10], f[11]); w1.z = cvt_pk_bf16(f[12], f[13]); w1.w = cvt_pk_bf16(f[14], f[15]);
        const int tok = b * S + blk * 128 + wid * 16 + qq;
        bf16_t* op = (bf16_t*)(ws + WS_MIXB) + (size_t)tok * D + h * 64 + dp;
        *(u32x4*)op = w0; *(u32x4*)(op + 8) = w1;
        sq += dpp_f<0xB1>(sq); sq += dpp_f<0x4E>(sq);
        if ((lane & 3) == 0) ((float*)(ws + WS_SSQ))[((size_t)l * NTOK + tok) * 4 + h] = sq;
    }
    __syncthreads();
}
__device__ __forceinline__ void phase_a2(const Args& a, int l, LAS unsigned char* lds, int vcu, int G) {
    KArgs* ka = kargs();
    for (int it = vcu; it < 256; it += G) { const int b = it >> 6, h = (it >> 4) & 3, jj = it & 15; a2_unit(a, l, b, h, 31 - jj, lds); a2_unit(a, l, b, h, jj, lds); }
}
__device__ __forceinline__ void phase_anorm(const Args& a, int l, int vcu, int G) {
    KArgs* ka = kargs();
    const int tid = opaque_tid(), wid = __builtin_amdgcn_readfirstlane(tid >> 6), lane = tid & 63;
    const bf16_t* oa = (const bf16_t*)(ka->ws + WS_OA); bf16_t* mixb = (bf16_t*)(ka->ws + WS_HA);
    const f32x4 gv = *(const f32x4*)(IN_F(I_ONORM) + l * D + 4 * lane);
    for (int tok = vcu * 8 + wid; tok < NTOK; tok += G * 8) {
        const u32x2 v = *(const u32x2*)(oa + (size_t)tok * 256 + 4 * lane);
        const float o0 = bflo(v.x), o1 = bfhi(v.x), o2 = bflo(v.y), o3 = bfhi(v.y);
        const float r = rsqrtf(wave_sum((o0 * o0 + o1 * o1) + (o2 * o2 + o3 * o3)) * (1.0f / 256.0f) + EPS);
        u32x2 w; w.x = cvt_pk_bf16(o0 * r * gv[0], o1 * r * gv[1]); w.y = cvt_pk_bf16(o2 * r * gv[2], o3 * r * gv[3]);
        *(u32x2*)(mixb + (size_t)tok * D + 4 * lane) = w;
    }
}
__global__ void __launch_bounds__(NTHR, 2) mk_fwd(Args a) {
    extern __shared__ __attribute__((aligned(16))) unsigned char lds_raw[];
    LAS unsigned char* lds = (LAS unsigned char*)lds_raw;
    const int tid = threadIdx.x, G = gridDim.x, bx = blockIdx.x;
    const int vcu = (G % 8 == 0) ? (bx % 8) * (G / 8) + bx / 8 : bx;
    if (tid < 64) ((LAS unsigned*)(lds + LDS_MISC))[tid] = 0u;
    __syncthreads();
    XcdBarrier bar; bar.bar = (unsigned*)(a.ws + WS_BAR); bar.x = 0; bar.st = nullptr;
    if (a.fused) bar = xcd_barrier_post((unsigned*)(a.ws + WS_BAR), (volatile LAS unsigned*)(lds + LDS_MISC + MISC_BAR));
#define GRID_BAR() do { if (a.fused) xcd_barrier(bar); } while (0)
#ifdef ONLY_PH
#define IN(k) ((k) == ONLY_PH && a.ph_lo <= (k) && (k) < a.ph_hi)
#else
#define IN(k) (a.ph_lo <= (k) && (k) < a.ph_hi)
#endif
    if (IN(PH_PRO)) { phase_prologue(a, lds, vcu, G); GRID_BAR(); }
    if (IN(PH_NORM0)) { KArgs* ka = kargs(); unsigned char* ws = ka->ws; float* modp = (float*)(ws + WS_MOD); phase_norm(IN_F(I_X), IN_F(I_NORM1), modp, modp + 1024, (bf16_t*)(ws + WS_HA), vcu, G); phase_rbias(a, lds, vcu); GRID_BAR(); }
    for (int l = a.l_lo; l < a.l_hi; ++l) {
        if (IN(PH_G1)) {
            KArgs* ka = kargs(); unsigned char* ws = ka->ws;
            pg8::DenseOrder S; S.init((const bf16_t*)(ws + WS_HA), (const bf16_t*)(ws + WS_WINT) + (size_t)l * NP * D, NTOK, (G == 256) ? NP - 256 : NP, D, G, bx);
            pg8::EpiBf16 E{(bf16_t*)(ws + WS_PROJ), NP};
            pg8::gemm_phase(lds, S, E);
            GRID_BAR();
        }
        if (IN(PH_MIX)) {
            if (G == 256 && bx < 64) {
                KArgs* ka = kargs(); unsigned char* ws = ka->ws;
                pg8::DenseOrder S; S.init((const bf16_t*)(ws + WS_HA), (const bf16_t*)(ws + WS_WINT) + (size_t)l * NP * D + (size_t)(NP - 256) * D, NTOK, 256, D, 64, bx);
                pg8::EpiBf16 E{(bf16_t*)(ws + WS_PROJ) + (NP - 256), NP};
                pg8::gemm_phase(lds, S, E);
            }
            phase_mix1(a, l, lds, vcu, G, bx); GRID_BAR();
        }
        if (IN(PH_A1)) { phase_a1(a, l, lds, vcu, G); GRID_BAR(); }
        if (IN(PH_A2)) { phase_a2(a, l, lds, vcu, G); GRID_BAR(); }
        if (IN(PH_G2)) {
            KArgs* ka = kargs(); unsigned char* ws = ka->ws; const float* xin = IN_F(I_X); const bf16_t* xinb = (l == 0) ? (const bf16_t*)nullptr : (const bf16_t*)(ws + WS_X1) + (size_t)NTOK * D; const float* mod = (const float*)(ws + WS_MOD) + (size_t)l * 4 * 6144;
            pg8::DenseOrder S; S.init((const bf16_t*)(ws + WS_MIXB), (const bf16_t*)(ws + WS_WOUTT) + (size_t)l * D * D, NTOK, D, D, G, bx);
            pg8::EpiResid E{xin, xinb, (bf16_t*)(ws + WS_X1), mod + 2048, (const float*)(ws + WS_SSQ) + (size_t)l * NTOK * 4};
            pg8::gemm_phase<pg8::EpiResid, pg8::DenseOrder, true>(lds, S, E);
            GRID_BAR();
        }
        if (IN(PH_ROUTE)) { phase_route(a, l, lds, vcu, G); GRID_BAR(); }
        if (IN(PH_UP)) {
            KArgs* ka = kargs(); unsigned char* ws = ka->ws;
            moe_cum(a, l, lds);
            pg8::MoeOrder<true> S; S.A = (const bf16_t*)(ws + WS_HA); S.Bt = (const bf16_t*)(ws + WS_WGUT) + (size_t)l * NE * 1024 * 1024; S.K = D; S.bstride = (size_t)1024 * 1024;
            S.list = (const int*)(ws + WS_LIST); S.cum = (const LAS int*)(lds + LDS_MISC + MISC_CUM); S.cnts = (const LAS int*)(lds + LDS_MISC + MISC_CNT); S.G = G; S.c = vcu; S.nun = S.cum[32] * 4;
            pg8::EpiHid E{(bf16_t*)(ws + WS_HID)};
            pg8::gemm_phase(lds, S, E);
            GRID_BAR();
        }
        if (IN(PH_DOWN)) {
            KArgs* ka = kargs(); unsigned char* ws = ka->ws;
            moe_cum(a, l, lds);
            pg8::MoeOrder<false> S; S.A = (const bf16_t*)(ws + WS_HID); S.Bt = (const bf16_t*)(ws + WS_WDT) + (size_t)l * NE * 1024 * 512; S.K = F; S.bstride = (size_t)1024 * 512;
            S.list = nullptr; S.cum = (const LAS int*)(lds + LDS_MISC + MISC_CUM); S.cnts = (const LAS int*)(lds + LDS_MISC + MISC_CNT); S.G = G; S.c = vcu; S.nun = S.cum[32] * 4;
            pg8::EpiDown E{(bf16_t*)(ws + WS_Y), (const float*)(ws + WS_LGATE)};
            pg8::gemm_phase(lds, S, E);
            GRID_BAR();
        }
        if (IN(PH_COMB)) { phase_combine(a, l, lds, vcu, G); GRID_BAR(); }
    }
#undef IN
#undef GRID_BAR
}


static void launch_ph(const Args& base, int grid, int l_lo, int l_hi, int ph_lo, int ph_hi, int fused, hipStream_t stream) {
    Args a = base; a.l_lo = l_lo; a.l_hi = l_hi; a.ph_lo = ph_lo; a.ph_hi = ph_hi; a.fused = fused; a.pad = 0;
    hipLaunchKernelGGL(mk_fwd, dim3(grid), dim3(NTHR), LDS_BYTES, stream, a);
}

extern "C" void kernel_launch(void* const* d_in, const int* in_sizes, int n_in, void* d_out, int out_size, void* d_ws, size_t ws_size, hipStream_t stream) {
    static int grid = 0;
    if (grid == 0) {
        int dev = 0, cus = 0;
        if (hipGetDevice(&dev) != hipSuccess || hipDeviceGetAttribute(&cus, hipDeviceAttributeMultiprocessorCount, dev) != hipSuccess) { grid = -1; return; }
        if (hipFuncSetAttribute((const void*)mk_fwd, hipFuncAttributeMaxDynamicSharedMemorySize, LDS_BYTES) != hipSuccess) { fprintf(stderr, "hipFuncSetAttribute failed\n"); grid = -1; return; }
        (void)hipGetLastError();
        grid = cus;
    }
    if (grid < 0) return;
    unsigned char* ws = (unsigned char*)d_ws;
    (void)hipMemsetAsync(ws, 0, WS_ZERO_BYTES, stream);
    Args a{};
    for (int i = 0; i < 32; ++i) a.in[i] = d_in[i];
    a.out = (float*)d_out; a.ws = ws;
#ifdef MK_MULTI
    launch_ph(a, grid, 0, 0, PH_PRO, PH_PRO + 1, 0, stream);
#ifdef MK_REP
    if (MK_REP == PH_PRO) launch_ph(a, grid, 0, 0, PH_PRO, PH_PRO + 1, 0, stream);
#endif
    launch_ph(a, grid, 0, 0, PH_NORM0, PH_NORM0 + 1, 0, stream);
#ifdef MK_REP
    if (MK_REP == PH_NORM0) launch_ph(a, grid, 0, 0, PH_NORM0, PH_NORM0 + 1, 0, stream);
#endif
    for (int l = 0; l < L; ++l)
        for (int ph = PH_G1; ph < PH_END; ++ph) {
            launch_ph(a, grid, l, l + 1, ph, ph + 1, 0, stream);
#ifdef MK_REP
            if (ph == MK_REP) launch_ph(a, grid, l, l + 1, ph, ph + 1, 0, stream);
#endif
#ifdef MK_ROUTE_PROBE
            if (ph == PH_ROUTE) { Args a2 = a; a2.l_lo = l; a2.l_hi = l + 1; a2.ph_lo = ph; a2.ph_hi = ph + 1; a2.fused = 0; a2.pad = 1; hipLaunchKernelGGL(mk_fwd, dim3(grid), dim3(NTHR), LDS_BYTES, stream, a2); }
#endif
        }
#else
    launch_ph(a, grid, 0, L, PH_PRO, PH_END, 1, stream);
#endif
}
```

```cpp
#include <hip/hip_runtime.h>
#include <stdint.h>
#include <stdio.h>

#define LAS __attribute__((address_space(3)))
typedef unsigned short bf16_t;
typedef short bf16x8 __attribute__((ext_vector_type(8)));
typedef float f32x4 __attribute__((ext_vector_type(4)));
typedef float f32x16 __attribute__((ext_vector_type(16)));
typedef unsigned u32x4 __attribute__((ext_vector_type(4)));
typedef unsigned u32x2 __attribute__((ext_vector_type(2)));

constexpr int Bn = 4, S = 4096, D = 1024, L = 2, NTOK = Bn * S, DIN = 2212, F = 512, NE = 32;
constexpr int NP = 2304;
constexpr int NK = 0, NV = 256, NIQ = 512, NIK = 640, NIW = 672, NBA = 768, NBG = 1024, NC = 1280, NDU = 1536, NDV = 1792, NQ = 2048;
constexpr float EPS = 1e-6f;
constexpr int NTHR = 512;
constexpr int SLOTS = 40960;

constexpr int LDS_BYTES = 163840, LDS_MISC = 147456;
constexpr int MISC_BAR = 0;
constexpr int MISC_CUM = 64;
constexpr int MISC_CNT = 64 + 160;

constexpr size_t al256c(size_t v) { return (v + 255) & ~(size_t)255; }
constexpr size_t WS_BAR = 0;
constexpr size_t WS_CNT = 16384;
constexpr size_t WS_ZERO_BYTES = 16384 + 32768;
constexpr size_t WS_MOD = WS_ZERO_BYTES;
constexpr size_t WS_ROPEA = WS_MOD + al256c((size_t)L * 4 * 6144 * 4);
constexpr size_t WS_ROPEI = WS_ROPEA + al256c((size_t)NTOK * 16 * 4);
constexpr size_t WS_LIST = WS_ROPEI + al256c((size_t)NTOK * 8 * 4);
constexpr size_t WS_LGATE = WS_LIST + al256c((size_t)NE * NTOK * 4);
constexpr size_t WS_TOKINFO = WS_LGATE + al256c((size_t)NE * NTOK * 4);
constexpr size_t WS_SGUW = WS_TOKINFO + al256c((size_t)NTOK * 16);
constexpr size_t WS_POOLT = WS_SGUW + al256c((size_t)L * 4 * 128 * 128 * 2);
constexpr size_t WS_WHL = WS_POOLT + al256c((size_t)L * 4 * 64 * 64 * 2);
constexpr size_t WS_RBIAS = WS_WHL + al256c((size_t)L * 2 * 48 * 1024 * 2);
constexpr size_t WS_SSQ = WS_RBIAS + al256c((size_t)L * 4 * 32 * 48 * 4);
constexpr size_t WS_WINT = WS_SSQ + al256c((size_t)L * NTOK * 4 * 4);
constexpr size_t WS_WOUTT = WS_WINT + al256c((size_t)L * NP * D * 2);
constexpr size_t WS_PWT = WS_WOUTT + al256c((size_t)L * D * D * 2);
constexpr size_t WS_WGUT = WS_PWT + al256c((size_t)L * 256 * 256 * 2);
constexpr size_t WS_WDT = WS_WGUT + al256c((size_t)L * NE * 1024 * 1024 * 2);
constexpr size_t WS_HA = WS_WDT + al256c((size_t)L * NE * 1024 * 512 * 2);
constexpr size_t WS_X1 = WS_HA + al256c((size_t)NTOK * D * 2);
constexpr size_t WS_R = WS_X1 + al256c((size_t)NTOK * D * 4);
constexpr size_t WS_PROJ = WS_R;
constexpr size_t WS_R2 = WS_PROJ + al256c((size_t)NTOK * NP * 2);
constexpr size_t WS_HID = WS_R;
constexpr size_t WS_Y = WS_HID + al256c((size_t)SLOTS * F * 2);

__device__ __forceinline__ unsigned cvt_pk_bf16(float lo, float hi) { unsigned r; asm volatile("v_cvt_pk_bf16_f32 %0, %1, %2" : "=v"(r) : "v"(lo), "v"(hi)); return r; }
__device__ __forceinline__ float bf2f(bf16_t v) { return __uint_as_float(((unsigned)v) << 16); }
__device__ __forceinline__ float bflo(unsigned w) { return __uint_as_float(w << 16); }
__device__ __forceinline__ float bfhi(unsigned w) { return __uint_as_float(w & 0xffff0000u); }
template <int CTRL> __device__ __forceinline__ float dpp_f(float v) { return __builtin_bit_cast(float, __builtin_amdgcn_update_dpp(0, __builtin_bit_cast(int, v), CTRL, 0xF, 0xF, true)); }
__device__ __forceinline__ float row_sum16(float v) {
    v += dpp_f<0xB1>(v);
    v += dpp_f<0x4E>(v);
    v += dpp_f<0x141>(v);
    v += dpp_f<0x140>(v);
    return v;
}
__device__ __forceinline__ float wave_sum(float v) {
    v = row_sum16(v);
    const float r0 = __builtin_bit_cast(float, __builtin_amdgcn_readlane(__builtin_bit_cast(int, v), 0)), r1 = __builtin_bit_cast(float, __builtin_amdgcn_readlane(__builtin_bit_cast(int, v), 16));
    const float r2 = __builtin_bit_cast(float, __builtin_amdgcn_readlane(__builtin_bit_cast(int, v), 32)), r3 = __builtin_bit_cast(float, __builtin_amdgcn_readlane(__builtin_bit_cast(int, v), 48));
    return (r0 + r1) + (r2 + r3);
}
__device__ __forceinline__ float wave_max(float v) {
#pragma unroll
    for (int o = 32; o >= 1; o >>= 1) v = fmaxf(v, __shfl_xor(v, o));
    return v;
}
__device__ __forceinline__ float silu_f(float v) { return v / (1.0f + expf(-v)); }
__device__ __forceinline__ float silu_fast(float v) { return v * __builtin_amdgcn_rcpf(1.0f + __expf(-v)); }
__device__ __forceinline__ float sigmoid_f(float v) { return 1.0f / (1.0f + expf(-v)); }
__device__ __forceinline__ float sigmoid_fast(float v) { return __builtin_amdgcn_rcpf(1.0f + __expf(-v)); }
__device__ __forceinline__ int opaque_tid() { int t = threadIdx.x; asm volatile("" : "+v"(t)); return t; }
__device__ __forceinline__ int ld_agent(const int* p) { return __hip_atomic_load(p, __ATOMIC_RELAXED, __HIP_MEMORY_SCOPE_AGENT); }

#define XB_TMO      128
#define XB_XCNT(j)  (256  + 64 * (j))
#define XB_XSUB(j)  (1280 + 64 * (j))
#define XB_XGEN(j)  (2304 + 64 * (j))
#define XB_TOP      3328
#define XB_TOPGEN   3392
#define XCD_BAR_WORDS 3456
#define XB_SPIN_CAP (1u << 18)
__device__ __forceinline__ unsigned xb_ld(unsigned* p)              { return __hip_atomic_load(p, __ATOMIC_RELAXED, __HIP_MEMORY_SCOPE_AGENT); }
__device__ __forceinline__ unsigned xb_add(unsigned* p, unsigned v) { return __hip_atomic_fetch_add(p, v, __ATOMIC_RELAXED, __HIP_MEMORY_SCOPE_AGENT); }
__device__ __forceinline__ unsigned xb_xcc_id() { return (unsigned)__builtin_amdgcn_s_getreg((3 << 11) | 20) & 0xFu; }
#define XB_SPIN(cond, bar) do { unsigned _sp = 0; while (cond) { __builtin_amdgcn_s_sleep(1); \
    if ((++_sp & 255u) == 0u) { if (xb_ld(&(bar)[XB_TMO])) break; if (_sp > XB_SPIN_CAP) { atomicAdd(&(bar)[XB_TMO], 1u); break; } } } } while (0)
struct XcdBarrier { unsigned* bar; unsigned x; volatile LAS unsigned* st; };
__device__ __forceinline__ XcdBarrier xcd_barrier_post(unsigned* bar, volatile LAS unsigned* st) {
    XcdBarrier b; b.bar = bar; b.x = xb_xcc_id(); b.st = st;
    if (threadIdx.x == 0) (void)xb_add(&bar[XB_XCNT(b.x)], 1u);
    return b;
}
__device__ __forceinline__ void xcd_barrier_complete(unsigned* bar, unsigned x, unsigned& nloc, unsigned& nx) {
    const unsigned G = gridDim.x * gridDim.y * gridDim.z;
    unsigned sum, cnt, mine, sp = 0u;
    for (;;) {
        sum = 0u; cnt = 0u; mine = 0u;
#pragma unroll
        for (unsigned j = 0; j < 16; ++j) { const unsigned c = xb_ld(&bar[XB_XCNT(j)]); sum += c; cnt += (c > 0u) ? 1u : 0u; mine = (j == x) ? c : mine; }
        if (sum == G) break;
        __builtin_amdgcn_s_sleep(1);
        if ((++sp & 255u) == 0u) { if (xb_ld(&bar[XB_TMO])) break; if (sp > XB_SPIN_CAP) { atomicAdd(&bar[XB_TMO], 1u); break; } }
    }
    nloc = mine > 0u ? mine : 1u; nx = cnt > 0u ? cnt : 1u;
}
__device__ __forceinline__ void xcd_barrier(const XcdBarrier& b) {
    asm volatile("s_waitcnt vmcnt(0)" ::: "memory");
    __syncthreads();
    if (threadIdx.x == 0) {
        unsigned* bar = b.bar;
        __builtin_amdgcn_s_waitcnt(0);
        unsigned nloc = b.st[0], nx = b.st[1];
        if (nloc == 0u) { xcd_barrier_complete(bar, b.x, nloc, nx); b.st[0] = nloc; b.st[1] = nx; }
        const unsigned old = xb_add(&bar[XB_XSUB(b.x)], 1u);
        const unsigned gen = old / nloc;
        if (old + 1u == (gen + 1u) * nloc) {
            __builtin_amdgcn_fence(__ATOMIC_RELEASE, "agent");
            asm volatile("s_waitcnt vmcnt(0)" ::: "memory");
            const unsigned og = xb_add(&bar[XB_TOP], 1u);
            const unsigned tg = og / nx;
            if (og + 1u == (tg + 1u) * nx) xb_add(&bar[XB_TOPGEN], 1u);
            else XB_SPIN(xb_ld(&bar[XB_TOPGEN]) == tg, bar);
            __builtin_amdgcn_fence(__ATOMIC_ACQUIRE, "agent");
            xb_add(&bar[XB_XGEN(b.x)], 1u);
            asm volatile("s_waitcnt vmcnt(0)" ::: "memory");
        } else {
            XB_SPIN(xb_ld(&bar[XB_XGEN(b.x)]) == gen, bar);
            __builtin_amdgcn_fence(__ATOMIC_ACQUIRE, "agent");
            asm volatile("s_waitcnt vmcnt(0)" ::: "memory");
        }
    }
    __syncthreads();
}

namespace pg8 {
constexpr int BM = 256, BK = 64, HALF = 128, HTB = HALF * BK * 2, STAGE_BYTES = 8 * HTB, NXCD = 8, WGM = 8;
__host__ __device__ __forceinline__ int lds_byte(int r, int c) { const int st = (r >> 4) * 2 + (c >> 5), rr = r & 15, cc = c & 31, ob = rr * 64 + cc * 2; return st * 1024 + (ob ^ (((ob >> 9) & 1) << 5)); }
__host__ __device__ __forceinline__ void stage_rc(int b, int& R, int& C) { const int st = b / 1024, sb = b % 1024, swz = sb ^ (((sb >> 9) & 1) << 5); R = (st >> 1) * 16 + swz / 64; C = (st & 1) * 32 + (swz % 64) / 2; }
__host__ __device__ __forceinline__ int perm32(int rho) { const int n = rho >> 4, i = rho & 15; return 8 * (i >> 2) + 4 * n + (i & 3); }

struct Unit { int pm, pn, e, mt, cnt; };

struct DenseOrder {
    const bf16_t* A; const bf16_t* Bt; int K;
    int nM, nN, nwg, G, c;
    __device__ void init(const bf16_t* A_, const bf16_t* Bt_, int M, int N, int K_, int G_, int c_) { A = A_; Bt = Bt_; K = K_; nM = M / BM; nN = N / BM; nwg = nM * nN; G = G_; c = c_; }
    __device__ bool next(int i, Unit& u) const {
        const long Lx = (long)i * G + c; if (Lx >= nwg) return false;
        int wgid = (int)Lx; { const int q = nwg / NXCD, r = nwg % NXCD, xcd = wgid % NXCD, off = wgid / NXCD; wgid = (xcd < r ? xcd * (q + 1) : r * (q + 1) + (xcd - r) * q) + off; }
        const int nig = WGM * nN, gid = wgid / nig, fm = gid * WGM, gsz = (nM - fm) < WGM ? (nM - fm) : WGM;
        u.pm = fm + ((wgid % nig) % gsz); u.pn = (wgid % nig) / gsz; u.e = 0; u.mt = 0; u.cnt = 0; return true;
    }
    __device__ __forceinline__ const char* a_base(const Unit& u) const { return (const char*)A + (size_t)u.pm * BM * K * 2; }
    __device__ __forceinline__ unsigned a_voff(const Unit&, int row, int C) const { return (unsigned)(row * K + C) * 2u; }
    __device__ __forceinline__ const char* b_base(const Unit& u) const { return (const char*)Bt + (size_t)u.pn * BM * K * 2; }
};
template <bool gather> struct MoeOrder {
    const bf16_t* A; const bf16_t* Bt; int K; size_t bstride;
    const int* list;
    const LAS int* cum; const LAS int* cnts;
    int G, c, nun;
    __device__ bool next(int i, Unit& u) const {
        const int Lx = i * G + c; if (Lx >= nun) return false;
        const int t = Lx >> 2; u.pn = Lx & 3; u.pm = t;
        int e = 0;
#pragma unroll 1
        for (int j = 1; j < NE; ++j) e += (cum[j] <= t) ? 1 : 0;
        u.e = e; u.mt = t - cum[e]; u.cnt = cnts[e]; return true;
    }
    __device__ __forceinline__ const char* a_base(const Unit& u) const { return gather ? (const char*)A : (const char*)A + (size_t)u.pm * BM * K * 2; }
    __device__ __forceinline__ unsigned a_voff(const Unit& u, int row, int C) const {
        if (gather) { const int pos = u.mt * BM + row; const int tok = (pos < u.cnt) ? list[(size_t)u.e * NTOK + pos] : 0; return (unsigned)(tok * K + C) * 2u; }
        return (unsigned)(row * K + C) * 2u;
    }
    __device__ __forceinline__ const char* b_base(const Unit& u) const { return (const char*)(Bt + (size_t)u.e * bstride) + (size_t)u.pn * BM * K * 2; }
};

struct EpiBf16 {
    static constexpr bool PERM = true;
    bf16_t* O; int ldc;
    __device__ __forceinline__ void operator()(const f32x4 (&acc)[2][2][4][2], const Unit& u, int wr, int wc, int fr, int fq) const {
        const int row0 = u.pm * BM + wr * 64 + fr, col0 = u.pn * BM + wc * 32 + 8 * fq;
#pragma unroll
        for (int ai = 0; ai < 2; ++ai)
#pragma unroll
            for (int m = 0; m < 4; ++m) { bf16_t* rowp = O + (size_t)(row0 + ai * HALF + m * 16) * ldc + col0;
#pragma unroll
                for (int bj = 0; bj < 2; ++bj) { const f32x4 v0 = acc[ai][bj][m][0], v1 = acc[ai][bj][m][1];
                    u32x4 w; w.x = cvt_pk_bf16(v0[0], v0[1]); w.y = cvt_pk_bf16(v0[2], v0[3]); w.z = cvt_pk_bf16(v1[0], v1[1]); w.w = cvt_pk_bf16(v1[2], v1[3]);
                    *(u32x4*)(rowp + bj * HALF) = w; } }
    }
};
struct EpiResid {
    static constexpr bool PERM = true;
    const float* X; const bf16_t* Xb; bf16_t* C; const float* gate;
    const float* ssq;
    __device__ __forceinline__ void rowscale(f32x4 (&acc)[2][2][4][2], const Unit& u, int wr, int fr) const {
        int rbase = u.pm * BM + wr * 64 + fr;
        asm volatile("" : "+v"(rbase));
#pragma unroll
        for (int ai = 0; ai < 2; ++ai)
#pragma unroll
            for (int m = 0; m < 4; ++m) { const f32x4 sv = *(const f32x4*)(ssq + (size_t)(rbase + ai * HALF + m * 16) * 4); const float r = rsqrtf(((sv[0] + sv[1]) + (sv[2] + sv[3])) * (1.0f / 256.0f) + EPS);
#pragma unroll
                for (int bj = 0; bj < 2; ++bj)
#pragma unroll
                    for (int n = 0; n < 2; ++n) acc[ai][bj][m][n] *= r; }
    }
    __device__ __forceinline__ void operator()(const f32x4 (&acc)[2][2][4][2], const Unit& u, int wr, int wc, int fr, int fq) const {
        const int row0 = u.pm * BM + wr * 64 + fr, col0 = u.pn * BM + wc * 32 + 8 * fq;
        const float* gp = gate + (size_t)((u.pm * BM) / S) * 6144 + col0;
        f32x4 gv[2][2];
#pragma unroll
        for (int bj = 0; bj < 2; ++bj)
#pragma unroll
            for (int n = 0; n < 2; ++n) gv[bj][n] = *(const f32x4*)(gp + bj * HALF + n * 4);
#pragma unroll
        for (int ai = 0; ai < 2; ++ai)
#pragma unroll
            for (int m = 0; m < 4; ++m) { const size_t off = (size_t)(row0 + ai * HALF + m * 16) * D + col0;
#pragma unroll
                for (int bj = 0; bj < 2; ++bj) {
                    f32x4 x0, x1v;
                    if (Xb) { const u32x4 xw = *(const u32x4*)(Xb + off + bj * HALF); x0 = (f32x4){bflo(xw.x), bfhi(xw.x), bflo(xw.y), bfhi(xw.y)}; x1v = (f32x4){bflo(xw.z), bfhi(xw.z), bflo(xw.w), bfhi(xw.w)}; }
                    else { x0 = *(const f32x4*)(X + off + bj * HALF); x1v = *(const f32x4*)(X + off + bj * HALF + 4); }
                    const f32x4 o0 = x0 + gv[bj][0] * acc[ai][bj][m][0], o1 = x1v + gv[bj][1] * acc[ai][bj][m][1];
                    u32x4 w; w.x = cvt_pk_bf16(o0[0], o0[1]); w.y = cvt_pk_bf16(o0[2], o0[3]); w.z = cvt_pk_bf16(o1[0], o1[1]); w.w = cvt_pk_bf16(o1[2], o1[3]);
                    *(u32x4*)(C + off + bj * HALF) = w; }
                asm volatile("" ::: "memory"); }
    }
};
struct EpiHid {
    static constexpr bool PERM = true;
    bf16_t* H;
    __device__ __forceinline__ void operator()(const f32x4 (&acc)[2][2][4][2], const Unit& u, int wr, int wc, int fr, int fq) const {
        const int row0 = u.pm * BM + wr * 64 + fr, col0 = u.pn * HALF + wc * 32 + 8 * fq;
#pragma unroll
        for (int ai = 0; ai < 2; ++ai)
#pragma unroll
            for (int m = 0; m < 4; ++m) { float h[8];
#pragma unroll
                for (int n = 0; n < 2; ++n)
#pragma unroll
                    for (int j = 0; j < 4; ++j) h[n * 4 + j] = silu_fast(acc[ai][0][m][n][j]) * acc[ai][1][m][n][j];
                u32x4 w; w.x = cvt_pk_bf16(h[0], h[1]); w.y = cvt_pk_bf16(h[2], h[3]); w.z = cvt_pk_bf16(h[4], h[5]); w.w = cvt_pk_bf16(h[6], h[7]);
                *(u32x4*)(H + (size_t)(row0 + ai * HALF + m * 16) * F + col0) = w; }
    }
};
struct EpiDown {
    static constexpr bool PERM = true;
    bf16_t* Y; const float* lgate;
    __device__ __forceinline__ void operator()(const f32x4 (&acc)[2][2][4][2], const Unit& u, int wr, int wc, int fr, int fq) const {
        const int rl0 = wr * 64 + fr, col0 = u.pn * BM + wc * 32 + 8 * fq;
        const float* gp = lgate + (size_t)u.e * NTOK + u.mt * BM;
#pragma unroll
        for (int ai = 0; ai < 2; ++ai)
#pragma unroll
            for (int m = 0; m < 4; ++m) { const int rl = rl0 + ai * HALF + m * 16; const float g = (u.mt * BM + rl < u.cnt) ? gp[rl] : 0.f;
                bf16_t* rowp = Y + (size_t)(u.pm * BM + rl) * D + col0;
#pragma unroll
                for (int bj = 0; bj < 2; ++bj) { const f32x4 v0 = acc[ai][bj][m][0] * g, v1 = acc[ai][bj][m][1] * g;
                    u32x4 w; w.x = cvt_pk_bf16(v0[0], v0[1]); w.y = cvt_pk_bf16(v0[2], v0[3]); w.z = cvt_pk_bf16(v1[0], v1[1]); w.w = cvt_pk_bf16(v1[2], v1[3]);
                    *(u32x4*)(rowp + bj * HALF) = w; } }
    }
};

template <class Epi, class Sched, bool RSC = false>
__device__ __forceinline__ void gemm_phase(LAS unsigned char* lds, const Sched& S, const Epi& E) {
    const int tid = opaque_tid(), wid = __builtin_amdgcn_readfirstlane(tid >> 6), lane = tid & 63, wr = wid >> 2, wc = wid & 3, fr = lane & 15, fq = lane >> 4;
    const int K = S.K, nt = K / BK;
    int Rr[2], Cc[2]; unsigned voffB[2];
#pragma unroll
    for (int i = 0; i < 2; ++i) { stage_rc(tid * 16 + i * 8192, Rr[i], Cc[i]); const int Rb = Epi::PERM ? ((Rr[i] & ~31) + perm32(Rr[i] & 31)) : Rr[i]; voffB[i] = (unsigned)(Rb * K + Cc[i]) * 2u; }
    const size_t kstep = (size_t)(BK * 2);
    const size_t hstep = (size_t)HALF * K * 2;
    const unsigned ldsw = (unsigned)wid * 1024u;
    const int aoff = lds_byte(wr * 64 + fr, fq * 8), boff = lds_byte(wc * 32 + fr, fq * 8);
#define PG8_SA(b, h) (((b) * 2 + (h)) * HTB)
#define PG8_SB(b, h) ((4 + (b) * 2 + (h)) * HTB)
#define PG8_STAGE(bufoff, gbase, voff) do { _Pragma("unroll") for (int _i = 0; _i < 2; ++_i) \
        __builtin_amdgcn_global_load_lds((const unsigned*)((const char*)(gbase) + (voff)[_i]), (LAS unsigned*)(lds + (bufoff) + ldsw + _i * 8192), 16, 0, 0); } while (0)
#define PG8_LDA(dst, b, h) do { _Pragma("unroll") for (int m = 0; m < 4; ++m) _Pragma("unroll") for (int k = 0; k < 2; ++k) dst[m][k] = *(const LAS bf16x8*)(lds + PG8_SA(b, h) + aoff + m * 2048 + k * 1024); } while (0)
#define PG8_LDB(dst, b, h) do { _Pragma("unroll") for (int n = 0; n < 2; ++n) _Pragma("unroll") for (int k = 0; k < 2; ++k) dst[n][k] = *(const LAS bf16x8*)(lds + PG8_SB(b, h) + boff + n * 2048 + k * 1024); } while (0)
#define PG8_MMA(ai, bj, At, Bt) do { __builtin_amdgcn_s_setprio(1); _Pragma("unroll") for (int m = 0; m < 4; ++m) _Pragma("unroll") for (int n = 0; n < 2; ++n) _Pragma("unroll") for (int k = 0; k < 2; ++k) \
        acc[ai][bj][m][n] = __builtin_amdgcn_mfma_f32_16x16x32_bf16(Bt[n][k], At[m][k], acc[ai][bj][m][n], 0, 0, 0); __builtin_amdgcn_s_setprio(0); } while (0)
#define PG8_WAIT_V(n) asm volatile("s_waitcnt vmcnt(" #n ")" ::: "memory")
#define PG8_WAIT_L(n) asm volatile("s_waitcnt lgkmcnt(" #n ")" ::: "memory")
#define PG8_BAR __builtin_amdgcn_s_barrier()
#define PG8_SCHED __builtin_amdgcn_sched_barrier(0)
    Unit cur, nxt; int ui = 0;
    if (!S.next(0, cur)) return;
    f32x4 acc[2][2][4][2];
#pragma unroll
    for (int a = 0; a < 2; ++a)
#pragma unroll
        for (int b = 0; b < 2; ++b)
#pragma unroll
            for (int m = 0; m < 4; ++m)
#pragma unroll
                for (int n = 0; n < 2; ++n) acc[a][b][m][n] = (f32x4){0.f, 0.f, 0.f, 0.f};
    bf16x8 At[4][2], B0[2][2], B1[2][2];
    unsigned vA0[2], vA1[2], vN0[2], vN1[2];
#pragma unroll
    for (int i = 0; i < 2; ++i) { vA0[i] = S.a_voff(cur, Rr[i], Cc[i]); vA1[i] = S.a_voff(cur, HALF + Rr[i], Cc[i]); }
    const char* cA = S.a_base(cur); const char* cB = S.b_base(cur);
    PG8_STAGE(PG8_SB(0, 0), cB, voffB); PG8_STAGE(PG8_SB(0, 1), cB + hstep, voffB); PG8_STAGE(PG8_SA(0, 0), cA, vA0); PG8_STAGE(PG8_SA(0, 1), cA, vA1);
    if (wr == 1) PG8_BAR;
    PG8_WAIT_V(2); PG8_BAR;
    PG8_STAGE(PG8_SB(1, 0), cB + kstep, voffB); PG8_STAGE(PG8_SA(1, 0), cA + kstep, vA0); PG8_STAGE(PG8_SB(1, 1), cB + hstep + kstep, voffB);
    PG8_WAIT_V(6); PG8_BAR;
    for (;;) {
        const bool has_next = S.next(ui + 1, nxt);
        const char* nA = has_next ? S.a_base(nxt) : cA; const char* nB = has_next ? S.b_base(nxt) : cB;
#pragma unroll
        for (int i = 0; i < 2; ++i) { vN0[i] = has_next ? S.a_voff(nxt, Rr[i], Cc[i]) : vA0[i]; vN1[i] = has_next ? S.a_voff(nxt, HALF + Rr[i], Cc[i]) : vA1[i]; }
        for (int t = 0; t < nt; t += 2) {
            const bool last = (t == nt - 2);
            if constexpr (RSC) { if (t == 4) E.rowscale(acc, cur, wr, fr); }
            const char* a1 = cA + (size_t)(t + 1) * kstep;
            const char* a2 = last ? nA : cA + (size_t)(t + 2) * kstep; const char* b2 = last ? nB : cB + (size_t)(t + 2) * kstep;
            const char* a3 = a2 + kstep; const char* b3 = b2 + kstep;
            unsigned w0[2], w1[2];
#pragma unroll
            for (int i = 0; i < 2; ++i) { w0[i] = last ? vN0[i] : vA0[i]; w1[i] = last ? vN1[i] : vA1[i]; }
            PG8_LDB(B0, 0, 0); PG8_LDB(B1, 0, 1); PG8_SCHED; PG8_LDA(At, 0, 0); PG8_STAGE(PG8_SA(1, 1), a1, vA1);
            PG8_WAIT_V(8); PG8_WAIT_L(0); PG8_BAR; PG8_MMA(0, 0, At, B0); PG8_MMA(0, 1, At, B1); PG8_BAR; PG8_SCHED;
            PG8_LDA(At, 0, 1); PG8_STAGE(PG8_SB(0, 0), b2, voffB); PG8_STAGE(PG8_SB(0, 1), b2 + hstep, voffB); PG8_STAGE(PG8_SA(0, 0), a2, w0);
            PG8_WAIT_V(8); PG8_WAIT_L(0); PG8_BAR; PG8_MMA(1, 0, At, B0); PG8_MMA(1, 1, At, B1); PG8_BAR; PG8_SCHED;
            PG8_LDB(B0, 1, 0); PG8_LDB(B1, 1, 1); PG8_SCHED; PG8_LDA(At, 1, 0); PG8_STAGE(PG8_SA(0, 1), a2, w1);
            PG8_WAIT_V(8); PG8_WAIT_L(0); PG8_BAR; PG8_MMA(0, 0, At, B0); PG8_MMA(0, 1, At, B1); PG8_BAR; PG8_SCHED;
            PG8_LDA(At, 1, 1); PG8_STAGE(PG8_SB(1, 0), b3, voffB); PG8_STAGE(PG8_SB(1, 1), b3 + hstep, voffB); PG8_STAGE(PG8_SA(1, 0), a3, w0);
            PG8_WAIT_V(8); PG8_WAIT_L(0); PG8_BAR; PG8_MMA(1, 0, At, B0); PG8_MMA(1, 1, At, B1); PG8_BAR; PG8_SCHED;
        }
        if (wr == 0) PG8_BAR;
        E(acc, cur, wr, wc, fr, fq);
        if (!has_next) break;
#pragma unroll
        for (int a = 0; a < 2; ++a)
#pragma unroll
            for (int b = 0; b < 2; ++b)
#pragma unroll
                for (int m = 0; m < 4; ++m)
#pragma unroll
                    for (int n = 0; n < 2; ++n) acc[a][b][m][n] = (f32x4){0.f, 0.f, 0.f, 0.f};
        cur = nxt; cA = nA; cB = nB; ++ui;
#pragma unroll
        for (int i = 0; i < 2; ++i) { vA0[i] = vN0[i]; vA1[i] = vN1[i]; }
        if (wr == 1) PG8_BAR;
    }
    PG8_WAIT_V(0);
    PG8_BAR;
#undef PG8_SA
#undef PG8_SB
#undef PG8_STAGE
#undef PG8_LDA
#undef PG8_LDB
#undef PG8_MMA
#undef PG8_WAIT_V
#undef PG8_WAIT_L
#undef PG8_BAR
#undef PG8_SCHED
}
}
struct Args { const void* in[32]; float* out; unsigned char* ws; int l_lo, l_hi, ph_lo, ph_hi, fused, pad; };
enum { PH_PRO = 0, PH_NORM0 = 1, PH_G1 = 2, PH_MIX = 3, PH_A1 = 4, PH_A2 = 5, PH_AN = 6, PH_G2 = 7, PH_ROUTE = 8, PH_UP = 9, PH_DOWN = 10, PH_COMB = 11, PH_END = 12 };

typedef const Args __attribute__((address_space(4))) KArgs;
__device__ __forceinline__ KArgs* kargs() { KArgs* p = (KArgs*)__builtin_amdgcn_kernarg_segment_ptr(); asm volatile("" : "+s"(p)); return p; }
#define IN_F(i) ((const float*)ka->in[i])
enum { I_X = 0, I_C, I_POS, I_WADA, I_BADA, I_NORM1, I_WIN, I_QN, I_KN, I_CONVW, I_CONVB, I_CLNG, I_CLNB, I_PWW, I_PWB, I_POOLW, I_POOLB, I_POOLS, I_SLNG, I_SLNB, I_SGUW, I_SGUB,
       I_ONORM, I_WOUT, I_NORM2, I_WRG, I_BRG, I_WRE, I_BRE, I_WG, I_WU, I_WD };

__device__ __forceinline__ void sincos_d(double a, double& s, double& c) {
    const double k = rint(a * 0.63661977236758134308);
    const double r = (a - k * 1.57079632679489655800) - k * 6.123233995736766036e-17;
    const double r2 = r * r;
    const double sp = r * (1.0 + r2 * (-1.0 / 6 + r2 * (1.0 / 120 + r2 * (-1.0 / 5040 + r2 * (1.0 / 362880 + r2 * (-1.0 / 39916800 + r2 * (1.0 / 6227020800.0)))))));
    const double cp = 1.0 + r2 * (-0.5 + r2 * (1.0 / 24 + r2 * (-1.0 / 720 + r2 * (1.0 / 40320 + r2 * (-1.0 / 3628800 + r2 * (1.0 / 479001600.0 + r2 * (-1.0 / 87178291200.0)))))));
    const int q = ((int)k) & 3;
    if (q == 0) { s = sp; c = cp; } else if (q == 1) { s = cp; c = -sp; } else if (q == 2) { s = -sp; c = -cp; } else { s = -cp; c = sp; }
}

__device__ __forceinline__ bf16_t f2bf_(float f) { return (bf16_t)(cvt_pk_bf16(f, 0.f) & 0xffffu); }
struct TItem { const float* src; int ld; int ncol; bf16_t* dst; int ldd; const float* rsc; };
constexpr int NT_WIN = L * 36 * 4, NT_WOUT = L * 16 * 4, NT_PW = L * 4, NT_WGU = L * NE * 16 * 4, NT_WD = L * NE * 16 * 2;
constexpr int NT_ALL = NT_WIN + NT_WOUT + NT_PW + NT_WGU + NT_WD;
__device__ __forceinline__ void decode_titem(int it, const Args& a, TItem& t) {
    KArgs* ka = kargs();
    unsigned char* ws = ka->ws;
    t.rsc = nullptr;
    if (it < NT_WIN) {
        const int l = it / 144, r = it % 144, n0 = (r >> 2) * 64, k0 = (r & 3) * 256;
        const int c0 = n0 < 768 ? n0 + 256 : (n0 < 2048 ? n0 + 164 : n0 - 2048);
        t.ncol = (n0 < 768) ? ((n0 + 64 <= 676) ? 64 : (n0 < 676 ? 676 - n0 : 0)) : 64;
        t.src = IN_F(I_WIN) + ((size_t)l * D + k0) * DIN + c0; t.ld = DIN;
        t.dst = (bf16_t*)(ws + WS_WINT) + ((size_t)l * NP + n0) * D + k0; t.ldd = D; return;
    }
    it -= NT_WIN;
    if (it < NT_WOUT) {
        const int l = it / 64, r = it % 64, n0 = (r >> 2) * 64, k0 = (r & 3) * 256;
        t.ncol = 64; t.src = IN_F(I_WOUT) + ((size_t)l * D + k0) * D + n0; t.ld = D; t.rsc = (k0 == 0) ? IN_F(I_ONORM) + l * D : nullptr;
        t.dst = (bf16_t*)(ws + WS_WOUTT) + ((size_t)l * D + n0) * D + k0; t.ldd = D; return;
    }
    it -= NT_WOUT;
    if (it < NT_PW) {
        const int l = it / 4, n0 = (it & 3) * 64;
        t.ncol = 64; t.src = IN_F(I_PWW) + (size_t)l * 65536 + n0; t.ld = 256;
        t.dst = (bf16_t*)(ws + WS_PWT) + ((size_t)l * 256 + n0) * 256; t.ldd = 256; return;
    }
    it -= NT_PW;
    if (it < NT_WGU) {
        const int le = it / 64, r = it % 64, n0 = (r >> 2) * 64, k0 = (r & 3) * 256;
        const int pn = n0 >> 8, rr = n0 & 255;
        const float* W = (rr < 128) ? IN_F(I_WG) : IN_F(I_WU);
        t.ncol = 64; t.src = W + ((size_t)le * D + k0) * F + pn * 128 + (rr & 127); t.ld = F;
        t.dst = (bf16_t*)(ws + WS_WGUT) + ((size_t)le * 1024 + n0) * D + k0; t.ldd = D; return;
    }
    it -= NT_WGU;
    {
        const int le = it / 32, r = it % 32, n0 = (r >> 1) * 64, k0 = (r & 1) * 256;
        t.ncol = 64; t.src = IN_F(I_WD) + ((size_t)le * F + k0) * D + n0; t.ld = D;
        t.dst = (bf16_t*)(ws + WS_WDT) + ((size_t)le * D + n0) * F + k0; t.ldd = F;
    }
}
__device__ __forceinline__ void titem_load(const TItem& t, int tid, float4 (&v)[8]) {
    const int c4 = tid & 15, r0 = tid >> 4;
#pragma unroll
    for (int i = 0; i < 8; ++i) v[i] = (c4 * 4 < t.ncol) ? *(const float4*)(t.src + (size_t)(r0 + 32 * i) * t.ld + c4 * 4) : make_float4(0.f, 0.f, 0.f, 0.f);
    if (t.rsc) {
#pragma unroll
        for (int i = 0; i < 8; ++i) { const float s = t.rsc[r0 + 32 * i]; v[i].x *= s; v[i].y *= s; v[i].z *= s; v[i].w *= s; }
    }
}
__device__ __forceinline__ void phase_prologue(const Args& a, LAS unsigned char* lds, int vcu, int G) {
    KArgs* ka = kargs();
    const int tid = opaque_tid(), wid = __builtin_amdgcn_readfirstlane(tid >> 6), lane = tid & 63;
    LAS float* T = (LAS float*)lds;
    LAS float* cs = (LAS float*)(lds + 66560);
    LAS float* red = (LAS float*)(lds + 66560 + 16384);
    unsigned char* ws = ka->ws;
    if (vcu < 192) {
        for (int i = tid; i < 4096; i += NTHR) cs[i] = silu_f(IN_F(I_C)[i]);
        __syncthreads();
        for (int it = vcu; it < 192; it += G) {
            const int l = it / 96, j0 = (it % 96) * 64;
            const float* wp = IN_F(I_WADA) + ((size_t)l * D + wid * 128) * 6144 + j0 + lane;
            float a0 = 0.f, a1 = 0.f, a2 = 0.f, a3 = 0.f;
#pragma unroll 32
            for (int k = 0; k < 128; ++k) { const float wv = wp[(size_t)k * 6144]; const int kk = wid * 128 + k; a0 += cs[kk] * wv; a1 += cs[1024 + kk] * wv; a2 += cs[2048 + kk] * wv; a3 += cs[3072 + kk] * wv; }
            red[(wid * 4 + 0) * 64 + lane] = a0; red[(wid * 4 + 1) * 64 + lane] = a1; red[(wid * 4 + 2) * 64 + lane] = a2; red[(wid * 4 + 3) * 64 + lane] = a3;
            __syncthreads();
            if (wid < 4) { float s = 0.f;
#pragma unroll
                for (int w = 0; w < 8; ++w) s += red[(w * 4 + wid) * 64 + lane];
                ((float*)(ws + WS_MOD))[((size_t)l * 4 + wid) * 6144 + j0 + lane] = s + IN_F(I_BADA)[l * 6144 + j0 + lane]; }
            __syncthreads();
        }
    }
    for (int i = vcu * NTHR + tid; i < NTOK; i += G * NTHR) {
        const float invA[8] = {1.0f, 0.1939227432012558f, 0.03760603070259094f, 0.007292664609849453f, 0.0014142135623842478f, 0.00027424818836152554f, 5.318296098266728e-05f, 1.0313386155758053e-05f};
        const float invI[4] = {1.0f, 0.03760603070259094f, 0.0014142135623842478f, 5.318296098266728e-05f};
        const float p = (float)((const int*)ka->in[I_POS])[i];
        float* ra = (float*)(ws + WS_ROPEA) + (size_t)i * 16; float* ri = (float*)(ws + WS_ROPEI) + (size_t)i * 8;
#pragma unroll
        for (int j = 0; j < 8; ++j) { const float ang = p * invA[j]; double s, c; sincos_d((double)ang, s, c); ra[j] = (float)c; ra[8 + j] = (float)s; }
#pragma unroll
        for (int j = 0; j < 4; ++j) { const float ang = p * invI[j]; double s, c; sincos_d((double)ang, s, c); ri[j] = (float)c; ri[4 + j] = (float)s; }
    }
    for (int i = vcu * NTHR + tid; i < L * 4 * 128 * 128; i += G * NTHR) { const int s = i & 127, t = (i >> 7) & 127; ((bf16_t*)(ws + WS_SGUW))[i] = (bf16_t)(cvt_pk_bf16(s <= t ? IN_F(I_SGUW)[i] : 0.f, 0.f) & 0xffffu); }
    for (int i = vcu * NTHR + tid; i < L * 4 * 64 * 64; i += G * NTHR) { const int c = i & 63, d = (i >> 6) & 63, lg = i >> 12; ((bf16_t*)(ws + WS_POOLT))[i] = (bf16_t)(cvt_pk_bf16(IN_F(I_POOLW)[((size_t)lg * 64 + c) * 64 + d], 0.f) & 0xffffu); }
    for (int i = vcu * NTHR + tid; i < L * 48 * 1024; i += G * NTHR) {
        const int k = i & 1023, n = (i >> 10) % 48, lg = i / (48 * 1024);
        const float w = (n < 4) ? IN_F(I_WRG)[((size_t)lg * D + k) * 4 + n] : (n < 36) ? IN_F(I_WRE)[((size_t)lg * D + k) * 32 + (n - 4)] : 0.f;
        const unsigned hi = cvt_pk_bf16(w, 0.f) & 0xffffu; const float lo = w - __uint_as_float(hi << 16);
        bf16_t* dst = (bf16_t*)(ws + WS_WHL) + (size_t)lg * 2 * 48 * 1024 + (size_t)n * 1024 + k;
        dst[0] = (bf16_t)hi; dst[48 * 1024] = f2bf_(lo);
    }
    int it = (G - 1 - vcu);
    bool have = it < NT_ALL;
    TItem cur; cur.src = nullptr; cur.ld = 0; cur.ncol = 0; cur.dst = nullptr; cur.ldd = 0; cur.rsc = nullptr;
    float4 v[8];
    if (have) { decode_titem(it, a, cur); titem_load(cur, tid, v); }
    while (have) {
        { const int c4 = tid & 15, r0 = tid >> 4;
#pragma unroll
          for (int i = 0; i < 8; ++i) { LAS float* tp = T + (r0 + 32 * i) * 65 + c4 * 4; tp[0] = v[i].x; tp[1] = v[i].y; tp[2] = v[i].z; tp[3] = v[i].w; } }
        __syncthreads();
        const int itn = it + G; const bool hn = itn < NT_ALL; TItem nx = cur;
        if (hn) { decode_titem(itn, a, nx); titem_load(nx, tid, v); }
        { const int n = tid >> 3, kq = tid & 7;
#pragma unroll
          for (int j = 0; j < 4; ++j) { const int kc = j * 8 + kq; float f[8];
#pragma unroll
              for (int jj = 0; jj < 8; ++jj) f[jj] = T[(kc * 8 + jj) * 65 + n];
              u32x4 w; w.x = cvt_pk_bf16(f[0], f[1]); w.y = cvt_pk_bf16(f[2], f[3]); w.z = cvt_pk_bf16(f[4], f[5]); w.w = cvt_pk_bf16(f[6], f[7]);
              *(u32x4*)(cur.dst + (size_t)n * cur.ldd + kc * 8) = w; } }
        __syncthreads();
        cur = nx; it = itn; have = hn;
    }
}

__device__ __forceinline__ void phase_norm(const float* __restrict__ xin, const float* g, const float* shift, const float* scale, bf16_t* __restrict__ out, int vcu, int G) {
    const int tid = opaque_tid(), wid = __builtin_amdgcn_readfirstlane(tid >> 6), lane = tid & 63;
    for (int rb = vcu * 8 + wid; rb < NTOK / 8; rb += G * 8) {
        const int row0 = rb * 8, b = row0 / S;
        float4 A[4], C[4];
#pragma unroll
        for (int i = 0; i < 4; ++i) { const int k = 256 * i + 4 * lane; const float4 gv = *(const float4*)(g + k), sc = *(const float4*)(scale + (size_t)b * 6144 + k); C[i] = *(const float4*)(shift + (size_t)b * 6144 + k);
            A[i] = make_float4(gv.x * (1.f + sc.x), gv.y * (1.f + sc.y), gv.z * (1.f + sc.z), gv.w * (1.f + sc.w)); }
#pragma unroll 4
        for (int rr = 0; rr < 8; ++rr) {
            const size_t ro = (size_t)(row0 + rr) * D;
            float4 x[4]; float ss = 0.f;
#pragma unroll
            for (int i = 0; i < 4; ++i) { x[i] = *(const float4*)(xin + ro + 256 * i + 4 * lane); ss += x[i].x * x[i].x + x[i].y * x[i].y + x[i].z * x[i].z + x[i].w * x[i].w; }
            const float r = rsqrtf(wave_sum(ss) * (1.0f / D) + EPS);
#pragma unroll
            for (int i = 0; i < 4; ++i) { u32x2 w; w.x = cvt_pk_bf16(x[i].x * r * A[i].x + C[i].x, x[i].y * r * A[i].y + C[i].y); w.y = cvt_pk_bf16(x[i].z * r * A[i].z + C[i].z, x[i].w * r * A[i].w + C[i].w);
                *(u32x2*)(out + ro + 256 * i + 4 * lane) = w; }
        }
    }
}

__device__ __forceinline__ f32x4 mfma16r(const bf16x8 a, const bf16x8 b, const f32x4 c) { return __builtin_amdgcn_mfma_f32_16x16x32_bf16(a, b, c, 0, 0, 0); }
__device__ __forceinline__ void phase_rbias(const Args& a, LAS unsigned char* lds, int vcu, int G) {
    KArgs* ka = kargs();
    const int tid = opaque_tid();
    LAS float* red = (LAS float*)lds;
    for (int v = vcu; v < 256; v += G) {
        const int lb = v & 7, sl = v >> 3, l = lb >> 2, b = lb & 3, n = tid & 63, kp = tid >> 6;
        const float* sh = (const float*)(ka->ws + WS_MOD) + ((size_t)l * 4 + b) * 6144 + 3072;
        float s = 0.f;
        if (n < 36) {
#pragma unroll
            for (int i = 0; i < 4; ++i) { const int k = sl * 32 + kp * 4 + i; s += sh[k] * ((n < 4) ? IN_F(I_WRG)[((size_t)l * D + k) * 4 + n] : IN_F(I_WRE)[((size_t)l * D + k) * 32 + (n - 4)]); }
        }
        red[kp * 64 + n] = s;
        __syncthreads();
        if (tid < 48) { float t = 0.f;
            if (tid < 36) { for (int w = 0; w < 8; ++w) t += red[w * 64 + tid]; }
            ((float*)(ka->ws + WS_RBIAS))[((size_t)lb * 32 + sl) * 48 + tid] = t; }
        __syncthreads();
    }
}

__device__ __forceinline__ void phase_route(const Args& a, int l, LAS unsigned char* lds, int vcu, int G) {
    KArgs* ka = kargs();
    const int tid = opaque_tid(), wid = __builtin_amdgcn_readfirstlane(tid >> 6), lane = tid & 63, fr = lane & 15, kq = lane >> 4;
    unsigned char* ws = ka->ws;
    const bf16_t* x1 = (const bf16_t*)(ws + WS_X1);
    const float* mod = (const float*)(ws + WS_MOD) + (size_t)l * 4 * 6144;
    const float* g = IN_F(I_NORM2) + l * D; const float* shift = mod + 3072; const float* scale = mod + 4096;
    bf16_t* out = (bf16_t*)(ws + WS_HA);
    int* counts = (int*)(ws + WS_CNT) + l * NE * 64; int* list = (int*)(ws + WS_LIST); float* lgate = (float*)(ws + WS_LGATE); int* tokinfo = (int*)(ws + WS_TOKINFO);
    LAS int* lcnt = (LAS int*)(lds + LDS_MISC + 1024); LAS int* lbase = lcnt + 32; LAS int* rte = lbase + 32; LAS int* rtp = rte + 128; LAS int* rtt = rtp + 128; LAS float* rtg = (LAS float*)(rtt + 128);
#ifdef MK_ROUTE_PROBE
    if (a.pad) { counts = (int*)(ws + WS_CNT) + 4096 + l * NE * 64; unsigned char* sc = ws + ((size_t)440 << 20); out = (bf16_t*)sc; list = (int*)(sc + ((size_t)34 << 20)); lgate = (float*)(sc + ((size_t)37 << 20)); tokinfo = (int*)(sc + ((size_t)40 << 20)); }
#endif
    LAS float* part = (LAS float*)lds;
    LAS float* ssp = part + 8 * 16 * 48;
    LAS float* lgt = ssp + 8 * 16;
    LAS float* rrow = lgt + 16 * 48;
    const bf16_t* wh = (const bf16_t*)(ws + WS_WHL) + (size_t)l * 2 * 48 * 1024 + (size_t)fr * 1024 + 128 * wid + 8 * kq;
    LAS float* rb = (LAS float*)(lds + LDS_MISC + 8192);
    for (int r0 = vcu * 64; r0 < NTOK; r0 += G * 64) {
        const int b = r0 / S;
        if (tid < 48) { const float* rp = (const float*)(ws + WS_RBIAS) + ((size_t)(l * 4 + b) * 32) * 48 + tid; float t = 0.f;
            for (int sl = 0; sl < 32; ++sl) t += rp[sl * 48];
            if (tid < 36) t += (tid < 4) ? IN_F(I_BRG)[l * 4 + tid] : IN_F(I_BRE)[l * 32 + tid - 4];
            rb[tid] = t; }
        if (tid < 32) lcnt[tid] = 0;
#pragma unroll 1
        for (int q4 = 0; q4 < 4; ++q4) {
            float t[4][8];
            f32x4 acc[3];
#pragma unroll
            for (int nt = 0; nt < 3; ++nt) acc[nt] = (f32x4){0.f, 0.f, 0.f, 0.f};
            float ss = 0.f;
            const int row = r0 + 16 * q4 + fr;
#pragma unroll
            for (int ks = 0; ks < 4; ++ks) {
                const int k0 = 128 * wid + 32 * ks + 8 * kq;
                const f32x4 g0 = *(const f32x4*)(g + k0), g1 = *(const f32x4*)(g + k0 + 4), s0 = *(const f32x4*)(scale + (size_t)b * 6144 + k0), s1 = *(const f32x4*)(scale + (size_t)b * 6144 + k0 + 4);
                const float Ac[8] = {g0[0] * (1.f + s0[0]), g0[1] * (1.f + s0[1]), g0[2] * (1.f + s0[2]), g0[3] * (1.f + s0[3]), g1[0] * (1.f + s1[0]), g1[1] * (1.f + s1[1]), g1[2] * (1.f + s1[2]), g1[3] * (1.f + s1[3])};
                const u32x4 xw = *(const u32x4*)(x1 + (size_t)row * D + k0);
                const float v[8] = {bflo(xw.x), bfhi(xw.x), bflo(xw.y), bfhi(xw.y), bflo(xw.z), bfhi(xw.z), bflo(xw.w), bfhi(xw.w)};
                unsigned ph[4], pl[4];
#pragma unroll
                for (int j = 0; j < 8; ++j) { ss += v[j] * v[j]; t[ks][j] = v[j] * Ac[j]; }
#pragma unroll
                for (int j = 0; j < 4; ++j) { ph[j] = cvt_pk_bf16(t[ks][2 * j], t[ks][2 * j + 1]); pl[j] = cvt_pk_bf16(t[ks][2 * j] - bflo(ph[j]), t[ks][2 * j + 1] - bfhi(ph[j])); }
                const bf16x8 Ah = __builtin_bit_cast(bf16x8, (u32x4){ph[0], ph[1], ph[2], ph[3]}), Al = __builtin_bit_cast(bf16x8, (u32x4){pl[0], pl[1], pl[2], pl[3]});
#pragma unroll
                for (int nt = 0; nt < 3; ++nt) {
                    const bf16x8 Bh = *(const bf16x8*)(wh + (size_t)(16 * nt) * 1024 + 32 * ks), Bl = *(const bf16x8*)(wh + 48 * 1024 + (size_t)(16 * nt) * 1024 + 32 * ks);
                    acc[nt] = mfma16r(Ah, Bh, acc[nt]); acc[nt] = mfma16r(Al, Bh, acc[nt]); acc[nt] = mfma16r(Ah, Bl, acc[nt]);
                }
            }
            ss += __shfl_xor(ss, 16); ss += __shfl_xor(ss, 32);
            if (kq == 0) ssp[wid * 16 + fr] = ss;
#pragma unroll
            for (int nt = 0; nt < 3; ++nt)
#pragma unroll
                for (int r = 0; r < 4; ++r) part[(wid * 16 + 4 * kq + r) * 48 + 16 * nt + fr] = acc[nt][r];
            __syncthreads();
            for (int i = tid; i < 16 * 48; i += NTHR) { float s = 0.f;
#pragma unroll
                for (int w = 0; w < 8; ++w) s += part[w * 16 * 48 + i];
                lgt[i] = s; }
            if (tid < 16) { float s = 0.f;
#pragma unroll
                for (int w = 0; w < 8; ++w) s += ssp[w * 16 + tid];
                rrow[tid] = rsqrtf(s * (1.0f / D) + EPS); }
            __syncthreads();
            if (tid < 16) {
                const int tok = r0 + 16 * q4 + tid; const float r = rrow[tid];
                float ag[4];
#pragma unroll
                for (int j = 0; j < 4; ++j) ag[j] = r * lgt[tid * 48 + j] + rb[j];
                int gi = 0; float gm = ag[0];
#pragma unroll
                for (int j = 1; j < 4; ++j) if (ag[j] > gm) { gm = ag[j]; gi = j; }
                float den = 0.f;
#pragma unroll
                for (int j = 0; j < 4; ++j) den += expf(ag[j] - gm);
                const float p_sel = 1.0f / den;
                float el[8];
#pragma unroll
                for (int j = 0; j < 8; ++j) el[j] = r * lgt[tid * 48 + 4 + gi * 8 + j] + rb[4 + gi * 8 + j];
                int j0 = 0; float v0 = el[0];
#pragma unroll
                for (int j = 1; j < 8; ++j) if (el[j] > v0) { v0 = el[j]; j0 = j; }
                int j1 = 0; float v1 = -INFINITY;
#pragma unroll
                for (int j = 0; j < 8; ++j) if (j != j0 && el[j] > v1) { v1 = el[j]; j1 = j; }
                const float e1 = expf(v1 - v0);
                const float g0 = p_sel / (1.0f + e1), g1 = p_sel * e1 / (1.0f + e1);
                const int ex0 = gi * 8 + j0, ex1 = gi * 8 + j1, ai = (16 * q4 + tid) * 2;
                const int p0 = __hip_atomic_fetch_add(lcnt + ex0, 1, __ATOMIC_RELAXED, __HIP_MEMORY_SCOPE_WORKGROUP), p1 = __hip_atomic_fetch_add(lcnt + ex1, 1, __ATOMIC_RELAXED, __HIP_MEMORY_SCOPE_WORKGROUP);
                rte[ai] = ex0; rtp[ai] = p0; rtt[ai] = tok; rtg[ai] = g0;
                rte[ai + 1] = ex1; rtp[ai + 1] = p1; rtt[ai + 1] = tok; rtg[ai + 1] = g1;
            }
            {
                const float r = rrow[fr];
                bf16_t* op = out + (size_t)row * D + 128 * wid + 8 * kq;
#pragma unroll
                for (int ks = 0; ks < 4; ++ks) {
                    const float* cp = shift + (size_t)b * 6144 + 128 * wid + 32 * ks + 8 * kq;
                    const f32x4 c0 = *(const f32x4*)cp, c1 = *(const f32x4*)(cp + 4);
                    u32x4 w; w.x = cvt_pk_bf16(t[ks][0] * r + c0[0], t[ks][1] * r + c0[1]); w.y = cvt_pk_bf16(t[ks][2] * r + c0[2], t[ks][3] * r + c0[3]);
                    w.z = cvt_pk_bf16(t[ks][4] * r + c1[0], t[ks][5] * r + c1[1]); w.w = cvt_pk_bf16(t[ks][6] * r + c1[2], t[ks][7] * r + c1[3]);
                    *(u32x4*)(op + 32 * ks) = w;
                }
            }
            __syncthreads();
        }
        if (tid < 32) { const int c = lcnt[tid]; lbase[tid] = c ? atomicAdd(&counts[tid * 64], c) : 0; }
        __syncthreads();
        if (tid < 128) { const int e = rte[tid], pos = lbase[e] + rtp[tid], tk = rtt[tid];
            list[(size_t)e * NTOK + pos] = tk; lgate[(size_t)e * NTOK + pos] = rtg[tid];
            tokinfo[tk * 4 + (tid & 1) * 2] = e; tokinfo[tk * 4 + (tid & 1) * 2 + 1] = pos; }
        __syncthreads();
    }
}

__device__ __forceinline__ void moe_cum(const Args& a, int l, LAS unsigned char* lds) {
    KArgs* ka = kargs();
    LAS int* cum = (LAS int*)(lds + LDS_MISC + MISC_CUM); LAS int* cn = (LAS int*)(lds + LDS_MISC + MISC_CNT);
    const int* counts = (const int*)(ka->ws + WS_CNT) + l * NE * 64;
    const int tq = opaque_tid();
    if (tq < 33) { int s = 0; for (int j = 0; j < tq; ++j) s += (ld_agent(counts + j * 64) + 255) >> 8; cum[tq] = s; if (tq < 32) cn[tq] = ld_agent(counts + tq * 64); }
    __syncthreads();
}

__device__ __forceinline__ void phase_combine(const Args& a, int l, LAS unsigned char* lds, int vcu, int G) {
    KArgs* ka = kargs();
    const int tid = opaque_tid(), wid = __builtin_amdgcn_readfirstlane(tid >> 6), lane = tid & 63;
    unsigned char* ws = ka->ws;
    moe_cum(a, l, lds);
    const LAS int* cum = (const LAS int*)(lds + LDS_MISC + MISC_CUM);
    const bf16_t* __restrict__ x1 = (const bf16_t*)(ws + WS_X1);
    bf16_t* __restrict__ xnext = (bf16_t*)(ws + WS_X1) + (size_t)NTOK * D;
    const float* mod = (const float*)(ws + WS_MOD) + (size_t)l * 4 * 6144;
    const float* gate2 = mod + 5120;
    const bf16_t* __restrict__ Y = (const bf16_t*)(ws + WS_Y);
    const int* __restrict__ tokinfo = (const int*)(ws + WS_TOKINFO);
    float* __restrict__ outp = ka->out;
    const bool nextl = (l + 1 < L);
    const float* modn = (const float*)(ws + WS_MOD) + (size_t)(nextl ? l + 1 : l) * 4 * 6144;
    const float* gn = IN_F(I_NORM1) + (nextl ? l + 1 : l) * D;
    bf16_t* __restrict__ hout = (bf16_t*)(ws + WS_HA);
    for (int rb = vcu * 8 + wid; rb < NTOK / 8; rb += G * 8) {
        const int row0 = rb * 8, b = row0 / S;
        float4 A[4], C[4], G2[4];
#pragma unroll
        for (int i = 0; i < 4; ++i) { const int k = 256 * i + 4 * lane; const float4 gv = *(const float4*)(gn + k), sc = *(const float4*)(modn + 1024 + (size_t)b * 6144 + k); C[i] = *(const float4*)(modn + (size_t)b * 6144 + k);
            A[i] = make_float4(gv.x * (1.f + sc.x), gv.y * (1.f + sc.y), gv.z * (1.f + sc.z), gv.w * (1.f + sc.w)); G2[i] = *(const float4*)(gate2 + (size_t)b * 6144 + k); }
#pragma unroll 4
        for (int rr = 0; rr < 8; ++rr) {
            const int tok = row0 + rr; const size_t ro = (size_t)tok * D;
            const int4 ti = *(const int4*)(tokinfo + tok * 4);
            const size_t s0 = (size_t)(cum[ti.x] * 256 + ti.y) * D, s1 = (size_t)(cum[ti.z] * 256 + ti.w) * D;
            float4 xo[4]; float ss = 0.f;
#pragma unroll
            for (int i = 0; i < 4; ++i) { const int k = 256 * i + 4 * lane; const u32x2 xw = *(const u32x2*)(x1 + ro + k); const float4 xv = make_float4(bflo(xw.x), bfhi(xw.x), bflo(xw.y), bfhi(xw.y)); const u32x2 y0 = *(const u32x2*)(Y + s0 + k), y1 = *(const u32x2*)(Y + s1 + k);
                xo[i].x = xv.x + G2[i].x * (bflo(y0.x) + bflo(y1.x)); xo[i].y = xv.y + G2[i].y * (bfhi(y0.x) + bfhi(y1.x)); xo[i].z = xv.z + G2[i].z * (bflo(y0.y) + bflo(y1.y)); xo[i].w = xv.w + G2[i].w * (bfhi(y0.y) + bfhi(y1.y));
                if (nextl) { u32x2 xb; xb.x = cvt_pk_bf16(xo[i].x, xo[i].y); xb.y = cvt_pk_bf16(xo[i].z, xo[i].w); *(u32x2*)(xnext + ro + k) = xb; } else *(float4*)(outp + ro + k) = xo[i];
                ss += xo[i].x * xo[i].x + xo[i].y * xo[i].y + xo[i].z * xo[i].z + xo[i].w * xo[i].w; }
            if (nextl) {
                const float r = rsqrtf(wave_sum(ss) * (1.0f / D) + EPS);
#pragma unroll
                for (int i = 0; i < 4; ++i) { u32x2 w; w.x = cvt_pk_bf16(xo[i].x * r * A[i].x + C[i].x, xo[i].y * r * A[i].y + C[i].y); w.y = cvt_pk_bf16(xo[i].z * r * A[i].z + C[i].z, xo[i].w * r * A[i].w + C[i].w);
                    *(u32x2*)(hout + ro + 256 * i + 4 * lane) = w; }
            }
        }
    }
}
constexpr size_t WS_KN = WS_R2;
constexpr size_t WS_VT = WS_KN + al256c((size_t)NTOK * 256 * 2);
constexpr size_t WS_IKR = WS_VT + al256c((size_t)NTOK * 256 * 2);
constexpr size_t WS_MASK = WS_IKR + al256c((size_t)NTOK * 32 * 2);
constexpr size_t WS_OA = WS_MASK + al256c((size_t)NTOK * 128 * 4);
constexpr size_t WS_R3 = WS_OA + al256c((size_t)NTOK * 256 * 2);
constexpr size_t WS_MIXB = (WS_R3 > WS_Y + (size_t)SLOTS * D * 2 ? WS_R3 : WS_Y + al256c((size_t)SLOTS * D * 2));

__device__ __forceinline__ f32x4 mfma16(const bf16x8 a, const bf16x8 b, const f32x4 c) { return __builtin_amdgcn_mfma_f32_16x16x32_bf16(a, b, c, 0, 0, 0); }
__device__ __forceinline__ bf16_t f2bf(float f) { return (bf16_t)(cvt_pk_bf16(f, 0.f) & 0xffffu); }

__device__ __forceinline__ void rows_rms_store(const LAS float* YB, const float* gain, bf16_t* mixb, int tok0, int col0, int wid, int lane) {
    const f32x4 gv = *(const f32x4*)(gain + 4 * lane);
#pragma unroll 2
    for (int rr = 0; rr < 8; ++rr) {
        const int t = 8 * wid + rr;
        const f32x4 y = *(const LAS f32x4*)(YB + t * 260 + 4 * lane);
        const float ss = wave_sum(y[0] * y[0] + y[1] * y[1] + y[2] * y[2] + y[3] * y[3]);
        const float r = rsqrtf(ss * (1.0f / 256.0f) + EPS);
        u32x2 w; w.x = cvt_pk_bf16(y[0] * r * gv[0], y[1] * r * gv[1]); w.y = cvt_pk_bf16(y[2] * r * gv[2], y[3] * r * gv[3]);
        *(u32x2*)(mixb + (size_t)(tok0 + t) * D + col0 + 4 * lane) = w;
    }
}

__device__ __forceinline__ void item_pool(const Args& a, int l, int tile, LAS unsigned char* lds) {
    KArgs* ka = kargs();
    const int tid = opaque_tid(), wid = __builtin_amdgcn_readfirstlane(tid >> 6), lane = tid & 63;
    unsigned char* ws = ka->ws;
    const bf16_t* proj = (const bf16_t*)(ws + WS_PROJ);
    LAS bf16_t* P = (LAS bf16_t*)lds;
    LAS bf16_t* PA = (LAS bf16_t*)(lds + 40960);
    LAS float* YB = (LAS float*)(lds + 40960 + 33792);
    const int tok0 = tile * 64, b = tok0 / S, t0 = tok0 % S;
#pragma unroll
    for (int p = tid; p < 79 * 32; p += NTHR) {
        const int r = p >> 5, c8 = p & 31, t = t0 - 15 + r;
        u32x4 v = (u32x4){0u, 0u, 0u, 0u};
        if (t >= 0) v = *(const u32x4*)(proj + (size_t)(b * S + t) * NP + NC + c8 * 8);
        *(LAS u32x4*)(P + r * 256 + c8 * 8) = v;
    }
    __syncthreads();
    {
        const int c = tid & 255, half = tid >> 8, g = c >> 6, w = 2 << g, tt0 = half * 32;
        float run = 0.f;
        for (int jj = 1; jj < w; ++jj) run += bf2f(P[(15 + tt0 - jj) * 256 + c]);
        for (int i = 0; i < 32; ++i) {
            const int tt = tt0 + i, r = 15 + tt;
            const float pv = bf2f(P[r * 256 + c]);
            run += pv;
            const int tabs = t0 + tt, nn = (tabs + 1 < w) ? (tabs + 1) : w;
            PA[tt * 264 + c] = f2bf(run / (float)nn - pv);
            run -= bf2f(P[(r - w + 1) * 256 + c]);
        }
    }
    __syncthreads();
    {
        const int g = wid >> 1, mh = wid & 1, fr = lane & 15, fq = lane >> 4;
        const bf16_t* PT = (const bf16_t*)(ws + WS_POOLT) + (size_t)(l * 4 + g) * 64 * 64;
        f32x4 acc[2][4];
#pragma unroll
        for (int mi = 0; mi < 2; ++mi)
#pragma unroll
            for (int ni = 0; ni < 4; ++ni) acc[mi][ni] = (f32x4){0.f, 0.f, 0.f, 0.f};
#pragma unroll
        for (int ks = 0; ks < 2; ++ks) {
            bf16x8 A[2];
#pragma unroll
            for (int mi = 0; mi < 2; ++mi) A[mi] = *(const LAS bf16x8*)(PA + (16 * (2 * mh + mi) + fr) * 264 + g * 64 + 32 * ks + 8 * fq);
#pragma unroll
            for (int ni = 0; ni < 4; ++ni) { const bf16x8 Bf = *(const bf16x8*)(PT + (16 * ni + fr) * 64 + 32 * ks + 8 * fq);
#pragma unroll
                for (int mi = 0; mi < 2; ++mi) acc[mi][ni] = mfma16(A[mi], Bf, acc[mi][ni]); }
        }
        const float* pb = IN_F(I_POOLB) + l * 256; const float* ps = IN_F(I_POOLS) + l * 256;
#pragma unroll
        for (int ni = 0; ni < 4; ++ni) { const int d = g * 64 + 16 * ni + fr; const float bb = pb[d], sc = ps[d];
#pragma unroll
            for (int mi = 0; mi < 2; ++mi)
#pragma unroll
                for (int r = 0; r < 4; ++r) YB[(16 * (2 * mh + mi) + 4 * fq + r) * 260 + d] = (acc[mi][ni][r] + bb) * sc; }
    }
    __syncthreads();
    rows_rms_store(YB, IN_F(I_ONORM) + l * D + 512, (bf16_t*)(ws + WS_MIXB), tok0, 512, wid, lane);
    __syncthreads();
}

__device__ __forceinline__ void item_conv(const Args& a, int l, int tile, LAS unsigned char* lds) {
    KArgs* ka = kargs();
    const int tid = opaque_tid(), wid = __builtin_amdgcn_readfirstlane(tid >> 6), lane = tid & 63;
    unsigned char* ws = ka->ws;
    const bf16_t* proj = (const bf16_t*)(ws + WS_PROJ);
    LAS float* GL = (LAS float*)lds;
    LAS bf16_t* CA = (LAS bf16_t*)(lds + 96256);
    LAS float* YB = (LAS float*)lds;
    const int tok0 = tile * 64, b = tok0 / S, t0 = tok0 % S;
#pragma unroll
    for (int p = tid; p < 94 * 32; p += NTHR) {
        const int r = p >> 5, c8 = p & 31, t = t0 - 30 + r;
        f32x4 o0 = (f32x4){0.f, 0.f, 0.f, 0.f}, o1 = o0;
        if (t >= 0) {
            const bf16_t* pr = proj + (size_t)(b * S + t) * NP;
            const u32x4 av = *(const u32x4*)(pr + NBA + c8 * 8), gv = *(const u32x4*)(pr + NBG + c8 * 8);
            o0[0] = bflo(av.x) * sigmoid_fast(bflo(gv.x)); o0[1] = bfhi(av.x) * sigmoid_fast(bfhi(gv.x)); o0[2] = bflo(av.y) * sigmoid_fast(bflo(gv.y)); o0[3] = bfhi(av.y) * sigmoid_fast(bfhi(gv.y));
            o1[0] = bflo(av.z) * sigmoid_fast(bflo(gv.z)); o1[1] = bfhi(av.z) * sigmoid_fast(bfhi(gv.z)); o1[2] = bflo(av.w) * sigmoid_fast(bflo(gv.w)); o1[3] = bfhi(av.w) * sigmoid_fast(bfhi(gv.w));
        }
        *(LAS f32x4*)(GL + r * 256 + c8 * 8) = o0; *(LAS f32x4*)(GL + r * 256 + c8 * 8 + 4) = o1;
    }
    __syncthreads();
    {
        const int c = tid & 255, half = tid >> 8;
        float wv[31];
#pragma unroll
        for (int jj = 0; jj < 31; ++jj) wv[jj] = IN_F(I_CONVW)[((size_t)l * 31 + jj) * 256 + c];
        const float cb = IN_F(I_CONVB)[l * 256 + c];
        float yv[32];
#pragma unroll
        for (int ch = 0; ch < 8; ++ch) {
            const int tt = half * 32 + ch * 4;
            float x[34];
#pragma unroll
            for (int m2 = 0; m2 < 34; ++m2) x[m2] = GL[(tt + m2) * 256 + c];
#pragma unroll
            for (int i = 0; i < 4; ++i) {
                float y = cb;
#pragma unroll
                for (int jj = 0; jj < 31; ++jj) y += x[i + jj] * wv[jj];
                yv[ch * 4 + i] = y;
            }
        }
        __syncthreads();
#pragma unroll
        for (int i = 0; i < 32; ++i) YB[(half * 32 + i) * 260 + c] = yv[i];
    }
    __syncthreads();
    {
        const int t = tid >> 3, part = tid & 7;
        float y[32]; float s1 = 0.f;
#pragma unroll
        for (int i = 0; i < 8; ++i) { const f32x4 v = *(const LAS f32x4*)(YB + t * 260 + part * 32 + 4 * i); y[4 * i] = v[0]; y[4 * i + 1] = v[1]; y[4 * i + 2] = v[2]; y[4 * i + 3] = v[3]; s1 += (v[0] + v[1]) + (v[2] + v[3]); }
        s1 += dpp_f<0xB1>(s1);
        const float mu = s1 * (1.0f / 64.0f);
        float s2 = 0.f;
#pragma unroll
        for (int i = 0; i < 32; ++i) { y[i] -= mu; s2 += y[i] * y[i]; }
        s2 += dpp_f<0xB1>(s2);
        const float rs = rsqrtf(s2 * (1.0f / 64.0f) + EPS);
        const float* lng = IN_F(I_CLNG) + l * 256 + part * 32; const float* lnb = IN_F(I_CLNB) + l * 256 + part * 32;
#pragma unroll
        for (int i = 0; i < 4; ++i) {
            float o[8];
#pragma unroll
            for (int e = 0; e < 8; ++e) o[e] = silu_f(y[8 * i + e] * rs * lng[8 * i + e] + lnb[8 * i + e]);
            u32x4 w; w.x = cvt_pk_bf16(o[0], o[1]); w.y = cvt_pk_bf16(o[2], o[3]); w.z = cvt_pk_bf16(o[4], o[5]); w.w = cvt_pk_bf16(o[6], o[7]);
            *(LAS u32x4*)(CA + t * 264 + part * 32 + 8 * i) = w;
        }
    }
    __syncthreads();
    {
        const int fr = lane & 15, fq = lane >> 4;
        const bf16_t* PW = (const bf16_t*)(ws + WS_PWT) + (size_t)l * 65536;
        f32x4 acc[4][2];
#pragma unroll
        for (int mi = 0; mi < 4; ++mi)
#pragma unroll
            for (int ni = 0; ni < 2; ++ni) acc[mi][ni] = (f32x4){0.f, 0.f, 0.f, 0.f};
#pragma unroll 2
        for (int ks = 0; ks < 8; ++ks) {
            bf16x8 Bf[2];
#pragma unroll
            for (int ni = 0; ni < 2; ++ni) Bf[ni] = *(const bf16x8*)(PW + (size_t)(32 * wid + 16 * ni + fr) * 256 + 32 * ks + 8 * fq);
#pragma unroll
            for (int mi = 0; mi < 4; ++mi) { const bf16x8 Af = *(const LAS bf16x8*)(CA + (16 * mi + fr) * 264 + 32 * ks + 8 * fq);
#pragma unroll
                for (int ni = 0; ni < 2; ++ni) acc[mi][ni] = mfma16(Af, Bf[ni], acc[mi][ni]); }
        }
        const float* pwb = IN_F(I_PWB) + l * 256;
#pragma unroll
        for (int ni = 0; ni < 2; ++ni) { const int n = 32 * wid + 16 * ni + fr; const float bb = pwb[n];
#pragma unroll
            for (int mi = 0; mi < 4; ++mi)
#pragma unroll
                for (int r = 0; r < 4; ++r) YB[(16 * mi + 4 * fq + r) * 260 + n] = acc[mi][ni][r] + bb; }
    }
    __syncthreads();
    rows_rms_store(YB, IN_F(I_ONORM) + l * D + 256, (bf16_t*)(ws + WS_MIXB), tok0, 256, wid, lane);
    __syncthreads();
}

__device__ __forceinline__ void item_sgu(const Args& a, int l, int ch, LAS unsigned char* lds) {
    KArgs* ka = kargs();
    const int tid = opaque_tid(), wid = __builtin_amdgcn_readfirstlane(tid >> 6), lane = tid & 63;
    unsigned char* ws = ka->ws;
    const bf16_t* proj = (const bf16_t*)(ws + WS_PROJ);
    LAS bf16_t* VT = (LAS bf16_t*)lds;
    LAS bf16_t* OB = (LAS bf16_t*)(lds + 69632);
    const int tok0 = ch * 128;
    {
        const f32x4 lg = *(const f32x4*)(IN_F(I_SLNG) + l * 256 + 4 * lane), lb = *(const f32x4*)(IN_F(I_SLNB) + l * 256 + 4 * lane);
#pragma unroll 8
        for (int i = 0; i < 16; ++i) {
            const int s = 16 * wid + i;
            const u32x2 vv = *(const u32x2*)(proj + (size_t)(tok0 + s) * NP + NDV + 4 * lane);
            const float v0 = bflo(vv.x), v1 = bfhi(vv.x), v2 = bflo(vv.y), v3 = bfhi(vv.y);
            const float mu = wave_sum((v0 + v1) + (v2 + v3)) * (1.0f / 256.0f);
            const float d0 = v0 - mu, d1 = v1 - mu, d2 = v2 - mu, d3 = v3 - mu;
            const float rs = rsqrtf(wave_sum((d0 * d0 + d1 * d1) + (d2 * d2 + d3 * d3)) * (1.0f / 256.0f) + EPS);
            VT[(4 * lane + 0) * 136 + s] = f2bf(d0 * rs * lg[0] + lb[0]); VT[(4 * lane + 1) * 136 + s] = f2bf(d1 * rs * lg[1] + lb[1]);
            VT[(4 * lane + 2) * 136 + s] = f2bf(d2 * rs * lg[2] + lb[2]); VT[(4 * lane + 3) * 136 + s] = f2bf(d3 * rs * lg[3] + lb[3]);
        }
    }
    __syncthreads();
    {
        const int h = wid >> 1, np = wid & 1, fr = lane & 15, fq = lane >> 4;
        const bf16_t* W = (const bf16_t*)(ws + WS_SGUW) + (size_t)(l * 4 + h) * 128 * 128;
        const float* sb = IN_F(I_SGUB) + (l * 4 + h) * 128;
#pragma unroll 1
        for (int mi = 0; mi < 8; ++mi) {
            f32x4 acc[2] = {(f32x4){0.f, 0.f, 0.f, 0.f}, (f32x4){0.f, 0.f, 0.f, 0.f}};
            for (int ks = 0; ks <= (mi >> 1); ++ks) {
                const bf16x8 Af = *(const bf16x8*)(W + (size_t)(16 * mi + fr) * 128 + 32 * ks + 8 * fq);
#pragma unroll
                for (int ni = 0; ni < 2; ++ni) { const bf16x8 Bf = *(const LAS bf16x8*)(VT + (h * 64 + 32 * np + 16 * ni + fr) * 136 + 32 * ks + 8 * fq); acc[ni] = mfma16(Af, Bf, acc[ni]); }
            }
#pragma unroll
            for (int ni = 0; ni < 2; ++ni)
#pragma unroll
                for (int r = 0; r < 4; ++r) { const int t = 16 * mi + 4 * fq + r; OB[t * 264 + h * 64 + 32 * np + 16 * ni + fr] = f2bf(acc[ni][r] + sb[t]); }
        }
    }
    __syncthreads();
    {
        const f32x4 gv = *(const f32x4*)(IN_F(I_ONORM) + l * D + 768 + 4 * lane);
        bf16_t* mixb = (bf16_t*)(ws + WS_MIXB);
#pragma unroll 8
        for (int i = 0; i < 16; ++i) {
            const int t = 16 * wid + i;
            const u32x2 mv = *(const LAS u32x2*)(OB + t * 264 + 4 * lane);
            const u32x2 uv = *(const u32x2*)(proj + (size_t)(tok0 + t) * NP + NDU + 4 * lane);
            const float o0 = bflo(uv.x) * bflo(mv.x), o1 = bfhi(uv.x) * bfhi(mv.x), o2 = bflo(uv.y) * bflo(mv.y), o3 = bfhi(uv.y) * bfhi(mv.y);
            const float r = rsqrtf(wave_sum((o0 * o0 + o1 * o1) + (o2 * o2 + o3 * o3)) * (1.0f / 256.0f) + EPS);
            u32x2 w; w.x = cvt_pk_bf16(o0 * r * gv[0], o1 * r * gv[1]); w.y = cvt_pk_bf16(o2 * r * gv[2], o3 * r * gv[3]);
            *(u32x2*)(mixb + (size_t)(tok0 + t) * D + 768 + 4 * lane) = w;
        }
    }
    __syncthreads();
}

__device__ __forceinline__ void item_prepk(const Args& a, int l, int tile, LAS unsigned char* lds) {
    KArgs* ka = kargs();
    const int tid = opaque_tid(), wid = __builtin_amdgcn_readfirstlane(tid >> 6), lane = tid & 63;
    unsigned char* ws = ka->ws;
    const bf16_t* proj = (const bf16_t*)(ws + WS_PROJ);
    LAS bf16_t* VS = (LAS bf16_t*)lds;
    bf16_t* KN = (bf16_t*)(ws + WS_KN); bf16_t* VTg = (bf16_t*)(ws + WS_VT); bf16_t* IKR = (bf16_t*)(ws + WS_IKR);
    const float* ropeA = (const float*)(ws + WS_ROPEA); const float* ropeI = (const float*)(ws + WS_ROPEI);
    const int tok0 = tile * 64, b = tok0 / S, s0 = tok0 % S;
    const int li = lane & 15, head = lane >> 4;
    const f32x4 kg = *(const f32x4*)(IN_F(I_KN) + l * 64 + 4 * li);
#pragma unroll 4
    for (int i = 0; i < 8; ++i) {
        const int tl = 8 * wid + i, tok = tok0 + tl, s = s0 + tl;
        const bf16_t* pr = proj + (size_t)tok * NP;
        const u32x2 kv = *(const u32x2*)(pr + NK + 4 * lane);
        float k0 = bflo(kv.x), k1 = bfhi(kv.x), k2 = bflo(kv.y), k3 = bfhi(kv.y);
        float ss = (k0 * k0 + k1 * k1) + (k2 * k2 + k3 * k3);
        ss = row_sum16(ss);
        const float r = rsqrtf(ss * (1.0f / 64.0f) + EPS);
        k0 *= r * kg[0]; k1 *= r * kg[1]; k2 *= r * kg[2]; k3 *= r * kg[3];
        {
            const float p0 = __shfl_xor(k0, 2), p1 = __shfl_xor(k1, 2), p2 = __shfl_xor(k2, 2), p3 = __shfl_xor(k3, 2);
            if (li < 4) {
                const int dd = 4 * (li & 1);
                const f32x4 cs = *(const f32x4*)(ropeA + (size_t)tok * 16 + dd), sn = *(const f32x4*)(ropeA + (size_t)tok * 16 + 8 + dd);
                if (li < 2) { k0 = k0 * cs[0] - p0 * sn[0]; k1 = k1 * cs[1] - p1 * sn[1]; k2 = k2 * cs[2] - p2 * sn[2]; k3 = k3 * cs[3] - p3 * sn[3]; }
                else        { k0 = k0 * cs[0] + p0 * sn[0]; k1 = k1 * cs[1] + p1 * sn[1]; k2 = k2 * cs[2] + p2 * sn[2]; k3 = k3 * cs[3] + p3 * sn[3]; }
            }
        }
        u32x2 ko; ko.x = cvt_pk_bf16(k0, k1); ko.y = cvt_pk_bf16(k2, k3);
        *(u32x2*)(KN + ((size_t)((b * 4 + head) * 128 + (s >> 5)) * 32 + (s & 31)) * 64 + 4 * li) = ko;
        *(LAS u32x2*)(VS + tl * 256 + 4 * lane) = *(const u32x2*)(pr + NV + 4 * lane);
        if (lane < 8) {
            const u32x2 iv = *(const u32x2*)(pr + NIK + 4 * lane);
            float x0 = bflo(iv.x), x1 = bfhi(iv.x), x2 = bflo(iv.y), x3 = bfhi(iv.y);
            const float q0 = __shfl_xor(x0, 1), q1 = __shfl_xor(x1, 1), q2 = __shfl_xor(x2, 1), q3 = __shfl_xor(x3, 1);
            if (lane < 2) {
                const f32x4 cs = *(const f32x4*)(ropeI + (size_t)tok * 8), sn = *(const f32x4*)(ropeI + (size_t)tok * 8 + 4);
                if (lane == 0) { x0 = x0 * cs[0] - q0 * sn[0]; x1 = x1 * cs[1] - q1 * sn[1]; x2 = x2 * cs[2] - q2 * sn[2]; x3 = x3 * cs[3] - q3 * sn[3]; }
                else           { x0 = x0 * cs[0] + q0 * sn[0]; x1 = x1 * cs[1] + q1 * sn[1]; x2 = x2 * cs[2] + q2 * sn[2]; x3 = x3 * cs[3] + q3 * sn[3]; }
            }
            u32x2 io; io.x = cvt_pk_bf16(x0, x1); io.y = cvt_pk_bf16(x2, x3);
            *(u32x2*)(IKR + (size_t)tok * 32 + 4 * lane) = io;
        }
    }
    __syncthreads();
#pragma unroll
    for (int i = 0; i < 4; ++i) {
        const int p = tid + NTHR * i;
        const int h = p >> 9, ktl = (p >> 8) & 1, d = (p >> 2) & 63, part = p & 3;
        unsigned short e[8];
#pragma unroll
        for (int jj = 0; jj < 8; ++jj) { const int key = 4 * part + (jj & 3) + 16 * (jj >> 2); e[jj] = VS[(ktl * 32 + key) * 256 + h * 64 + d]; }
        u32x4 w; w.x = e[0] | ((unsigned)e[1] << 16); w.y = e[2] | ((unsigned)e[3] << 16); w.z = e[4] | ((unsigned)e[5] << 16); w.w = e[6] | ((unsigned)e[7] << 16);
        *(u32x4*)(VTg + ((size_t)((b * 4 + h) * 128 + (s0 >> 5) + ktl) * 64 + d) * 32 + 8 * part) = w;
    }
    __syncthreads();
}

__device__ __forceinline__ void phase_mix1(const Args& a, int l, LAS unsigned char* lds, int vcu, int G, int bx) {
    if (G == 256) {
        if (bx < 64) { item_conv(a, l, bx, lds); item_pool(a, l, bx, lds); }
        else {
            const int w = bx - 64;
            if (w < 128) item_sgu(a, l, w, lds);
            item_prepk(a, l, w, lds);
            item_conv(a, l, 64 + w, lds);
            if (w >= 128) item_prepk(a, l, 192 + (w - 128), lds);
            item_pool(a, l, 64 + w, lds);
        }
        return;
    }
    for (int it = vcu; it < 896; it += G) {
        if (it < 128) item_sgu(a, l, it, lds);
        else if (it < 384) item_conv(a, l, it - 128, lds);
        else if (it < 640) item_pool(a, l, it - 384, lds);
        else item_prepk(a, l, it - 640, lds);
    }
}
__device__ __forceinline__ f32x16 mfma32(const bf16x8 a, const bf16x8 b, const f32x16 c) { return __builtin_amdgcn_mfma_f32_32x32x16_bf16(a, b, c, 0, 0, 0); }
__device__ __forceinline__ unsigned mono_key(float f) { const unsigned u = __float_as_uint(f); return u ^ ((unsigned)((int)u >> 31) | 0x80000000u); }

__device__ __forceinline__ void a1_keys(const bf16x8 A0, const bf16x8 A1, const bf16x8 (&Bq)[4][2], const float (&cl)[4], unsigned (&key)[16]) {
    float sc[16];
#pragma unroll
    for (int r = 0; r < 16; ++r) sc[r] = 0.0f;
#pragma unroll
    for (int h = 0; h < 4; ++h) {
        f32x16 d;
#pragma unroll
        for (int r = 0; r < 16; ++r) d[r] = 0.f;
        d = mfma32(A0, Bq[h][0], d); d = mfma32(A1, Bq[h][1], d);
#pragma unroll
        for (int r = 0; r < 16; ++r) sc[r] += __builtin_amdgcn_fmed3f(d[r], 0.0f, cl[h]);
    }
#pragma unroll
    for (int r = 0; r < 16; ++r) key[r] = mono_key(sc[r]);
}

__device__ __forceinline__ unsigned wcode(unsigned key) {
    const int v = (int)(key >> 20);
    const int t = (key < 0x80000000u) ? (v < 1096 ? v : 1096) + 1901 : (v > 2999 ? v : 2999);
    const int c = t - 2864;
    return (unsigned)(c < 12 ? 12 : (c > 255 ? 255 : c));
}

#define A1_STREAM_BEGIN { \
    bf16x8 rA[4][2]; const int ntw_ = (nkt - wid + 7) >> 3; \
    _Pragma("unroll") for (int u_ = 0; u_ < 4; ++u_) { rA[u_][0] = Bq[0][0]; rA[u_][1] = Bq[0][0]; if (u_ < ntw_) { const size_t o_ = (size_t)(wid + 8 * u_) * 1024; rA[u_][0] = *(const bf16x8*)(ikl + o_); rA[u_][1] = *(const bf16x8*)(ikl + o_ + 16); } } \
    for (int i_ = 0; i_ < ntw_; i_ += 4) { \
        _Pragma("unroll") for (int u_ = 0; u_ < 4; ++u_) { if (i_ + u_ < ntw_) { \
            const bf16x8 cA0 = rA[u_][0], cA1 = rA[u_][1]; const int kt = wid + 8 * (i_ + u_); \
            if (i_ + u_ + 4 < ntw_) { const size_t o_ = (size_t)(kt + 32) * 1024; rA[u_][0] = *(const bf16x8*)(ikl + o_); rA[u_][1] = *(const bf16x8*)(ikl + o_ + 16); }
#define A1_STREAM_END } } } }

template <int KIND>
__device__ __forceinline__ void a1_pass(const bf16_t* ikl, int nkt, int wid, int q, int hh, const bf16x8 (&Bq)[4][2], const float (&cl)[4], LAS unsigned* hist, int sh, unsigned prefix, bool tieq, unsigned g16) {
    const unsigned dump = 256u * 32u + (unsigned)q;
    A1_STREAM_BEGIN
        unsigned key[16];
        a1_keys(cA0, cA1, Bq, cl, key);
#pragma unroll
        for (int r = 0; r < 16; ++r) {
            const int s = kt * 32 + (r & 3) + 8 * (r >> 2) + 4 * hh;
            unsigned digit; bool match;
            if (KIND == 0) { digit = key[r] >> 24; match = true; }
            else if (KIND == 1) { digit = (key[r] >> sh) & 255u; match = (key[r] >> (sh + 8)) == prefix; }
            else if (KIND == 2) { digit = 255u - (unsigned)(s >> 4); match = ((unsigned)tieq & (unsigned)(key[r] == prefix)) != 0u; }
            else if (KIND == 3) { digit = 15u - (unsigned)(s & 15); match = ((unsigned)tieq & (unsigned)(key[r] == prefix) & (unsigned)((unsigned)(s >> 4) == g16)) != 0u; }
            else { digit = wcode(key[r]); match = true; }
            const unsigned idx = match ? digit * 32u + (unsigned)q : dump;
            __hip_atomic_fetch_add(hist + idx, 1u, __ATOMIC_RELAXED, __HIP_MEMORY_SCOPE_WORKGROUP);
        }
    A1_STREAM_END
}

template <int MODE_CLASS>
__device__ __forceinline__ void a1_scan(LAS unsigned* hist, LAS unsigned* psum, LAS unsigned* qst, int tid, bool last) {
    const int sq = tid & 31, part = tid >> 5;
    const unsigned need = qst[32 + sq], pfx = qst[sq];
    unsigned local = 0u;
#pragma unroll
    for (int bb = 0; bb < 16; ++bb) local += hist[(16 * part + bb) * 32 + sq];
    psum[part * 32 + sq] = local;
    __syncthreads();
    unsigned above = 0u;
    for (int pp = part + 1; pp < 16; ++pp) above += psum[pp * 32 + sq];
    if (above < need && above + local >= need) {
        unsigned run = above;
        for (int bb = 15; bb >= 0; --bb) {
            const unsigned c = hist[(16 * part + bb) * 32 + sq];
            if (run + c >= need) {
                const unsigned bin = (unsigned)(16 * part + bb);
                if (MODE_CLASS == 0) { qst[sq] = (pfx << 8) | bin; qst[32 + sq] = need - run; qst[64 + sq] = c; if (last && need - run < c) qst[160] = 1u; }
                else if (MODE_CLASS == 1) { qst[128 + sq] = 255u - bin; qst[32 + sq] = need - run; qst[64 + sq] = 0xffffffffu; }
                else { qst[96 + sq] = qst[128 + sq] * 16u + (15u - bin); }
                break;
            }
            run += c;
        }
    }
}

constexpr int A1_HIST = 0, A1_PSUM = 257 * 32, A1_QST = A1_PSUM + 16 * 32, A1_MBUF = A1_QST + 6 * 32 + 32, A1_TBUF = A1_MBUF + 32 * 128;
constexpr int A1_CAPL = 16, A1_LKEY = A1_MBUF + 32 * 128, A1_LIDX = A1_LKEY + 512 * A1_CAPL, A1_PCNT = A1_LIDX + 512 * A1_CAPL, A1_CAP = 200;
__device__ __forceinline__ void a1_tile(const Args& a, int l, int b, int j, LAS unsigned char* lds) {
    KArgs* ka = kargs();
    const int tid = opaque_tid(), wid = __builtin_amdgcn_readfirstlane(tid >> 6), lane = tid & 63, q = lane & 31, hh = lane >> 5;
    unsigned char* ws = ka->ws;
    const bf16_t* proj = (const bf16_t*)(ws + WS_PROJ);
    const bf16_t* ikr = (const bf16_t*)(ws + WS_IKR) + (size_t)b * S * 32;
    const bf16_t* ikl = ikr + (lane & 31) * 32 + 8 * (lane >> 5);
    unsigned* maskg = (unsigned*)(ws + WS_MASK);
    LAS unsigned* L = (LAS unsigned*)lds;
    LAS unsigned* hist = L + A1_HIST; LAS unsigned* psum = L + A1_PSUM; LAS unsigned* qst = L + A1_QST; LAS unsigned* mbuf = L + A1_MBUF; LAS unsigned* tbuf = L + A1_TBUF;
    LAS unsigned* lkey = L + A1_LKEY; LAS unsigned* lidx = L + A1_LIDX; LAS unsigned* pcnt = L + A1_PCNT;
    const int t0 = j * 32, n = (t0 / 64 + 1) * 64, nkt = n / 32, nw = ((t0 / 128) + 1) * 4;
    if (n <= 256) {
        for (int i = tid; i < 32 * nw; i += NTHR) { const int qq = i / nw, w = i % nw; maskg[(size_t)(b * S + t0 + qq) * 128 + w] = (w < nkt) ? 0xffffffffu : 0u; }
        return;
    }
    bf16x8 Bq[4][2]; float cl[4];
    {
        const int tok = b * S + t0 + q;
        const bf16_t* pr = proj + (size_t)tok * NP;
        const f32x4 cs = *(const f32x4*)((const float*)(ws + WS_ROPEI) + (size_t)tok * 8), sn = *(const f32x4*)((const float*)(ws + WS_ROPEI) + (size_t)tok * 8 + 4);
#pragma unroll
        for (int h = 0; h < 4; ++h) {
            const float wsc = bf2f(pr[NIW + h]) * (0.5f * 0.17677669529663687f);
            cl[h] = (wsc > 0.f) ? INFINITY : -INFINITY;
#pragma unroll
            for (int ks = 0; ks < 2; ++ks) {
                const u32x4 raw = *(const u32x4*)(pr + NIQ + h * 32 + 16 * ks + 8 * hh);
                float v[8] = {bflo(raw.x), bfhi(raw.x), bflo(raw.y), bfhi(raw.y), bflo(raw.z), bfhi(raw.z), bflo(raw.w), bfhi(raw.w)};
                if (ks == 0 && hh == 0) {
#pragma unroll
                    for (int i = 0; i < 4; ++i) { const float x1 = v[i], x2 = v[i + 4]; v[i] = x1 * cs[i] - x2 * sn[i]; v[i + 4] = x2 * cs[i] + x1 * sn[i]; }
                }
                u32x4 pk; pk.x = cvt_pk_bf16(v[0] * wsc, v[1] * wsc); pk.y = cvt_pk_bf16(v[2] * wsc, v[3] * wsc); pk.z = cvt_pk_bf16(v[4] * wsc, v[5] * wsc); pk.w = cvt_pk_bf16(v[6] * wsc, v[7] * wsc);
                Bq[h][ks] = __builtin_bit_cast(bf16x8, pk);
            }
        }
    }
    {
        if (tid < 32) { qst[tid] = 0u; qst[32 + tid] = 256u; qst[64 + tid] = 0u; qst[96 + tid] = 4095u; qst[128 + tid] = 0u; }
        if (tid == 32) qst[160] = 0u;
        __syncthreads();
        for (int mode = 0; mode < 4; ++mode) {
            for (int i = tid; i < 257 * 32; i += NTHR) hist[i] = 0u;
            __syncthreads();
            const unsigned prefix = qst[q];
            const int sh = 24 - 8 * mode;
            if (mode == 0) a1_pass<0>(ikl, nkt, wid, q, hh, Bq, cl, hist, 0, 0u, false, 0u);
            else a1_pass<1>(ikl, nkt, wid, q, hh, Bq, cl, hist, sh, prefix, false, 0u);
            __syncthreads();
            a1_scan<0>(hist, psum, qst, tid, mode == 3);
            __syncthreads();
        }
        __syncthreads();
        {
            const unsigned T = qst[q];
            A1_STREAM_BEGIN
                unsigned key[16];
                a1_keys(cA0, cA1, Bq, cl, key);
                unsigned wb = 0u, tb = 0u;
#pragma unroll
                for (int r = 0; r < 16; ++r) {
                    const int row = (r & 3) + 8 * (r >> 2) + 4 * hh;
                    wb |= (key[r] > T) ? (1u << row) : 0u;
                    tb |= (key[r] == T) ? (1u << row) : 0u;
                }
                wb |= (unsigned)__shfl_xor((int)wb, 32); tb |= (unsigned)__shfl_xor((int)tb, 32);
                if (hh == 0) { mbuf[q * 128 + kt] = wb; tbuf[q * 128 + kt] = tb; }
            A1_STREAM_END
        }
        __syncthreads();
        for (int i = tid; i < 32 * nkt; i += NTHR) { const int qq = i / nkt, w = i % nkt; if (qst[32 + qq] >= qst[64 + qq]) mbuf[qq * 128 + w] |= tbuf[qq * 128 + w]; }
        if (tid < 32 && qst[32 + tid] < qst[64 + tid]) {
            unsigned rem = qst[32 + tid];
            for (int w = 0; w < nkt && rem; ++w) {
                unsigned t = tbuf[tid * 128 + w]; const unsigned c = (unsigned)__builtin_popcount(t);
                if (c <= rem) { mbuf[tid * 128 + w] |= t; rem -= c; }
                else { unsigned keep = 0u; for (; rem; --rem) { const unsigned low = t & (0u - t); keep |= low; t ^= low; } mbuf[tid * 128 + w] |= keep; }
            }
        }
    }
    __syncthreads();
    for (int i = tid; i < 32 * nw; i += NTHR) { const int qq = i / nw, w = i % nw; maskg[(size_t)(b * S + t0 + qq) * 128 + w] = (w < nkt) ? mbuf[qq * 128 + w] : 0u; }
    __syncthreads();
}
__device__ __forceinline__ void phase_a1(const Args& a, int l, LAS unsigned char* lds, int vcu, int G) {
    KArgs* ka = kargs();
    for (int it = vcu; it < 256; it += G) { const int b = it >> 6, jj = it & 63; a1_tile(a, l, b, 127 - jj, lds); a1_tile(a, l, b, jj, lds); }
}

__device__ __forceinline__ void a2_unit(const Args& a, int l, int b, int h, int blk, LAS unsigned char* lds) {
    KArgs* ka = kargs();
    const int tid = opaque_tid(), wid = __builtin_amdgcn_readfirstlane(tid >> 6), lane = tid & 63, fr = lane & 15, kq = lane >> 4;
    unsigned char* ws = ka->ws;
    const bf16_t* proj = (const bf16_t*)(ws + WS_PROJ);
    const char* KNb = (const char*)(ws + WS_KN) + (size_t)(b * 4 + h) * 128 * 4096;
    const char* VTb = (const char*)(ws + WS_VT) + (size_t)(b * 4 + h) * 128 * 4096;
    LAS unsigned char* Kb = lds;
    LAS unsigned char* Vb = lds + 32768;
    LAS float* Ob = (LAS float*)(lds + 65536) + wid * (16 * 68);
    const int nsteps = 2 * (blk + 1);
    const int tokq = b * S + blk * 128 + wid * 16 + fr;
    bf16x8 Qb[2]; float C2;
    {
        const float* qg = IN_F(I_QN) + l * 64; const float* kg = IN_F(I_KN) + l * 64;
        float gq = 0.f, gk = 0.f;
        for (int i = 0; i < 64; ++i) { gq = fmaxf(gq, fabsf(qg[i])); gk = fmaxf(gk, fabsf(kg[i])); }
        C2 = 8.0f * gq * gk * 1.4426950408889634f;
        const bf16_t* pr = proj + (size_t)tokq * NP + NQ + h * 64;
        float v[2][8]; float ss = 0.f;
#pragma unroll
        for (int ks = 0; ks < 2; ++ks) { const u32x4 raw = *(const u32x4*)(pr + 32 * ks + 8 * kq);
            v[ks][0] = bflo(raw.x); v[ks][1] = bfhi(raw.x); v[ks][2] = bflo(raw.y); v[ks][3] = bfhi(raw.y); v[ks][4] = bflo(raw.z); v[ks][5] = bfhi(raw.z); v[ks][6] = bflo(raw.w); v[ks][7] = bfhi(raw.w);
#pragma unroll
            for (int i = 0; i < 8; ++i) ss += v[ks][i] * v[ks][i]; }
        ss += __shfl_xor(ss, 16); ss += __shfl_xor(ss, 32);
        const float r = rsqrtf(ss * (1.0f / 64.0f) + EPS);
#pragma unroll
        for (int ks = 0; ks < 2; ++ks)
#pragma unroll
            for (int i = 0; i < 8; ++i) v[ks][i] *= r * qg[32 * ks + 8 * kq + i];
        {
            const float* ra = (const float*)(ws + WS_ROPEA) + (size_t)tokq * 16;
#pragma unroll
            for (int i = 0; i < 8; ++i) { const float pv = __shfl_xor(v[0][i], 16); const float c = ra[i], s = ra[8 + i];
                if (kq == 0) v[0][i] = v[0][i] * c - pv * s; else if (kq == 1) v[0][i] = v[0][i] * c + pv * s; }
        }
        const float qs = 0.125f * 1.4426950408889634f;
#pragma unroll
        for (int ks = 0; ks < 2; ++ks) { u32x4 pk; pk.x = cvt_pk_bf16(v[ks][0] * qs, v[ks][1] * qs); pk.y = cvt_pk_bf16(v[ks][2] * qs, v[ks][3] * qs); pk.z = cvt_pk_bf16(v[ks][4] * qs, v[ks][5] * qs); pk.w = cvt_pk_bf16(v[ks][6] * qs, v[ks][7] * qs);
            Qb[ks] = __builtin_bit_cast(bf16x8, pk); }
    }
    const unsigned* mrow = (const unsigned*)(ws + WS_MASK) + (size_t)tokq * 128;
    f32x4 O[4];
#pragma unroll
    for (int dt = 0; dt < 4; ++dt) O[dt] = (f32x4){0.f, 0.f, 0.f, 0.f};
    float lsum = 0.f;
    const unsigned bit0 = 1u << (4 * kq);
    const int kkey = tid >> 3, kch = tid & 7, vsub = tid >> 8, vd = (tid >> 2) & 63, vch = tid & 3;
    const int klds = kkey * 128 + ((kch ^ (kkey & 7)) * 16), vlds = vsub * 4096 + vd * 64 + ((vch ^ ((vd >> 2) & 3)) * 16);
    u32x4 kr0, kr1, kr2, kr3, vr0, vr1, vr2, vr3; u32x2 mw0, mw1, mw2, mw3;
#define A2_LOAD(j, st_) do { kr##j = *(const u32x4*)(KNb + (size_t)(st_) * 8192 + (size_t)tid * 16); vr##j = *(const u32x4*)(VTb + (size_t)(st_) * 8192 + (size_t)tid * 16); mw##j = *(const u32x2*)(mrow + 2 * (st_)); } while (0)
    A2_LOAD(0, 0); A2_LOAD(1, 1);
    if (nsteps > 2) { A2_LOAD(2, 2); A2_LOAD(3, 3); } else { kr2 = kr0; vr2 = vr0; mw2 = mw0; kr3 = kr0; vr3 = vr0; mw3 = mw0; }
    __syncthreads();
#define A2_HALF(Kc, Vc, mcur) do { \
        _Pragma("unroll") for (int sub = 0; sub < 2; ++sub) { \
            const unsigned m = sub ? (mcur).y : (mcur).x; \
            f32x4 Sx[2]; \
            _Pragma("unroll") for (int tl = 0; tl < 2; ++tl) { \
                const int key = 32 * sub + 16 * tl + fr; \
                const bf16x8 A0 = *(const LAS bf16x8*)((Kc) + key * 128 + (((0 + kq) ^ (key & 7)) * 16)); \
                const bf16x8 A1 = *(const LAS bf16x8*)((Kc) + key * 128 + (((4 + kq) ^ (key & 7)) * 16)); \
                f32x4 z = (f32x4){-C2, -C2, -C2, -C2};     \
                z = mfma16(A0, Qb[0], z); Sx[tl] = mfma16(A1, Qb[1], z); \
            } \
            float p[8]; \
            _Pragma("unroll") for (int r = 0; r < 4; ++r) { \
                const float e0 = __builtin_amdgcn_exp2f(Sx[0][r]), e1 = __builtin_amdgcn_exp2f(Sx[1][r]); \
                p[r] = (m & (bit0 << r)) ? e0 : 0.f; p[4 + r] = (m & (bit0 << (16 + r))) ? e1 : 0.f; \
            } \
            lsum += ((p[0] + p[1]) + (p[2] + p[3])) + ((p[4] + p[5]) + (p[6] + p[7])); \
            u32x4 pk; pk.x = cvt_pk_bf16(p[0], p[1]); pk.y = cvt_pk_bf16(p[2], p[3]); pk.z = cvt_pk_bf16(p[4], p[5]); pk.w = cvt_pk_bf16(p[6], p[7]); \
            const bf16x8 Pf = __builtin_bit_cast(bf16x8, pk); \
            _Pragma("unroll") for (int dt = 0; dt < 4; ++dt) { const int d = 16 * dt + fr; \
                const bf16x8 Av = *(const LAS bf16x8*)((Vc) + sub * 4096 + d * 64 + ((kq ^ ((d >> 2) & 3)) * 16)); \
                O[dt] = mfma16(Av, Pf, O[dt]); } \
        } } while (0)
#define A2_STEP2(ja, jb, s2_) do { \
        LAS unsigned char* Kc2 = Kb + ((s2_) & 1) * 16384; LAS unsigned char* Vc2 = Vb + ((s2_) & 1) * 16384; \
        *(LAS u32x4*)(Kc2 + klds) = kr##ja; *(LAS u32x4*)(Vc2 + vlds) = vr##ja; *(LAS u32x4*)(Kc2 + 8192 + klds) = kr##jb; *(LAS u32x4*)(Vc2 + 8192 + vlds) = vr##jb; \
        const u32x2 mcA = mw##ja, mcB = mw##jb; \
        __syncthreads(); \
        if (2 * (s2_) + 4 < nsteps) A2_LOAD(ja, 2 * (s2_) + 4); \
        if (2 * (s2_) + 5 < nsteps) A2_LOAD(jb, 2 * (s2_) + 5); \
        A2_HALF(Kc2, Vc2, mcA); A2_HALF(Kc2 + 8192, Vc2 + 8192, mcB); \
    } while (0)
    for (int s2 = 0; 2 * s2 < nsteps; s2 += 2) {
        A2_STEP2(0, 1, s2);
        if (2 * (s2 + 1) < nsteps) A2_STEP2(2, 3, s2 + 1);
    }
#undef A2_STEP2
#undef A2_HALF
#undef A2_LOAD
    lsum += __shfl_xor(lsum, 16); lsum += __shfl_xor(lsum, 32);
    const float inv = 1.0f / lsum;
#pragma unroll
    for (int dt = 0; dt < 4; ++dt)
#pragma unroll
        for (int r = 0; r < 4; ++r) Ob[fr * 68 + 16 * dt + 4 * kq + r] = O[dt][r] * inv;
    __syncthreads();
    {
        const int qq = lane >> 2, dp = (lane & 3) * 16;
        const LAS float* src = Ob + qq * 68 + dp;
        float f[16]; float sq = 0.f;
#pragma unroll
        for (int i = 0; i < 4; ++i) { const f32x4 t = *(const LAS f32x4*)(src + 4 * i); f[4 * i] = t[0]; f[4 * i + 1] = t[1]; f[4 * i + 2] = t[2]; f[4 * i + 3] = t[3]; sq += (t[0] * t[0] + t[1] * t[1]) + (t[2] * t[2] + t[3] * t[3]); }
        u32x4 w0, w1; w0.x = cvt_pk_bf16(f[0], f[1]); w0.y = cvt_pk_bf16(f[2], f[3]); w0.z = cvt_pk_bf16(f[4], f[5]); w0.w = cvt_pk_bf16(f[6], f[7]);
        w1.x = cvt_pk_bf16(f[8], f[9]); w1.y = cvt_pk_bf16(f[10], f[11]); w1.z = cvt_pk_bf16(f[12], f[13]); w1.w = cvt_pk_bf16(f[14], f[15]);
        const int tok = b * S + blk * 128 + wid * 16 + qq;
        bf16_t* op = (bf16_t*)(ws + WS_MIXB) + (size_t)tok * D + h * 64 + dp;
        *(u32x4*)op = w0; *(u32x4*)(op + 8) = w1;
        sq += dpp_f<0xB1>(sq); sq += dpp_f<0x4E>(sq);
        if ((lane & 3) == 0) ((float*)(ws + WS_SSQ))[((size_t)l * NTOK + tok) * 4 + h] = sq;
    }
    __syncthreads();
}
__device__ __forceinline__ void phase_a2(const Args& a, int l, LAS unsigned char* lds, int vcu, int G) {
    KArgs* ka = kargs();
    for (int it = vcu; it < 256; it += G) { const int b = it >> 6, h = (it >> 4) & 3, jj = it & 15; a2_unit(a, l, b, h, 31 - jj, lds); a2_unit(a, l, b, h, jj, lds); }
}
__device__ __forceinline__ void phase_anorm(const Args& a, int l, int vcu, int G) {
    KArgs* ka = kargs();
    const int tid = opaque_tid(), wid = __builtin_amdgcn_readfirstlane(tid >> 6), lane = tid & 63;
    const bf16_t* oa = (const bf16_t*)(ka->ws + WS_OA); bf16_t* mixb = (bf16_t*)(ka->ws + WS_HA);
    const f32x4 gv = *(const f32x4*)(IN_F(I_ONORM) + l * D + 4 * lane);
    for (int tok = vcu * 8 + wid; tok < NTOK; tok += G * 8) {
        const u32x2 v = *(const u32x2*)(oa + (size_t)tok * 256 + 4 * lane);
        const float o0 = bflo(v.x), o1 = bfhi(v.x), o2 = bflo(v.y), o3 = bfhi(v.y);
        const float r = rsqrtf(wave_sum((o0 * o0 + o1 * o1) + (o2 * o2 + o3 * o3)) * (1.0f / 256.0f) + EPS);
        u32x2 w; w.x = cvt_pk_bf16(o0 * r * gv[0], o1 * r * gv[1]); w.y = cvt_pk_bf16(o2 * r * gv[2], o3 * r * gv[3]);
        *(u32x2*)(mixb + (size_t)tok * D + 4 * lane) = w;
    }
}
__global__ void __launch_bounds__(NTHR, 2) mk_fwd(Args a) {
    extern __shared__ __attribute__((aligned(16))) unsigned char lds_raw[];
    LAS unsigned char* lds = (LAS unsigned char*)lds_raw;
    const int tid = threadIdx.x, G = gridDim.x, bx = blockIdx.x;
    const int vcu = (G % 8 == 0) ? (bx % 8) * (G / 8) + bx / 8 : bx;
    if (tid < 64) ((LAS unsigned*)(lds + LDS_MISC))[tid] = 0u;
    __syncthreads();
    XcdBarrier bar; bar.bar = (unsigned*)(a.ws + WS_BAR); bar.x = 0; bar.st = nullptr;
    if (a.fused) bar = xcd_barrier_post((unsigned*)(a.ws + WS_BAR), (volatile LAS unsigned*)(lds + LDS_MISC + MISC_BAR));
#define GRID_BAR() do { if (a.fused) xcd_barrier(bar); } while (0)
#ifdef ONLY_PH
#define IN(k) ((k) == ONLY_PH && a.ph_lo <= (k) && (k) < a.ph_hi)
#else
#define IN(k) (a.ph_lo <= (k) && (k) < a.ph_hi)
#endif
    if (IN(PH_PRO)) { phase_prologue(a, lds, vcu, G); GRID_BAR(); }
    if (IN(PH_NORM0)) { KArgs* ka = kargs(); unsigned char* ws = ka->ws; float* modp = (float*)(ws + WS_MOD); phase_norm(IN_F(I_X), IN_F(I_NORM1), modp, modp + 1024, (bf16_t*)(ws + WS_HA), vcu, G); phase_rbias(a, lds, vcu, G); GRID_BAR(); }
    for (int l = a.l_lo; l < a.l_hi; ++l) {
        if (IN(PH_G1)) {
            KArgs* ka = kargs(); unsigned char* ws = ka->ws;
            pg8::DenseOrder S; S.init((const bf16_t*)(ws + WS_HA), (const bf16_t*)(ws + WS_WINT) + (size_t)l * NP * D, NTOK, (G == 256) ? NP - 256 : NP, D, G, bx);
            pg8::EpiBf16 E{(bf16_t*)(ws + WS_PROJ), NP};
            pg8::gemm_phase(lds, S, E);
            GRID_BAR();
        }
        if (IN(PH_MIX)) {
            if (G == 256 && bx < 64) {
                KArgs* ka = kargs(); unsigned char* ws = ka->ws;
                pg8::DenseOrder S; S.init((const bf16_t*)(ws + WS_HA), (const bf16_t*)(ws + WS_WINT) + (size_t)l * NP * D + (size_t)(NP - 256) * D, NTOK, 256, D, 64, bx);
                pg8::EpiBf16 E{(bf16_t*)(ws + WS_PROJ) + (NP - 256), NP};
                pg8::gemm_phase(lds, S, E);
            }
            phase_mix1(a, l, lds, vcu, G, bx); GRID_BAR();
        }
        if (IN(PH_A1)) { phase_a1(a, l, lds, vcu, G); GRID_BAR(); }
        if (IN(PH_A2)) { phase_a2(a, l, lds, vcu, G); GRID_BAR(); }
        if (IN(PH_G2)) {
            KArgs* ka = kargs(); unsigned char* ws = ka->ws; const float* xin = IN_F(I_X); const bf16_t* xinb = (l == 0) ? (const bf16_t*)nullptr : (const bf16_t*)(ws + WS_X1) + (size_t)NTOK * D; const float* mod = (const float*)(ws + WS_MOD) + (size_t)l * 4 * 6144;
            pg8::DenseOrder S; S.init((const bf16_t*)(ws + WS_MIXB), (const bf16_t*)(ws + WS_WOUTT) + (size_t)l * D * D, NTOK, D, D, G, bx);
            pg8::EpiResid E{xin, xinb, (bf16_t*)(ws + WS_X1), mod + 2048, (const float*)(ws + WS_SSQ) + (size_t)l * NTOK * 4};
            pg8::gemm_phase<pg8::EpiResid, pg8::DenseOrder, true>(lds, S, E);
            GRID_BAR();
        }
        if (IN(PH_ROUTE)) { phase_route(a, l, lds, vcu, G); GRID_BAR(); }
        if (IN(PH_UP)) {
            KArgs* ka = kargs(); unsigned char* ws = ka->ws;
            moe_cum(a, l, lds);
            pg8::MoeOrder<true> S; S.A = (const bf16_t*)(ws + WS_HA); S.Bt = (const bf16_t*)(ws + WS_WGUT) + (size_t)l * NE * 1024 * 1024; S.K = D; S.bstride = (size_t)1024 * 1024;
            S.list = (const int*)(ws + WS_LIST); S.cum = (const LAS int*)(lds + LDS_MISC + MISC_CUM); S.cnts = (const LAS int*)(lds + LDS_MISC + MISC_CNT); S.G = G; S.c = vcu; S.nun = S.cum[32] * 4;
            pg8::EpiHid E{(bf16_t*)(ws + WS_HID)};
            pg8::gemm_phase(lds, S, E);
            GRID_BAR();
        }
        if (IN(PH_DOWN)) {
            KArgs* ka = kargs(); unsigned char* ws = ka->ws;
            moe_cum(a, l, lds);
            pg8::MoeOrder<false> S; S.A = (const bf16_t*)(ws + WS_HID); S.Bt = (const bf16_t*)(ws + WS_WDT) + (size_t)l * NE * 1024 * 512; S.K = F; S.bstride = (size_t)1024 * 512;
            S.list = nullptr; S.cum = (const LAS int*)(lds + LDS_MISC + MISC_CUM); S.cnts = (const LAS int*)(lds + LDS_MISC + MISC_CNT); S.G = G; S.c = vcu; S.nun = S.cum[32] * 4;
            pg8::EpiDown E{(bf16_t*)(ws + WS_Y), (const float*)(ws + WS_LGATE)};
            pg8::gemm_phase(lds, S, E);
            GRID_BAR();
        }
        if (IN(PH_COMB)) { phase_combine(a, l, lds, vcu, G); GRID_BAR(); }
    }
#undef IN
#undef GRID_BAR
}


static void launch_ph(const Args& base, int grid, int l_lo, int l_hi, int ph_lo, int ph_hi, int fused, hipStream_t stream) {
    Args a = base; a.l_lo = l_lo; a.l_hi = l_hi; a.ph_lo = ph_lo; a.ph_hi = ph_hi; a.fused = fused; a.pad = 0;
    hipLaunchKernelGGL(mk_fwd, dim3(grid), dim3(NTHR), LDS_BYTES, stream, a);
}

extern "C" void kernel_launch(void* const* d_in, const int* in_sizes, int n_in, void* d_out, int out_size, void* d_ws, size_t ws_size, hipStream_t stream) {
    static int grid = 0;
    if (grid == 0) {
        int dev = 0, cus = 0;
        if (hipGetDevice(&dev) != hipSuccess || hipDeviceGetAttribute(&cus, hipDeviceAttributeMultiprocessorCount, dev) != hipSuccess) { grid = -1; return; }
        if (hipFuncSetAttribute((const void*)mk_fwd, hipFuncAttributeMaxDynamicSharedMemorySize, LDS_BYTES) != hipSuccess) { fprintf(stderr, "hipFuncSetAttribute failed\n"); grid = -1; return; }
        (void)hipGetLastError();
        grid = cus;
    }
    if (grid < 0) return;
    unsigned char* ws = (unsigned char*)d_ws;
    (void)hipMemsetAsync(ws, 0, WS_ZERO_BYTES, stream);
    Args a{};
    for (int i = 0; i < 32; ++i) a.in[i] = d_in[i];
    a.out = (float*)d_out; a.ws = ws;
#ifdef MK_MULTI
    launch_ph(a, grid, 0, 0, PH_PRO, PH_PRO + 1, 0, stream);
#ifdef MK_REP
    if (MK_REP == PH_PRO) launch_ph(a, grid, 0, 0, PH_PRO, PH_PRO + 1, 0, stream);
#endif
    launch_ph(a, grid, 0, 0, PH_NORM0, PH_NORM0 + 1, 0, stream);
#ifdef MK_REP
    if (MK_REP == PH_NORM0) launch_ph(a, grid, 0, 0, PH_NORM0, PH_NORM0 + 1, 0, stream);
#endif
    for (int l = 0; l < L; ++l)
        for (int ph = PH_G1; ph < PH_END; ++ph) {
            launch_ph(a, grid, l, l + 1, ph, ph + 1, 0, stream);
#ifdef MK_REP
            if (ph == MK_REP) launch_ph(a, grid, l, l + 1, ph, ph + 1, 0, stream);
#endif
#ifdef MK_ROUTE_PROBE
            if (ph == PH_ROUTE) { Args a2 = a; a2.l_lo = l; a2.l_hi = l + 1; a2.ph_lo = ph; a2.ph_hi = ph + 1; a2.fused = 0; a2.pad = 1; hipLaunchKernelGGL(mk_fwd, dim3(grid), dim3(NTHR), LDS_BYTES, stream, a2); }
#endif
        }
#else
    launch_ph(a, grid, 0, L, PH_PRO, PH_END, 1, stream);
#endif
}
```

```cpp
#include <hip/hip_runtime.h>
#include <stdint.h>
#include <stdio.h>

#define LAS __attribute__((address_space(3)))
typedef unsigned short bf16_t;
typedef short bf16x8 __attribute__((ext_vector_type(8)));
typedef float f32x4 __attribute__((ext_vector_type(4)));
typedef float f32x16 __attribute__((ext_vector_type(16)));
typedef unsigned u32x4 __attribute__((ext_vector_type(4)));
typedef unsigned u32x2 __attribute__((ext_vector_type(2)));

constexpr int Bn = 4, S = 4096, D = 1024, L = 2, NTOK = Bn * S, DIN = 2212, F = 512, NE = 32;
constexpr int NP = 2304;
constexpr int NK = 0, NV = 256, NIQ = 512, NIK = 640, NIW = 672, NBA = 768, NBG = 1024, NC = 1280, NDU = 1536, NDV = 1792, NQ = 2048;
constexpr float EPS = 1e-6f;
constexpr int NTHR = 512;
constexpr int SLOTS = 40960;

constexpr int LDS_BYTES = 163840, LDS_MISC = 147456;
constexpr int MISC_BAR = 0;
constexpr int MISC_CUM = 64;
constexpr int MISC_CNT = 64 + 160;

constexpr size_t al256c(size_t v) { return (v + 255) & ~(size_t)255; }
constexpr size_t WS_BAR = 0;
constexpr size_t WS_CNT = 16384;
constexpr size_t WS_ZERO_BYTES = 16384 + 32768;
constexpr size_t WS_MOD = WS_ZERO_BYTES;
constexpr size_t WS_ROPEA = WS_MOD + al256c((size_t)L * 4 * 6144 * 4);
constexpr size_t WS_ROPEI = WS_ROPEA + al256c((size_t)NTOK * 16 * 4);
constexpr size_t WS_LIST = WS_ROPEI + al256c((size_t)NTOK * 8 * 4);
constexpr size_t WS_LGATE = WS_LIST + al256c((size_t)NE * NTOK * 4);
constexpr size_t WS_TOKINFO = WS_LGATE + al256c((size_t)NE * NTOK * 4);
constexpr size_t WS_SGUW = WS_TOKINFO + al256c((size_t)NTOK * 16);
constexpr size_t WS_POOLT = WS_SGUW + al256c((size_t)L * 4 * 128 * 128 * 2);
constexpr size_t WS_WHL = WS_POOLT + al256c((size_t)L * 4 * 64 * 64 * 2);
constexpr size_t WS_RBIAS = WS_WHL + al256c((size_t)L * 2 * 48 * 1024 * 2);
constexpr size_t WS_SSQ = WS_RBIAS + al256c((size_t)L * 4 * 32 * 48 * 4);
constexpr size_t WS_WINT = WS_SSQ + al256c((size_t)L * NTOK * 4 * 4);
constexpr size_t WS_WOUTT = WS_WINT + al256c((size_t)L * NP * D * 2);
constexpr size_t WS_PWT = WS_WOUTT + al256c((size_t)L * D * D * 2);
constexpr size_t WS_WGUT = WS_PWT + al256c((size_t)L * 256 * 256 * 2);
constexpr size_t WS_WDT = WS_WGUT + al256c((size_t)L * NE * 1024 * 1024 * 2);
constexpr size_t WS_HA = WS_WDT + al256c((size_t)L * NE * 1024 * 512 * 2);
constexpr size_t WS_X1 = WS_HA + al256c((size_t)NTOK * D * 2);
constexpr size_t WS_R = WS_X1 + al256c((size_t)NTOK * D * 4);
constexpr size_t WS_PROJ = WS_R;
constexpr size_t WS_R2 = WS_PROJ + al256c((size_t)NTOK * NP * 2);
constexpr size_t WS_HID = WS_R;
constexpr size_t WS_Y = WS_HID + al256c((size_t)SLOTS * F * 2);

__device__ __forceinline__ unsigned cvt_pk_bf16(float lo, float hi) { unsigned r; asm volatile("v_cvt_pk_bf16_f32 %0, %1, %2" : "=v"(r) : "v"(lo), "v"(hi)); return r; }
__device__ __forceinline__ float bf2f(bf16_t v) { return __uint_as_float(((unsigned)v) << 16); }
__device__ __forceinline__ float bflo(unsigned w) { return __uint_as_float(w << 16); }
__device__ __forceinline__ float bfhi(unsigned w) { return __uint_as_float(w & 0xffff0000u); }
template <int CTRL> __device__ __forceinline__ float dpp_f(float v) { return __builtin_bit_cast(float, __builtin_amdgcn_update_dpp(0, __builtin_bit_cast(int, v), CTRL, 0xF, 0xF, true)); }
__device__ __forceinline__ float row_sum16(float v) {
    v += dpp_f<0xB1>(v);
    v += dpp_f<0x4E>(v);
    v += dpp_f<0x141>(v);
    v += dpp_f<0x140>(v);
    return v;
}
__device__ __forceinline__ float wave_sum(float v) {
    v = row_sum16(v);
    const float r0 = __builtin_bit_cast(float, __builtin_amdgcn_readlane(__builtin_bit_cast(int, v), 0)), r1 = __builtin_bit_cast(float, __builtin_amdgcn_readlane(__builtin_bit_cast(int, v), 16));
    const float r2 = __builtin_bit_cast(float, __builtin_amdgcn_readlane(__builtin_bit_cast(int, v), 32)), r3 = __builtin_bit_cast(float, __builtin_amdgcn_readlane(__builtin_bit_cast(int, v), 48));
    return (r0 + r1) + (r2 + r3);
}
__device__ __forceinline__ float wave_max(float v) {
#pragma unroll
    for (int o = 32; o >= 1; o >>= 1) v = fmaxf(v, __shfl_xor(v, o));
    return v;
}
__device__ __forceinline__ float silu_f(float v) { return v / (1.0f + expf(-v)); }
__device__ __forceinline__ float silu_fast(float v) { return v * __builtin_amdgcn_rcpf(1.0f + __expf(-v)); }
__device__ __forceinline__ float sigmoid_f(float v) { return 1.0f / (1.0f + expf(-v)); }
__device__ __forceinline__ float sigmoid_fast(float v) { return __builtin_amdgcn_rcpf(1.0f + __expf(-v)); }
__device__ __forceinline__ int opaque_tid() { int t = threadIdx.x; asm volatile("" : "+v"(t)); return t; }
__device__ __forceinline__ int ld_agent(const int* p) { return __hip_atomic_load(p, __ATOMIC_RELAXED, __HIP_MEMORY_SCOPE_AGENT); }

#define XB_TMO      128
#define XB_XCNT(j)  (256  + 64 * (j))
#define XB_XSUB(j)  (1280 + 64 * (j))
#define XB_XGEN(j)  (2304 + 64 * (j))
#define XB_TOP      3328
#define XB_TOPGEN   3392
#define XCD_BAR_WORDS 3456
#define XB_SPIN_CAP (1u << 18)
__device__ __forceinline__ unsigned xb_ld(unsigned* p)              { return __hip_atomic_load(p, __ATOMIC_RELAXED, __HIP_MEMORY_SCOPE_AGENT); }
__device__ __forceinline__ unsigned xb_add(unsigned* p, unsigned v) { return __hip_atomic_fetch_add(p, v, __ATOMIC_RELAXED, __HIP_MEMORY_SCOPE_AGENT); }
__device__ __forceinline__ unsigned xb_xcc_id() { return (unsigned)__builtin_amdgcn_s_getreg((3 << 11) | 20) & 0xFu; }
#define XB_SPIN(cond, bar) do { unsigned _sp = 0; while (cond) { __builtin_amdgcn_s_sleep(1); \
    if ((++_sp & 255u) == 0u) { if (xb_ld(&(bar)[XB_TMO])) break; if (_sp > XB_SPIN_CAP) { atomicAdd(&(bar)[XB_TMO], 1u); break; } } } } while (0)
struct XcdBarrier { unsigned* bar; unsigned x; volatile LAS unsigned* st; };
__device__ __forceinline__ XcdBarrier xcd_barrier_post(unsigned* bar, volatile LAS unsigned* st) {
    XcdBarrier b; b.bar = bar; b.x = xb_xcc_id(); b.st = st;
    if (threadIdx.x == 0) (void)xb_add(&bar[XB_XCNT(b.x)], 1u);
    return b;
}
__device__ __forceinline__ void xcd_barrier_complete(unsigned* bar, unsigned x, unsigned& nloc, unsigned& nx) {
    const unsigned G = gridDim.x * gridDim.y * gridDim.z;
    unsigned sum, cnt, mine, sp = 0u;
    for (;;) {
        sum = 0u; cnt = 0u; mine = 0u;
#pragma unroll
        for (unsigned j = 0; j < 16; ++j) { const unsigned c = xb_ld(&bar[XB_XCNT(j)]); sum += c; cnt += (c > 0u) ? 1u : 0u; mine = (j == x) ? c : mine; }
        if (sum == G) break;
        __builtin_amdgcn_s_sleep(1);
        if ((++sp & 255u) == 0u) { if (xb_ld(&bar[XB_TMO])) break; if (sp > XB_SPIN_CAP) { atomicAdd(&bar[XB_TMO], 1u); break; } }
    }
    nloc = mine > 0u ? mine : 1u; nx = cnt > 0u ? cnt : 1u;
}
__device__ __forceinline__ void xcd_barrier(const XcdBarrier& b) {
    asm volatile("s_waitcnt vmcnt(0)" ::: "memory");
    __syncthreads();
    if (threadIdx.x == 0) {
        unsigned* bar = b.bar;
        __builtin_amdgcn_s_waitcnt(0);
        unsigned nloc = b.st[0], nx = b.st[1];
        if (nloc == 0u) { xcd_barrier_complete(bar, b.x, nloc, nx); b.st[0] = nloc; b.st[1] = nx; }
        const unsigned old = xb_add(&bar[XB_XSUB(b.x)], 1u);
        const unsigned gen = old / nloc;
        if (old + 1u == (gen + 1u) * nloc) {
            __builtin_amdgcn_fence(__ATOMIC_RELEASE, "agent");
            asm volatile("s_waitcnt vmcnt(0)" ::: "memory");
            const unsigned og = xb_add(&bar[XB_TOP], 1u);
            const unsigned tg = og / nx;
            if (og + 1u == (tg + 1u) * nx) xb_add(&bar[XB_TOPGEN], 1u);
            else XB_SPIN(xb_ld(&bar[XB_TOPGEN]) == tg, bar);
            __builtin_amdgcn_fence(__ATOMIC_ACQUIRE, "agent");
            xb_add(&bar[XB_XGEN(b.x)], 1u);
            asm volatile("s_waitcnt vmcnt(0)" ::: "memory");
        } else {
            XB_SPIN(xb_ld(&bar[XB_XGEN(b.x)]) == gen, bar);
            __builtin_amdgcn_fence(__ATOMIC_ACQUIRE, "agent");
            asm volatile("s_waitcnt vmcnt(0)" ::: "memory");
        }
    }
    __syncthreads();
}

namespace pg8 {
constexpr int BM = 256, BK = 64, HALF = 128, HTB = HALF * BK * 2, STAGE_BYTES = 8 * HTB, NXCD = 8, WGM = 8;
__host__ __device__ __forceinline__ int lds_byte(int r, int c) { const int st = (r >> 4) * 2 + (c >> 5), rr = r & 15, cc = c & 31, ob = rr * 64 + cc * 2; return st * 1024 + (ob ^ (((ob >> 9) & 1) << 5)); }
__host__ __device__ __forceinline__ void stage_rc(int b, int& R, int& C) { const int st = b / 1024, sb = b % 1024, swz = sb ^ (((sb >> 9) & 1) << 5); R = (st >> 1) * 16 + swz / 64; C = (st & 1) * 32 + (swz % 64) / 2; }
__host__ __device__ __forceinline__ int perm32(int rho) { const int n = rho >> 4, i = rho & 15; return 8 * (i >> 2) + 4 * n + (i & 3); }

struct Unit { int pm, pn, e, mt, cnt; };

struct DenseOrder {
    const bf16_t* A; const bf16_t* Bt; int K;
    int nM, nN, nwg, G, c;
    __device__ void init(const bf16_t* A_, const bf16_t* Bt_, int M, int N, int K_, int G_, int c_) { A = A_; Bt = Bt_; K = K_; nM = M / BM; nN = N / BM; nwg = nM * nN; G = G_; c = c_; }
    __device__ bool next(int i, Unit& u) const {
        const long Lx = (long)i * G + c; if (Lx >= nwg) return false;
        int wgid = (int)Lx; { const int q = nwg / NXCD, r = nwg % NXCD, xcd = wgid % NXCD, off = wgid / NXCD; wgid = (xcd < r ? xcd * (q + 1) : r * (q + 1) + (xcd - r) * q) + off; }
        const int nig = WGM * nN, gid = wgid / nig, fm = gid * WGM, gsz = (nM - fm) < WGM ? (nM - fm) : WGM;
        u.pm = fm + ((wgid % nig) % gsz); u.pn = (wgid % nig) / gsz; u.e = 0; u.mt = 0; u.cnt = 0; return true;
    }
    __device__ __forceinline__ const char* a_base(const Unit& u) const { return (const char*)A + (size_t)u.pm * BM * K * 2; }
    __device__ __forceinline__ unsigned a_voff(const Unit&, int row, int C) const { return (unsigned)(row * K + C) * 2u; }
    __device__ __forceinline__ const char* b_base(const Unit& u) const { return (const char*)Bt + (size_t)u.pn * BM * K * 2; }
};
template <bool gather> struct MoeOrder {
    const bf16_t* A; const bf16_t* Bt; int K; size_t bstride;
    const int* list;
    const LAS int* cum; const LAS int* cnts;
    int G, c, nun;
    __device__ bool next(int i, Unit& u) const {
        const int Lx = i * G + c; if (Lx >= nun) return false;
        const int t = Lx >> 2; u.pn = Lx & 3; u.pm = t;
        int e = 0;
#pragma unroll 1
        for (int j = 1; j < NE; ++j) e += (cum[j] <= t) ? 1 : 0;
        u.e = e; u.mt = t - cum[e]; u.cnt = cnts[e]; return true;
    }
    __device__ __forceinline__ const char* a_base(const Unit& u) const { return gather ? (const char*)A : (const char*)A + (size_t)u.pm * BM * K * 2; }
    __device__ __forceinline__ unsigned a_voff(const Unit& u, int row, int C) const {
        if (gather) { const int pos = u.mt * BM + row; const int tok = (pos < u.cnt) ? list[(size_t)u.e * NTOK + pos] : 0; return (unsigned)(tok * K + C) * 2u; }
        return (unsigned)(row * K + C) * 2u;
    }
    __device__ __forceinline__ const char* b_base(const Unit& u) const { return (const char*)(Bt + (size_t)u.e * bstride) + (size_t)u.pn * BM * K * 2; }
};

struct EpiBf16 {
    static constexpr bool PERM = true;
    bf16_t* O; int ldc;
    __device__ __forceinline__ void operator()(const f32x4 (&acc)[2][2][4][2], const Unit& u, int wr, int wc, int fr, int fq) const {
        const int row0 = u.pm * BM + wr * 64 + fr, col0 = u.pn * BM + wc * 32 + 8 * fq;
#pragma unroll
        for (int ai = 0; ai < 2; ++ai)
#pragma unroll
            for (int m = 0; m < 4; ++m) { bf16_t* rowp = O + (size_t)(row0 + ai * HALF + m * 16) * ldc + col0;
#pragma unroll
                for (int bj = 0; bj < 2; ++bj) { const f32x4 v0 = acc[ai][bj][m][0], v1 = acc[ai][bj][m][1];
                    u32x4 w; w.x = cvt_pk_bf16(v0[0], v0[1]); w.y = cvt_pk_bf16(v0[2], v0[3]); w.z = cvt_pk_bf16(v1[0], v1[1]); w.w = cvt_pk_bf16(v1[2], v1[3]);
                    *(u32x4*)(rowp + bj * HALF) = w; } }
    }
};
struct EpiResid {
    static constexpr bool PERM = true;
    const float* X; const bf16_t* Xb; bf16_t* C; const float* gate;
    const float* ssq;
    __device__ __forceinline__ void rowscale(f32x4 (&acc)[2][2][4][2], const Unit& u, int wr, int fr) const {
        int rbase = u.pm * BM + wr * 64 + fr;
        asm volatile("" : "+v"(rbase));
#pragma unroll
        for (int ai = 0; ai < 2; ++ai)
#pragma unroll
            for (int m = 0; m < 4; ++m) { const f32x4 sv = *(const f32x4*)(ssq + (size_t)(rbase + ai * HALF + m * 16) * 4); const float r = rsqrtf(((sv[0] + sv[1]) + (sv[2] + sv[3])) * (1.0f / 256.0f) + EPS);
#pragma unroll
                for (int bj = 0; bj < 2; ++bj)
#pragma unroll
                    for (int n = 0; n < 2; ++n) acc[ai][bj][m][n] *= r; }
    }
    __device__ __forceinline__ void operator()(const f32x4 (&acc)[2][2][4][2], const Unit& u, int wr, int wc, int fr, int fq) const {
        const int row0 = u.pm * BM + wr * 64 + fr, col0 = u.pn * BM + wc * 32 + 8 * fq;
        const float* gp = gate + (size_t)((u.pm * BM) / S) * 6144 + col0;
        f32x4 gv[2][2];
#pragma unroll
        for (int bj = 0; bj < 2; ++bj)
#pragma unroll
            for (int n = 0; n < 2; ++n) gv[bj][n] = *(const f32x4*)(gp + bj * HALF + n * 4);
#pragma unroll
        for (int ai = 0; ai < 2; ++ai)
#pragma unroll
            for (int m = 0; m < 4; ++m) { const size_t off = (size_t)(row0 + ai * HALF + m * 16) * D + col0;
#pragma unroll
                for (int bj = 0; bj < 2; ++bj) {
                    f32x4 x0, x1v;
                    if (Xb) { const u32x4 xw = *(const u32x4*)(Xb + off + bj * HALF); x0 = (f32x4){bflo(xw.x), bfhi(xw.x), bflo(xw.y), bfhi(xw.y)}; x1v = (f32x4){bflo(xw.z), bfhi(xw.z), bflo(xw.w), bfhi(xw.w)}; }
                    else { x0 = *(const f32x4*)(X + off + bj * HALF); x1v = *(const f32x4*)(X + off + bj * HALF + 4); }
                    const f32x4 o0 = x0 + gv[bj][0] * acc[ai][bj][m][0], o1 = x1v + gv[bj][1] * acc[ai][bj][m][1];
                    u32x4 w; w.x = cvt_pk_bf16(o0[0], o0[1]); w.y = cvt_pk_bf16(o0[2], o0[3]); w.z = cvt_pk_bf16(o1[0], o1[1]); w.w = cvt_pk_bf16(o1[2], o1[3]);
                    *(u32x4*)(C + off + bj * HALF) = w; }
                asm volatile("" ::: "memory"); }
    }
};
struct EpiHid {
    static constexpr bool PERM = true;
    bf16_t* H;
    __device__ __forceinline__ void operator()(const f32x4 (&acc)[2][2][4][2], const Unit& u, int wr, int wc, int fr, int fq) const {
        const int row0 = u.pm * BM + wr * 64 + fr, col0 = u.pn * HALF + wc * 32 + 8 * fq;
#pragma unroll
        for (int ai = 0; ai < 2; ++ai)
#pragma unroll
            for (int m = 0; m < 4; ++m) { float h[8];
#pragma unroll
                for (int n = 0; n < 2; ++n)
#pragma unroll
                    for (int j = 0; j < 4; ++j) h[n * 4 + j] = silu_fast(acc[ai][0][m][n][j]) * acc[ai][1][m][n][j];
                u32x4 w; w.x = cvt_pk_bf16(h[0], h[1]); w.y = cvt_pk_bf16(h[2], h[3]); w.z = cvt_pk_bf16(h[4], h[5]); w.w = cvt_pk_bf16(h[6], h[7]);
                *(u32x4*)(H + (size_t)(row0 + ai * HALF + m * 16) * F + col0) = w; }
    }
};
struct EpiDown {
    static constexpr bool PERM = true;
    bf16_t* Y; const float* lgate;
    __device__ __forceinline__ void operator()(const f32x4 (&acc)[2][2][4][2], const Unit& u, int wr, int wc, int fr, int fq) const {
        const int rl0 = wr * 64 + fr, col0 = u.pn * BM + wc * 32 + 8 * fq;
        const float* gp = lgate + (size_t)u.e * NTOK + u.mt * BM;
#pragma unroll
        for (int ai = 0; ai < 2; ++ai)
#pragma unroll
            for (int m = 0; m < 4; ++m) { const int rl = rl0 + ai * HALF + m * 16; const float g = (u.mt * BM + rl < u.cnt) ? gp[rl] : 0.f;
                bf16_t* rowp = Y + (size_t)(u.pm * BM + rl) * D + col0;
#pragma unroll
                for (int bj = 0; bj < 2; ++bj) { const f32x4 v0 = acc[ai][bj][m][0] * g, v1 = acc[ai][bj][m][1] * g;
                    u32x4 w; w.x = cvt_pk_bf16(v0[0], v0[1]); w.y = cvt_pk_bf16(v0[2], v0[3]); w.z = cvt_pk_bf16(v1[0], v1[1]); w.w = cvt_pk_bf16(v1[2], v1[3]);
                    *(u32x4*)(rowp + bj * HALF) = w; } }
    }
};

template <class Epi, class Sched, bool RSC = false>
__device__ __forceinline__ void gemm_phase(LAS unsigned char* lds, const Sched& S, const Epi& E) {
    const int tid = opaque_tid(), wid = __builtin_amdgcn_readfirstlane(tid >> 6), lane = tid & 63, wr = wid >> 2, wc = wid & 3, fr = lane & 15, fq = lane >> 4;
    const int K = S.K, nt = K / BK;
    int Rr[2], Cc[2]; unsigned voffB[2];
#pragma unroll
    for (int i = 0; i < 2; ++i) { stage_rc(tid * 16 + i * 8192, Rr[i], Cc[i]); const int Rb = Epi::PERM ? ((Rr[i] & ~31) + perm32(Rr[i] & 31)) : Rr[i]; voffB[i] = (unsigned)(Rb * K + Cc[i]) * 2u; }
    const size_t kstep = (size_t)(BK * 2);
    const size_t hstep = (size_t)HALF * K * 2;
    const unsigned ldsw = (unsigned)wid * 1024u;
    const int aoff = lds_byte(wr * 64 + fr, fq * 8), boff = lds_byte(wc * 32 + fr, fq * 8);
#define PG8_SA(b, h) (((b) * 2 + (h)) * HTB)
#define PG8_SB(b, h) ((4 + (b) * 2 + (h)) * HTB)
#define PG8_STAGE(bufoff, gbase, voff) do { _Pragma("unroll") for (int _i = 0; _i < 2; ++_i) \
        __builtin_amdgcn_global_load_lds((const unsigned*)((const char*)(gbase) + (voff)[_i]), (LAS unsigned*)(lds + (bufoff) + ldsw + _i * 8192), 16, 0, 0); } while (0)
#define PG8_LDA(dst, b, h) do { _Pragma("unroll") for (int m = 0; m < 4; ++m) _Pragma("unroll") for (int k = 0; k < 2; ++k) dst[m][k] = *(const LAS bf16x8*)(lds + PG8_SA(b, h) + aoff + m * 2048 + k * 1024); } while (0)
#define PG8_LDB(dst, b, h) do { _Pragma("unroll") for (int n = 0; n < 2; ++n) _Pragma("unroll") for (int k = 0; k < 2; ++k) dst[n][k] = *(const LAS bf16x8*)(lds + PG8_SB(b, h) + boff + n * 2048 + k * 1024); } while (0)
#define PG8_MMA(ai, bj, At, Bt) do { __builtin_amdgcn_s_setprio(1); _Pragma("unroll") for (int m = 0; m < 4; ++m) _Pragma("unroll") for (int n = 0; n < 2; ++n) _Pragma("unroll") for (int k = 0; k < 2; ++k) \
        acc[ai][bj][m][n] = __builtin_amdgcn_mfma_f32_16x16x32_bf16(Bt[n][k], At[m][k], acc[ai][bj][m][n], 0, 0, 0); __builtin_amdgcn_s_setprio(0); } while (0)
#define PG8_WAIT_V(n) asm volatile("s_waitcnt vmcnt(" #n ")" ::: "memory")
#define PG8_WAIT_L(n) asm volatile("s_waitcnt lgkmcnt(" #n ")" ::: "memory")
#define PG8_BAR __builtin_amdgcn_s_barrier()
#define PG8_SCHED __builtin_amdgcn_sched_barrier(0)
    Unit cur, nxt; int ui = 0;
    if (!S.next(0, cur)) return;
    f32x4 acc[2][2][4][2];
#pragma unroll
    for (int a = 0; a < 2; ++a)
#pragma unroll
        for (int b = 0; b < 2; ++b)
#pragma unroll
            for (int m = 0; m < 4; ++m)
#pragma unroll
                for (int n = 0; n < 2; ++n) acc[a][b][m][n] = (f32x4){0.f, 0.f, 0.f, 0.f};
    bf16x8 At[4][2], B0[2][2], B1[2][2];
    unsigned vA0[2], vA1[2], vN0[2], vN1[2];
#pragma unroll
    for (int i = 0; i < 2; ++i) { vA0[i] = S.a_voff(cur, Rr[i], Cc[i]); vA1[i] = S.a_voff(cur, HALF + Rr[i], Cc[i]); }
    const char* cA = S.a_base(cur); const char* cB = S.b_base(cur);
    PG8_STAGE(PG8_SB(0, 0), cB, voffB); PG8_STAGE(PG8_SB(0, 1), cB + hstep, voffB); PG8_STAGE(PG8_SA(0, 0), cA, vA0); PG8_STAGE(PG8_SA(0, 1), cA, vA1);
    if (wr == 1) PG8_BAR;
    PG8_WAIT_V(2); PG8_BAR;
    PG8_STAGE(PG8_SB(1, 0), cB + kstep, voffB); PG8_STAGE(PG8_SA(1, 0), cA + kstep, vA0); PG8_STAGE(PG8_SB(1, 1), cB + hstep + kstep, voffB);
    PG8_WAIT_V(6); PG8_BAR;
    for (;;) {
        const bool has_next = S.next(ui + 1, nxt);
        const char* nA = has_next ? S.a_base(nxt) : cA; const char* nB = has_next ? S.b_base(nxt) : cB;
#pragma unroll
        for (int i = 0; i < 2; ++i) { vN0[i] = has_next ? S.a_voff(nxt, Rr[i], Cc[i]) : vA0[i]; vN1[i] = has_next ? S.a_voff(nxt, HALF + Rr[i], Cc[i]) : vA1[i]; }
        for (int t = 0; t < nt; t += 2) {
            const bool last = (t == nt - 2);
            if constexpr (RSC) { if (t == 4) E.rowscale(acc, cur, wr, fr); }
            const char* a1 = cA + (size_t)(t + 1) * kstep;
            const char* a2 = last ? nA : cA + (size_t)(t + 2) * kstep; const char* b2 = last ? nB : cB + (size_t)(t + 2) * kstep;
            const char* a3 = a2 + kstep; const char* b3 = b2 + kstep;
            unsigned w0[2], w1[2];
#pragma unroll
            for (int i = 0; i < 2; ++i) { w0[i] = last ? vN0[i] : vA0[i]; w1[i] = last ? vN1[i] : vA1[i]; }
            PG8_LDB(B0, 0, 0); PG8_LDB(B1, 0, 1); PG8_SCHED; PG8_LDA(At, 0, 0); PG8_STAGE(PG8_SA(1, 1), a1, vA1);
            PG8_WAIT_V(8); PG8_WAIT_L(0); PG8_BAR; PG8_MMA(0, 0, At, B0); PG8_MMA(0, 1, At, B1); PG8_BAR; PG8_SCHED;
            PG8_LDA(At, 0, 1); PG8_STAGE(PG8_SB(0, 0), b2, voffB); PG8_STAGE(PG8_SB(0, 1), b2 + hstep, voffB); PG8_STAGE(PG8_SA(0, 0), a2, w0);
            PG8_WAIT_V(8); PG8_WAIT_L(0); PG8_BAR; PG8_MMA(1, 0, At, B0); PG8_MMA(1, 1, At, B1); PG8_BAR; PG8_SCHED;
            PG8_LDB(B0, 1, 0); PG8_LDB(B1, 1, 1); PG8_SCHED; PG8_LDA(At, 1, 0); PG8_STAGE(PG8_SA(0, 1), a2, w1);
            PG8_WAIT_V(8); PG8_WAIT_L(0); PG8_BAR; PG8_MMA(0, 0, At, B0); PG8_MMA(0, 1, At, B1); PG8_BAR; PG8_SCHED;
            PG8_LDA(At, 1, 1); PG8_STAGE(PG8_SB(1, 0), b3, voffB); PG8_STAGE(PG8_SB(1, 1), b3 + hstep, voffB); PG8_STAGE(PG8_SA(1, 0), a3, w0);
            PG8_WAIT_V(8); PG8_WAIT_L(0); PG8_BAR; PG8_MMA(1, 0, At, B0); PG8_MMA(1, 1, At, B1); PG8_BAR; PG8_SCHED;
        }
        if (wr == 0) PG8_BAR;
        E(acc, cur, wr, wc, fr, fq);
        if (!has_next) break;
#pragma unroll
        for (int a = 0; a < 2; ++a)
#pragma unroll
            for (int b = 0; b < 2; ++b)
#pragma unroll
                for (int m = 0; m < 4; ++m)
#pragma unroll
                    for (int n = 0; n < 2; ++n) acc[a][b][m][n] = (f32x4){0.f, 0.f, 0.f, 0.f};
        cur = nxt; cA = nA; cB = nB; ++ui;
#pragma unroll
        for (int i = 0; i < 2; ++i) { vA0[i] = vN0[i]; vA1[i] = vN1[i]; }
        if (wr == 1) PG8_BAR;
    }
    PG8_WAIT_V(0);
    PG8_BAR;
#undef PG8_SA
#undef PG8_SB
#undef PG8_STAGE
#undef PG8_LDA
#undef PG8_LDB
#undef PG8_MMA
#undef PG8_WAIT_V
#undef PG8_WAIT_L
#undef PG8_BAR
#undef PG8_SCHED
}
}
struct Args { const void* in[32]; float* out; unsigned char* ws; int l_lo, l_hi, ph_lo, ph_hi, fused, pad; };
enum { PH_PRO = 0, PH_NORM0 = 1, PH_G1 = 2, PH_MIX = 3, PH_A1 = 4, PH_A2 = 5, PH_AN = 6, PH_G2 = 7, PH_ROUTE = 8, PH_UP = 9, PH_DOWN = 10, PH_COMB = 11, PH_END = 12 };

typedef const Args __attribute__((address_space(4))) KArgs;
__device__ __forceinline__ KArgs* kargs() { KArgs* p = (KArgs*)__builtin_amdgcn_kernarg_segment_ptr(); asm volatile("" : "+s"(p)); return p; }
#define IN_F(i) ((const float*)ka->in[i])
enum { I_X = 0, I_C, I_POS, I_WADA, I_BADA, I_NORM1, I_WIN, I_QN, I_KN, I_CONVW, I_CONVB, I_CLNG, I_CLNB, I_PWW, I_PWB, I_POOLW, I_POOLB, I_POOLS, I_SLNG, I_SLNB, I_SGUW, I_SGUB,
       I_ONORM, I_WOUT, I_NORM2, I_WRG, I_BRG, I_WRE, I_BRE, I_WG, I_WU, I_WD };

__device__ __forceinline__ void sincos_d(double a, double& s, double& c) {
    const double k = rint(a * 0.63661977236758134308);
    const double r = (a - k * 1.57079632679489655800) - k * 6.123233995736766036e-17;
    const double r2 = r * r;
    const double sp = r * (1.0 + r2 * (-1.0 / 6 + r2 * (1.0 / 120 + r2 * (-1.0 / 5040 + r2 * (1.0 / 362880 + r2 * (-1.0 / 39916800 + r2 * (1.0 / 6227020800.0)))))));
    const double cp = 1.0 + r2 * (-0.5 + r2 * (1.0 / 24 + r2 * (-1.0 / 720 + r2 * (1.0 / 40320 + r2 * (-1.0 / 3628800 + r2 * (1.0 / 479001600.0 + r2 * (-1.0 / 87178291200.0)))))));
    const int q = ((int)k) & 3;
    if (q == 0) { s = sp; c = cp; } else if (q == 1) { s = cp; c = -sp; } else if (q == 2) { s = -sp; c = -cp; } else { s = -cp; c = sp; }
}

__device__ __forceinline__ bf16_t f2bf_(float f) { return (bf16_t)(cvt_pk_bf16(f, 0.f) & 0xffffu); }
struct TItem { const float* src; int ld; int ncol; bf16_t* dst; int ldd; const float* rsc; };
constexpr int NT_WIN = L * 36 * 4, NT_WOUT = L * 16 * 4, NT_PW = L * 4, NT_WGU = L * NE * 16 * 4, NT_WD = L * NE * 16 * 2;
constexpr int NT_ALL = NT_WIN + NT_WOUT + NT_PW + NT_WGU + NT_WD;
__device__ __forceinline__ void decode_titem(int it, const Args& a, TItem& t) {
    KArgs* ka = kargs();
    unsigned char* ws = ka->ws;
    t.rsc = nullptr;
    if (it < NT_WIN) {
        const int l = it / 144, r = it % 144, n0 = (r >> 2) * 64, k0 = (r & 3) * 256;
        const int c0 = n0 < 768 ? n0 + 256 : (n0 < 2048 ? n0 + 164 : n0 - 2048);
        t.ncol = (n0 < 768) ? ((n0 + 64 <= 676) ? 64 : (n0 < 676 ? 676 - n0 : 0)) : 64;
        t.src = IN_F(I_WIN) + ((size_t)l * D + k0) * DIN + c0; t.ld = DIN;
        t.dst = (bf16_t*)(ws + WS_WINT) + ((size_t)l * NP + n0) * D + k0; t.ldd = D; return;
    }
    it -= NT_WIN;
    if (it < NT_WOUT) {
        const int l = it / 64, r = it % 64, n0 = (r >> 2) * 64, k0 = (r & 3) * 256;
        t.ncol = 64; t.src = IN_F(I_WOUT) + ((size_t)l * D + k0) * D + n0; t.ld = D; t.rsc = (k0 == 0) ? IN_F(I_ONORM) + l * D : nullptr;
        t.dst = (bf16_t*)(ws + WS_WOUTT) + ((size_t)l * D + n0) * D + k0; t.ldd = D; return;
    }
    it -= NT_WOUT;
    if (it < NT_PW) {
        const int l = it / 4, n0 = (it & 3) * 64;
        t.ncol = 64; t.src = IN_F(I_PWW) + (size_t)l * 65536 + n0; t.ld = 256;
        t.dst = (bf16_t*)(ws + WS_PWT) + ((size_t)l * 256 + n0) * 256; t.ldd = 256; return;
    }
    it -= NT_PW;
    if (it < NT_WGU) {
        const int le = it / 64, r = it % 64, n0 = (r >> 2) * 64, k0 = (r & 3) * 256;
        const int pn = n0 >> 8, rr = n0 & 255;
        const float* W = (rr < 128) ? IN_F(I_WG) : IN_F(I_WU);
        t.ncol = 64; t.src = W + ((size_t)le * D + k0) * F + pn * 128 + (rr & 127); t.ld = F;
        t.dst = (bf16_t*)(ws + WS_WGUT) + ((size_t)le * 1024 + n0) * D + k0; t.ldd = D; return;
    }
    it -= NT_WGU;
    {
        const int le = it / 32, r = it % 32, n0 = (r >> 1) * 64, k0 = (r & 1) * 256;
        t.ncol = 64; t.src = IN_F(I_WD) + ((size_t)le * F + k0) * D + n0; t.ld = D;
        t.dst = (bf16_t*)(ws + WS_WDT) + ((size_t)le * D + n0) * F + k0; t.ldd = F;
    }
}
__device__ __forceinline__ void titem_load(const TItem& t, int tid, float4 (&v)[8]) {
    const int c4 = tid & 15, r0 = tid >> 4;
#pragma unroll
    for (int i = 0; i < 8; ++i) v[i] = (c4 * 4 < t.ncol) ? *(const float4*)(t.src + (size_t)(r0 + 32 * i) * t.ld + c4 * 4) : make_float4(0.f, 0.f, 0.f, 0.f);
    if (t.rsc) {
#pragma unroll
        for (int i = 0; i < 8; ++i) { const float s = t.rsc[r0 + 32 * i]; v[i].x *= s; v[i].y *= s; v[i].z *= s; v[i].w *= s; }
    }
}
__device__ __forceinline__ void phase_prologue(const Args& a, LAS unsigned char* lds, int vcu, int G) {
    KArgs* ka = kargs();
    const int tid = opaque_tid(), wid = __builtin_amdgcn_readfirstlane(tid >> 6), lane = tid & 63;
    LAS float* T = (LAS float*)lds;
    LAS float* cs = (LAS float*)(lds + 66560);
    LAS float* red = (LAS float*)(lds + 66560 + 16384);
    unsigned char* ws = ka->ws;
    if (vcu < 192) {
        for (int i = tid; i < 4096; i += NTHR) cs[i] = silu_f(IN_F(I_C)[i]);
        __syncthreads();
        for (int it = vcu; it < 192; it += G) {
            const int l = it / 96, j0 = (it % 96) * 64;
            const float* wp = IN_F(I_WADA) + ((size_t)l * D + wid * 128) * 6144 + j0 + lane;
            float a0 = 0.f, a1 = 0.f, a2 = 0.f, a3 = 0.f;
#pragma unroll 32
            for (int k = 0; k < 128; ++k) { const float wv = wp[(size_t)k * 6144]; const int kk = wid * 128 + k; a0 += cs[kk] * wv; a1 += cs[1024 + kk] * wv; a2 += cs[2048 + kk] * wv; a3 += cs[3072 + kk] * wv; }
            red[(wid * 4 + 0) * 64 + lane] = a0; red[(wid * 4 + 1) * 64 + lane] = a1; red[(wid * 4 + 2) * 64 + lane] = a2; red[(wid * 4 + 3) * 64 + lane] = a3;
            __syncthreads();
            if (wid < 4) { float s = 0.f;
#pragma unroll
                for (int w = 0; w < 8; ++w) s += red[(w * 4 + wid) * 64 + lane];
                ((float*)(ws + WS_MOD))[((size_t)l * 4 + wid) * 6144 + j0 + lane] = s + IN_F(I_BADA)[l * 6144 + j0 + lane]; }
            __syncthreads();
        }
    }
    for (int i = vcu * NTHR + tid; i < NTOK; i += G * NTHR) {
        const float invA[8] = {1.0f, 0.1939227432012558f, 0.03760603070259094f, 0.007292664609849453f, 0.0014142135623842478f, 0.00027424818836152554f, 5.318296098266728e-05f, 1.0313386155758053e-05f};
        const float invI[4] = {1.0f, 0.03760603070259094f, 0.0014142135623842478f, 5.318296098266728e-05f};
        const float p = (float)((const int*)ka->in[I_POS])[i];
        float* ra = (float*)(ws + WS_ROPEA) + (size_t)i * 16; float* ri = (float*)(ws + WS_ROPEI) + (size_t)i * 8;
#pragma unroll
        for (int j = 0; j < 8; ++j) { const float ang = p * invA[j]; double s, c; sincos_d((double)ang, s, c); ra[j] = (float)c; ra[8 + j] = (float)s; }
#pragma unroll
        for (int j = 0; j < 4; ++j) { const float ang = p * invI[j]; double s, c; sincos_d((double)ang, s, c); ri[j] = (float)c; ri[4 + j] = (float)s; }
    }
    for (int i = vcu * NTHR + tid; i < L * 4 * 128 * 128; i += G * NTHR) { const int s = i & 127, t = (i >> 7) & 127; ((bf16_t*)(ws + WS_SGUW))[i] = (bf16_t)(cvt_pk_bf16(s <= t ? IN_F(I_SGUW)[i] : 0.f, 0.f) & 0xffffu); }
    for (int i = vcu * NTHR + tid; i < L * 4 * 64 * 64; i += G * NTHR) { const int c = i & 63, d = (i >> 6) & 63, lg = i >> 12; ((bf16_t*)(ws + WS_POOLT))[i] = (bf16_t)(cvt_pk_bf16(IN_F(I_POOLW)[((size_t)lg * 64 + c) * 64 + d], 0.f) & 0xffffu); }
    for (int i = vcu * NTHR + tid; i < L * 48 * 1024; i += G * NTHR) {
        const int k = i & 1023, n = (i >> 10) % 48, lg = i / (48 * 1024);
        const float w = (n < 4) ? IN_F(I_WRG)[((size_t)lg * D + k) * 4 + n] : (n < 36) ? IN_F(I_WRE)[((size_t)lg * D + k) * 32 + (n - 4)] : 0.f;
        const unsigned hi = cvt_pk_bf16(w, 0.f) & 0xffffu; const float lo = w - __uint_as_float(hi << 16);
        bf16_t* dst = (bf16_t*)(ws + WS_WHL) + (size_t)lg * 2 * 48 * 1024 + (size_t)n * 1024 + k;
        dst[0] = (bf16_t)hi; dst[48 * 1024] = f2bf_(lo);
    }
    int it = (G - 1 - vcu);
    bool have = it < NT_ALL;
    TItem cur; cur.src = nullptr; cur.ld = 0; cur.ncol = 0; cur.dst = nullptr; cur.ldd = 0; cur.rsc = nullptr;
    float4 v[8];
    if (have) { decode_titem(it, a, cur); titem_load(cur, tid, v); }
    while (have) {
        { const int c4 = tid & 15, r0 = tid >> 4;
#pragma unroll
          for (int i = 0; i < 8; ++i) { LAS float* tp = T + (r0 + 32 * i) * 65 + c4 * 4; tp[0] = v[i].x; tp[1] = v[i].y; tp[2] = v[i].z; tp[3] = v[i].w; } }
        __syncthreads();
        const int itn = it + G; const bool hn = itn < NT_ALL; TItem nx = cur;
        if (hn) { decode_titem(itn, a, nx); titem_load(nx, tid, v); }
        { const int n = tid >> 3, kq = tid & 7;
#pragma unroll
          for (int j = 0; j < 4; ++j) { const int kc = j * 8 + kq; float f[8];
#pragma unroll
              for (int jj = 0; jj < 8; ++jj) f[jj] = T[(kc * 8 + jj) * 65 + n];
              u32x4 w; w.x = cvt_pk_bf16(f[0], f[1]); w.y = cvt_pk_bf16(f[2], f[3]); w.z = cvt_pk_bf16(f[4], f[5]); w.w = cvt_pk_bf16(f[6], f[7]);
              *(u32x4*)(cur.dst + (size_t)n * cur.ldd + kc * 8) = w; } }
        __syncthreads();
        cur = nx; it = itn; have = hn;
    }
}

__device__ __forceinline__ void phase_norm(const float* __restrict__ xin, const float* g, const float* shift, const float* scale, bf16_t* __restrict__ out, int vcu, int G) {
    const int tid = opaque_tid(), wid = __builtin_amdgcn_readfirstlane(tid >> 6), lane = tid & 63;
    for (int rb = vcu * 8 + wid; rb < NTOK / 8; rb += G * 8) {
        const int row0 = rb * 8, b = row0 / S;
        float4 A[4], C[4];
#pragma unroll
        for (int i = 0; i < 4; ++i) { const int k = 256 * i + 4 * lane; const float4 gv = *(const float4*)(g + k), sc = *(const float4*)(scale + (size_t)b * 6144 + k); C[i] = *(const float4*)(shift + (size_t)b * 6144 + k);
            A[i] = make_float4(gv.x * (1.f + sc.x), gv.y * (1.f + sc.y), gv.z * (1.f + sc.z), gv.w * (1.f + sc.w)); }
#pragma unroll 4
        for (int rr = 0; rr < 8; ++rr) {
            const size_t ro = (size_t)(row0 + rr) * D;
            float4 x[4]; float ss = 0.f;
#pragma unroll
            for (int i = 0; i < 4; ++i) { x[i] = *(const float4*)(xin + ro + 256 * i + 4 * lane); ss += x[i].x * x[i].x + x[i].y * x[i].y + x[i].z * x[i].z + x[i].w * x[i].w; }
            const float r = rsqrtf(wave_sum(ss) * (1.0f / D) + EPS);
#pragma unroll
            for (int i = 0; i < 4; ++i) { u32x2 w; w.x = cvt_pk_bf16(x[i].x * r * A[i].x + C[i].x, x[i].y * r * A[i].y + C[i].y); w.y = cvt_pk_bf16(x[i].z * r * A[i].z + C[i].z, x[i].w * r * A[i].w + C[i].w);
                *(u32x2*)(out + ro + 256 * i + 4 * lane) = w; }
        }
    }
}

__device__ __forceinline__ f32x4 mfma16r(const bf16x8 a, const bf16x8 b, const f32x4 c) { return __builtin_amdgcn_mfma_f32_16x16x32_bf16(a, b, c, 0, 0, 0); }
__device__ __forceinline__ void phase_rbias(const Args& a, LAS unsigned char* lds, int vcu, int G) {
    KArgs* ka = kargs();
    const int tid = opaque_tid();
    LAS float* red = (LAS float*)lds;
    for (int v = vcu; v < 256; v += G) {
        const int lb = v & 7, sl = v >> 3, l = lb >> 2, b = lb & 3, n = tid & 63, kp = tid >> 6;
        const float* sh = (const float*)(ka->ws + WS_MOD) + ((size_t)l * 4 + b) * 6144 + 3072;
        float s = 0.f;
        if (n < 36) {
#pragma unroll
            for (int i = 0; i < 4; ++i) { const int k = sl * 32 + kp * 4 + i; s += sh[k] * ((n < 4) ? IN_F(I_WRG)[((size_t)l * D + k) * 4 + n] : IN_F(I_WRE)[((size_t)l * D + k) * 32 + (n - 4)]); }
        }
        red[kp * 64 + n] = s;
        __syncthreads();
        if (tid < 48) { float t = 0.f;
            if (tid < 36) { for (int w = 0; w < 8; ++w) t += red[w * 64 + tid]; }
            ((float*)(ka->ws + WS_RBIAS))[((size_t)lb * 32 + sl) * 48 + tid] = t; }
        __syncthreads();
    }
}

__device__ __forceinline__ void phase_route(const Args& a, int l, LAS unsigned char* lds, int vcu, int G) {
    KArgs* ka = kargs();
    const int tid = opaque_tid(), wid = __builtin_amdgcn_readfirstlane(tid >> 6), lane = tid & 63, fr = lane & 15, kq = lane >> 4;
    unsigned char* ws = ka->ws;
    const bf16_t* x1 = (const bf16_t*)(ws + WS_X1);
    const float* mod = (const float*)(ws + WS_MOD) + (size_t)l * 4 * 6144;
    const float* g = IN_F(I_NORM2) + l * D; const float* shift = mod + 3072; const float* scale = mod + 4096;
    bf16_t* out = (bf16_t*)(ws + WS_HA);
    int* counts = (int*)(ws + WS_CNT) + l * NE * 64; int* list = (int*)(ws + WS_LIST); float* lgate = (float*)(ws + WS_LGATE); int* tokinfo = (int*)(ws + WS_TOKINFO);
    LAS int* lcnt = (LAS int*)(lds + LDS_MISC + 1024); LAS int* lbase = lcnt + 32; LAS int* rte = lbase + 32; LAS int* rtp = rte + 128; LAS int* rtt = rtp + 128; LAS float* rtg = (LAS float*)(rtt + 128);
    LAS float* part = (LAS float*)lds;
    LAS float* ssp = part + 8 * 16 * 48;
    LAS float* lgt = ssp + 8 * 16;
    LAS float* rrow = lgt + 16 * 48;
    const bf16_t* wh = (const bf16_t*)(ws + WS_WHL) + (size_t)l * 2 * 48 * 1024 + (size_t)fr * 1024 + 128 * wid + 8 * kq;
    LAS float* rb = (LAS float*)(lds + LDS_MISC + 8192);
    for (int r0 = vcu * 64; r0 < NTOK; r0 += G * 64) {
        const int b = r0 / S;
        if (tid < 48) { const float* rp = (const float*)(ws + WS_RBIAS) + ((size_t)(l * 4 + b) * 32) * 48 + tid; float t = 0.f;
            for (int sl = 0; sl < 32; ++sl) t += rp[sl * 48];
            if (tid < 36) t += (tid < 4) ? IN_F(I_BRG)[l * 4 + tid] : IN_F(I_BRE)[l * 32 + tid - 4];
            rb[tid] = t; }
        if (tid < 32) lcnt[tid] = 0;
#pragma unroll 1
        for (int q4 = 0; q4 < 4; ++q4) {
            float t[4][8];
            f32x4 acc[3];
#pragma unroll
            for (int nt = 0; nt < 3; ++nt) acc[nt] = (f32x4){0.f, 0.f, 0.f, 0.f};
            float ss = 0.f;
            const int row = r0 + 16 * q4 + fr;
#pragma unroll
            for (int ks = 0; ks < 4; ++ks) {
                const int k0 = 128 * wid + 32 * ks + 8 * kq;
                const f32x4 g0 = *(const f32x4*)(g + k0), g1 = *(const f32x4*)(g + k0 + 4), s0 = *(const f32x4*)(scale + (size_t)b * 6144 + k0), s1 = *(const f32x4*)(scale + (size_t)b * 6144 + k0 + 4);
                const float Ac[8] = {g0[0] * (1.f + s0[0]), g0[1] * (1.f + s0[1]), g0[2] * (1.f + s0[2]), g0[3] * (1.f + s0[3]), g1[0] * (1.f + s1[0]), g1[1] * (1.f + s1[1]), g1[2] * (1.f + s1[2]), g1[3] * (1.f + s1[3])};
                const u32x4 xw = *(const u32x4*)(x1 + (size_t)row * D + k0);
                const float v[8] = {bflo(xw.x), bfhi(xw.x), bflo(xw.y), bfhi(xw.y), bflo(xw.z), bfhi(xw.z), bflo(xw.w), bfhi(xw.w)};
                unsigned ph[4], pl[4];
#pragma unroll
                for (int j = 0; j < 8; ++j) { ss += v[j] * v[j]; t[ks][j] = v[j] * Ac[j]; }
#pragma unroll
                for (int j = 0; j < 4; ++j) { ph[j] = cvt_pk_bf16(t[ks][2 * j], t[ks][2 * j + 1]); pl[j] = cvt_pk_bf16(t[ks][2 * j] - bflo(ph[j]), t[ks][2 * j + 1] - bfhi(ph[j])); }
                const bf16x8 Ah = __builtin_bit_cast(bf16x8, (u32x4){ph[0], ph[1], ph[2], ph[3]}), Al = __builtin_bit_cast(bf16x8, (u32x4){pl[0], pl[1], pl[2], pl[3]});
#pragma unroll
                for (int nt = 0; nt < 3; ++nt) {
                    const bf16x8 Bh = *(const bf16x8*)(wh + (size_t)(16 * nt) * 1024 + 32 * ks), Bl = *(const bf16x8*)(wh + 48 * 1024 + (size_t)(16 * nt) * 1024 + 32 * ks);
                    acc[nt] = mfma16r(Ah, Bh, acc[nt]); acc[nt] = mfma16r(Al, Bh, acc[nt]); acc[nt] = mfma16r(Ah, Bl, acc[nt]);
                }
            }
            ss += __shfl_xor(ss, 16); ss += __shfl_xor(ss, 32);
            if (kq == 0) ssp[wid * 16 + fr] = ss;
#pragma unroll
            for (int nt = 0; nt < 3; ++nt)
#pragma unroll
                for (int r = 0; r < 4; ++r) part[(wid * 16 + 4 * kq + r) * 48 + 16 * nt + fr] = acc[nt][r];
            __syncthreads();
            for (int i = tid; i < 16 * 48; i += NTHR) { float s = 0.f;
#pragma unroll
                for (int w = 0; w < 8; ++w) s += part[w * 16 * 48 + i];
                lgt[i] = s; }
            if (tid < 16) { float s = 0.f;
#pragma unroll
                for (int w = 0; w < 8; ++w) s += ssp[w * 16 + tid];
                rrow[tid] = rsqrtf(s * (1.0f / D) + EPS); }
            __syncthreads();
            if (tid < 16) {
                const int tok = r0 + 16 * q4 + tid; const float r = rrow[tid];
                float ag[4];
#pragma unroll
                for (int j = 0; j < 4; ++j) ag[j] = r * lgt[tid * 48 + j] + rb[j];
                int gi = 0; float gm = ag[0];
#pragma unroll
                for (int j = 1; j < 4; ++j) if (ag[j] > gm) { gm = ag[j]; gi = j; }
                float den = 0.f;
#pragma unroll
                for (int j = 0; j < 4; ++j) den += expf(ag[j] - gm);
                const float p_sel = 1.0f / den;
                float el[8];
#pragma unroll
                for (int j = 0; j < 8; ++j) el[j] = r * lgt[tid * 48 + 4 + gi * 8 + j] + rb[4 + gi * 8 + j];
                int j0 = 0; float v0 = el[0];
#pragma unroll
                for (int j = 1; j < 8; ++j) if (el[j] > v0) { v0 = el[j]; j0 = j; }
                int j1 = 0; float v1 = -INFINITY;
#pragma unroll
                for (int j = 0; j < 8; ++j) if (j != j0 && el[j] > v1) { v1 = el[j]; j1 = j; }
                const float e1 = expf(v1 - v0);
                const float g0 = p_sel / (1.0f + e1), g1 = p_sel * e1 / (1.0f + e1);
                const int ex0 = gi * 8 + j0, ex1 = gi * 8 + j1, ai = (16 * q4 + tid) * 2;
                const int p0 = __hip_atomic_fetch_add(lcnt + ex0, 1, __ATOMIC_RELAXED, __HIP_MEMORY_SCOPE_WORKGROUP), p1 = __hip_atomic_fetch_add(lcnt + ex1, 1, __ATOMIC_RELAXED, __HIP_MEMORY_SCOPE_WORKGROUP);
                rte[ai] = ex0; rtp[ai] = p0; rtt[ai] = tok; rtg[ai] = g0;
                rte[ai + 1] = ex1; rtp[ai + 1] = p1; rtt[ai + 1] = tok; rtg[ai + 1] = g1;
            }
            {
                const float r = rrow[fr];
                bf16_t* op = out + (size_t)row * D + 128 * wid + 8 * kq;
#pragma unroll
                for (int ks = 0; ks < 4; ++ks) {
                    const float* cp = shift + (size_t)b * 6144 + 128 * wid + 32 * ks + 8 * kq;
                    const f32x4 c0 = *(const f32x4*)cp, c1 = *(const f32x4*)(cp + 4);
                    u32x4 w; w.x = cvt_pk_bf16(t[ks][0] * r + c0[0], t[ks][1] * r + c0[1]); w.y = cvt_pk_bf16(t[ks][2] * r + c0[2], t[ks][3] * r + c0[3]);
                    w.z = cvt_pk_bf16(t[ks][4] * r + c1[0], t[ks][5] * r + c1[1]); w.w = cvt_pk_bf16(t[ks][6] * r + c1[2], t[ks][7] * r + c1[3]);
                    *(u32x4*)(op + 32 * ks) = w;
                }
            }
            __syncthreads();
        }
        if (tid < 32) { const int c = lcnt[tid]; lbase[tid] = c ? atomicAdd(&counts[tid * 64], c) : 0; }
        __syncthreads();
        if (tid < 128) { const int e = rte[tid], pos = lbase[e] + rtp[tid], tk = rtt[tid];
            list[(size_t)e * NTOK + pos] = tk; lgate[(size_t)e * NTOK + pos] = rtg[tid];
            tokinfo[tk * 4 + (tid & 1) * 2] = e; tokinfo[tk * 4 + (tid & 1) * 2 + 1] = pos; }
        __syncthreads();
    }
}

__device__ __forceinline__ void moe_cum(const Args& a, int l, LAS unsigned char* lds) {
    KArgs* ka = kargs();
    LAS int* cum = (LAS int*)(lds + LDS_MISC + MISC_CUM); LAS int* cn = (LAS int*)(lds + LDS_MISC + MISC_CNT);
    const int* counts = (const int*)(ka->ws + WS_CNT) + l * NE * 64;
    const int tq = opaque_tid();
    if (tq < 33) { int s = 0; for (int j = 0; j < tq; ++j) s += (ld_agent(counts + j * 64) + 255) >> 8; cum[tq] = s; if (tq < 32) cn[tq] = ld_agent(counts + tq * 64); }
    __syncthreads();
}

__device__ __forceinline__ void phase_combine(const Args& a, int l, LAS unsigned char* lds, int vcu, int G) {
    KArgs* ka = kargs();
    const int tid = opaque_tid(), wid = __builtin_amdgcn_readfirstlane(tid >> 6), lane = tid & 63;
    unsigned char* ws = ka->ws;
    moe_cum(a, l, lds);
    const LAS int* cum = (const LAS int*)(lds + LDS_MISC + MISC_CUM);
    const bf16_t* __restrict__ x1 = (const bf16_t*)(ws + WS_X1);
    bf16_t* __restrict__ xnext = (bf16_t*)(ws + WS_X1) + (size_t)NTOK * D;
    const float* mod = (const float*)(ws + WS_MOD) + (size_t)l * 4 * 6144;
    const float* gate2 = mod + 5120;
    const bf16_t* __restrict__ Y = (const bf16_t*)(ws + WS_Y);
    const int* __restrict__ tokinfo = (const int*)(ws + WS_TOKINFO);
    float* __restrict__ outp = ka->out;
    const bool nextl = (l + 1 < L);
    const float* modn = (const float*)(ws + WS_MOD) + (size_t)(nextl ? l + 1 : l) * 4 * 6144;
    const float* gn = IN_F(I_NORM1) + (nextl ? l + 1 : l) * D;
    bf16_t* __restrict__ hout = (bf16_t*)(ws + WS_HA);
    for (int rb = vcu * 8 + wid; rb < NTOK / 8; rb += G * 8) {
        const int row0 = rb * 8, b = row0 / S;
        float4 A[4], C[4], G2[4];
#pragma unroll
        for (int i = 0; i < 4; ++i) { const int k = 256 * i + 4 * lane; const float4 gv = *(const float4*)(gn + k), sc = *(const float4*)(modn + 1024 + (size_t)b * 6144 + k); C[i] = *(const float4*)(modn + (size_t)b * 6144 + k);
            A[i] = make_float4(gv.x * (1.f + sc.x), gv.y * (1.f + sc.y), gv.z * (1.f + sc.z), gv.w * (1.f + sc.w)); G2[i] = *(const float4*)(gate2 + (size_t)b * 6144 + k); }
#pragma unroll 4
        for (int rr = 0; rr < 8; ++rr) {
            const int tok = row0 + rr; const size_t ro = (size_t)tok * D;
            const int4 ti = *(const int4*)(tokinfo + tok * 4);
            const size_t s0 = (size_t)(cum[ti.x] * 256 + ti.y) * D, s1 = (size_t)(cum[ti.z] * 256 + ti.w) * D;
            float4 xo[4]; float ss = 0.f;
#pragma unroll
            for (int i = 0; i < 4; ++i) { const int k = 256 * i + 4 * lane; const u32x2 xw = *(const u32x2*)(x1 + ro + k); const float4 xv = make_float4(bflo(xw.x), bfhi(xw.x), bflo(xw.y), bfhi(xw.y)); const u32x2 y0 = *(const u32x2*)(Y + s0 + k), y1 = *(const u32x2*)(Y + s1 + k);
                xo[i].x = xv.x + G2[i].x * (bflo(y0.x) + bflo(y1.x)); xo[i].y = xv.y + G2[i].y * (bfhi(y0.x) + bfhi(y1.x)); xo[i].z = xv.z + G2[i].z * (bflo(y0.y) + bflo(y1.y)); xo[i].w = xv.w + G2[i].w * (bfhi(y0.y) + bfhi(y1.y));
                if (nextl) { u32x2 xb; xb.x = cvt_pk_bf16(xo[i].x, xo[i].y); xb.y = cvt_pk_bf16(xo[i].z, xo[i].w); *(u32x2*)(xnext + ro + k) = xb; } else *(float4*)(outp + ro + k) = xo[i];
                ss += xo[i].x * xo[i].x + xo[i].y * xo[i].y + xo[i].z * xo[i].z + xo[i].w * xo[i].w; }
            if (nextl) {
                const float r = rsqrtf(wave_sum(ss) * (1.0f / D) + EPS);
#pragma unroll
                for (int i = 0; i < 4; ++i) { u32x2 w; w.x = cvt_pk_bf16(xo[i].x * r * A[i].x + C[i].x, xo[i].y * r * A[i].y + C[i].y); w.y = cvt_pk_bf16(xo[i].z * r * A[i].z + C[i].z, xo[i].w * r * A[i].w + C[i].w);
                    *(u32x2*)(hout + ro + 256 * i + 4 * lane) = w; }
            }
        }
    }
}
constexpr size_t WS_KN = WS_R2;
constexpr size_t WS_VT = WS_KN + al256c((size_t)NTOK * 256 * 2);
constexpr size_t WS_IKR = WS_VT + al256c((size_t)NTOK * 256 * 2);
constexpr size_t WS_MASK = WS_IKR + al256c((size_t)NTOK * 32 * 2);
constexpr size_t WS_OA = WS_MASK + al256c((size_t)NTOK * 128 * 4);
constexpr size_t WS_R3 = WS_OA + al256c((size_t)NTOK * 256 * 2);
constexpr size_t WS_MIXB = (WS_R3 > WS_Y + (size_t)SLOTS * D * 2 ? WS_R3 : WS_Y + al256c((size_t)SLOTS * D * 2));

__device__ __forceinline__ f32x4 mfma16(const bf16x8 a, const bf16x8 b, const f32x4 c) { return __builtin_amdgcn_mfma_f32_16x16x32_bf16(a, b, c, 0, 0, 0); }
__device__ __forceinline__ bf16_t f2bf(float f) { return (bf16_t)(cvt_pk_bf16(f, 0.f) & 0xffffu); }

__device__ __forceinline__ void rows_rms_store(const LAS float* YB, const float* gain, bf16_t* mixb, int tok0, int col0, int wid, int lane) {
    const f32x4 gv = *(const f32x4*)(gain + 4 * lane);
#pragma unroll 2
    for (int rr = 0; rr < 8; ++rr) {
        const int t = 8 * wid + rr;
        const f32x4 y = *(const LAS f32x4*)(YB + t * 260 + 4 * lane);
        const float ss = wave_sum(y[0] * y[0] + y[1] * y[1] + y[2] * y[2] + y[3] * y[3]);
        const float r = rsqrtf(ss * (1.0f / 256.0f) + EPS);
        u32x2 w; w.x = cvt_pk_bf16(y[0] * r * gv[0], y[1] * r * gv[1]); w.y = cvt_pk_bf16(y[2] * r * gv[2], y[3] * r * gv[3]);
        *(u32x2*)(mixb + (size_t)(tok0 + t) * D + col0 + 4 * lane) = w;
    }
}

__device__ __forceinline__ void item_pool(const Args& a, int l, int tile, LAS unsigned char* lds) {
    KArgs* ka = kargs();
    const int tid = opaque_tid(), wid = __builtin_amdgcn_readfirstlane(tid >> 6), lane = tid & 63;
    unsigned char* ws = ka->ws;
    const bf16_t* proj = (const bf16_t*)(ws + WS_PROJ);
    LAS bf16_t* P = (LAS bf16_t*)lds;
    LAS bf16_t* PA = (LAS bf16_t*)(lds + 40960);
    LAS float* YB = (LAS float*)(lds + 40960 + 33792);
    const int tok0 = tile * 64, b = tok0 / S, t0 = tok0 % S;
#pragma unroll
    for (int p = tid; p < 79 * 32; p += NTHR) {
        const int r = p >> 5, c8 = p & 31, t = t0 - 15 + r;
        u32x4 v = (u32x4){0u, 0u, 0u, 0u};
        if (t >= 0) v = *(const u32x4*)(proj + (size_t)(b * S + t) * NP + NC + c8 * 8);
        *(LAS u32x4*)(P + r * 256 + c8 * 8) = v;
    }
    __syncthreads();
    {
        const int c = tid & 255, half = tid >> 8, g = c >> 6, w = 2 << g, tt0 = half * 32;
        float run = 0.f;
        for (int jj = 1; jj < w; ++jj) run += bf2f(P[(15 + tt0 - jj) * 256 + c]);
        for (int i = 0; i < 32; ++i) {
            const int tt = tt0 + i, r = 15 + tt;
            const float pv = bf2f(P[r * 256 + c]);
            run += pv;
            const int tabs = t0 + tt, nn = (tabs + 1 < w) ? (tabs + 1) : w;
            PA[tt * 264 + c] = f2bf(run / (float)nn - pv);
            run -= bf2f(P[(r - w + 1) * 256 + c]);
        }
    }
    __syncthreads();
    {
        const int g = wid >> 1, mh = wid & 1, fr = lane & 15, fq = lane >> 4;
        const bf16_t* PT = (const bf16_t*)(ws + WS_POOLT) + (size_t)(l * 4 + g) * 64 * 64;
        f32x4 acc[2][4];
#pragma unroll
        for (int mi = 0; mi < 2; ++mi)
#pragma unroll
            for (int ni = 0; ni < 4; ++ni) acc[mi][ni] = (f32x4){0.f, 0.f, 0.f, 0.f};
#pragma unroll
        for (int ks = 0; ks < 2; ++ks) {
            bf16x8 A[2];
#pragma unroll
            for (int mi = 0; mi < 2; ++mi) A[mi] = *(const LAS bf16x8*)(PA + (16 * (2 * mh + mi) + fr) * 264 + g * 64 + 32 * ks + 8 * fq);
#pragma unroll
            for (int ni = 0; ni < 4; ++ni) { const bf16x8 Bf = *(const bf16x8*)(PT + (16 * ni + fr) * 64 + 32 * ks + 8 * fq);
#pragma unroll
                for (int mi = 0; mi < 2; ++mi) acc[mi][ni] = mfma16(A[mi], Bf, acc[mi][ni]); }
        }
        const float* pb = IN_F(I_POOLB) + l * 256; const float* ps = IN_F(I_POOLS) + l * 256;
#pragma unroll
        for (int ni = 0; ni < 4; ++ni) { const int d = g * 64 + 16 * ni + fr; const float bb = pb[d], sc = ps[d];
#pragma unroll
            for (int mi = 0; mi < 2; ++mi)
#pragma unroll
                for (int r = 0; r < 4; ++r) YB[(16 * (2 * mh + mi) + 4 * fq + r) * 260 + d] = (acc[mi][ni][r] + bb) * sc; }
    }
    __syncthreads();
    rows_rms_store(YB, IN_F(I_ONORM) + l * D + 512, (bf16_t*)(ws + WS_MIXB), tok0, 512, wid, lane);
    __syncthreads();
}

__device__ __forceinline__ void item_conv(const Args& a, int l, int tile, LAS unsigned char* lds) {
    KArgs* ka = kargs();
    const int tid = opaque_tid(), wid = __builtin_amdgcn_readfirstlane(tid >> 6), lane = tid & 63;
    unsigned char* ws = ka->ws;
    const bf16_t* proj = (const bf16_t*)(ws + WS_PROJ);
    LAS float* GL = (LAS float*)lds;
    LAS bf16_t* CA = (LAS bf16_t*)(lds + 96256);
    LAS float* YB = (LAS float*)lds;
    const int tok0 = tile * 64, b = tok0 / S, t0 = tok0 % S;
#pragma unroll
    for (int p = tid; p < 94 * 32; p += NTHR) {
        const int r = p >> 5, c8 = p & 31, t = t0 - 30 + r;
        f32x4 o0 = (f32x4){0.f, 0.f, 0.f, 0.f}, o1 = o0;
        if (t >= 0) {
            const bf16_t* pr = proj + (size_t)(b * S + t) * NP;
            const u32x4 av = *(const u32x4*)(pr + NBA + c8 * 8), gv = *(const u32x4*)(pr + NBG + c8 * 8);
            o0[0] = bflo(av.x) * sigmoid_fast(bflo(gv.x)); o0[1] = bfhi(av.x) * sigmoid_fast(bfhi(gv.x)); o0[2] = bflo(av.y) * sigmoid_fast(bflo(gv.y)); o0[3] = bfhi(av.y) * sigmoid_fast(bfhi(gv.y));
            o1[0] = bflo(av.z) * sigmoid_fast(bflo(gv.z)); o1[1] = bfhi(av.z) * sigmoid_fast(bfhi(gv.z)); o1[2] = bflo(av.w) * sigmoid_fast(bflo(gv.w)); o1[3] = bfhi(av.w) * sigmoid_fast(bfhi(gv.w));
        }
        *(LAS f32x4*)(GL + r * 256 + c8 * 8) = o0; *(LAS f32x4*)(GL + r * 256 + c8 * 8 + 4) = o1;
    }
    __syncthreads();
    {
        const int c = tid & 255, half = tid >> 8;
        float wv[31];
#pragma unroll
        for (int jj = 0; jj < 31; ++jj) wv[jj] = IN_F(I_CONVW)[((size_t)l * 31 + jj) * 256 + c];
        const float cb = IN_F(I_CONVB)[l * 256 + c];
        float yv[32];
#pragma unroll
        for (int ch = 0; ch < 8; ++ch) {
            const int tt = half * 32 + ch * 4;
            float x[34];
#pragma unroll
            for (int m2 = 0; m2 < 34; ++m2) x[m2] = GL[(tt + m2) * 256 + c];
#pragma unroll
            for (int i = 0; i < 4; ++i) {
                float y = cb;
#pragma unroll
                for (int jj = 0; jj < 31; ++jj) y += x[i + jj] * wv[jj];
                yv[ch * 4 + i] = y;
            }
        }
        __syncthreads();
#pragma unroll
        for (int i = 0; i < 32; ++i) YB[(half * 32 + i) * 260 + c] = yv[i];
    }
    __syncthreads();
    {
        const int t = tid >> 3, part = tid & 7;
        float y[32]; float s1 = 0.f;
#pragma unroll
        for (int i = 0; i < 8; ++i) { const f32x4 v = *(const LAS f32x4*)(YB + t * 260 + part * 32 + 4 * i); y[4 * i] = v[0]; y[4 * i + 1] = v[1]; y[4 * i + 2] = v[2]; y[4 * i + 3] = v[3]; s1 += (v[0] + v[1]) + (v[2] + v[3]); }
        s1 += dpp_f<0xB1>(s1);
        const float mu = s1 * (1.0f / 64.0f);
        float s2 = 0.f;
#pragma unroll
        for (int i = 0; i < 32; ++i) { y[i] -= mu; s2 += y[i] * y[i]; }
        s2 += dpp_f<0xB1>(s2);
        const float rs = rsqrtf(s2 * (1.0f / 64.0f) + EPS);
        const float* lng = IN_F(I_CLNG) + l * 256 + part * 32; const float* lnb = IN_F(I_CLNB) + l * 256 + part * 32;
#pragma unroll
        for (int i = 0; i < 4; ++i) {
            float o[8];
#pragma unroll
            for (int e = 0; e < 8; ++e) o[e] = silu_f(y[8 * i + e] * rs * lng[8 * i + e] + lnb[8 * i + e]);
            u32x4 w; w.x = cvt_pk_bf16(o[0], o[1]); w.y = cvt_pk_bf16(o[2], o[3]); w.z = cvt_pk_bf16(o[4], o[5]); w.w = cvt_pk_bf16(o[6], o[7]);
            *(LAS u32x4*)(CA + t * 264 + part * 32 + 8 * i) = w;
        }
    }
    __syncthreads();
    {
        const int fr = lane & 15, fq = lane >> 4;
        const bf16_t* PW = (const bf16_t*)(ws + WS_PWT) + (size_t)l * 65536;
        f32x4 acc[4][2];
#pragma unroll
        for (int mi = 0; mi < 4; ++mi)
#pragma unroll
            for (int ni = 0; ni < 2; ++ni) acc[mi][ni] = (f32x4){0.f, 0.f, 0.f, 0.f};
#pragma unroll 2
        for (int ks = 0; ks < 8; ++ks) {
            bf16x8 Bf[2];
#pragma unroll
            for (int ni = 0; ni < 2; ++ni) Bf[ni] = *(const bf16x8*)(PW + (size_t)(32 * wid + 16 * ni + fr) * 256 + 32 * ks + 8 * fq);
#pragma unroll
            for (int mi = 0; mi < 4; ++mi) { const bf16x8 Af = *(const LAS bf16x8*)(CA + (16 * mi + fr) * 264 + 32 * ks + 8 * fq);
#pragma unroll
                for (int ni = 0; ni < 2; ++ni) acc[mi][ni] = mfma16(Af, Bf[ni], acc[mi][ni]); }
        }
        const float* pwb = IN_F(I_PWB) + l * 256;
#pragma unroll
        for (int ni = 0; ni < 2; ++ni) { const int n = 32 * wid + 16 * ni + fr; const float bb = pwb[n];
#pragma unroll
            for (int mi = 0; mi < 4; ++mi)
#pragma unroll
                for (int r = 0; r < 4; ++r) YB[(16 * mi + 4 * fq + r) * 260 + n] = acc[mi][ni][r] + bb; }
    }
    __syncthreads();
    rows_rms_store(YB, IN_F(I_ONORM) + l * D + 256, (bf16_t*)(ws + WS_MIXB), tok0, 256, wid, lane);
    __syncthreads();
}

__device__ __forceinline__ void item_sgu(const Args& a, int l, int ch, LAS unsigned char* lds) {
    KArgs* ka = kargs();
    const int tid = opaque_tid(), wid = __builtin_amdgcn_readfirstlane(tid >> 6), lane = tid & 63;
    unsigned char* ws = ka->ws;
    const bf16_t* proj = (const bf16_t*)(ws + WS_PROJ);
    LAS bf16_t* VT = (LAS bf16_t*)lds;
    LAS bf16_t* OB = (LAS bf16_t*)(lds + 69632);
    const int tok0 = ch * 128;
    {
        const f32x4 lg = *(const f32x4*)(IN_F(I_SLNG) + l * 256 + 4 * lane), lb = *(const f32x4*)(IN_F(I_SLNB) + l * 256 + 4 * lane);
#pragma unroll 8
        for (int i = 0; i < 16; ++i) {
            const int s = 16 * wid + i;
            const u32x2 vv = *(const u32x2*)(proj + (size_t)(tok0 + s) * NP + NDV + 4 * lane);
            const float v0 = bflo(vv.x), v1 = bfhi(vv.x), v2 = bflo(vv.y), v3 = bfhi(vv.y);
            const float mu = wave_sum((v0 + v1) + (v2 + v3)) * (1.0f / 256.0f);
            const float d0 = v0 - mu, d1 = v1 - mu, d2 = v2 - mu, d3 = v3 - mu;
            const float rs = rsqrtf(wave_sum((d0 * d0 + d1 * d1) + (d2 * d2 + d3 * d3)) * (1.0f / 256.0f) + EPS);
            VT[(4 * lane + 0) * 136 + s] = f2bf(d0 * rs * lg[0] + lb[0]); VT[(4 * lane + 1) * 136 + s] = f2bf(d1 * rs * lg[1] + lb[1]);
            VT[(4 * lane + 2) * 136 + s] = f2bf(d2 * rs * lg[2] + lb[2]); VT[(4 * lane + 3) * 136 + s] = f2bf(d3 * rs * lg[3] + lb[3]);
        }
    }
    __syncthreads();
    {
        const int h = wid >> 1, np = wid & 1, fr = lane & 15, fq = lane >> 4;
        const bf16_t* W = (const bf16_t*)(ws + WS_SGUW) + (size_t)(l * 4 + h) * 128 * 128;
        const float* sb = IN_F(I_SGUB) + (l * 4 + h) * 128;
#pragma unroll 1
        for (int mi = 0; mi < 8; ++mi) {
            f32x4 acc[2] = {(f32x4){0.f, 0.f, 0.f, 0.f}, (f32x4){0.f, 0.f, 0.f, 0.f}};
            for (int ks = 0; ks <= (mi >> 1); ++ks) {
                const bf16x8 Af = *(const bf16x8*)(W + (size_t)(16 * mi + fr) * 128 + 32 * ks + 8 * fq);
#pragma unroll
                for (int ni = 0; ni < 2; ++ni) { const bf16x8 Bf = *(const LAS bf16x8*)(VT + (h * 64 + 32 * np + 16 * ni + fr) * 136 + 32 * ks + 8 * fq); acc[ni] = mfma16(Af, Bf, acc[ni]); }
            }
#pragma unroll
            for (int ni = 0; ni < 2; ++ni)
#pragma unroll
                for (int r = 0; r < 4; ++r) { const int t = 16 * mi + 4 * fq + r; OB[t * 264 + h * 64 + 32 * np + 16 * ni + fr] = f2bf(acc[ni][r] + sb[t]); }
        }
    }
    __syncthreads();
    {
        const f32x4 gv = *(const f32x4*)(IN_F(I_ONORM) + l * D + 768 + 4 * lane);
        bf16_t* mixb = (bf16_t*)(ws + WS_MIXB);
#pragma unroll 8
        for (int i = 0; i < 16; ++i) {
            const int t = 16 * wid + i;
            const u32x2 mv = *(const LAS u32x2*)(OB + t * 264 + 4 * lane);
            const u32x2 uv = *(const u32x2*)(proj + (size_t)(tok0 + t) * NP + NDU + 4 * lane);
            const float o0 = bflo(uv.x) * bflo(mv.x), o1 = bfhi(uv.x) * bfhi(mv.x), o2 = bflo(uv.y) * bflo(mv.y), o3 = bfhi(uv.y) * bfhi(mv.y);
            const float r = rsqrtf(wave_sum((o0 * o0 + o1 * o1) + (o2 * o2 + o3 * o3)) * (1.0f / 256.0f) + EPS);
            u32x2 w; w.x = cvt_pk_bf16(o0 * r * gv[0], o1 * r * gv[1]); w.y = cvt_pk_bf16(o2 * r * gv[2], o3 * r * gv[3]);
            *(u32x2*)(mixb + (size_t)(tok0 + t) * D + 768 + 4 * lane) = w;
        }
    }
    __syncthreads();
}

__device__ __forceinline__ void item_prepk(const Args& a, int l, int tile, LAS unsigned char* lds) {
    KArgs* ka = kargs();
    const int tid = opaque_tid(), wid = __builtin_amdgcn_readfirstlane(tid >> 6), lane = tid & 63;
    unsigned char* ws = ka->ws;
    const bf16_t* proj = (const bf16_t*)(ws + WS_PROJ);
    LAS bf16_t* VS = (LAS bf16_t*)lds;
    bf16_t* KN = (bf16_t*)(ws + WS_KN); bf16_t* VTg = (bf16_t*)(ws + WS_VT); bf16_t* IKR = (bf16_t*)(ws + WS_IKR);
    const float* ropeA = (const float*)(ws + WS_ROPEA); const float* ropeI = (const float*)(ws + WS_ROPEI);
    const int tok0 = tile * 64, b = tok0 / S, s0 = tok0 % S;
    const int li = lane & 15, head = lane >> 4;
    const f32x4 kg = *(const f32x4*)(IN_F(I_KN) + l * 64 + 4 * li);
#pragma unroll 4
    for (int i = 0; i < 8; ++i) {
        const int tl = 8 * wid + i, tok = tok0 + tl, s = s0 + tl;
        const bf16_t* pr = proj + (size_t)tok * NP;
        const u32x2 kv = *(const u32x2*)(pr + NK + 4 * lane);
        float k0 = bflo(kv.x), k1 = bfhi(kv.x), k2 = bflo(kv.y), k3 = bfhi(kv.y);
        float ss = (k0 * k0 + k1 * k1) + (k2 * k2 + k3 * k3);
        ss = row_sum16(ss);
        const float r = rsqrtf(ss * (1.0f / 64.0f) + EPS);
        k0 *= r * kg[0]; k1 *= r * kg[1]; k2 *= r * kg[2]; k3 *= r * kg[3];
        {
            const float p0 = __shfl_xor(k0, 2), p1 = __shfl_xor(k1, 2), p2 = __shfl_xor(k2, 2), p3 = __shfl_xor(k3, 2);
            if (li < 4) {
                const int dd = 4 * (li & 1);
                const f32x4 cs = *(const f32x4*)(ropeA + (size_t)tok * 16 + dd), sn = *(const f32x4*)(ropeA + (size_t)tok * 16 + 8 + dd);
                if (li < 2) { k0 = k0 * cs[0] - p0 * sn[0]; k1 = k1 * cs[1] - p1 * sn[1]; k2 = k2 * cs[2] - p2 * sn[2]; k3 = k3 * cs[3] - p3 * sn[3]; }
                else        { k0 = k0 * cs[0] + p0 * sn[0]; k1 = k1 * cs[1] + p1 * sn[1]; k2 = k2 * cs[2] + p2 * sn[2]; k3 = k3 * cs[3] + p3 * sn[3]; }
            }
        }
        u32x2 ko; ko.x = cvt_pk_bf16(k0, k1); ko.y = cvt_pk_bf16(k2, k3);
        *(u32x2*)(KN + ((size_t)((b * 4 + head) * 128 + (s >> 5)) * 32 + (s & 31)) * 64 + 4 * li) = ko;
        *(LAS u32x2*)(VS + tl * 256 + 4 * lane) = *(const u32x2*)(pr + NV + 4 * lane);
        if (lane < 8) {
            const u32x2 iv = *(const u32x2*)(pr + NIK + 4 * lane);
            float x0 = bflo(iv.x), x1 = bfhi(iv.x), x2 = bflo(iv.y), x3 = bfhi(iv.y);
            const float q0 = __shfl_xor(x0, 1), q1 = __shfl_xor(x1, 1), q2 = __shfl_xor(x2, 1), q3 = __shfl_xor(x3, 1);
            if (lane < 2) {
                const f32x4 cs = *(const f32x4*)(ropeI + (size_t)tok * 8), sn = *(const f32x4*)(ropeI + (size_t)tok * 8 + 4);
                if (lane == 0) { x0 = x0 * cs[0] - q0 * sn[0]; x1 = x1 * cs[1] - q1 * sn[1]; x2 = x2 * cs[2] - q2 * sn[2]; x3 = x3 * cs[3] - q3 * sn[3]; }
                else           { x0 = x0 * cs[0] + q0 * sn[0]; x1 = x1 * cs[1] + q1 * sn[1]; x2 = x2 * cs[2] + q2 * sn[2]; x3 = x3 * cs[3] + q3 * sn[3]; }
            }
            u32x2 io; io.x = cvt_pk_bf16(x0, x1); io.y = cvt_pk_bf16(x2, x3);
            *(u32x2*)(IKR + (size_t)tok * 32 + 4 * lane) = io;
        }
    }
    __syncthreads();
#pragma unroll
    for (int i = 0; i < 4; ++i) {
        const int p = tid + NTHR * i;
        const int h = p >> 9, ktl = (p >> 8) & 1, d = (p >> 2) & 63, part = p & 3;
        unsigned short e[8];
#pragma unroll
        for (int jj = 0; jj < 8; ++jj) { const int key = 4 * part + (jj & 3) + 16 * (jj >> 2); e[jj] = VS[(ktl * 32 + key) * 256 + h * 64 + d]; }
        u32x4 w; w.x = e[0] | ((unsigned)e[1] << 16); w.y = e[2] | ((unsigned)e[3] << 16); w.z = e[4] | ((unsigned)e[5] << 16); w.w = e[6] | ((unsigned)e[7] << 16);
        *(u32x4*)(VTg + ((size_t)((b * 4 + h) * 128 + (s0 >> 5) + ktl) * 64 + d) * 32 + 8 * part) = w;
    }
    __syncthreads();
}

__device__ __forceinline__ void phase_mix1(const Args& a, int l, LAS unsigned char* lds, int vcu, int G, int bx) {
    if (G == 256) {
        if (bx < 64) { item_conv(a, l, bx, lds); item_pool(a, l, bx, lds); }
        else {
            const int w = bx - 64;
            if (w < 128) item_sgu(a, l, w, lds);
            item_prepk(a, l, w, lds);
            item_conv(a, l, 64 + w, lds);
            if (w >= 128) item_prepk(a, l, 192 + (w - 128), lds);
            item_pool(a, l, 64 + w, lds);
        }
        return;
    }
    for (int it = vcu; it < 896; it += G) {
        if (it < 128) item_sgu(a, l, it, lds);
        else if (it < 384) item_conv(a, l, it - 128, lds);
        else if (it < 640) item_pool(a, l, it - 384, lds);
        else item_prepk(a, l, it - 640, lds);
    }
}
__device__ __forceinline__ f32x16 mfma32(const bf16x8 a, const bf16x8 b, const f32x16 c) { return __builtin_amdgcn_mfma_f32_32x32x16_bf16(a, b, c, 0, 0, 0); }
__device__ __forceinline__ unsigned mono_key(float f) { const unsigned u = __float_as_uint(f); return u ^ ((unsigned)((int)u >> 31) | 0x80000000u); }

__device__ __forceinline__ void a1_keys(const bf16x8 A0, const bf16x8 A1, const bf16x8 (&Bq)[4][2], const float (&cl)[4], unsigned (&key)[16]) {
    float sc[16];
#pragma unroll
    for (int r = 0; r < 16; ++r) sc[r] = 0.0f;
#pragma unroll
    for (int h = 0; h < 4; ++h) {
        f32x16 d;
#pragma unroll
        for (int r = 0; r < 16; ++r) d[r] = 0.f;
        d = mfma32(A0, Bq[h][0], d); d = mfma32(A1, Bq[h][1], d);
#pragma unroll
        for (int r = 0; r < 16; ++r) sc[r] += __builtin_amdgcn_fmed3f(d[r], 0.0f, cl[h]);
    }
#pragma unroll
    for (int r = 0; r < 16; ++r) key[r] = mono_key(sc[r]);
}

__device__ __forceinline__ unsigned wcode(unsigned key) {
    const int v = (int)(key >> 20);
    const int t = (key < 0x80000000u) ? (v < 1096 ? v : 1096) + 1901 : (v > 2999 ? v : 2999);
    const int c = t - 2864;
    return (unsigned)(c < 12 ? 12 : (c > 255 ? 255 : c));
}

#define A1_STREAM_BEGIN { \
    bf16x8 rA[4][2]; const int ntw_ = (nkt - wid + 7) >> 3; \
    _Pragma("unroll") for (int u_ = 0; u_ < 4; ++u_) { rA[u_][0] = Bq[0][0]; rA[u_][1] = Bq[0][0]; if (u_ < ntw_) { const size_t o_ = (size_t)(wid + 8 * u_) * 1024; rA[u_][0] = *(const bf16x8*)(ikl + o_); rA[u_][1] = *(const bf16x8*)(ikl + o_ + 16); } } \
    for (int i_ = 0; i_ < ntw_; i_ += 4) { \
        _Pragma("unroll") for (int u_ = 0; u_ < 4; ++u_) { if (i_ + u_ < ntw_) { \
            const bf16x8 cA0 = rA[u_][0], cA1 = rA[u_][1]; const int kt = wid + 8 * (i_ + u_); \
            if (i_ + u_ + 4 < ntw_) { const size_t o_ = (size_t)(kt + 32) * 1024; rA[u_][0] = *(const bf16x8*)(ikl + o_); rA[u_][1] = *(const bf16x8*)(ikl + o_ + 16); }
#define A1_STREAM_END } } } }

template <int KIND>
__device__ __forceinline__ void a1_pass(const bf16_t* ikl, int nkt, int wid, int q, int hh, const bf16x8 (&Bq)[4][2], const float (&cl)[4], LAS unsigned* hist, int sh, unsigned prefix, bool tieq, unsigned g16) {
    const unsigned dump = 256u * 32u + (unsigned)q;
    A1_STREAM_BEGIN
        unsigned key[16];
        a1_keys(cA0, cA1, Bq, cl, key);
#pragma unroll
        for (int r = 0; r < 16; ++r) {
            const int s = kt * 32 + (r & 3) + 8 * (r >> 2) + 4 * hh;
            unsigned digit; bool match;
            if (KIND == 0) { digit = key[r] >> 24; match = true; }
            else if (KIND == 1) { digit = (key[r] >> sh) & 255u; match = (key[r] >> (sh + 8)) == prefix; }
            else if (KIND == 2) { digit = 255u - (unsigned)(s >> 4); match = ((unsigned)tieq & (unsigned)(key[r] == prefix)) != 0u; }
            else if (KIND == 3) { digit = 15u - (unsigned)(s & 15); match = ((unsigned)tieq & (unsigned)(key[r] == prefix) & (unsigned)((unsigned)(s >> 4) == g16)) != 0u; }
            else { digit = wcode(key[r]); match = true; }
            const unsigned idx = match ? digit * 32u + (unsigned)q : dump;
            __hip_atomic_fetch_add(hist + idx, 1u, __ATOMIC_RELAXED, __HIP_MEMORY_SCOPE_WORKGROUP);
        }
    A1_STREAM_END
}

template <int MODE_CLASS>
__device__ __forceinline__ void a1_scan(LAS unsigned* hist, LAS unsigned* psum, LAS unsigned* qst, int tid, bool last) {
    const int sq = tid & 31, part = tid >> 5;
    const unsigned need = qst[32 + sq], pfx = qst[sq];
    unsigned local = 0u;
#pragma unroll
    for (int bb = 0; bb < 16; ++bb) local += hist[(16 * part + bb) * 32 + sq];
    psum[part * 32 + sq] = local;
    __syncthreads();
    unsigned above = 0u;
    for (int pp = part + 1; pp < 16; ++pp) above += psum[pp * 32 + sq];
    if (above < need && above + local >= need) {
        unsigned run = above;
        for (int bb = 15; bb >= 0; --bb) {
            const unsigned c = hist[(16 * part + bb) * 32 + sq];
            if (run + c >= need) {
                const unsigned bin = (unsigned)(16 * part + bb);
                if (MODE_CLASS == 0) { qst[sq] = (pfx << 8) | bin; qst[32 + sq] = need - run; qst[64 + sq] = c; if (last && need - run < c) qst[160] = 1u; }
                else if (MODE_CLASS == 1) { qst[128 + sq] = 255u - bin; qst[32 + sq] = need - run; qst[64 + sq] = 0xffffffffu; }
                else { qst[96 + sq] = qst[128 + sq] * 16u + (15u - bin); }
                break;
            }
            run += c;
        }
    }
}

constexpr int A1_HIST = 0, A1_PSUM = 257 * 32, A1_QST = A1_PSUM + 16 * 32, A1_MBUF = A1_QST + 6 * 32 + 32, A1_TBUF = A1_MBUF + 32 * 128;
constexpr int A1_CAPL = 16, A1_LKEY = A1_MBUF + 32 * 128, A1_LIDX = A1_LKEY + 512 * A1_CAPL, A1_PCNT = A1_LIDX + 512 * A1_CAPL, A1_CAP = 200;
__device__ __forceinline__ void a1_tile(const Args& a, int l, int b, int j, LAS unsigned char* lds) {
    KArgs* ka = kargs();
    const int tid = opaque_tid(), wid = __builtin_amdgcn_readfirstlane(tid >> 6), lane = tid & 63, q = lane & 31, hh = lane >> 5;
    unsigned char* ws = ka->ws;
    const bf16_t* proj = (const bf16_t*)(ws + WS_PROJ);
    const bf16_t* ikr = (const bf16_t*)(ws + WS_IKR) + (size_t)b * S * 32;
    const bf16_t* ikl = ikr + (lane & 31) * 32 + 8 * (lane >> 5);
    unsigned* maskg = (unsigned*)(ws + WS_MASK);
    LAS unsigned* L = (LAS unsigned*)lds;
    LAS unsigned* hist = L + A1_HIST; LAS unsigned* psum = L + A1_PSUM; LAS unsigned* qst = L + A1_QST; LAS unsigned* mbuf = L + A1_MBUF; LAS unsigned* tbuf = L + A1_TBUF;
    LAS unsigned* lkey = L + A1_LKEY; LAS unsigned* lidx = L + A1_LIDX; LAS unsigned* pcnt = L + A1_PCNT;
    const int t0 = j * 32, n = (t0 / 64 + 1) * 64, nkt = n / 32, nw = ((t0 / 128) + 1) * 4;
    if (n <= 256) {
        for (int i = tid; i < 32 * nw; i += NTHR) { const int qq = i / nw, w = i % nw; maskg[(size_t)(b * S + t0 + qq) * 128 + w] = (w < nkt) ? 0xffffffffu : 0u; }
        return;
    }
    bf16x8 Bq[4][2]; float cl[4];
    {
        const int tok = b * S + t0 + q;
        const bf16_t* pr = proj + (size_t)tok * NP;
        const f32x4 cs = *(const f32x4*)((const float*)(ws + WS_ROPEI) + (size_t)tok * 8), sn = *(const f32x4*)((const float*)(ws + WS_ROPEI) + (size_t)tok * 8 + 4);
#pragma unroll
        for (int h = 0; h < 4; ++h) {
            const float wsc = bf2f(pr[NIW + h]) * (0.5f * 0.17677669529663687f);
            cl[h] = (wsc > 0.f) ? INFINITY : -INFINITY;
#pragma unroll
            for (int ks = 0; ks < 2; ++ks) {
                const u32x4 raw = *(const u32x4*)(pr + NIQ + h * 32 + 16 * ks + 8 * hh);
                float v[8] = {bflo(raw.x), bfhi(raw.x), bflo(raw.y), bfhi(raw.y), bflo(raw.z), bfhi(raw.z), bflo(raw.w), bfhi(raw.w)};
                if (ks == 0 && hh == 0) {
#pragma unroll
                    for (int i = 0; i < 4; ++i) { const float x1 = v[i], x2 = v[i + 4]; v[i] = x1 * cs[i] - x2 * sn[i]; v[i + 4] = x2 * cs[i] + x1 * sn[i]; }
                }
                u32x4 pk; pk.x = cvt_pk_bf16(v[0] * wsc, v[1] * wsc); pk.y = cvt_pk_bf16(v[2] * wsc, v[3] * wsc); pk.z = cvt_pk_bf16(v[4] * wsc, v[5] * wsc); pk.w = cvt_pk_bf16(v[6] * wsc, v[7] * wsc);
                Bq[h][ks] = __builtin_bit_cast(bf16x8, pk);
            }
        }
    }
    {
        if (tid < 32) { qst[tid] = 0u; qst[32 + tid] = 256u; qst[64 + tid] = 0u; qst[96 + tid] = 4095u; qst[128 + tid] = 0u; }
        if (tid == 32) qst[160] = 0u;
        __syncthreads();
        for (int mode = 0; mode < 4; ++mode) {
            for (int i = tid; i < 257 * 32; i += NTHR) hist[i] = 0u;
            __syncthreads();
            const unsigned prefix = qst[q];
            const int sh = 24 - 8 * mode;
            if (mode == 0) a1_pass<0>(ikl, nkt, wid, q, hh, Bq, cl, hist, 0, 0u, false, 0u);
            else a1_pass<1>(ikl, nkt, wid, q, hh, Bq, cl, hist, sh, prefix, false, 0u);
            __syncthreads();
            a1_scan<0>(hist, psum, qst, tid, mode == 3);
            __syncthreads();
        }
        __syncthreads();
        {
            const unsigned T = qst[q];
            A1_STREAM_BEGIN
                unsigned key[16];
                a1_keys(cA0, cA1, Bq, cl, key);
                unsigned wb = 0u, tb = 0u;
#pragma unroll
                for (int r = 0; r < 16; ++r) {
                    const int row = (r & 3) + 8 * (r >> 2) + 4 * hh;
                    wb |= (key[r] > T) ? (1u << row) : 0u;
                    tb |= (key[r] == T) ? (1u << row) : 0u;
                }
                wb |= (unsigned)__shfl_xor((int)wb, 32); tb |= (unsigned)__shfl_xor((int)tb, 32);
                if (hh == 0) { mbuf[q * 128 + kt] = wb; tbuf[q * 128 + kt] = tb; }
            A1_STREAM_END
        }
        __syncthreads();
        for (int i = tid; i < 32 * nkt; i += NTHR) { const int qq = i / nkt, w = i % nkt; if (qst[32 + qq] >= qst[64 + qq]) mbuf[qq * 128 + w] |= tbuf[qq * 128 + w]; }
        if (tid < 32 && qst[32 + tid] < qst[64 + tid]) {
            unsigned rem = qst[32 + tid];
            for (int w = 0; w < nkt && rem; ++w) {
                unsigned t = tbuf[tid * 128 + w]; const unsigned c = (unsigned)__builtin_popcount(t);
                if (c <= rem) { mbuf[tid * 128 + w] |= t; rem -= c; }
                else { unsigned keep = 0u; for (; rem; --rem) { const unsigned low = t & (0u - t); keep |= low; t ^= low; } mbuf[tid * 128 + w] |= keep; }
            }
        }
    }
    __syncthreads();
    for (int i = tid; i < 32 * nw; i += NTHR) { const int qq = i / nw, w = i % nw; maskg[(size_t)(b * S + t0 + qq) * 128 + w] = (w < nkt) ? mbuf[qq * 128 + w] : 0u; }
    __syncthreads();
}
__device__ __forceinline__ void phase_a1(const Args& a, int l, LAS unsigned char* lds, int vcu, int G) {
    KArgs* ka = kargs();
    for (int it = vcu; it < 256; it += G) { const int b = it >> 6, jj = it & 63; a1_tile(a, l, b, 127 - jj, lds); a1_tile(a, l, b, jj, lds); }
}

__device__ __forceinline__ void a2_unit(const Args& a, int l, int b, int h, int blk, LAS unsigned char* lds) {
    KArgs* ka = kargs();
    const int tid = opaque_tid(), wid = __builtin_amdgcn_readfirstlane(tid >> 6), lane = tid & 63, fr = lane & 15, kq = lane >> 4;
    unsigned char* ws = ka->ws;
    const bf16_t* proj = (const bf16_t*)(ws + WS_PROJ);
    const char* KNb = (const char*)(ws + WS_KN) + (size_t)(b * 4 + h) * 128 * 4096;
    const char* VTb = (const char*)(ws + WS_VT) + (size_t)(b * 4 + h) * 128 * 4096;
    LAS unsigned char* Kb = lds;
    LAS unsigned char* Vb = lds + 32768;
    LAS float* Ob = (LAS float*)(lds + 65536) + wid * (16 * 68);
    const int nsteps = 2 * (blk + 1);
    const int tokq = b * S + blk * 128 + wid * 16 + fr;
    bf16x8 Qb[2]; float C2;
    {
        const float* qg = IN_F(I_QN) + l * 64; const float* kg = IN_F(I_KN) + l * 64;
        float gq = 0.f, gk = 0.f;
        for (int i = 0; i < 64; ++i) { gq = fmaxf(gq, fabsf(qg[i])); gk = fmaxf(gk, fabsf(kg[i])); }
        C2 = 8.0f * gq * gk * 1.4426950408889634f;
        const bf16_t* pr = proj + (size_t)tokq * NP + NQ + h * 64;
        float v[2][8]; float ss = 0.f;
#pragma unroll
        for (int ks = 0; ks < 2; ++ks) { const u32x4 raw = *(const u32x4*)(pr + 32 * ks + 8 * kq);
            v[ks][0] = bflo(raw.x); v[ks][1] = bfhi(raw.x); v[ks][2] = bflo(raw.y); v[ks][3] = bfhi(raw.y); v[ks][4] = bflo(raw.z); v[ks][5] = bfhi(raw.z); v[ks][6] = bflo(raw.w); v[ks][7] = bfhi(raw.w);
#pragma unroll
            for (int i = 0; i < 8; ++i) ss += v[ks][i] * v[ks][i]; }
        ss += __shfl_xor(ss, 16); ss += __shfl_xor(ss, 32);
        const float r = rsqrtf(ss * (1.0f / 64.0f) + EPS);
#pragma unroll
        for (int ks = 0; ks < 2; ++ks)
#pragma unroll
            for (int i = 0; i < 8; ++i) v[ks][i] *= r * qg[32 * ks + 8 * kq + i];
        {
            const float* ra = (const float*)(ws + WS_ROPEA) + (size_t)tokq * 16;
#pragma unroll
            for (int i = 0; i < 8; ++i) { const float pv = __shfl_xor(v[0][i], 16); const float c = ra[i], s = ra[8 + i];
                if (kq == 0) v[0][i] = v[0][i] * c - pv * s; else if (kq == 1) v[0][i] = v[0][i] * c + pv * s; }
        }
        const float qs = 0.125f * 1.4426950408889634f;
#pragma unroll
        for (int ks = 0; ks < 2; ++ks) { u32x4 pk; pk.x = cvt_pk_bf16(v[ks][0] * qs, v[ks][1] * qs); pk.y = cvt_pk_bf16(v[ks][2] * qs, v[ks][3] * qs); pk.z = cvt_pk_bf16(v[ks][4] * qs, v[ks][5] * qs); pk.w = cvt_pk_bf16(v[ks][6] * qs, v[ks][7] * qs);
            Qb[ks] = __builtin_bit_cast(bf16x8, pk); }
    }
    const unsigned* mrow = (const unsigned*)(ws + WS_MASK) + (size_t)tokq * 128;
    f32x4 O[4];
#pragma unroll
    for (int dt = 0; dt < 4; ++dt) O[dt] = (f32x4){0.f, 0.f, 0.f, 0.f};
    float lsum = 0.f;
    const unsigned bit0 = 1u << (4 * kq);
    const int kkey = tid >> 3, kch = tid & 7, vsub = tid >> 8, vd = (tid >> 2) & 63, vch = tid & 3;
    const int klds = kkey * 128 + ((kch ^ (kkey & 7)) * 16), vlds = vsub * 4096 + vd * 64 + ((vch ^ ((vd >> 2) & 3)) * 16);
    u32x4 kr0, kr1, kr2, kr3, vr0, vr1, vr2, vr3; u32x2 mw0, mw1, mw2, mw3;
#define A2_LOAD(j, st_) do { kr##j = *(const u32x4*)(KNb + (size_t)(st_) * 8192 + (size_t)tid * 16); vr##j = *(const u32x4*)(VTb + (size_t)(st_) * 8192 + (size_t)tid * 16); mw##j = *(const u32x2*)(mrow + 2 * (st_)); } while (0)
    A2_LOAD(0, 0); A2_LOAD(1, 1);
    if (nsteps > 2) { A2_LOAD(2, 2); A2_LOAD(3, 3); } else { kr2 = kr0; vr2 = vr0; mw2 = mw0; kr3 = kr0; vr3 = vr0; mw3 = mw0; }
    __syncthreads();
#define A2_HALF(Kc, Vc, mcur) do { \
        _Pragma("unroll") for (int sub = 0; sub < 2; ++sub) { \
            const unsigned m = sub ? (mcur).y : (mcur).x; \
            f32x4 Sx[2]; \
            _Pragma("unroll") for (int tl = 0; tl < 2; ++tl) { \
                const int key = 32 * sub + 16 * tl + fr; \
                const bf16x8 A0 = *(const LAS bf16x8*)((Kc) + key * 128 + (((0 + kq) ^ (key & 7)) * 16)); \
                const bf16x8 A1 = *(const LAS bf16x8*)((Kc) + key * 128 + (((4 + kq) ^ (key & 7)) * 16)); \
                f32x4 z = (f32x4){-C2, -C2, -C2, -C2};     \
                z = mfma16(A0, Qb[0], z); Sx[tl] = mfma16(A1, Qb[1], z); \
            } \
            float p[8]; \
            _Pragma("unroll") for (int r = 0; r < 4; ++r) { \
                const float e0 = __builtin_amdgcn_exp2f(Sx[0][r]), e1 = __builtin_amdgcn_exp2f(Sx[1][r]); \
                p[r] = (m & (bit0 << r)) ? e0 : 0.f; p[4 + r] = (m & (bit0 << (16 + r))) ? e1 : 0.f; \
            } \
            lsum += ((p[0] + p[1]) + (p[2] + p[3])) + ((p[4] + p[5]) + (p[6] + p[7])); \
            u32x4 pk; pk.x = cvt_pk_bf16(p[0], p[1]); pk.y = cvt_pk_bf16(p[2], p[3]); pk.z = cvt_pk_bf16(p[4], p[5]); pk.w = cvt_pk_bf16(p[6], p[7]); \
            const bf16x8 Pf = __builtin_bit_cast(bf16x8, pk); \
            _Pragma("unroll") for (int dt = 0; dt < 4; ++dt) { const int d = 16 * dt + fr; \
                const bf16x8 Av = *(const LAS bf16x8*)((Vc) + sub * 4096 + d * 64 + ((kq ^ ((d >> 2) & 3)) * 16)); \
                O[dt] = mfma16(Av, Pf, O[dt]); } \
        } } while (0)
#define A2_STEP2(ja, jb, s2_) do { \
        LAS unsigned char* Kc2 = Kb + ((s2_) & 1) * 16384; LAS unsigned char* Vc2 = Vb + ((s2_) & 1) * 16384; \
        *(LAS u32x4*)(Kc2 + klds) = kr##ja; *(LAS u32x4*)(Vc2 + vlds) = vr##ja; *(LAS u32x4*)(Kc2 + 8192 + klds) = kr##jb; *(LAS u32x4*)(Vc2 + 8192 + vlds) = vr##jb; \
        const u32x2 mcA = mw##ja, mcB = mw##jb; \
        __syncthreads(); \
        if (2 * (s2_) + 4 < nsteps) A2_LOAD(ja, 2 * (s2_) + 4); \
        if (2 * (s2_) + 5 < nsteps) A2_LOAD(jb, 2 * (s2_) + 5); \
        A2_HALF(Kc2, Vc2, mcA); A2_HALF(Kc2 + 8192, Vc2 + 8192, mcB); \
    } while (0)
    for (int s2 = 0; 2 * s2 < nsteps; s2 += 2) {
        A2_STEP2(0, 1, s2);
        if (2 * (s2 + 1) < nsteps) A2_STEP2(2, 3, s2 + 1);
    }
#undef A2_STEP2
#undef A2_HALF
#undef A2_LOAD
    lsum += __shfl_xor(lsum, 16); lsum += __shfl_xor(lsum, 32);
    const float inv = 1.0f / lsum;
#pragma unroll
    for (int dt = 0; dt < 4; ++dt)
#pragma unroll
        for (int r = 0; r < 4; ++r) Ob[fr * 68 + 16 * dt + 4 * kq + r] = O[dt][r] * inv;
    __syncthreads();
    {
        const int qq = lane >> 2, dp = (lane & 3) * 16;
        const LAS float* src = Ob + qq * 68 + dp;
        float f[16]; float sq = 0.f;
#pragma unroll
        for (int i = 0; i < 4; ++i) { const f32x4 t = *(const LAS f32x4*)(src + 4 * i); f[4 * i] = t[0]; f[4 * i + 1] = t[1]; f[4 * i + 2] = t[2]; f[4 * i + 3] = t[3]; sq += (t[0] * t[0] + t[1] * t[1]) + (t[2] * t[2] + t[3] * t[3]); }
        u32x4 w0, w1; w0.x = cvt_pk_bf16(f[0], f[1]); w0.y = cvt_pk_bf16(f[2], f[3]); w0.z = cvt_pk_bf16(f[4], f[5]); w0.w = cvt_pk_bf16(f[6], f[7]);
        w1.x = cvt_pk_bf16(f[8], f[9]); w1.y = cvt_pk_bf16(f[10], f[11]); w1.z = cvt_pk_bf16(f[12], f[13]); w1.w = cvt_pk_bf16(f[14], f[15]);
        const int tok = b * S + blk * 128 + wid * 16 + qq;
        bf16_t* op = (bf16_t*)(ws + WS_MIXB) + (size_t)tok * D + h * 64 + dp;
        *(u32x4*)op = w0; *(u32x4*)(op + 8) = w1;
        sq += dpp_f<0xB1>(sq); sq += dpp_f<0x4E>(sq);
        if ((lane & 3) == 0) ((float*)(ws + WS_SSQ))[((size_t)l * NTOK + tok) * 4 + h] = sq;
    }
    __syncthreads();
}
__device__ __forceinline__ void phase_a2(const Args& a, int l, LAS unsigned char* lds, int vcu, int G) {
    KArgs* ka = kargs();
    for (int it = vcu; it < 256; it += G) { const int b = it >> 6, h = (it >> 4) & 3, jj = it & 15; a2_unit(a, l, b, h, 31 - jj, lds); a2_unit(a, l, b, h, jj, lds); }
}
__global__ void __launch_bounds__(NTHR, 2) mk_fwd(Args a) {
    extern __shared__ __attribute__((aligned(16))) unsigned char lds_raw[];
    LAS unsigned char* lds = (LAS unsigned char*)lds_raw;
    const int tid = threadIdx.x, G = gridDim.x, bx = blockIdx.x;
    const int vcu = (G % 8 == 0) ? (bx % 8) * (G / 8) + bx / 8 : bx;
    if (tid < 64) ((LAS unsigned*)(lds + LDS_MISC))[tid] = 0u;
    __syncthreads();
    XcdBarrier bar; bar.bar = (unsigned*)(a.ws + WS_BAR); bar.x = 0; bar.st = nullptr;
    if (a.fused) bar = xcd_barrier_post((unsigned*)(a.ws + WS_BAR), (volatile LAS unsigned*)(lds + LDS_MISC + MISC_BAR));
#define GRID_BAR() do { if (a.fused) xcd_barrier(bar); } while (0)
#ifdef ONLY_PH
#define IN(k) ((k) == ONLY_PH && a.ph_lo <= (k) && (k) < a.ph_hi)
#else
#define IN(k) (a.ph_lo <= (k) && (k) < a.ph_hi)
#endif
    if (IN(PH_PRO)) { phase_prologue(a, lds, vcu, G); GRID_BAR(); }
    if (IN(PH_NORM0)) { KArgs* ka = kargs(); unsigned char* ws = ka->ws; float* modp = (float*)(ws + WS_MOD); phase_norm(IN_F(I_X), IN_F(I_NORM1), modp, modp + 1024, (bf16_t*)(ws + WS_HA), vcu, G); phase_rbias(a, lds, vcu, G); GRID_BAR(); }
    for (int l = a.l_lo; l < a.l_hi; ++l) {
        if (IN(PH_G1)) {
            KArgs* ka = kargs(); unsigned char* ws = ka->ws;
            pg8::DenseOrder S; S.init((const bf16_t*)(ws + WS_HA), (const bf16_t*)(ws + WS_WINT) + (size_t)l * NP * D, NTOK, (G == 256) ? NP - 256 : NP, D, G, bx);
            pg8::EpiBf16 E{(bf16_t*)(ws + WS_PROJ), NP};
            pg8::gemm_phase(lds, S, E);
            GRID_BAR();
        }
        if (IN(PH_MIX)) {
            if (G == 256 && bx < 64) {
                KArgs* ka = kargs(); unsigned char* ws = ka->ws;
                pg8::DenseOrder S; S.init((const bf16_t*)(ws + WS_HA), (const bf16_t*)(ws + WS_WINT) + (size_t)l * NP * D + (size_t)(NP - 256) * D, NTOK, 256, D, 64, bx);
                pg8::EpiBf16 E{(bf16_t*)(ws + WS_PROJ) + (NP - 256), NP};
                pg8::gemm_phase(lds, S, E);
            }
            phase_mix1(a, l, lds, vcu, G, bx); GRID_BAR();
        }
        if (IN(PH_A1)) { phase_a1(a, l, lds, vcu, G); GRID_BAR(); }
        if (IN(PH_A2)) { phase_a2(a, l, lds, vcu, G); GRID_BAR(); }
        if (IN(PH_G2)) {
            KArgs* ka = kargs(); unsigned char* ws = ka->ws; const float* xin = IN_F(I_X); const bf16_t* xinb = (l == 0) ? (const bf16_t*)nullptr : (const bf16_t*)(ws + WS_X1) + (size_t)NTOK * D; const float* mod = (const float*)(ws + WS_MOD) + (size_t)l * 4 * 6144;
            pg8::DenseOrder S; S.init((const bf16_t*)(ws + WS_MIXB), (const bf16_t*)(ws + WS_WOUTT) + (size_t)l * D * D, NTOK, D, D, G, bx);
            pg8::EpiResid E{xin, xinb, (bf16_t*)(ws + WS_X1), mod + 2048, (const float*)(ws + WS_SSQ) + (size_t)l * NTOK * 4};
            pg8::gemm_phase<pg8::EpiResid, pg8::DenseOrder, true>(lds, S, E);
            GRID_BAR();
        }
        if (IN(PH_ROUTE)) { phase_route(a, l, lds, vcu, G); GRID_BAR(); }
        if (IN(PH_UP)) {
            KArgs* ka = kargs(); unsigned char* ws = ka->ws;
            moe_cum(a, l, lds);
            pg8::MoeOrder<true> S; S.A = (const bf16_t*)(ws + WS_HA); S.Bt = (const bf16_t*)(ws + WS_WGUT) + (size_t)l * NE * 1024 * 1024; S.K = D; S.bstride = (size_t)1024 * 1024;
            S.list = (const int*)(ws + WS_LIST); S.cum = (const LAS int*)(lds + LDS_MISC + MISC_CUM); S.cnts = (const LAS int*)(lds + LDS_MISC + MISC_CNT); S.G = G; S.c = vcu; S.nun = S.cum[32] * 4;
            pg8::EpiHid E{(bf16_t*)(ws + WS_HID)};
            pg8::gemm_phase(lds, S, E);
            GRID_BAR();
        }
        if (IN(PH_DOWN)) {
            KArgs* ka = kargs(); unsigned char* ws = ka->ws;
            moe_cum(a, l, lds);
            pg8::MoeOrder<false> S; S.A = (const bf16_t*)(ws + WS_HID); S.Bt = (const bf16_t*)(ws + WS_WDT) + (size_t)l * NE * 1024 * 512; S.K = F; S.bstride = (size_t)1024 * 512;
            S.list = nullptr; S.cum = (const LAS int*)(lds + LDS_MISC + MISC_CUM); S.cnts = (const LAS int*)(lds + LDS_MISC + MISC_CNT); S.G = G; S.c = vcu; S.nun = S.cum[32] * 4;
            pg8::EpiDown E{(bf16_t*)(ws + WS_Y), (const float*)(ws + WS_LGATE)};
            pg8::gemm_phase(lds, S, E);
            GRID_BAR();
        }
        if (IN(PH_COMB)) { phase_combine(a, l, lds, vcu, G); GRID_BAR(); }
    }
#undef IN
#undef GRID_BAR
}


static void launch_ph(const Args& base, int grid, int l_lo, int l_hi, int ph_lo, int ph_hi, int fused, hipStream_t stream) {
    Args a = base; a.l_lo = l_lo; a.l_hi = l_hi; a.ph_lo = ph_lo; a.ph_hi = ph_hi; a.fused = fused; a.pad = 0;
    hipLaunchKernelGGL(mk_fwd, dim3(grid), dim3(NTHR), LDS_BYTES, stream, a);
}

extern "C" void kernel_launch(void* const* d_in, const int* in_sizes, int n_in, void* d_out, int out_size, void* d_ws, size_t ws_size, hipStream_t stream) {
    static int grid = 0;
    if (grid == 0) {
        int dev = 0, cus = 0;
        if (hipGetDevice(&dev) != hipSuccess || hipDeviceGetAttribute(&cus, hipDeviceAttributeMultiprocessorCount, dev) != hipSuccess) { grid = -1; return; }
        if (hipFuncSetAttribute((const void*)mk_fwd, hipFuncAttributeMaxDynamicSharedMemorySize, LDS_BYTES) != hipSuccess) { fprintf(stderr, "hipFuncSetAttribute failed\n"); grid = -1; return; }
        (void)hipGetLastError();
        grid = cus;
    }
    if (grid < 0) return;
    unsigned char* ws = (unsigned char*)d_ws;
    (void)hipMemsetAsync(ws, 0, WS_ZERO_BYTES, stream);
    Args a{};
    for (int i = 0; i < 32; ++i) a.in[i] = d_in[i];
    a.out = (float*)d_out; a.ws = ws;
#ifdef MK_MULTI
    launch_ph(a, grid, 0, 0, PH_PRO, PH_PRO + 1, 0, stream);
#ifdef MK_REP
    if (MK_REP == PH_PRO) launch_ph(a, grid, 0, 0, PH_PRO, PH_PRO + 1, 0, stream);
#endif
    launch_ph(a, grid, 0, 0, PH_NORM0, PH_NORM0 + 1, 0, stream);
#ifdef MK_REP
    if (MK_REP == PH_NORM0) launch_ph(a, grid, 0, 0, PH_NORM0, PH_NORM0 + 1, 0, stream);
#endif
    for (int l = 0; l < L; ++l)
        for (int ph = PH_G1; ph < PH_END; ++ph) {
            launch_ph(a, grid, l, l + 1, ph, ph + 1, 0, stream);
#ifdef MK_REP
            if (ph == MK_REP) launch_ph(a, grid, l, l + 1, ph, ph + 1, 0, stream);
#endif
        }
#else
    launch_ph(a, grid, 0, L, PH_PRO, PH_END, 1, stream);
#endif
}
```

```cpp
#include <hip/hip_runtime.h>
#include <stdint.h>
#include <stdio.h>

#define LAS __attribute__((address_space(3)))
typedef unsigned short bf16_t;
typedef short bf16x8 __attribute__((ext_vector_type(8)));
typedef float f32x4 __attribute__((ext_vector_type(4)));
typedef float f32x16 __attribute__((ext_vector_type(16)));
typedef unsigned u32x4 __attribute__((ext_vector_type(4)));
typedef unsigned u32x2 __attribute__((ext_vector_type(2)));

constexpr int Bn = 4, S = 4096, D = 1024, L = 2, NTOK = Bn * S, DIN = 2212, F = 512, NE = 32;
constexpr int NP = 2304;
constexpr int NK = 0, NV = 256, NIQ = 512, NIK = 640, NIW = 672, NBA = 768, NBG = 1024, NC = 1280, NDU = 1536, NDV = 1792, NQ = 2048;
constexpr float EPS = 1e-6f;
constexpr int NTHR = 512;
constexpr int SLOTS = 40960;

constexpr int LDS_BYTES = 163840, LDS_MISC = 147456;
constexpr int MISC_BAR = 0;
constexpr int MISC_CUM = 64;
constexpr int MISC_CNT = 64 + 160;

constexpr size_t al256c(size_t v) { return (v + 255) & ~(size_t)255; }
constexpr size_t WS_BAR = 0;
constexpr size_t WS_CNT = 16384;
constexpr size_t WS_ZERO_BYTES = 16384 + 32768;
constexpr size_t WS_MOD = WS_ZERO_BYTES;
constexpr size_t WS_ROPEA = WS_MOD + al256c((size_t)L * 4 * 6144 * 4);
constexpr size_t WS_ROPEI = WS_ROPEA + al256c((size_t)NTOK * 16 * 4);
constexpr size_t WS_LIST = WS_ROPEI + al256c((size_t)NTOK * 8 * 4);
constexpr size_t WS_LGATE = WS_LIST + al256c((size_t)NE * NTOK * 4);
constexpr size_t WS_TOKINFO = WS_LGATE + al256c((size_t)NE * NTOK * 4);
constexpr size_t WS_SGUW = WS_TOKINFO + al256c((size_t)NTOK * 16);
constexpr size_t WS_POOLT = WS_SGUW + al256c((size_t)L * 4 * 128 * 128 * 2);
constexpr size_t WS_WHL = WS_POOLT + al256c((size_t)L * 4 * 64 * 64 * 2);
constexpr size_t WS_RBIAS = WS_WHL + al256c((size_t)L * 2 * 48 * 1024 * 2);
constexpr size_t WS_SSQ = WS_RBIAS + al256c((size_t)L * 4 * 32 * 48 * 4);
constexpr size_t WS_WINT = WS_SSQ + al256c((size_t)L * NTOK * 4 * 4);
constexpr size_t WS_WOUTT = WS_WINT + al256c((size_t)L * NP * D * 2);
constexpr size_t WS_PWT = WS_WOUTT + al256c((size_t)L * D * D * 2);
constexpr size_t WS_WGUT = WS_PWT + al256c((size_t)L * 256 * 256 * 2);
constexpr size_t WS_WDT = WS_WGUT + al256c((size_t)L * NE * 1024 * 1024 * 2);
constexpr size_t WS_HA = WS_WDT + al256c((size_t)L * NE * 1024 * 512 * 2);
constexpr size_t WS_X1 = WS_HA + al256c((size_t)NTOK * D * 2);
constexpr size_t WS_R = WS_X1 + al256c((size_t)NTOK * D * 4);
constexpr size_t WS_PROJ = WS_R;
constexpr size_t WS_R2 = WS_PROJ + al256c((size_t)NTOK * NP * 2);
constexpr size_t WS_HID = WS_R;
constexpr size_t WS_Y = WS_HID + al256c((size_t)SLOTS * F * 2);

__device__ __forceinline__ unsigned cvt_pk_bf16(float lo, float hi) { unsigned r; asm volatile("v_cvt_pk_bf16_f32 %0, %1, %2" : "=v"(r) : "v"(lo), "v"(hi)); return r; }
__device__ __forceinline__ float bf2f(bf16_t v) { return __uint_as_float(((unsigned)v) << 16); }
__device__ __forceinline__ float bflo(unsigned w) { return __uint_as_float(w << 16); }
__device__ __forceinline__ float bfhi(unsigned w) { return __uint_as_float(w & 0xffff0000u); }
template <int CTRL> __device__ __forceinline__ float dpp_f(float v) { return __builtin_bit_cast(float, __builtin_amdgcn_update_dpp(0, __builtin_bit_cast(int, v), CTRL, 0xF, 0xF, true)); }
__device__ __forceinline__ float row_sum16(float v) {
    v += dpp_f<0xB1>(v);
    v += dpp_f<0x4E>(v);
    v += dpp_f<0x141>(v);
    v += dpp_f<0x140>(v);
    return v;
}
__device__ __forceinline__ float wave_sum(float v) {
    v = row_sum16(v);
    const float r0 = __builtin_bit_cast(float, __builtin_amdgcn_readlane(__builtin_bit_cast(int, v), 0)), r1 = __builtin_bit_cast(float, __builtin_amdgcn_readlane(__builtin_bit_cast(int, v), 16));
    const float r2 = __builtin_bit_cast(float, __builtin_amdgcn_readlane(__builtin_bit_cast(int, v), 32)), r3 = __builtin_bit_cast(float, __builtin_amdgcn_readlane(__builtin_bit_cast(int, v), 48));
    return (r0 + r1) + (r2 + r3);
}
__device__ __forceinline__ float wave_max(float v) {
#pragma unroll
    for (int o = 32; o >= 1; o >>= 1) v = fmaxf(v, __shfl_xor(v, o));
    return v;
}
__device__ __forceinline__ float silu_f(float v) { return v / (1.0f + expf(-v)); }
__device__ __forceinline__ float silu_fast(float v) { return v * __builtin_amdgcn_rcpf(1.0f + __expf(-v)); }
__device__ __forceinline__ float sigmoid_f(float v) { return 1.0f / (1.0f + expf(-v)); }
__device__ __forceinline__ float sigmoid_fast(float v) { return __builtin_amdgcn_rcpf(1.0f + __expf(-v)); }
__device__ __forceinline__ int opaque_tid() { int t = threadIdx.x; asm volatile("" : "+v"(t)); return t; }
__device__ __forceinline__ int ld_agent(const int* p) { return __hip_atomic_load(p, __ATOMIC_RELAXED, __HIP_MEMORY_SCOPE_AGENT); }

#define XB_TMO      128
#define XB_XCNT(j)  (256  + 64 * (j))
#define XB_XSUB(j)  (1280 + 64 * (j))
#define XB_XGEN(j)  (2304 + 64 * (j))
#define XB_TOP      3328
#define XB_TOPGEN   3392
#define XCD_BAR_WORDS 3456
#define XB_SPIN_CAP (1u << 18)
__device__ __forceinline__ unsigned xb_ld(unsigned* p)              { return __hip_atomic_load(p, __ATOMIC_RELAXED, __HIP_MEMORY_SCOPE_AGENT); }
__device__ __forceinline__ unsigned xb_add(unsigned* p, unsigned v) { return __hip_atomic_fetch_add(p, v, __ATOMIC_RELAXED, __HIP_MEMORY_SCOPE_AGENT); }
__device__ __forceinline__ unsigned xb_xcc_id() { return (unsigned)__builtin_amdgcn_s_getreg((3 << 11) | 20) & 0xFu; }
#define XB_SPIN(cond, bar) do { unsigned _sp = 0; while (cond) { __builtin_amdgcn_s_sleep(1); \
    if ((++_sp & 255u) == 0u) { if (xb_ld(&(bar)[XB_TMO])) break; if (_sp > XB_SPIN_CAP) { atomicAdd(&(bar)[XB_TMO], 1u); break; } } } } while (0)
struct XcdBarrier { unsigned* bar; unsigned x; volatile LAS unsigned* st; };
__device__ __forceinline__ XcdBarrier xcd_barrier_post(unsigned* bar, volatile LAS unsigned* st) {
    XcdBarrier b; b.bar = bar; b.x = xb_xcc_id(); b.st = st;
    if (threadIdx.x == 0) (void)xb_add(&bar[XB_XCNT(b.x)], 1u);
    return b;
}
__device__ __forceinline__ void xcd_barrier_complete(unsigned* bar, unsigned x, unsigned& nloc, unsigned& nx) {
    const unsigned G = gridDim.x * gridDim.y * gridDim.z;
    unsigned sum, cnt, mine, sp = 0u;
    for (;;) {
        sum = 0u; cnt = 0u; mine = 0u;
#pragma unroll
        for (unsigned j = 0; j < 16; ++j) { const unsigned c = xb_ld(&bar[XB_XCNT(j)]); sum += c; cnt += (c > 0u) ? 1u : 0u; mine = (j == x) ? c : mine; }
        if (sum == G) break;
        __builtin_amdgcn_s_sleep(1);
        if ((++sp & 255u) == 0u) { if (xb_ld(&bar[XB_TMO])) break; if (sp > XB_SPIN_CAP) { atomicAdd(&bar[XB_TMO], 1u); break; } }
    }
    nloc = mine > 0u ? mine : 1u; nx = cnt > 0u ? cnt : 1u;
}
__device__ __forceinline__ void xcd_barrier(const XcdBarrier& b) {
    asm volatile("s_waitcnt vmcnt(0)" ::: "memory");
    __syncthreads();
    if (threadIdx.x == 0) {
        unsigned* bar = b.bar;
        __builtin_amdgcn_s_waitcnt(0);
        unsigned nloc = b.st[0], nx = b.st[1];
        if (nloc == 0u) { xcd_barrier_complete(bar, b.x, nloc, nx); b.st[0] = nloc; b.st[1] = nx; }
        const unsigned old = xb_add(&bar[XB_XSUB(b.x)], 1u);
        const unsigned gen = old / nloc;
        if (old + 1u == (gen + 1u) * nloc) {
            __builtin_amdgcn_fence(__ATOMIC_RELEASE, "agent");
            asm volatile("s_waitcnt vmcnt(0)" ::: "memory");
            const unsigned og = xb_add(&bar[XB_TOP], 1u);
            const unsigned tg = og / nx;
            if (og + 1u == (tg + 1u) * nx) xb_add(&bar[XB_TOPGEN], 1u);
            else XB_SPIN(xb_ld(&bar[XB_TOPGEN]) == tg, bar);
            __builtin_amdgcn_fence(__ATOMIC_ACQUIRE, "agent");
            xb_add(&bar[XB_XGEN(b.x)], 1u);
            asm volatile("s_waitcnt vmcnt(0)" ::: "memory");
        } else {
            XB_SPIN(xb_ld(&bar[XB_XGEN(b.x)]) == gen, bar);
            __builtin_amdgcn_fence(__ATOMIC_ACQUIRE, "agent");
            asm volatile("s_waitcnt vmcnt(0)" ::: "memory");
        }
    }
    __syncthreads();
}

namespace pg8 {
constexpr int BM = 256, BK = 64, HALF = 128, HTB = HALF * BK * 2, STAGE_BYTES = 8 * HTB, NXCD = 8, WGM = 8;
__host__ __device__ __forceinline__ int lds_byte(int r, int c) { const int st = (r >> 4) * 2 + (c >> 5), rr = r & 15, cc = c & 31, ob = rr * 64 + cc * 2; return st * 1024 + (ob ^ (((ob >> 9) & 1) << 5)); }
__host__ __device__ __forceinline__ void stage_rc(int b, int& R, int& C) { const int st = b / 1024, sb = b % 1024, swz = sb ^ (((sb >> 9) & 1) << 5); R = (st >> 1) * 16 + swz / 64; C = (st & 1) * 32 + (swz % 64) / 2; }
__host__ __device__ __forceinline__ int perm32(int rho) { const int n = rho >> 4, i = rho & 15; return 8 * (i >> 2) + 4 * n + (i & 3); }

struct Unit { int pm, pn, e, mt, cnt; };

struct DenseOrder {
    const bf16_t* A; const bf16_t* Bt; int K;
    int nM, nN, nwg, G, c;
    __device__ void init(const bf16_t* A_, const bf16_t* Bt_, int M, int N, int K_, int G_, int c_) { A = A_; Bt = Bt_; K = K_; nM = M / BM; nN = N / BM; nwg = nM * nN; G = G_; c = c_; }
    __device__ bool next(int i, Unit& u) const {
        const long Lx = (long)i * G + c; if (Lx >= nwg) return false;
        int wgid = (int)Lx; { const int q = nwg / NXCD, r = nwg % NXCD, xcd = wgid % NXCD, off = wgid / NXCD; wgid = (xcd < r ? xcd * (q + 1) : r * (q + 1) + (xcd - r) * q) + off; }
        const int nig = WGM * nN, gid = wgid / nig, fm = gid * WGM, gsz = (nM - fm) < WGM ? (nM - fm) : WGM;
        u.pm = fm + ((wgid % nig) % gsz); u.pn = (wgid % nig) / gsz; u.e = 0; u.mt = 0; u.cnt = 0; return true;
    }
    __device__ __forceinline__ const char* a_base(const Unit& u) const { return (const char*)A + (size_t)u.pm * BM * K * 2; }
    __device__ __forceinline__ unsigned a_voff(const Unit&, int row, int C) const { return (unsigned)(row * K + C) * 2u; }
    __device__ __forceinline__ const char* b_base(const Unit& u) const { return (const char*)Bt + (size_t)u.pn * BM * K * 2; }
};
template <bool gather> struct MoeOrder {
    const bf16_t* A; const bf16_t* Bt; int K; size_t bstride;
    const int* list;
    const LAS int* cum; const LAS int* cnts;
    int G, c, nun;
    __device__ bool next(int i, Unit& u) const {
        const int Lx = i * G + c; if (Lx >= nun) return false;
        const int t = Lx >> 2; u.pn = Lx & 3; u.pm = t;
        int e = 0;
#pragma unroll 1
        for (int j = 1; j < NE; ++j) e += (cum[j] <= t) ? 1 : 0;
        u.e = e; u.mt = t - cum[e]; u.cnt = cnts[e]; return true;
    }
    __device__ __forceinline__ const char* a_base(const Unit& u) const { return gather ? (const char*)A : (const char*)A + (size_t)u.pm * BM * K * 2; }
    __device__ __forceinline__ unsigned a_voff(const Unit& u, int row, int C) const {
        if (gather) { const int pos = u.mt * BM + row; const int tok = (pos < u.cnt) ? list[(size_t)u.e * NTOK + pos] : 0; return (unsigned)(tok * K + C) * 2u; }
        return (unsigned)(row * K + C) * 2u;
    }
    __device__ __forceinline__ const char* b_base(const Unit& u) const { return (const char*)(Bt + (size_t)u.e * bstride) + (size_t)u.pn * BM * K * 2; }
};

struct EpiBf16 {
    static constexpr bool PERM = true;
    bf16_t* O; int ldc;
    __device__ __forceinline__ void operator()(const f32x4 (&acc)[2][2][4][2], const Unit& u, int wr, int wc, int fr, int fq) const {
        const int row0 = u.pm * BM + wr * 64 + fr, col0 = u.pn * BM + wc * 32 + 8 * fq;
#pragma unroll
        for (int ai = 0; ai < 2; ++ai)
#pragma unroll
            for (int m = 0; m < 4; ++m) { bf16_t* rowp = O + (size_t)(row0 + ai * HALF + m * 16) * ldc + col0;
#pragma unroll
                for (int bj = 0; bj < 2; ++bj) { const f32x4 v0 = acc[ai][bj][m][0], v1 = acc[ai][bj][m][1];
                    u32x4 w; w.x = cvt_pk_bf16(v0[0], v0[1]); w.y = cvt_pk_bf16(v0[2], v0[3]); w.z = cvt_pk_bf16(v1[0], v1[1]); w.w = cvt_pk_bf16(v1[2], v1[3]);
                    *(u32x4*)(rowp + bj * HALF) = w; } }
    }
};
struct EpiResid {
    static constexpr bool PERM = true;
    const float* X; const bf16_t* Xb; bf16_t* C; const float* gate;
    const float* ssq;
    __device__ __forceinline__ void rowscale(f32x4 (&acc)[2][2][4][2], const Unit& u, int wr, int fr) const {
        int rbase = u.pm * BM + wr * 64 + fr;
        asm volatile("" : "+v"(rbase));
#pragma unroll
        for (int ai = 0; ai < 2; ++ai)
#pragma unroll
            for (int m = 0; m < 4; ++m) { const f32x4 sv = *(const f32x4*)(ssq + (size_t)(rbase + ai * HALF + m * 16) * 4); const float r = rsqrtf(((sv[0] + sv[1]) + (sv[2] + sv[3])) * (1.0f / 256.0f) + EPS);
#pragma unroll
                for (int bj = 0; bj < 2; ++bj)
#pragma unroll
                    for (int n = 0; n < 2; ++n) acc[ai][bj][m][n] *= r; }
    }
    __device__ __forceinline__ void operator()(const f32x4 (&acc)[2][2][4][2], const Unit& u, int wr, int wc, int fr, int fq) const {
        const int row0 = u.pm * BM + wr * 64 + fr, col0 = u.pn * BM + wc * 32 + 8 * fq;
        const float* gp = gate + (size_t)((u.pm * BM) / S) * 6144 + col0;
        f32x4 gv[2][2];
#pragma unroll
        for (int bj = 0; bj < 2; ++bj)
#pragma unroll
            for (int n = 0; n < 2; ++n) gv[bj][n] = *(const f32x4*)(gp + bj * HALF + n * 4);
#pragma unroll
        for (int ai = 0; ai < 2; ++ai)
#pragma unroll
            for (int m = 0; m < 4; ++m) { const size_t off = (size_t)(row0 + ai * HALF + m * 16) * D + col0;
#pragma unroll
                for (int bj = 0; bj < 2; ++bj) {
                    f32x4 x0, x1v;
                    if (Xb) { const u32x4 xw = *(const u32x4*)(Xb + off + bj * HALF); x0 = (f32x4){bflo(xw.x), bfhi(xw.x), bflo(xw.y), bfhi(xw.y)}; x1v = (f32x4){bflo(xw.z), bfhi(xw.z), bflo(xw.w), bfhi(xw.w)}; }
                    else { x0 = *(const f32x4*)(X + off + bj * HALF); x1v = *(const f32x4*)(X + off + bj * HALF + 4); }
                    const f32x4 o0 = x0 + gv[bj][0] * acc[ai][bj][m][0], o1 = x1v + gv[bj][1] * acc[ai][bj][m][1];
                    u32x4 w; w.x = cvt_pk_bf16(o0[0], o0[1]); w.y = cvt_pk_bf16(o0[2], o0[3]); w.z = cvt_pk_bf16(o1[0], o1[1]); w.w = cvt_pk_bf16(o1[2], o1[3]);
                    *(u32x4*)(C + off + bj * HALF) = w; }
                asm volatile("" ::: "memory"); }
    }
};
struct EpiHid {
    static constexpr bool PERM = true;
    bf16_t* H;
    __device__ __forceinline__ void operator()(const f32x4 (&acc)[2][2][4][2], const Unit& u, int wr, int wc, int fr, int fq) const {
        const int row0 = u.pm * BM + wr * 64 + fr, col0 = u.pn * HALF + wc * 32 + 8 * fq;
#pragma unroll
        for (int ai = 0; ai < 2; ++ai)
#pragma unroll
            for (int m = 0; m < 4; ++m) { float h[8];
#pragma unroll
                for (int n = 0; n < 2; ++n)
#pragma unroll
                    for (int j = 0; j < 4; ++j) h[n * 4 + j] = silu_fast(acc[ai][0][m][n][j]) * acc[ai][1][m][n][j];
                u32x4 w; w.x = cvt_pk_bf16(h[0], h[1]); w.y = cvt_pk_bf16(h[2], h[3]); w.z = cvt_pk_bf16(h[4], h[5]); w.w = cvt_pk_bf16(h[6], h[7]);
                *(u32x4*)(H + (size_t)(row0 + ai * HALF + m * 16) * F + col0) = w; }
    }
};
struct EpiDown {
    static constexpr bool PERM = true;
    bf16_t* Y; const float* lgate;
    __device__ __forceinline__ void operator()(const f32x4 (&acc)[2][2][4][2], const Unit& u, int wr, int wc, int fr, int fq) const {
        const int rl0 = wr * 64 + fr, col0 = u.pn * BM + wc * 32 + 8 * fq;
        const float* gp = lgate + (size_t)u.e * NTOK + u.mt * BM;
#pragma unroll
        for (int ai = 0; ai < 2; ++ai)
#pragma unroll
            for (int m = 0; m < 4; ++m) { const int rl = rl0 + ai * HALF + m * 16; const float g = (u.mt * BM + rl < u.cnt) ? gp[rl] : 0.f;
                bf16_t* rowp = Y + (size_t)(u.pm * BM + rl) * D + col0;
#pragma unroll
                for (int bj = 0; bj < 2; ++bj) { const f32x4 v0 = acc[ai][bj][m][0] * g, v1 = acc[ai][bj][m][1] * g;
                    u32x4 w; w.x = cvt_pk_bf16(v0[0], v0[1]); w.y = cvt_pk_bf16(v0[2], v0[3]); w.z = cvt_pk_bf16(v1[0], v1[1]); w.w = cvt_pk_bf16(v1[2], v1[3]);
                    *(u32x4*)(rowp + bj * HALF) = w; } }
    }
};

template <class Epi, class Sched, bool RSC = false>
__device__ __forceinline__ void gemm_phase(LAS unsigned char* lds, const Sched& S, const Epi& E) {
    const int tid = opaque_tid(), wid = __builtin_amdgcn_readfirstlane(tid >> 6), lane = tid & 63, wr = wid >> 2, wc = wid & 3, fr = lane & 15, fq = lane >> 4;
    const int K = S.K, nt = K / BK;
    int Rr[2], Cc[2]; unsigned voffB[2];
#pragma unroll
    for (int i = 0; i < 2; ++i) { stage_rc(tid * 16 + i * 8192, Rr[i], Cc[i]); const int Rb = Epi::PERM ? ((Rr[i] & ~31) + perm32(Rr[i] & 31)) : Rr[i]; voffB[i] = (unsigned)(Rb * K + Cc[i]) * 2u; }
    const size_t kstep = (size_t)(BK * 2);
    const size_t hstep = (size_t)HALF * K * 2;
    const unsigned ldsw = (unsigned)wid * 1024u;
    const int aoff = lds_byte(wr * 64 + fr, fq * 8), boff = lds_byte(wc * 32 + fr, fq * 8);
#define PG8_SA(b, h) (((b) * 2 + (h)) * HTB)
#define PG8_SB(b, h) ((4 + (b) * 2 + (h)) * HTB)
#define PG8_STAGE(bufoff, gbase, voff) do { _Pragma("unroll") for (int _i = 0; _i < 2; ++_i) \
        __builtin_amdgcn_global_load_lds((const unsigned*)((const char*)(gbase) + (voff)[_i]), (LAS unsigned*)(lds + (bufoff) + ldsw + _i * 8192), 16, 0, 0); } while (0)
#define PG8_LDA(dst, b, h) do { _Pragma("unroll") for (int m = 0; m < 4; ++m) _Pragma("unroll") for (int k = 0; k < 2; ++k) dst[m][k] = *(const LAS bf16x8*)(lds + PG8_SA(b, h) + aoff + m * 2048 + k * 1024); } while (0)
#define PG8_LDB(dst, b, h) do { _Pragma("unroll") for (int n = 0; n < 2; ++n) _Pragma("unroll") for (int k = 0; k < 2; ++k) dst[n][k] = *(const LAS bf16x8*)(lds + PG8_SB(b, h) + boff + n * 2048 + k * 1024); } while (0)
#define PG8_MMA(ai, bj, At, Bt) do { __builtin_amdgcn_s_setprio(1); _Pragma("unroll") for (int m = 0; m < 4; ++m) _Pragma("unroll") for (int n = 0; n < 2; ++n) _Pragma("unroll") for (int k = 0; k < 2; ++k) \
        acc[ai][bj][m][n] = __builtin_amdgcn_mfma_f32_16x16x32_bf16(Bt[n][k], At[m][k], acc[ai][bj][m][n], 0, 0, 0); __builtin_amdgcn_s_setprio(0); } while (0)
#define PG8_WAIT_V(n) asm volatile("s_waitcnt vmcnt(" #n ")" ::: "memory")
#define PG8_WAIT_L(n) asm volatile("s_waitcnt lgkmcnt(" #n ")" ::: "memory")
#define PG8_BAR __builtin_amdgcn_s_barrier()
#define PG8_SCHED __builtin_amdgcn_sched_barrier(0)
    Unit cur, nxt; int ui = 0;
    if (!S.next(0, cur)) return;
    f32x4 acc[2][2][4][2];
#pragma unroll
    for (int a = 0; a < 2; ++a)
#pragma unroll
        for (int b = 0; b < 2; ++b)
#pragma unroll
            for (int m = 0; m < 4; ++m)
#pragma unroll
                for (int n = 0; n < 2; ++n) acc[a][b][m][n] = (f32x4){0.f, 0.f, 0.f, 0.f};
    bf16x8 At[4][2], B0[2][2], B1[2][2];
    unsigned vA0[2], vA1[2], vN0[2], vN1[2];
#pragma unroll
    for (int i = 0; i < 2; ++i) { vA0[i] = S.a_voff(cur, Rr[i], Cc[i]); vA1[i] = S.a_voff(cur, HALF + Rr[i], Cc[i]); }
    const char* cA = S.a_base(cur); const char* cB = S.b_base(cur);
    PG8_STAGE(PG8_SB(0, 0), cB, voffB); PG8_STAGE(PG8_SB(0, 1), cB + hstep, voffB); PG8_STAGE(PG8_SA(0, 0), cA, vA0); PG8_STAGE(PG8_SA(0, 1), cA, vA1);
    if (wr == 1) PG8_BAR;
    PG8_WAIT_V(2); PG8_BAR;
    PG8_STAGE(PG8_SB(1, 0), cB + kstep, voffB); PG8_STAGE(PG8_SA(1, 0), cA + kstep, vA0); PG8_STAGE(PG8_SB(1, 1), cB + hstep + kstep, voffB);
    PG8_WAIT_V(6); PG8_BAR;
    for (;;) {
        const bool has_next = S.next(ui + 1, nxt);
        const char* nA = has_next ? S.a_base(nxt) : cA; const char* nB = has_next ? S.b_base(nxt) : cB;
#pragma unroll
        for (int i = 0; i < 2; ++i) { vN0[i] = has_next ? S.a_voff(nxt, Rr[i], Cc[i]) : vA0[i]; vN1[i] = has_next ? S.a_voff(nxt, HALF + Rr[i], Cc[i]) : vA1[i]; }
        for (int t = 0; t < nt; t += 2) {
            const bool last = (t == nt - 2);
            if constexpr (RSC) { if (t == 4) E.rowscale(acc, cur, wr, fr); }
            const char* a1 = cA + (size_t)(t + 1) * kstep;
            const char* a2 = last ? nA : cA + (size_t)(t + 2) * kstep; const char* b2 = last ? nB : cB + (size_t)(t + 2) * kstep;
            const char* a3 = a2 + kstep; const char* b3 = b2 + kstep;
            unsigned w0[2], w1[2];
#pragma unroll
            for (int i = 0; i < 2; ++i) { w0[i] = last ? vN0[i] : vA0[i]; w1[i] = last ? vN1[i] : vA1[i]; }
            PG8_LDB(B0, 0, 0); PG8_LDB(B1, 0, 1); PG8_SCHED; PG8_LDA(At, 0, 0); PG8_STAGE(PG8_SA(1, 1), a1, vA1);
            PG8_WAIT_V(8); PG8_WAIT_L(0); PG8_BAR; PG8_MMA(0, 0, At, B0); PG8_MMA(0, 1, At, B1); PG8_BAR; PG8_SCHED;
            PG8_LDA(At, 0, 1); PG8_STAGE(PG8_SB(0, 0), b2, voffB); PG8_STAGE(PG8_SB(0, 1), b2 + hstep, voffB); PG8_STAGE(PG8_SA(0, 0), a2, w0);
            PG8_WAIT_V(8); PG8_WAIT_L(0); PG8_BAR; PG8_MMA(1, 0, At, B0); PG8_MMA(1, 1, At, B1); PG8_BAR; PG8_SCHED;
            PG8_LDB(B0, 1, 0); PG8_LDB(B1, 1, 1); PG8_SCHED; PG8_LDA(At, 1, 0); PG8_STAGE(PG8_SA(0, 1), a2, w1);
            PG8_WAIT_V(8); PG8_WAIT_L(0); PG8_BAR; PG8_MMA(0, 0, At, B0); PG8_MMA(0, 1, At, B1); PG8_BAR; PG8_SCHED;
            PG8_LDA(At, 1, 1); PG8_STAGE(PG8_SB(1, 0), b3, voffB); PG8_STAGE(PG8_SB(1, 1), b3 + hstep, voffB); PG8_STAGE(PG8_SA(1, 0), a3, w0);
            PG8_WAIT_V(8); PG8_WAIT_L(0); PG8_BAR; PG8_MMA(1, 0, At, B0); PG8_MMA(1, 1, At, B1); PG8_BAR; PG8_SCHED;
        }
        if (wr == 0) PG8_BAR;
        E(acc, cur, wr, wc, fr, fq);
        if (!has_next) break;
#pragma unroll
        for (int a = 0; a < 2; ++a)
#pragma unroll
            for (int b = 0; b < 2; ++b)
#pragma unroll
                for (int m = 0; m < 4; ++m)
#pragma unroll
                    for (int n = 0; n < 2; ++n) acc[a][b][m][n] = (f32x4){0.f, 0.f, 0.f, 0.f};
        cur = nxt; cA = nA; cB = nB; ++ui;
#pragma unroll
        for (int i = 0; i < 2; ++i) { vA0[i] = vN0[i]; vA1[i] = vN1[i]; }
        if (wr == 1) PG8_BAR;
    }
    PG8_WAIT_V(0);
    PG8_BAR;
#undef PG8_SA
#undef PG8_SB
#undef PG8_STAGE
#undef PG8_LDA
#undef PG8_LDB
#undef PG8_MMA
#undef PG8_WAIT_V
#undef PG8_WAIT_L
#undef PG8_BAR
#undef PG8_SCHED
}
}
struct Args { const void* in[32]; float* out; unsigned char* ws; int l_lo, l_hi, ph_lo, ph_hi, fused, pad; };
enum { PH_PRO = 0, PH_NORM0 = 1, PH_G1 = 2, PH_MIX = 3, PH_A1 = 4, PH_A2 = 5, PH_AN = 6, PH_G2 = 7, PH_ROUTE = 8, PH_UP = 9, PH_DOWN = 10, PH_COMB = 11, PH_END = 12 };

typedef const Args __attribute__((address_space(4))) KArgs;
__device__ __forceinline__ KArgs* kargs() { KArgs* p = (KArgs*)__builtin_amdgcn_kernarg_segment_ptr(); asm volatile("" : "+s"(p)); return p; }
#define IN_F(i) ((const float*)ka->in[i])
enum { I_X = 0, I_C, I_POS, I_WADA, I_BADA, I_NORM1, I_WIN, I_QN, I_KN, I_CONVW, I_CONVB, I_CLNG, I_CLNB, I_PWW, I_PWB, I_POOLW, I_POOLB, I_POOLS, I_SLNG, I_SLNB, I_SGUW, I_SGUB,
       I_ONORM, I_WOUT, I_NORM2, I_WRG, I_BRG, I_WRE, I_BRE, I_WG, I_WU, I_WD };

__device__ __forceinline__ void sincos_d(double a, double& s, double& c) {
    const double k = rint(a * 0.63661977236758134308);
    const double r = (a - k * 1.57079632679489655800) - k * 6.123233995736766036e-17;
    const double r2 = r * r;
    const double sp = r * (1.0 + r2 * (-1.0 / 6 + r2 * (1.0 / 120 + r2 * (-1.0 / 5040 + r2 * (1.0 / 362880 + r2 * (-1.0 / 39916800 + r2 * (1.0 / 6227020800.0)))))));
    const double cp = 1.0 + r2 * (-0.5 + r2 * (1.0 / 24 + r2 * (-1.0 / 720 + r2 * (1.0 / 40320 + r2 * (-1.0 / 3628800 + r2 * (1.0 / 479001600.0 + r2 * (-1.0 / 87178291200.0)))))));
    const int q = ((int)k) & 3;
    if (q == 0) { s = sp; c = cp; } else if (q == 1) { s = cp; c = -sp; } else if (q == 2) { s = -sp; c = -cp; } else { s = -cp; c = sp; }
}

__device__ __forceinline__ bf16_t f2bf_(float f) { return (bf16_t)(cvt_pk_bf16(f, 0.f) & 0xffffu); }
struct TItem { const float* src; int ld; int ncol; bf16_t* dst; int ldd; const float* rsc; };
constexpr int NT_WIN = L * 36 * 4, NT_WOUT = L * 16 * 4, NT_PW = L * 4, NT_WGU = L * NE * 16 * 4, NT_WD = L * NE * 16 * 2;
constexpr int NT_ALL = NT_WIN + NT_WOUT + NT_PW + NT_WGU + NT_WD;
__device__ __forceinline__ void decode_titem(int it, const Args& a, TItem& t) {
    KArgs* ka = kargs();
    unsigned char* ws = ka->ws;
    t.rsc = nullptr;
    if (it < NT_WIN) {
        const int l = it / 144, r = it % 144, n0 = (r >> 2) * 64, k0 = (r & 3) * 256;
        const int c0 = n0 < 768 ? n0 + 256 : (n0 < 2048 ? n0 + 164 : n0 - 2048);
        t.ncol = (n0 < 768) ? ((n0 + 64 <= 676) ? 64 : (n0 < 676 ? 676 - n0 : 0)) : 64;
        t.src = IN_F(I_WIN) + ((size_t)l * D + k0) * DIN + c0; t.ld = DIN;
        t.dst = (bf16_t*)(ws + WS_WINT) + ((size_t)l * NP + n0) * D + k0; t.ldd = D; return;
    }
    it -= NT_WIN;
    if (it < NT_WOUT) {
        const int l = it / 64, r = it % 64, n0 = (r >> 2) * 64, k0 = (r & 3) * 256;
        t.ncol = 64; t.src = IN_F(I_WOUT) + ((size_t)l * D + k0) * D + n0; t.ld = D; t.rsc = (k0 == 0) ? IN_F(I_ONORM) + l * D : nullptr;
        t.dst = (bf16_t*)(ws + WS_WOUTT) + ((size_t)l * D + n0) * D + k0; t.ldd = D; return;
    }
    it -= NT_WOUT;
    if (it < NT_PW) {
        const int l = it / 4, n0 = (it & 3) * 64;
        t.ncol = 64; t.src = IN_F(I_PWW) + (size_t)l * 65536 + n0; t.ld = 256;
        t.dst = (bf16_t*)(ws + WS_PWT) + ((size_t)l * 256 + n0) * 256; t.ldd = 256; return;
    }
    it -= NT_PW;
    if (it < NT_WGU) {
        const int le = it / 64, r = it % 64, n0 = (r >> 2) * 64, k0 = (r & 3) * 256;
        const int pn = n0 >> 8, rr = n0 & 255;
        const float* W = (rr < 128) ? IN_F(I_WG) : IN_F(I_WU);
        t.ncol = 64; t.src = W + ((size_t)le * D + k0) * F + pn * 128 + (rr & 127); t.ld = F;
        t.dst = (bf16_t*)(ws + WS_WGUT) + ((size_t)le * 1024 + n0) * D + k0; t.ldd = D; return;
    }
    it -= NT_WGU;
    {
        const int le = it / 32, r = it % 32, n0 = (r >> 1) * 64, k0 = (r & 1) * 256;
        t.ncol = 64; t.src = IN_F(I_WD) + ((size_t)le * F + k0) * D + n0; t.ld = D;
        t.dst = (bf16_t*)(ws + WS_WDT) + ((size_t)le * D + n0) * F + k0; t.ldd = F;
    }
}
__device__ __forceinline__ void titem_load(const TItem& t, int tid, float4 (&v)[8]) {
    const int c4 = tid & 15, r0 = tid >> 4;
#pragma unroll
    for (int i = 0; i < 8; ++i) v[i] = (c4 * 4 < t.ncol) ? *(const float4*)(t.src + (size_t)(r0 + 32 * i) * t.ld + c4 * 4) : make_float4(0.f, 0.f, 0.f, 0.f);
    if (t.rsc) {
#pragma unroll
        for (int i = 0; i < 8; ++i) { const float s = t.rsc[r0 + 32 * i]; v[i].x *= s; v[i].y *= s; v[i].z *= s; v[i].w *= s; }
    }
}
__device__ __forceinline__ void phase_prologue(const Args& a, LAS unsigned char* lds, int vcu, int G) {
    KArgs* ka = kargs();
    const int tid = opaque_tid(), wid = __builtin_amdgcn_readfirstlane(tid >> 6), lane = tid & 63;
    LAS float* T = (LAS float*)lds;
    LAS float* cs = (LAS float*)(lds + 66560);
    LAS float* red = (LAS float*)(lds + 66560 + 16384);
    unsigned char* ws = ka->ws;
    if (vcu < 192) {
        for (int i = tid; i < 4096; i += NTHR) cs[i] = silu_f(IN_F(I_C)[i]);
        __syncthreads();
        for (int it = vcu; it < 192; it += G) {
            const int l = it / 96, j0 = (it % 96) * 64;
            const float* wp = IN_F(I_WADA) + ((size_t)l * D + wid * 128) * 6144 + j0 + lane;
            float a0 = 0.f, a1 = 0.f, a2 = 0.f, a3 = 0.f;
#pragma unroll 32
            for (int k = 0; k < 128; ++k) { const float wv = wp[(size_t)k * 6144]; const int kk = wid * 128 + k; a0 += cs[kk] * wv; a1 += cs[1024 + kk] * wv; a2 += cs[2048 + kk] * wv; a3 += cs[3072 + kk] * wv; }
            red[(wid * 4 + 0) * 64 + lane] = a0; red[(wid * 4 + 1) * 64 + lane] = a1; red[(wid * 4 + 2) * 64 + lane] = a2; red[(wid * 4 + 3) * 64 + lane] = a3;
            __syncthreads();
            if (wid < 4) { float s = 0.f;
#pragma unroll
                for (int w = 0; w < 8; ++w) s += red[(w * 4 + wid) * 64 + lane];
                ((float*)(ws + WS_MOD))[((size_t)l * 4 + wid) * 6144 + j0 + lane] = s + IN_F(I_BADA)[l * 6144 + j0 + lane]; }
            __syncthreads();
        }
    }
    for (int i = vcu * NTHR + tid; i < NTOK; i += G * NTHR) {
        const float invA[8] = {1.0f, 0.1939227432012558f, 0.03760603070259094f, 0.007292664609849453f, 0.0014142135623842478f, 0.00027424818836152554f, 5.318296098266728e-05f, 1.0313386155758053e-05f};
        const float invI[4] = {1.0f, 0.03760603070259094f, 0.0014142135623842478f, 5.318296098266728e-05f};
        const float p = (float)((const int*)ka->in[I_POS])[i];
        float* ra = (float*)(ws + WS_ROPEA) + (size_t)i * 16; float* ri = (float*)(ws + WS_ROPEI) + (size_t)i * 8;
#pragma unroll
        for (int j = 0; j < 8; ++j) { const float ang = p * invA[j]; double s, c; sincos_d((double)ang, s, c); ra[j] = (float)c; ra[8 + j] = (float)s; }
#pragma unroll
        for (int j = 0; j < 4; ++j) { const float ang = p * invI[j]; double s, c; sincos_d((double)ang, s, c); ri[j] = (float)c; ri[4 + j] = (float)s; }
    }
    for (int i = vcu * NTHR + tid; i < L * 4 * 128 * 128; i += G * NTHR) { const int s = i & 127, t = (i >> 7) & 127; ((bf16_t*)(ws + WS_SGUW))[i] = (bf16_t)(cvt_pk_bf16(s <= t ? IN_F(I_SGUW)[i] : 0.f, 0.f) & 0xffffu); }
    for (int i = vcu * NTHR + tid; i < L * 4 * 64 * 64; i += G * NTHR) { const int c = i & 63, d = (i >> 6) & 63, lg = i >> 12; ((bf16_t*)(ws + WS_POOLT))[i] = (bf16_t)(cvt_pk_bf16(IN_F(I_POOLW)[((size_t)lg * 64 + c) * 64 + d], 0.f) & 0xffffu); }
    for (int i = vcu * NTHR + tid; i < L * 48 * 1024; i += G * NTHR) {
        const int k = i & 1023, n = (i >> 10) % 48, lg = i / (48 * 1024);
        const float w = (n < 4) ? IN_F(I_WRG)[((size_t)lg * D + k) * 4 + n] : (n < 36) ? IN_F(I_WRE)[((size_t)lg * D + k) * 32 + (n - 4)] : 0.f;
        const unsigned hi = cvt_pk_bf16(w, 0.f) & 0xffffu; const float lo = w - __uint_as_float(hi << 16);
        bf16_t* dst = (bf16_t*)(ws + WS_WHL) + (size_t)lg * 2 * 48 * 1024 + (size_t)n * 1024 + k;
        dst[0] = (bf16_t)hi; dst[48 * 1024] = f2bf_(lo);
    }
    int it = (G - 1 - vcu);
    bool have = it < NT_ALL;
    TItem cur; cur.src = nullptr; cur.ld = 0; cur.ncol = 0; cur.dst = nullptr; cur.ldd = 0; cur.rsc = nullptr;
    float4 v[8];
    if (have) { decode_titem(it, a, cur); titem_load(cur, tid, v); }
    while (have) {
        { const int c4 = tid & 15, r0 = tid >> 4;
#pragma unroll
          for (int i = 0; i < 8; ++i) { LAS float* tp = T + (r0 + 32 * i) * 65 + c4 * 4; tp[0] = v[i].x; tp[1] = v[i].y; tp[2] = v[i].z; tp[3] = v[i].w; } }
        __syncthreads();
        const int itn = it + G; const bool hn = itn < NT_ALL; TItem nx = cur;
        if (hn) { decode_titem(itn, a, nx); titem_load(nx, tid, v); }
        { const int n = tid >> 3, kq = tid & 7;
#pragma unroll
          for (int j = 0; j < 4; ++j) { const int kc = j * 8 + kq; float f[8];
#pragma unroll
              for (int jj = 0; jj < 8; ++jj) f[jj] = T[(kc * 8 + jj) * 65 + n];
              u32x4 w; w.x = cvt_pk_bf16(f[0], f[1]); w.y = cvt_pk_bf16(f[2], f[3]); w.z = cvt_pk_bf16(f[4], f[5]); w.w = cvt_pk_bf16(f[6], f[7]);
              *(u32x4*)(cur.dst + (size_t)n * cur.ldd + kc * 8) = w; } }
        __syncthreads();
        cur = nx; it = itn; have = hn;
    }
}

__device__ __forceinline__ void phase_norm(const float* __restrict__ xin, const float* g, const float* shift, const float* scale, bf16_t* __restrict__ out, int vcu, int G) {
    const int tid = opaque_tid(), wid = __builtin_amdgcn_readfirstlane(tid >> 6), lane = tid & 63;
    for (int rb = vcu * 8 + wid; rb < NTOK / 8; rb += G * 8) {
        const int row0 = rb * 8, b = row0 / S;
        float4 A[4], C[4];
#pragma unroll
        for (int i = 0; i < 4; ++i) { const int k = 256 * i + 4 * lane; const float4 gv = *(const float4*)(g + k), sc = *(const float4*)(scale + (size_t)b * 6144 + k); C[i] = *(const float4*)(shift + (size_t)b * 6144 + k);
            A[i] = make_float4(gv.x * (1.f + sc.x), gv.y * (1.f + sc.y), gv.z * (1.f + sc.z), gv.w * (1.f + sc.w)); }
#pragma unroll 4
        for (int rr = 0; rr < 8; ++rr) {
            const size_t ro = (size_t)(row0 + rr) * D;
            float4 x[4]; float ss = 0.f;
#pragma unroll
            for (int i = 0; i < 4; ++i) { x[i] = *(const float4*)(xin + ro + 256 * i + 4 * lane); ss += x[i].x * x[i].x + x[i].y * x[i].y + x[i].z * x[i].z + x[i].w * x[i].w; }
            const float r = rsqrtf(wave_sum(ss) * (1.0f / D) + EPS);
#pragma unroll
            for (int i = 0; i < 4; ++i) { u32x2 w; w.x = cvt_pk_bf16(x[i].x * r * A[i].x + C[i].x, x[i].y * r * A[i].y + C[i].y); w.y = cvt_pk_bf16(x[i].z * r * A[i].z + C[i].z, x[i].w * r * A[i].w + C[i].w);
                *(u32x2*)(out + ro + 256 * i + 4 * lane) = w; }
        }
    }
}

__device__ __forceinline__ f32x4 mfma16r(const bf16x8 a, const bf16x8 b, const f32x4 c) { return __builtin_amdgcn_mfma_f32_16x16x32_bf16(a, b, c, 0, 0, 0); }
__device__ __forceinline__ void phase_rbias(const Args& a, LAS unsigned char* lds, int vcu, int G) {
    KArgs* ka = kargs();
    const int tid = opaque_tid();
    LAS float* red = (LAS float*)lds;
    for (int v = vcu; v < 256; v += G) {
        const int lb = v & 7, sl = v >> 3, l = lb >> 2, b = lb & 3, n = tid & 63, kp = tid >> 6;
        const float* sh = (const float*)(ka->ws + WS_MOD) + ((size_t)l * 4 + b) * 6144 + 3072;
        float s = 0.f;
        if (n < 36) {
#pragma unroll
            for (int i = 0; i < 4; ++i) { const int k = sl * 32 + kp * 4 + i; s += sh[k] * ((n < 4) ? IN_F(I_WRG)[((size_t)l * D + k) * 4 + n] : IN_F(I_WRE)[((size_t)l * D + k) * 32 + (n - 4)]); }
        }
        red[kp * 64 + n] = s;
        __syncthreads();
        if (tid < 48) { float t = 0.f;
            if (tid < 36) { for (int w = 0; w < 8; ++w) t += red[w * 64 + tid]; }
            ((float*)(ka->ws + WS_RBIAS))[((size_t)lb * 32 + sl) * 48 + tid] = t; }
        __syncthreads();
    }
}

__device__ __forceinline__ void phase_route(const Args& a, int l, LAS unsigned char* lds, int vcu, int G) {
    KArgs* ka = kargs();
    const int tid = opaque_tid(), wid = __builtin_amdgcn_readfirstlane(tid >> 6), lane = tid & 63, fr = lane & 15, kq = lane >> 4;
    unsigned char* ws = ka->ws;
    const bf16_t* x1 = (const bf16_t*)(ws + WS_X1);
    const float* mod = (const float*)(ws + WS_MOD) + (size_t)l * 4 * 6144;
    const float* g = IN_F(I_NORM2) + l * D; const float* shift = mod + 3072; const float* scale = mod + 4096;
    bf16_t* out = (bf16_t*)(ws + WS_HA);
    int* counts = (int*)(ws + WS_CNT) + l * NE * 64; int* list = (int*)(ws + WS_LIST); float* lgate = (float*)(ws + WS_LGATE); int* tokinfo = (int*)(ws + WS_TOKINFO);
    LAS int* lcnt = (LAS int*)(lds + LDS_MISC + 1024); LAS int* lbase = lcnt + 32; LAS int* rte = lbase + 32; LAS int* rtp = rte + 128; LAS int* rtt = rtp + 128; LAS float* rtg = (LAS float*)(rtt + 128);
    LAS float* part = (LAS float*)lds;
    LAS float* ssp = part + 8 * 16 * 48;
    LAS float* lgt = ssp + 8 * 16;
    LAS float* rrow = lgt + 16 * 48;
    const bf16_t* wh = (const bf16_t*)(ws + WS_WHL) + (size_t)l * 2 * 48 * 1024 + (size_t)fr * 1024 + 128 * wid + 8 * kq;
    LAS float* rb = (LAS float*)(lds + LDS_MISC + 8192);
    for (int r0 = vcu * 64; r0 < NTOK; r0 += G * 64) {
        const int b = r0 / S;
        if (tid < 48) { const float* rp = (const float*)(ws + WS_RBIAS) + ((size_t)(l * 4 + b) * 32) * 48 + tid; float t = 0.f;
            for (int sl = 0; sl < 32; ++sl) t += rp[sl * 48];
            if (tid < 36) t += (tid < 4) ? IN_F(I_BRG)[l * 4 + tid] : IN_F(I_BRE)[l * 32 + tid - 4];
            rb[tid] = t; }
        if (tid < 32) lcnt[tid] = 0;
#pragma unroll 1
        for (int q4 = 0; q4 < 4; ++q4) {
            float t[4][8];
            f32x4 acc[3];
#pragma unroll
            for (int nt = 0; nt < 3; ++nt) acc[nt] = (f32x4){0.f, 0.f, 0.f, 0.f};
            float ss = 0.f;
            const int row = r0 + 16 * q4 + fr;
#pragma unroll
            for (int ks = 0; ks < 4; ++ks) {
                const int k0 = 128 * wid + 32 * ks + 8 * kq;
                const f32x4 g0 = *(const f32x4*)(g + k0), g1 = *(const f32x4*)(g + k0 + 4), s0 = *(const f32x4*)(scale + (size_t)b * 6144 + k0), s1 = *(const f32x4*)(scale + (size_t)b * 6144 + k0 + 4);
                const float Ac[8] = {g0[0] * (1.f + s0[0]), g0[1] * (1.f + s0[1]), g0[2] * (1.f + s0[2]), g0[3] * (1.f + s0[3]), g1[0] * (1.f + s1[0]), g1[1] * (1.f + s1[1]), g1[2] * (1.f + s1[2]), g1[3] * (1.f + s1[3])};
                const u32x4 xw = *(const u32x4*)(x1 + (size_t)row * D + k0);
                const float v[8] = {bflo(xw.x), bfhi(xw.x), bflo(xw.y), bfhi(xw.y), bflo(xw.z), bfhi(xw.z), bflo(xw.w), bfhi(xw.w)};
                unsigned ph[4], pl[4];
#pragma unroll
                for (int j = 0; j < 8; ++j) { ss += v[j] * v[j]; t[ks][j] = v[j] * Ac[j]; }
#pragma unroll
                for (int j = 0; j < 4; ++j) { ph[j] = cvt_pk_bf16(t[ks][2 * j], t[ks][2 * j + 1]); pl[j] = cvt_pk_bf16(t[ks][2 * j] - bflo(ph[j]), t[ks][2 * j + 1] - bfhi(ph[j])); }
                const bf16x8 Ah = __builtin_bit_cast(bf16x8, (u32x4){ph[0], ph[1], ph[2], ph[3]}), Al = __builtin_bit_cast(bf16x8, (u32x4){pl[0], pl[1], pl[2], pl[3]});
#pragma unroll
                for (int nt = 0; nt < 3; ++nt) {
                    const bf16x8 Bh = *(const bf16x8*)(wh + (size_t)(16 * nt) * 1024 + 32 * ks), Bl = *(const bf16x8*)(wh + 48 * 1024 + (size_t)(16 * nt) * 1024 + 32 * ks);
                    acc[nt] = mfma16r(Ah, Bh, acc[nt]); acc[nt] = mfma16r(Al, Bh, acc[nt]); acc[nt] = mfma16r(Ah, Bl, acc[nt]);
                }
            }
            ss += __shfl_xor(ss, 16); ss += __shfl_xor(ss, 32);
            if (kq == 0) ssp[wid * 16 + fr] = ss;
#pragma unroll
            for (int nt = 0; nt < 3; ++nt)
#pragma unroll
                for (int r = 0; r < 4; ++r) part[(wid * 16 + 4 * kq + r) * 48 + 16 * nt + fr] = acc[nt][r];
            __syncthreads();
            for (int i = tid; i < 16 * 48; i += NTHR) { float s = 0.f;
#pragma unroll
                for (int w = 0; w < 8; ++w) s += part[w * 16 * 48 + i];
                lgt[i] = s; }
            if (tid < 16) { float s = 0.f;
#pragma unroll
                for (int w = 0; w < 8; ++w) s += ssp[w * 16 + tid];
                rrow[tid] = rsqrtf(s * (1.0f / D) + EPS); }
            __syncthreads();
            if (tid < 16) {
                const int tok = r0 + 16 * q4 + tid; const float r = rrow[tid];
                float ag[4];
#pragma unroll
                for (int j = 0; j < 4; ++j) ag[j] = r * lgt[tid * 48 + j] + rb[j];
                int gi = 0; float gm = ag[0];
#pragma unroll
                for (int j = 1; j < 4; ++j) if (ag[j] > gm) { gm = ag[j]; gi = j; }
                float den = 0.f;
#pragma unroll
                for (int j = 0; j < 4; ++j) den += expf(ag[j] - gm);
                const float p_sel = 1.0f / den;
                float el[8];
#pragma unroll
                for (int j = 0; j < 8; ++j) el[j] = r * lgt[tid * 48 + 4 + gi * 8 + j] + rb[4 + gi * 8 + j];
                int j0 = 0; float v0 = el[0];
#pragma unroll
                for (int j = 1; j < 8; ++j) if (el[j] > v0) { v0 = el[j]; j0 = j; }
                int j1 = 0; float v1 = -INFINITY;
#pragma unroll
                for (int j = 0; j < 8; ++j) if (j != j0 && el[j] > v1) { v1 = el[j]; j1 = j; }
                const float e1 = expf(v1 - v0);
                const float g0 = p_sel / (1.0f + e1), g1 = p_sel * e1 / (1.0f + e1);
                const int ex0 = gi * 8 + j0, ex1 = gi * 8 + j1, ai = (16 * q4 + tid) * 2;
                const int p0 = __hip_atomic_fetch_add(lcnt + ex0, 1, __ATOMIC_RELAXED, __HIP_MEMORY_SCOPE_WORKGROUP), p1 = __hip_atomic_fetch_add(lcnt + ex1, 1, __ATOMIC_RELAXED, __HIP_MEMORY_SCOPE_WORKGROUP);
                rte[ai] = ex0; rtp[ai] = p0; rtt[ai] = tok; rtg[ai] = g0;
                rte[ai + 1] = ex1; rtp[ai + 1] = p1; rtt[ai + 1] = tok; rtg[ai + 1] = g1;
            }
            {
                const float r = rrow[fr];
                bf16_t* op = out + (size_t)row * D + 128 * wid + 8 * kq;
#pragma unroll
                for (int ks = 0; ks < 4; ++ks) {
                    const float* cp = shift + (size_t)b * 6144 + 128 * wid + 32 * ks + 8 * kq;
                    const f32x4 c0 = *(const f32x4*)cp, c1 = *(const f32x4*)(cp + 4);
                    u32x4 w; w.x = cvt_pk_bf16(t[ks][0] * r + c0[0], t[ks][1] * r + c0[1]); w.y = cvt_pk_bf16(t[ks][2] * r + c0[2], t[ks][3] * r + c0[3]);
                    w.z = cvt_pk_bf16(t[ks][4] * r + c1[0], t[ks][5] * r + c1[1]); w.w = cvt_pk_bf16(t[ks][6] * r + c1[2], t[ks][7] * r + c1[3]);
                    *(u32x4*)(op + 32 * ks) = w;
                }
            }
            __syncthreads();
        }
        if (tid < 32) { const int c = lcnt[tid]; lbase[tid] = c ? atomicAdd(&counts[tid * 64], c) : 0; }
        __syncthreads();
        if (tid < 128) { const int e = rte[tid], pos = lbase[e] + rtp[tid], tk = rtt[tid];
            list[(size_t)e * NTOK + pos] = tk; lgate[(size_t)e * NTOK + pos] = rtg[tid];
            tokinfo[tk * 4 + (tid & 1) * 2] = e; tokinfo[tk * 4 + (tid & 1) * 2 + 1] = pos; }
        __syncthreads();
    }
}

__device__ __forceinline__ void moe_cum(const Args& a, int l, LAS unsigned char* lds) {
    KArgs* ka = kargs();
    LAS int* cum = (LAS int*)(lds + LDS_MISC + MISC_CUM); LAS int* cn = (LAS int*)(lds + LDS_MISC + MISC_CNT);
    const int* counts = (const int*)(ka->ws + WS_CNT) + l * NE * 64;
    const int tq = opaque_tid();
    if (tq < 33) { int s = 0; for (int j = 0; j < tq; ++j) s += (ld_agent(counts + j * 64) + 255) >> 8; cum[tq] = s; if (tq < 32) cn[tq] = ld_agent(counts + tq * 64); }
    __syncthreads();
}

__device__ __forceinline__ void phase_combine(const Args& a, int l, LAS unsigned char* lds, int vcu, int G) {
    KArgs* ka = kargs();
    const int tid = opaque_tid(), wid = __builtin_amdgcn_readfirstlane(tid >> 6), lane = tid & 63;
    unsigned char* ws = ka->ws;
    moe_cum(a, l, lds);
    const LAS int* cum = (const LAS int*)(lds + LDS_MISC + MISC_CUM);
    const bf16_t* __restrict__ x1 = (const bf16_t*)(ws + WS_X1);
    bf16_t* __restrict__ xnext = (bf16_t*)(ws + WS_X1) + (size_t)NTOK * D;
    const float* mod = (const float*)(ws + WS_MOD) + (size_t)l * 4 * 6144;
    const float* gate2 = mod + 5120;
    const bf16_t* __restrict__ Y = (const bf16_t*)(ws + WS_Y);
    const int* __restrict__ tokinfo = (const int*)(ws + WS_TOKINFO);
    float* __restrict__ outp = ka->out;
    const bool nextl = (l + 1 < L);
    const float* modn = (const float*)(ws + WS_MOD) + (size_t)(nextl ? l + 1 : l) * 4 * 6144;
    const float* gn = IN_F(I_NORM1) + (nextl ? l + 1 : l) * D;
    bf16_t* __restrict__ hout = (bf16_t*)(ws + WS_HA);
    for (int rb = vcu * 8 + wid; rb < NTOK / 8; rb += G * 8) {
        const int row0 = rb * 8, b = row0 / S;
        float4 A[4], C[4], G2[4];
#pragma unroll
        for (int i = 0; i < 4; ++i) { const int k = 256 * i + 4 * lane; const float4 gv = *(const float4*)(gn + k), sc = *(const float4*)(modn + 1024 + (size_t)b * 6144 + k); C[i] = *(const float4*)(modn + (size_t)b * 6144 + k);
            A[i] = make_float4(gv.x * (1.f + sc.x), gv.y * (1.f + sc.y), gv.z * (1.f + sc.z), gv.w * (1.f + sc.w)); G2[i] = *(const float4*)(gate2 + (size_t)b * 6144 + k); }
#pragma unroll 4
        for (int rr = 0; rr < 8; ++rr) {
            const int tok = row0 + rr; const size_t ro = (size_t)tok * D;
            const int4 ti = *(const int4*)(tokinfo + tok * 4);
            const size_t s0 = (size_t)(cum[ti.x] * 256 + ti.y) * D, s1 = (size_t)(cum[ti.z] * 256 + ti.w) * D;
            float4 xo[4]; float ss = 0.f;
#pragma unroll
            for (int i = 0; i < 4; ++i) { const int k = 256 * i + 4 * lane; const u32x2 xw = *(const u32x2*)(x1 + ro + k); const float4 xv = make_float4(bflo(xw.x), bfhi(xw.x), bflo(xw.y), bfhi(xw.y)); const u32x2 y0 = *(const u32x2*)(Y + s0 + k), y1 = *(const u32x2*)(Y + s1 + k);
                xo[i].x = xv.x + G2[i].x * (bflo(y0.x) + bflo(y1.x)); xo[i].y = xv.y + G2[i].y * (bfhi(y0.x) + bfhi(y1.x)); xo[i].z = xv.z + G2[i].z * (bflo(y0.y) + bflo(y1.y)); xo[i].w = xv.w + G2[i].w * (bfhi(y0.y) + bfhi(y1.y));
                if (nextl) { u32x2 xb; xb.x = cvt_pk_bf16(xo[i].x, xo[i].y); xb.y = cvt_pk_bf16(xo[i].z, xo[i].w); *(u32x2*)(xnext + ro + k) = xb; } else *(float4*)(outp + ro + k) = xo[i];
                ss += xo[i].x * xo[i].x + xo[i].y * xo[i].y + xo[i].z * xo[i].z + xo[i].w * xo[i].w; }
            if (nextl) {
                const float r = rsqrtf(wave_sum(ss) * (1.0f / D) + EPS);
#pragma unroll
                for (int i = 0; i < 4; ++i) { u32x2 w; w.x = cvt_pk_bf16(xo[i].x * r * A[i].x + C[i].x, xo[i].y * r * A[i].y + C[i].y); w.y = cvt_pk_bf16(xo[i].z * r * A[i].z + C[i].z, xo[i].w * r * A[i].w + C[i].w);
                    *(u32x2*)(hout + ro + 256 * i + 4 * lane) = w; }
            }
        }
    }
}
constexpr size_t WS_KN = WS_R2;
constexpr size_t WS_VT = WS_KN + al256c((size_t)NTOK * 256 * 2);
constexpr size_t WS_IKR = WS_VT + al256c((size_t)NTOK * 256 * 2);
constexpr size_t WS_MASK = WS_IKR + al256c((size_t)NTOK * 32 * 2);
constexpr size_t WS_OA = WS_MASK + al256c((size_t)NTOK * 128 * 4);
constexpr size_t WS_R3 = WS_OA + al256c((size_t)NTOK * 256 * 2);
constexpr size_t WS_MIXB = (WS_R3 > WS_Y + (size_t)SLOTS * D * 2 ? WS_R3 : WS_Y + al256c((size_t)SLOTS * D * 2));

__device__ __forceinline__ f32x4 mfma16(const bf16x8 a, const bf16x8 b, const f32x4 c) { return __builtin_amdgcn_mfma_f32_16x16x32_bf16(a, b, c, 0, 0, 0); }
__device__ __forceinline__ bf16_t f2bf(float f) { return (bf16_t)(cvt_pk_bf16(f, 0.f) & 0xffffu); }

__device__ __forceinline__ void rows_rms_store(const LAS float* YB, const float* gain, bf16_t* mixb, int tok0, int col0, int wid, int lane) {
    const f32x4 gv = *(const f32x4*)(gain + 4 * lane);
#pragma unroll 2
    for (int rr = 0; rr < 8; ++rr) {
        const int t = 8 * wid + rr;
        const f32x4 y = *(const LAS f32x4*)(YB + t * 260 + 4 * lane);
        const float ss = wave_sum(y[0] * y[0] + y[1] * y[1] + y[2] * y[2] + y[3] * y[3]);
        const float r = rsqrtf(ss * (1.0f / 256.0f) + EPS);
        u32x2 w; w.x = cvt_pk_bf16(y[0] * r * gv[0], y[1] * r * gv[1]); w.y = cvt_pk_bf16(y[2] * r * gv[2], y[3] * r * gv[3]);
        *(u32x2*)(mixb + (size_t)(tok0 + t) * D + col0 + 4 * lane) = w;
    }
}

__device__ __forceinline__ void item_pool(const Args& a, int l, int tile, LAS unsigned char* lds) {
    KArgs* ka = kargs();
    const int tid = opaque_tid(), wid = __builtin_amdgcn_readfirstlane(tid >> 6), lane = tid & 63;
    unsigned char* ws = ka->ws;
    const bf16_t* proj = (const bf16_t*)(ws + WS_PROJ);
    LAS bf16_t* P = (LAS bf16_t*)lds;
    LAS bf16_t* PA = (LAS bf16_t*)(lds + 40960);
    LAS float* YB = (LAS float*)(lds + 40960 + 33792);
    const int tok0 = tile * 64, b = tok0 / S, t0 = tok0 % S;
#pragma unroll
    for (int p = tid; p < 79 * 32; p += NTHR) {
        const int r = p >> 5, c8 = p & 31, t = t0 - 15 + r;
        u32x4 v = (u32x4){0u, 0u, 0u, 0u};
        if (t >= 0) v = *(const u32x4*)(proj + (size_t)(b * S + t) * NP + NC + c8 * 8);
        *(LAS u32x4*)(P + r * 256 + c8 * 8) = v;
    }
    __syncthreads();
    {
        const int c = tid & 255, half = tid >> 8, g = c >> 6, w = 2 << g, tt0 = half * 32;
        float run = 0.f;
        for (int jj = 1; jj < w; ++jj) run += bf2f(P[(15 + tt0 - jj) * 256 + c]);
        for (int i = 0; i < 32; ++i) {
            const int tt = tt0 + i, r = 15 + tt;
            const float pv = bf2f(P[r * 256 + c]);
            run += pv;
            const int tabs = t0 + tt, nn = (tabs + 1 < w) ? (tabs + 1) : w;
            PA[tt * 264 + c] = f2bf(run / (float)nn - pv);
            run -= bf2f(P[(r - w + 1) * 256 + c]);
        }
    }
    __syncthreads();
    {
        const int g = wid >> 1, mh = wid & 1, fr = lane & 15, fq = lane >> 4;
        const bf16_t* PT = (const bf16_t*)(ws + WS_POOLT) + (size_t)(l * 4 + g) * 64 * 64;
        f32x4 acc[2][4];
#pragma unroll
        for (int mi = 0; mi < 2; ++mi)
#pragma unroll
            for (int ni = 0; ni < 4; ++ni) acc[mi][ni] = (f32x4){0.f, 0.f, 0.f, 0.f};
#pragma unroll
        for (int ks = 0; ks < 2; ++ks) {
            bf16x8 A[2];
#pragma unroll
            for (int mi = 0; mi < 2; ++mi) A[mi] = *(const LAS bf16x8*)(PA + (16 * (2 * mh + mi) + fr) * 264 + g * 64 + 32 * ks + 8 * fq);
#pragma unroll
            for (int ni = 0; ni < 4; ++ni) { const bf16x8 Bf = *(const bf16x8*)(PT + (16 * ni + fr) * 64 + 32 * ks + 8 * fq);
#pragma unroll
                for (int mi = 0; mi < 2; ++mi) acc[mi][ni] = mfma16(A[mi], Bf, acc[mi][ni]); }
        }
        const float* pb = IN_F(I_POOLB) + l * 256; const float* ps = IN_F(I_POOLS) + l * 256;
#pragma unroll
        for (int ni = 0; ni < 4; ++ni) { const int d = g * 64 + 16 * ni + fr; const float bb = pb[d], sc = ps[d];
#pragma unroll
            for (int mi = 0; mi < 2; ++mi)
#pragma unroll
                for (int r = 0; r < 4; ++r) YB[(16 * (2 * mh + mi) + 4 * fq + r) * 260 + d] = (acc[mi][ni][r] + bb) * sc; }
    }
    __syncthreads();
    rows_rms_store(YB, IN_F(I_ONORM) + l * D + 512, (bf16_t*)(ws + WS_MIXB), tok0, 512, wid, lane);
    __syncthreads();
}

__device__ __forceinline__ void item_conv(const Args& a, int l, int tile, LAS unsigned char* lds) {
    KArgs* ka = kargs();
    const int tid = opaque_tid(), wid = __builtin_amdgcn_readfirstlane(tid >> 6), lane = tid & 63;
    unsigned char* ws = ka->ws;
    const bf16_t* proj = (const bf16_t*)(ws + WS_PROJ);
    LAS float* GL = (LAS float*)lds;
    LAS bf16_t* CA = (LAS bf16_t*)(lds + 96256);
    LAS float* YB = (LAS float*)lds;
    const int tok0 = tile * 64, b = tok0 / S, t0 = tok0 % S;
#pragma unroll
    for (int p = tid; p < 94 * 32; p += NTHR) {
        const int r = p >> 5, c8 = p & 31, t = t0 - 30 + r;
        f32x4 o0 = (f32x4){0.f, 0.f, 0.f, 0.f}, o1 = o0;
        if (t >= 0) {
            const bf16_t* pr = proj + (size_t)(b * S + t) * NP;
            const u32x4 av = *(const u32x4*)(pr + NBA + c8 * 8), gv = *(const u32x4*)(pr + NBG + c8 * 8);
            o0[0] = bflo(av.x) * sigmoid_fast(bflo(gv.x)); o0[1] = bfhi(av.x) * sigmoid_fast(bfhi(gv.x)); o0[2] = bflo(av.y) * sigmoid_fast(bflo(gv.y)); o0[3] = bfhi(av.y) * sigmoid_fast(bfhi(gv.y));
            o1[0] = bflo(av.z) * sigmoid_fast(bflo(gv.z)); o1[1] = bfhi(av.z) * sigmoid_fast(bfhi(gv.z)); o1[2] = bflo(av.w) * sigmoid_fast(bflo(gv.w)); o1[3] = bfhi(av.w) * sigmoid_fast(bfhi(gv.w));
        }
        *(LAS f32x4*)(GL + r * 256 + c8 * 8) = o0; *(LAS f32x4*)(GL + r * 256 + c8 * 8 + 4) = o1;
    }
    __syncthreads();
    {
        const int c = tid & 255, half = tid >> 8;
        float wv[31];
#pragma unroll
        for (int jj = 0; jj < 31; ++jj) wv[jj] = IN_F(I_CONVW)[((size_t)l * 31 + jj) * 256 + c];
        const float cb = IN_F(I_CONVB)[l * 256 + c];
        float yv[32];
#pragma unroll
        for (int ch = 0; ch < 8; ++ch) {
            const int tt = half * 32 + ch * 4;
            float x[34];
#pragma unroll
            for (int m2 = 0; m2 < 34; ++m2) x[m2] = GL[(tt + m2) * 256 + c];
#pragma unroll
            for (int i = 0; i < 4; ++i) {
                float y = cb;
#pragma unroll
                for (int jj = 0; jj < 31; ++jj) y += x[i + jj] * wv[jj];
                yv[ch * 4 + i] = y;
            }
        }
        __syncthreads();
#pragma unroll
        for (int i = 0; i < 32; ++i) YB[(half * 32 + i) * 260 + c] = yv[i];
    }
    __syncthreads();
    {
        const int t = tid >> 3, part = tid & 7;
        float y[32]; float s1 = 0.f;
#pragma unroll
        for (int i = 0; i < 8; ++i) { const f32x4 v = *(const LAS f32x4*)(YB + t * 260 + part * 32 + 4 * i); y[4 * i] = v[0]; y[4 * i + 1] = v[1]; y[4 * i + 2] = v[2]; y[4 * i + 3] = v[3]; s1 += (v[0] + v[1]) + (v[2] + v[3]); }
        s1 += dpp_f<0xB1>(s1);
        const float mu = s1 * (1.0f / 64.0f);
        float s2 = 0.f;
#pragma unroll
        for (int i = 0; i < 32; ++i) { y[i] -= mu; s2 += y[i] * y[i]; }
        s2 += dpp_f<0xB1>(s2);
        const float rs = rsqrtf(s2 * (1.0f / 64.0f) + EPS);
        const float* lng = IN_F(I_CLNG) + l * 256 + part * 32; const float* lnb = IN_F(I_CLNB) + l * 256 + part * 32;
#pragma unroll
        for (int i = 0; i < 4; ++i) {
            float o[8];
#pragma unroll
            for (int e = 0; e < 8; ++e) o[e] = silu_f(y[8 * i + e] * rs * lng[8 * i + e] + lnb[8 * i + e]);
            u32x4 w; w.x = cvt_pk_bf16(o[0], o[1]); w.y = cvt_pk_bf16(o[2], o[3]); w.z = cvt_pk_bf16(o[4], o[5]); w.w = cvt_pk_bf16(o[6], o[7]);
            *(LAS u32x4*)(CA + t * 264 + part * 32 + 8 * i) = w;
        }
    }
    __syncthreads();
    {
        const int fr = lane & 15, fq = lane >> 4;
        const bf16_t* PW = (const bf16_t*)(ws + WS_PWT) + (size_t)l * 65536;
        f32x4 acc[4][2];
#pragma unroll
        for (int mi = 0; mi < 4; ++mi)
#pragma unroll
            for (int ni = 0; ni < 2; ++ni) acc[mi][ni] = (f32x4){0.f, 0.f, 0.f, 0.f};
#pragma unroll 2
        for (int ks = 0; ks < 8; ++ks) {
            bf16x8 Bf[2];
#pragma unroll
            for (int ni = 0; ni < 2; ++ni) Bf[ni] = *(const bf16x8*)(PW + (size_t)(32 * wid + 16 * ni + fr) * 256 + 32 * ks + 8 * fq);
#pragma unroll
            for (int mi = 0; mi < 4; ++mi) { const bf16x8 Af = *(const LAS bf16x8*)(CA + (16 * mi + fr) * 264 + 32 * ks + 8 * fq);
#pragma unroll
                for (int ni = 0; ni < 2; ++ni) acc[mi][ni] = mfma16(Af, Bf[ni], acc[mi][ni]); }
        }
        const float* pwb = IN_F(I_PWB) + l * 256;
#pragma unroll
        for (int ni = 0; ni < 2; ++ni) { const int n = 32 * wid + 16 * ni + fr; const float bb = pwb[n];
#pragma unroll
            for (int mi = 0; mi < 4; ++mi)
#pragma unroll
                for (int r = 0; r < 4; ++r) YB[(16 * mi + 4 * fq + r) * 260 + n] = acc[mi][ni][r] + bb; }
    }
    __syncthreads();
    rows_rms_store(YB, IN_F(I_ONORM) + l * D + 256, (bf16_t*)(ws + WS_MIXB), tok0, 256, wid, lane);
    __syncthreads();
}

__device__ __forceinline__ void item_sgu(const Args& a, int l, int ch, LAS unsigned char* lds) {
    KArgs* ka = kargs();
    const int tid = opaque_tid(), wid = __builtin_amdgcn_readfirstlane(tid >> 6), lane = tid & 63;
    unsigned char* ws = ka->ws;
    const bf16_t* proj = (const bf16_t*)(ws + WS_PROJ);
    LAS bf16_t* VT = (LAS bf16_t*)lds;
    LAS bf16_t* OB = (LAS bf16_t*)(lds + 69632);
    const int tok0 = ch * 128;
    {
        const f32x4 lg = *(const f32x4*)(IN_F(I_SLNG) + l * 256 + 4 * lane), lb = *(const f32x4*)(IN_F(I_SLNB) + l * 256 + 4 * lane);
#pragma unroll 8
        for (int i = 0; i < 16; ++i) {
            const int s = 16 * wid + i;
            const u32x2 vv = *(const u32x2*)(proj + (size_t)(tok0 + s) * NP + NDV + 4 * lane);
            const float v0 = bflo(vv.x), v1 = bfhi(vv.x), v2 = bflo(vv.y), v3 = bfhi(vv.y);
            const float mu = wave_sum((v0 + v1) + (v2 + v3)) * (1.0f / 256.0f);
            const float d0 = v0 - mu, d1 = v1 - mu, d2 = v2 - mu, d3 = v3 - mu;
            const float rs = rsqrtf(wave_sum((d0 * d0 + d1 * d1) + (d2 * d2 + d3 * d3)) * (1.0f / 256.0f) + EPS);
            VT[(4 * lane + 0) * 136 + s] = f2bf(d0 * rs * lg[0] + lb[0]); VT[(4 * lane + 1) * 136 + s] = f2bf(d1 * rs * lg[1] + lb[1]);
            VT[(4 * lane + 2) * 136 + s] = f2bf(d2 * rs * lg[2] + lb[2]); VT[(4 * lane + 3) * 136 + s] = f2bf(d3 * rs * lg[3] + lb[3]);
        }
    }
    __syncthreads();
    {
        const int h = wid >> 1, np = wid & 1, fr = lane & 15, fq = lane >> 4;
        const bf16_t* W = (const bf16_t*)(ws + WS_SGUW) + (size_t)(l * 4 + h) * 128 * 128;
        const float* sb = IN_F(I_SGUB) + (l * 4 + h) * 128;
#pragma unroll 1
        for (int mi = 0; mi < 8; ++mi) {
            f32x4 acc[2] = {(f32x4){0.f, 0.f, 0.f, 0.f}, (f32x4){0.f, 0.f, 0.f, 0.f}};
            for (int ks = 0; ks <= (mi >> 1); ++ks) {
                const bf16x8 Af = *(const bf16x8*)(W + (size_t)(16 * mi + fr) * 128 + 32 * ks + 8 * fq);
#pragma unroll
                for (int ni = 0; ni < 2; ++ni) { const bf16x8 Bf = *(const LAS bf16x8*)(VT + (h * 64 + 32 * np + 16 * ni + fr) * 136 + 32 * ks + 8 * fq); acc[ni] = mfma16(Af, Bf, acc[ni]); }
            }
#pragma unroll
            for (int ni = 0; ni < 2; ++ni)
#pragma unroll
                for (int r = 0; r < 4; ++r) { const int t = 16 * mi + 4 * fq + r; OB[t * 264 + h * 64 + 32 * np + 16 * ni + fr] = f2bf(acc[ni][r] + sb[t]); }
        }
    }
    __syncthreads();
    {
        const f32x4 gv = *(const f32x4*)(IN_F(I_ONORM) + l * D + 768 + 4 * lane);
        bf16_t* mixb = (bf16_t*)(ws + WS_MIXB);
#pragma unroll 8
        for (int i = 0; i < 16; ++i) {
            const int t = 16 * wid + i;
            const u32x2 mv = *(const LAS u32x2*)(OB + t * 264 + 4 * lane);
            const u32x2 uv = *(const u32x2*)(proj + (size_t)(tok0 + t) * NP + NDU + 4 * lane);
            const float o0 = bflo(uv.x) * bflo(mv.x), o1 = bfhi(uv.x) * bfhi(mv.x), o2 = bflo(uv.y) * bflo(mv.y), o3 = bfhi(uv.y) * bfhi(mv.y);
            const float r = rsqrtf(wave_sum((o0 * o0 + o1 * o1) + (o2 * o2 + o3 * o3)) * (1.0f / 256.0f) + EPS);
            u32x2 w; w.x = cvt_pk_bf16(o0 * r * gv[0], o1 * r * gv[1]); w.y = cvt_pk_bf16(o2 * r * gv[2], o3 * r * gv[3]);
            *(u32x2*)(mixb + (size_t)(tok0 + t) * D + 768 + 4 * lane) = w;
        }
    }
    __syncthreads();
}

__device__ __forceinline__ void item_prepk(const Args& a, int l, int tile, LAS unsigned char* lds) {
    KArgs* ka = kargs();
    const int tid = opaque_tid(), wid = __builtin_amdgcn_readfirstlane(tid >> 6), lane = tid & 63;
    unsigned char* ws = ka->ws;
    const bf16_t* proj = (const bf16_t*)(ws + WS_PROJ);
    LAS bf16_t* VS = (LAS bf16_t*)lds;
    bf16_t* KN = (bf16_t*)(ws + WS_KN); bf16_t* VTg = (bf16_t*)(ws + WS_VT); bf16_t* IKR = (bf16_t*)(ws + WS_IKR);
    const float* ropeA = (const float*)(ws + WS_ROPEA); const float* ropeI = (const float*)(ws + WS_ROPEI);
    const int tok0 = tile * 64, b = tok0 / S, s0 = tok0 % S;
    const int li = lane & 15, head = lane >> 4;
    const f32x4 kg = *(const f32x4*)(IN_F(I_KN) + l * 64 + 4 * li);
#pragma unroll 4
    for (int i = 0; i < 8; ++i) {
        const int tl = 8 * wid + i, tok = tok0 + tl, s = s0 + tl;
        const bf16_t* pr = proj + (size_t)tok * NP;
        const u32x2 kv = *(const u32x2*)(pr + NK + 4 * lane);
        float k0 = bflo(kv.x), k1 = bfhi(kv.x), k2 = bflo(kv.y), k3 = bfhi(kv.y);
        float ss = (k0 * k0 + k1 * k1) + (k2 * k2 + k3 * k3);
        ss = row_sum16(ss);
        const float r = rsqrtf(ss * (1.0f / 64.0f) + EPS);
        k0 *= r * kg[0]; k1 *= r * kg[1]; k2 *= r * kg[2]; k3 *= r * kg[3];
        {
            const float p0 = __shfl_xor(k0, 2), p1 = __shfl_xor(k1, 2), p2 = __shfl_xor(k2, 2), p3 = __shfl_xor(k3, 2);
            if (li < 4) {
                const int dd = 4 * (li & 1);
                const f32x4 cs = *(const f32x4*)(ropeA + (size_t)tok * 16 + dd), sn = *(const f32x4*)(ropeA + (size_t)tok * 16 + 8 + dd);
                if (li < 2) { k0 = k0 * cs[0] - p0 * sn[0]; k1 = k1 * cs[1] - p1 * sn[1]; k2 = k2 * cs[2] - p2 * sn[2]; k3 = k3 * cs[3] - p3 * sn[3]; }
                else        { k0 = k0 * cs[0] + p0 * sn[0]; k1 = k1 * cs[1] + p1 * sn[1]; k2 = k2 * cs[2] + p2 * sn[2]; k3 = k3 * cs[3] + p3 * sn[3]; }
            }
        }
        u32x2 ko; ko.x = cvt_pk_bf16(k0, k1); ko.y = cvt_pk_bf16(k2, k3);
        *(u32x2*)(KN + ((size_t)((b * 4 + head) * 128 + (s >> 5)) * 32 + (s & 31)) * 64 + 4 * li) = ko;
        *(LAS u32x2*)(VS + tl * 256 + 4 * lane) = *(const u32x2*)(pr + NV + 4 * lane);
        if (lane < 8) {
            const u32x2 iv = *(const u32x2*)(pr + NIK + 4 * lane);
            float x0 = bflo(iv.x), x1 = bfhi(iv.x), x2 = bflo(iv.y), x3 = bfhi(iv.y);
            const float q0 = __shfl_xor(x0, 1), q1 = __shfl_xor(x1, 1), q2 = __shfl_xor(x2, 1), q3 = __shfl_xor(x3, 1);
            if (lane < 2) {
                const f32x4 cs = *(const f32x4*)(ropeI + (size_t)tok * 8), sn = *(const f32x4*)(ropeI + (size_t)tok * 8 + 4);
                if (lane == 0) { x0 = x0 * cs[0] - q0 * sn[0]; x1 = x1 * cs[1] - q1 * sn[1]; x2 = x2 * cs[2] - q2 * sn[2]; x3 = x3 * cs[3] - q3 * sn[3]; }
                else           { x0 = x0 * cs[0] + q0 * sn[0]; x1 = x1 * cs[1] + q1 * sn[1]; x2 = x2 * cs[2] + q2 * sn[2]; x3 = x3 * cs[3] + q3 * sn[3]; }
            }
            u32x2 io; io.x = cvt_pk_bf16(x0, x1); io.y = cvt_pk_bf16(x2, x3);
            *(u32x2*)(IKR + (size_t)tok * 32 + 4 * lane) = io;
        }
    }
    __syncthreads();
#pragma unroll
    for (int i = 0; i < 4; ++i) {
        const int p = tid + NTHR * i;
        const int h = p >> 9, ktl = (p >> 8) & 1, d = (p >> 2) & 63, part = p & 3;
        unsigned short e[8];
#pragma unroll
        for (int jj = 0; jj < 8; ++jj) { const int key = 4 * part + (jj & 3) + 16 * (jj >> 2); e[jj] = VS[(ktl * 32 + key) * 256 + h * 64 + d]; }
        u32x4 w; w.x = e[0] | ((unsigned)e[1] << 16); w.y = e[2] | ((unsigned)e[3] << 16); w.z = e[4] | ((unsigned)e[5] << 16); w.w = e[6] | ((unsigned)e[7] << 16);
        *(u32x4*)(VTg + ((size_t)((b * 4 + h) * 128 + (s0 >> 5) + ktl) * 64 + d) * 32 + 8 * part) = w;
    }
    __syncthreads();
}

__device__ __forceinline__ void phase_mix1(const Args& a, int l, LAS unsigned char* lds, int vcu, int G, int bx) {
    if (G == 256) {
        if (bx < 64) { item_conv(a, l, bx, lds); item_pool(a, l, bx, lds); }
        else {
            const int w = bx - 64;
            if (w < 128) item_sgu(a, l, w, lds);
            item_prepk(a, l, w, lds);
            item_conv(a, l, 64 + w, lds);
            if (w >= 128) item_prepk(a, l, 192 + (w - 128), lds);
            item_pool(a, l, 64 + w, lds);
        }
        return;
    }
    for (int it = vcu; it < 896; it += G) {
        if (it < 128) item_sgu(a, l, it, lds);
        else if (it < 384) item_conv(a, l, it - 128, lds);
        else if (it < 640) item_pool(a, l, it - 384, lds);
        else item_prepk(a, l, it - 640, lds);
    }
}
__device__ __forceinline__ f32x16 mfma32(const bf16x8 a, const bf16x8 b, const f32x16 c) { return __builtin_amdgcn_mfma_f32_32x32x16_bf16(a, b, c, 0, 0, 0); }
typedef float f32x2 __attribute__((ext_vector_type(2)));

__device__ __forceinline__ void a1_scores(const bf16x8 A0, const bf16x8 A1, const bf16x8 (&Bq)[4][2], const float (&cl)[4], f32x2 (&sc)[8]) {
    f32x16 d[4];
#pragma unroll
    for (int h = 0; h < 4; ++h) {
#pragma unroll
        for (int r = 0; r < 16; ++r) d[h][r] = 0.f;
        d[h] = mfma32(A0, Bq[h][0], d[h]); d[h] = mfma32(A1, Bq[h][1], d[h]);
    }
#pragma unroll
    for (int p = 0; p < 8; ++p) {
        f32x2 m[4];
#pragma unroll
        for (int h = 0; h < 4; ++h) { m[h][0] = __builtin_amdgcn_fmed3f(d[h][2 * p], 0.0f, cl[h]); m[h][1] = __builtin_amdgcn_fmed3f(d[h][2 * p + 1], 0.0f, cl[h]); }
        sc[p] = (m[0] + m[1]) + (m[2] + m[3]);
    }
}

#define A1_STREAM_BEGIN { \
    bf16x8 rA[4][2]; const int ntw_ = (nkt - wid + 7) >> 3; \
    _Pragma("unroll") for (int u_ = 0; u_ < 4; ++u_) { rA[u_][0] = Bq[0][0]; rA[u_][1] = Bq[0][0]; if (u_ < ntw_) { const size_t o_ = (size_t)(wid + 8 * u_) * 1024; rA[u_][0] = *(const bf16x8*)(ikl + o_); rA[u_][1] = *(const bf16x8*)(ikl + o_ + 16); } } \
    for (int i_ = 0; i_ < ntw_; i_ += 4) { \
        _Pragma("unroll") for (int u_ = 0; u_ < 4; ++u_) { if (i_ + u_ < ntw_) { \
            const bf16x8 cA0 = rA[u_][0], cA1 = rA[u_][1]; const int kt = wid + 8 * (i_ + u_); \
            if (i_ + u_ + 4 < ntw_) { const size_t o_ = (size_t)(kt + 32) * 1024; rA[u_][0] = *(const bf16x8*)(ikl + o_); rA[u_][1] = *(const bf16x8*)(ikl + o_ + 16); }
#define A1_STREAM_END } } } }

template <int KIND>
__device__ __forceinline__ void a1_pass(const bf16_t* ikl, int nkt, int wid, const bf16x8 (&Bq)[4][2], const float (&cl)[4], LAS unsigned char* histb, unsigned q4, unsigned cadd) {
    A1_STREAM_BEGIN
        f32x2 sc[8];
        a1_scores(cA0, cA1, Bq, cl, sc);
#pragma unroll
        for (int r = 0; r < 16; ++r) {
            const unsigned u = __float_as_uint(sc[r >> 1][r & 1]);
            unsigned addr;
            if (KIND == 0) addr = (((u + 0x8000u) >> 17) & 0x7f80u) | q4;
            else { unsigned dg = (u + cadd) >> 16; dg = dg < 256u ? dg : 256u; addr = (dg << 7) + q4; }
            __hip_atomic_fetch_add((LAS unsigned*)(histb + addr), 1u, __ATOMIC_RELAXED, __HIP_MEMORY_SCOPE_WORKGROUP);
        }
    A1_STREAM_END
}

template <int LEVEL>
__device__ __forceinline__ void a1_scan(LAS unsigned* hist, LAS unsigned* psum, LAS unsigned* qst, int tid) {
    const int sq = tid & 31, part = tid >> 5;
    const unsigned need = qst[32 + sq], p1 = qst[sq];
    const bool neg = (p1 & 0x80u) != 0u;
#define A1_RAWROW(bn) (LEVEL == 0 ? ((bn) >= 128 ? (bn) - 128 : 255 - (bn)) : (neg ? 255 - (bn) : (bn)))
    unsigned local = 0u;
#pragma unroll
    for (int bb = 0; bb < 16; ++bb) local += hist[A1_RAWROW(16 * part + bb) * 32 + sq];
    psum[part * 32 + sq] = local;
    __syncthreads();
    unsigned above = 0u;
    for (int pp = part + 1; pp < 16; ++pp) above += psum[pp * 32 + sq];
    if (above < need && above + local >= need) {
        unsigned run = above;
        for (int bb = 15; bb >= 0; --bb) {
            const int raw = A1_RAWROW(16 * part + bb);
            const unsigned c = hist[raw * 32 + sq];
            if (run + c >= need) {
                if (LEVEL == 0) { qst[sq] = (unsigned)raw; qst[32 + sq] = need - run; }
                else { qst[sq] = (p1 << 8) | (unsigned)raw; qst[32 + sq] = need - run; qst[64 + sq] = c; }
                break;
            }
            run += c;
        }
    }
#undef A1_RAWROW
}

__device__ __forceinline__ void a1_cmp2(unsigned& gt, unsigned& ge, float s0, float s1, float tg, float te) {
#ifdef A1_NOASM
    gt = (gt << 1) | (s0 >= tg ? 1u : 0u); ge = (ge << 1) | (s0 >= te ? 1u : 0u);
    gt = (gt << 1) | (s1 >= tg ? 1u : 0u); ge = (ge << 1) | (s1 >= te ? 1u : 0u);
#else
    unsigned long long m1, m2, m3;
    asm("v_cmp_ge_f32 vcc, %[s0], %[tg]\n\t"
        "v_cmp_ge_f32 %[m1], %[s0], %[te]\n\t"
        "v_cmp_ge_f32 %[m2], %[s1], %[tg]\n\t"
        "v_cmp_ge_f32 %[m3], %[s1], %[te]\n\t"
        "v_addc_co_u32 %[g], vcc, %[g], %[g], vcc\n\t"
        "v_addc_co_u32 %[e], %[m1], %[e], %[e], %[m1]\n\t"
        "v_addc_co_u32 %[g], %[m2], %[g], %[g], %[m2]\n\t"
        "v_addc_co_u32 %[e], %[m3], %[e], %[e], %[m3]"
        : [g] "+v"(gt), [e] "+v"(ge), [m1] "=&s"(m1), [m2] "=&s"(m2), [m3] "=&s"(m3)
        : [s0] "v"(s0), [s1] "v"(s1), [tg] "v"(tg), [te] "v"(te)
        : "vcc");
#endif
}
__device__ __forceinline__ unsigned a1_spread(unsigned x) { return (x & 0xfu) | ((x & 0xf0u) << 4) | ((x & 0xf00u) << 8) | ((x & 0xf000u) << 12); }

constexpr int A1_HISTA = 0, A1_HISTB = 257 * 32, A1_PSUM = 2 * 257 * 32, A1_QST = A1_PSUM + 16 * 32, A1_MBUF = A1_QST + 128, A1_TBUF = A1_MBUF + 32 * 128;
__device__ __forceinline__ void a1_tile(const Args& a, int l, int b, int j, LAS unsigned char* lds) {
    KArgs* ka = kargs();
    const int tid = opaque_tid(), wid = __builtin_amdgcn_readfirstlane(tid >> 6), lane = tid & 63, q = lane & 31, hh = lane >> 5;
    unsigned char* ws = ka->ws;
    const bf16_t* proj = (const bf16_t*)(ws + WS_PROJ);
    const bf16_t* ikr = (const bf16_t*)(ws + WS_IKR) + (size_t)b * S * 32;
    const bf16_t* ikl = ikr + (lane & 31) * 32 + 8 * (lane >> 5);
    unsigned* maskg = (unsigned*)(ws + WS_MASK);
    LAS unsigned* L = (LAS unsigned*)lds;
    LAS unsigned* psum = L + A1_PSUM; LAS unsigned* qst = L + A1_QST; LAS unsigned* mbuf = L + A1_MBUF; LAS unsigned* tbuf = L + A1_TBUF;
    const int t0 = j * 32, n = (t0 / 64 + 1) * 64, nkt = n / 32, nw = ((t0 / 128) + 1) * 4;
    if (n <= 256) {
        for (int i = tid; i < 32 * nw; i += NTHR) { const int qq = i / nw, w = i % nw; maskg[(size_t)(b * S + t0 + qq) * 128 + w] = (w < nkt) ? 0xffffffffu : 0u; }
        return;
    }
    bf16x8 Bq[4][2]; float cl[4];
    {
        const int tok = b * S + t0 + q;
        const bf16_t* pr = proj + (size_t)tok * NP;
        const f32x4 cs = *(const f32x4*)((const float*)(ws + WS_ROPEI) + (size_t)tok * 8), sn = *(const f32x4*)((const float*)(ws + WS_ROPEI) + (size_t)tok * 8 + 4);
#pragma unroll
        for (int h = 0; h < 4; ++h) {
            const float wsc = bf2f(pr[NIW + h]) * (0.5f * 0.17677669529663687f);
            cl[h] = (wsc > 0.f) ? INFINITY : -INFINITY;
#pragma unroll
            for (int ks = 0; ks < 2; ++ks) {
                const u32x4 raw = *(const u32x4*)(pr + NIQ + h * 32 + 16 * ks + 8 * hh);
                float v[8] = {bflo(raw.x), bfhi(raw.x), bflo(raw.y), bfhi(raw.y), bflo(raw.z), bfhi(raw.z), bflo(raw.w), bfhi(raw.w)};
                if (ks == 0 && hh == 0) {
#pragma unroll
                    for (int i = 0; i < 4; ++i) { const float x1 = v[i], x2 = v[i + 4]; v[i] = x1 * cs[i] - x2 * sn[i]; v[i + 4] = x2 * cs[i] + x1 * sn[i]; }
                }
                u32x4 pk; pk.x = cvt_pk_bf16(v[0] * wsc, v[1] * wsc); pk.y = cvt_pk_bf16(v[2] * wsc, v[3] * wsc); pk.z = cvt_pk_bf16(v[4] * wsc, v[5] * wsc); pk.w = cvt_pk_bf16(v[6] * wsc, v[7] * wsc);
                Bq[h][ks] = __builtin_bit_cast(bf16x8, pk);
            }
        }
    }
    { LAS u32x4* hz = (LAS u32x4*)(L + A1_HISTA); for (int i = tid; i < 2 * 257 * 32 / 4; i += NTHR) hz[i] = (u32x4){0u, 0u, 0u, 0u}; }
    if (tid < 32) { qst[tid] = 0u; qst[32 + tid] = 256u; qst[64 + tid] = 0u; }
    __syncthreads();
    const unsigned q4 = (unsigned)q * 4u;
    a1_pass<0>(ikl, nkt, wid, Bq, cl, (LAS unsigned char*)(L + A1_HISTA), q4, 0u);
    __syncthreads();
    a1_scan<0>(L + A1_HISTA, psum, qst, tid);
    __syncthreads();
    a1_pass<1>(ikl, nkt, wid, Bq, cl, (LAS unsigned char*)(L + A1_HISTB), q4, 0x8000u - (qst[q] << 24));
    __syncthreads();
    a1_scan<1>(L + A1_HISTB, psum, qst, tid);
    __syncthreads();
    {
        const unsigned T = qst[q], mag = T & 0x7fffu;
        unsigned bg, be;
        if ((T & 0x8000u) == 0u) { be = mag ? (mag << 16) - 0x8000u : 0u; bg = ((mag + 1u) << 16) - 0x8000u; }
        else { be = 0x80000000u | (((mag + 1u) << 16) - 0x8001u); bg = mag ? (0x80000000u | ((mag << 16) - 0x8001u)) : 0u; }
        const float tg = __uint_as_float(bg), te = __uint_as_float(be);
        A1_STREAM_BEGIN
            f32x2 sc[8];
            a1_scores(cA0, cA1, Bq, cl, sc);
            unsigned gt = 0u, ge = 0u;
#pragma unroll
            for (int p = 7; p >= 0; --p) a1_cmp2(gt, ge, sc[p][1], sc[p][0], tg, te);
            unsigned wb = a1_spread(gt & 0xffffu) << (4 * hh), eb = a1_spread(ge & 0xffffu) << (4 * hh);
            wb |= (unsigned)__shfl_xor((int)wb, 32); eb |= (unsigned)__shfl_xor((int)eb, 32);
            if (hh == 0) { mbuf[q * 128 + kt] = wb; tbuf[q * 128 + kt] = eb & ~wb; }
        A1_STREAM_END
    }
    __syncthreads();
    {
        const int qq = tid >> 4, part = tid & 15;
        const unsigned need = qst[32 + qq];
        const u32x4 ta = *(const LAS u32x4*)(tbuf + qq * 128 + part * 8), tb = *(const LAS u32x4*)(tbuf + qq * 128 + part * 8 + 4);
        const u32x4 ma = *(const LAS u32x4*)(mbuf + qq * 128 + part * 8), mb = *(const LAS u32x4*)(mbuf + qq * 128 + part * 8 + 4);
        unsigned t[8] = {ta.x, ta.y, ta.z, ta.w, tb.x, tb.y, tb.z, tb.w}, m[8] = {ma.x, ma.y, ma.z, ma.w, mb.x, mb.y, mb.z, mb.w};
        unsigned c = 0u;
#pragma unroll
        for (int i = 0; i < 8; ++i) { if (part * 8 + i >= nkt) { t[i] = 0u; m[i] = 0u; } c += (unsigned)__builtin_popcount(t[i]); }
        unsigned inc = c;
#pragma unroll
        for (int dd = 1; dd < 16; dd <<= 1) { const unsigned v = (unsigned)__shfl_up((int)inc, dd, 16); if (part >= dd) inc += v; }
        int rem = (int)need - (int)(inc - c);
#pragma unroll
        for (int i = 0; i < 8; ++i) {
            const int ci = __builtin_popcount(t[i]);
            unsigned keep = 0u;
            if (rem >= ci) keep = t[i];
            else if (rem > 0) { unsigned tt = t[i]; for (int k = rem; k > 0; --k) { const unsigned low = tt & (0u - tt); keep |= low; tt ^= low; } }
            m[i] |= keep; rem -= ci;
        }
        unsigned* mg = maskg + (size_t)(b * S + t0 + qq) * 128 + part * 8;
        if (part * 8 < nw) *(u32x4*)mg = (u32x4){m[0], m[1], m[2], m[3]};
        if (part * 8 + 4 < nw) *(u32x4*)(mg + 4) = (u32x4){m[4], m[5], m[6], m[7]};
    }
    __syncthreads();
}
__device__ __forceinline__ void phase_a1(const Args& a, int l, LAS unsigned char* lds, int vcu, int G) {
    KArgs* ka = kargs();
    for (int it = vcu; it < 256; it += G) { const int b = it >> 6, jj = it & 63; a1_tile(a, l, b, 127 - jj, lds); a1_tile(a, l, b, jj, lds); }
}

__device__ __forceinline__ void a2_unit(const Args& a, int l, int b, int h, int blk, LAS unsigned char* lds) {
    KArgs* ka = kargs();
    const int tid = opaque_tid(), wid = __builtin_amdgcn_readfirstlane(tid >> 6), lane = tid & 63, fr = lane & 15, kq = lane >> 4;
    unsigned char* ws = ka->ws;
    const bf16_t* proj = (const bf16_t*)(ws + WS_PROJ);
    const char* KNb = (const char*)(ws + WS_KN) + (size_t)(b * 4 + h) * 128 * 4096;
    const char* VTb = (const char*)(ws + WS_VT) + (size_t)(b * 4 + h) * 128 * 4096;
    LAS unsigned char* Kb = lds;
    LAS unsigned char* Vb = lds + 32768;
    LAS float* Ob = (LAS float*)(lds + 65536) + wid * (16 * 68);
    const int nsteps = 2 * (blk + 1);
    const int tokq = b * S + blk * 128 + wid * 16 + fr;
    bf16x8 Qb[2]; float C2;
    {
        const float* qg = IN_F(I_QN) + l * 64; const float* kg = IN_F(I_KN) + l * 64;
        float gq = 0.f, gk = 0.f;
        for (int i = 0; i < 64; ++i) { gq = fmaxf(gq, fabsf(qg[i])); gk = fmaxf(gk, fabsf(kg[i])); }
        C2 = 8.0f * gq * gk * 1.4426950408889634f;
        const bf16_t* pr = proj + (size_t)tokq * NP + NQ + h * 64;
        float v[2][8]; float ss = 0.f;
#pragma unroll
        for (int ks = 0; ks < 2; ++ks) { const u32x4 raw = *(const u32x4*)(pr + 32 * ks + 8 * kq);
            v[ks][0] = bflo(raw.x); v[ks][1] = bfhi(raw.x); v[ks][2] = bflo(raw.y); v[ks][3] = bfhi(raw.y); v[ks][4] = bflo(raw.z); v[ks][5] = bfhi(raw.z); v[ks][6] = bflo(raw.w); v[ks][7] = bfhi(raw.w);
#pragma unroll
            for (int i = 0; i < 8; ++i) ss += v[ks][i] * v[ks][i]; }
        ss += __shfl_xor(ss, 16); ss += __shfl_xor(ss, 32);
        const float r = rsqrtf(ss * (1.0f / 64.0f) + EPS);
#pragma unroll
        for (int ks = 0; ks < 2; ++ks)
#pragma unroll
            for (int i = 0; i < 8; ++i) v[ks][i] *= r * qg[32 * ks + 8 * kq + i];
        {
            const float* ra = (const float*)(ws + WS_ROPEA) + (size_t)tokq * 16;
#pragma unroll
            for (int i = 0; i < 8; ++i) { const float pv = __shfl_xor(v[0][i], 16); const float c = ra[i], s = ra[8 + i];
                if (kq == 0) v[0][i] = v[0][i] * c - pv * s; else if (kq == 1) v[0][i] = v[0][i] * c + pv * s; }
        }
        const float qs = 0.125f * 1.4426950408889634f;
#pragma unroll
        for (int ks = 0; ks < 2; ++ks) { u32x4 pk; pk.x = cvt_pk_bf16(v[ks][0] * qs, v[ks][1] * qs); pk.y = cvt_pk_bf16(v[ks][2] * qs, v[ks][3] * qs); pk.z = cvt_pk_bf16(v[ks][4] * qs, v[ks][5] * qs); pk.w = cvt_pk_bf16(v[ks][6] * qs, v[ks][7] * qs);
            Qb[ks] = __builtin_bit_cast(bf16x8, pk); }
    }
    const unsigned* mrow = (const unsigned*)(ws + WS_MASK) + (size_t)tokq * 128;
    f32x4 O[4];
#pragma unroll
    for (int dt = 0; dt < 4; ++dt) O[dt] = (f32x4){0.f, 0.f, 0.f, 0.f};
    float lsum = 0.f;
    const unsigned bit0 = 1u << (4 * kq);
    const int kkey = tid >> 3, kch = tid & 7, vsub = tid >> 8, vd = (tid >> 2) & 63, vch = tid & 3;
    const int klds = kkey * 128 + ((kch ^ (kkey & 7)) * 16), vlds = vsub * 4096 + vd * 64 + ((vch ^ ((vd >> 2) & 3)) * 16);
    u32x4 kr0, kr1, kr2, kr3, vr0, vr1, vr2, vr3; u32x2 mw0, mw1, mw2, mw3;
#define A2_LOAD(j, st_) do { kr##j = *(const u32x4*)(KNb + (size_t)(st_) * 8192 + (size_t)tid * 16); vr##j = *(const u32x4*)(VTb + (size_t)(st_) * 8192 + (size_t)tid * 16); mw##j = *(const u32x2*)(mrow + 2 * (st_)); } while (0)
    A2_LOAD(0, 0); A2_LOAD(1, 1);
    if (nsteps > 2) { A2_LOAD(2, 2); A2_LOAD(3, 3); } else { kr2 = kr0; vr2 = vr0; mw2 = mw0; kr3 = kr0; vr3 = vr0; mw3 = mw0; }
    __syncthreads();
#define A2_HALF(Kc, Vc, mcur) do { \
        _Pragma("unroll") for (int sub = 0; sub < 2; ++sub) { \
            const unsigned m = sub ? (mcur).y : (mcur).x; \
            f32x4 Sx[2]; \
            _Pragma("unroll") for (int tl = 0; tl < 2; ++tl) { \
                const int key = 32 * sub + 16 * tl + fr; \
                const bf16x8 A0 = *(const LAS bf16x8*)((Kc) + key * 128 + (((0 + kq) ^ (key & 7)) * 16)); \
                const bf16x8 A1 = *(const LAS bf16x8*)((Kc) + key * 128 + (((4 + kq) ^ (key & 7)) * 16)); \
                f32x4 z = (f32x4){-C2, -C2, -C2, -C2};     \
                z = mfma16(A0, Qb[0], z); Sx[tl] = mfma16(A1, Qb[1], z); \
            } \
            float p[8]; \
            _Pragma("unroll") for (int r = 0; r < 4; ++r) { \
                const float e0 = __builtin_amdgcn_exp2f(Sx[0][r]), e1 = __builtin_amdgcn_exp2f(Sx[1][r]); \
                p[r] = (m & (bit0 << r)) ? e0 : 0.f; p[4 + r] = (m & (bit0 << (16 + r))) ? e1 : 0.f; \
            } \
            lsum += ((p[0] + p[1]) + (p[2] + p[3])) + ((p[4] + p[5]) + (p[6] + p[7])); \
            u32x4 pk; pk.x = cvt_pk_bf16(p[0], p[1]); pk.y = cvt_pk_bf16(p[2], p[3]); pk.z = cvt_pk_bf16(p[4], p[5]); pk.w = cvt_pk_bf16(p[6], p[7]); \
            const bf16x8 Pf = __builtin_bit_cast(bf16x8, pk); \
            _Pragma("unroll") for (int dt = 0; dt < 4; ++dt) { const int d = 16 * dt + fr; \
                const bf16x8 Av = *(const LAS bf16x8*)((Vc) + sub * 4096 + d * 64 + ((kq ^ ((d >> 2) & 3)) * 16)); \
                O[dt] = mfma16(Av, Pf, O[dt]); } \
        } } while (0)
#define A2_STEP2(ja, jb, s2_) do { \
        LAS unsigned char* Kc2 = Kb + ((s2_) & 1) * 16384; LAS unsigned char* Vc2 = Vb + ((s2_) & 1) * 16384; \
        *(LAS u32x4*)(Kc2 + klds) = kr##ja; *(LAS u32x4*)(Vc2 + vlds) = vr##ja; *(LAS u32x4*)(Kc2 + 8192 + klds) = kr##jb; *(LAS u32x4*)(Vc2 + 8192 + vlds) = vr##jb; \
        const u32x2 mcA = mw##ja, mcB = mw##jb; \
        __syncthreads(); \
        if (2 * (s2_) + 4 < nsteps) A2_LOAD(ja, 2 * (s2_) + 4); \
        if (2 * (s2_) + 5 < nsteps) A2_LOAD(jb, 2 * (s2_) + 5); \
        A2_HALF(Kc2, Vc2, mcA); A2_HALF(Kc2 + 8192, Vc2 + 8192, mcB); \
    } while (0)
    for (int s2 = 0; 2 * s2 < nsteps; s2 += 2) {
        A2_STEP2(0, 1, s2);
        if (2 * (s2 + 1) < nsteps) A2_STEP2(2, 3, s2 + 1);
    }
#undef A2_STEP2
#undef A2_HALF
#undef A2_LOAD
    lsum += __shfl_xor(lsum, 16); lsum += __shfl_xor(lsum, 32);
    const float inv = 1.0f / lsum;
#pragma unroll
    for (int dt = 0; dt < 4; ++dt)
#pragma unroll
        for (int r = 0; r < 4; ++r) Ob[fr * 68 + 16 * dt + 4 * kq + r] = O[dt][r] * inv;
    __syncthreads();
    {
        const int qq = lane >> 2, dp = (lane & 3) * 16;
        const LAS float* src = Ob + qq * 68 + dp;
        float f[16]; float sq = 0.f;
#pragma unroll
        for (int i = 0; i < 4; ++i) { const f32x4 t = *(const LAS f32x4*)(src + 4 * i); f[4 * i] = t[0]; f[4 * i + 1] = t[1]; f[4 * i + 2] = t[2]; f[4 * i + 3] = t[3]; sq += (t[0] * t[0] + t[1] * t[1]) + (t[2] * t[2] + t[3] * t[3]); }
        u32x4 w0, w1; w0.x = cvt_pk_bf16(f[0], f[1]); w0.y = cvt_pk_bf16(f[2], f[3]); w0.z = cvt_pk_bf16(f[4], f[5]); w0.w = cvt_pk_bf16(f[6], f[7]);
        w1.x = cvt_pk_bf16(f[8], f[9]); w1.y = cvt_pk_bf16(f[10], f[11]); w1.z = cvt_pk_bf16(f[12], f[13]); w1.w = cvt_pk_bf16(f[14], f[15]);
        const int tok = b * S + blk * 128 + wid * 16 + qq;
        bf16_t* op = (bf16_t*)(ws + WS_MIXB) + (size_t)tok * D + h * 64 + dp;
        *(u32x4*)op = w0; *(u32x4*)(op + 8) = w1;
        sq += dpp_f<0xB1>(sq); sq += dpp_f<0x4E>(sq);
        if ((lane & 3) == 0) ((float*)(ws + WS_SSQ))[((size_t)l * NTOK + tok) * 4 + h] = sq;
    }
    __syncthreads();
}
__device__ __forceinline__ void phase_a2(const Args& a, int l, LAS unsigned char* lds, int vcu, int G) {
    KArgs* ka = kargs();
    for (int it = vcu; it < 256; it += G) { const int b = it >> 6, h = (it >> 4) & 3, jj = it & 15; a2_unit(a, l, b, h, 31 - jj, lds); a2_unit(a, l, b, h, jj, lds); }
}
__global__ void __launch_bounds__(NTHR, 2) mk_fwd(Args a) {
    extern __shared__ __attribute__((aligned(16))) unsigned char lds_raw[];
    LAS unsigned char* lds = (LAS unsigned char*)lds_raw;
    const int tid = threadIdx.x, G = gridDim.x, bx = blockIdx.x;
    const int vcu = (G % 8 == 0) ? (bx % 8) * (G / 8) + bx / 8 : bx;
    if (tid < 64) ((LAS unsigned*)(lds + LDS_MISC))[tid] = 0u;
    __syncthreads();
    XcdBarrier bar; bar.bar = (unsigned*)(a.ws + WS_BAR); bar.x = 0; bar.st = nullptr;
    if (a.fused) bar = xcd_barrier_post((unsigned*)(a.ws + WS_BAR), (volatile LAS unsigned*)(lds + LDS_MISC + MISC_BAR));
#define GRID_BAR() do { if (a.fused) xcd_barrier(bar); } while (0)
#ifdef ONLY_PH
#define IN(k) ((k) == ONLY_PH && a.ph_lo <= (k) && (k) < a.ph_hi)
#else
#define IN(k) (a.ph_lo <= (k) && (k) < a.ph_hi)
#endif
    if (IN(PH_PRO)) { phase_prologue(a, lds, vcu, G); GRID_BAR(); }
    if (IN(PH_NORM0)) { KArgs* ka = kargs(); unsigned char* ws = ka->ws; float* modp = (float*)(ws + WS_MOD); phase_norm(IN_F(I_X), IN_F(I_NORM1), modp, modp + 1024, (bf16_t*)(ws + WS_HA), vcu, G); phase_rbias(a, lds, vcu, G); GRID_BAR(); }
    for (int l = a.l_lo; l < a.l_hi; ++l) {
        if (IN(PH_G1)) {
            KArgs* ka = kargs(); unsigned char* ws = ka->ws;
            pg8::DenseOrder S; S.init((const bf16_t*)(ws + WS_HA), (const bf16_t*)(ws + WS_WINT) + (size_t)l * NP * D, NTOK, (G == 256) ? NP - 256 : NP, D, G, bx);
            pg8::EpiBf16 E{(bf16_t*)(ws + WS_PROJ), NP};
            pg8::gemm_phase(lds, S, E);
            GRID_BAR();
        }
        if (IN(PH_MIX)) {
            if (G == 256 && bx < 64) {
                KArgs* ka = kargs(); unsigned char* ws = ka->ws;
                pg8::DenseOrder S; S.init((const bf16_t*)(ws + WS_HA), (const bf16_t*)(ws + WS_WINT) + (size_t)l * NP * D + (size_t)(NP - 256) * D, NTOK, 256, D, 64, bx);
                pg8::EpiBf16 E{(bf16_t*)(ws + WS_PROJ) + (NP - 256), NP};
                pg8::gemm_phase(lds, S, E);
            }
            phase_mix1(a, l, lds, vcu, G, bx); GRID_BAR();
        }
        if (IN(PH_A1)) { phase_a1(a, l, lds, vcu, G); GRID_BAR(); }
        if (IN(PH_A2)) { phase_a2(a, l, lds, vcu, G); GRID_BAR(); }
        if (IN(PH_G2)) {
            KArgs* ka = kargs(); unsigned char* ws = ka->ws; const float* xin = IN_F(I_X); const bf16_t* xinb = (l == 0) ? (const bf16_t*)nullptr : (const bf16_t*)(ws + WS_X1) + (size_t)NTOK * D; const float* mod = (const float*)(ws + WS_MOD) + (size_t)l * 4 * 6144;
            pg8::DenseOrder S; S.init((const bf16_t*)(ws + WS_MIXB), (const bf16_t*)(ws + WS_WOUTT) + (size_t)l * D * D, NTOK, D, D, G, bx);
            pg8::EpiResid E{xin, xinb, (bf16_t*)(ws + WS_X1), mod + 2048, (const float*)(ws + WS_SSQ) + (size_t)l * NTOK * 4};
            pg8::gemm_phase<pg8::EpiResid, pg8::DenseOrder, true>(lds, S, E);
            GRID_BAR();
        }
        if (IN(PH_ROUTE)) { phase_route(a, l, lds, vcu, G); GRID_BAR(); }
        if (IN(PH_UP)) {
            KArgs* ka = kargs(); unsigned char* ws = ka->ws;
            moe_cum(a, l, lds);
            pg8::MoeOrder<true> S; S.A = (const bf16_t*)(ws + WS_HA); S.Bt = (const bf16_t*)(ws + WS_WGUT) + (size_t)l * NE * 1024 * 1024; S.K = D; S.bstride = (size_t)1024 * 1024;
            S.list = (const int*)(ws + WS_LIST); S.cum = (const LAS int*)(lds + LDS_MISC + MISC_CUM); S.cnts = (const LAS int*)(lds + LDS_MISC + MISC_CNT); S.G = G; S.c = vcu; S.nun = S.cum[32] * 4;
            pg8::EpiHid E{(bf16_t*)(ws + WS_HID)};
            pg8::gemm_phase(lds, S, E);
            GRID_BAR();
        }
        if (IN(PH_DOWN)) {
            KArgs* ka = kargs(); unsigned char* ws = ka->ws;
            moe_cum(a, l, lds);
            pg8::MoeOrder<false> S; S.A = (const bf16_t*)(ws + WS_HID); S.Bt = (const bf16_t*)(ws + WS_WDT) + (size_t)l * NE * 1024 * 512; S.K = F; S.bstride = (size_t)1024 * 512;
            S.list = nullptr; S.cum = (const LAS int*)(lds + LDS_MISC + MISC_CUM); S.cnts = (const LAS int*)(lds + LDS_MISC + MISC_CNT); S.G = G; S.c = vcu; S.nun = S.cum[32] * 4;
            pg8::EpiDown E{(bf16_t*)(ws + WS_Y), (const float*)(ws + WS_LGATE)};
            pg8::gemm_phase(lds, S, E);
            GRID_BAR();
        }
        if (IN(PH_COMB)) { phase_combine(a, l, lds, vcu, G); GRID_BAR(); }
    }
#undef IN
#undef GRID_BAR
}


static void launch_ph(const Args& base, int grid, int l_lo, int l_hi, int ph_lo, int ph_hi, int fused, hipStream_t stream) {
    Args a = base; a.l_lo = l_lo; a.l_hi = l_hi; a.ph_lo = ph_lo; a.ph_hi = ph_hi; a.fused = fused; a.pad = 0;
    hipLaunchKernelGGL(mk_fwd, dim3(grid), dim3(NTHR), LDS_BYTES, stream, a);
}

extern "C" void kernel_launch(void* const* d_in, const int* in_sizes, int n_in, void* d_out, int out_size, void* d_ws, size_t ws_size, hipStream_t stream) {
    static int grid = 0;
    if (grid == 0) {
        int dev = 0, cus = 0;
        if (hipGetDevice(&dev) != hipSuccess || hipDeviceGetAttribute(&cus, hipDeviceAttributeMultiprocessorCount, dev) != hipSuccess) { grid = -1; return; }
        if (hipFuncSetAttribute((const void*)mk_fwd, hipFuncAttributeMaxDynamicSharedMemorySize, LDS_BYTES) != hipSuccess) { fprintf(stderr, "hipFuncSetAttribute failed\n"); grid = -1; return; }
        (void)hipGetLastError();
        grid = cus;
    }
    if (grid < 0) return;
    unsigned char* ws = (unsigned char*)d_ws;
    (void)hipMemsetAsync(ws, 0, WS_ZERO_BYTES, stream);
    Args a{};
    for (int i = 0; i < 32; ++i) a.in[i] = d_in[i];
    a.out = (float*)d_out; a.ws = ws;
#ifdef MK_MULTI
    launch_ph(a, grid, 0, 0, PH_PRO, PH_PRO + 1, 0, stream);
#ifdef MK_REP
    if (MK_REP == PH_PRO) launch_ph(a, grid, 0, 0, PH_PRO, PH_PRO + 1, 0, stream);
#endif
    launch_ph(a, grid, 0, 0, PH_NORM0, PH_NORM0 + 1, 0, stream);
#ifdef MK_REP
    if (MK_REP == PH_NORM0) launch_ph(a, grid, 0, 0, PH_NORM0, PH_NORM0 + 1, 0, stream);
#endif
    for (int l = 0; l < L; ++l)
        for (int ph = PH_G1; ph < PH_END; ++ph) {
            launch_ph(a, grid, l, l + 1, ph, ph + 1, 0, stream);
#ifdef MK_REP
            if (ph == MK_REP) launch_ph(a, grid, l, l + 1, ph, ph + 1, 0, stream);
#endif
        }
#else
    launch_ph(a, grid, 0, L, PH_PRO, PH_END, 1, stream);
#endif
}
```

```cpp
#include <hip/hip_runtime.h>
#include <stdint.h>
#include <stdio.h>

#define LAS __attribute__((address_space(3)))
typedef unsigned short bf16_t;
typedef short bf16x8 __attribute__((ext_vector_type(8)));
typedef float f32x4 __attribute__((ext_vector_type(4)));
typedef float f32x16 __attribute__((ext_vector_type(16)));
typedef unsigned u32x4 __attribute__((ext_vector_type(4)));
typedef unsigned u32x2 __attribute__((ext_vector_type(2)));

constexpr int Bn = 4, S = 4096, D = 1024, L = 2, NTOK = Bn * S, DIN = 2212, F = 512, NE = 32;
constexpr int NP = 2304;
constexpr int NK = 0, NV = 256, NIQ = 512, NIK = 640, NIW = 672, NBA = 768, NBG = 1024, NC = 1280, NDU = 1536, NDV = 1792, NQ = 2048;
constexpr float EPS = 1e-6f;
constexpr int NTHR = 512;
constexpr int SLOTS = 40960;

constexpr int LDS_BYTES = 163840, LDS_MISC = 147456;
constexpr int MISC_BAR = 0;
constexpr int MISC_CUM = 64;
constexpr int MISC_CNT = 64 + 160;

constexpr size_t al256c(size_t v) { return (v + 255) & ~(size_t)255; }
constexpr size_t WS_BAR = 0;
constexpr size_t WS_CNT = 16384;
constexpr size_t WS_FLAG = 16384 + 16384;
constexpr size_t WS_ZERO_BYTES = 16384 + 32768;
constexpr size_t WS_MOD = WS_ZERO_BYTES;
constexpr size_t WS_ROPEA = WS_MOD + al256c((size_t)L * 4 * 6144 * 4);
constexpr size_t WS_ROPEI = WS_ROPEA + al256c((size_t)NTOK * 16 * 4);
constexpr size_t WS_LIST = WS_ROPEI + al256c((size_t)NTOK * 8 * 4);
constexpr size_t WS_LGATE = WS_LIST + al256c((size_t)NE * NTOK * 4);
constexpr size_t WS_TOKINFO = WS_LGATE + al256c((size_t)NE * NTOK * 4);
constexpr size_t WS_SGUW = WS_TOKINFO + al256c((size_t)NTOK * 16);
constexpr size_t WS_POOLT = WS_SGUW + al256c((size_t)L * 4 * 128 * 128 * 2);
constexpr size_t WS_WHL = WS_POOLT + al256c((size_t)L * 4 * 64 * 64 * 2);
constexpr size_t WS_RBIAS = WS_WHL + al256c((size_t)L * 2 * 48 * 1024 * 2);
constexpr size_t WS_SSQ = WS_RBIAS + al256c((size_t)L * 4 * 32 * 48 * 4);
constexpr size_t WS_WINT = WS_SSQ + al256c((size_t)L * NTOK * 4 * 4);
constexpr size_t WS_WOUTT = WS_WINT + al256c((size_t)L * NP * D * 2);
constexpr size_t WS_PWT = WS_WOUTT + al256c((size_t)L * D * D * 2);
constexpr size_t WS_WGUT = WS_PWT + al256c((size_t)L * 256 * 256 * 2);
constexpr size_t WS_WDT = WS_WGUT + al256c((size_t)L * NE * 1024 * 1024 * 2);
constexpr size_t WS_HA = WS_WDT + al256c((size_t)L * NE * 1024 * 512 * 2);
constexpr size_t WS_X1 = WS_HA + al256c((size_t)NTOK * D * 2);
constexpr size_t WS_R = WS_X1 + al256c((size_t)NTOK * D * 4);
constexpr size_t WS_PROJ = WS_R;
constexpr size_t WS_R2 = WS_PROJ + al256c((size_t)NTOK * NP * 2);
constexpr size_t WS_HID = WS_R;
constexpr size_t WS_Y = WS_HID + al256c((size_t)SLOTS * F * 2);

__device__ __forceinline__ unsigned cvt_pk_bf16(float lo, float hi) { unsigned r; asm volatile("v_cvt_pk_bf16_f32 %0, %1, %2" : "=v"(r) : "v"(lo), "v"(hi)); return r; }
__device__ __forceinline__ float bf2f(bf16_t v) { return __uint_as_float(((unsigned)v) << 16); }
__device__ __forceinline__ float bflo(unsigned w) { return __uint_as_float(w << 16); }
__device__ __forceinline__ float bfhi(unsigned w) { return __uint_as_float(w & 0xffff0000u); }
template <int CTRL> __device__ __forceinline__ float dpp_f(float v) { return __builtin_bit_cast(float, __builtin_amdgcn_update_dpp(0, __builtin_bit_cast(int, v), CTRL, 0xF, 0xF, true)); }
__device__ __forceinline__ float row_sum16(float v) {
    v += dpp_f<0xB1>(v);
    v += dpp_f<0x4E>(v);
    v += dpp_f<0x141>(v);
    v += dpp_f<0x140>(v);
    return v;
}
__device__ __forceinline__ float wave_sum(float v) {
    v = row_sum16(v);
    const float r0 = __builtin_bit_cast(float, __builtin_amdgcn_readlane(__builtin_bit_cast(int, v), 0)), r1 = __builtin_bit_cast(float, __builtin_amdgcn_readlane(__builtin_bit_cast(int, v), 16));
    const float r2 = __builtin_bit_cast(float, __builtin_amdgcn_readlane(__builtin_bit_cast(int, v), 32)), r3 = __builtin_bit_cast(float, __builtin_amdgcn_readlane(__builtin_bit_cast(int, v), 48));
    return (r0 + r1) + (r2 + r3);
}
__device__ __forceinline__ float wave_max(float v) {
#pragma unroll
    for (int o = 32; o >= 1; o >>= 1) v = fmaxf(v, __shfl_xor(v, o));
    return v;
}
__device__ __forceinline__ float silu_f(float v) { return v / (1.0f + expf(-v)); }
__device__ __forceinline__ float silu_fast(float v) { return v * __builtin_amdgcn_rcpf(1.0f + __expf(-v)); }
__device__ __forceinline__ float sigmoid_f(float v) { return 1.0f / (1.0f + expf(-v)); }
__device__ __forceinline__ float sigmoid_fast(float v) { return __builtin_amdgcn_rcpf(1.0f + __expf(-v)); }
__device__ __forceinline__ int opaque_tid() { int t = threadIdx.x; asm volatile("" : "+v"(t)); return t; }
__device__ __forceinline__ int ld_agent(const int* p) { return __hip_atomic_load(p, __ATOMIC_RELAXED, __HIP_MEMORY_SCOPE_AGENT); }

#define XB_TMO      128
#define XB_XCNT(j)  (256  + 64 * (j))
#define XB_XSUB(j)  (1280 + 64 * (j))
#define XB_XGEN(j)  (2304 + 64 * (j))
#define XB_TOP      3328
#define XB_TOPGEN   3392
#define XCD_BAR_WORDS 3456
#define XB_SPIN_CAP (1u << 18)
__device__ __forceinline__ unsigned xb_ld(unsigned* p)              { return __hip_atomic_load(p, __ATOMIC_RELAXED, __HIP_MEMORY_SCOPE_AGENT); }
__device__ __forceinline__ unsigned xb_add(unsigned* p, unsigned v) { return __hip_atomic_fetch_add(p, v, __ATOMIC_RELAXED, __HIP_MEMORY_SCOPE_AGENT); }
__device__ __forceinline__ unsigned xb_xcc_id() { return (unsigned)__builtin_amdgcn_s_getreg((3 << 11) | 20) & 0xFu; }
#define XB_SPIN(cond, bar) do { unsigned _sp = 0; while (cond) { __builtin_amdgcn_s_sleep(1); \
    if ((++_sp & 255u) == 0u) { if (xb_ld(&(bar)[XB_TMO])) break; if (_sp > XB_SPIN_CAP) { atomicAdd(&(bar)[XB_TMO], 1u); break; } } } } while (0)
struct XcdBarrier { unsigned* bar; unsigned x; volatile LAS unsigned* st; };
__device__ __forceinline__ XcdBarrier xcd_barrier_post(unsigned* bar, volatile LAS unsigned* st) {
    XcdBarrier b; b.bar = bar; b.x = xb_xcc_id(); b.st = st;
    if (threadIdx.x == 0) (void)xb_add(&bar[XB_XCNT(b.x)], 1u);
    return b;
}
__device__ __forceinline__ void xcd_barrier_complete(unsigned* bar, unsigned x, unsigned& nloc, unsigned& nx) {
    const unsigned G = gridDim.x * gridDim.y * gridDim.z;
    unsigned sum, cnt, mine, sp = 0u;
    for (;;) {
        sum = 0u; cnt = 0u; mine = 0u;
#pragma unroll
        for (unsigned j = 0; j < 16; ++j) { const unsigned c = xb_ld(&bar[XB_XCNT(j)]); sum += c; cnt += (c > 0u) ? 1u : 0u; mine = (j == x) ? c : mine; }
        if (sum == G) break;
        __builtin_amdgcn_s_sleep(1);
        if ((++sp & 255u) == 0u) { if (xb_ld(&bar[XB_TMO])) break; if (sp > XB_SPIN_CAP) { atomicAdd(&bar[XB_TMO], 1u); break; } }
    }
    nloc = mine > 0u ? mine : 1u; nx = cnt > 0u ? cnt : 1u;
}
__device__ __forceinline__ void xcd_barrier(const XcdBarrier& b) {
    asm volatile("s_waitcnt vmcnt(0)" ::: "memory");
    __syncthreads();
    if (threadIdx.x == 0) {
        unsigned* bar = b.bar;
        __builtin_amdgcn_s_waitcnt(0);
        unsigned nloc = b.st[0], nx = b.st[1];
        if (nloc == 0u) { xcd_barrier_complete(bar, b.x, nloc, nx); b.st[0] = nloc; b.st[1] = nx; }
        const unsigned old = xb_add(&bar[XB_XSUB(b.x)], 1u);
        const unsigned gen = old / nloc;
        if (old + 1u == (gen + 1u) * nloc) {
            __builtin_amdgcn_fence(__ATOMIC_RELEASE, "agent");
            asm volatile("s_waitcnt vmcnt(0)" ::: "memory");
            const unsigned og = xb_add(&bar[XB_TOP], 1u);
            const unsigned tg = og / nx;
            if (og + 1u == (tg + 1u) * nx) xb_add(&bar[XB_TOPGEN], 1u);
            else XB_SPIN(xb_ld(&bar[XB_TOPGEN]) == tg, bar);
            __builtin_amdgcn_fence(__ATOMIC_ACQUIRE, "agent");
            xb_add(&bar[XB_XGEN(b.x)], 1u);
            asm volatile("s_waitcnt vmcnt(0)" ::: "memory");
        } else {
            XB_SPIN(xb_ld(&bar[XB_XGEN(b.x)]) == gen, bar);
            __builtin_amdgcn_fence(__ATOMIC_ACQUIRE, "agent");
            asm volatile("s_waitcnt vmcnt(0)" ::: "memory");
        }
    }
    __syncthreads();
}

namespace pg8 {
constexpr int BM = 256, BK = 64, HALF = 128, HTB = HALF * BK * 2, STAGE_BYTES = 8 * HTB, NXCD = 8, WGM = 8;
__host__ __device__ __forceinline__ int lds_byte(int r, int c) { const int st = (r >> 4) * 2 + (c >> 5), rr = r & 15, cc = c & 31, ob = rr * 64 + cc * 2; return st * 1024 + (ob ^ (((ob >> 9) & 1) << 5)); }
__host__ __device__ __forceinline__ void stage_rc(int b, int& R, int& C) { const int st = b / 1024, sb = b % 1024, swz = sb ^ (((sb >> 9) & 1) << 5); R = (st >> 1) * 16 + swz / 64; C = (st & 1) * 32 + (swz % 64) / 2; }
__host__ __device__ __forceinline__ int perm32(int rho) { const int n = rho >> 4, i = rho & 15; return 8 * (i >> 2) + 4 * n + (i & 3); }

struct Unit { int pm, pn, e, mt, cnt; };

struct DenseOrder {
    static constexpr int SYNC = 0;
    const bf16_t* A; const bf16_t* Bt; int K;
    int nM, nN, nwg, G, c;
    __device__ void init(const bf16_t* A_, const bf16_t* Bt_, int M, int N, int K_, int G_, int c_) { A = A_; Bt = Bt_; K = K_; nM = M / BM; nN = N / BM; nwg = nM * nN; G = G_; c = c_; }
    __device__ bool next(int i, Unit& u) const {
        const long Lx = (long)i * G + c; if (Lx >= nwg) return false;
        int wgid = (int)Lx; { const int q = nwg / NXCD, r = nwg % NXCD, xcd = wgid % NXCD, off = wgid / NXCD; wgid = (xcd < r ? xcd * (q + 1) : r * (q + 1) + (xcd - r) * q) + off; }
        const int nig = WGM * nN, gid = wgid / nig, fm = gid * WGM, gsz = (nM - fm) < WGM ? (nM - fm) : WGM;
        u.pm = fm + ((wgid % nig) % gsz); u.pn = (wgid % nig) / gsz; u.e = 0; u.mt = 0; u.cnt = 0; return true;
    }
    __device__ __forceinline__ const char* a_base(const Unit& u) const { return (const char*)A + (size_t)u.pm * BM * K * 2; }
    __device__ __forceinline__ unsigned a_voff(const Unit&, int row, int C) const { return (unsigned)(row * K + C) * 2u; }
    __device__ __forceinline__ const char* b_base(const Unit& u) const { return (const char*)Bt + (size_t)u.pn * BM * K * 2; }
};
template <bool gather> struct MoeOrder {
    static constexpr int SYNC = gather ? 1 : 2;
    int* flag;
    const bf16_t* A; const bf16_t* Bt; int K; size_t bstride;
    const int* list;
    const LAS int* cum; const LAS int* cnts;
    int G, c, nun;
    __device__ bool next(int i, Unit& u) const {
        const int Lx = i * G + c; if (Lx >= nun) return false;
        const int t = Lx >> 2; u.pn = Lx & 3; u.pm = t;
        int e = 0;
#pragma unroll 1
        for (int j = 1; j < NE; ++j) e += (cum[j] <= t) ? 1 : 0;
        u.e = e; u.mt = t - cum[e]; u.cnt = cnts[e]; return true;
    }
    __device__ __forceinline__ const char* a_base(const Unit& u) const { return gather ? (const char*)A : (const char*)A + (size_t)u.pm * BM * K * 2; }
    __device__ __forceinline__ unsigned a_voff(const Unit& u, int row, int C) const {
        if (gather) { const int pos = u.mt * BM + row; const int tok = (pos < u.cnt) ? list[(size_t)u.e * NTOK + pos] : 0; return (unsigned)(tok * K + C) * 2u; }
        return (unsigned)(row * K + C) * 2u;
    }
    __device__ __forceinline__ const char* b_base(const Unit& u) const { return (const char*)(Bt + (size_t)u.e * bstride) + (size_t)u.pn * BM * K * 2; }
};

struct EpiBf16 {
    static constexpr bool PERM = true;
    bf16_t* O; int ldc;
    __device__ __forceinline__ void operator()(const f32x4 (&acc)[2][2][4][2], const Unit& u, int wr, int wc, int fr, int fq) const {
        const int row0 = u.pm * BM + wr * 64 + fr, col0 = u.pn * BM + wc * 32 + 8 * fq;
#pragma unroll
        for (int ai = 0; ai < 2; ++ai)
#pragma unroll
            for (int m = 0; m < 4; ++m) { bf16_t* rowp = O + (size_t)(row0 + ai * HALF + m * 16) * ldc + col0;
#pragma unroll
                for (int bj = 0; bj < 2; ++bj) { const f32x4 v0 = acc[ai][bj][m][0], v1 = acc[ai][bj][m][1];
                    u32x4 w; w.x = cvt_pk_bf16(v0[0], v0[1]); w.y = cvt_pk_bf16(v0[2], v0[3]); w.z = cvt_pk_bf16(v1[0], v1[1]); w.w = cvt_pk_bf16(v1[2], v1[3]);
                    *(u32x4*)(rowp + bj * HALF) = w; } }
    }
};
struct EpiResid {
    static constexpr bool PERM = true;
    const float* X; const bf16_t* Xb; bf16_t* C; const float* gate;
    const float* ssq;
    __device__ __forceinline__ void rowscale(f32x4 (&acc)[2][2][4][2], const Unit& u, int wr, int fr) const {
        int rbase = u.pm * BM + wr * 64 + fr;
        asm volatile("" : "+v"(rbase));
#pragma unroll
        for (int ai = 0; ai < 2; ++ai)
#pragma unroll
            for (int m = 0; m < 4; ++m) { const f32x4 sv = *(const f32x4*)(ssq + (size_t)(rbase + ai * HALF + m * 16) * 4); const float r = rsqrtf(((sv[0] + sv[1]) + (sv[2] + sv[3])) * (1.0f / 256.0f) + EPS);
#pragma unroll
                for (int bj = 0; bj < 2; ++bj)
#pragma unroll
                    for (int n = 0; n < 2; ++n) acc[ai][bj][m][n] *= r; }
    }
    __device__ __forceinline__ void operator()(const f32x4 (&acc)[2][2][4][2], const Unit& u, int wr, int wc, int fr, int fq) const {
        const int row0 = u.pm * BM + wr * 64 + fr, col0 = u.pn * BM + wc * 32 + 8 * fq;
        const float* gp = gate + (size_t)((u.pm * BM) / S) * 6144 + col0;
        f32x4 gv[2][2];
#pragma unroll
        for (int bj = 0; bj < 2; ++bj)
#pragma unroll
            for (int n = 0; n < 2; ++n) gv[bj][n] = *(const f32x4*)(gp + bj * HALF + n * 4);
#pragma unroll
        for (int ai = 0; ai < 2; ++ai)
#pragma unroll
            for (int m = 0; m < 4; ++m) { const size_t off = (size_t)(row0 + ai * HALF + m * 16) * D + col0;
#pragma unroll
                for (int bj = 0; bj < 2; ++bj) {
                    f32x4 x0, x1v;
                    if (Xb) { const u32x4 xw = *(const u32x4*)(Xb + off + bj * HALF); x0 = (f32x4){bflo(xw.x), bfhi(xw.x), bflo(xw.y), bfhi(xw.y)}; x1v = (f32x4){bflo(xw.z), bfhi(xw.z), bflo(xw.w), bfhi(xw.w)}; }
                    else { x0 = *(const f32x4*)(X + off + bj * HALF); x1v = *(const f32x4*)(X + off + bj * HALF + 4); }
                    const f32x4 o0 = x0 + gv[bj][0] * acc[ai][bj][m][0], o1 = x1v + gv[bj][1] * acc[ai][bj][m][1];
                    u32x4 w; w.x = cvt_pk_bf16(o0[0], o0[1]); w.y = cvt_pk_bf16(o0[2], o0[3]); w.z = cvt_pk_bf16(o1[0], o1[1]); w.w = cvt_pk_bf16(o1[2], o1[3]);
                    *(u32x4*)(C + off + bj * HALF) = w; }
                asm volatile("" ::: "memory"); }
    }
};
__device__ __forceinline__ void store_wt16(void* ptr, u32x4 w) { asm volatile("global_store_dwordx4 %0, %1, off sc1\n\ts_nop 1" :: "v"(ptr), "v"(w) : "memory"); }
__device__ __forceinline__ void flag_wait(const int* flag, int want) {
    while (__hip_atomic_load(flag, __ATOMIC_RELAXED, __HIP_MEMORY_SCOPE_AGENT) < want) __builtin_amdgcn_s_sleep(1);
    __builtin_amdgcn_fence(__ATOMIC_ACQUIRE, "agent");
    asm volatile("s_waitcnt vmcnt(0)" ::: "memory");
}
struct EpiHid {
    static constexpr bool PERM = true;
    bf16_t* H;
    __device__ __forceinline__ void operator()(const f32x4 (&acc)[2][2][4][2], const Unit& u, int wr, int wc, int fr, int fq) const {
        const int row0 = u.pm * BM + wr * 64 + fr, col0 = u.pn * HALF + wc * 32 + 8 * fq;
#pragma unroll
        for (int ai = 0; ai < 2; ++ai)
#pragma unroll
            for (int m = 0; m < 4; ++m) { float h[8];
#pragma unroll
                for (int n = 0; n < 2; ++n)
#pragma unroll
                    for (int j = 0; j < 4; ++j) h[n * 4 + j] = silu_fast(acc[ai][0][m][n][j]) * acc[ai][1][m][n][j];
                u32x4 w; w.x = cvt_pk_bf16(h[0], h[1]); w.y = cvt_pk_bf16(h[2], h[3]); w.z = cvt_pk_bf16(h[4], h[5]); w.w = cvt_pk_bf16(h[6], h[7]);
                store_wt16(H + (size_t)(row0 + ai * HALF + m * 16) * F + col0, w); }
    }
};
struct EpiDown {
    static constexpr bool PERM = true;
    bf16_t* Y; const float* lgate;
    __device__ __forceinline__ void operator()(const f32x4 (&acc)[2][2][4][2], const Unit& u, int wr, int wc, int fr, int fq) const {
        const int rl0 = wr * 64 + fr, col0 = u.pn * BM + wc * 32 + 8 * fq;
        const float* gp = lgate + (size_t)u.e * NTOK + u.mt * BM;
#pragma unroll
        for (int ai = 0; ai < 2; ++ai)
#pragma unroll
            for (int m = 0; m < 4; ++m) { const int rl = rl0 + ai * HALF + m * 16; const float g = (u.mt * BM + rl < u.cnt) ? gp[rl] : 0.f;
                bf16_t* rowp = Y + (size_t)(u.pm * BM + rl) * D + col0;
#pragma unroll
                for (int bj = 0; bj < 2; ++bj) { const f32x4 v0 = acc[ai][bj][m][0] * g, v1 = acc[ai][bj][m][1] * g;
                    u32x4 w; w.x = cvt_pk_bf16(v0[0], v0[1]); w.y = cvt_pk_bf16(v0[2], v0[3]); w.z = cvt_pk_bf16(v1[0], v1[1]); w.w = cvt_pk_bf16(v1[2], v1[3]);
                    *(u32x4*)(rowp + bj * HALF) = w; } }
    }
};

template <class Epi, class Sched, bool RSC = false>
__device__ __forceinline__ void gemm_phase(LAS unsigned char* lds, const Sched& S, const Epi& E) {
    const int tid = opaque_tid(), wid = __builtin_amdgcn_readfirstlane(tid >> 6), lane = tid & 63, wr = wid >> 2, wc = wid & 3, fr = lane & 15, fq = lane >> 4;
    const int K = S.K, nt = K / BK;
    int Rr[2], Cc[2]; unsigned voffB[2];
#pragma unroll
    for (int i = 0; i < 2; ++i) { stage_rc(tid * 16 + i * 8192, Rr[i], Cc[i]); const int Rb = Epi::PERM ? ((Rr[i] & ~31) + perm32(Rr[i] & 31)) : Rr[i]; voffB[i] = (unsigned)(Rb * K + Cc[i]) * 2u; }
    const size_t kstep = (size_t)(BK * 2);
    const size_t hstep = (size_t)HALF * K * 2;
    const unsigned ldsw = (unsigned)wid * 1024u;
    const int aoff = lds_byte(wr * 64 + fr, fq * 8), boff = lds_byte(wc * 32 + fr, fq * 8);
#define PG8_SA(b, h) (((b) * 2 + (h)) * HTB)
#define PG8_SB(b, h) ((4 + (b) * 2 + (h)) * HTB)
#define PG8_STAGE(bufoff, gbase, voff) do { _Pragma("unroll") for (int _i = 0; _i < 2; ++_i) \
        __builtin_amdgcn_global_load_lds((const unsigned*)((const char*)(gbase) + (voff)[_i]), (LAS unsigned*)(lds + (bufoff) + ldsw + _i * 8192), 16, 0, 0); } while (0)
#define PG8_LDA(dst, b, h) do { _Pragma("unroll") for (int m = 0; m < 4; ++m) _Pragma("unroll") for (int k = 0; k < 2; ++k) dst[m][k] = *(const LAS bf16x8*)(lds + PG8_SA(b, h) + aoff + m * 2048 + k * 1024); } while (0)
#define PG8_LDB(dst, b, h) do { _Pragma("unroll") for (int n = 0; n < 2; ++n) _Pragma("unroll") for (int k = 0; k < 2; ++k) dst[n][k] = *(const LAS bf16x8*)(lds + PG8_SB(b, h) + boff + n * 2048 + k * 1024); } while (0)
#define PG8_MMA(ai, bj, At, Bt) do { __builtin_amdgcn_s_setprio(1); _Pragma("unroll") for (int m = 0; m < 4; ++m) _Pragma("unroll") for (int n = 0; n < 2; ++n) _Pragma("unroll") for (int k = 0; k < 2; ++k) \
        acc[ai][bj][m][n] = __builtin_amdgcn_mfma_f32_16x16x32_bf16(Bt[n][k], At[m][k], acc[ai][bj][m][n], 0, 0, 0); __builtin_amdgcn_s_setprio(0); } while (0)
#define PG8_WAIT_V(n) asm volatile("s_waitcnt vmcnt(" #n ")" ::: "memory")
#define PG8_WAIT_L(n) asm volatile("s_waitcnt lgkmcnt(" #n ")" ::: "memory")
#define PG8_BAR __builtin_amdgcn_s_barrier()
#define PG8_SCHED __builtin_amdgcn_sched_barrier(0)
    Unit cur, nxt; int ui = 0;
    if (!S.next(0, cur)) return;
    if constexpr (Sched::SYNC == 2) { if (wid == 0) flag_wait(S.flag + cur.pm * 8, 4); __builtin_amdgcn_s_barrier(); }
    f32x4 acc[2][2][4][2];
#pragma unroll
    for (int a = 0; a < 2; ++a)
#pragma unroll
        for (int b = 0; b < 2; ++b)
#pragma unroll
            for (int m = 0; m < 4; ++m)
#pragma unroll
                for (int n = 0; n < 2; ++n) acc[a][b][m][n] = (f32x4){0.f, 0.f, 0.f, 0.f};
    bf16x8 At[4][2], B0[2][2], B1[2][2];
    unsigned vA0[2], vA1[2], vN0[2], vN1[2];
#pragma unroll
    for (int i = 0; i < 2; ++i) { vA0[i] = S.a_voff(cur, Rr[i], Cc[i]); vA1[i] = S.a_voff(cur, HALF + Rr[i], Cc[i]); }
    const char* cA = S.a_base(cur); const char* cB = S.b_base(cur);
    PG8_STAGE(PG8_SB(0, 0), cB, voffB); PG8_STAGE(PG8_SB(0, 1), cB + hstep, voffB); PG8_STAGE(PG8_SA(0, 0), cA, vA0); PG8_STAGE(PG8_SA(0, 1), cA, vA1);
    if (wr == 1) PG8_BAR;
    PG8_WAIT_V(2); PG8_BAR;
    PG8_STAGE(PG8_SB(1, 0), cB + kstep, voffB); PG8_STAGE(PG8_SA(1, 0), cA + kstep, vA0); PG8_STAGE(PG8_SB(1, 1), cB + hstep + kstep, voffB);
    PG8_WAIT_V(6); PG8_BAR;
    for (;;) {
        const bool has_next = S.next(ui + 1, nxt);
        const char* nA = has_next ? S.a_base(nxt) : cA; const char* nB = has_next ? S.b_base(nxt) : cB;
#pragma unroll
        for (int i = 0; i < 2; ++i) { vN0[i] = has_next ? S.a_voff(nxt, Rr[i], Cc[i]) : vA0[i]; vN1[i] = has_next ? S.a_voff(nxt, HALF + Rr[i], Cc[i]) : vA1[i]; }
        for (int t = 0; t < nt; t += 2) {
            const bool last = (t == nt - 2);
            if constexpr (Sched::SYNC == 2) { if (last && has_next && wid == 0) flag_wait(S.flag + nxt.pm * 8, 4); }
            if constexpr (RSC) { if (t == 4) E.rowscale(acc, cur, wr, fr); }
            const char* a1 = cA + (size_t)(t + 1) * kstep;
            const char* a2 = last ? nA : cA + (size_t)(t + 2) * kstep; const char* b2 = last ? nB : cB + (size_t)(t + 2) * kstep;
            const char* a3 = a2 + kstep; const char* b3 = b2 + kstep;
            unsigned w0[2], w1[2];
#pragma unroll
            for (int i = 0; i < 2; ++i) { w0[i] = last ? vN0[i] : vA0[i]; w1[i] = last ? vN1[i] : vA1[i]; }
            PG8_LDB(B0, 0, 0); PG8_LDB(B1, 0, 1); PG8_SCHED; PG8_LDA(At, 0, 0); PG8_STAGE(PG8_SA(1, 1), a1, vA1);
            PG8_WAIT_V(8); PG8_WAIT_L(0); PG8_BAR; PG8_MMA(0, 0, At, B0); PG8_MMA(0, 1, At, B1); PG8_BAR; PG8_SCHED;
            PG8_LDA(At, 0, 1); PG8_STAGE(PG8_SB(0, 0), b2, voffB); PG8_STAGE(PG8_SB(0, 1), b2 + hstep, voffB); PG8_STAGE(PG8_SA(0, 0), a2, w0);
            PG8_WAIT_V(8); PG8_WAIT_L(0); PG8_BAR; PG8_MMA(1, 0, At, B0); PG8_MMA(1, 1, At, B1); PG8_BAR; PG8_SCHED;
            PG8_LDB(B0, 1, 0); PG8_LDB(B1, 1, 1); PG8_SCHED; PG8_LDA(At, 1, 0); PG8_STAGE(PG8_SA(0, 1), a2, w1);
            PG8_WAIT_V(8); PG8_WAIT_L(0); PG8_BAR; PG8_MMA(0, 0, At, B0); PG8_MMA(0, 1, At, B1); PG8_BAR; PG8_SCHED;
            PG8_LDA(At, 1, 1); PG8_STAGE(PG8_SB(1, 0), b3, voffB); PG8_STAGE(PG8_SB(1, 1), b3 + hstep, voffB); PG8_STAGE(PG8_SA(1, 0), a3, w0);
            PG8_WAIT_V(8); PG8_WAIT_L(0); PG8_BAR; PG8_MMA(1, 0, At, B0); PG8_MMA(1, 1, At, B1); PG8_BAR; PG8_SCHED;
        }
        if (wr == 0) PG8_BAR;
        E(acc, cur, wr, wc, fr, fq);
        if constexpr (Sched::SYNC == 1) { PG8_WAIT_V(0); PG8_BAR; if (tid == 0) __hip_atomic_fetch_add(S.flag + cur.pm * 8, 1, __ATOMIC_RELAXED, __HIP_MEMORY_SCOPE_AGENT); }
        if (!has_next) break;
#pragma unroll
        for (int a = 0; a < 2; ++a)
#pragma unroll
            for (int b = 0; b < 2; ++b)
#pragma unroll
                for (int m = 0; m < 4; ++m)
#pragma unroll
                    for (int n = 0; n < 2; ++n) acc[a][b][m][n] = (f32x4){0.f, 0.f, 0.f, 0.f};
        cur = nxt; cA = nA; cB = nB; ++ui;
#pragma unroll
        for (int i = 0; i < 2; ++i) { vA0[i] = vN0[i]; vA1[i] = vN1[i]; }
        if (wr == 1) PG8_BAR;
    }
    PG8_WAIT_V(0);
    PG8_BAR;
#undef PG8_SA
#undef PG8_SB
#undef PG8_STAGE
#undef PG8_LDA
#undef PG8_LDB
#undef PG8_MMA
#undef PG8_WAIT_V
#undef PG8_WAIT_L
#undef PG8_BAR
#undef PG8_SCHED
}
}
struct Args { const void* in[32]; float* out; unsigned char* ws; int l_lo, l_hi, ph_lo, ph_hi, fused, pad; };
enum { PH_PRO = 0, PH_NORM0 = 1, PH_G1 = 2, PH_MIX = 3, PH_A1 = 4, PH_A2 = 5, PH_AN = 6, PH_G2 = 7, PH_ROUTE = 8, PH_UP = 9, PH_DOWN = 10, PH_COMB = 11, PH_END = 12 };

typedef const Args __attribute__((address_space(4))) KArgs;
__device__ __forceinline__ KArgs* kargs() { KArgs* p = (KArgs*)__builtin_amdgcn_kernarg_segment_ptr(); asm volatile("" : "+s"(p)); return p; }
#define IN_F(i) ((const float*)ka->in[i])
enum { I_X = 0, I_C, I_POS, I_WADA, I_BADA, I_NORM1, I_WIN, I_QN, I_KN, I_CONVW, I_CONVB, I_CLNG, I_CLNB, I_PWW, I_PWB, I_POOLW, I_POOLB, I_POOLS, I_SLNG, I_SLNB, I_SGUW, I_SGUB,
       I_ONORM, I_WOUT, I_NORM2, I_WRG, I_BRG, I_WRE, I_BRE, I_WG, I_WU, I_WD };

__device__ __forceinline__ void sincos_d(double a, double& s, double& c) {
    const double k = rint(a * 0.63661977236758134308);
    const double r = (a - k * 1.57079632679489655800) - k * 6.123233995736766036e-17;
    const double r2 = r * r;
    const double sp = r * (1.0 + r2 * (-1.0 / 6 + r2 * (1.0 / 120 + r2 * (-1.0 / 5040 + r2 * (1.0 / 362880 + r2 * (-1.0 / 39916800 + r2 * (1.0 / 6227020800.0)))))));
    const double cp = 1.0 + r2 * (-0.5 + r2 * (1.0 / 24 + r2 * (-1.0 / 720 + r2 * (1.0 / 40320 + r2 * (-1.0 / 3628800 + r2 * (1.0 / 479001600.0 + r2 * (-1.0 / 87178291200.0)))))));
    const int q = ((int)k) & 3;
    if (q == 0) { s = sp; c = cp; } else if (q == 1) { s = cp; c = -sp; } else if (q == 2) { s = -sp; c = -cp; } else { s = -cp; c = sp; }
}

__device__ __forceinline__ bf16_t f2bf_(float f) { return (bf16_t)(cvt_pk_bf16(f, 0.f) & 0xffffu); }
struct TItem { const float* src; int ld; int ncol; bf16_t* dst; int ldd; const float* rsc; };
constexpr int NT_WIN = L * 36 * 4, NT_WOUT = L * 16 * 4, NT_PW = L * 4, NT_WGU = L * NE * 16 * 4, NT_WD = L * NE * 16 * 2;
constexpr int NT_ALL = NT_WIN + NT_WOUT + NT_PW + NT_WGU + NT_WD;
__device__ __forceinline__ void decode_titem(int it, const Args& a, TItem& t) {
    KArgs* ka = kargs();
    unsigned char* ws = ka->ws;
    t.rsc = nullptr;
    if (it < NT_WIN) {
        const int l = it / 144, r = it % 144, n0 = (r >> 2) * 64, k0 = (r & 3) * 256;
        const int c0 = n0 < 768 ? n0 + 256 : (n0 < 2048 ? n0 + 164 : n0 - 2048);
        t.ncol = (n0 < 768) ? ((n0 + 64 <= 676) ? 64 : (n0 < 676 ? 676 - n0 : 0)) : 64;
        t.src = IN_F(I_WIN) + ((size_t)l * D + k0) * DIN + c0; t.ld = DIN;
        t.dst = (bf16_t*)(ws + WS_WINT) + ((size_t)l * NP + n0) * D + k0; t.ldd = D; return;
    }
    it -= NT_WIN;
    if (it < NT_WOUT) {
        const int l = it / 64, r = it % 64, n0 = (r >> 2) * 64, k0 = (r & 3) * 256;
        t.ncol = 64; t.src = IN_F(I_WOUT) + ((size_t)l * D + k0) * D + n0; t.ld = D; t.rsc = (k0 == 0) ? IN_F(I_ONORM) + l * D : nullptr;
        t.dst = (bf16_t*)(ws + WS_WOUTT) + ((size_t)l * D + n0) * D + k0; t.ldd = D; return;
    }
    it -= NT_WOUT;
    if (it < NT_PW) {
        const int l = it / 4, n0 = (it & 3) * 64;
        t.ncol = 64; t.src = IN_F(I_PWW) + (size_t)l * 65536 + n0; t.ld = 256;
        t.dst = (bf16_t*)(ws + WS_PWT) + ((size_t)l * 256 + n0) * 256; t.ldd = 256; return;
    }
    it -= NT_PW;
    if (it < NT_WGU) {
        const int le = it / 64, r = it % 64, n0 = (r >> 2) * 64, k0 = (r & 3) * 256;
        const int pn = n0 >> 8, rr = n0 & 255;
        const float* W = (rr < 128) ? IN_F(I_WG) : IN_F(I_WU);
        t.ncol = 64; t.src = W + ((size_t)le * D + k0) * F + pn * 128 + (rr & 127); t.ld = F;
        t.dst = (bf16_t*)(ws + WS_WGUT) + ((size_t)le * 1024 + n0) * D + k0; t.ldd = D; return;
    }
    it -= NT_WGU;
    {
        const int le = it / 32, r = it % 32, n0 = (r >> 1) * 64, k0 = (r & 1) * 256;
        t.ncol = 64; t.src = IN_F(I_WD) + ((size_t)le * F + k0) * D + n0; t.ld = D;
        t.dst = (bf16_t*)(ws + WS_WDT) + ((size_t)le * D + n0) * F + k0; t.ldd = F;
    }
}
__device__ __forceinline__ void titem_load(const TItem& t, int tid, float4 (&v)[8]) {
    const int c4 = tid & 15, r0 = tid >> 4;
#pragma unroll
    for (int i = 0; i < 8; ++i) v[i] = (c4 * 4 < t.ncol) ? *(const float4*)(t.src + (size_t)(r0 + 32 * i) * t.ld + c4 * 4) : make_float4(0.f, 0.f, 0.f, 0.f);
    if (t.rsc) {
#pragma unroll
        for (int i = 0; i < 8; ++i) { const float s = t.rsc[r0 + 32 * i]; v[i].x *= s; v[i].y *= s; v[i].z *= s; v[i].w *= s; }
    }
}
__device__ __forceinline__ void phase_prologue(const Args& a, LAS unsigned char* lds, int vcu, int G) {
    KArgs* ka = kargs();
    const int tid = opaque_tid(), wid = __builtin_amdgcn_readfirstlane(tid >> 6), lane = tid & 63;
    LAS float* T = (LAS float*)lds;
    LAS float* cs = (LAS float*)(lds + 66560);
    LAS float* red = (LAS float*)(lds + 66560 + 16384);
    unsigned char* ws = ka->ws;
    if (vcu < 192) {
        for (int i = tid; i < 4096; i += NTHR) cs[i] = silu_f(IN_F(I_C)[i]);
        __syncthreads();
        for (int it = vcu; it < 192; it += G) {
            const int l = it / 96, j0 = (it % 96) * 64;
            const float* wp = IN_F(I_WADA) + ((size_t)l * D + wid * 128) * 6144 + j0 + lane;
            float a0 = 0.f, a1 = 0.f, a2 = 0.f, a3 = 0.f;
#pragma unroll 32
            for (int k = 0; k < 128; ++k) { const float wv = wp[(size_t)k * 6144]; const int kk = wid * 128 + k; a0 += cs[kk] * wv; a1 += cs[1024 + kk] * wv; a2 += cs[2048 + kk] * wv; a3 += cs[3072 + kk] * wv; }
            red[(wid * 4 + 0) * 64 + lane] = a0; red[(wid * 4 + 1) * 64 + lane] = a1; red[(wid * 4 + 2) * 64 + lane] = a2; red[(wid * 4 + 3) * 64 + lane] = a3;
            __syncthreads();
            if (wid < 4) { float s = 0.f;
#pragma unroll
                for (int w = 0; w < 8; ++w) s += red[(w * 4 + wid) * 64 + lane];
                ((float*)(ws + WS_MOD))[((size_t)l * 4 + wid) * 6144 + j0 + lane] = s + IN_F(I_BADA)[l * 6144 + j0 + lane]; }
            __syncthreads();
        }
    }
    for (int i = vcu * NTHR + tid; i < NTOK; i += G * NTHR) {
        const float invA[8] = {1.0f, 0.1939227432012558f, 0.03760603070259094f, 0.007292664609849453f, 0.0014142135623842478f, 0.00027424818836152554f, 5.318296098266728e-05f, 1.0313386155758053e-05f};
        const float invI[4] = {1.0f, 0.03760603070259094f, 0.0014142135623842478f, 5.318296098266728e-05f};
        const float p = (float)((const int*)ka->in[I_POS])[i];
        float* ra = (float*)(ws + WS_ROPEA) + (size_t)i * 16; float* ri = (float*)(ws + WS_ROPEI) + (size_t)i * 8;
#pragma unroll
        for (int j = 0; j < 8; ++j) { const float ang = p * invA[j]; double s, c; sincos_d((double)ang, s, c); ra[j] = (float)c; ra[8 + j] = (float)s; }
#pragma unroll
        for (int j = 0; j < 4; ++j) { const float ang = p * invI[j]; double s, c; sincos_d((double)ang, s, c); ri[j] = (float)c; ri[4 + j] = (float)s; }
    }
    for (int i = vcu * NTHR + tid; i < L * 4 * 128 * 128; i += G * NTHR) { const int s = i & 127, t = (i >> 7) & 127; ((bf16_t*)(ws + WS_SGUW))[i] = (bf16_t)(cvt_pk_bf16(s <= t ? IN_F(I_SGUW)[i] : 0.f, 0.f) & 0xffffu); }
    for (int i = vcu * NTHR + tid; i < L * 4 * 64 * 64; i += G * NTHR) { const int c = i & 63, d = (i >> 6) & 63, lg = i >> 12; ((bf16_t*)(ws + WS_POOLT))[i] = (bf16_t)(cvt_pk_bf16(IN_F(I_POOLW)[((size_t)lg * 64 + c) * 64 + d], 0.f) & 0xffffu); }
    for (int i = vcu * NTHR + tid; i < L * 48 * 1024; i += G * NTHR) {
        const int k = i & 1023, n = (i >> 10) % 48, lg = i / (48 * 1024);
        const float w = (n < 4) ? IN_F(I_WRG)[((size_t)lg * D + k) * 4 + n] : (n < 36) ? IN_F(I_WRE)[((size_t)lg * D + k) * 32 + (n - 4)] : 0.f;
        const unsigned hi = cvt_pk_bf16(w, 0.f) & 0xffffu; const float lo = w - __uint_as_float(hi << 16);
        bf16_t* dst = (bf16_t*)(ws + WS_WHL) + (size_t)lg * 2 * 48 * 1024 + (size_t)n * 1024 + k;
        dst[0] = (bf16_t)hi; dst[48 * 1024] = f2bf_(lo);
    }
    int it = (G - 1 - vcu);
    bool have = it < NT_ALL;
    TItem cur; cur.src = nullptr; cur.ld = 0; cur.ncol = 0; cur.dst = nullptr; cur.ldd = 0; cur.rsc = nullptr;
    float4 v[8];
    if (have) { decode_titem(it, a, cur); titem_load(cur, tid, v); }
    while (have) {
        { const int c4 = tid & 15, r0 = tid >> 4;
#pragma unroll
          for (int i = 0; i < 8; ++i) { LAS float* tp = T + (r0 + 32 * i) * 65 + c4 * 4; tp[0] = v[i].x; tp[1] = v[i].y; tp[2] = v[i].z; tp[3] = v[i].w; } }
        __syncthreads();
        const int itn = it + G; const bool hn = itn < NT_ALL; TItem nx = cur;
        if (hn) { decode_titem(itn, a, nx); titem_load(nx, tid, v); }
        { const int n = tid >> 3, kq = tid & 7;
#pragma unroll
          for (int j = 0; j < 4; ++j) { const int kc = j * 8 + kq; float f[8];
#pragma unroll
              for (int jj = 0; jj < 8; ++jj) f[jj] = T[(kc * 8 + jj) * 65 + n];
              u32x4 w; w.x = cvt_pk_bf16(f[0], f[1]); w.y = cvt_pk_bf16(f[2], f[3]); w.z = cvt_pk_bf16(f[4], f[5]); w.w = cvt_pk_bf16(f[6], f[7]);
              *(u32x4*)(cur.dst + (size_t)n * cur.ldd + kc * 8) = w; } }
        __syncthreads();
        cur = nx; it = itn; have = hn;
    }
}

__device__ __forceinline__ void phase_norm(const float* __restrict__ xin, const float* g, const float* shift, const float* scale, bf16_t* __restrict__ out, int vcu, int G) {
    const int tid = opaque_tid(), wid = __builtin_amdgcn_readfirstlane(tid >> 6), lane = tid & 63;
    for (int rb = vcu * 8 + wid; rb < NTOK / 8; rb += G * 8) {
        const int row0 = rb * 8, b = row0 / S;
        float4 A[4], C[4];
#pragma unroll
        for (int i = 0; i < 4; ++i) { const int k = 256 * i + 4 * lane; const float4 gv = *(const float4*)(g + k), sc = *(const float4*)(scale + (size_t)b * 6144 + k); C[i] = *(const float4*)(shift + (size_t)b * 6144 + k);
            A[i] = make_float4(gv.x * (1.f + sc.x), gv.y * (1.f + sc.y), gv.z * (1.f + sc.z), gv.w * (1.f + sc.w)); }
#pragma unroll 4
        for (int rr = 0; rr < 8; ++rr) {
            const size_t ro = (size_t)(row0 + rr) * D;
            float4 x[4]; float ss = 0.f;
#pragma unroll
            for (int i = 0; i < 4; ++i) { x[i] = *(const float4*)(xin + ro + 256 * i + 4 * lane); ss += x[i].x * x[i].x + x[i].y * x[i].y + x[i].z * x[i].z + x[i].w * x[i].w; }
            const float r = rsqrtf(wave_sum(ss) * (1.0f / D) + EPS);
#pragma unroll
            for (int i = 0; i < 4; ++i) { u32x2 w; w.x = cvt_pk_bf16(x[i].x * r * A[i].x + C[i].x, x[i].y * r * A[i].y + C[i].y); w.y = cvt_pk_bf16(x[i].z * r * A[i].z + C[i].z, x[i].w * r * A[i].w + C[i].w);
                *(u32x2*)(out + ro + 256 * i + 4 * lane) = w; }
        }
    }
}

__device__ __forceinline__ f32x4 mfma16r(const bf16x8 a, const bf16x8 b, const f32x4 c) { return __builtin_amdgcn_mfma_f32_16x16x32_bf16(a, b, c, 0, 0, 0); }
__device__ __forceinline__ void phase_rbias(const Args& a, LAS unsigned char* lds, int vcu, int G) {
    KArgs* ka = kargs();
    const int tid = opaque_tid();
    LAS float* red = (LAS float*)lds;
    for (int v = vcu; v < 256; v += G) {
        const int lb = v & 7, sl = v >> 3, l = lb >> 2, b = lb & 3, n = tid & 63, kp = tid >> 6;
        const float* sh = (const float*)(ka->ws + WS_MOD) + ((size_t)l * 4 + b) * 6144 + 3072;
        float s = 0.f;
        if (n < 36) {
#pragma unroll
            for (int i = 0; i < 4; ++i) { const int k = sl * 32 + kp * 4 + i; s += sh[k] * ((n < 4) ? IN_F(I_WRG)[((size_t)l * D + k) * 4 + n] : IN_F(I_WRE)[((size_t)l * D + k) * 32 + (n - 4)]); }
        }
        red[kp * 64 + n] = s;
        __syncthreads();
        if (tid < 48) { float t = 0.f;
            if (tid < 36) { for (int w = 0; w < 8; ++w) t += red[w * 64 + tid]; }
            ((float*)(ka->ws + WS_RBIAS))[((size_t)lb * 32 + sl) * 48 + tid] = t; }
        __syncthreads();
    }
}

__device__ __forceinline__ void phase_route(const Args& a, int l, LAS unsigned char* lds, int vcu, int G) {
    KArgs* ka = kargs();
    const int tid = opaque_tid(), wid = __builtin_amdgcn_readfirstlane(tid >> 6), lane = tid & 63, fr = lane & 15, kq = lane >> 4;
    unsigned char* ws = ka->ws;
    const bf16_t* x1 = (const bf16_t*)(ws + WS_X1);
    const float* mod = (const float*)(ws + WS_MOD) + (size_t)l * 4 * 6144;
    const float* g = IN_F(I_NORM2) + l * D; const float* shift = mod + 3072; const float* scale = mod + 4096;
    bf16_t* out = (bf16_t*)(ws + WS_HA);
    int* counts = (int*)(ws + WS_CNT) + l * NE * 64; int* list = (int*)(ws + WS_LIST); float* lgate = (float*)(ws + WS_LGATE); int* tokinfo = (int*)(ws + WS_TOKINFO);
    LAS int* lcnt = (LAS int*)(lds + LDS_MISC + 1024); LAS int* lbase = lcnt + 32; LAS int* rte = lbase + 32; LAS int* rtp = rte + 128; LAS int* rtt = rtp + 128; LAS float* rtg = (LAS float*)(rtt + 128);
    LAS float* part = (LAS float*)lds;
    LAS float* ssp = part + 8 * 16 * 48;
    LAS float* lgt = ssp + 8 * 16;
    LAS float* rrow = lgt + 16 * 48;
    const bf16_t* wh = (const bf16_t*)(ws + WS_WHL) + (size_t)l * 2 * 48 * 1024 + (size_t)fr * 1024 + 128 * wid + 8 * kq;
    LAS float* rb = (LAS float*)(lds + LDS_MISC + 8192);
    for (int r0 = vcu * 64; r0 < NTOK; r0 += G * 64) {
        const int b = r0 / S;
        if (tid < 48) { const float* rp = (const float*)(ws + WS_RBIAS) + ((size_t)(l * 4 + b) * 32) * 48 + tid; float t = 0.f;
            for (int sl = 0; sl < 32; ++sl) t += rp[sl * 48];
            if (tid < 36) t += (tid < 4) ? IN_F(I_BRG)[l * 4 + tid] : IN_F(I_BRE)[l * 32 + tid - 4];
            rb[tid] = t; }
        if (tid < 32) lcnt[tid] = 0;
#pragma unroll 1
        for (int q4 = 0; q4 < 4; ++q4) {
            float t[4][8];
            f32x4 acc[3];
#pragma unroll
            for (int nt = 0; nt < 3; ++nt) acc[nt] = (f32x4){0.f, 0.f, 0.f, 0.f};
            float ss = 0.f;
            const int row = r0 + 16 * q4 + fr;
#pragma unroll
            for (int ks = 0; ks < 4; ++ks) {
                const int k0 = 128 * wid + 32 * ks + 8 * kq;
                const f32x4 g0 = *(const f32x4*)(g + k0), g1 = *(const f32x4*)(g + k0 + 4), s0 = *(const f32x4*)(scale + (size_t)b * 6144 + k0), s1 = *(const f32x4*)(scale + (size_t)b * 6144 + k0 + 4);
                const float Ac[8] = {g0[0] * (1.f + s0[0]), g0[1] * (1.f + s0[1]), g0[2] * (1.f + s0[2]), g0[3] * (1.f + s0[3]), g1[0] * (1.f + s1[0]), g1[1] * (1.f + s1[1]), g1[2] * (1.f + s1[2]), g1[3] * (1.f + s1[3])};
                const u32x4 xw = *(const u32x4*)(x1 + (size_t)row * D + k0);
                const float v[8] = {bflo(xw.x), bfhi(xw.x), bflo(xw.y), bfhi(xw.y), bflo(xw.z), bfhi(xw.z), bflo(xw.w), bfhi(xw.w)};
                unsigned ph[4], pl[4];
#pragma unroll
                for (int j = 0; j < 8; ++j) { ss += v[j] * v[j]; t[ks][j] = v[j] * Ac[j]; }
#pragma unroll
                for (int j = 0; j < 4; ++j) { ph[j] = cvt_pk_bf16(t[ks][2 * j], t[ks][2 * j + 1]); pl[j] = cvt_pk_bf16(t[ks][2 * j] - bflo(ph[j]), t[ks][2 * j + 1] - bfhi(ph[j])); }
                const bf16x8 Ah = __builtin_bit_cast(bf16x8, (u32x4){ph[0], ph[1], ph[2], ph[3]}), Al = __builtin_bit_cast(bf16x8, (u32x4){pl[0], pl[1], pl[2], pl[3]});
#pragma unroll
                for (int nt = 0; nt < 3; ++nt) {
                    const bf16x8 Bh = *(const bf16x8*)(wh + (size_t)(16 * nt) * 1024 + 32 * ks), Bl = *(const bf16x8*)(wh + 48 * 1024 + (size_t)(16 * nt) * 1024 + 32 * ks);
                    acc[nt] = mfma16r(Ah, Bh, acc[nt]); acc[nt] = mfma16r(Al, Bh, acc[nt]); acc[nt] = mfma16r(Ah, Bl, acc[nt]);
                }
            }
            ss += __shfl_xor(ss, 16); ss += __shfl_xor(ss, 32);
            if (kq == 0) ssp[wid * 16 + fr] = ss;
#pragma unroll
            for (int nt = 0; nt < 3; ++nt)
#pragma unroll
                for (int r = 0; r < 4; ++r) part[(wid * 16 + 4 * kq + r) * 48 + 16 * nt + fr] = acc[nt][r];
            __syncthreads();
            for (int i = tid; i < 16 * 48; i += NTHR) { float s = 0.f;
#pragma unroll
                for (int w = 0; w < 8; ++w) s += part[w * 16 * 48 + i];
                lgt[i] = s; }
            if (tid < 16) { float s = 0.f;
#pragma unroll
                for (int w = 0; w < 8; ++w) s += ssp[w * 16 + tid];
                rrow[tid] = rsqrtf(s * (1.0f / D) + EPS); }
            __syncthreads();
            if (tid < 16) {
                const int tok = r0 + 16 * q4 + tid; const float r = rrow[tid];
                float ag[4];
#pragma unroll
                for (int j = 0; j < 4; ++j) ag[j] = r * lgt[tid * 48 + j] + rb[j];
                int gi = 0; float gm = ag[0];
#pragma unroll
                for (int j = 1; j < 4; ++j) if (ag[j] > gm) { gm = ag[j]; gi = j; }
                float den = 0.f;
#pragma unroll
                for (int j = 0; j < 4; ++j) den += expf(ag[j] - gm);
                const float p_sel = 1.0f / den;
                float el[8];
#pragma unroll
                for (int j = 0; j < 8; ++j) el[j] = r * lgt[tid * 48 + 4 + gi * 8 + j] + rb[4 + gi * 8 + j];
                int j0 = 0; float v0 = el[0];
#pragma unroll
                for (int j = 1; j < 8; ++j) if (el[j] > v0) { v0 = el[j]; j0 = j; }
                int j1 = 0; float v1 = -INFINITY;
#pragma unroll
                for (int j = 0; j < 8; ++j) if (j != j0 && el[j] > v1) { v1 = el[j]; j1 = j; }
                const float e1 = expf(v1 - v0);
                const float g0 = p_sel / (1.0f + e1), g1 = p_sel * e1 / (1.0f + e1);
                const int ex0 = gi * 8 + j0, ex1 = gi * 8 + j1, ai = (16 * q4 + tid) * 2;
                const int p0 = __hip_atomic_fetch_add(lcnt + ex0, 1, __ATOMIC_RELAXED, __HIP_MEMORY_SCOPE_WORKGROUP), p1 = __hip_atomic_fetch_add(lcnt + ex1, 1, __ATOMIC_RELAXED, __HIP_MEMORY_SCOPE_WORKGROUP);
                rte[ai] = ex0; rtp[ai] = p0; rtt[ai] = tok; rtg[ai] = g0;
                rte[ai + 1] = ex1; rtp[ai + 1] = p1; rtt[ai + 1] = tok; rtg[ai + 1] = g1;
            }
            {
                const float r = rrow[fr];
                bf16_t* op = out + (size_t)row * D + 128 * wid + 8 * kq;
#pragma unroll
                for (int ks = 0; ks < 4; ++ks) {
                    const float* cp = shift + (size_t)b * 6144 + 128 * wid + 32 * ks + 8 * kq;
                    const f32x4 c0 = *(const f32x4*)cp, c1 = *(const f32x4*)(cp + 4);
                    u32x4 w; w.x = cvt_pk_bf16(t[ks][0] * r + c0[0], t[ks][1] * r + c0[1]); w.y = cvt_pk_bf16(t[ks][2] * r + c0[2], t[ks][3] * r + c0[3]);
                    w.z = cvt_pk_bf16(t[ks][4] * r + c1[0], t[ks][5] * r + c1[1]); w.w = cvt_pk_bf16(t[ks][6] * r + c1[2], t[ks][7] * r + c1[3]);
                    *(u32x4*)(op + 32 * ks) = w;
                }
            }
            __syncthreads();
        }
        if (tid < 32) { const int c = lcnt[tid]; lbase[tid] = c ? atomicAdd(&counts[tid * 64], c) : 0; }
        __syncthreads();
        if (tid < 128) { const int e = rte[tid], pos = lbase[e] + rtp[tid], tk = rtt[tid];
            list[(size_t)e * NTOK + pos] = tk; lgate[(size_t)e * NTOK + pos] = rtg[tid];
            tokinfo[tk * 4 + (tid & 1) * 2] = e; tokinfo[tk * 4 + (tid & 1) * 2 + 1] = pos; }
        __syncthreads();
    }
}

__device__ __forceinline__ void moe_cum(const Args& a, int l, LAS unsigned char* lds) {
    KArgs* ka = kargs();
    LAS int* cum = (LAS int*)(lds + LDS_MISC + MISC_CUM); LAS int* cn = (LAS int*)(lds + LDS_MISC + MISC_CNT);
    const int* counts = (const int*)(ka->ws + WS_CNT) + l * NE * 64;
    const int tq = opaque_tid();
    if (tq < 33) { int s = 0; for (int j = 0; j < tq; ++j) s += (ld_agent(counts + j * 64) + 255) >> 8; cum[tq] = s; if (tq < 32) cn[tq] = ld_agent(counts + tq * 64); }
    __syncthreads();
}

__device__ __forceinline__ void phase_combine(const Args& a, int l, LAS unsigned char* lds, int vcu, int G) {
    KArgs* ka = kargs();
    const int tid = opaque_tid(), wid = __builtin_amdgcn_readfirstlane(tid >> 6), lane = tid & 63;
    unsigned char* ws = ka->ws;
    moe_cum(a, l, lds);
    const LAS int* cum = (const LAS int*)(lds + LDS_MISC + MISC_CUM);
    const bf16_t* __restrict__ x1 = (const bf16_t*)(ws + WS_X1);
    bf16_t* __restrict__ xnext = (bf16_t*)(ws + WS_X1) + (size_t)NTOK * D;
    const float* mod = (const float*)(ws + WS_MOD) + (size_t)l * 4 * 6144;
    const float* gate2 = mod + 5120;
    const bf16_t* __restrict__ Y = (const bf16_t*)(ws + WS_Y);
    const int* __restrict__ tokinfo = (const int*)(ws + WS_TOKINFO);
    float* __restrict__ outp = ka->out;
    const bool nextl = (l + 1 < L);
    const float* modn = (const float*)(ws + WS_MOD) + (size_t)(nextl ? l + 1 : l) * 4 * 6144;
    const float* gn = IN_F(I_NORM1) + (nextl ? l + 1 : l) * D;
    bf16_t* __restrict__ hout = (bf16_t*)(ws + WS_HA);
    for (int rb = vcu * 8 + wid; rb < NTOK / 8; rb += G * 8) {
        const int row0 = rb * 8, b = row0 / S;
        float4 A[4], C[4], G2[4];
#pragma unroll
        for (int i = 0; i < 4; ++i) { const int k = 256 * i + 4 * lane; const float4 gv = *(const float4*)(gn + k), sc = *(const float4*)(modn + 1024 + (size_t)b * 6144 + k); C[i] = *(const float4*)(modn + (size_t)b * 6144 + k);
            A[i] = make_float4(gv.x * (1.f + sc.x), gv.y * (1.f + sc.y), gv.z * (1.f + sc.z), gv.w * (1.f + sc.w)); G2[i] = *(const float4*)(gate2 + (size_t)b * 6144 + k); }
#pragma unroll 4
        for (int rr = 0; rr < 8; ++rr) {
            const int tok = row0 + rr; const size_t ro = (size_t)tok * D;
            const int4 ti = *(const int4*)(tokinfo + tok * 4);
            const size_t s0 = (size_t)(cum[ti.x] * 256 + ti.y) * D, s1 = (size_t)(cum[ti.z] * 256 + ti.w) * D;
            float4 xo[4]; float ss = 0.f;
#pragma unroll
            for (int i = 0; i < 4; ++i) { const int k = 256 * i + 4 * lane; const u32x2 xw = *(const u32x2*)(x1 + ro + k); const float4 xv = make_float4(bflo(xw.x), bfhi(xw.x), bflo(xw.y), bfhi(xw.y)); const u32x2 y0 = *(const u32x2*)(Y + s0 + k), y1 = *(const u32x2*)(Y + s1 + k);
                xo[i].x = xv.x + G2[i].x * (bflo(y0.x) + bflo(y1.x)); xo[i].y = xv.y + G2[i].y * (bfhi(y0.x) + bfhi(y1.x)); xo[i].z = xv.z + G2[i].z * (bflo(y0.y) + bflo(y1.y)); xo[i].w = xv.w + G2[i].w * (bfhi(y0.y) + bfhi(y1.y));
                if (nextl) { u32x2 xb; xb.x = cvt_pk_bf16(xo[i].x, xo[i].y); xb.y = cvt_pk_bf16(xo[i].z, xo[i].w); *(u32x2*)(xnext + ro + k) = xb; } else *(float4*)(outp + ro + k) = xo[i];
                ss += xo[i].x * xo[i].x + xo[i].y * xo[i].y + xo[i].z * xo[i].z + xo[i].w * xo[i].w; }
            if (nextl) {
                const float r = rsqrtf(wave_sum(ss) * (1.0f / D) + EPS);
#pragma unroll
                for (int i = 0; i < 4; ++i) { u32x2 w; w.x = cvt_pk_bf16(xo[i].x * r * A[i].x + C[i].x, xo[i].y * r * A[i].y + C[i].y); w.y = cvt_pk_bf16(xo[i].z * r * A[i].z + C[i].z, xo[i].w * r * A[i].w + C[i].w);
                    *(u32x2*)(hout + ro + 256 * i + 4 * lane) = w; }
            }
        }
    }
}
constexpr size_t WS_KN = WS_R2;
constexpr size_t WS_VT = WS_KN + al256c((size_t)NTOK * 256 * 2);
constexpr size_t WS_IKR = WS_VT + al256c((size_t)NTOK * 256 * 2);
constexpr size_t WS_MASK = WS_IKR + al256c((size_t)NTOK * 32 * 2);
constexpr size_t WS_OA = WS_MASK + al256c((size_t)NTOK * 128 * 4);
constexpr size_t WS_R3 = WS_OA + al256c((size_t)NTOK * 256 * 2);
constexpr size_t WS_MIXB = (WS_R3 > WS_Y + (size_t)SLOTS * D * 2 ? WS_R3 : WS_Y + al256c((size_t)SLOTS * D * 2));

__device__ __forceinline__ f32x4 mfma16(const bf16x8 a, const bf16x8 b, const f32x4 c) { return __builtin_amdgcn_mfma_f32_16x16x32_bf16(a, b, c, 0, 0, 0); }
__device__ __forceinline__ bf16_t f2bf(float f) { return (bf16_t)(cvt_pk_bf16(f, 0.f) & 0xffffu); }

__device__ __forceinline__ void rows_rms_store(const LAS float* YB, const float* gain, bf16_t* mixb, int tok0, int col0, int wid, int lane) {
    const f32x4 gv = *(const f32x4*)(gain + 4 * lane);
#pragma unroll 2
    for (int rr = 0; rr < 8; ++rr) {
        const int t = 8 * wid + rr;
        const f32x4 y = *(const LAS f32x4*)(YB + t * 260 + 4 * lane);
        const float ss = wave_sum(y[0] * y[0] + y[1] * y[1] + y[2] * y[2] + y[3] * y[3]);
        const float r = rsqrtf(ss * (1.0f / 256.0f) + EPS);
        u32x2 w; w.x = cvt_pk_bf16(y[0] * r * gv[0], y[1] * r * gv[1]); w.y = cvt_pk_bf16(y[2] * r * gv[2], y[3] * r * gv[3]);
        *(u32x2*)(mixb + (size_t)(tok0 + t) * D + col0 + 4 * lane) = w;
    }
}

__device__ __forceinline__ void item_pool(const Args& a, int l, int tile, LAS unsigned char* lds) {
    KArgs* ka = kargs();
    const int tid = opaque_tid(), wid = __builtin_amdgcn_readfirstlane(tid >> 6), lane = tid & 63;
    unsigned char* ws = ka->ws;
    const bf16_t* proj = (const bf16_t*)(ws + WS_PROJ);
    LAS bf16_t* P = (LAS bf16_t*)lds;
    LAS bf16_t* PA = (LAS bf16_t*)(lds + 40960);
    LAS float* YB = (LAS float*)(lds + 40960 + 33792);
    const int tok0 = tile * 64, b = tok0 / S, t0 = tok0 % S;
#pragma unroll
    for (int p = tid; p < 79 * 32; p += NTHR) {
        const int r = p >> 5, c8 = p & 31, t = t0 - 15 + r;
        u32x4 v = (u32x4){0u, 0u, 0u, 0u};
        if (t >= 0) v = *(const u32x4*)(proj + (size_t)(b * S + t) * NP + NC + c8 * 8);
        *(LAS u32x4*)(P + r * 256 + c8 * 8) = v;
    }
    __syncthreads();
    {
        const int c = tid & 255, half = tid >> 8, g = c >> 6, w = 2 << g, tt0 = half * 32;
        float run = 0.f;
        for (int jj = 1; jj < w; ++jj) run += bf2f(P[(15 + tt0 - jj) * 256 + c]);
        for (int i = 0; i < 32; ++i) {
            const int tt = tt0 + i, r = 15 + tt;
            const float pv = bf2f(P[r * 256 + c]);
            run += pv;
            const int tabs = t0 + tt, nn = (tabs + 1 < w) ? (tabs + 1) : w;
            PA[tt * 264 + c] = f2bf(run / (float)nn - pv);
            run -= bf2f(P[(r - w + 1) * 256 + c]);
        }
    }
    __syncthreads();
    {
        const int g = wid >> 1, mh = wid & 1, fr = lane & 15, fq = lane >> 4;
        const bf16_t* PT = (const bf16_t*)(ws + WS_POOLT) + (size_t)(l * 4 + g) * 64 * 64;
        f32x4 acc[2][4];
#pragma unroll
        for (int mi = 0; mi < 2; ++mi)
#pragma unroll
            for (int ni = 0; ni < 4; ++ni) acc[mi][ni] = (f32x4){0.f, 0.f, 0.f, 0.f};
#pragma unroll
        for (int ks = 0; ks < 2; ++ks) {
            bf16x8 A[2];
#pragma unroll
            for (int mi = 0; mi < 2; ++mi) A[mi] = *(const LAS bf16x8*)(PA + (16 * (2 * mh + mi) + fr) * 264 + g * 64 + 32 * ks + 8 * fq);
#pragma unroll
            for (int ni = 0; ni < 4; ++ni) { const bf16x8 Bf = *(const bf16x8*)(PT + (16 * ni + fr) * 64 + 32 * ks + 8 * fq);
#pragma unroll
                for (int mi = 0; mi < 2; ++mi) acc[mi][ni] = mfma16(A[mi], Bf, acc[mi][ni]); }
        }
        const float* pb = IN_F(I_POOLB) + l * 256; const float* ps = IN_F(I_POOLS) + l * 256;
#pragma unroll
        for (int ni = 0; ni < 4; ++ni) { const int d = g * 64 + 16 * ni + fr; const float bb = pb[d], sc = ps[d];
#pragma unroll
            for (int mi = 0; mi < 2; ++mi)
#pragma unroll
                for (int r = 0; r < 4; ++r) YB[(16 * (2 * mh + mi) + 4 * fq + r) * 260 + d] = (acc[mi][ni][r] + bb) * sc; }
    }
    __syncthreads();
    rows_rms_store(YB, IN_F(I_ONORM) + l * D + 512, (bf16_t*)(ws + WS_MIXB), tok0, 512, wid, lane);
    __syncthreads();
}

__device__ __forceinline__ void item_conv(const Args& a, int l, int tile, LAS unsigned char* lds) {
    KArgs* ka = kargs();
    const int tid = opaque_tid(), wid = __builtin_amdgcn_readfirstlane(tid >> 6), lane = tid & 63;
    unsigned char* ws = ka->ws;
    const bf16_t* proj = (const bf16_t*)(ws + WS_PROJ);
    LAS float* GL = (LAS float*)lds;
    LAS bf16_t* CA = (LAS bf16_t*)(lds + 96256);
    LAS float* YB = (LAS float*)lds;
    const int tok0 = tile * 64, b = tok0 / S, t0 = tok0 % S;
#pragma unroll
    for (int p = tid; p < 94 * 32; p += NTHR) {
        const int r = p >> 5, c8 = p & 31, t = t0 - 30 + r;
        f32x4 o0 = (f32x4){0.f, 0.f, 0.f, 0.f}, o1 = o0;
        if (t >= 0) {
            const bf16_t* pr = proj + (size_t)(b * S + t) * NP;
            const u32x4 av = *(const u32x4*)(pr + NBA + c8 * 8), gv = *(const u32x4*)(pr + NBG + c8 * 8);
            o0[0] = bflo(av.x) * sigmoid_fast(bflo(gv.x)); o0[1] = bfhi(av.x) * sigmoid_fast(bfhi(gv.x)); o0[2] = bflo(av.y) * sigmoid_fast(bflo(gv.y)); o0[3] = bfhi(av.y) * sigmoid_fast(bfhi(gv.y));
            o1[0] = bflo(av.z) * sigmoid_fast(bflo(gv.z)); o1[1] = bfhi(av.z) * sigmoid_fast(bfhi(gv.z)); o1[2] = bflo(av.w) * sigmoid_fast(bflo(gv.w)); o1[3] = bfhi(av.w) * sigmoid_fast(bfhi(gv.w));
        }
        *(LAS f32x4*)(GL + r * 256 + c8 * 8) = o0; *(LAS f32x4*)(GL + r * 256 + c8 * 8 + 4) = o1;
    }
    __syncthreads();
    {
        const int c = tid & 255, half = tid >> 8;
        float wv[31];
#pragma unroll
        for (int jj = 0; jj < 31; ++jj) wv[jj] = IN_F(I_CONVW)[((size_t)l * 31 + jj) * 256 + c];
        const float cb = IN_F(I_CONVB)[l * 256 + c];
        float yv[32];
#pragma unroll
        for (int ch = 0; ch < 8; ++ch) {
            const int tt = half * 32 + ch * 4;
            float x[34];
#pragma unroll
            for (int m2 = 0; m2 < 34; ++m2) x[m2] = GL[(tt + m2) * 256 + c];
#pragma unroll
            for (int i = 0; i < 4; ++i) {
                float y = cb;
#pragma unroll
                for (int jj = 0; jj < 31; ++jj) y += x[i + jj] * wv[jj];
                yv[ch * 4 + i] = y;
            }
        }
        __syncthreads();
#pragma unroll
        for (int i = 0; i < 32; ++i) YB[(half * 32 + i) * 260 + c] = yv[i];
    }
    __syncthreads();
    {
        const int t = tid >> 3, part = tid & 7;
        float y[32]; float s1 = 0.f;
#pragma unroll
        for (int i = 0; i < 8; ++i) { const f32x4 v = *(const LAS f32x4*)(YB + t * 260 + part * 32 + 4 * i); y[4 * i] = v[0]; y[4 * i + 1] = v[1]; y[4 * i + 2] = v[2]; y[4 * i + 3] = v[3]; s1 += (v[0] + v[1]) + (v[2] + v[3]); }
        s1 += dpp_f<0xB1>(s1);
        const float mu = s1 * (1.0f / 64.0f);
        float s2 = 0.f;
#pragma unroll
        for (int i = 0; i < 32; ++i) { y[i] -= mu; s2 += y[i] * y[i]; }
        s2 += dpp_f<0xB1>(s2);
        const float rs = rsqrtf(s2 * (1.0f / 64.0f) + EPS);
        const float* lng = IN_F(I_CLNG) + l * 256 + part * 32; const float* lnb = IN_F(I_CLNB) + l * 256 + part * 32;
#pragma unroll
        for (int i = 0; i < 4; ++i) {
            float o[8];
#pragma unroll
            for (int e = 0; e < 8; ++e) o[e] = silu_f(y[8 * i + e] * rs * lng[8 * i + e] + lnb[8 * i + e]);
            u32x4 w; w.x = cvt_pk_bf16(o[0], o[1]); w.y = cvt_pk_bf16(o[2], o[3]); w.z = cvt_pk_bf16(o[4], o[5]); w.w = cvt_pk_bf16(o[6], o[7]);
            *(LAS u32x4*)(CA + t * 264 + part * 32 + 8 * i) = w;
        }
    }
    __syncthreads();
    {
        const int fr = lane & 15, fq = lane >> 4;
        const bf16_t* PW = (const bf16_t*)(ws + WS_PWT) + (size_t)l * 65536;
        f32x4 acc[4][2];
#pragma unroll
        for (int mi = 0; mi < 4; ++mi)
#pragma unroll
            for (int ni = 0; ni < 2; ++ni) acc[mi][ni] = (f32x4){0.f, 0.f, 0.f, 0.f};
#pragma unroll 2
        for (int ks = 0; ks < 8; ++ks) {
            bf16x8 Bf[2];
#pragma unroll
            for (int ni = 0; ni < 2; ++ni) Bf[ni] = *(const bf16x8*)(PW + (size_t)(32 * wid + 16 * ni + fr) * 256 + 32 * ks + 8 * fq);
#pragma unroll
            for (int mi = 0; mi < 4; ++mi) { const bf16x8 Af = *(const LAS bf16x8*)(CA + (16 * mi + fr) * 264 + 32 * ks + 8 * fq);
#pragma unroll
                for (int ni = 0; ni < 2; ++ni) acc[mi][ni] = mfma16(Af, Bf[ni], acc[mi][ni]); }
        }
        const float* pwb = IN_F(I_PWB) + l * 256;
#pragma unroll
        for (int ni = 0; ni < 2; ++ni) { const int n = 32 * wid + 16 * ni + fr; const float bb = pwb[n];
#pragma unroll
            for (int mi = 0; mi < 4; ++mi)
#pragma unroll
                for (int r = 0; r < 4; ++r) YB[(16 * mi + 4 * fq + r) * 260 + n] = acc[mi][ni][r] + bb; }
    }
    __syncthreads();
    rows_rms_store(YB, IN_F(I_ONORM) + l * D + 256, (bf16_t*)(ws + WS_MIXB), tok0, 256, wid, lane);
    __syncthreads();
}

__device__ __forceinline__ void item_sgu(const Args& a, int l, int ch, LAS unsigned char* lds) {
    KArgs* ka = kargs();
    const int tid = opaque_tid(), wid = __builtin_amdgcn_readfirstlane(tid >> 6), lane = tid & 63;
    unsigned char* ws = ka->ws;
    const bf16_t* proj = (const bf16_t*)(ws + WS_PROJ);
    LAS bf16_t* VT = (LAS bf16_t*)lds;
    LAS bf16_t* OB = (LAS bf16_t*)(lds + 69632);
    const int tok0 = ch * 128;
    {
        const f32x4 lg = *(const f32x4*)(IN_F(I_SLNG) + l * 256 + 4 * lane), lb = *(const f32x4*)(IN_F(I_SLNB) + l * 256 + 4 * lane);
#pragma unroll 8
        for (int i = 0; i < 16; ++i) {
            const int s = 16 * wid + i;
            const u32x2 vv = *(const u32x2*)(proj + (size_t)(tok0 + s) * NP + NDV + 4 * lane);
            const float v0 = bflo(vv.x), v1 = bfhi(vv.x), v2 = bflo(vv.y), v3 = bfhi(vv.y);
            const float mu = wave_sum((v0 + v1) + (v2 + v3)) * (1.0f / 256.0f);
            const float d0 = v0 - mu, d1 = v1 - mu, d2 = v2 - mu, d3 = v3 - mu;
            const float rs = rsqrtf(wave_sum((d0 * d0 + d1 * d1) + (d2 * d2 + d3 * d3)) * (1.0f / 256.0f) + EPS);
            VT[(4 * lane + 0) * 136 + s] = f2bf(d0 * rs * lg[0] + lb[0]); VT[(4 * lane + 1) * 136 + s] = f2bf(d1 * rs * lg[1] + lb[1]);
            VT[(4 * lane + 2) * 136 + s] = f2bf(d2 * rs * lg[2] + lb[2]); VT[(4 * lane + 3) * 136 + s] = f2bf(d3 * rs * lg[3] + lb[3]);
        }
    }
    __syncthreads();
    {
        const int h = wid >> 1, np = wid & 1, fr = lane & 15, fq = lane >> 4;
        const bf16_t* W = (const bf16_t*)(ws + WS_SGUW) + (size_t)(l * 4 + h) * 128 * 128;
        const float* sb = IN_F(I_SGUB) + (l * 4 + h) * 128;
#pragma unroll 1
        for (int mi = 0; mi < 8; ++mi) {
            f32x4 acc[2] = {(f32x4){0.f, 0.f, 0.f, 0.f}, (f32x4){0.f, 0.f, 0.f, 0.f}};
            for (int ks = 0; ks <= (mi >> 1); ++ks) {
                const bf16x8 Af = *(const bf16x8*)(W + (size_t)(16 * mi + fr) * 128 + 32 * ks + 8 * fq);
#pragma unroll
                for (int ni = 0; ni < 2; ++ni) { const bf16x8 Bf = *(const LAS bf16x8*)(VT + (h * 64 + 32 * np + 16 * ni + fr) * 136 + 32 * ks + 8 * fq); acc[ni] = mfma16(Af, Bf, acc[ni]); }
            }
#pragma unroll
            for (int ni = 0; ni < 2; ++ni)
#pragma unroll
                for (int r = 0; r < 4; ++r) { const int t = 16 * mi + 4 * fq + r; OB[t * 264 + h * 64 + 32 * np + 16 * ni + fr] = f2bf(acc[ni][r] + sb[t]); }
        }
    }
    __syncthreads();
    {
        const f32x4 gv = *(const f32x4*)(IN_F(I_ONORM) + l * D + 768 + 4 * lane);
        bf16_t* mixb = (bf16_t*)(ws + WS_MIXB);
#pragma unroll 8
        for (int i = 0; i < 16; ++i) {
            const int t = 16 * wid + i;
            const u32x2 mv = *(const LAS u32x2*)(OB + t * 264 + 4 * lane);
            const u32x2 uv = *(const u32x2*)(proj + (size_t)(tok0 + t) * NP + NDU + 4 * lane);
            const float o0 = bflo(uv.x) * bflo(mv.x), o1 = bfhi(uv.x) * bfhi(mv.x), o2 = bflo(uv.y) * bflo(mv.y), o3 = bfhi(uv.y) * bfhi(mv.y);
            const float r = rsqrtf(wave_sum((o0 * o0 + o1 * o1) + (o2 * o2 + o3 * o3)) * (1.0f / 256.0f) + EPS);
            u32x2 w; w.x = cvt_pk_bf16(o0 * r * gv[0], o1 * r * gv[1]); w.y = cvt_pk_bf16(o2 * r * gv[2], o3 * r * gv[3]);
            *(u32x2*)(mixb + (size_t)(tok0 + t) * D + 768 + 4 * lane) = w;
        }
    }
    __syncthreads();
}

__device__ __forceinline__ void item_prepk(const Args& a, int l, int tile, LAS unsigned char* lds) {
    KArgs* ka = kargs();
    const int tid = opaque_tid(), wid = __builtin_amdgcn_readfirstlane(tid >> 6), lane = tid & 63;
    unsigned char* ws = ka->ws;
    const bf16_t* proj = (const bf16_t*)(ws + WS_PROJ);
    LAS bf16_t* VS = (LAS bf16_t*)lds;
    bf16_t* KN = (bf16_t*)(ws + WS_KN); bf16_t* VTg = (bf16_t*)(ws + WS_VT); bf16_t* IKR = (bf16_t*)(ws + WS_IKR);
    const float* ropeA = (const float*)(ws + WS_ROPEA); const float* ropeI = (const float*)(ws + WS_ROPEI);
    const int tok0 = tile * 64, b = tok0 / S, s0 = tok0 % S;
    const int li = lane & 15, head = lane >> 4;
    const f32x4 kg = *(const f32x4*)(IN_F(I_KN) + l * 64 + 4 * li);
#pragma unroll 4
    for (int i = 0; i < 8; ++i) {
        const int tl = 8 * wid + i, tok = tok0 + tl, s = s0 + tl;
        const bf16_t* pr = proj + (size_t)tok * NP;
        const u32x2 kv = *(const u32x2*)(pr + NK + 4 * lane);
        float k0 = bflo(kv.x), k1 = bfhi(kv.x), k2 = bflo(kv.y), k3 = bfhi(kv.y);
        float ss = (k0 * k0 + k1 * k1) + (k2 * k2 + k3 * k3);
        ss = row_sum16(ss);
        const float r = rsqrtf(ss * (1.0f / 64.0f) + EPS);
        k0 *= r * kg[0]; k1 *= r * kg[1]; k2 *= r * kg[2]; k3 *= r * kg[3];
        {
            const float p0 = __shfl_xor(k0, 2), p1 = __shfl_xor(k1, 2), p2 = __shfl_xor(k2, 2), p3 = __shfl_xor(k3, 2);
            if (li < 4) {
                const int dd = 4 * (li & 1);
                const f32x4 cs = *(const f32x4*)(ropeA + (size_t)tok * 16 + dd), sn = *(const f32x4*)(ropeA + (size_t)tok * 16 + 8 + dd);
                if (li < 2) { k0 = k0 * cs[0] - p0 * sn[0]; k1 = k1 * cs[1] - p1 * sn[1]; k2 = k2 * cs[2] - p2 * sn[2]; k3 = k3 * cs[3] - p3 * sn[3]; }
                else        { k0 = k0 * cs[0] + p0 * sn[0]; k1 = k1 * cs[1] + p1 * sn[1]; k2 = k2 * cs[2] + p2 * sn[2]; k3 = k3 * cs[3] + p3 * sn[3]; }
            }
        }
        u32x2 ko; ko.x = cvt_pk_bf16(k0, k1); ko.y = cvt_pk_bf16(k2, k3);
        *(u32x2*)(KN + ((size_t)((b * 4 + head) * 128 + (s >> 5)) * 32 + (s & 31)) * 64 + 4 * li) = ko;
        *(LAS u32x2*)(VS + tl * 256 + 4 * lane) = *(const u32x2*)(pr + NV + 4 * lane);
        if (lane < 8) {
            const u32x2 iv = *(const u32x2*)(pr + NIK + 4 * lane);
            float x0 = bflo(iv.x), x1 = bfhi(iv.x), x2 = bflo(iv.y), x3 = bfhi(iv.y);
            const float q0 = __shfl_xor(x0, 1), q1 = __shfl_xor(x1, 1), q2 = __shfl_xor(x2, 1), q3 = __shfl_xor(x3, 1);
            if (lane < 2) {
                const f32x4 cs = *(const f32x4*)(ropeI + (size_t)tok * 8), sn = *(const f32x4*)(ropeI + (size_t)tok * 8 + 4);
                if (lane == 0) { x0 = x0 * cs[0] - q0 * sn[0]; x1 = x1 * cs[1] - q1 * sn[1]; x2 = x2 * cs[2] - q2 * sn[2]; x3 = x3 * cs[3] - q3 * sn[3]; }
                else           { x0 = x0 * cs[0] + q0 * sn[0]; x1 = x1 * cs[1] + q1 * sn[1]; x2 = x2 * cs[2] + q2 * sn[2]; x3 = x3 * cs[3] + q3 * sn[3]; }
            }
            u32x2 io; io.x = cvt_pk_bf16(x0, x1); io.y = cvt_pk_bf16(x2, x3);
            *(u32x2*)(IKR + (size_t)tok * 32 + 4 * lane) = io;
        }
    }
    __syncthreads();
#pragma unroll
    for (int i = 0; i < 4; ++i) {
        const int p = tid + NTHR * i;
        const int h = p >> 9, ktl = (p >> 8) & 1, d = (p >> 2) & 63, part = p & 3;
        unsigned short e[8];
#pragma unroll
        for (int jj = 0; jj < 8; ++jj) { const int key = 4 * part + (jj & 3) + 16 * (jj >> 2); e[jj] = VS[(ktl * 32 + key) * 256 + h * 64 + d]; }
        u32x4 w; w.x = e[0] | ((unsigned)e[1] << 16); w.y = e[2] | ((unsigned)e[3] << 16); w.z = e[4] | ((unsigned)e[5] << 16); w.w = e[6] | ((unsigned)e[7] << 16);
        *(u32x4*)(VTg + ((size_t)((b * 4 + h) * 128 + (s0 >> 5) + ktl) * 64 + d) * 32 + 8 * part) = w;
    }
    __syncthreads();
}

__device__ __forceinline__ void phase_mix1(const Args& a, int l, LAS unsigned char* lds, int vcu, int G, int bx) {
    if (G == 256) {
        if (bx < 64) { item_conv(a, l, bx, lds); item_pool(a, l, bx, lds); }
        else {
            const int w = bx - 64;
            if (w < 128) item_sgu(a, l, w, lds);
            item_prepk(a, l, w, lds);
            item_conv(a, l, 64 + w, lds);
            if (w >= 128) item_prepk(a, l, 192 + (w - 128), lds);
            item_pool(a, l, 64 + w, lds);
        }
        return;
    }
    for (int it = vcu; it < 896; it += G) {
        if (it < 128) item_sgu(a, l, it, lds);
        else if (it < 384) item_conv(a, l, it - 128, lds);
        else if (it < 640) item_pool(a, l, it - 384, lds);
        else item_prepk(a, l, it - 640, lds);
    }
}
__device__ __forceinline__ f32x16 mfma32(const bf16x8 a, const bf16x8 b, const f32x16 c) { return __builtin_amdgcn_mfma_f32_32x32x16_bf16(a, b, c, 0, 0, 0); }
typedef float f32x2 __attribute__((ext_vector_type(2)));

__device__ __forceinline__ void a1_scores(const bf16x8 A0, const bf16x8 A1, const bf16x8 (&Bq)[4][2], const float (&cl)[4], f32x2 (&sc)[8]) {
    f32x16 d[4];
#pragma unroll
    for (int h = 0; h < 4; ++h) {
#pragma unroll
        for (int r = 0; r < 16; ++r) d[h][r] = 0.f;
        d[h] = mfma32(A0, Bq[h][0], d[h]); d[h] = mfma32(A1, Bq[h][1], d[h]);
    }
#pragma unroll
    for (int p = 0; p < 8; ++p) {
        f32x2 m[4];
#pragma unroll
        for (int h = 0; h < 4; ++h) { m[h][0] = __builtin_amdgcn_fmed3f(d[h][2 * p], 0.0f, cl[h]); m[h][1] = __builtin_amdgcn_fmed3f(d[h][2 * p + 1], 0.0f, cl[h]); }
        sc[p] = (m[0] + m[1]) + (m[2] + m[3]);
    }
}

#define A1_STREAM_BEGIN { \
    bf16x8 rA[4][2]; const int ntw_ = (nkt - wid + 7) >> 3; \
    _Pragma("unroll") for (int u_ = 0; u_ < 4; ++u_) { rA[u_][0] = Bq[0][0]; rA[u_][1] = Bq[0][0]; if (u_ < ntw_) { const size_t o_ = (size_t)(wid + 8 * u_) * 1024; rA[u_][0] = *(const bf16x8*)(ikl + o_); rA[u_][1] = *(const bf16x8*)(ikl + o_ + 16); } } \
    for (int i_ = 0; i_ < ntw_; i_ += 4) { \
        _Pragma("unroll") for (int u_ = 0; u_ < 4; ++u_) { if (i_ + u_ < ntw_) { \
            const bf16x8 cA0 = rA[u_][0], cA1 = rA[u_][1]; const int kt = wid + 8 * (i_ + u_); \
            if (i_ + u_ + 4 < ntw_) { const size_t o_ = (size_t)(kt + 32) * 1024; rA[u_][0] = *(const bf16x8*)(ikl + o_); rA[u_][1] = *(const bf16x8*)(ikl + o_ + 16); }
#define A1_STREAM_END } } } }

template <int KIND>
__device__ __forceinline__ void a1_pass(const bf16_t* ikl, int nkt, int wid, const bf16x8 (&Bq)[4][2], const float (&cl)[4], LAS unsigned char* histb, unsigned q4, unsigned cadd) {
    A1_STREAM_BEGIN
        f32x2 sc[8];
        a1_scores(cA0, cA1, Bq, cl, sc);
#pragma unroll
        for (int r = 0; r < 16; ++r) {
            const unsigned u = __float_as_uint(sc[r >> 1][r & 1]);
            unsigned addr;
            if (KIND == 0) addr = (((u + 0x8000u) >> 17) & 0x7f80u) | q4;
            else { unsigned dg = (u + cadd) >> 16; dg = dg < 256u ? dg : 256u; addr = (dg << 7) + q4; }
            __hip_atomic_fetch_add((LAS unsigned*)(histb + addr), 1u, __ATOMIC_RELAXED, __HIP_MEMORY_SCOPE_WORKGROUP);
        }
    A1_STREAM_END
}

template <int LEVEL>
__device__ __forceinline__ void a1_scan(LAS unsigned* hist, LAS unsigned* psum, LAS unsigned* qst, int tid) {
    const int sq = tid & 31, part = tid >> 5;
    const unsigned need = qst[32 + sq], p1 = qst[sq];
    const bool neg = (p1 & 0x80u) != 0u;
#define A1_RAWROW(bn) (LEVEL == 0 ? ((bn) >= 128 ? (bn) - 128 : 255 - (bn)) : (neg ? 255 - (bn) : (bn)))
    unsigned local = 0u;
#pragma unroll
    for (int bb = 0; bb < 16; ++bb) local += hist[A1_RAWROW(16 * part + bb) * 32 + sq];
    psum[part * 32 + sq] = local;
    __syncthreads();
    unsigned above = 0u;
    for (int pp = part + 1; pp < 16; ++pp) above += psum[pp * 32 + sq];
    if (above < need && above + local >= need) {
        unsigned run = above;
        for (int bb = 15; bb >= 0; --bb) {
            const int raw = A1_RAWROW(16 * part + bb);
            const unsigned c = hist[raw * 32 + sq];
            if (run + c >= need) {
                if (LEVEL == 0) { qst[sq] = (unsigned)raw; qst[32 + sq] = need - run; }
                else { qst[sq] = (p1 << 8) | (unsigned)raw; qst[32 + sq] = need - run; qst[64 + sq] = c; }
                break;
            }
            run += c;
        }
    }
#undef A1_RAWROW
}

__device__ __forceinline__ void a1_cmp2(unsigned& gt, unsigned& ge, float s0, float s1, float tg, float te) {
#ifdef A1_NOASM
    gt = (gt << 1) | (s0 >= tg ? 1u : 0u); ge = (ge << 1) | (s0 >= te ? 1u : 0u);
    gt = (gt << 1) | (s1 >= tg ? 1u : 0u); ge = (ge << 1) | (s1 >= te ? 1u : 0u);
#else
    unsigned long long m1, m2, m3;
    asm("v_cmp_ge_f32 vcc, %[s0], %[tg]\n\t"
        "v_cmp_ge_f32 %[m1], %[s0], %[te]\n\t"
        "v_cmp_ge_f32 %[m2], %[s1], %[tg]\n\t"
        "v_cmp_ge_f32 %[m3], %[s1], %[te]\n\t"
        "v_addc_co_u32 %[g], vcc, %[g], %[g], vcc\n\t"
        "v_addc_co_u32 %[e], %[m1], %[e], %[e], %[m1]\n\t"
        "v_addc_co_u32 %[g], %[m2], %[g], %[g], %[m2]\n\t"
        "v_addc_co_u32 %[e], %[m3], %[e], %[e], %[m3]"
        : [g] "+v"(gt), [e] "+v"(ge), [m1] "=&s"(m1), [m2] "=&s"(m2), [m3] "=&s"(m3)
        : [s0] "v"(s0), [s1] "v"(s1), [tg] "v"(tg), [te] "v"(te)
        : "vcc");
#endif
}
__device__ __forceinline__ unsigned a1_spread(unsigned x) { return (x & 0xfu) | ((x & 0xf0u) << 4) | ((x & 0xf00u) << 8) | ((x & 0xf000u) << 12); }

constexpr int A1_HISTA = 0, A1_HISTB = 257 * 32, A1_PSUM = 2 * 257 * 32, A1_QST = A1_PSUM + 16 * 32, A1_MBUF = A1_QST + 128, A1_TBUF = A1_MBUF + 32 * 128;
__device__ __forceinline__ void a1_tile(const Args& a, int l, int b, int j, LAS unsigned char* lds) {
    KArgs* ka = kargs();
    const int tid = opaque_tid(), wid = __builtin_amdgcn_readfirstlane(tid >> 6), lane = tid & 63, q = lane & 31, hh = lane >> 5;
    unsigned char* ws = ka->ws;
    const bf16_t* proj = (const bf16_t*)(ws + WS_PROJ);
    const bf16_t* ikr = (const bf16_t*)(ws + WS_IKR) + (size_t)b * S * 32;
    const bf16_t* ikl = ikr + (lane & 31) * 32 + 8 * (lane >> 5);
    unsigned* maskg = (unsigned*)(ws + WS_MASK);
    LAS unsigned* L = (LAS unsigned*)lds;
    LAS unsigned* psum = L + A1_PSUM; LAS unsigned* qst = L + A1_QST; LAS unsigned* mbuf = L + A1_MBUF; LAS unsigned* tbuf = L + A1_TBUF;
    const int t0 = j * 32, n = (t0 / 64 + 1) * 64, nkt = n / 32, nw = ((t0 / 128) + 1) * 4;
    if (n <= 256) {
        for (int i = tid; i < 32 * nw; i += NTHR) { const int qq = i / nw, w = i % nw; maskg[(size_t)(b * S + t0 + qq) * 128 + w] = (w < nkt) ? 0xffffffffu : 0u; }
        return;
    }
    bf16x8 Bq[4][2]; float cl[4];
    {
        const int tok = b * S + t0 + q;
        const bf16_t* pr = proj + (size_t)tok * NP;
        const f32x4 cs = *(const f32x4*)((const float*)(ws + WS_ROPEI) + (size_t)tok * 8), sn = *(const f32x4*)((const float*)(ws + WS_ROPEI) + (size_t)tok * 8 + 4);
#pragma unroll
        for (int h = 0; h < 4; ++h) {
            const float wsc = bf2f(pr[NIW + h]) * (0.5f * 0.17677669529663687f);
            cl[h] = (wsc > 0.f) ? INFINITY : -INFINITY;
#pragma unroll
            for (int ks = 0; ks < 2; ++ks) {
                const u32x4 raw = *(const u32x4*)(pr + NIQ + h * 32 + 16 * ks + 8 * hh);
                float v[8] = {bflo(raw.x), bfhi(raw.x), bflo(raw.y), bfhi(raw.y), bflo(raw.z), bfhi(raw.z), bflo(raw.w), bfhi(raw.w)};
                if (ks == 0 && hh == 0) {
#pragma unroll
                    for (int i = 0; i < 4; ++i) { const float x1 = v[i], x2 = v[i + 4]; v[i] = x1 * cs[i] - x2 * sn[i]; v[i + 4] = x2 * cs[i] + x1 * sn[i]; }
                }
                u32x4 pk; pk.x = cvt_pk_bf16(v[0] * wsc, v[1] * wsc); pk.y = cvt_pk_bf16(v[2] * wsc, v[3] * wsc); pk.z = cvt_pk_bf16(v[4] * wsc, v[5] * wsc); pk.w = cvt_pk_bf16(v[6] * wsc, v[7] * wsc);
                Bq[h][ks] = __builtin_bit_cast(bf16x8, pk);
            }
        }
    }
    { LAS u32x4* hz = (LAS u32x4*)(L + A1_HISTA); for (int i = tid; i < 2 * 257 * 32 / 4; i += NTHR) hz[i] = (u32x4){0u, 0u, 0u, 0u}; }
    if (tid < 32) { qst[tid] = 0u; qst[32 + tid] = 256u; qst[64 + tid] = 0u; }
    __syncthreads();
    const unsigned q4 = (unsigned)q * 4u;
    a1_pass<0>(ikl, nkt, wid, Bq, cl, (LAS unsigned char*)(L + A1_HISTA), q4, 0u);
    __syncthreads();
    a1_scan<0>(L + A1_HISTA, psum, qst, tid);
    __syncthreads();
    a1_pass<1>(ikl, nkt, wid, Bq, cl, (LAS unsigned char*)(L + A1_HISTB), q4, 0x8000u - (qst[q] << 24));
    __syncthreads();
    a1_scan<1>(L + A1_HISTB, psum, qst, tid);
    __syncthreads();
    {
        const unsigned T = qst[q], mag = T & 0x7fffu;
        unsigned bg, be;
        if ((T & 0x8000u) == 0u) { be = mag ? (mag << 16) - 0x8000u : 0u; bg = ((mag + 1u) << 16) - 0x8000u; }
        else { be = 0x80000000u | (((mag + 1u) << 16) - 0x8001u); bg = mag ? (0x80000000u | ((mag << 16) - 0x8001u)) : 0u; }
        const float tg = __uint_as_float(bg), te = __uint_as_float(be);
        A1_STREAM_BEGIN
            f32x2 sc[8];
            a1_scores(cA0, cA1, Bq, cl, sc);
            unsigned gt = 0u, ge = 0u;
#pragma unroll
            for (int p = 7; p >= 0; --p) a1_cmp2(gt, ge, sc[p][1], sc[p][0], tg, te);
            unsigned wb = a1_spread(gt & 0xffffu) << (4 * hh), eb = a1_spread(ge & 0xffffu) << (4 * hh);
            wb |= (unsigned)__shfl_xor((int)wb, 32); eb |= (unsigned)__shfl_xor((int)eb, 32);
            if (hh == 0) { mbuf[q * 128 + kt] = wb; tbuf[q * 128 + kt] = eb & ~wb; }
        A1_STREAM_END
    }
    __syncthreads();
    {
        const int qq = tid >> 4, part = tid & 15;
        const unsigned need = qst[32 + qq];
        const u32x4 ta = *(const LAS u32x4*)(tbuf + qq * 128 + part * 8), tb = *(const LAS u32x4*)(tbuf + qq * 128 + part * 8 + 4);
        const u32x4 ma = *(const LAS u32x4*)(mbuf + qq * 128 + part * 8), mb = *(const LAS u32x4*)(mbuf + qq * 128 + part * 8 + 4);
        unsigned t[8] = {ta.x, ta.y, ta.z, ta.w, tb.x, tb.y, tb.z, tb.w}, m[8] = {ma.x, ma.y, ma.z, ma.w, mb.x, mb.y, mb.z, mb.w};
        unsigned c = 0u;
#pragma unroll
        for (int i = 0; i < 8; ++i) { if (part * 8 + i >= nkt) { t[i] = 0u; m[i] = 0u; } c += (unsigned)__builtin_popcount(t[i]); }
        unsigned inc = c;
#pragma unroll
        for (int dd = 1; dd < 16; dd <<= 1) { const unsigned v = (unsigned)__shfl_up((int)inc, dd, 16); if (part >= dd) inc += v; }
        int rem = (int)need - (int)(inc - c);
#pragma unroll
        for (int i = 0; i < 8; ++i) {
            const int ci = __builtin_popcount(t[i]);
            unsigned keep = 0u;
            if (rem >= ci) keep = t[i];
            else if (rem > 0) { unsigned tt = t[i]; for (int k = rem; k > 0; --k) { const unsigned low = tt & (0u - tt); keep |= low; tt ^= low; } }
            m[i] |= keep; rem -= ci;
        }
        unsigned* mg = maskg + (size_t)(b * S + t0 + qq) * 128 + part * 8;
        if (part * 8 < nw) *(u32x4*)mg = (u32x4){m[0], m[1], m[2], m[3]};
        if (part * 8 + 4 < nw) *(u32x4*)(mg + 4) = (u32x4){m[4], m[5], m[6], m[7]};
    }
    __syncthreads();
}
__device__ __forceinline__ void phase_a1(const Args& a, int l, LAS unsigned char* lds, int vcu, int G) {
    KArgs* ka = kargs();
    for (int it = vcu; it < 256; it += G) { const int b = it >> 6, jj = it & 63; a1_tile(a, l, b, 127 - jj, lds); a1_tile(a, l, b, jj, lds); }
}

__device__ __forceinline__ void a2_unit(const Args& a, int l, int b, int h, int blk, LAS unsigned char* lds) {
    KArgs* ka = kargs();
    const int tid = opaque_tid(), wid = __builtin_amdgcn_readfirstlane(tid >> 6), lane = tid & 63, fr = lane & 15, kq = lane >> 4;
    unsigned char* ws = ka->ws;
    const bf16_t* proj = (const bf16_t*)(ws + WS_PROJ);
    const char* KNb = (const char*)(ws + WS_KN) + (size_t)(b * 4 + h) * 128 * 4096;
    const char* VTb = (const char*)(ws + WS_VT) + (size_t)(b * 4 + h) * 128 * 4096;
    LAS unsigned char* Kb = lds;
    LAS unsigned char* Vb = lds + 32768;
    LAS float* Ob = (LAS float*)(lds + 65536) + wid * (16 * 68);
    const int nsteps = 2 * (blk + 1);
    const int tokq = b * S + blk * 128 + wid * 16 + fr;
    bf16x8 Qb[2]; float C2;
    {
        const float* qg = IN_F(I_QN) + l * 64; const float* kg = IN_F(I_KN) + l * 64;
        float gq = 0.f, gk = 0.f;
        for (int i = 0; i < 64; ++i) { gq = fmaxf(gq, fabsf(qg[i])); gk = fmaxf(gk, fabsf(kg[i])); }
        C2 = 8.0f * gq * gk * 1.4426950408889634f;
        const bf16_t* pr = proj + (size_t)tokq * NP + NQ + h * 64;
        float v[2][8]; float ss = 0.f;
#pragma unroll
        for (int ks = 0; ks < 2; ++ks) { const u32x4 raw = *(const u32x4*)(pr + 32 * ks + 8 * kq);
            v[ks][0] = bflo(raw.x); v[ks][1] = bfhi(raw.x); v[ks][2] = bflo(raw.y); v[ks][3] = bfhi(raw.y); v[ks][4] = bflo(raw.z); v[ks][5] = bfhi(raw.z); v[ks][6] = bflo(raw.w); v[ks][7] = bfhi(raw.w);
#pragma unroll
            for (int i = 0; i < 8; ++i) ss += v[ks][i] * v[ks][i]; }
        ss += __shfl_xor(ss, 16); ss += __shfl_xor(ss, 32);
        const float r = rsqrtf(ss * (1.0f / 64.0f) + EPS);
#pragma unroll
        for (int ks = 0; ks < 2; ++ks)
#pragma unroll
            for (int i = 0; i < 8; ++i) v[ks][i] *= r * qg[32 * ks + 8 * kq + i];
        {
            const float* ra = (const float*)(ws + WS_ROPEA) + (size_t)tokq * 16;
#pragma unroll
            for (int i = 0; i < 8; ++i) { const float pv = __shfl_xor(v[0][i], 16); const float c = ra[i], s = ra[8 + i];
                if (kq == 0) v[0][i] = v[0][i] * c - pv * s; else if (kq == 1) v[0][i] = v[0][i] * c + pv * s; }
        }
        const float qs = 0.125f * 1.4426950408889634f;
#pragma unroll
        for (int ks = 0; ks < 2; ++ks) { u32x4 pk; pk.x = cvt_pk_bf16(v[ks][0] * qs, v[ks][1] * qs); pk.y = cvt_pk_bf16(v[ks][2] * qs, v[ks][3] * qs); pk.z = cvt_pk_bf16(v[ks][4] * qs, v[ks][5] * qs); pk.w = cvt_pk_bf16(v[ks][6] * qs, v[ks][7] * qs);
            Qb[ks] = __builtin_bit_cast(bf16x8, pk); }
    }
    const unsigned* mrow = (const unsigned*)(ws + WS_MASK) + (size_t)tokq * 128;
    f32x4 O[4];
#pragma unroll
    for (int dt = 0; dt < 4; ++dt) O[dt] = (f32x4){0.f, 0.f, 0.f, 0.f};
    float lsum = 0.f;
    const unsigned bit0 = 1u << (4 * kq);
    const int kkey = tid >> 3, kch = tid & 7, vsub = tid >> 8, vd = (tid >> 2) & 63, vch = tid & 3;
    const int klds = kkey * 128 + ((kch ^ (kkey & 7)) * 16), vlds = vsub * 4096 + vd * 64 + ((vch ^ ((vd >> 2) & 3)) * 16);
    u32x4 kr0, kr1, kr2, kr3, vr0, vr1, vr2, vr3; u32x2 mw0, mw1, mw2, mw3;
#define A2_LOAD(j, st_) do { kr##j = *(const u32x4*)(KNb + (size_t)(st_) * 8192 + (size_t)tid * 16); vr##j = *(const u32x4*)(VTb + (size_t)(st_) * 8192 + (size_t)tid * 16); mw##j = *(const u32x2*)(mrow + 2 * (st_)); } while (0)
    A2_LOAD(0, 0); A2_LOAD(1, 1);
    if (nsteps > 2) { A2_LOAD(2, 2); A2_LOAD(3, 3); } else { kr2 = kr0; vr2 = vr0; mw2 = mw0; kr3 = kr0; vr3 = vr0; mw3 = mw0; }
    __syncthreads();
#define A2_HALF(Kc, Vc, mcur) do { \
        _Pragma("unroll") for (int sub = 0; sub < 2; ++sub) { \
            const unsigned m = sub ? (mcur).y : (mcur).x; \
            f32x4 Sx[2]; \
            _Pragma("unroll") for (int tl = 0; tl < 2; ++tl) { \
                const int key = 32 * sub + 16 * tl + fr; \
                const bf16x8 A0 = *(const LAS bf16x8*)((Kc) + key * 128 + (((0 + kq) ^ (key & 7)) * 16)); \
                const bf16x8 A1 = *(const LAS bf16x8*)((Kc) + key * 128 + (((4 + kq) ^ (key & 7)) * 16)); \
                f32x4 z = (f32x4){-C2, -C2, -C2, -C2};     \
                z = mfma16(A0, Qb[0], z); Sx[tl] = mfma16(A1, Qb[1], z); \
            } \
            float p[8]; \
            _Pragma("unroll") for (int r = 0; r < 4; ++r) { \
                const float e0 = __builtin_amdgcn_exp2f(Sx[0][r]), e1 = __builtin_amdgcn_exp2f(Sx[1][r]); \
                p[r] = (m & (bit0 << r)) ? e0 : 0.f; p[4 + r] = (m & (bit0 << (16 + r))) ? e1 : 0.f; \
            } \
            lsum += ((p[0] + p[1]) + (p[2] + p[3])) + ((p[4] + p[5]) + (p[6] + p[7])); \
            u32x4 pk; pk.x = cvt_pk_bf16(p[0], p[1]); pk.y = cvt_pk_bf16(p[2], p[3]); pk.z = cvt_pk_bf16(p[4], p[5]); pk.w = cvt_pk_bf16(p[6], p[7]); \
            const bf16x8 Pf = __builtin_bit_cast(bf16x8, pk); \
            _Pragma("unroll") for (int dt = 0; dt < 4; ++dt) { const int d = 16 * dt + fr; \
                const bf16x8 Av = *(const LAS bf16x8*)((Vc) + sub * 4096 + d * 64 + ((kq ^ ((d >> 2) & 3)) * 16)); \
                O[dt] = mfma16(Av, Pf, O[dt]); } \
        } } while (0)
#define A2_STEP2(ja, jb, s2_) do { \
        LAS unsigned char* Kc2 = Kb + ((s2_) & 1) * 16384; LAS unsigned char* Vc2 = Vb + ((s2_) & 1) * 16384; \
        *(LAS u32x4*)(Kc2 + klds) = kr##ja; *(LAS u32x4*)(Vc2 + vlds) = vr##ja; *(LAS u32x4*)(Kc2 + 8192 + klds) = kr##jb; *(LAS u32x4*)(Vc2 + 8192 + vlds) = vr##jb; \
        const u32x2 mcA = mw##ja, mcB = mw##jb; \
        __syncthreads(); \
        if (2 * (s2_) + 4 < nsteps) A2_LOAD(ja, 2 * (s2_) + 4); \
        if (2 * (s2_) + 5 < nsteps) A2_LOAD(jb, 2 * (s2_) + 5); \
        A2_HALF(Kc2, Vc2, mcA); A2_HALF(Kc2 + 8192, Vc2 + 8192, mcB); \
    } while (0)
    for (int s2 = 0; 2 * s2 < nsteps; s2 += 2) {
        A2_STEP2(0, 1, s2);
        if (2 * (s2 + 1) < nsteps) A2_STEP2(2, 3, s2 + 1);
    }
#undef A2_STEP2
#undef A2_HALF
#undef A2_LOAD
    lsum += __shfl_xor(lsum, 16); lsum += __shfl_xor(lsum, 32);
    const float inv = 1.0f / lsum;
#pragma unroll
    for (int dt = 0; dt < 4; ++dt)
#pragma unroll
        for (int r = 0; r < 4; ++r) Ob[fr * 68 + 16 * dt + 4 * kq + r] = O[dt][r] * inv;
    __syncthreads();
    {
        const int qq = lane >> 2, dp = (lane & 3) * 16;
        const LAS float* src = Ob + qq * 68 + dp;
        float f[16]; float sq = 0.f;
#pragma unroll
        for (int i = 0; i < 4; ++i) { const f32x4 t = *(const LAS f32x4*)(src + 4 * i); f[4 * i] = t[0]; f[4 * i + 1] = t[1]; f[4 * i + 2] = t[2]; f[4 * i + 3] = t[3]; sq += (t[0] * t[0] + t[1] * t[1]) + (t[2] * t[2] + t[3] * t[3]); }
        u32x4 w0, w1; w0.x = cvt_pk_bf16(f[0], f[1]); w0.y = cvt_pk_bf16(f[2], f[3]); w0.z = cvt_pk_bf16(f[4], f[5]); w0.w = cvt_pk_bf16(f[6], f[7]);
        w1.x = cvt_pk_bf16(f[8], f[9]); w1.y = cvt_pk_bf16(f[10], f[11]); w1.z = cvt_pk_bf16(f[12], f[13]); w1.w = cvt_pk_bf16(f[14], f[15]);
        const int tok = b * S + blk * 128 + wid * 16 + qq;
        bf16_t* op = (bf16_t*)(ws + WS_MIXB) + (size_t)tok * D + h * 64 + dp;
        *(u32x4*)op = w0; *(u32x4*)(op + 8) = w1;
        sq += dpp_f<0xB1>(sq); sq += dpp_f<0x4E>(sq);
        if ((lane & 3) == 0) ((float*)(ws + WS_SSQ))[((size_t)l * NTOK + tok) * 4 + h] = sq;
    }
    __syncthreads();
}
__device__ __forceinline__ void phase_a2(const Args& a, int l, LAS unsigned char* lds, int vcu, int G) {
    KArgs* ka = kargs();
    for (int it = vcu; it < 256; it += G) { const int b = it >> 6, h = (it >> 4) & 3, jj = it & 15; a2_unit(a, l, b, h, 31 - jj, lds); a2_unit(a, l, b, h, jj, lds); }
}
__global__ void __launch_bounds__(NTHR, 2) mk_fwd(Args a) {
    extern __shared__ __attribute__((aligned(16))) unsigned char lds_raw[];
    LAS unsigned char* lds = (LAS unsigned char*)lds_raw;
    const int tid = threadIdx.x, G = gridDim.x, bx = blockIdx.x;
    const int vcu = (G % 8 == 0) ? (bx % 8) * (G / 8) + bx / 8 : bx;
    if (tid < 64) ((LAS unsigned*)(lds + LDS_MISC))[tid] = 0u;
    __syncthreads();
    XcdBarrier bar; bar.bar = (unsigned*)(a.ws + WS_BAR); bar.x = 0; bar.st = nullptr;
    if (a.fused) bar = xcd_barrier_post((unsigned*)(a.ws + WS_BAR), (volatile LAS unsigned*)(lds + LDS_MISC + MISC_BAR));
#define GRID_BAR() do { if (a.fused) xcd_barrier(bar); } while (0)
#ifdef ONLY_PH
#define IN(k) ((k) == ONLY_PH && a.ph_lo <= (k) && (k) < a.ph_hi)
#else
#define IN(k) (a.ph_lo <= (k) && (k) < a.ph_hi)
#endif
    if (IN(PH_PRO)) { phase_prologue(a, lds, vcu, G); GRID_BAR(); }
    if (IN(PH_NORM0)) { KArgs* ka = kargs(); unsigned char* ws = ka->ws; float* modp = (float*)(ws + WS_MOD); phase_norm(IN_F(I_X), IN_F(I_NORM1), modp, modp + 1024, (bf16_t*)(ws + WS_HA), vcu, G); phase_rbias(a, lds, vcu, G); GRID_BAR(); }
    for (int l = a.l_lo; l < a.l_hi; ++l) {
        if (IN(PH_G1)) {
            KArgs* ka = kargs(); unsigned char* ws = ka->ws;
            pg8::DenseOrder S; S.init((const bf16_t*)(ws + WS_HA), (const bf16_t*)(ws + WS_WINT) + (size_t)l * NP * D, NTOK, (G == 256) ? NP - 256 : NP, D, G, bx);
            pg8::EpiBf16 E{(bf16_t*)(ws + WS_PROJ), NP};
            pg8::gemm_phase(lds, S, E);
            GRID_BAR();
        }
        if (IN(PH_MIX)) {
            if (G == 256 && bx < 64) {
                KArgs* ka = kargs(); unsigned char* ws = ka->ws;
                pg8::DenseOrder S; S.init((const bf16_t*)(ws + WS_HA), (const bf16_t*)(ws + WS_WINT) + (size_t)l * NP * D + (size_t)(NP - 256) * D, NTOK, 256, D, 64, bx);
                pg8::EpiBf16 E{(bf16_t*)(ws + WS_PROJ) + (NP - 256), NP};
                pg8::gemm_phase(lds, S, E);
            }
            phase_mix1(a, l, lds, vcu, G, bx); GRID_BAR();
        }
        if (IN(PH_A1)) { phase_a1(a, l, lds, vcu, G); GRID_BAR(); }
        if (IN(PH_A2)) { phase_a2(a, l, lds, vcu, G); GRID_BAR(); }
        if (IN(PH_G2)) {
            KArgs* ka = kargs(); unsigned char* ws = ka->ws; const float* xin = IN_F(I_X); const bf16_t* xinb = (l == 0) ? (const bf16_t*)nullptr : (const bf16_t*)(ws + WS_X1) + (size_t)NTOK * D; const float* mod = (const float*)(ws + WS_MOD) + (size_t)l * 4 * 6144;
            pg8::DenseOrder S; S.init((const bf16_t*)(ws + WS_MIXB), (const bf16_t*)(ws + WS_WOUTT) + (size_t)l * D * D, NTOK, D, D, G, bx);
            pg8::EpiResid E{xin, xinb, (bf16_t*)(ws + WS_X1), mod + 2048, (const float*)(ws + WS_SSQ) + (size_t)l * NTOK * 4};
            pg8::gemm_phase<pg8::EpiResid, pg8::DenseOrder, true>(lds, S, E);
            GRID_BAR();
        }
        if (IN(PH_ROUTE)) { phase_route(a, l, lds, vcu, G); GRID_BAR(); }
        if (IN(PH_UP)) {
            KArgs* ka = kargs(); unsigned char* ws = ka->ws;
            moe_cum(a, l, lds);
            pg8::MoeOrder<true> S; S.A = (const bf16_t*)(ws + WS_HA); S.Bt = (const bf16_t*)(ws + WS_WGUT) + (size_t)l * NE * 1024 * 1024; S.K = D; S.bstride = (size_t)1024 * 1024;
            S.list = (const int*)(ws + WS_LIST); S.cum = (const LAS int*)(lds + LDS_MISC + MISC_CUM); S.cnts = (const LAS int*)(lds + LDS_MISC + MISC_CNT); S.G = G; S.c = vcu; S.nun = S.cum[32] * 4;
            S.flag = (int*)(ws + WS_FLAG) + l * 160 * 8;
            pg8::EpiHid E{(bf16_t*)(ws + WS_HID)};
            pg8::gemm_phase(lds, S, E);
        }
        if (IN(PH_DOWN)) {
            KArgs* ka = kargs(); unsigned char* ws = ka->ws;
            moe_cum(a, l, lds);
            pg8::MoeOrder<false> S; S.A = (const bf16_t*)(ws + WS_HID); S.Bt = (const bf16_t*)(ws + WS_WDT) + (size_t)l * NE * 1024 * 512; S.K = F; S.bstride = (size_t)1024 * 512;
            S.list = nullptr; S.cum = (const LAS int*)(lds + LDS_MISC + MISC_CUM); S.cnts = (const LAS int*)(lds + LDS_MISC + MISC_CNT); S.G = G; S.c = G - 1 - vcu; S.nun = S.cum[32] * 4;
            S.flag = (int*)(ws + WS_FLAG) + l * 160 * 8;
            pg8::EpiDown E{(bf16_t*)(ws + WS_Y), (const float*)(ws + WS_LGATE)};
            pg8::gemm_phase(lds, S, E);
            GRID_BAR();
        }
        if (IN(PH_COMB)) { phase_combine(a, l, lds, vcu, G); GRID_BAR(); }
    }
#undef IN
#undef GRID_BAR
}


static void launch_ph(const Args& base, int grid, int l_lo, int l_hi, int ph_lo, int ph_hi, int fused, hipStream_t stream) {
    Args a = base; a.l_lo = l_lo; a.l_hi = l_hi; a.ph_lo = ph_lo; a.ph_hi = ph_hi; a.fused = fused; a.pad = 0;
    hipLaunchKernelGGL(mk_fwd, dim3(grid), dim3(NTHR), LDS_BYTES, stream, a);
}

extern "C" void kernel_launch(void* const* d_in, const int* in_sizes, int n_in, void* d_out, int out_size, void* d_ws, size_t ws_size, hipStream_t stream) {
    static int grid = 0;
    if (grid == 0) {
        int dev = 0, cus = 0;
        if (hipGetDevice(&dev) != hipSuccess || hipDeviceGetAttribute(&cus, hipDeviceAttributeMultiprocessorCount, dev) != hipSuccess) { grid = -1; return; }
        if (hipFuncSetAttribute((const void*)mk_fwd, hipFuncAttributeMaxDynamicSharedMemorySize, LDS_BYTES) != hipSuccess) { fprintf(stderr, "hipFuncSetAttribute failed\n"); grid = -1; return; }
        (void)hipGetLastError();
        grid = cus;
    }
    if (grid < 0) return;
    unsigned char* ws = (unsigned char*)d_ws;
    (void)hipMemsetAsync(ws, 0, WS_ZERO_BYTES, stream);
    Args a{};
    for (int i = 0; i < 32; ++i) a.in[i] = d_in[i];
    a.out = (float*)d_out; a.ws = ws;
#ifdef MK_MULTI
    launch_ph(a, grid, 0, 0, PH_PRO, PH_PRO + 1, 0, stream);
#ifdef MK_REP
    if (MK_REP == PH_PRO) launch_ph(a, grid, 0, 0, PH_PRO, PH_PRO + 1, 0, stream);
#endif
    launch_ph(a, grid, 0, 0, PH_NORM0, PH_NORM0 + 1, 0, stream);
#ifdef MK_REP
    if (MK_REP == PH_NORM0) launch_ph(a, grid, 0, 0, PH_NORM0, PH_NORM0 + 1, 0, stream);
#endif
    for (int l = 0; l < L; ++l)
        for (int ph = PH_G1; ph < PH_END; ++ph) {
            launch_ph(a, grid, l, l + 1, ph, ph + 1, 0, stream);
#ifdef MK_REP
            if (ph == MK_REP) launch_ph(a, grid, l, l + 1, ph, ph + 1, 0, stream);
#endif
        }
#else
    launch_ph(a, grid, 0, L, PH_PRO, PH_END, 1, stream);
#endif
}
```

```cpp
#include <hip/hip_runtime.h>
#include <stdint.h>
#include <stdio.h>

#define LAS __attribute__((address_space(3)))
typedef unsigned short bf16_t;
typedef short bf16x8 __attribute__((ext_vector_type(8)));
typedef float f32x4 __attribute__((ext_vector_type(4)));
typedef float f32x16 __attribute__((ext_vector_type(16)));
typedef unsigned u32x4 __attribute__((ext_vector_type(4)));
typedef unsigned u32x2 __attribute__((ext_vector_type(2)));

constexpr int Bn = 4, S = 4096, D = 1024, L = 2, NTOK = Bn * S, DIN = 2212, F = 512, NE = 32;
constexpr int NP = 2304;
constexpr int NK = 0, NV = 256, NIQ = 512, NIK = 640, NIW = 672, NBA = 768, NBG = 1024, NC = 1280, NDU = 1536, NDV = 1792, NQ = 2048;
constexpr float EPS = 1e-6f;
constexpr int NTHR = 512;
constexpr int SLOTS = 40960;

constexpr int LDS_BYTES = 163840, LDS_MISC = 147456;
constexpr int MISC_BAR = 0;
constexpr int MISC_CUM = 64;
constexpr int MISC_CNT = 64 + 160;

constexpr size_t al256c(size_t v) { return (v + 255) & ~(size_t)255; }
constexpr size_t WS_BAR = 0;
constexpr size_t WS_CNT = 16384;
constexpr size_t WS_FLAG = 16384 + 16384;
constexpr size_t WS_ZERO_BYTES = 16384 + 32768;
constexpr size_t WS_MOD = WS_ZERO_BYTES;
constexpr size_t WS_ROPEA = WS_MOD + al256c((size_t)L * 4 * 6144 * 4);
constexpr size_t WS_ROPEI = WS_ROPEA + al256c((size_t)NTOK * 16 * 4);
constexpr size_t WS_LIST = WS_ROPEI + al256c((size_t)NTOK * 8 * 4);
constexpr size_t WS_LGATE = WS_LIST + al256c((size_t)NE * NTOK * 4);
constexpr size_t WS_TOKINFO = WS_LGATE + al256c((size_t)NE * NTOK * 4);
constexpr size_t WS_SGUW = WS_TOKINFO + al256c((size_t)NTOK * 16);
constexpr size_t WS_POOLT = WS_SGUW + al256c((size_t)L * 4 * 128 * 128 * 2);
constexpr size_t WS_WHL = WS_POOLT + al256c((size_t)L * 4 * 64 * 64 * 2);
constexpr size_t WS_RBIAS = WS_WHL + al256c((size_t)L * 2 * 48 * 1024 * 2);
constexpr size_t WS_SSQ = WS_RBIAS + al256c((size_t)L * 4 * 32 * 48 * 4);
constexpr size_t WS_WINT = WS_SSQ + al256c((size_t)L * NTOK * 4 * 4);
constexpr size_t WS_WOUTT = WS_WINT + al256c((size_t)L * NP * D * 2);
constexpr size_t WS_PWT = WS_WOUTT + al256c((size_t)L * D * D * 2);
constexpr size_t WS_WGUT = WS_PWT + al256c((size_t)L * 256 * 256 * 2);
constexpr size_t WS_WDT = WS_WGUT + al256c((size_t)L * NE * 1024 * 1024 * 2);
constexpr size_t WS_HA = WS_WDT + al256c((size_t)L * NE * 1024 * 512 * 2);
constexpr size_t WS_X1 = WS_HA + al256c((size_t)NTOK * D * 2);
constexpr size_t WS_R = WS_X1 + al256c((size_t)NTOK * D * 4);
constexpr size_t WS_PROJ = WS_R;
constexpr size_t WS_R2 = WS_PROJ + al256c((size_t)NTOK * NP * 2);
constexpr size_t WS_HID = WS_R;
constexpr size_t WS_Y = WS_HID + al256c((size_t)SLOTS * F * 2);

__device__ __forceinline__ unsigned cvt_pk_bf16(float lo, float hi) { unsigned r; asm volatile("v_cvt_pk_bf16_f32 %0, %1, %2" : "=v"(r) : "v"(lo), "v"(hi)); return r; }
__device__ __forceinline__ float bf2f(bf16_t v) { return __uint_as_float(((unsigned)v) << 16); }
__device__ __forceinline__ float bflo(unsigned w) { return __uint_as_float(w << 16); }
__device__ __forceinline__ float bfhi(unsigned w) { return __uint_as_float(w & 0xffff0000u); }
template <int CTRL> __device__ __forceinline__ float dpp_f(float v) { return __builtin_bit_cast(float, __builtin_amdgcn_update_dpp(0, __builtin_bit_cast(int, v), CTRL, 0xF, 0xF, true)); }
__device__ __forceinline__ float row_sum16(float v) {
    v += dpp_f<0xB1>(v);
    v += dpp_f<0x4E>(v);
    v += dpp_f<0x141>(v);
    v += dpp_f<0x140>(v);
    return v;
}
__device__ __forceinline__ float wave_sum(float v) {
    v = row_sum16(v);
    const float r0 = __builtin_bit_cast(float, __builtin_amdgcn_readlane(__builtin_bit_cast(int, v), 0)), r1 = __builtin_bit_cast(float, __builtin_amdgcn_readlane(__builtin_bit_cast(int, v), 16));
    const float r2 = __builtin_bit_cast(float, __builtin_amdgcn_readlane(__builtin_bit_cast(int, v), 32)), r3 = __builtin_bit_cast(float, __builtin_amdgcn_readlane(__builtin_bit_cast(int, v), 48));
    return (r0 + r1) + (r2 + r3);
}
__device__ __forceinline__ float wave_max(float v) {
#pragma unroll
    for (int o = 32; o >= 1; o >>= 1) v = fmaxf(v, __shfl_xor(v, o));
    return v;
}
__device__ __forceinline__ float silu_f(float v) { return v / (1.0f + expf(-v)); }
__device__ __forceinline__ float silu_fast(float v) { return v * __builtin_amdgcn_rcpf(1.0f + __expf(-v)); }
__device__ __forceinline__ float sigmoid_f(float v) { return 1.0f / (1.0f + expf(-v)); }
__device__ __forceinline__ float sigmoid_fast(float v) { return __builtin_amdgcn_rcpf(1.0f + __expf(-v)); }
__device__ __forceinline__ int opaque_tid() { int t = threadIdx.x; asm volatile("" : "+v"(t)); return t; }
__device__ __forceinline__ int ld_agent(const int* p) { return __hip_atomic_load(p, __ATOMIC_RELAXED, __HIP_MEMORY_SCOPE_AGENT); }

#define XB_TMO      128
#define XB_XCNT(j)  (256  + 64 * (j))
#define XB_XSUB(j)  (1280 + 64 * (j))
#define XB_XGEN(j)  (2304 + 64 * (j))
#define XB_TOP      3328
#define XB_TOPGEN   3392
#define XCD_BAR_WORDS 3456
#define XB_SPIN_CAP (1u << 18)
__device__ __forceinline__ unsigned xb_ld(unsigned* p)              { return __hip_atomic_load(p, __ATOMIC_RELAXED, __HIP_MEMORY_SCOPE_AGENT); }
__device__ __forceinline__ unsigned xb_add(unsigned* p, unsigned v) { return __hip_atomic_fetch_add(p, v, __ATOMIC_RELAXED, __HIP_MEMORY_SCOPE_AGENT); }
__device__ __forceinline__ unsigned xb_xcc_id() { return (unsigned)__builtin_amdgcn_s_getreg((3 << 11) | 20) & 0xFu; }
#define XB_SPIN(cond, bar) do { unsigned _sp = 0; while (cond) { __builtin_amdgcn_s_sleep(1); \
    if ((++_sp & 255u) == 0u) { if (xb_ld(&(bar)[XB_TMO])) break; if (_sp > XB_SPIN_CAP) { atomicAdd(&(bar)[XB_TMO], 1u); break; } } } } while (0)
struct XcdBarrier { unsigned* bar; unsigned x; volatile LAS unsigned* st; };
__device__ __forceinline__ XcdBarrier xcd_barrier_post(unsigned* bar, volatile LAS unsigned* st) {
    XcdBarrier b; b.bar = bar; b.x = xb_xcc_id(); b.st = st;
    if (threadIdx.x == 0) (void)xb_add(&bar[XB_XCNT(b.x)], 1u);
    return b;
}
__device__ __forceinline__ void xcd_barrier_complete(unsigned* bar, unsigned x, unsigned& nloc, unsigned& nx) {
    const unsigned G = gridDim.x * gridDim.y * gridDim.z;
    unsigned sum, cnt, mine, sp = 0u;
    for (;;) {
        sum = 0u; cnt = 0u; mine = 0u;
#pragma unroll
        for (unsigned j = 0; j < 16; ++j) { const unsigned c = xb_ld(&bar[XB_XCNT(j)]); sum += c; cnt += (c > 0u) ? 1u : 0u; mine = (j == x) ? c : mine; }
        if (sum == G) break;
        __builtin_amdgcn_s_sleep(1);
        if ((++sp & 255u) == 0u) { if (xb_ld(&bar[XB_TMO])) break; if (sp > XB_SPIN_CAP) { atomicAdd(&bar[XB_TMO], 1u); break; } }
    }
    nloc = mine > 0u ? mine : 1u; nx = cnt > 0u ? cnt : 1u;
}
__device__ __forceinline__ void xcd_barrier(const XcdBarrier& b) {
    asm volatile("s_waitcnt vmcnt(0)" ::: "memory");
    __syncthreads();
    if (threadIdx.x == 0) {
        unsigned* bar = b.bar;
        __builtin_amdgcn_s_waitcnt(0);
        unsigned nloc = b.st[0], nx = b.st[1];
        if (nloc == 0u) { xcd_barrier_complete(bar, b.x, nloc, nx); b.st[0] = nloc; b.st[1] = nx; }
        const unsigned old = xb_add(&bar[XB_XSUB(b.x)], 1u);
        const unsigned gen = old / nloc;
        if (old + 1u == (gen + 1u) * nloc) {
            __builtin_amdgcn_fence(__ATOMIC_RELEASE, "agent");
            asm volatile("s_waitcnt vmcnt(0)" ::: "memory");
            const unsigned og = xb_add(&bar[XB_TOP], 1u);
            const unsigned tg = og / nx;
            if (og + 1u == (tg + 1u) * nx) xb_add(&bar[XB_TOPGEN], 1u);
            else XB_SPIN(xb_ld(&bar[XB_TOPGEN]) == tg, bar);
            __builtin_amdgcn_fence(__ATOMIC_ACQUIRE, "agent");
            xb_add(&bar[XB_XGEN(b.x)], 1u);
            asm volatile("s_waitcnt vmcnt(0)" ::: "memory");
        } else {
            XB_SPIN(xb_ld(&bar[XB_XGEN(b.x)]) == gen, bar);
            __builtin_amdgcn_fence(__ATOMIC_ACQUIRE, "agent");
            asm volatile("s_waitcnt vmcnt(0)" ::: "memory");
        }
    }
    __syncthreads();
}

namespace pg8 {
constexpr int BM = 256, BK = 64, HALF = 128, HTB = HALF * BK * 2, STAGE_BYTES = 8 * HTB, NXCD = 8, WGM = 8;
__host__ __device__ __forceinline__ int lds_byte(int r, int c) { const int st = (r >> 4) * 2 + (c >> 5), rr = r & 15, cc = c & 31, ob = rr * 64 + cc * 2; return st * 1024 + (ob ^ (((ob >> 9) & 1) << 5)); }
__host__ __device__ __forceinline__ void stage_rc(int b, int& R, int& C) { const int st = b / 1024, sb = b % 1024, swz = sb ^ (((sb >> 9) & 1) << 5); R = (st >> 1) * 16 + swz / 64; C = (st & 1) * 32 + (swz % 64) / 2; }
__host__ __device__ __forceinline__ int perm32(int rho) { const int n = rho >> 4, i = rho & 15; return 8 * (i >> 2) + 4 * n + (i & 3); }

struct Unit { int pm, pn, e, mt, cnt; };

struct DenseOrder {
    static constexpr int SYNC = 0;
    const bf16_t* A; const bf16_t* Bt; int K;
    int nM, nN, nwg, G, c;
    __device__ void init(const bf16_t* A_, const bf16_t* Bt_, int M, int N, int K_, int G_, int c_) { A = A_; Bt = Bt_; K = K_; nM = M / BM; nN = N / BM; nwg = nM * nN; G = G_; c = c_; }
    __device__ bool next(int i, Unit& u) const {
        const long Lx = (long)i * G + c; if (Lx >= nwg) return false;
        int wgid = (int)Lx; { const int q = nwg / NXCD, r = nwg % NXCD, xcd = wgid % NXCD, off = wgid / NXCD; wgid = (xcd < r ? xcd * (q + 1) : r * (q + 1) + (xcd - r) * q) + off; }
        const int nig = WGM * nN, gid = wgid / nig, fm = gid * WGM, gsz = (nM - fm) < WGM ? (nM - fm) : WGM;
        u.pm = fm + ((wgid % nig) % gsz); u.pn = (wgid % nig) / gsz; u.e = 0; u.mt = 0; u.cnt = 0; return true;
    }
    __device__ __forceinline__ const char* a_base(const Unit& u) const { return (const char*)A + (size_t)u.pm * BM * K * 2; }
    __device__ __forceinline__ unsigned a_voff(const Unit&, int row, int C) const { return (unsigned)(row * K + C) * 2u; }
    __device__ __forceinline__ const char* b_base(const Unit& u) const { return (const char*)Bt + (size_t)u.pn * BM * K * 2; }
};
template <bool gather> struct MoeOrder {
    static constexpr int SYNC = gather ? 1 : 2;
    int* flag;
    const bf16_t* A; const bf16_t* Bt; int K; size_t bstride;
    const int* list;
    const LAS int* cum; const LAS int* cnts;
    int G, c, nun;
    __device__ bool next(int i, Unit& u) const {
        const int Lx = i * G + c; if (Lx >= nun) return false;
        const int t = Lx >> 2; u.pn = Lx & 3; u.pm = t;
        int e = 0;
#pragma unroll 1
        for (int j = 1; j < NE; ++j) e += (cum[j] <= t) ? 1 : 0;
        u.e = e; u.mt = t - cum[e]; u.cnt = cnts[e]; return true;
    }
    __device__ __forceinline__ const char* a_base(const Unit& u) const { return gather ? (const char*)A : (const char*)A + (size_t)u.pm * BM * K * 2; }
    __device__ __forceinline__ unsigned a_voff(const Unit& u, int row, int C) const {
        if (gather) { const int pos = u.mt * BM + row; const int tok = (pos < u.cnt) ? list[(size_t)u.e * NTOK + pos] : 0; return (unsigned)(tok * K + C) * 2u; }
        return (unsigned)(row * K + C) * 2u;
    }
    __device__ __forceinline__ const char* b_base(const Unit& u) const { return (const char*)(Bt + (size_t)u.e * bstride) + (size_t)u.pn * BM * K * 2; }
};

struct EpiBf16 {
    static constexpr bool PERM = true;
    bf16_t* O; int ldc;
    __device__ __forceinline__ void operator()(const f32x4 (&acc)[2][2][4][2], const Unit& u, int wr, int wc, int fr, int fq) const {
        const int row0 = u.pm * BM + wr * 64 + fr, col0 = u.pn * BM + wc * 32 + 8 * fq;
#pragma unroll
        for (int ai = 0; ai < 2; ++ai)
#pragma unroll
            for (int m = 0; m < 4; ++m) { bf16_t* rowp = O + (size_t)(row0 + ai * HALF + m * 16) * ldc + col0;
#pragma unroll
                for (int bj = 0; bj < 2; ++bj) { const f32x4 v0 = acc[ai][bj][m][0], v1 = acc[ai][bj][m][1];
                    u32x4 w; w.x = cvt_pk_bf16(v0[0], v0[1]); w.y = cvt_pk_bf16(v0[2], v0[3]); w.z = cvt_pk_bf16(v1[0], v1[1]); w.w = cvt_pk_bf16(v1[2], v1[3]);
                    *(u32x4*)(rowp + bj * HALF) = w; } }
    }
};
struct EpiResid {
    static constexpr bool PERM = true;
    const float* X; const bf16_t* Xb; bf16_t* C; const float* gate;
    const float* ssq;
    __device__ __forceinline__ void rowscale(f32x4 (&acc)[2][2][4][2], const Unit& u, int wr, int fr) const {
        int rbase = u.pm * BM + wr * 64 + fr;
        asm volatile("" : "+v"(rbase));
#pragma unroll
        for (int ai = 0; ai < 2; ++ai)
#pragma unroll
            for (int m = 0; m < 4; ++m) { const f32x4 sv = *(const f32x4*)(ssq + (size_t)(rbase + ai * HALF + m * 16) * 4); const float r = rsqrtf(((sv[0] + sv[1]) + (sv[2] + sv[3])) * (1.0f / 256.0f) + EPS);
#pragma unroll
                for (int bj = 0; bj < 2; ++bj)
#pragma unroll
                    for (int n = 0; n < 2; ++n) acc[ai][bj][m][n] *= r; }
    }
    __device__ __forceinline__ void operator()(const f32x4 (&acc)[2][2][4][2], const Unit& u, int wr, int wc, int fr, int fq) const {
        const int row0 = u.pm * BM + wr * 64 + fr, col0 = u.pn * BM + wc * 32 + 8 * fq;
        const float* gp = gate + (size_t)((u.pm * BM) / S) * 6144 + col0;
        f32x4 gv[2][2];
#pragma unroll
        for (int bj = 0; bj < 2; ++bj)
#pragma unroll
            for (int n = 0; n < 2; ++n) gv[bj][n] = *(const f32x4*)(gp + bj * HALF + n * 4);
#pragma unroll
        for (int ai = 0; ai < 2; ++ai)
#pragma unroll
            for (int m = 0; m < 4; ++m) { const size_t off = (size_t)(row0 + ai * HALF + m * 16) * D + col0;
#pragma unroll
                for (int bj = 0; bj < 2; ++bj) {
                    f32x4 x0, x1v;
                    if (Xb) { const u32x4 xw = *(const u32x4*)(Xb + off + bj * HALF); x0 = (f32x4){bflo(xw.x), bfhi(xw.x), bflo(xw.y), bfhi(xw.y)}; x1v = (f32x4){bflo(xw.z), bfhi(xw.z), bflo(xw.w), bfhi(xw.w)}; }
                    else { x0 = *(const f32x4*)(X + off + bj * HALF); x1v = *(const f32x4*)(X + off + bj * HALF + 4); }
                    const f32x4 o0 = x0 + gv[bj][0] * acc[ai][bj][m][0], o1 = x1v + gv[bj][1] * acc[ai][bj][m][1];
                    u32x4 w; w.x = cvt_pk_bf16(o0[0], o0[1]); w.y = cvt_pk_bf16(o0[2], o0[3]); w.z = cvt_pk_bf16(o1[0], o1[1]); w.w = cvt_pk_bf16(o1[2], o1[3]);
                    *(u32x4*)(C + off + bj * HALF) = w; }
                asm volatile("" ::: "memory"); }
    }
};
__device__ __forceinline__ void store_wt16(void* ptr, u32x4 w) { asm volatile("global_store_dwordx4 %0, %1, off sc1\n\ts_nop 1" :: "v"(ptr), "v"(w) : "memory"); }
__device__ __forceinline__ void flag_wait(const int* flag, int want) {
    while (__hip_atomic_load(flag, __ATOMIC_RELAXED, __HIP_MEMORY_SCOPE_AGENT) < want) __builtin_amdgcn_s_sleep(1);
    __builtin_amdgcn_fence(__ATOMIC_ACQUIRE, "agent");
    asm volatile("s_waitcnt vmcnt(0)" ::: "memory");
}
struct EpiHid {
    static constexpr bool PERM = true;
    bf16_t* H;
    __device__ __forceinline__ void operator()(const f32x4 (&acc)[2][2][4][2], const Unit& u, int wr, int wc, int fr, int fq) const {
        const int row0 = u.pm * BM + wr * 64 + fr, col0 = u.pn * HALF + wc * 32 + 8 * fq;
#pragma unroll
        for (int ai = 0; ai < 2; ++ai)
#pragma unroll
            for (int m = 0; m < 4; ++m) { float h[8];
#pragma unroll
                for (int n = 0; n < 2; ++n)
#pragma unroll
                    for (int j = 0; j < 4; ++j) h[n * 4 + j] = silu_fast(acc[ai][0][m][n][j]) * acc[ai][1][m][n][j];
                u32x4 w; w.x = cvt_pk_bf16(h[0], h[1]); w.y = cvt_pk_bf16(h[2], h[3]); w.z = cvt_pk_bf16(h[4], h[5]); w.w = cvt_pk_bf16(h[6], h[7]);
                store_wt16(H + (size_t)(row0 + ai * HALF + m * 16) * F + col0, w); }
    }
};
struct EpiDown {
    static constexpr bool PERM = true;
    bf16_t* Y; const float* lgate;
    __device__ __forceinline__ void operator()(const f32x4 (&acc)[2][2][4][2], const Unit& u, int wr, int wc, int fr, int fq) const {
        const int rl0 = wr * 64 + fr, col0 = u.pn * BM + wc * 32 + 8 * fq;
        const float* gp = lgate + (size_t)u.e * NTOK + u.mt * BM;
#pragma unroll
        for (int ai = 0; ai < 2; ++ai)
#pragma unroll
            for (int m = 0; m < 4; ++m) { const int rl = rl0 + ai * HALF + m * 16; const float g = (u.mt * BM + rl < u.cnt) ? gp[rl] : 0.f;
                bf16_t* rowp = Y + (size_t)(u.pm * BM + rl) * D + col0;
#pragma unroll
                for (int bj = 0; bj < 2; ++bj) { const f32x4 v0 = acc[ai][bj][m][0] * g, v1 = acc[ai][bj][m][1] * g;
                    u32x4 w; w.x = cvt_pk_bf16(v0[0], v0[1]); w.y = cvt_pk_bf16(v0[2], v0[3]); w.z = cvt_pk_bf16(v1[0], v1[1]); w.w = cvt_pk_bf16(v1[2], v1[3]);
                    *(u32x4*)(rowp + bj * HALF) = w; } }
    }
};

template <class Epi, class Sched, bool RSC = false>
__device__ __forceinline__ void gemm_phase(LAS unsigned char* lds, const Sched& S, const Epi& E) {
    const int tid = opaque_tid(), wid = __builtin_amdgcn_readfirstlane(tid >> 6), lane = tid & 63, wr = wid >> 2, wc = wid & 3, fr = lane & 15, fq = lane >> 4;
    const int K = S.K, nt = K / BK;
    int Rr[2], Cc[2]; unsigned voffB[2];
#pragma unroll
    for (int i = 0; i < 2; ++i) { stage_rc(tid * 16 + i * 8192, Rr[i], Cc[i]); const int Rb = Epi::PERM ? ((Rr[i] & ~31) + perm32(Rr[i] & 31)) : Rr[i]; voffB[i] = (unsigned)(Rb * K + Cc[i]) * 2u; }
    const size_t kstep = (size_t)(BK * 2);
    const size_t hstep = (size_t)HALF * K * 2;
    const unsigned ldsw = (unsigned)wid * 1024u;
    const int aoff = lds_byte(wr * 64 + fr, fq * 8), boff = lds_byte(wc * 32 + fr, fq * 8);
#define PG8_SA(b, h) (((b) * 2 + (h)) * HTB)
#define PG8_SB(b, h) ((4 + (b) * 2 + (h)) * HTB)
#define PG8_STAGE(bufoff, gbase, voff) do { _Pragma("unroll") for (int _i = 0; _i < 2; ++_i) \
        __builtin_amdgcn_global_load_lds((const unsigned*)((const char*)(gbase) + (voff)[_i]), (LAS unsigned*)(lds + (bufoff) + ldsw + _i * 8192), 16, 0, 0); } while (0)
#define PG8_LDA(dst, b, h) do { _Pragma("unroll") for (int m = 0; m < 4; ++m) _Pragma("unroll") for (int k = 0; k < 2; ++k) dst[m][k] = *(const LAS bf16x8*)(lds + PG8_SA(b, h) + aoff + m * 2048 + k * 1024); } while (0)
#define PG8_LDB(dst, b, h) do { _Pragma("unroll") for (int n = 0; n < 2; ++n) _Pragma("unroll") for (int k = 0; k < 2; ++k) dst[n][k] = *(const LAS bf16x8*)(lds + PG8_SB(b, h) + boff + n * 2048 + k * 1024); } while (0)
#define PG8_MMA(ai, bj, At, Bt) do { __builtin_amdgcn_s_setprio(1); _Pragma("unroll") for (int m = 0; m < 4; ++m) _Pragma("unroll") for (int n = 0; n < 2; ++n) _Pragma("unroll") for (int k = 0; k < 2; ++k) \
        acc[ai][bj][m][n] = __builtin_amdgcn_mfma_f32_16x16x32_bf16(Bt[n][k], At[m][k], acc[ai][bj][m][n], 0, 0, 0); __builtin_amdgcn_s_setprio(0); } while (0)
#define PG8_WAIT_V(n) asm volatile("s_waitcnt vmcnt(" #n ")" ::: "memory")
#define PG8_WAIT_L(n) asm volatile("s_waitcnt lgkmcnt(" #n ")" ::: "memory")
#define PG8_BAR __builtin_amdgcn_s_barrier()
#define PG8_SCHED __builtin_amdgcn_sched_barrier(0)
    Unit cur, nxt; int ui = 0;
    if (!S.next(0, cur)) return;
    if constexpr (Sched::SYNC == 2) { if (wid == 0) flag_wait(S.flag + cur.pm * 8, 4); __builtin_amdgcn_s_barrier(); }
    f32x4 acc[2][2][4][2];
#pragma unroll
    for (int a = 0; a < 2; ++a)
#pragma unroll
        for (int b = 0; b < 2; ++b)
#pragma unroll
            for (int m = 0; m < 4; ++m)
#pragma unroll
                for (int n = 0; n < 2; ++n) acc[a][b][m][n] = (f32x4){0.f, 0.f, 0.f, 0.f};
    bf16x8 At[4][2], B0[2][2], B1[2][2];
    unsigned vA0[2], vA1[2], vN0[2], vN1[2];
#pragma unroll
    for (int i = 0; i < 2; ++i) { vA0[i] = S.a_voff(cur, Rr[i], Cc[i]); vA1[i] = S.a_voff(cur, HALF + Rr[i], Cc[i]); }
    const char* cA = S.a_base(cur); const char* cB = S.b_base(cur);
    PG8_STAGE(PG8_SB(0, 0), cB, voffB); PG8_STAGE(PG8_SB(0, 1), cB + hstep, voffB); PG8_STAGE(PG8_SA(0, 0), cA, vA0); PG8_STAGE(PG8_SA(0, 1), cA, vA1);
    if (wr == 1) PG8_BAR;
    PG8_WAIT_V(2); PG8_BAR;
    PG8_STAGE(PG8_SB(1, 0), cB + kstep, voffB); PG8_STAGE(PG8_SA(1, 0), cA + kstep, vA0); PG8_STAGE(PG8_SB(1, 1), cB + hstep + kstep, voffB);
    PG8_WAIT_V(6); PG8_BAR;
    for (;;) {
        const bool has_next = S.next(ui + 1, nxt);
        const char* nA = has_next ? S.a_base(nxt) : cA; const char* nB = has_next ? S.b_base(nxt) : cB;
#pragma unroll
        for (int i = 0; i < 2; ++i) { vN0[i] = has_next ? S.a_voff(nxt, Rr[i], Cc[i]) : vA0[i]; vN1[i] = has_next ? S.a_voff(nxt, HALF + Rr[i], Cc[i]) : vA1[i]; }
        for (int t = 0; t < nt; t += 2) {
            const bool last = (t == nt - 2);
            if constexpr (Sched::SYNC == 2) { if (last && has_next && wid == 0) flag_wait(S.flag + nxt.pm * 8, 4); }
            if constexpr (RSC) { if (t == 4) E.rowscale(acc, cur, wr, fr); }
            const char* a1 = cA + (size_t)(t + 1) * kstep;
            const char* a2 = last ? nA : cA + (size_t)(t + 2) * kstep; const char* b2 = last ? nB : cB + (size_t)(t + 2) * kstep;
            const char* a3 = a2 + kstep; const char* b3 = b2 + kstep;
            unsigned w0[2], w1[2];
#pragma unroll
            for (int i = 0; i < 2; ++i) { w0[i] = last ? vN0[i] : vA0[i]; w1[i] = last ? vN1[i] : vA1[i]; }
            PG8_LDB(B0, 0, 0); PG8_LDB(B1, 0, 1); PG8_SCHED; PG8_LDA(At, 0, 0); PG8_STAGE(PG8_SA(1, 1), a1, vA1);
            PG8_WAIT_V(8); PG8_WAIT_L(0); PG8_BAR; PG8_MMA(0, 0, At, B0); PG8_MMA(0, 1, At, B1); PG8_BAR; PG8_SCHED;
            PG8_LDA(At, 0, 1); PG8_STAGE(PG8_SB(0, 0), b2, voffB); PG8_STAGE(PG8_SB(0, 1), b2 + hstep, voffB); PG8_STAGE(PG8_SA(0, 0), a2, w0);
            PG8_WAIT_V(8); PG8_WAIT_L(0); PG8_BAR; PG8_MMA(1, 0, At, B0); PG8_MMA(1, 1, At, B1); PG8_BAR; PG8_SCHED;
            PG8_LDB(B0, 1, 0); PG8_LDB(B1, 1, 1); PG8_SCHED; PG8_LDA(At, 1, 0); PG8_STAGE(PG8_SA(0, 1), a2, w1);
            PG8_WAIT_V(8); PG8_WAIT_L(0); PG8_BAR; PG8_MMA(0, 0, At, B0); PG8_MMA(0, 1, At, B1); PG8_BAR; PG8_SCHED;
            PG8_LDA(At, 1, 1); PG8_STAGE(PG8_SB(1, 0), b3, voffB); PG8_STAGE(PG8_SB(1, 1), b3 + hstep, voffB); PG8_STAGE(PG8_SA(1, 0), a3, w0);
            PG8_WAIT_V(8); PG8_WAIT_L(0); PG8_BAR; PG8_MMA(1, 0, At, B0); PG8_MMA(1, 1, At, B1); PG8_BAR; PG8_SCHED;
        }
        if (wr == 0) PG8_BAR;
        E(acc, cur, wr, wc, fr, fq);
        if constexpr (Sched::SYNC == 1) { PG8_WAIT_V(0); PG8_BAR; if (tid == 0) __hip_atomic_fetch_add(S.flag + cur.pm * 8, 1, __ATOMIC_RELAXED, __HIP_MEMORY_SCOPE_AGENT); }
        if (!has_next) break;
#pragma unroll
        for (int a = 0; a < 2; ++a)
#pragma unroll
            for (int b = 0; b < 2; ++b)
#pragma unroll
                for (int m = 0; m < 4; ++m)
#pragma unroll
                    for (int n = 0; n < 2; ++n) acc[a][b][m][n] = (f32x4){0.f, 0.f, 0.f, 0.f};
        cur = nxt; cA = nA; cB = nB; ++ui;
#pragma unroll
        for (int i = 0; i < 2; ++i) { vA0[i] = vN0[i]; vA1[i] = vN1[i]; }
        if (wr == 1) PG8_BAR;
    }
    PG8_WAIT_V(0);
    PG8_BAR;
#undef PG8_SA
#undef PG8_SB
#undef PG8_STAGE
#undef PG8_LDA
#undef PG8_LDB
#undef PG8_MMA
#undef PG8_WAIT_V
#undef PG8_WAIT_L
#undef PG8_BAR
#undef PG8_SCHED
}
}
struct Args { const void* in[32]; float* out; unsigned char* ws; int l_lo, l_hi, ph_lo, ph_hi, fused, pad; };
enum { PH_PRO = 0, PH_NORM0 = 1, PH_G1 = 2, PH_MIX = 3, PH_A1 = 4, PH_A2 = 5, PH_AN = 6, PH_G2 = 7, PH_ROUTE = 8, PH_UP = 9, PH_DOWN = 10, PH_COMB = 11, PH_END = 12 };

typedef const Args __attribute__((address_space(4))) KArgs;
__device__ __forceinline__ KArgs* kargs() { KArgs* p = (KArgs*)__builtin_amdgcn_kernarg_segment_ptr(); asm volatile("" : "+s"(p)); return p; }
#define IN_F(i) ((const float*)ka->in[i])
enum { I_X = 0, I_C, I_POS, I_WADA, I_BADA, I_NORM1, I_WIN, I_QN, I_KN, I_CONVW, I_CONVB, I_CLNG, I_CLNB, I_PWW, I_PWB, I_POOLW, I_POOLB, I_POOLS, I_SLNG, I_SLNB, I_SGUW, I_SGUB,
       I_ONORM, I_WOUT, I_NORM2, I_WRG, I_BRG, I_WRE, I_BRE, I_WG, I_WU, I_WD };

__device__ __forceinline__ void sincos_d(double a, double& s, double& c) {
    const double k = rint(a * 0.63661977236758134308);
    const double r = (a - k * 1.57079632679489655800) - k * 6.123233995736766036e-17;
    const double r2 = r * r;
    const double sp = r * (1.0 + r2 * (-1.0 / 6 + r2 * (1.0 / 120 + r2 * (-1.0 / 5040 + r2 * (1.0 / 362880 + r2 * (-1.0 / 39916800 + r2 * (1.0 / 6227020800.0)))))));
    const double cp = 1.0 + r2 * (-0.5 + r2 * (1.0 / 24 + r2 * (-1.0 / 720 + r2 * (1.0 / 40320 + r2 * (-1.0 / 3628800 + r2 * (1.0 / 479001600.0 + r2 * (-1.0 / 87178291200.0)))))));
    const int q = ((int)k) & 3;
    if (q == 0) { s = sp; c = cp; } else if (q == 1) { s = cp; c = -sp; } else if (q == 2) { s = -sp; c = -cp; } else { s = -cp; c = sp; }
}

__device__ __forceinline__ bf16_t f2bf_(float f) { return (bf16_t)(cvt_pk_bf16(f, 0.f) & 0xffffu); }
struct TItem { const float* src; int ld; int ncol; bf16_t* dst; int ldd; const float* rsc; };
constexpr int NT_WIN = L * 36 * 4, NT_WOUT = L * 16 * 4, NT_PW = L * 4, NT_WGU = L * NE * 16 * 4, NT_WD = L * NE * 16 * 2;
constexpr int NT_ALL = NT_WIN + NT_WOUT + NT_PW + NT_WGU + NT_WD;
__device__ __forceinline__ void decode_titem(int it, const Args& a, TItem& t) {
    KArgs* ka = kargs();
    unsigned char* ws = ka->ws;
    t.rsc = nullptr;
    if (it < NT_WIN) {
        const int l = it / 144, r = it % 144, n0 = (r >> 2) * 64, k0 = (r & 3) * 256;
        const int c0 = n0 < 768 ? n0 + 256 : (n0 < 2048 ? n0 + 164 : n0 - 2048);
        t.ncol = (n0 < 768) ? ((n0 + 64 <= 676) ? 64 : (n0 < 676 ? 676 - n0 : 0)) : 64;
        t.src = IN_F(I_WIN) + ((size_t)l * D + k0) * DIN + c0; t.ld = DIN;
        t.dst = (bf16_t*)(ws + WS_WINT) + ((size_t)l * NP + n0) * D + k0; t.ldd = D; return;
    }
    it -= NT_WIN;
    if (it < NT_WOUT) {
        const int l = it / 64, r = it % 64, n0 = (r >> 2) * 64, k0 = (r & 3) * 256;
        t.ncol = 64; t.src = IN_F(I_WOUT) + ((size_t)l * D + k0) * D + n0; t.ld = D; t.rsc = (k0 == 0) ? IN_F(I_ONORM) + l * D : nullptr;
        t.dst = (bf16_t*)(ws + WS_WOUTT) + ((size_t)l * D + n0) * D + k0; t.ldd = D; return;
    }
    it -= NT_WOUT;
    if (it < NT_PW) {
        const int l = it / 4, n0 = (it & 3) * 64;
        t.ncol = 64; t.src = IN_F(I_PWW) + (size_t)l * 65536 + n0; t.ld = 256;
        t.dst = (bf16_t*)(ws + WS_PWT) + ((size_t)l * 256 + n0) * 256; t.ldd = 256; return;
    }
    it -= NT_PW;
    if (it < NT_WGU) {
        const int le = it / 64, r = it % 64, n0 = (r >> 2) * 64, k0 = (r & 3) * 256;
        const int pn = n0 >> 8, rr = n0 & 255;
        const float* W = (rr < 128) ? IN_F(I_WG) : IN_F(I_WU);
        t.ncol = 64; t.src = W + ((size_t)le * D + k0) * F + pn * 128 + (rr & 127); t.ld = F;
        t.dst = (bf16_t*)(ws + WS_WGUT) + ((size_t)le * 1024 + n0) * D + k0; t.ldd = D; return;
    }
    it -= NT_WGU;
    {
        const int le = it / 32, r = it % 32, n0 = (r >> 1) * 64, k0 = (r & 1) * 256;
        t.ncol = 64; t.src = IN_F(I_WD) + ((size_t)le * F + k0) * D + n0; t.ld = D;
        t.dst = (bf16_t*)(ws + WS_WDT) + ((size_t)le * D + n0) * F + k0; t.ldd = F;
    }
}
__device__ __forceinline__ void titem_load(const TItem& t, int tid, float4 (&v)[8]) {
    const int c4 = tid & 15, r0 = tid >> 4;
#pragma unroll
    for (int i = 0; i < 8; ++i) v[i] = (c4 * 4 < t.ncol) ? *(const float4*)(t.src + (size_t)(r0 + 32 * i) * t.ld + c4 * 4) : make_float4(0.f, 0.f, 0.f, 0.f);
    if (t.rsc) {
#pragma unroll
        for (int i = 0; i < 8; ++i) { const float s = t.rsc[r0 + 32 * i]; v[i].x *= s; v[i].y *= s; v[i].z *= s; v[i].w *= s; }
    }
}
__device__ __forceinline__ void phase_prologue(const Args& a, LAS unsigned char* lds, int vcu, int G) {
    KArgs* ka = kargs();
    const int tid = opaque_tid(), wid = __builtin_amdgcn_readfirstlane(tid >> 6), lane = tid & 63;
    LAS float* T = (LAS float*)lds;
    LAS float* cs = (LAS float*)(lds + 66560);
    LAS float* red = (LAS float*)(lds + 66560 + 16384);
    unsigned char* ws = ka->ws;
    if (vcu < 192) {
        for (int i = tid; i < 4096; i += NTHR) cs[i] = silu_f(IN_F(I_C)[i]);
        __syncthreads();
        for (int it = vcu; it < 192; it += G) {
            const int l = it / 96, j0 = (it % 96) * 64;
            const float* wp = IN_F(I_WADA) + ((size_t)l * D + wid * 128) * 6144 + j0 + lane;
            float a0 = 0.f, a1 = 0.f, a2 = 0.f, a3 = 0.f;
#pragma unroll 32
            for (int k = 0; k < 128; ++k) { const float wv = wp[(size_t)k * 6144]; const int kk = wid * 128 + k; a0 += cs[kk] * wv; a1 += cs[1024 + kk] * wv; a2 += cs[2048 + kk] * wv; a3 += cs[3072 + kk] * wv; }
            red[(wid * 4 + 0) * 64 + lane] = a0; red[(wid * 4 + 1) * 64 + lane] = a1; red[(wid * 4 + 2) * 64 + lane] = a2; red[(wid * 4 + 3) * 64 + lane] = a3;
            __syncthreads();
            if (wid < 4) { float s = 0.f;
#pragma unroll
                for (int w = 0; w < 8; ++w) s += red[(w * 4 + wid) * 64 + lane];
                ((float*)(ws + WS_MOD))[((size_t)l * 4 + wid) * 6144 + j0 + lane] = s + IN_F(I_BADA)[l * 6144 + j0 + lane]; }
            __syncthreads();
        }
    }
    for (int i = vcu * NTHR + tid; i < NTOK; i += G * NTHR) {
        const float invA[8] = {1.0f, 0.1939227432012558f, 0.03760603070259094f, 0.007292664609849453f, 0.0014142135623842478f, 0.00027424818836152554f, 5.318296098266728e-05f, 1.0313386155758053e-05f};
        const float invI[4] = {1.0f, 0.03760603070259094f, 0.0014142135623842478f, 5.318296098266728e-05f};
        const float p = (float)((const int*)ka->in[I_POS])[i];
        float* ra = (float*)(ws + WS_ROPEA) + (size_t)i * 16; float* ri = (float*)(ws + WS_ROPEI) + (size_t)i * 8;
#pragma unroll
        for (int j = 0; j < 8; ++j) { const float ang = p * invA[j]; double s, c; sincos_d((double)ang, s, c); ra[j] = (float)c; ra[8 + j] = (float)s; }
#pragma unroll
        for (int j = 0; j < 4; ++j) { const float ang = p * invI[j]; double s, c; sincos_d((double)ang, s, c); ri[j] = (float)c; ri[4 + j] = (float)s; }
    }
    for (int i = vcu * NTHR + tid; i < L * 4 * 128 * 128; i += G * NTHR) { const int s = i & 127, t = (i >> 7) & 127; ((bf16_t*)(ws + WS_SGUW))[i] = (bf16_t)(cvt_pk_bf16(s <= t ? IN_F(I_SGUW)[i] : 0.f, 0.f) & 0xffffu); }
    for (int i = vcu * NTHR + tid; i < L * 4 * 64 * 64; i += G * NTHR) { const int c = i & 63, d = (i >> 6) & 63, lg = i >> 12; ((bf16_t*)(ws + WS_POOLT))[i] = (bf16_t)(cvt_pk_bf16(IN_F(I_POOLW)[((size_t)lg * 64 + c) * 64 + d], 0.f) & 0xffffu); }
    for (int i = vcu * NTHR + tid; i < L * 48 * 1024; i += G * NTHR) {
        const int k = i & 1023, n = (i >> 10) % 48, lg = i / (48 * 1024);
        const float w = (n < 4) ? IN_F(I_WRG)[((size_t)lg * D + k) * 4 + n] : (n < 36) ? IN_F(I_WRE)[((size_t)lg * D + k) * 32 + (n - 4)] : 0.f;
        const unsigned hi = cvt_pk_bf16(w, 0.f) & 0xffffu; const float lo = w - __uint_as_float(hi << 16);
        bf16_t* dst = (bf16_t*)(ws + WS_WHL) + (size_t)lg * 2 * 48 * 1024 + (size_t)n * 1024 + k;
        dst[0] = (bf16_t)hi; dst[48 * 1024] = f2bf_(lo);
    }
    int it = (G - 1 - vcu);
    bool have = it < NT_ALL;
    TItem cur; cur.src = nullptr; cur.ld = 0; cur.ncol = 0; cur.dst = nullptr; cur.ldd = 0; cur.rsc = nullptr;
    float4 v[8];
    if (have) { decode_titem(it, a, cur); titem_load(cur, tid, v); }
    while (have) {
        { const int c4 = tid & 15, r0 = tid >> 4;
#pragma unroll
          for (int i = 0; i < 8; ++i) { LAS float* tp = T + (r0 + 32 * i) * 65 + c4 * 4; tp[0] = v[i].x; tp[1] = v[i].y; tp[2] = v[i].z; tp[3] = v[i].w; } }
        __syncthreads();
        const int itn = it + G; const bool hn = itn < NT_ALL; TItem nx = cur;
        if (hn) { decode_titem(itn, a, nx); titem_load(nx, tid, v); }
        { const int n = tid >> 3, kq = tid & 7;
#pragma unroll
          for (int j = 0; j < 4; ++j) { const int kc = j * 8 + kq; float f[8];
#pragma unroll
              for (int jj = 0; jj < 8; ++jj) f[jj] = T[(kc * 8 + jj) * 65 + n];
              u32x4 w; w.x = cvt_pk_bf16(f[0], f[1]); w.y = cvt_pk_bf16(f[2], f[3]); w.z = cvt_pk_bf16(f[4], f[5]); w.w = cvt_pk_bf16(f[6], f[7]);
              *(u32x4*)(cur.dst + (size_t)n * cur.ldd + kc * 8) = w; } }
        __syncthreads();
        cur = nx; it = itn; have = hn;
    }
}

__device__ __forceinline__ void phase_norm(const float* __restrict__ xin, const float* g, const float* shift, const float* scale, bf16_t* __restrict__ out, int vcu, int G) {
    const int tid = opaque_tid(), wid = __builtin_amdgcn_readfirstlane(tid >> 6), lane = tid & 63;
    for (int rb = vcu * 8 + wid; rb < NTOK / 8; rb += G * 8) {
        const int row0 = rb * 8, b = row0 / S;
        float4 A[4], C[4];
#pragma unroll
        for (int i = 0; i < 4; ++i) { const int k = 256 * i + 4 * lane; const float4 gv = *(const float4*)(g + k), sc = *(const float4*)(scale + (size_t)b * 6144 + k); C[i] = *(const float4*)(shift + (size_t)b * 6144 + k);
            A[i] = make_float4(gv.x * (1.f + sc.x), gv.y * (1.f + sc.y), gv.z * (1.f + sc.z), gv.w * (1.f + sc.w)); }
#pragma unroll 4
        for (int rr = 0; rr < 8; ++rr) {
            const size_t ro = (size_t)(row0 + rr) * D;
            float4 x[4]; float ss = 0.f;
#pragma unroll
            for (int i = 0; i < 4; ++i) { x[i] = *(const float4*)(xin + ro + 256 * i + 4 * lane); ss += x[i].x * x[i].x + x[i].y * x[i].y + x[i].z * x[i].z + x[i].w * x[i].w; }
            const float r = rsqrtf(wave_sum(ss) * (1.0f / D) + EPS);
#pragma unroll
            for (int i = 0; i < 4; ++i) { u32x2 w; w.x = cvt_pk_bf16(x[i].x * r * A[i].x + C[i].x, x[i].y * r * A[i].y + C[i].y); w.y = cvt_pk_bf16(x[i].z * r * A[i].z + C[i].z, x[i].w * r * A[i].w + C[i].w);
                *(u32x2*)(out + ro + 256 * i + 4 * lane) = w; }
        }
    }
}

__device__ __forceinline__ f32x4 mfma16r(const bf16x8 a, const bf16x8 b, const f32x4 c) { return __builtin_amdgcn_mfma_f32_16x16x32_bf16(a, b, c, 0, 0, 0); }
__device__ __forceinline__ void phase_rbias(const Args& a, LAS unsigned char* lds, int vcu, int G) {
    KArgs* ka = kargs();
    const int tid = opaque_tid();
    LAS float* red = (LAS float*)lds;
    for (int v = vcu; v < 256; v += G) {
        const int lb = v & 7, sl = v >> 3, l = lb >> 2, b = lb & 3, n = tid & 63, kp = tid >> 6;
        const float* sh = (const float*)(ka->ws + WS_MOD) + ((size_t)l * 4 + b) * 6144 + 3072;
        float s = 0.f;
        if (n < 36) {
#pragma unroll
            for (int i = 0; i < 4; ++i) { const int k = sl * 32 + kp * 4 + i; s += sh[k] * ((n < 4) ? IN_F(I_WRG)[((size_t)l * D + k) * 4 + n] : IN_F(I_WRE)[((size_t)l * D + k) * 32 + (n - 4)]); }
        }
        red[kp * 64 + n] = s;
        __syncthreads();
        if (tid < 48) { float t = 0.f;
            if (tid < 36) { for (int w = 0; w < 8; ++w) t += red[w * 64 + tid]; }
            ((float*)(ka->ws + WS_RBIAS))[((size_t)lb * 32 + sl) * 48 + tid] = t; }
        __syncthreads();
    }
}

__device__ __forceinline__ void phase_route(const Args& a, int l, LAS unsigned char* lds, int vcu, int G) {
    KArgs* ka = kargs();
    const int tid = opaque_tid(), wid = __builtin_amdgcn_readfirstlane(tid >> 6), lane = tid & 63, fr = lane & 15, kq = lane >> 4;
    unsigned char* ws = ka->ws;
    const bf16_t* x1 = (const bf16_t*)(ws + WS_X1);
    const float* mod = (const float*)(ws + WS_MOD) + (size_t)l * 4 * 6144;
    const float* g = IN_F(I_NORM2) + l * D; const float* shift = mod + 3072; const float* scale = mod + 4096;
    bf16_t* out = (bf16_t*)(ws + WS_HA);
    int* counts = (int*)(ws + WS_CNT) + l * NE * 64; int* list = (int*)(ws + WS_LIST); float* lgate = (float*)(ws + WS_LGATE); int* tokinfo = (int*)(ws + WS_TOKINFO);
    LAS int* lcnt = (LAS int*)(lds + LDS_MISC + 1024); LAS int* lbase = lcnt + 32; LAS int* rte = lbase + 32; LAS int* rtp = rte + 128; LAS int* rtt = rtp + 128; LAS float* rtg = (LAS float*)(rtt + 128);
    LAS float* part = (LAS float*)lds;
    LAS float* ssp = part + 8 * 16 * 48;
    LAS float* lgt = ssp + 8 * 16;
    LAS float* rrow = lgt + 16 * 48;
    const bf16_t* wh = (const bf16_t*)(ws + WS_WHL) + (size_t)l * 2 * 48 * 1024 + (size_t)fr * 1024 + 128 * wid + 8 * kq;
    LAS float* rb = (LAS float*)(lds + LDS_MISC + 8192);
    for (int r0 = vcu * 64; r0 < NTOK; r0 += G * 64) {
        const int b = r0 / S;
        if (tid < 48) { const float* rp = (const float*)(ws + WS_RBIAS) + ((size_t)(l * 4 + b) * 32) * 48 + tid; float t = 0.f;
            for (int sl = 0; sl < 32; ++sl) t += rp[sl * 48];
            if (tid < 36) t += (tid < 4) ? IN_F(I_BRG)[l * 4 + tid] : IN_F(I_BRE)[l * 32 + tid - 4];
            rb[tid] = t; }
        if (tid < 32) lcnt[tid] = 0;
#pragma unroll 1
        for (int q4 = 0; q4 < 4; ++q4) {
            float t[4][8];
            f32x4 acc[3];
#pragma unroll
            for (int nt = 0; nt < 3; ++nt) acc[nt] = (f32x4){0.f, 0.f, 0.f, 0.f};
            float ss = 0.f;
            const int row = r0 + 16 * q4 + fr;
#pragma unroll
            for (int ks = 0; ks < 4; ++ks) {
                const int k0 = 128 * wid + 32 * ks + 8 * kq;
                const f32x4 g0 = *(const f32x4*)(g + k0), g1 = *(const f32x4*)(g + k0 + 4), s0 = *(const f32x4*)(scale + (size_t)b * 6144 + k0), s1 = *(const f32x4*)(scale + (size_t)b * 6144 + k0 + 4);
                const float Ac[8] = {g0[0] * (1.f + s0[0]), g0[1] * (1.f + s0[1]), g0[2] * (1.f + s0[2]), g0[3] * (1.f + s0[3]), g1[0] * (1.f + s1[0]), g1[1] * (1.f + s1[1]), g1[2] * (1.f + s1[2]), g1[3] * (1.f + s1[3])};
                const u32x4 xw = *(const u32x4*)(x1 + (size_t)row * D + k0);
                const float v[8] = {bflo(xw.x), bfhi(xw.x), bflo(xw.y), bfhi(xw.y), bflo(xw.z), bfhi(xw.z), bflo(xw.w), bfhi(xw.w)};
                unsigned ph[4], pl[4];
#pragma unroll
                for (int j = 0; j < 8; ++j) { ss += v[j] * v[j]; t[ks][j] = v[j] * Ac[j]; }
#pragma unroll
                for (int j = 0; j < 4; ++j) { ph[j] = cvt_pk_bf16(t[ks][2 * j], t[ks][2 * j + 1]); pl[j] = cvt_pk_bf16(t[ks][2 * j] - bflo(ph[j]), t[ks][2 * j + 1] - bfhi(ph[j])); }
                const bf16x8 Ah = __builtin_bit_cast(bf16x8, (u32x4){ph[0], ph[1], ph[2], ph[3]}), Al = __builtin_bit_cast(bf16x8, (u32x4){pl[0], pl[1], pl[2], pl[3]});
#pragma unroll
                for (int nt = 0; nt < 3; ++nt) {
                    const bf16x8 Bh = *(const bf16x8*)(wh + (size_t)(16 * nt) * 1024 + 32 * ks), Bl = *(const bf16x8*)(wh + 48 * 1024 + (size_t)(16 * nt) * 1024 + 32 * ks);
                    acc[nt] = mfma16r(Ah, Bh, acc[nt]); acc[nt] = mfma16r(Al, Bh, acc[nt]); acc[nt] = mfma16r(Ah, Bl, acc[nt]);
                }
            }
            ss += __shfl_xor(ss, 16); ss += __shfl_xor(ss, 32);
            if (kq == 0) ssp[wid * 16 + fr] = ss;
#pragma unroll
            for (int nt = 0; nt < 3; ++nt)
#pragma unroll
                for (int r = 0; r < 4; ++r) part[(wid * 16 + 4 * kq + r) * 48 + 16 * nt + fr] = acc[nt][r];
            __syncthreads();
            for (int i = tid; i < 16 * 48; i += NTHR) { float s = 0.f;
#pragma unroll
                for (int w = 0; w < 8; ++w) s += part[w * 16 * 48 + i];
                lgt[i] = s; }
            if (tid < 16) { float s = 0.f;
#pragma unroll
                for (int w = 0; w < 8; ++w) s += ssp[w * 16 + tid];
                rrow[tid] = rsqrtf(s * (1.0f / D) + EPS); }
            __syncthreads();
            if (tid < 16) {
                const int tok = r0 + 16 * q4 + tid; const float r = rrow[tid];
                float ag[4];
#pragma unroll
                for (int j = 0; j < 4; ++j) ag[j] = r * lgt[tid * 48 + j] + rb[j];
                int gi = 0; float gm = ag[0];
#pragma unroll
                for (int j = 1; j < 4; ++j) if (ag[j] > gm) { gm = ag[j]; gi = j; }
                float den = 0.f;
#pragma unroll
                for (int j = 0; j < 4; ++j) den += expf(ag[j] - gm);
                const float p_sel = 1.0f / den;
                float el[8];
#pragma unroll
                for (int j = 0; j < 8; ++j) el[j] = r * lgt[tid * 48 + 4 + gi * 8 + j] + rb[4 + gi * 8 + j];
                int j0 = 0; float v0 = el[0];
#pragma unroll
                for (int j = 1; j < 8; ++j) if (el[j] > v0) { v0 = el[j]; j0 = j; }
                int j1 = 0; float v1 = -INFINITY;
#pragma unroll
                for (int j = 0; j < 8; ++j) if (j != j0 && el[j] > v1) { v1 = el[j]; j1 = j; }
                const float e1 = expf(v1 - v0);
                const float g0 = p_sel / (1.0f + e1), g1 = p_sel * e1 / (1.0f + e1);
                const int ex0 = gi * 8 + j0, ex1 = gi * 8 + j1, ai = (16 * q4 + tid) * 2;
                const int p0 = __hip_atomic_fetch_add(lcnt + ex0, 1, __ATOMIC_RELAXED, __HIP_MEMORY_SCOPE_WORKGROUP), p1 = __hip_atomic_fetch_add(lcnt + ex1, 1, __ATOMIC_RELAXED, __HIP_MEMORY_SCOPE_WORKGROUP);
                rte[ai] = ex0; rtp[ai] = p0; rtt[ai] = tok; rtg[ai] = g0;
                rte[ai + 1] = ex1; rtp[ai + 1] = p1; rtt[ai + 1] = tok; rtg[ai + 1] = g1;
            }
            {
                const float r = rrow[fr];
                bf16_t* op = out + (size_t)row * D + 128 * wid + 8 * kq;
#pragma unroll
                for (int ks = 0; ks < 4; ++ks) {
                    const float* cp = shift + (size_t)b * 6144 + 128 * wid + 32 * ks + 8 * kq;
                    const f32x4 c0 = *(const f32x4*)cp, c1 = *(const f32x4*)(cp + 4);
                    u32x4 w; w.x = cvt_pk_bf16(t[ks][0] * r + c0[0], t[ks][1] * r + c0[1]); w.y = cvt_pk_bf16(t[ks][2] * r + c0[2], t[ks][3] * r + c0[3]);
                    w.z = cvt_pk_bf16(t[ks][4] * r + c1[0], t[ks][5] * r + c1[1]); w.w = cvt_pk_bf16(t[ks][6] * r + c1[2], t[ks][7] * r + c1[3]);
                    *(u32x4*)(op + 32 * ks) = w;
                }
            }
            __syncthreads();
        }
        if (tid < 32) { const int c = lcnt[tid]; lbase[tid] = c ? atomicAdd(&counts[tid * 64], c) : 0; }
        __syncthreads();
        if (tid < 128) { const int e = rte[tid], pos = lbase[e] + rtp[tid], tk = rtt[tid];
            list[(size_t)e * NTOK + pos] = tk; lgate[(size_t)e * NTOK + pos] = rtg[tid];
            tokinfo[tk * 4 + (tid & 1) * 2] = e; tokinfo[tk * 4 + (tid & 1) * 2 + 1] = pos; }
        __syncthreads();
    }
}

__device__ __forceinline__ void moe_cum(const Args& a, int l, LAS unsigned char* lds) {
    KArgs* ka = kargs();
    LAS int* cum = (LAS int*)(lds + LDS_MISC + MISC_CUM); LAS int* cn = (LAS int*)(lds + LDS_MISC + MISC_CNT);
    const int* counts = (const int*)(ka->ws + WS_CNT) + l * NE * 64;
    const int tq = opaque_tid();
    if (tq < 33) { int s = 0; for (int j = 0; j < tq; ++j) s += (ld_agent(counts + j * 64) + 255) >> 8; cum[tq] = s; if (tq < 32) cn[tq] = ld_agent(counts + tq * 64); }
    __syncthreads();
}

__device__ __forceinline__ void phase_combine(const Args& a, int l, LAS unsigned char* lds, int vcu, int G) {
    KArgs* ka = kargs();
    const int tid = opaque_tid(), wid = __builtin_amdgcn_readfirstlane(tid >> 6), lane = tid & 63;
    unsigned char* ws = ka->ws;
    moe_cum(a, l, lds);
    const LAS int* cum = (const LAS int*)(lds + LDS_MISC + MISC_CUM);
    const bf16_t* __restrict__ x1 = (const bf16_t*)(ws + WS_X1);
    bf16_t* __restrict__ xnext = (bf16_t*)(ws + WS_X1) + (size_t)NTOK * D;
    const float* mod = (const float*)(ws + WS_MOD) + (size_t)l * 4 * 6144;
    const float* gate2 = mod + 5120;
    const bf16_t* __restrict__ Y = (const bf16_t*)(ws + WS_Y);
    const int* __restrict__ tokinfo = (const int*)(ws + WS_TOKINFO);
    float* __restrict__ outp = ka->out;
    const bool nextl = (l + 1 < L);
    const float* modn = (const float*)(ws + WS_MOD) + (size_t)(nextl ? l + 1 : l) * 4 * 6144;
    const float* gn = IN_F(I_NORM1) + (nextl ? l + 1 : l) * D;
    bf16_t* __restrict__ hout = (bf16_t*)(ws + WS_HA);
    for (int rb = vcu * 8 + wid; rb < NTOK / 8; rb += G * 8) {
        const int row0 = rb * 8, b = row0 / S;
        float4 A[4], C[4], G2[4];
#pragma unroll
        for (int i = 0; i < 4; ++i) { const int k = 256 * i + 4 * lane; const float4 gv = *(const float4*)(gn + k), sc = *(const float4*)(modn + 1024 + (size_t)b * 6144 + k); C[i] = *(const float4*)(modn + (size_t)b * 6144 + k);
            A[i] = make_float4(gv.x * (1.f + sc.x), gv.y * (1.f + sc.y), gv.z * (1.f + sc.z), gv.w * (1.f + sc.w)); G2[i] = *(const float4*)(gate2 + (size_t)b * 6144 + k); }
#pragma unroll 4
        for (int rr = 0; rr < 8; ++rr) {
            const int tok = row0 + rr; const size_t ro = (size_t)tok * D;
            const int4 ti = *(const int4*)(tokinfo + tok * 4);
            const size_t s0 = (size_t)(cum[ti.x] * 256 + ti.y) * D, s1 = (size_t)(cum[ti.z] * 256 + ti.w) * D;
            float4 xo[4]; float ss = 0.f;
#pragma unroll
            for (int i = 0; i < 4; ++i) { const int k = 256 * i + 4 * lane; const u32x2 xw = *(const u32x2*)(x1 + ro + k); const float4 xv = make_float4(bflo(xw.x), bfhi(xw.x), bflo(xw.y), bfhi(xw.y)); const u32x2 y0 = *(const u32x2*)(Y + s0 + k), y1 = *(const u32x2*)(Y + s1 + k);
                xo[i].x = xv.x + G2[i].x * (bflo(y0.x) + bflo(y1.x)); xo[i].y = xv.y + G2[i].y * (bfhi(y0.x) + bfhi(y1.x)); xo[i].z = xv.z + G2[i].z * (bflo(y0.y) + bflo(y1.y)); xo[i].w = xv.w + G2[i].w * (bfhi(y0.y) + bfhi(y1.y));
                if (nextl) { u32x2 xb; xb.x = cvt_pk_bf16(xo[i].x, xo[i].y); xb.y = cvt_pk_bf16(xo[i].z, xo[i].w); *(u32x2*)(xnext + ro + k) = xb; } else *(float4*)(outp + ro + k) = xo[i];
                ss += xo[i].x * xo[i].x + xo[i].y * xo[i].y + xo[i].z * xo[i].z + xo[i].w * xo[i].w; }
            if (nextl) {
                const float r = rsqrtf(wave_sum(ss) * (1.0f / D) + EPS);
#pragma unroll
                for (int i = 0; i < 4; ++i) { u32x2 w; w.x = cvt_pk_bf16(xo[i].x * r * A[i].x + C[i].x, xo[i].y * r * A[i].y + C[i].y); w.y = cvt_pk_bf16(xo[i].z * r * A[i].z + C[i].z, xo[i].w * r * A[i].w + C[i].w);
                    *(u32x2*)(hout + ro + 256 * i + 4 * lane) = w; }
            }
        }
    }
}
constexpr size_t WS_KN = WS_R2;
constexpr size_t WS_VT = WS_KN + al256c((size_t)NTOK * 256 * 2);
constexpr size_t WS_IKR = WS_VT + al256c((size_t)NTOK * 256 * 2);
constexpr size_t WS_MASK = WS_IKR + al256c((size_t)NTOK * 32 * 2);
constexpr size_t WS_OA = WS_MASK + al256c((size_t)NTOK * 128 * 4);
constexpr size_t WS_R3 = WS_OA + al256c((size_t)NTOK * 256 * 2);
constexpr size_t WS_MIXB = (WS_R3 > WS_Y + (size_t)SLOTS * D * 2 ? WS_R3 : WS_Y + al256c((size_t)SLOTS * D * 2));

__device__ __forceinline__ f32x4 mfma16(const bf16x8 a, const bf16x8 b, const f32x4 c) { return __builtin_amdgcn_mfma_f32_16x16x32_bf16(a, b, c, 0, 0, 0); }
__device__ __forceinline__ bf16_t f2bf(float f) { return (bf16_t)(cvt_pk_bf16(f, 0.f) & 0xffffu); }

__device__ __forceinline__ void rows_rms_store(const LAS float* YB, const float* gain, bf16_t* mixb, int tok0, int col0, int wid, int lane) {
    const f32x4 gv = *(const f32x4*)(gain + 4 * lane);
#pragma unroll 2
    for (int rr = 0; rr < 8; ++rr) {
        const int t = 8 * wid + rr;
        const f32x4 y = *(const LAS f32x4*)(YB + t * 260 + 4 * lane);
        const float ss = wave_sum(y[0] * y[0] + y[1] * y[1] + y[2] * y[2] + y[3] * y[3]);
        const float r = rsqrtf(ss * (1.0f / 256.0f) + EPS);
        u32x2 w; w.x = cvt_pk_bf16(y[0] * r * gv[0], y[1] * r * gv[1]); w.y = cvt_pk_bf16(y[2] * r * gv[2], y[3] * r * gv[3]);
        *(u32x2*)(mixb + (size_t)(tok0 + t) * D + col0 + 4 * lane) = w;
    }
}

__device__ __forceinline__ void item_pool(const Args& a, int l, int tile, LAS unsigned char* lds) {
    KArgs* ka = kargs();
    const int tid = opaque_tid(), wid = __builtin_amdgcn_readfirstlane(tid >> 6), lane = tid & 63;
    unsigned char* ws = ka->ws;
    const bf16_t* proj = (const bf16_t*)(ws + WS_PROJ);
    LAS bf16_t* P = (LAS bf16_t*)lds;
    LAS bf16_t* PA = (LAS bf16_t*)(lds + 40960);
    LAS float* YB = (LAS float*)(lds + 40960 + 33792);
    const int tok0 = tile * 64, b = tok0 / S, t0 = tok0 % S;
#pragma unroll
    for (int p = tid; p < 79 * 32; p += NTHR) {
        const int r = p >> 5, c8 = p & 31, t = t0 - 15 + r;
        u32x4 v = (u32x4){0u, 0u, 0u, 0u};
        if (t >= 0) v = *(const u32x4*)(proj + (size_t)(b * S + t) * NP + NC + c8 * 8);
        *(LAS u32x4*)(P + r * 256 + c8 * 8) = v;
    }
    __syncthreads();
    {
        const int c = tid & 255, half = tid >> 8, g = c >> 6, w = 2 << g, tt0 = half * 32;
        float run = 0.f;
        for (int jj = 1; jj < w; ++jj) run += bf2f(P[(15 + tt0 - jj) * 256 + c]);
        for (int i = 0; i < 32; ++i) {
            const int tt = tt0 + i, r = 15 + tt;
            const float pv = bf2f(P[r * 256 + c]);
            run += pv;
            const int tabs = t0 + tt, nn = (tabs + 1 < w) ? (tabs + 1) : w;
            PA[tt * 264 + c] = f2bf(run / (float)nn - pv);
            run -= bf2f(P[(r - w + 1) * 256 + c]);
        }
    }
    __syncthreads();
    {
        const int g = wid >> 1, mh = wid & 1, fr = lane & 15, fq = lane >> 4;
        const bf16_t* PT = (const bf16_t*)(ws + WS_POOLT) + (size_t)(l * 4 + g) * 64 * 64;
        f32x4 acc[2][4];
#pragma unroll
        for (int mi = 0; mi < 2; ++mi)
#pragma unroll
            for (int ni = 0; ni < 4; ++ni) acc[mi][ni] = (f32x4){0.f, 0.f, 0.f, 0.f};
#pragma unroll
        for (int ks = 0; ks < 2; ++ks) {
            bf16x8 A[2];
#pragma unroll
            for (int mi = 0; mi < 2; ++mi) A[mi] = *(const LAS bf16x8*)(PA + (16 * (2 * mh + mi) + fr) * 264 + g * 64 + 32 * ks + 8 * fq);
#pragma unroll
            for (int ni = 0; ni < 4; ++ni) { const bf16x8 Bf = *(const bf16x8*)(PT + (16 * ni + fr) * 64 + 32 * ks + 8 * fq);
#pragma unroll
                for (int mi = 0; mi < 2; ++mi) acc[mi][ni] = mfma16(A[mi], Bf, acc[mi][ni]); }
        }
        const float* pb = IN_F(I_POOLB) + l * 256; const float* ps = IN_F(I_POOLS) + l * 256;
#pragma unroll
        for (int ni = 0; ni < 4; ++ni) { const int d = g * 64 + 16 * ni + fr; const float bb = pb[d], sc = ps[d];
#pragma unroll
            for (int mi = 0; mi < 2; ++mi)
#pragma unroll
                for (int r = 0; r < 4; ++r) YB[(16 * (2 * mh + mi) + 4 * fq + r) * 260 + d] = (acc[mi][ni][r] + bb) * sc; }
    }
    __syncthreads();
    rows_rms_store(YB, IN_F(I_ONORM) + l * D + 512, (bf16_t*)(ws + WS_MIXB), tok0, 512, wid, lane);
    __syncthreads();
}

__device__ __forceinline__ void item_conv(const Args& a, int l, int tile, LAS unsigned char* lds) {
    KArgs* ka = kargs();
    const int tid = opaque_tid(), wid = __builtin_amdgcn_readfirstlane(tid >> 6), lane = tid & 63;
    unsigned char* ws = ka->ws;
    const bf16_t* proj = (const bf16_t*)(ws + WS_PROJ);
    LAS float* GL = (LAS float*)lds;
    LAS bf16_t* CA = (LAS bf16_t*)(lds + 96256);
    LAS float* YB = (LAS float*)lds;
    const int tok0 = tile * 64, b = tok0 / S, t0 = tok0 % S;
#pragma unroll
    for (int p = tid; p < 94 * 32; p += NTHR) {
        const int r = p >> 5, c8 = p & 31, t = t0 - 30 + r;
        f32x4 o0 = (f32x4){0.f, 0.f, 0.f, 0.f}, o1 = o0;
        if (t >= 0) {
            const bf16_t* pr = proj + (size_t)(b * S + t) * NP;
            const u32x4 av = *(const u32x4*)(pr + NBA + c8 * 8), gv = *(const u32x4*)(pr + NBG + c8 * 8);
            o0[0] = bflo(av.x) * sigmoid_fast(bflo(gv.x)); o0[1] = bfhi(av.x) * sigmoid_fast(bfhi(gv.x)); o0[2] = bflo(av.y) * sigmoid_fast(bflo(gv.y)); o0[3] = bfhi(av.y) * sigmoid_fast(bfhi(gv.y));
            o1[0] = bflo(av.z) * sigmoid_fast(bflo(gv.z)); o1[1] = bfhi(av.z) * sigmoid_fast(bfhi(gv.z)); o1[2] = bflo(av.w) * sigmoid_fast(bflo(gv.w)); o1[3] = bfhi(av.w) * sigmoid_fast(bfhi(gv.w));
        }
        *(LAS f32x4*)(GL + r * 256 + c8 * 8) = o0; *(LAS f32x4*)(GL + r * 256 + c8 * 8 + 4) = o1;
    }
    __syncthreads();
    {
        const int c = tid & 255, half = tid >> 8;
        float wv[31];
#pragma unroll
        for (int jj = 0; jj < 31; ++jj) wv[jj] = IN_F(I_CONVW)[((size_t)l * 31 + jj) * 256 + c];
        const float cb = IN_F(I_CONVB)[l * 256 + c];
        float yv[32];
#pragma unroll
        for (int ch = 0; ch < 8; ++ch) {
            const int tt = half * 32 + ch * 4;
            float x[34];
#pragma unroll
            for (int m2 = 0; m2 < 34; ++m2) x[m2] = GL[(tt + m2) * 256 + c];
#pragma unroll
            for (int i = 0; i < 4; ++i) {
                float y = cb;
#pragma unroll
                for (int jj = 0; jj < 31; ++jj) y += x[i + jj] * wv[jj];
                yv[ch * 4 + i] = y;
            }
        }
        __syncthreads();
#pragma unroll
        for (int i = 0; i < 32; ++i) YB[(half * 32 + i) * 260 + c] = yv[i];
    }
    __syncthreads();
    {
        const int t = tid >> 3, part = tid & 7;
        float y[32]; float s1 = 0.f;
#pragma unroll
        for (int i = 0; i < 8; ++i) { const f32x4 v = *(const LAS f32x4*)(YB + t * 260 + part * 32 + 4 * i); y[4 * i] = v[0]; y[4 * i + 1] = v[1]; y[4 * i + 2] = v[2]; y[4 * i + 3] = v[3]; s1 += (v[0] + v[1]) + (v[2] + v[3]); }
        s1 += dpp_f<0xB1>(s1);
        const float mu = s1 * (1.0f / 64.0f);
        float s2 = 0.f;
#pragma unroll
        for (int i = 0; i < 32; ++i) { y[i] -= mu; s2 += y[i] * y[i]; }
        s2 += dpp_f<0xB1>(s2);
        const float rs = rsqrtf(s2 * (1.0f / 64.0f) + EPS);
        const float* lng = IN_F(I_CLNG) + l * 256 + part * 32; const float* lnb = IN_F(I_CLNB) + l * 256 + part * 32;
#pragma unroll
        for (int i = 0; i < 4; ++i) {
            float o[8];
#pragma unroll
            for (int e = 0; e < 8; ++e) o[e] = silu_f(y[8 * i + e] * rs * lng[8 * i + e] + lnb[8 * i + e]);
            u32x4 w; w.x = cvt_pk_bf16(o[0], o[1]); w.y = cvt_pk_bf16(o[2], o[3]); w.z = cvt_pk_bf16(o[4], o[5]); w.w = cvt_pk_bf16(o[6], o[7]);
            *(LAS u32x4*)(CA + t * 264 + part * 32 + 8 * i) = w;
        }
    }
    __syncthreads();
    {
        const int fr = lane & 15, fq = lane >> 4;
        const bf16_t* PW = (const bf16_t*)(ws + WS_PWT) + (size_t)l * 65536;
        f32x4 acc[4][2];
#pragma unroll
        for (int mi = 0; mi < 4; ++mi)
#pragma unroll
            for (int ni = 0; ni < 2; ++ni) acc[mi][ni] = (f32x4){0.f, 0.f, 0.f, 0.f};
#pragma unroll 2
        for (int ks = 0; ks < 8; ++ks) {
            bf16x8 Bf[2];
#pragma unroll
            for (int ni = 0; ni < 2; ++ni) Bf[ni] = *(const bf16x8*)(PW + (size_t)(32 * wid + 16 * ni + fr) * 256 + 32 * ks + 8 * fq);
#pragma unroll
            for (int mi = 0; mi < 4; ++mi) { const bf16x8 Af = *(const LAS bf16x8*)(CA + (16 * mi + fr) * 264 + 32 * ks + 8 * fq);
#pragma unroll
                for (int ni = 0; ni < 2; ++ni) acc[mi][ni] = mfma16(Af, Bf[ni], acc[mi][ni]); }
        }
        const float* pwb = IN_F(I_PWB) + l * 256;
#pragma unroll
        for (int ni = 0; ni < 2; ++ni) { const int n = 32 * wid + 16 * ni + fr; const float bb = pwb[n];
#pragma unroll
            for (int mi = 0; mi < 4; ++mi)
#pragma unroll
                for (int r = 0; r < 4; ++r) YB[(16 * mi + 4 * fq + r) * 260 + n] = acc[mi][ni][r] + bb; }
    }
    __syncthreads();
    rows_rms_store(YB, IN_F(I_ONORM) + l * D + 256, (bf16_t*)(ws + WS_MIXB), tok0, 256, wid, lane);
    __syncthreads();
}

__device__ __forceinline__ void item_sgu(const Args& a, int l, int ch, LAS unsigned char* lds) {
    KArgs* ka = kargs();
    const int tid = opaque_tid(), wid = __builtin_amdgcn_readfirstlane(tid >> 6), lane = tid & 63;
    unsigned char* ws = ka->ws;
    const bf16_t* proj = (const bf16_t*)(ws + WS_PROJ);
    LAS bf16_t* VS = (LAS bf16_t*)lds;
    LAS bf16_t* OB = (LAS bf16_t*)(lds + 69632);
    const int tok0 = ch * 128;
    {
        const f32x4 lg = *(const f32x4*)(IN_F(I_SLNG) + l * 256 + 4 * lane), lb = *(const f32x4*)(IN_F(I_SLNB) + l * 256 + 4 * lane);
#pragma unroll 8
        for (int i = 0; i < 16; ++i) {
            const int s = 16 * wid + i;
            const u32x2 vv = *(const u32x2*)(proj + (size_t)(tok0 + s) * NP + NDV + 4 * lane);
            const float v0 = bflo(vv.x), v1 = bfhi(vv.x), v2 = bflo(vv.y), v3 = bfhi(vv.y);
            const float mu = wave_sum((v0 + v1) + (v2 + v3)) * (1.0f / 256.0f);
            const float d0 = v0 - mu, d1 = v1 - mu, d2 = v2 - mu, d3 = v3 - mu;
            const float rs = rsqrtf(wave_sum((d0 * d0 + d1 * d1) + (d2 * d2 + d3 * d3)) * (1.0f / 256.0f) + EPS);
            u32x2 w; w.x = cvt_pk_bf16(d0 * rs * lg[0] + lb[0], d1 * rs * lg[1] + lb[1]); w.y = cvt_pk_bf16(d2 * rs * lg[2] + lb[2], d3 * rs * lg[3] + lb[3]);
            *(LAS u32x2*)(VS + s * 260 + 4 * lane) = w;
        }
    }
    __syncthreads();
    {
        const int h = wid >> 1, np = wid & 1, fr = lane & 15, fq = lane >> 4;
        const bf16_t* W = (const bf16_t*)(ws + WS_SGUW) + (size_t)(l * 4 + h) * 128 * 128;
        const float* sb = IN_F(I_SGUB) + (l * 4 + h) * 128;
        bf16x8 Bf[4][2];
#pragma unroll
        for (int ks = 0; ks < 4; ++ks)
#pragma unroll
            for (int ni = 0; ni < 2; ++ni) {
                unsigned short e[8];
#pragma unroll
                for (int jj = 0; jj < 8; ++jj) e[jj] = VS[(32 * ks + 8 * fq + jj) * 260 + h * 64 + 32 * np + 16 * ni + fr];
                u32x4 w; w.x = e[0] | ((unsigned)e[1] << 16); w.y = e[2] | ((unsigned)e[3] << 16); w.z = e[4] | ((unsigned)e[5] << 16); w.w = e[6] | ((unsigned)e[7] << 16);
                Bf[ks][ni] = __builtin_bit_cast(bf16x8, w);
            }
#pragma unroll
        for (int mi = 0; mi < 8; ++mi) {
            f32x4 acc[2] = {(f32x4){0.f, 0.f, 0.f, 0.f}, (f32x4){0.f, 0.f, 0.f, 0.f}};
#pragma unroll
            for (int ks = 0; ks <= (mi >> 1); ++ks) {
                const bf16x8 Af = *(const bf16x8*)(W + (size_t)(16 * mi + fr) * 128 + 32 * ks + 8 * fq);
#pragma unroll
                for (int ni = 0; ni < 2; ++ni) acc[ni] = mfma16(Af, Bf[ks][ni], acc[ni]);
            }
#pragma unroll
            for (int ni = 0; ni < 2; ++ni)
#pragma unroll
                for (int r = 0; r < 4; ++r) { const int t = 16 * mi + 4 * fq + r; OB[t * 264 + h * 64 + 32 * np + 16 * ni + fr] = f2bf(acc[ni][r] + sb[t]); }
        }
    }
    __syncthreads();
    {
        const f32x4 gv = *(const f32x4*)(IN_F(I_ONORM) + l * D + 768 + 4 * lane);
        bf16_t* mixb = (bf16_t*)(ws + WS_MIXB);
#pragma unroll 8
        for (int i = 0; i < 16; ++i) {
            const int t = 16 * wid + i;
            const u32x2 mv = *(const LAS u32x2*)(OB + t * 264 + 4 * lane);
            const u32x2 uv = *(const u32x2*)(proj + (size_t)(tok0 + t) * NP + NDU + 4 * lane);
            const float o0 = bflo(uv.x) * bflo(mv.x), o1 = bfhi(uv.x) * bfhi(mv.x), o2 = bflo(uv.y) * bflo(mv.y), o3 = bfhi(uv.y) * bfhi(mv.y);
            const float r = rsqrtf(wave_sum((o0 * o0 + o1 * o1) + (o2 * o2 + o3 * o3)) * (1.0f / 256.0f) + EPS);
            u32x2 w; w.x = cvt_pk_bf16(o0 * r * gv[0], o1 * r * gv[1]); w.y = cvt_pk_bf16(o2 * r * gv[2], o3 * r * gv[3]);
            *(u32x2*)(mixb + (size_t)(tok0 + t) * D + 768 + 4 * lane) = w;
        }
    }
    __syncthreads();
}

__device__ __forceinline__ void item_prepk(const Args& a, int l, int tile, LAS unsigned char* lds) {
    KArgs* ka = kargs();
    const int tid = opaque_tid(), wid = __builtin_amdgcn_readfirstlane(tid >> 6), lane = tid & 63;
    unsigned char* ws = ka->ws;
    const bf16_t* proj = (const bf16_t*)(ws + WS_PROJ);
    LAS bf16_t* VS = (LAS bf16_t*)lds;
    bf16_t* KN = (bf16_t*)(ws + WS_KN); bf16_t* VTg = (bf16_t*)(ws + WS_VT); bf16_t* IKR = (bf16_t*)(ws + WS_IKR);
    const float* ropeA = (const float*)(ws + WS_ROPEA); const float* ropeI = (const float*)(ws + WS_ROPEI);
    const int tok0 = tile * 64, b = tok0 / S, s0 = tok0 % S;
    const int li = lane & 15, head = lane >> 4;
    const f32x4 kg = *(const f32x4*)(IN_F(I_KN) + l * 64 + 4 * li);
#pragma unroll 4
    for (int i = 0; i < 8; ++i) {
        const int tl = 8 * wid + i, tok = tok0 + tl, s = s0 + tl;
        const bf16_t* pr = proj + (size_t)tok * NP;
        const u32x2 kv = *(const u32x2*)(pr + NK + 4 * lane);
        float k0 = bflo(kv.x), k1 = bfhi(kv.x), k2 = bflo(kv.y), k3 = bfhi(kv.y);
        float ss = (k0 * k0 + k1 * k1) + (k2 * k2 + k3 * k3);
        ss = row_sum16(ss);
        const float r = rsqrtf(ss * (1.0f / 64.0f) + EPS);
        k0 *= r * kg[0]; k1 *= r * kg[1]; k2 *= r * kg[2]; k3 *= r * kg[3];
        {
            const float p0 = __shfl_xor(k0, 2), p1 = __shfl_xor(k1, 2), p2 = __shfl_xor(k2, 2), p3 = __shfl_xor(k3, 2);
            if (li < 4) {
                const int dd = 4 * (li & 1);
                const f32x4 cs = *(const f32x4*)(ropeA + (size_t)tok * 16 + dd), sn = *(const f32x4*)(ropeA + (size_t)tok * 16 + 8 + dd);
                if (li < 2) { k0 = k0 * cs[0] - p0 * sn[0]; k1 = k1 * cs[1] - p1 * sn[1]; k2 = k2 * cs[2] - p2 * sn[2]; k3 = k3 * cs[3] - p3 * sn[3]; }
                else        { k0 = k0 * cs[0] + p0 * sn[0]; k1 = k1 * cs[1] + p1 * sn[1]; k2 = k2 * cs[2] + p2 * sn[2]; k3 = k3 * cs[3] + p3 * sn[3]; }
            }
        }
        u32x2 ko; ko.x = cvt_pk_bf16(k0, k1); ko.y = cvt_pk_bf16(k2, k3);
        *(u32x2*)(KN + ((size_t)((b * 4 + head) * 128 + (s >> 5)) * 32 + (s & 31)) * 64 + 4 * li) = ko;
        *(LAS u32x2*)(VS + tl * 264 + 4 * lane) = *(const u32x2*)(pr + NV + 4 * lane);
        if (lane < 8) {
            const u32x2 iv = *(const u32x2*)(pr + NIK + 4 * lane);
            float x0 = bflo(iv.x), x1 = bfhi(iv.x), x2 = bflo(iv.y), x3 = bfhi(iv.y);
            const float q0 = __shfl_xor(x0, 1), q1 = __shfl_xor(x1, 1), q2 = __shfl_xor(x2, 1), q3 = __shfl_xor(x3, 1);
            if (lane < 2) {
                const f32x4 cs = *(const f32x4*)(ropeI + (size_t)tok * 8), sn = *(const f32x4*)(ropeI + (size_t)tok * 8 + 4);
                if (lane == 0) { x0 = x0 * cs[0] - q0 * sn[0]; x1 = x1 * cs[1] - q1 * sn[1]; x2 = x2 * cs[2] - q2 * sn[2]; x3 = x3 * cs[3] - q3 * sn[3]; }
                else           { x0 = x0 * cs[0] + q0 * sn[0]; x1 = x1 * cs[1] + q1 * sn[1]; x2 = x2 * cs[2] + q2 * sn[2]; x3 = x3 * cs[3] + q3 * sn[3]; }
            }
            u32x2 io; io.x = cvt_pk_bf16(x0, x1); io.y = cvt_pk_bf16(x2, x3);
            *(u32x2*)(IKR + (size_t)tok * 32 + 4 * lane) = io;
        }
    }
    __syncthreads();
#pragma unroll
    for (int i = 0; i < 4; ++i) {
        const int p = tid + NTHR * i;
        const int h = p >> 9, ktl = (p >> 8) & 1, d = (p >> 2) & 63, part = p & 3;
        unsigned short e[8];
#pragma unroll
        for (int jj = 0; jj < 8; ++jj) { const int key = 4 * part + (jj & 3) + 16 * (jj >> 2); e[jj] = VS[(ktl * 32 + key) * 264 + h * 64 + d]; }
        u32x4 w; w.x = e[0] | ((unsigned)e[1] << 16); w.y = e[2] | ((unsigned)e[3] << 16); w.z = e[4] | ((unsigned)e[5] << 16); w.w = e[6] | ((unsigned)e[7] << 16);
        *(u32x4*)(VTg + ((size_t)((b * 4 + h) * 128 + (s0 >> 5) + ktl) * 64 + d) * 32 + 8 * part) = w;
    }
    __syncthreads();
}

__device__ __forceinline__ void phase_mix1(const Args& a, int l, LAS unsigned char* lds, int vcu, int G, int bx) {
    if (G == 256) {
        if (bx < 64) { item_conv(a, l, bx, lds); item_pool(a, l, bx, lds); }
        else {
            const int w = bx - 64;
            if (w < 128) item_sgu(a, l, w, lds);
            item_prepk(a, l, w, lds);
            item_conv(a, l, 64 + w, lds);
            if (w >= 128) item_prepk(a, l, 192 + (w - 128), lds);
            item_pool(a, l, 64 + w, lds);
        }
        return;
    }
    for (int it = vcu; it < 896; it += G) {
        if (it < 128) item_sgu(a, l, it, lds);
        else if (it < 384) item_conv(a, l, it - 128, lds);
        else if (it < 640) item_pool(a, l, it - 384, lds);
        else item_prepk(a, l, it - 640, lds);
    }
}
__device__ __forceinline__ f32x16 mfma32(const bf16x8 a, const bf16x8 b, const f32x16 c) { return __builtin_amdgcn_mfma_f32_32x32x16_bf16(a, b, c, 0, 0, 0); }
typedef float f32x2 __attribute__((ext_vector_type(2)));

__device__ __forceinline__ void a1_scores(const bf16x8 A0, const bf16x8 A1, const bf16x8 (&Bq)[4][2], const float (&cl)[4], f32x2 (&sc)[8]) {
    f32x16 d[4];
#pragma unroll
    for (int h = 0; h < 4; ++h) {
#pragma unroll
        for (int r = 0; r < 16; ++r) d[h][r] = 0.f;
        d[h] = mfma32(A0, Bq[h][0], d[h]); d[h] = mfma32(A1, Bq[h][1], d[h]);
    }
#pragma unroll
    for (int p = 0; p < 8; ++p) {
        f32x2 m[4];
#pragma unroll
        for (int h = 0; h < 4; ++h) { m[h][0] = __builtin_amdgcn_fmed3f(d[h][2 * p], 0.0f, cl[h]); m[h][1] = __builtin_amdgcn_fmed3f(d[h][2 * p + 1], 0.0f, cl[h]); }
        sc[p] = (m[0] + m[1]) + (m[2] + m[3]);
    }
}

#define A1_STREAM_BEGIN { \
    bf16x8 rA[4][2]; const int ntw_ = (nkt - wid + 7) >> 3; \
    _Pragma("unroll") for (int u_ = 0; u_ < 4; ++u_) { rA[u_][0] = Bq[0][0]; rA[u_][1] = Bq[0][0]; if (u_ < ntw_) { const size_t o_ = (size_t)(wid + 8 * u_) * 1024; rA[u_][0] = *(const bf16x8*)(ikl + o_); rA[u_][1] = *(const bf16x8*)(ikl + o_ + 16); } } \
    for (int i_ = 0; i_ < ntw_; i_ += 4) { \
        _Pragma("unroll") for (int u_ = 0; u_ < 4; ++u_) { if (i_ + u_ < ntw_) { \
            const bf16x8 cA0 = rA[u_][0], cA1 = rA[u_][1]; const int kt = wid + 8 * (i_ + u_); \
            if (i_ + u_ + 4 < ntw_) { const size_t o_ = (size_t)(kt + 32) * 1024; rA[u_][0] = *(const bf16x8*)(ikl + o_); rA[u_][1] = *(const bf16x8*)(ikl + o_ + 16); }
#define A1_STREAM_END } } } }

template <int KIND>
__device__ __forceinline__ void a1_pass(const bf16_t* ikl, int nkt, int wid, const bf16x8 (&Bq)[4][2], const float (&cl)[4], LAS unsigned char* histb, unsigned q4, unsigned cadd) {
    A1_STREAM_BEGIN
        f32x2 sc[8];
        a1_scores(cA0, cA1, Bq, cl, sc);
#pragma unroll
        for (int r = 0; r < 16; ++r) {
            const unsigned u = __float_as_uint(sc[r >> 1][r & 1]);
            unsigned addr;
            if (KIND == 0) addr = (((u + 0x8000u) >> 17) & 0x7f80u) | q4;
            else { unsigned dg = (u + cadd) >> 16; dg = dg < 256u ? dg : 256u; addr = (dg << 7) + q4; }
            __hip_atomic_fetch_add((LAS unsigned*)(histb + addr), 1u, __ATOMIC_RELAXED, __HIP_MEMORY_SCOPE_WORKGROUP);
        }
    A1_STREAM_END
}

template <int LEVEL>
__device__ __forceinline__ void a1_scan(LAS unsigned* hist, LAS unsigned* psum, LAS unsigned* qst, int tid) {
    const int sq = tid & 31, part = tid >> 5;
    const unsigned need = qst[32 + sq], p1 = qst[sq];
    const bool neg = (p1 & 0x80u) != 0u;
#define A1_RAWROW(bn) (LEVEL == 0 ? ((bn) >= 128 ? (bn) - 128 : 255 - (bn)) : (neg ? 255 - (bn) : (bn)))
    unsigned local = 0u;
#pragma unroll
    for (int bb = 0; bb < 16; ++bb) local += hist[A1_RAWROW(16 * part + bb) * 32 + sq];
    psum[part * 32 + sq] = local;
    __syncthreads();
    unsigned above = 0u;
    for (int pp = part + 1; pp < 16; ++pp) above += psum[pp * 32 + sq];
    if (above < need && above + local >= need) {
        unsigned run = above;
        for (int bb = 15; bb >= 0; --bb) {
            const int raw = A1_RAWROW(16 * part + bb);
            const unsigned c = hist[raw * 32 + sq];
            if (run + c >= need) {
                if (LEVEL == 0) { qst[sq] = (unsigned)raw; qst[32 + sq] = need - run; }
                else { qst[sq] = (p1 << 8) | (unsigned)raw; qst[32 + sq] = need - run; qst[64 + sq] = c; }
                break;
            }
            run += c;
        }
    }
#undef A1_RAWROW
}

__device__ __forceinline__ void a1_cmp2(unsigned& gt, unsigned& ge, float s0, float s1, float tg, float te) {
#ifdef A1_NOASM
    gt = (gt << 1) | (s0 >= tg ? 1u : 0u); ge = (ge << 1) | (s0 >= te ? 1u : 0u);
    gt = (gt << 1) | (s1 >= tg ? 1u : 0u); ge = (ge << 1) | (s1 >= te ? 1u : 0u);
#else
    unsigned long long m1, m2, m3;
    asm("v_cmp_ge_f32 vcc, %[s0], %[tg]\n\t"
        "v_cmp_ge_f32 %[m1], %[s0], %[te]\n\t"
        "v_cmp_ge_f32 %[m2], %[s1], %[tg]\n\t"
        "v_cmp_ge_f32 %[m3], %[s1], %[te]\n\t"
        "v_addc_co_u32 %[g], vcc, %[g], %[g], vcc\n\t"
        "v_addc_co_u32 %[e], %[m1], %[e], %[e], %[m1]\n\t"
        "v_addc_co_u32 %[g], %[m2], %[g], %[g], %[m2]\n\t"
        "v_addc_co_u32 %[e], %[m3], %[e], %[e], %[m3]"
        : [g] "+v"(gt), [e] "+v"(ge), [m1] "=&s"(m1), [m2] "=&s"(m2), [m3] "=&s"(m3)
        : [s0] "v"(s0), [s1] "v"(s1), [tg] "v"(tg), [te] "v"(te)
        : "vcc");
#endif
}
__device__ __forceinline__ unsigned a1_spread(unsigned x) { return (x & 0xfu) | ((x & 0xf0u) << 4) | ((x & 0xf00u) << 8) | ((x & 0xf000u) << 12); }

constexpr int A1_HISTA = 0, A1_HISTB = 257 * 32, A1_PSUM = 2 * 257 * 32, A1_QST = A1_PSUM + 16 * 32, A1_MBUF = A1_QST + 128, A1_TBUF = A1_MBUF + 32 * 128;
__device__ __forceinline__ void a1_tile(const Args& a, int l, int b, int j, LAS unsigned char* lds) {
    KArgs* ka = kargs();
    const int tid = opaque_tid(), wid = __builtin_amdgcn_readfirstlane(tid >> 6), lane = tid & 63, q = lane & 31, hh = lane >> 5;
    unsigned char* ws = ka->ws;
    const bf16_t* proj = (const bf16_t*)(ws + WS_PROJ);
    const bf16_t* ikr = (const bf16_t*)(ws + WS_IKR) + (size_t)b * S * 32;
    const bf16_t* ikl = ikr + (lane & 31) * 32 + 8 * (lane >> 5);
    unsigned* maskg = (unsigned*)(ws + WS_MASK);
    LAS unsigned* L = (LAS unsigned*)lds;
    LAS unsigned* psum = L + A1_PSUM; LAS unsigned* qst = L + A1_QST; LAS unsigned* mbuf = L + A1_MBUF; LAS unsigned* tbuf = L + A1_TBUF;
    const int t0 = j * 32, n = (t0 / 64 + 1) * 64, nkt = n / 32, nw = ((t0 / 128) + 1) * 4;
    if (n <= 256) {
        for (int i = tid; i < 32 * nw; i += NTHR) { const int qq = i / nw, w = i % nw; maskg[(size_t)(b * S + t0 + qq) * 128 + w] = (w < nkt) ? 0xffffffffu : 0u; }
        return;
    }
    bf16x8 Bq[4][2]; float cl[4];
    {
        const int tok = b * S + t0 + q;
        const bf16_t* pr = proj + (size_t)tok * NP;
        const f32x4 cs = *(const f32x4*)((const float*)(ws + WS_ROPEI) + (size_t)tok * 8), sn = *(const f32x4*)((const float*)(ws + WS_ROPEI) + (size_t)tok * 8 + 4);
#pragma unroll
        for (int h = 0; h < 4; ++h) {
            const float wsc = bf2f(pr[NIW + h]) * (0.5f * 0.17677669529663687f);
            cl[h] = (wsc > 0.f) ? INFINITY : -INFINITY;
#pragma unroll
            for (int ks = 0; ks < 2; ++ks) {
                const u32x4 raw = *(const u32x4*)(pr + NIQ + h * 32 + 16 * ks + 8 * hh);
                float v[8] = {bflo(raw.x), bfhi(raw.x), bflo(raw.y), bfhi(raw.y), bflo(raw.z), bfhi(raw.z), bflo(raw.w), bfhi(raw.w)};
                if (ks == 0 && hh == 0) {
#pragma unroll
                    for (int i = 0; i < 4; ++i) { const float x1 = v[i], x2 = v[i + 4]; v[i] = x1 * cs[i] - x2 * sn[i]; v[i + 4] = x2 * cs[i] + x1 * sn[i]; }
                }
                u32x4 pk; pk.x = cvt_pk_bf16(v[0] * wsc, v[1] * wsc); pk.y = cvt_pk_bf16(v[2] * wsc, v[3] * wsc); pk.z = cvt_pk_bf16(v[4] * wsc, v[5] * wsc); pk.w = cvt_pk_bf16(v[6] * wsc, v[7] * wsc);
                Bq[h][ks] = __builtin_bit_cast(bf16x8, pk);
            }
        }
    }
    { LAS u32x4* hz = (LAS u32x4*)(L + A1_HISTA); for (int i = tid; i < 2 * 257 * 32 / 4; i += NTHR) hz[i] = (u32x4){0u, 0u, 0u, 0u}; }
    if (tid < 32) { qst[tid] = 0u; qst[32 + tid] = 256u; qst[64 + tid] = 0u; }
    __syncthreads();
    const unsigned q4 = (unsigned)q * 4u;
    a1_pass<0>(ikl, nkt, wid, Bq, cl, (LAS unsigned char*)(L + A1_HISTA), q4, 0u);
    __syncthreads();
    a1_scan<0>(L + A1_HISTA, psum, qst, tid);
    __syncthreads();
    a1_pass<1>(ikl, nkt, wid, Bq, cl, (LAS unsigned char*)(L + A1_HISTB), q4, 0x8000u - (qst[q] << 24));
    __syncthreads();
    a1_scan<1>(L + A1_HISTB, psum, qst, tid);
    __syncthreads();
    {
        const unsigned T = qst[q], mag = T & 0x7fffu;
        unsigned bg, be;
        if ((T & 0x8000u) == 0u) { be = mag ? (mag << 16) - 0x8000u : 0u; bg = ((mag + 1u) << 16) - 0x8000u; }
        else { be = 0x80000000u | (((mag + 1u) << 16) - 0x8001u); bg = mag ? (0x80000000u | ((mag << 16) - 0x8001u)) : 0u; }
        const float tg = __uint_as_float(bg), te = __uint_as_float(be);
        A1_STREAM_BEGIN
            f32x2 sc[8];
            a1_scores(cA0, cA1, Bq, cl, sc);
            unsigned gt = 0u, ge = 0u;
#pragma unroll
            for (int p = 7; p >= 0; --p) a1_cmp2(gt, ge, sc[p][1], sc[p][0], tg, te);
            unsigned wb = a1_spread(gt & 0xffffu) << (4 * hh), eb = a1_spread(ge & 0xffffu) << (4 * hh);
            wb |= (unsigned)__shfl_xor((int)wb, 32); eb |= (unsigned)__shfl_xor((int)eb, 32);
            if (hh == 0) { mbuf[q * 128 + kt] = wb; tbuf[q * 128 + kt] = eb & ~wb; }
        A1_STREAM_END
    }
    __syncthreads();
    {
        const int qq = tid >> 4, part = tid & 15;
        const unsigned need = qst[32 + qq];
        const u32x4 ta = *(const LAS u32x4*)(tbuf + qq * 128 + part * 8), tb = *(const LAS u32x4*)(tbuf + qq * 128 + part * 8 + 4);
        const u32x4 ma = *(const LAS u32x4*)(mbuf + qq * 128 + part * 8), mb = *(const LAS u32x4*)(mbuf + qq * 128 + part * 8 + 4);
        unsigned t[8] = {ta.x, ta.y, ta.z, ta.w, tb.x, tb.y, tb.z, tb.w}, m[8] = {ma.x, ma.y, ma.z, ma.w, mb.x, mb.y, mb.z, mb.w};
        unsigned c = 0u;
#pragma unroll
        for (int i = 0; i < 8; ++i) { if (part * 8 + i >= nkt) { t[i] = 0u; m[i] = 0u; } c += (unsigned)__builtin_popcount(t[i]); }
        unsigned inc = c;
#pragma unroll
        for (int dd = 1; dd < 16; dd <<= 1) { const unsigned v = (unsigned)__shfl_up((int)inc, dd, 16); if (part >= dd) inc += v; }
        int rem = (int)need - (int)(inc - c);
#pragma unroll
        for (int i = 0; i < 8; ++i) {
            const int ci = __builtin_popcount(t[i]);
            unsigned keep = 0u;
            if (rem >= ci) keep = t[i];
            else if (rem > 0) { unsigned tt = t[i]; for (int k = rem; k > 0; --k) { const unsigned low = tt & (0u - tt); keep |= low; tt ^= low; } }
            m[i] |= keep; rem -= ci;
        }
        unsigned* mg = maskg + (size_t)(b * S + t0 + qq) * 128 + part * 8;
        if (part * 8 < nw) *(u32x4*)mg = (u32x4){m[0], m[1], m[2], m[3]};
        if (part * 8 + 4 < nw) *(u32x4*)(mg + 4) = (u32x4){m[4], m[5], m[6], m[7]};
    }
    __syncthreads();
}
__device__ __forceinline__ void phase_a1(const Args& a, int l, LAS unsigned char* lds, int vcu, int G) {
    KArgs* ka = kargs();
    for (int it = vcu; it < 256; it += G) { const int b = it >> 6, jj = it & 63; a1_tile(a, l, b, 127 - jj, lds); a1_tile(a, l, b, jj, lds); }
}

__device__ __forceinline__ void a2_unit(const Args& a, int l, int b, int h, int blk, LAS unsigned char* lds) {
    KArgs* ka = kargs();
    const int tid = opaque_tid(), wid = __builtin_amdgcn_readfirstlane(tid >> 6), lane = tid & 63, fr = lane & 15, kq = lane >> 4;
    unsigned char* ws = ka->ws;
    const bf16_t* proj = (const bf16_t*)(ws + WS_PROJ);
    const char* KNb = (const char*)(ws + WS_KN) + (size_t)(b * 4 + h) * 128 * 4096;
    const char* VTb = (const char*)(ws + WS_VT) + (size_t)(b * 4 + h) * 128 * 4096;
    LAS unsigned char* Kb = lds;
    LAS unsigned char* Vb = lds + 32768;
    LAS float* Ob = (LAS float*)(lds + 65536) + wid * (16 * 68);
    const int nsteps = 2 * (blk + 1);
    const int tokq = b * S + blk * 128 + wid * 16 + fr;
    bf16x8 Qb[2]; float C2;
    {
        const float* qg = IN_F(I_QN) + l * 64; const float* kg = IN_F(I_KN) + l * 64;
        float gq = 0.f, gk = 0.f;
        for (int i = 0; i < 64; ++i) { gq = fmaxf(gq, fabsf(qg[i])); gk = fmaxf(gk, fabsf(kg[i])); }
        C2 = 8.0f * gq * gk * 1.4426950408889634f;
        const bf16_t* pr = proj + (size_t)tokq * NP + NQ + h * 64;
        float v[2][8]; float ss = 0.f;
#pragma unroll
        for (int ks = 0; ks < 2; ++ks) { const u32x4 raw = *(const u32x4*)(pr + 32 * ks + 8 * kq);
            v[ks][0] = bflo(raw.x); v[ks][1] = bfhi(raw.x); v[ks][2] = bflo(raw.y); v[ks][3] = bfhi(raw.y); v[ks][4] = bflo(raw.z); v[ks][5] = bfhi(raw.z); v[ks][6] = bflo(raw.w); v[ks][7] = bfhi(raw.w);
#pragma unroll
            for (int i = 0; i < 8; ++i) ss += v[ks][i] * v[ks][i]; }
        ss += __shfl_xor(ss, 16); ss += __shfl_xor(ss, 32);
        const float r = rsqrtf(ss * (1.0f / 64.0f) + EPS);
#pragma unroll
        for (int ks = 0; ks < 2; ++ks)
#pragma unroll
            for (int i = 0; i < 8; ++i) v[ks][i] *= r * qg[32 * ks + 8 * kq + i];
        {
            const float* ra = (const float*)(ws + WS_ROPEA) + (size_t)tokq * 16;
#pragma unroll
            for (int i = 0; i < 8; ++i) { const float pv = __shfl_xor(v[0][i], 16); const float c = ra[i], s = ra[8 + i];
                if (kq == 0) v[0][i] = v[0][i] * c - pv * s; else if (kq == 1) v[0][i] = v[0][i] * c + pv * s; }
        }
        const float qs = 0.125f * 1.4426950408889634f;
#pragma unroll
        for (int ks = 0; ks < 2; ++ks) { u32x4 pk; pk.x = cvt_pk_bf16(v[ks][0] * qs, v[ks][1] * qs); pk.y = cvt_pk_bf16(v[ks][2] * qs, v[ks][3] * qs); pk.z = cvt_pk_bf16(v[ks][4] * qs, v[ks][5] * qs); pk.w = cvt_pk_bf16(v[ks][6] * qs, v[ks][7] * qs);
            Qb[ks] = __builtin_bit_cast(bf16x8, pk); }
    }
    const unsigned* mrow = (const unsigned*)(ws + WS_MASK) + (size_t)tokq * 128;
    f32x4 O[4];
#pragma unroll
    for (int dt = 0; dt < 4; ++dt) O[dt] = (f32x4){0.f, 0.f, 0.f, 0.f};
    float lsum = 0.f;
    const unsigned bit0 = 1u << (4 * kq);
    const int kkey = tid >> 3, kch = tid & 7, vsub = tid >> 8, vd = (tid >> 2) & 63, vch = tid & 3;
    const int klds = kkey * 128 + ((kch ^ (kkey & 7)) * 16), vlds = vsub * 4096 + vd * 64 + ((vch ^ ((vd >> 2) & 3)) * 16);
    u32x4 kr0, kr1, kr2, kr3, vr0, vr1, vr2, vr3; u32x2 mw0, mw1, mw2, mw3;
#define A2_LOAD(j, st_) do { kr##j = *(const u32x4*)(KNb + (size_t)(st_) * 8192 + (size_t)tid * 16); vr##j = *(const u32x4*)(VTb + (size_t)(st_) * 8192 + (size_t)tid * 16); mw##j = *(const u32x2*)(mrow + 2 * (st_)); } while (0)
    A2_LOAD(0, 0); A2_LOAD(1, 1);
    if (nsteps > 2) { A2_LOAD(2, 2); A2_LOAD(3, 3); } else { kr2 = kr0; vr2 = vr0; mw2 = mw0; kr3 = kr0; vr3 = vr0; mw3 = mw0; }
    __syncthreads();
#define A2_HALF(Kc, Vc, mcur) do { \
        _Pragma("unroll") for (int sub = 0; sub < 2; ++sub) { \
            const unsigned m = sub ? (mcur).y : (mcur).x; \
            f32x4 Sx[2]; \
            _Pragma("unroll") for (int tl = 0; tl < 2; ++tl) { \
                const int key = 32 * sub + 16 * tl + fr; \
                const bf16x8 A0 = *(const LAS bf16x8*)((Kc) + key * 128 + (((0 + kq) ^ (key & 7)) * 16)); \
                const bf16x8 A1 = *(const LAS bf16x8*)((Kc) + key * 128 + (((4 + kq) ^ (key & 7)) * 16)); \
                f32x4 z = (f32x4){-C2, -C2, -C2, -C2};     \
                z = mfma16(A0, Qb[0], z); Sx[tl] = mfma16(A1, Qb[1], z); \
            } \
            float p[8]; \
            _Pragma("unroll") for (int r = 0; r < 4; ++r) { \
                const float e0 = __builtin_amdgcn_exp2f(Sx[0][r]), e1 = __builtin_amdgcn_exp2f(Sx[1][r]); \
                p[r] = (m & (bit0 << r)) ? e0 : 0.f; p[4 + r] = (m & (bit0 << (16 + r))) ? e1 : 0.f; \
            } \
            lsum += ((p[0] + p[1]) + (p[2] + p[3])) + ((p[4] + p[5]) + (p[6] + p[7])); \
            u32x4 pk; pk.x = cvt_pk_bf16(p[0], p[1]); pk.y = cvt_pk_bf16(p[2], p[3]); pk.z = cvt_pk_bf16(p[4], p[5]); pk.w = cvt_pk_bf16(p[6], p[7]); \
            const bf16x8 Pf = __builtin_bit_cast(bf16x8, pk); \
            _Pragma("unroll") for (int dt = 0; dt < 4; ++dt) { const int d = 16 * dt + fr; \
                const bf16x8 Av = *(const LAS bf16x8*)((Vc) + sub * 4096 + d * 64 + ((kq ^ ((d >> 2) & 3)) * 16)); \
                O[dt] = mfma16(Av, Pf, O[dt]); } \
        } } while (0)
#define A2_STEP2(ja, jb, s2_) do { \
        LAS unsigned char* Kc2 = Kb + ((s2_) & 1) * 16384; LAS unsigned char* Vc2 = Vb + ((s2_) & 1) * 16384; \
        *(LAS u32x4*)(Kc2 + klds) = kr##ja; *(LAS u32x4*)(Vc2 + vlds) = vr##ja; *(LAS u32x4*)(Kc2 + 8192 + klds) = kr##jb; *(LAS u32x4*)(Vc2 + 8192 + vlds) = vr##jb; \
        const u32x2 mcA = mw##ja, mcB = mw##jb; \
        __syncthreads(); \
        if (2 * (s2_) + 4 < nsteps) A2_LOAD(ja, 2 * (s2_) + 4); \
        if (2 * (s2_) + 5 < nsteps) A2_LOAD(jb, 2 * (s2_) + 5); \
        A2_HALF(Kc2, Vc2, mcA); A2_HALF(Kc2 + 8192, Vc2 + 8192, mcB); \
    } while (0)
    for (int s2 = 0; 2 * s2 < nsteps; s2 += 2) {
        A2_STEP2(0, 1, s2);
        if (2 * (s2 + 1) < nsteps) A2_STEP2(2, 3, s2 + 1);
    }
#undef A2_STEP2
#undef A2_HALF
#undef A2_LOAD
    lsum += __shfl_xor(lsum, 16); lsum += __shfl_xor(lsum, 32);
    const float inv = 1.0f / lsum;
#pragma unroll
    for (int dt = 0; dt < 4; ++dt)
#pragma unroll
        for (int r = 0; r < 4; ++r) Ob[fr * 68 + 16 * dt + 4 * kq + r] = O[dt][r] * inv;
    __syncthreads();
    {
        const int qq = lane >> 2, dp = (lane & 3) * 16;
        const LAS float* src = Ob + qq * 68 + dp;
        float f[16]; float sq = 0.f;
#pragma unroll
        for (int i = 0; i < 4; ++i) { const f32x4 t = *(const LAS f32x4*)(src + 4 * i); f[4 * i] = t[0]; f[4 * i + 1] = t[1]; f[4 * i + 2] = t[2]; f[4 * i + 3] = t[3]; sq += (t[0] * t[0] + t[1] * t[1]) + (t[2] * t[2] + t[3] * t[3]); }
        u32x4 w0, w1; w0.x = cvt_pk_bf16(f[0], f[1]); w0.y = cvt_pk_bf16(f[2], f[3]); w0.z = cvt_pk_bf16(f[4], f[5]); w0.w = cvt_pk_bf16(f[6], f[7]);
        w1.x = cvt_pk_bf16(f[8], f[9]); w1.y = cvt_pk_bf16(f[10], f[11]); w1.z = cvt_pk_bf16(f[12], f[13]); w1.w = cvt_pk_bf16(f[14], f[15]);
        const int tok = b * S + blk * 128 + wid * 16 + qq;
        bf16_t* op = (bf16_t*)(ws + WS_MIXB) + (size_t)tok * D + h * 64 + dp;
        *(u32x4*)op = w0; *(u32x4*)(op + 8) = w1;
        sq += dpp_f<0xB1>(sq); sq += dpp_f<0x4E>(sq);
        if ((lane & 3) == 0) ((float*)(ws + WS_SSQ))[((size_t)l * NTOK + tok) * 4 + h] = sq;
    }
    __syncthreads();
}
__device__ __forceinline__ void phase_a2(const Args& a, int l, LAS unsigned char* lds, int vcu, int G) {
    KArgs* ka = kargs();
    for (int it = vcu; it < 256; it += G) { const int b = it >> 6, h = (it >> 4) & 3, jj = it & 15; a2_unit(a, l, b, h, 31 - jj, lds); a2_unit(a, l, b, h, jj, lds); }
}
__global__ void __launch_bounds__(NTHR, 2) mk_fwd(Args a) {
    extern __shared__ __attribute__((aligned(16))) unsigned char lds_raw[];
    LAS unsigned char* lds = (LAS unsigned char*)lds_raw;
    const int tid = threadIdx.x, G = gridDim.x, bx = blockIdx.x;
    const int vcu = (G % 8 == 0) ? (bx % 8) * (G / 8) + bx / 8 : bx;
    if (tid < 64) ((LAS unsigned*)(lds + LDS_MISC))[tid] = 0u;
    __syncthreads();
    XcdBarrier bar; bar.bar = (unsigned*)(a.ws + WS_BAR); bar.x = 0; bar.st = nullptr;
    if (a.fused) bar = xcd_barrier_post((unsigned*)(a.ws + WS_BAR), (volatile LAS unsigned*)(lds + LDS_MISC + MISC_BAR));
#define GRID_BAR() do { if (a.fused) xcd_barrier(bar); } while (0)
#ifdef ONLY_PH
#define IN(k) ((k) == ONLY_PH && a.ph_lo <= (k) && (k) < a.ph_hi)
#else
#define IN(k) (a.ph_lo <= (k) && (k) < a.ph_hi)
#endif
    if (IN(PH_PRO)) { phase_prologue(a, lds, vcu, G); GRID_BAR(); }
    if (IN(PH_NORM0)) { KArgs* ka = kargs(); unsigned char* ws = ka->ws; float* modp = (float*)(ws + WS_MOD); phase_norm(IN_F(I_X), IN_F(I_NORM1), modp, modp + 1024, (bf16_t*)(ws + WS_HA), vcu, G); phase_rbias(a, lds, vcu, G); GRID_BAR(); }
    for (int l = a.l_lo; l < a.l_hi; ++l) {
        if (IN(PH_G1)) {
            KArgs* ka = kargs(); unsigned char* ws = ka->ws;
            pg8::DenseOrder S; S.init((const bf16_t*)(ws + WS_HA), (const bf16_t*)(ws + WS_WINT) + (size_t)l * NP * D, NTOK, (G == 256) ? NP - 256 : NP, D, G, bx);
            pg8::EpiBf16 E{(bf16_t*)(ws + WS_PROJ), NP};
            pg8::gemm_phase(lds, S, E);
            GRID_BAR();
        }
        if (IN(PH_MIX)) {
            if (G == 256 && bx < 64) {
                KArgs* ka = kargs(); unsigned char* ws = ka->ws;
                pg8::DenseOrder S; S.init((const bf16_t*)(ws + WS_HA), (const bf16_t*)(ws + WS_WINT) + (size_t)l * NP * D + (size_t)(NP - 256) * D, NTOK, 256, D, 64, bx);
                pg8::EpiBf16 E{(bf16_t*)(ws + WS_PROJ) + (NP - 256), NP};
                pg8::gemm_phase(lds, S, E);
            }
            phase_mix1(a, l, lds, vcu, G, bx); GRID_BAR();
        }
        if (IN(PH_A1)) { phase_a1(a, l, lds, vcu, G); GRID_BAR(); }
        if (IN(PH_A2)) { phase_a2(a, l, lds, vcu, G); GRID_BAR(); }
        if (IN(PH_G2)) {
            KArgs* ka = kargs(); unsigned char* ws = ka->ws; const float* xin = IN_F(I_X); const bf16_t* xinb = (l == 0) ? (const bf16_t*)nullptr : (const bf16_t*)(ws + WS_X1) + (size_t)NTOK * D; const float* mod = (const float*)(ws + WS_MOD) + (size_t)l * 4 * 6144;
            pg8::DenseOrder S; S.init((const bf16_t*)(ws + WS_MIXB), (const bf16_t*)(ws + WS_WOUTT) + (size_t)l * D * D, NTOK, D, D, G, bx);
            pg8::EpiResid E{xin, xinb, (bf16_t*)(ws + WS_X1), mod + 2048, (const float*)(ws + WS_SSQ) + (size_t)l * NTOK * 4};
            pg8::gemm_phase<pg8::EpiResid, pg8::DenseOrder, true>(lds, S, E);
            GRID_BAR();
        }
        if (IN(PH_ROUTE)) { phase_route(a, l, lds, vcu, G); GRID_BAR(); }
        if (IN(PH_UP)) {
            KArgs* ka = kargs(); unsigned char* ws = ka->ws;
            moe_cum(a, l, lds);
            pg8::MoeOrder<true> S; S.A = (const bf16_t*)(ws + WS_HA); S.Bt = (const bf16_t*)(ws + WS_WGUT) + (size_t)l * NE * 1024 * 1024; S.K = D; S.bstride = (size_t)1024 * 1024;
            S.list = (const int*)(ws + WS_LIST); S.cum = (const LAS int*)(lds + LDS_MISC + MISC_CUM); S.cnts = (const LAS int*)(lds + LDS_MISC + MISC_CNT); S.G = G; S.c = vcu; S.nun = S.cum[32] * 4;
            S.flag = (int*)(ws + WS_FLAG) + l * 160 * 8;
            pg8::EpiHid E{(bf16_t*)(ws + WS_HID)};
            pg8::gemm_phase(lds, S, E);
        }
        if (IN(PH_DOWN)) {
            KArgs* ka = kargs(); unsigned char* ws = ka->ws;
            moe_cum(a, l, lds);
            pg8::MoeOrder<false> S; S.A = (const bf16_t*)(ws + WS_HID); S.Bt = (const bf16_t*)(ws + WS_WDT) + (size_t)l * NE * 1024 * 512; S.K = F; S.bstride = (size_t)1024 * 512;
            S.list = nullptr; S.cum = (const LAS int*)(lds + LDS_MISC + MISC_CUM); S.cnts = (const LAS int*)(lds + LDS_MISC + MISC_CNT); S.G = G; S.c = G - 1 - vcu; S.nun = S.cum[32] * 4;
            S.flag = (int*)(ws + WS_FLAG) + l * 160 * 8;
            pg8::EpiDown E{(bf16_t*)(ws + WS_Y), (const float*)(ws + WS_LGATE)};
            pg8::gemm_phase(lds, S, E);
            GRID_BAR();
        }
        if (IN(PH_COMB)) { phase_combine(a, l, lds, vcu, G); GRID_BAR(); }
    }
#undef IN
#undef GRID_BAR
}


static void launch_ph(const Args& base, int grid, int l_lo, int l_hi, int ph_lo, int ph_hi, int fused, hipStream_t stream) {
    Args a = base; a.l_lo = l_lo; a.l_hi = l_hi; a.ph_lo = ph_lo; a.ph_hi = ph_hi; a.fused = fused; a.pad = 0;
    hipLaunchKernelGGL(mk_fwd, dim3(grid), dim3(NTHR), LDS_BYTES, stream, a);
}

extern "C" void kernel_launch(void* const* d_in, const int* in_sizes, int n_in, void* d_out, int out_size, void* d_ws, size_t ws_size, hipStream_t stream) {
    static int grid = 0;
    if (grid == 0) {
        int dev = 0, cus = 0;
        if (hipGetDevice(&dev) != hipSuccess || hipDeviceGetAttribute(&cus, hipDeviceAttributeMultiprocessorCount, dev) != hipSuccess) { grid = -1; return; }
        if (hipFuncSetAttribute((const void*)mk_fwd, hipFuncAttributeMaxDynamicSharedMemorySize, LDS_BYTES) != hipSuccess) { fprintf(stderr, "hipFuncSetAttribute failed\n"); grid = -1; return; }
        (void)hipGetLastError();
        grid = cus;
    }
    if (grid < 0) return;
    unsigned char* ws = (unsigned char*)d_ws;
    (void)hipMemsetAsync(ws, 0, WS_ZERO_BYTES, stream);
    Args a{};
    for (int i = 0; i < 32; ++i) a.in[i] = d_in[i];
    a.out = (float*)d_out; a.ws = ws;
#ifdef MK_MULTI
    launch_ph(a, grid, 0, 0, PH_PRO, PH_PRO + 1, 0, stream);
#ifdef MK_REP
    if (MK_REP == PH_PRO) launch_ph(a, grid, 0, 0, PH_PRO, PH_PRO + 1, 0, stream);
#endif
    launch_ph(a, grid, 0, 0, PH_NORM0, PH_NORM0 + 1, 0, stream);
#ifdef MK_REP
    if (MK_REP == PH_NORM0) launch_ph(a, grid, 0, 0, PH_NORM0, PH_NORM0 + 1, 0, stream);
#endif
    for (int l = 0; l < L; ++l)
        for (int ph = PH_G1; ph < PH_END; ++ph) {
            launch_ph(a, grid, l, l + 1, ph, ph + 1, 0, stream);
#ifdef MK_REP
            if (ph == MK_REP) launch_ph(a, grid, l, l + 1, ph, ph + 1, 0, stream);
#endif
        }
#else
    launch_ph(a, grid, 0, L, PH_PRO, PH_END, 1, stream);
#endif
}
```

```cpp
#include <hip/hip_runtime.h>
#include <stdint.h>
#include <stdio.h>

#define LAS __attribute__((address_space(3)))
typedef unsigned short bf16_t;
typedef short bf16x8 __attribute__((ext_vector_type(8)));
typedef float f32x4 __attribute__((ext_vector_type(4)));
typedef float f32x16 __attribute__((ext_vector_type(16)));
typedef unsigned u32x4 __attribute__((ext_vector_type(4)));
typedef unsigned u32x2 __attribute__((ext_vector_type(2)));

constexpr int Bn = 4, S = 4096, D = 1024, L = 2, NTOK = Bn * S, DIN = 2212, F = 512, NE = 32;
constexpr int NP = 2304;
constexpr int NK = 0, NV = 256, NIQ = 512, NIK = 640, NIW = 672, NBA = 768, NBG = 1024, NC = 1280, NDU = 1536, NDV = 1792, NQ = 2048;
constexpr float EPS = 1e-6f;
constexpr int NTHR = 512;
constexpr int SLOTS = 40960;

constexpr int LDS_BYTES = 163840, LDS_MISC = 147456;
constexpr int MISC_BAR = 0;
constexpr int MISC_CUM = 64;
constexpr int MISC_CNT = 64 + 160;

constexpr size_t al256c(size_t v) { return (v + 255) & ~(size_t)255; }
constexpr size_t WS_BAR = 0;
constexpr size_t WS_CNT = 16384;
constexpr size_t WS_FLAG = 16384 + 16384;
constexpr size_t WS_ZERO_BYTES = 16384 + 32768;
constexpr size_t WS_MOD = WS_ZERO_BYTES;
constexpr size_t WS_ROPEA = WS_MOD + al256c((size_t)L * 4 * 6144 * 4);
constexpr size_t WS_ROPEI = WS_ROPEA + al256c((size_t)NTOK * 16 * 4);
constexpr size_t WS_LIST = WS_ROPEI + al256c((size_t)NTOK * 8 * 4);
constexpr size_t WS_LGATE = WS_LIST + al256c((size_t)NE * NTOK * 4);
constexpr size_t WS_TOKINFO = WS_LGATE + al256c((size_t)NE * NTOK * 4);
constexpr size_t WS_SGUW = WS_TOKINFO + al256c((size_t)NTOK * 16);
constexpr size_t WS_POOLT = WS_SGUW + al256c((size_t)L * 4 * 128 * 128 * 2);
constexpr size_t WS_WHL = WS_POOLT + al256c((size_t)L * 4 * 64 * 64 * 2);
constexpr size_t WS_RBIAS = WS_WHL + al256c((size_t)L * 2 * 48 * 1024 * 2);
constexpr size_t WS_SSQ = WS_RBIAS + al256c((size_t)L * 4 * 32 * 48 * 4);
constexpr size_t WS_WINT = WS_SSQ + al256c((size_t)L * NTOK * 4 * 4);
constexpr size_t WS_WOUTT = WS_WINT + al256c((size_t)L * NP * D * 2);
constexpr size_t WS_PWT = WS_WOUTT + al256c((size_t)L * D * D * 2);
constexpr size_t WS_WGUT = WS_PWT + al256c((size_t)L * 256 * 256 * 2);
constexpr size_t WS_WDT = WS_WGUT + al256c((size_t)L * NE * 1024 * 1024 * 2);
constexpr size_t WS_HA = WS_WDT + al256c((size_t)L * NE * 1024 * 512 * 2);
constexpr size_t WS_X1 = WS_HA + al256c((size_t)NTOK * D * 2);
constexpr size_t WS_R = WS_X1 + al256c((size_t)NTOK * D * 4);
constexpr size_t WS_PROJ = WS_R;
constexpr size_t WS_R2 = WS_PROJ + al256c((size_t)NTOK * NP * 2);
constexpr size_t WS_HID = WS_R;
constexpr size_t WS_Y = WS_HID + al256c((size_t)SLOTS * F * 2);

__device__ __forceinline__ unsigned cvt_pk_bf16(float lo, float hi) { unsigned r; asm volatile("v_cvt_pk_bf16_f32 %0, %1, %2" : "=v"(r) : "v"(lo), "v"(hi)); return r; }
__device__ __forceinline__ float bf2f(bf16_t v) { return __uint_as_float(((unsigned)v) << 16); }
__device__ __forceinline__ float bflo(unsigned w) { return __uint_as_float(w << 16); }
__device__ __forceinline__ float bfhi(unsigned w) { return __uint_as_float(w & 0xffff0000u); }
template <int CTRL> __device__ __forceinline__ float dpp_f(float v) { return __builtin_bit_cast(float, __builtin_amdgcn_update_dpp(0, __builtin_bit_cast(int, v), CTRL, 0xF, 0xF, true)); }
__device__ __forceinline__ float row_sum16(float v) {
    v += dpp_f<0xB1>(v);
    v += dpp_f<0x4E>(v);
    v += dpp_f<0x141>(v);
    v += dpp_f<0x140>(v);
    return v;
}
__device__ __forceinline__ float wave_sum(float v) {
    v = row_sum16(v);
    const float r0 = __builtin_bit_cast(float, __builtin_amdgcn_readlane(__builtin_bit_cast(int, v), 0)), r1 = __builtin_bit_cast(float, __builtin_amdgcn_readlane(__builtin_bit_cast(int, v), 16));
    const float r2 = __builtin_bit_cast(float, __builtin_amdgcn_readlane(__builtin_bit_cast(int, v), 32)), r3 = __builtin_bit_cast(float, __builtin_amdgcn_readlane(__builtin_bit_cast(int, v), 48));
    return (r0 + r1) + (r2 + r3);
}
__device__ __forceinline__ float wave_max(float v) {
#pragma unroll
    for (int o = 32; o >= 1; o >>= 1) v = fmaxf(v, __shfl_xor(v, o));
    return v;
}
__device__ __forceinline__ float silu_f(float v) { return v / (1.0f + expf(-v)); }
__device__ __forceinline__ float silu_fast(float v) { return v * __builtin_amdgcn_rcpf(1.0f + __expf(-v)); }
__device__ __forceinline__ float sigmoid_f(float v) { return 1.0f / (1.0f + expf(-v)); }
__device__ __forceinline__ float sigmoid_fast(float v) { return __builtin_amdgcn_rcpf(1.0f + __expf(-v)); }
__device__ __forceinline__ int opaque_tid() { int t = threadIdx.x; asm volatile("" : "+v"(t)); return t; }
__device__ __forceinline__ int ld_agent(const int* p) { return __hip_atomic_load(p, __ATOMIC_RELAXED, __HIP_MEMORY_SCOPE_AGENT); }

#define XB_TMO      128
#define XB_XCNT(j)  (256  + 64 * (j))
#define XB_XSUB(j)  (1280 + 64 * (j))
#define XB_XGEN(j)  (2304 + 64 * (j))
#define XB_TOP      3328
#define XB_TOPGEN   3392
#define XCD_BAR_WORDS 3456
#define XB_SPIN_CAP (1u << 18)
__device__ __forceinline__ unsigned xb_ld(unsigned* p)              { return __hip_atomic_load(p, __ATOMIC_RELAXED, __HIP_MEMORY_SCOPE_AGENT); }
__device__ __forceinline__ unsigned xb_add(unsigned* p, unsigned v) { return __hip_atomic_fetch_add(p, v, __ATOMIC_RELAXED, __HIP_MEMORY_SCOPE_AGENT); }
__device__ __forceinline__ unsigned xb_xcc_id() { return (unsigned)__builtin_amdgcn_s_getreg((3 << 11) | 20) & 0xFu; }
#define XB_SPIN(cond, bar) do { unsigned _sp = 0; while (cond) { __builtin_amdgcn_s_sleep(1); \
    if ((++_sp & 255u) == 0u) { if (xb_ld(&(bar)[XB_TMO])) break; if (_sp > XB_SPIN_CAP) { atomicAdd(&(bar)[XB_TMO], 1u); break; } } } } while (0)
struct XcdBarrier { unsigned* bar; unsigned x; volatile LAS unsigned* st; };
__device__ __forceinline__ XcdBarrier xcd_barrier_post(unsigned* bar, volatile LAS unsigned* st) {
    XcdBarrier b; b.bar = bar; b.x = xb_xcc_id(); b.st = st;
    if (threadIdx.x == 0) (void)xb_add(&bar[XB_XCNT(b.x)], 1u);
    return b;
}
__device__ __forceinline__ void xcd_barrier_complete(unsigned* bar, unsigned x, unsigned& nloc, unsigned& nx) {
    const unsigned G = gridDim.x * gridDim.y * gridDim.z;
    unsigned sum, cnt, mine, sp = 0u;
    for (;;) {
        sum = 0u; cnt = 0u; mine = 0u;
#pragma unroll
        for (unsigned j = 0; j < 16; ++j) { const unsigned c = xb_ld(&bar[XB_XCNT(j)]); sum += c; cnt += (c > 0u) ? 1u : 0u; mine = (j == x) ? c : mine; }
        if (sum == G) break;
        __builtin_amdgcn_s_sleep(1);
        if ((++sp & 255u) == 0u) { if (xb_ld(&bar[XB_TMO])) break; if (sp > XB_SPIN_CAP) { atomicAdd(&bar[XB_TMO], 1u); break; } }
    }
    nloc = mine > 0u ? mine : 1u; nx = cnt > 0u ? cnt : 1u;
}
__device__ __forceinline__ void xcd_barrier(const XcdBarrier& b) {
    asm volatile("s_waitcnt vmcnt(0)" ::: "memory");
    __syncthreads();
    if (threadIdx.x == 0) {
        unsigned* bar = b.bar;
        __builtin_amdgcn_s_waitcnt(0);
        unsigned nloc = b.st[0], nx = b.st[1];
        if (nloc == 0u) { xcd_barrier_complete(bar, b.x, nloc, nx); b.st[0] = nloc; b.st[1] = nx; }
        const unsigned old = xb_add(&bar[XB_XSUB(b.x)], 1u);
        const unsigned gen = old / nloc;
        if (old + 1u == (gen + 1u) * nloc) {
            __builtin_amdgcn_fence(__ATOMIC_RELEASE, "agent");
            asm volatile("s_waitcnt vmcnt(0)" ::: "memory");
            const unsigned og = xb_add(&bar[XB_TOP], 1u);
            const unsigned tg = og / nx;
            if (og + 1u == (tg + 1u) * nx) xb_add(&bar[XB_TOPGEN], 1u);
            else XB_SPIN(xb_ld(&bar[XB_TOPGEN]) == tg, bar);
            __builtin_amdgcn_fence(__ATOMIC_ACQUIRE, "agent");
            xb_add(&bar[XB_XGEN(b.x)], 1u);
            asm volatile("s_waitcnt vmcnt(0)" ::: "memory");
        } else {
            XB_SPIN(xb_ld(&bar[XB_XGEN(b.x)]) == gen, bar);
            __builtin_amdgcn_fence(__ATOMIC_ACQUIRE, "agent");
            asm volatile("s_waitcnt vmcnt(0)" ::: "memory");
        }
    }
    __syncthreads();
}

namespace pg8 {
constexpr int BM = 256, BK = 64, HALF = 128, HTB = HALF * BK * 2, STAGE_BYTES = 8 * HTB, NXCD = 8, WGM = 8;
__host__ __device__ __forceinline__ int lds_byte(int r, int c) { const int st = (r >> 4) * 2 + (c >> 5), rr = r & 15, cc = c & 31, ob = rr * 64 + cc * 2; return st * 1024 + (ob ^ (((ob >> 9) & 1) << 5)); }
__host__ __device__ __forceinline__ void stage_rc(int b, int& R, int& C) { const int st = b / 1024, sb = b % 1024, swz = sb ^ (((sb >> 9) & 1) << 5); R = (st >> 1) * 16 + swz / 64; C = (st & 1) * 32 + (swz % 64) / 2; }
__host__ __device__ __forceinline__ int perm32(int rho) { const int n = rho >> 4, i = rho & 15; return 8 * (i >> 2) + 4 * n + (i & 3); }

struct Unit { int pm, pn, e, mt, cnt; };

struct DenseOrder {
    static constexpr int SYNC = 0;
    const bf16_t* A; const bf16_t* Bt; int K;
    int nM, nN, nwg, G, c;
    __device__ void init(const bf16_t* A_, const bf16_t* Bt_, int M, int N, int K_, int G_, int c_) { A = A_; Bt = Bt_; K = K_; nM = M / BM; nN = N / BM; nwg = nM * nN; G = G_; c = c_; }
    __device__ bool next(int i, Unit& u) const {
        const long Lx = (long)i * G + c; if (Lx >= nwg) return false;
        int wgid = (int)Lx; { const int q = nwg / NXCD, r = nwg % NXCD, xcd = wgid % NXCD, off = wgid / NXCD; wgid = (xcd < r ? xcd * (q + 1) : r * (q + 1) + (xcd - r) * q) + off; }
        const int nig = WGM * nN, gid = wgid / nig, fm = gid * WGM, gsz = (nM - fm) < WGM ? (nM - fm) : WGM;
        u.pm = fm + ((wgid % nig) % gsz); u.pn = (wgid % nig) / gsz; u.e = 0; u.mt = 0; u.cnt = 0; return true;
    }
    __device__ __forceinline__ const char* a_base(const Unit& u) const { return (const char*)A + (size_t)u.pm * BM * K * 2; }
    __device__ __forceinline__ unsigned a_voff(const Unit&, int row, int C) const { return (unsigned)(row * K + C) * 2u; }
    __device__ __forceinline__ const char* b_base(const Unit& u) const { return (const char*)Bt + (size_t)u.pn * BM * K * 2; }
};
template <bool gather> struct MoeOrder {
    static constexpr int SYNC = gather ? 1 : 2;
    int* flag;
    const bf16_t* A; const bf16_t* Bt; int K; size_t bstride;
    const int* list;
    const LAS int* cum; const LAS int* cnts;
    int G, c, nun;
    __device__ bool next(int i, Unit& u) const {
        const int Lx = i * G + c; if (Lx >= nun) return false;
        const int t = Lx >> 2; u.pn = Lx & 3; u.pm = t;
        int e = 0;
#pragma unroll 1
        for (int j = 1; j < NE; ++j) e += (cum[j] <= t) ? 1 : 0;
        u.e = e; u.mt = t - cum[e]; u.cnt = cnts[e]; return true;
    }
    __device__ __forceinline__ const char* a_base(const Unit& u) const { return gather ? (const char*)A : (const char*)A + (size_t)u.pm * BM * K * 2; }
    __device__ __forceinline__ unsigned a_voff(const Unit& u, int row, int C) const {
        if (gather) { const int pos = u.mt * BM + row; const int tok = (pos < u.cnt) ? list[(size_t)u.e * NTOK + pos] : 0; return (unsigned)(tok * K + C) * 2u; }
        return (unsigned)(row * K + C) * 2u;
    }
    __device__ __forceinline__ const char* b_base(const Unit& u) const { return (const char*)(Bt + (size_t)u.e * bstride) + (size_t)u.pn * BM * K * 2; }
};

struct EpiBf16 {
    static constexpr bool PERM = true;
    bf16_t* O; int ldc;
    __device__ __forceinline__ void operator()(const f32x4 (&acc)[2][2][4][2], const Unit& u, int wr, int wc, int fr, int fq) const {
        const int row0 = u.pm * BM + wr * 64 + fr, col0 = u.pn * BM + wc * 32 + 8 * fq;
#pragma unroll
        for (int ai = 0; ai < 2; ++ai)
#pragma unroll
            for (int m = 0; m < 4; ++m) { bf16_t* rowp = O + (size_t)(row0 + ai * HALF + m * 16) * ldc + col0;
#pragma unroll
                for (int bj = 0; bj < 2; ++bj) { const f32x4 v0 = acc[ai][bj][m][0], v1 = acc[ai][bj][m][1];
                    u32x4 w; w.x = cvt_pk_bf16(v0[0], v0[1]); w.y = cvt_pk_bf16(v0[2], v0[3]); w.z = cvt_pk_bf16(v1[0], v1[1]); w.w = cvt_pk_bf16(v1[2], v1[3]);
                    *(u32x4*)(rowp + bj * HALF) = w; } }
    }
};
struct EpiResid {
    static constexpr bool PERM = true;
    const float* X; const bf16_t* Xb; bf16_t* C; const float* gate;
    const float* ssq;
    __device__ __forceinline__ void rowscale(f32x4 (&acc)[2][2][4][2], const Unit& u, int wr, int fr) const {
        int rbase = u.pm * BM + wr * 64 + fr;
        asm volatile("" : "+v"(rbase));
#pragma unroll
        for (int ai = 0; ai < 2; ++ai)
#pragma unroll
            for (int m = 0; m < 4; ++m) { const f32x4 sv = *(const f32x4*)(ssq + (size_t)(rbase + ai * HALF + m * 16) * 4); const float r = rsqrtf(((sv[0] + sv[1]) + (sv[2] + sv[3])) * (1.0f / 256.0f) + EPS);
#pragma unroll
                for (int bj = 0; bj < 2; ++bj)
#pragma unroll
                    for (int n = 0; n < 2; ++n) acc[ai][bj][m][n] *= r; }
    }
    __device__ __forceinline__ void operator()(const f32x4 (&acc)[2][2][4][2], const Unit& u, int wr, int wc, int fr, int fq) const {
        const int row0 = u.pm * BM + wr * 64 + fr, col0 = u.pn * BM + wc * 32 + 8 * fq;
        const float* gp = gate + (size_t)((u.pm * BM) / S) * 6144 + col0;
        f32x4 gv[2][2];
#pragma unroll
        for (int bj = 0; bj < 2; ++bj)
#pragma unroll
            for (int n = 0; n < 2; ++n) gv[bj][n] = *(const f32x4*)(gp + bj * HALF + n * 4);
#pragma unroll
        for (int ai = 0; ai < 2; ++ai)
#pragma unroll
            for (int m = 0; m < 4; ++m) { const size_t off = (size_t)(row0 + ai * HALF + m * 16) * D + col0;
#pragma unroll
                for (int bj = 0; bj < 2; ++bj) {
                    f32x4 x0, x1v;
                    if (Xb) { const u32x4 xw = *(const u32x4*)(Xb + off + bj * HALF); x0 = (f32x4){bflo(xw.x), bfhi(xw.x), bflo(xw.y), bfhi(xw.y)}; x1v = (f32x4){bflo(xw.z), bfhi(xw.z), bflo(xw.w), bfhi(xw.w)}; }
                    else { x0 = *(const f32x4*)(X + off + bj * HALF); x1v = *(const f32x4*)(X + off + bj * HALF + 4); }
                    const f32x4 o0 = x0 + gv[bj][0] * acc[ai][bj][m][0], o1 = x1v + gv[bj][1] * acc[ai][bj][m][1];
                    u32x4 w; w.x = cvt_pk_bf16(o0[0], o0[1]); w.y = cvt_pk_bf16(o0[2], o0[3]); w.z = cvt_pk_bf16(o1[0], o1[1]); w.w = cvt_pk_bf16(o1[2], o1[3]);
                    *(u32x4*)(C + off + bj * HALF) = w; }
                asm volatile("" ::: "memory"); }
    }
};
__device__ __forceinline__ void store_wt16(void* ptr, u32x4 w) { asm volatile("global_store_dwordx4 %0, %1, off sc1\n\ts_nop 1" :: "v"(ptr), "v"(w) : "memory"); }
__device__ __forceinline__ void flag_wait(const int* flag, int want) {
    while (__hip_atomic_load(flag, __ATOMIC_RELAXED, __HIP_MEMORY_SCOPE_AGENT) < want) __builtin_amdgcn_s_sleep(1);
    __builtin_amdgcn_fence(__ATOMIC_ACQUIRE, "agent");
    asm volatile("s_waitcnt vmcnt(0)" ::: "memory");
}
struct EpiHid {
    static constexpr bool PERM = true;
    bf16_t* H;
    __device__ __forceinline__ void operator()(const f32x4 (&acc)[2][2][4][2], const Unit& u, int wr, int wc, int fr, int fq) const {
        const int row0 = u.pm * BM + wr * 64 + fr, col0 = u.pn * HALF + wc * 32 + 8 * fq;
#pragma unroll
        for (int ai = 0; ai < 2; ++ai)
#pragma unroll
            for (int m = 0; m < 4; ++m) { float h[8];
#pragma unroll
                for (int n = 0; n < 2; ++n)
#pragma unroll
                    for (int j = 0; j < 4; ++j) h[n * 4 + j] = silu_fast(acc[ai][0][m][n][j]) * acc[ai][1][m][n][j];
                u32x4 w; w.x = cvt_pk_bf16(h[0], h[1]); w.y = cvt_pk_bf16(h[2], h[3]); w.z = cvt_pk_bf16(h[4], h[5]); w.w = cvt_pk_bf16(h[6], h[7]);
                store_wt16(H + (size_t)(row0 + ai * HALF + m * 16) * F + col0, w); }
    }
};
struct EpiDown {
    static constexpr bool PERM = true;
    bf16_t* Y; const float* lgate;
    __device__ __forceinline__ void operator()(const f32x4 (&acc)[2][2][4][2], const Unit& u, int wr, int wc, int fr, int fq) const {
        const int rl0 = wr * 64 + fr, col0 = u.pn * BM + wc * 32 + 8 * fq;
        const float* gp = lgate + (size_t)u.e * NTOK + u.mt * BM;
#pragma unroll
        for (int ai = 0; ai < 2; ++ai)
#pragma unroll
            for (int m = 0; m < 4; ++m) { const int rl = rl0 + ai * HALF + m * 16; const float g = (u.mt * BM + rl < u.cnt) ? gp[rl] : 0.f;
                bf16_t* rowp = Y + (size_t)(u.pm * BM + rl) * D + col0;
#pragma unroll
                for (int bj = 0; bj < 2; ++bj) { const f32x4 v0 = acc[ai][bj][m][0] * g, v1 = acc[ai][bj][m][1] * g;
                    u32x4 w; w.x = cvt_pk_bf16(v0[0], v0[1]); w.y = cvt_pk_bf16(v0[2], v0[3]); w.z = cvt_pk_bf16(v1[0], v1[1]); w.w = cvt_pk_bf16(v1[2], v1[3]);
                    *(u32x4*)(rowp + bj * HALF) = w; } }
    }
};

template <class Epi, class Sched, bool RSC = false>
__device__ __forceinline__ void gemm_phase(LAS unsigned char* lds, const Sched& S, const Epi& E) {
    const int tid = opaque_tid(), wid = __builtin_amdgcn_readfirstlane(tid >> 6), lane = tid & 63, wr = wid >> 2, wc = wid & 3, fr = lane & 15, fq = lane >> 4;
    const int K = S.K, nt = K / BK;
    int Rr[2], Cc[2]; unsigned voffB[2];
#pragma unroll
    for (int i = 0; i < 2; ++i) { stage_rc(tid * 16 + i * 8192, Rr[i], Cc[i]); const int Rb = Epi::PERM ? ((Rr[i] & ~31) + perm32(Rr[i] & 31)) : Rr[i]; voffB[i] = (unsigned)(Rb * K + Cc[i]) * 2u; }
    const size_t kstep = (size_t)(BK * 2);
    const size_t hstep = (size_t)HALF * K * 2;
    const unsigned ldsw = (unsigned)wid * 1024u;
    const int aoff = lds_byte(wr * 64 + fr, fq * 8), boff = lds_byte(wc * 32 + fr, fq * 8);
#define PG8_SA(b, h) (((b) * 2 + (h)) * HTB)
#define PG8_SB(b, h) ((4 + (b) * 2 + (h)) * HTB)
#define PG8_STAGE(bufoff, gbase, voff) do { _Pragma("unroll") for (int _i = 0; _i < 2; ++_i) \
        __builtin_amdgcn_global_load_lds((const unsigned*)((const char*)(gbase) + (voff)[_i]), (LAS unsigned*)(lds + (bufoff) + ldsw + _i * 8192), 16, 0, 0); } while (0)
#define PG8_LDA(dst, b, h) do { _Pragma("unroll") for (int m = 0; m < 4; ++m) _Pragma("unroll") for (int k = 0; k < 2; ++k) dst[m][k] = *(const LAS bf16x8*)(lds + PG8_SA(b, h) + aoff + m * 2048 + k * 1024); } while (0)
#define PG8_LDB(dst, b, h) do { _Pragma("unroll") for (int n = 0; n < 2; ++n) _Pragma("unroll") for (int k = 0; k < 2; ++k) dst[n][k] = *(const LAS bf16x8*)(lds + PG8_SB(b, h) + boff + n * 2048 + k * 1024); } while (0)
#define PG8_MMA(ai, bj, At, Bt) do { __builtin_amdgcn_s_setprio(1); _Pragma("unroll") for (int m = 0; m < 4; ++m) _Pragma("unroll") for (int n = 0; n < 2; ++n) _Pragma("unroll") for (int k = 0; k < 2; ++k) \
        acc[ai][bj][m][n] = __builtin_amdgcn_mfma_f32_16x16x32_bf16(Bt[n][k], At[m][k], acc[ai][bj][m][n], 0, 0, 0); __builtin_amdgcn_s_setprio(0); } while (0)
#define PG8_WAIT_V(n) asm volatile("s_waitcnt vmcnt(" #n ")" ::: "memory")
#define PG8_WAIT_L(n) asm volatile("s_waitcnt lgkmcnt(" #n ")" ::: "memory")
#define PG8_BAR __builtin_amdgcn_s_barrier()
#define PG8_SCHED __builtin_amdgcn_sched_barrier(0)
    Unit cur, nxt; int ui = 0;
    if (!S.next(0, cur)) return;
    if constexpr (Sched::SYNC == 2) { if (wid == 0) flag_wait(S.flag + cur.pm * 8, 4); __builtin_amdgcn_s_barrier(); }
    f32x4 acc[2][2][4][2];
#pragma unroll
    for (int a = 0; a < 2; ++a)
#pragma unroll
        for (int b = 0; b < 2; ++b)
#pragma unroll
            for (int m = 0; m < 4; ++m)
#pragma unroll
                for (int n = 0; n < 2; ++n) acc[a][b][m][n] = (f32x4){0.f, 0.f, 0.f, 0.f};
    bf16x8 At[4][2], B0[2][2], B1[2][2];
    unsigned vA0[2], vA1[2], vN0[2], vN1[2];
#pragma unroll
    for (int i = 0; i < 2; ++i) { vA0[i] = S.a_voff(cur, Rr[i], Cc[i]); vA1[i] = S.a_voff(cur, HALF + Rr[i], Cc[i]); }
    const char* cA = S.a_base(cur); const char* cB = S.b_base(cur);
    PG8_STAGE(PG8_SB(0, 0), cB, voffB); PG8_STAGE(PG8_SB(0, 1), cB + hstep, voffB); PG8_STAGE(PG8_SA(0, 0), cA, vA0); PG8_STAGE(PG8_SA(0, 1), cA, vA1);
    if (wr == 1) PG8_BAR;
    PG8_WAIT_V(2); PG8_BAR;
    PG8_STAGE(PG8_SB(1, 0), cB + kstep, voffB); PG8_STAGE(PG8_SA(1, 0), cA + kstep, vA0); PG8_STAGE(PG8_SB(1, 1), cB + hstep + kstep, voffB);
    PG8_WAIT_V(6); PG8_BAR;
    for (;;) {
        const bool has_next = S.next(ui + 1, nxt);
        const char* nA = has_next ? S.a_base(nxt) : cA; const char* nB = has_next ? S.b_base(nxt) : cB;
#pragma unroll
        for (int i = 0; i < 2; ++i) { vN0[i] = has_next ? S.a_voff(nxt, Rr[i], Cc[i]) : vA0[i]; vN1[i] = has_next ? S.a_voff(nxt, HALF + Rr[i], Cc[i]) : vA1[i]; }
        for (int t = 0; t < nt; t += 2) {
            const bool last = (t == nt - 2);
            if constexpr (Sched::SYNC == 2) { if (last && has_next && wid == 0) flag_wait(S.flag + nxt.pm * 8, 4); }
            if constexpr (RSC) { if (t == 4) E.rowscale(acc, cur, wr, fr); }
            const char* a1 = cA + (size_t)(t + 1) * kstep;
            const char* a2 = last ? nA : cA + (size_t)(t + 2) * kstep; const char* b2 = last ? nB : cB + (size_t)(t + 2) * kstep;
            const char* a3 = a2 + kstep; const char* b3 = b2 + kstep;
            unsigned w0[2], w1[2];
#pragma unroll
            for (int i = 0; i < 2; ++i) { w0[i] = last ? vN0[i] : vA0[i]; w1[i] = last ? vN1[i] : vA1[i]; }
            PG8_LDB(B0, 0, 0); PG8_LDB(B1, 0, 1); PG8_SCHED; PG8_LDA(At, 0, 0); PG8_STAGE(PG8_SA(1, 1), a1, vA1);
            PG8_WAIT_V(8); PG8_WAIT_L(0); PG8_BAR; PG8_MMA(0, 0, At, B0); PG8_MMA(0, 1, At, B1); PG8_BAR; PG8_SCHED;
            PG8_LDA(At, 0, 1); PG8_STAGE(PG8_SB(0, 0), b2, voffB); PG8_STAGE(PG8_SB(0, 1), b2 + hstep, voffB); PG8_STAGE(PG8_SA(0, 0), a2, w0);
            PG8_WAIT_V(8); PG8_WAIT_L(0); PG8_BAR; PG8_MMA(1, 0, At, B0); PG8_MMA(1, 1, At, B1); PG8_BAR; PG8_SCHED;
            PG8_LDB(B0, 1, 0); PG8_LDB(B1, 1, 1); PG8_SCHED; PG8_LDA(At, 1, 0); PG8_STAGE(PG8_SA(0, 1), a2, w1);
            PG8_WAIT_V(8); PG8_WAIT_L(0); PG8_BAR; PG8_MMA(0, 0, At, B0); PG8_MMA(0, 1, At, B1); PG8_BAR; PG8_SCHED;
            PG8_LDA(At, 1, 1); PG8_STAGE(PG8_SB(1, 0), b3, voffB); PG8_STAGE(PG8_SB(1, 1), b3 + hstep, voffB); PG8_STAGE(PG8_SA(1, 0), a3, w0);
            PG8_WAIT_V(8); PG8_WAIT_L(0); PG8_BAR; PG8_MMA(1, 0, At, B0); PG8_MMA(1, 1, At, B1); PG8_BAR; PG8_SCHED;
        }
        if (wr == 0) PG8_BAR;
        E(acc, cur, wr, wc, fr, fq);
        if constexpr (Sched::SYNC == 1) { PG8_WAIT_V(0); PG8_BAR; if (tid == 0) __hip_atomic_fetch_add(S.flag + cur.pm * 8, 1, __ATOMIC_RELAXED, __HIP_MEMORY_SCOPE_AGENT); }
        if (!has_next) break;
#pragma unroll
        for (int a = 0; a < 2; ++a)
#pragma unroll
            for (int b = 0; b < 2; ++b)
#pragma unroll
                for (int m = 0; m < 4; ++m)
#pragma unroll
                    for (int n = 0; n < 2; ++n) acc[a][b][m][n] = (f32x4){0.f, 0.f, 0.f, 0.f};
        cur = nxt; cA = nA; cB = nB; ++ui;
#pragma unroll
        for (int i = 0; i < 2; ++i) { vA0[i] = vN0[i]; vA1[i] = vN1[i]; }
        if (wr == 1) PG8_BAR;
    }
    PG8_WAIT_V(0);
    PG8_BAR;
#undef PG8_SA
#undef PG8_SB
#undef PG8_STAGE
#undef PG8_LDA
#undef PG8_LDB
#undef PG8_MMA
#undef PG8_WAIT_V
#undef PG8_WAIT_L
#undef PG8_BAR
#undef PG8_SCHED
}
}
struct Args { const void* in[32]; float* out; unsigned char* ws; int l_lo, l_hi, ph_lo, ph_hi, fused, pad; };
enum { PH_PRO = 0, PH_NORM0 = 1, PH_G1 = 2, PH_MIX = 3, PH_A1 = 4, PH_A2 = 5, PH_AN = 6, PH_G2 = 7, PH_ROUTE = 8, PH_UP = 9, PH_DOWN = 10, PH_COMB = 11, PH_END = 12 };

typedef const Args __attribute__((address_space(4))) KArgs;
__device__ __forceinline__ KArgs* kargs() { KArgs* p = (KArgs*)__builtin_amdgcn_kernarg_segment_ptr(); asm volatile("" : "+s"(p)); return p; }
#define IN_F(i) ((const float*)ka->in[i])
enum { I_X = 0, I_C, I_POS, I_WADA, I_BADA, I_NORM1, I_WIN, I_QN, I_KN, I_CONVW, I_CONVB, I_CLNG, I_CLNB, I_PWW, I_PWB, I_POOLW, I_POOLB, I_POOLS, I_SLNG, I_SLNB, I_SGUW, I_SGUB,
       I_ONORM, I_WOUT, I_NORM2, I_WRG, I_BRG, I_WRE, I_BRE, I_WG, I_WU, I_WD };

__device__ __forceinline__ void sincos_d(double a, double& s, double& c) {
    const double k = rint(a * 0.63661977236758134308);
    const double r = (a - k * 1.57079632679489655800) - k * 6.123233995736766036e-17;
    const double r2 = r * r;
    const double sp = r * (1.0 + r2 * (-1.0 / 6 + r2 * (1.0 / 120 + r2 * (-1.0 / 5040 + r2 * (1.0 / 362880 + r2 * (-1.0 / 39916800 + r2 * (1.0 / 6227020800.0)))))));
    const double cp = 1.0 + r2 * (-0.5 + r2 * (1.0 / 24 + r2 * (-1.0 / 720 + r2 * (1.0 / 40320 + r2 * (-1.0 / 3628800 + r2 * (1.0 / 479001600.0 + r2 * (-1.0 / 87178291200.0)))))));
    const int q = ((int)k) & 3;
    if (q == 0) { s = sp; c = cp; } else if (q == 1) { s = cp; c = -sp; } else if (q == 2) { s = -sp; c = -cp; } else { s = -cp; c = sp; }
}

__device__ __forceinline__ bf16_t f2bf_(float f) { return (bf16_t)(cvt_pk_bf16(f, 0.f) & 0xffffu); }
struct TItem { const float* src; int ld; int ncol; bf16_t* dst; int ldd; const float* rsc; };
constexpr int NT_WIN = L * 36 * 4, NT_WOUT = L * 16 * 4, NT_PW = L * 4, NT_WGU = L * NE * 16 * 4, NT_WD = L * NE * 16 * 2;
constexpr int NT_ALL = NT_WIN + NT_WOUT + NT_PW + NT_WGU + NT_WD;
__device__ __forceinline__ void decode_titem(int it, const Args& a, TItem& t) {
    KArgs* ka = kargs();
    unsigned char* ws = ka->ws;
    t.rsc = nullptr;
    if (it < NT_WIN) {
        const int l = it / 144, r = it % 144, n0 = (r >> 2) * 64, k0 = (r & 3) * 256;
        const int c0 = n0 < 768 ? n0 + 256 : (n0 < 2048 ? n0 + 164 : n0 - 2048);
        t.ncol = (n0 < 768) ? ((n0 + 64 <= 676) ? 64 : (n0 < 676 ? 676 - n0 : 0)) : 64;
        t.src = IN_F(I_WIN) + ((size_t)l * D + k0) * DIN + c0; t.ld = DIN;
        t.dst = (bf16_t*)(ws + WS_WINT) + ((size_t)l * NP + n0) * D + k0; t.ldd = D; return;
    }
    it -= NT_WIN;
    if (it < NT_WOUT) {
        const int l = it / 64, r = it % 64, n0 = (r >> 2) * 64, k0 = (r & 3) * 256;
        t.ncol = 64; t.src = IN_F(I_WOUT) + ((size_t)l * D + k0) * D + n0; t.ld = D; t.rsc = (k0 == 0) ? IN_F(I_ONORM) + l * D : nullptr;
        t.dst = (bf16_t*)(ws + WS_WOUTT) + ((size_t)l * D + n0) * D + k0; t.ldd = D; return;
    }
    it -= NT_WOUT;
    if (it < NT_PW) {
        const int l = it / 4, n0 = (it & 3) * 64;
        t.ncol = 64; t.src = IN_F(I_PWW) + (size_t)l * 65536 + n0; t.ld = 256;
        t.dst = (bf16_t*)(ws + WS_PWT) + ((size_t)l * 256 + n0) * 256; t.ldd = 256; return;
    }
    it -= NT_PW;
    if (it < NT_WGU) {
        const int le = it / 64, r = it % 64, n0 = (r >> 2) * 64, k0 = (r & 3) * 256;
        const int pn = n0 >> 8, rr = n0 & 255;
        const float* W = (rr < 128) ? IN_F(I_WG) : IN_F(I_WU);
        t.ncol = 64; t.src = W + ((size_t)le * D + k0) * F + pn * 128 + (rr & 127); t.ld = F;
        t.dst = (bf16_t*)(ws + WS_WGUT) + ((size_t)le * 1024 + n0) * D + k0; t.ldd = D; return;
    }
    it -= NT_WGU;
    {
        const int le = it / 32, r = it % 32, n0 = (r >> 1) * 64, k0 = (r & 1) * 256;
        t.ncol = 64; t.src = IN_F(I_WD) + ((size_t)le * F + k0) * D + n0; t.ld = D;
        t.dst = (bf16_t*)(ws + WS_WDT) + ((size_t)le * D + n0) * F + k0; t.ldd = F;
    }
}
__device__ __forceinline__ void titem_load(const TItem& t, int tid, float4 (&v)[8]) {
    const int c4 = tid & 15, r0 = tid >> 4;
#pragma unroll
    for (int i = 0; i < 8; ++i) v[i] = (c4 * 4 < t.ncol) ? *(const float4*)(t.src + (size_t)(r0 + 32 * i) * t.ld + c4 * 4) : make_float4(0.f, 0.f, 0.f, 0.f);
    if (t.rsc) {
#pragma unroll
        for (int i = 0; i < 8; ++i) { const float s = t.rsc[r0 + 32 * i]; v[i].x *= s; v[i].y *= s; v[i].z *= s; v[i].w *= s; }
    }
}
__device__ __forceinline__ void phase_prologue(const Args& a, LAS unsigned char* lds, int vcu, int G) {
    KArgs* ka = kargs();
    const int tid = opaque_tid(), wid = __builtin_amdgcn_readfirstlane(tid >> 6), lane = tid & 63;
    LAS float* T = (LAS float*)lds;
    LAS float* cs = (LAS float*)(lds + 66560);
    LAS float* red = (LAS float*)(lds + 66560 + 16384);
    unsigned char* ws = ka->ws;
    if (vcu < 192) {
        for (int i = tid; i < 4096; i += NTHR) cs[i] = silu_f(IN_F(I_C)[i]);
        __syncthreads();
        for (int it = vcu; it < 192; it += G) {
            const int l = it / 96, j0 = (it % 96) * 64;
            const float* wp = IN_F(I_WADA) + ((size_t)l * D + wid * 128) * 6144 + j0 + lane;
            float a0 = 0.f, a1 = 0.f, a2 = 0.f, a3 = 0.f;
#pragma unroll 32
            for (int k = 0; k < 128; ++k) { const float wv = wp[(size_t)k * 6144]; const int kk = wid * 128 + k; a0 += cs[kk] * wv; a1 += cs[1024 + kk] * wv; a2 += cs[2048 + kk] * wv; a3 += cs[3072 + kk] * wv; }
            red[(wid * 4 + 0) * 64 + lane] = a0; red[(wid * 4 + 1) * 64 + lane] = a1; red[(wid * 4 + 2) * 64 + lane] = a2; red[(wid * 4 + 3) * 64 + lane] = a3;
            __syncthreads();
            if (wid < 4) { float s = 0.f;
#pragma unroll
                for (int w = 0; w < 8; ++w) s += red[(w * 4 + wid) * 64 + lane];
                ((float*)(ws + WS_MOD))[((size_t)l * 4 + wid) * 6144 + j0 + lane] = s + IN_F(I_BADA)[l * 6144 + j0 + lane]; }
            __syncthreads();
        }
    }
    for (int i = vcu * NTHR + tid; i < NTOK; i += G * NTHR) {
        const float invA[8] = {1.0f, 0.1939227432012558f, 0.03760603070259094f, 0.007292664609849453f, 0.0014142135623842478f, 0.00027424818836152554f, 5.318296098266728e-05f, 1.0313386155758053e-05f};
        const float invI[4] = {1.0f, 0.03760603070259094f, 0.0014142135623842478f, 5.318296098266728e-05f};
        const float p = (float)((const int*)ka->in[I_POS])[i];
        float* ra = (float*)(ws + WS_ROPEA) + (size_t)i * 16; float* ri = (float*)(ws + WS_ROPEI) + (size_t)i * 8;
#pragma unroll
        for (int j = 0; j < 8; ++j) { const float ang = p * invA[j]; double s, c; sincos_d((double)ang, s, c); ra[j] = (float)c; ra[8 + j] = (float)s; }
#pragma unroll
        for (int j = 0; j < 4; ++j) { const float ang = p * invI[j]; double s, c; sincos_d((double)ang, s, c); ri[j] = (float)c; ri[4 + j] = (float)s; }
    }
    for (int i = vcu * NTHR + tid; i < L * 4 * 128 * 128; i += G * NTHR) { const int s = i & 127, t = (i >> 7) & 127; ((bf16_t*)(ws + WS_SGUW))[i] = (bf16_t)(cvt_pk_bf16(s <= t ? IN_F(I_SGUW)[i] : 0.f, 0.f) & 0xffffu); }
    for (int i = vcu * NTHR + tid; i < L * 4 * 64 * 64; i += G * NTHR) { const int c = i & 63, d = (i >> 6) & 63, lg = i >> 12; ((bf16_t*)(ws + WS_POOLT))[i] = (bf16_t)(cvt_pk_bf16(IN_F(I_POOLW)[((size_t)lg * 64 + c) * 64 + d], 0.f) & 0xffffu); }
    for (int i = vcu * NTHR + tid; i < L * 48 * 1024; i += G * NTHR) {
        const int k = i & 1023, n = (i >> 10) % 48, lg = i / (48 * 1024);
        const float w = (n < 4) ? IN_F(I_WRG)[((size_t)lg * D + k) * 4 + n] : (n < 36) ? IN_F(I_WRE)[((size_t)lg * D + k) * 32 + (n - 4)] : 0.f;
        const unsigned hi = cvt_pk_bf16(w, 0.f) & 0xffffu; const float lo = w - __uint_as_float(hi << 16);
        bf16_t* dst = (bf16_t*)(ws + WS_WHL) + (size_t)lg * 2 * 48 * 1024 + (size_t)n * 1024 + k;
        dst[0] = (bf16_t)hi; dst[48 * 1024] = f2bf_(lo);
    }
    int* qctr = (int*)(ws + WS_FLAG + 12288);
    LAS int* qn = (LAS int*)(lds + LDS_MISC + 512);
    int pend = 0;
    if (tid == 0) { qn[0] = __hip_atomic_fetch_add(qctr, 1, __ATOMIC_RELAXED, __HIP_MEMORY_SCOPE_AGENT); pend = __hip_atomic_fetch_add(qctr, 1, __ATOMIC_RELAXED, __HIP_MEMORY_SCOPE_AGENT); }
    __syncthreads();
    int it = qn[0];
    bool have = it < NT_ALL;
    TItem cur; cur.src = nullptr; cur.ld = 0; cur.ncol = 0; cur.dst = nullptr; cur.ldd = 0; cur.rsc = nullptr;
    float4 v[8];
    if (have) { decode_titem(it, a, cur); titem_load(cur, tid, v); }
    int par = 1;
    while (have) {
        { const int c4 = tid & 15, r0 = tid >> 4;
#pragma unroll
          for (int i = 0; i < 8; ++i) { LAS float* tp = T + (r0 + 32 * i) * 65 + c4 * 4; tp[0] = v[i].x; tp[1] = v[i].y; tp[2] = v[i].z; tp[3] = v[i].w; } }
        if (tid == 0) qn[par] = pend;
        __syncthreads();
        const int itn = qn[par]; const bool hn = itn < NT_ALL; TItem nx = cur;
        if (tid == 0 && hn) pend = __hip_atomic_fetch_add(qctr, 1, __ATOMIC_RELAXED, __HIP_MEMORY_SCOPE_AGENT);
        if (hn) { decode_titem(itn, a, nx); titem_load(nx, tid, v); }
        { const int n = tid >> 3, kq = tid & 7;
#pragma unroll
          for (int j = 0; j < 4; ++j) { const int kc = j * 8 + kq; float f[8];
#pragma unroll
              for (int jj = 0; jj < 8; ++jj) f[jj] = T[(kc * 8 + jj) * 65 + n];
              u32x4 w; w.x = cvt_pk_bf16(f[0], f[1]); w.y = cvt_pk_bf16(f[2], f[3]); w.z = cvt_pk_bf16(f[4], f[5]); w.w = cvt_pk_bf16(f[6], f[7]);
              *(u32x4*)(cur.dst + (size_t)n * cur.ldd + kc * 8) = w; } }
        __syncthreads();
        cur = nx; it = itn; have = hn; par ^= 1;
    }
}

__device__ __forceinline__ void phase_norm(const float* __restrict__ xin, const float* g, const float* shift, const float* scale, bf16_t* __restrict__ out, int vcu, int G) {
    const int tid = opaque_tid(), wid = __builtin_amdgcn_readfirstlane(tid >> 6), lane = tid & 63;
    for (int rb = vcu * 8 + wid; rb < NTOK / 8; rb += G * 8) {
        const int row0 = rb * 8, b = row0 / S;
        float4 A[4], C[4];
#pragma unroll
        for (int i = 0; i < 4; ++i) { const int k = 256 * i + 4 * lane; const float4 gv = *(const float4*)(g + k), sc = *(const float4*)(scale + (size_t)b * 6144 + k); C[i] = *(const float4*)(shift + (size_t)b * 6144 + k);
            A[i] = make_float4(gv.x * (1.f + sc.x), gv.y * (1.f + sc.y), gv.z * (1.f + sc.z), gv.w * (1.f + sc.w)); }
#pragma unroll 4
        for (int rr = 0; rr < 8; ++rr) {
            const size_t ro = (size_t)(row0 + rr) * D;
            float4 x[4]; float ss = 0.f;
#pragma unroll
            for (int i = 0; i < 4; ++i) { x[i] = *(const float4*)(xin + ro + 256 * i + 4 * lane); ss += x[i].x * x[i].x + x[i].y * x[i].y + x[i].z * x[i].z + x[i].w * x[i].w; }
            const float r = rsqrtf(wave_sum(ss) * (1.0f / D) + EPS);
#pragma unroll
            for (int i = 0; i < 4; ++i) { u32x2 w; w.x = cvt_pk_bf16(x[i].x * r * A[i].x + C[i].x, x[i].y * r * A[i].y + C[i].y); w.y = cvt_pk_bf16(x[i].z * r * A[i].z + C[i].z, x[i].w * r * A[i].w + C[i].w);
                *(u32x2*)(out + ro + 256 * i + 4 * lane) = w; }
        }
    }
}

__device__ __forceinline__ f32x4 mfma16r(const bf16x8 a, const bf16x8 b, const f32x4 c) { return __builtin_amdgcn_mfma_f32_16x16x32_bf16(a, b, c, 0, 0, 0); }
__device__ __forceinline__ void phase_rbias(const Args& a, LAS unsigned char* lds, int vcu, int G) {
    KArgs* ka = kargs();
    const int tid = opaque_tid();
    LAS float* red = (LAS float*)lds;
    for (int v = vcu; v < 256; v += G) {
        const int lb = v & 7, sl = v >> 3, l = lb >> 2, b = lb & 3, n = tid & 63, kp = tid >> 6;
        const float* sh = (const float*)(ka->ws + WS_MOD) + ((size_t)l * 4 + b) * 6144 + 3072;
        float s = 0.f;
        if (n < 36) {
#pragma unroll
            for (int i = 0; i < 4; ++i) { const int k = sl * 32 + kp * 4 + i; s += sh[k] * ((n < 4) ? IN_F(I_WRG)[((size_t)l * D + k) * 4 + n] : IN_F(I_WRE)[((size_t)l * D + k) * 32 + (n - 4)]); }
        }
        red[kp * 64 + n] = s;
        __syncthreads();
        if (tid < 48) { float t = 0.f;
            if (tid < 36) { for (int w = 0; w < 8; ++w) t += red[w * 64 + tid]; }
            ((float*)(ka->ws + WS_RBIAS))[((size_t)lb * 32 + sl) * 48 + tid] = t; }
        __syncthreads();
    }
}

__device__ __forceinline__ void phase_route(const Args& a, int l, LAS unsigned char* lds, int vcu, int G) {
    KArgs* ka = kargs();
    const int tid = opaque_tid(), wid = __builtin_amdgcn_readfirstlane(tid >> 6), lane = tid & 63, fr = lane & 15, kq = lane >> 4;
    unsigned char* ws = ka->ws;
    const bf16_t* x1 = (const bf16_t*)(ws + WS_X1);
    const float* mod = (const float*)(ws + WS_MOD) + (size_t)l * 4 * 6144;
    const float* g = IN_F(I_NORM2) + l * D; const float* shift = mod + 3072; const float* scale = mod + 4096;
    bf16_t* out = (bf16_t*)(ws + WS_HA);
    int* counts = (int*)(ws + WS_CNT) + l * NE * 64; int* list = (int*)(ws + WS_LIST); float* lgate = (float*)(ws + WS_LGATE); int* tokinfo = (int*)(ws + WS_TOKINFO);
    LAS int* lcnt = (LAS int*)(lds + LDS_MISC + 1024); LAS int* lbase = lcnt + 32; LAS int* rte = lbase + 32; LAS int* rtp = rte + 128; LAS int* rtt = rtp + 128; LAS float* rtg = (LAS float*)(rtt + 128);
    LAS float* part = (LAS float*)lds;
    LAS float* ssp = part + 8 * 16 * 48;
    LAS float* lgt = ssp + 8 * 16;
    LAS float* rrow = lgt + 16 * 48;
    const bf16_t* wh = (const bf16_t*)(ws + WS_WHL) + (size_t)l * 2 * 48 * 1024 + (size_t)fr * 1024 + 128 * wid + 8 * kq;
    LAS float* rb = (LAS float*)(lds + LDS_MISC + 8192);
    for (int r0 = vcu * 64; r0 < NTOK; r0 += G * 64) {
        const int b = r0 / S;
        if (tid < 48) { const float* rp = (const float*)(ws + WS_RBIAS) + ((size_t)(l * 4 + b) * 32) * 48 + tid; float t = 0.f;
            for (int sl = 0; sl < 32; ++sl) t += rp[sl * 48];
            if (tid < 36) t += (tid < 4) ? IN_F(I_BRG)[l * 4 + tid] : IN_F(I_BRE)[l * 32 + tid - 4];
            rb[tid] = t; }
        if (tid < 32) lcnt[tid] = 0;
#pragma unroll 1
        for (int q4 = 0; q4 < 4; ++q4) {
            float t[4][8];
            f32x4 acc[3];
#pragma unroll
            for (int nt = 0; nt < 3; ++nt) acc[nt] = (f32x4){0.f, 0.f, 0.f, 0.f};
            float ss = 0.f;
            const int row = r0 + 16 * q4 + fr;
#pragma unroll
            for (int ks = 0; ks < 4; ++ks) {
                const int k0 = 128 * wid + 32 * ks + 8 * kq;
                const f32x4 g0 = *(const f32x4*)(g + k0), g1 = *(const f32x4*)(g + k0 + 4), s0 = *(const f32x4*)(scale + (size_t)b * 6144 + k0), s1 = *(const f32x4*)(scale + (size_t)b * 6144 + k0 + 4);
                const float Ac[8] = {g0[0] * (1.f + s0[0]), g0[1] * (1.f + s0[1]), g0[2] * (1.f + s0[2]), g0[3] * (1.f + s0[3]), g1[0] * (1.f + s1[0]), g1[1] * (1.f + s1[1]), g1[2] * (1.f + s1[2]), g1[3] * (1.f + s1[3])};
                const u32x4 xw = *(const u32x4*)(x1 + (size_t)row * D + k0);
                const float v[8] = {bflo(xw.x), bfhi(xw.x), bflo(xw.y), bfhi(xw.y), bflo(xw.z), bfhi(xw.z), bflo(xw.w), bfhi(xw.w)};
                unsigned ph[4], pl[4];
#pragma unroll
                for (int j = 0; j < 8; ++j) { ss += v[j] * v[j]; t[ks][j] = v[j] * Ac[j]; }
#pragma unroll
                for (int j = 0; j < 4; ++j) { ph[j] = cvt_pk_bf16(t[ks][2 * j], t[ks][2 * j + 1]); pl[j] = cvt_pk_bf16(t[ks][2 * j] - bflo(ph[j]), t[ks][2 * j + 1] - bfhi(ph[j])); }
                const bf16x8 Ah = __builtin_bit_cast(bf16x8, (u32x4){ph[0], ph[1], ph[2], ph[3]}), Al = __builtin_bit_cast(bf16x8, (u32x4){pl[0], pl[1], pl[2], pl[3]});
#pragma unroll
                for (int nt = 0; nt < 3; ++nt) {
                    const bf16x8 Bh = *(const bf16x8*)(wh + (size_t)(16 * nt) * 1024 + 32 * ks), Bl = *(const bf16x8*)(wh + 48 * 1024 + (size_t)(16 * nt) * 1024 + 32 * ks);
                    acc[nt] = mfma16r(Ah, Bh, acc[nt]); acc[nt] = mfma16r(Al, Bh, acc[nt]); acc[nt] = mfma16r(Ah, Bl, acc[nt]);
                }
            }
            ss += __shfl_xor(ss, 16); ss += __shfl_xor(ss, 32);
            if (kq == 0) ssp[wid * 16 + fr] = ss;
#pragma unroll
            for (int nt = 0; nt < 3; ++nt)
#pragma unroll
                for (int r = 0; r < 4; ++r) part[(wid * 16 + 4 * kq + r) * 48 + 16 * nt + fr] = acc[nt][r];
            __syncthreads();
            for (int i = tid; i < 16 * 48; i += NTHR) { float s = 0.f;
#pragma unroll
                for (int w = 0; w < 8; ++w) s += part[w * 16 * 48 + i];
                lgt[i] = s; }
            if (tid < 16) { float s = 0.f;
#pragma unroll
                for (int w = 0; w < 8; ++w) s += ssp[w * 16 + tid];
                rrow[tid] = rsqrtf(s * (1.0f / D) + EPS); }
            __syncthreads();
            if (tid < 16) {
                const int tok = r0 + 16 * q4 + tid; const float r = rrow[tid];
                float ag[4];
#pragma unroll
                for (int j = 0; j < 4; ++j) ag[j] = r * lgt[tid * 48 + j] + rb[j];
                int gi = 0; float gm = ag[0];
#pragma unroll
                for (int j = 1; j < 4; ++j) if (ag[j] > gm) { gm = ag[j]; gi = j; }
                float den = 0.f;
#pragma unroll
                for (int j = 0; j < 4; ++j) den += expf(ag[j] - gm);
                const float p_sel = 1.0f / den;
                float el[8];
#pragma unroll
                for (int j = 0; j < 8; ++j) el[j] = r * lgt[tid * 48 + 4 + gi * 8 + j] + rb[4 + gi * 8 + j];
                int j0 = 0; float v0 = el[0];
#pragma unroll
                for (int j = 1; j < 8; ++j) if (el[j] > v0) { v0 = el[j]; j0 = j; }
                int j1 = 0; float v1 = -INFINITY;
#pragma unroll
                for (int j = 0; j < 8; ++j) if (j != j0 && el[j] > v1) { v1 = el[j]; j1 = j; }
                const float e1 = expf(v1 - v0);
                const float g0 = p_sel / (1.0f + e1), g1 = p_sel * e1 / (1.0f + e1);
                const int ex0 = gi * 8 + j0, ex1 = gi * 8 + j1, ai = (16 * q4 + tid) * 2;
                const int p0 = __hip_atomic_fetch_add(lcnt + ex0, 1, __ATOMIC_RELAXED, __HIP_MEMORY_SCOPE_WORKGROUP), p1 = __hip_atomic_fetch_add(lcnt + ex1, 1, __ATOMIC_RELAXED, __HIP_MEMORY_SCOPE_WORKGROUP);
                rte[ai] = ex0; rtp[ai] = p0; rtt[ai] = tok; rtg[ai] = g0;
                rte[ai + 1] = ex1; rtp[ai + 1] = p1; rtt[ai + 1] = tok; rtg[ai + 1] = g1;
            }
            {
                const float r = rrow[fr];
                bf16_t* op = out + (size_t)row * D + 128 * wid + 8 * kq;
#pragma unroll
                for (int ks = 0; ks < 4; ++ks) {
                    const float* cp = shift + (size_t)b * 6144 + 128 * wid + 32 * ks + 8 * kq;
                    const f32x4 c0 = *(const f32x4*)cp, c1 = *(const f32x4*)(cp + 4);
                    u32x4 w; w.x = cvt_pk_bf16(t[ks][0] * r + c0[0], t[ks][1] * r + c0[1]); w.y = cvt_pk_bf16(t[ks][2] * r + c0[2], t[ks][3] * r + c0[3]);
                    w.z = cvt_pk_bf16(t[ks][4] * r + c1[0], t[ks][5] * r + c1[1]); w.w = cvt_pk_bf16(t[ks][6] * r + c1[2], t[ks][7] * r + c1[3]);
                    *(u32x4*)(op + 32 * ks) = w;
                }
            }
            __syncthreads();
        }
        if (tid < 32) { const int c = lcnt[tid]; lbase[tid] = c ? atomicAdd(&counts[tid * 64], c) : 0; }
        __syncthreads();
        if (tid < 128) { const int e = rte[tid], pos = lbase[e] + rtp[tid], tk = rtt[tid];
            list[(size_t)e * NTOK + pos] = tk; lgate[(size_t)e * NTOK + pos] = rtg[tid];
            tokinfo[tk * 4 + (tid & 1) * 2] = e; tokinfo[tk * 4 + (tid & 1) * 2 + 1] = pos; }
        __syncthreads();
    }
}

__device__ __forceinline__ void moe_cum(const Args& a, int l, LAS unsigned char* lds) {
    KArgs* ka = kargs();
    LAS int* cum = (LAS int*)(lds + LDS_MISC + MISC_CUM); LAS int* cn = (LAS int*)(lds + LDS_MISC + MISC_CNT);
    const int* counts = (const int*)(ka->ws + WS_CNT) + l * NE * 64;
    const int tq = opaque_tid();
    if (tq < 33) { int s = 0; for (int j = 0; j < tq; ++j) s += (ld_agent(counts + j * 64) + 255) >> 8; cum[tq] = s; if (tq < 32) cn[tq] = ld_agent(counts + tq * 64); }
    __syncthreads();
}

__device__ __forceinline__ void phase_combine(const Args& a, int l, LAS unsigned char* lds, int vcu, int G) {
    KArgs* ka = kargs();
    const int tid = opaque_tid(), wid = __builtin_amdgcn_readfirstlane(tid >> 6), lane = tid & 63;
    unsigned char* ws = ka->ws;
    moe_cum(a, l, lds);
    const LAS int* cum = (const LAS int*)(lds + LDS_MISC + MISC_CUM);
    const bf16_t* __restrict__ x1 = (const bf16_t*)(ws + WS_X1);
    bf16_t* __restrict__ xnext = (bf16_t*)(ws + WS_X1) + (size_t)NTOK * D;
    const float* mod = (const float*)(ws + WS_MOD) + (size_t)l * 4 * 6144;
    const float* gate2 = mod + 5120;
    const bf16_t* __restrict__ Y = (const bf16_t*)(ws + WS_Y);
    const int* __restrict__ tokinfo = (const int*)(ws + WS_TOKINFO);
    float* __restrict__ outp = ka->out;
    const bool nextl = (l + 1 < L);
    const float* modn = (const float*)(ws + WS_MOD) + (size_t)(nextl ? l + 1 : l) * 4 * 6144;
    const float* gn = IN_F(I_NORM1) + (nextl ? l + 1 : l) * D;
    bf16_t* __restrict__ hout = (bf16_t*)(ws + WS_HA);
    for (int rb = vcu * 8 + wid; rb < NTOK / 8; rb += G * 8) {
        const int row0 = rb * 8, b = row0 / S;
        float4 A[4], C[4], G2[4];
#pragma unroll
        for (int i = 0; i < 4; ++i) { const int k = 256 * i + 4 * lane; const float4 gv = *(const float4*)(gn + k), sc = *(const float4*)(modn + 1024 + (size_t)b * 6144 + k); C[i] = *(const float4*)(modn + (size_t)b * 6144 + k);
            A[i] = make_float4(gv.x * (1.f + sc.x), gv.y * (1.f + sc.y), gv.z * (1.f + sc.z), gv.w * (1.f + sc.w)); G2[i] = *(const float4*)(gate2 + (size_t)b * 6144 + k); }
#pragma unroll 4
        for (int rr = 0; rr < 8; ++rr) {
            const int tok = row0 + rr; const size_t ro = (size_t)tok * D;
            const int4 ti = *(const int4*)(tokinfo + tok * 4);
            const size_t s0 = (size_t)(cum[ti.x] * 256 + ti.y) * D, s1 = (size_t)(cum[ti.z] * 256 + ti.w) * D;
            float4 xo[4]; float ss = 0.f;
#pragma unroll
            for (int i = 0; i < 4; ++i) { const int k = 256 * i + 4 * lane; const u32x2 xw = *(const u32x2*)(x1 + ro + k); const float4 xv = make_float4(bflo(xw.x), bfhi(xw.x), bflo(xw.y), bfhi(xw.y)); const u32x2 y0 = *(const u32x2*)(Y + s0 + k), y1 = *(const u32x2*)(Y + s1 + k);
                xo[i].x = xv.x + G2[i].x * (bflo(y0.x) + bflo(y1.x)); xo[i].y = xv.y + G2[i].y * (bfhi(y0.x) + bfhi(y1.x)); xo[i].z = xv.z + G2[i].z * (bflo(y0.y) + bflo(y1.y)); xo[i].w = xv.w + G2[i].w * (bfhi(y0.y) + bfhi(y1.y));
                if (nextl) { u32x2 xb; xb.x = cvt_pk_bf16(xo[i].x, xo[i].y); xb.y = cvt_pk_bf16(xo[i].z, xo[i].w); *(u32x2*)(xnext + ro + k) = xb; } else *(float4*)(outp + ro + k) = xo[i];
                ss += xo[i].x * xo[i].x + xo[i].y * xo[i].y + xo[i].z * xo[i].z + xo[i].w * xo[i].w; }
            if (nextl) {
                const float r = rsqrtf(wave_sum(ss) * (1.0f / D) + EPS);
#pragma unroll
                for (int i = 0; i < 4; ++i) { u32x2 w; w.x = cvt_pk_bf16(xo[i].x * r * A[i].x + C[i].x, xo[i].y * r * A[i].y + C[i].y); w.y = cvt_pk_bf16(xo[i].z * r * A[i].z + C[i].z, xo[i].w * r * A[i].w + C[i].w);
                    *(u32x2*)(hout + ro + 256 * i + 4 * lane) = w; }
            }
        }
    }
}
constexpr size_t WS_KN = WS_R2;
constexpr size_t WS_VT = WS_KN + al256c((size_t)NTOK * 256 * 2);
constexpr size_t WS_IKR = WS_VT + al256c((size_t)NTOK * 256 * 2);
constexpr size_t WS_MASK = WS_IKR + al256c((size_t)NTOK * 32 * 2);
constexpr size_t WS_OA = WS_MASK + al256c((size_t)NTOK * 128 * 4);
constexpr size_t WS_R3 = WS_OA + al256c((size_t)NTOK * 256 * 2);
constexpr size_t WS_MIXB = (WS_R3 > WS_Y + (size_t)SLOTS * D * 2 ? WS_R3 : WS_Y + al256c((size_t)SLOTS * D * 2));

__device__ __forceinline__ f32x4 mfma16(const bf16x8 a, const bf16x8 b, const f32x4 c) { return __builtin_amdgcn_mfma_f32_16x16x32_bf16(a, b, c, 0, 0, 0); }
__device__ __forceinline__ bf16_t f2bf(float f) { return (bf16_t)(cvt_pk_bf16(f, 0.f) & 0xffffu); }

__device__ __forceinline__ void rows_rms_store(const LAS float* YB, const float* gain, bf16_t* mixb, int tok0, int col0, int wid, int lane) {
    const f32x4 gv = *(const f32x4*)(gain + 4 * lane);
#pragma unroll 2
    for (int rr = 0; rr < 8; ++rr) {
        const int t = 8 * wid + rr;
        const f32x4 y = *(const LAS f32x4*)(YB + t * 260 + 4 * lane);
        const float ss = wave_sum(y[0] * y[0] + y[1] * y[1] + y[2] * y[2] + y[3] * y[3]);
        const float r = rsqrtf(ss * (1.0f / 256.0f) + EPS);
        u32x2 w; w.x = cvt_pk_bf16(y[0] * r * gv[0], y[1] * r * gv[1]); w.y = cvt_pk_bf16(y[2] * r * gv[2], y[3] * r * gv[3]);
        *(u32x2*)(mixb + (size_t)(tok0 + t) * D + col0 + 4 * lane) = w;
    }
}

__device__ __forceinline__ void item_pool(const Args& a, int l, int tile, LAS unsigned char* lds) {
    KArgs* ka = kargs();
    const int tid = opaque_tid(), wid = __builtin_amdgcn_readfirstlane(tid >> 6), lane = tid & 63;
    unsigned char* ws = ka->ws;
    const bf16_t* proj = (const bf16_t*)(ws + WS_PROJ);
    LAS bf16_t* P = (LAS bf16_t*)lds;
    LAS bf16_t* PA = (LAS bf16_t*)(lds + 40960);
    LAS float* YB = (LAS float*)(lds + 40960 + 33792);
    const int tok0 = tile * 64, b = tok0 / S, t0 = tok0 % S;
#pragma unroll
    for (int p = tid; p < 79 * 32; p += NTHR) {
        const int r = p >> 5, c8 = p & 31, t = t0 - 15 + r;
        u32x4 v = (u32x4){0u, 0u, 0u, 0u};
        if (t >= 0) v = *(const u32x4*)(proj + (size_t)(b * S + t) * NP + NC + c8 * 8);
        *(LAS u32x4*)(P + r * 256 + c8 * 8) = v;
    }
    __syncthreads();
    {
        const int c = tid & 255, half = tid >> 8, g = c >> 6, w = 2 << g, tt0 = half * 32;
        float run = 0.f;
        for (int jj = 1; jj < w; ++jj) run += bf2f(P[(15 + tt0 - jj) * 256 + c]);
        for (int i = 0; i < 32; ++i) {
            const int tt = tt0 + i, r = 15 + tt;
            const float pv = bf2f(P[r * 256 + c]);
            run += pv;
            const int tabs = t0 + tt, nn = (tabs + 1 < w) ? (tabs + 1) : w;
            PA[tt * 264 + c] = f2bf(run / (float)nn - pv);
            run -= bf2f(P[(r - w + 1) * 256 + c]);
        }
    }
    __syncthreads();
    {
        const int g = wid >> 1, mh = wid & 1, fr = lane & 15, fq = lane >> 4;
        const bf16_t* PT = (const bf16_t*)(ws + WS_POOLT) + (size_t)(l * 4 + g) * 64 * 64;
        f32x4 acc[2][4];
#pragma unroll
        for (int mi = 0; mi < 2; ++mi)
#pragma unroll
            for (int ni = 0; ni < 4; ++ni) acc[mi][ni] = (f32x4){0.f, 0.f, 0.f, 0.f};
#pragma unroll
        for (int ks = 0; ks < 2; ++ks) {
            bf16x8 A[2];
#pragma unroll
            for (int mi = 0; mi < 2; ++mi) A[mi] = *(const LAS bf16x8*)(PA + (16 * (2 * mh + mi) + fr) * 264 + g * 64 + 32 * ks + 8 * fq);
#pragma unroll
            for (int ni = 0; ni < 4; ++ni) { const bf16x8 Bf = *(const bf16x8*)(PT + (16 * ni + fr) * 64 + 32 * ks + 8 * fq);
#pragma unroll
                for (int mi = 0; mi < 2; ++mi) acc[mi][ni] = mfma16(A[mi], Bf, acc[mi][ni]); }
        }
        const float* pb = IN_F(I_POOLB) + l * 256; const float* ps = IN_F(I_POOLS) + l * 256;
#pragma unroll
        for (int ni = 0; ni < 4; ++ni) { const int d = g * 64 + 16 * ni + fr; const float bb = pb[d], sc = ps[d];
#pragma unroll
            for (int mi = 0; mi < 2; ++mi)
#pragma unroll
                for (int r = 0; r < 4; ++r) YB[(16 * (2 * mh + mi) + 4 * fq + r) * 260 + d] = (acc[mi][ni][r] + bb) * sc; }
    }
    __syncthreads();
    rows_rms_store(YB, IN_F(I_ONORM) + l * D + 512, (bf16_t*)(ws + WS_MIXB), tok0, 512, wid, lane);
    __syncthreads();
}

__device__ __forceinline__ void item_conv(const Args& a, int l, int tile, LAS unsigned char* lds) {
    KArgs* ka = kargs();
    const int tid = opaque_tid(), wid = __builtin_amdgcn_readfirstlane(tid >> 6), lane = tid & 63;
    unsigned char* ws = ka->ws;
    const bf16_t* proj = (const bf16_t*)(ws + WS_PROJ);
    LAS float* GL = (LAS float*)lds;
    LAS bf16_t* CA = (LAS bf16_t*)(lds + 96256);
    LAS float* YB = (LAS float*)lds;
    const int tok0 = tile * 64, b = tok0 / S, t0 = tok0 % S;
#pragma unroll
    for (int p = tid; p < 94 * 32; p += NTHR) {
        const int r = p >> 5, c8 = p & 31, t = t0 - 30 + r;
        f32x4 o0 = (f32x4){0.f, 0.f, 0.f, 0.f}, o1 = o0;
        if (t >= 0) {
            const bf16_t* pr = proj + (size_t)(b * S + t) * NP;
            const u32x4 av = *(const u32x4*)(pr + NBA + c8 * 8), gv = *(const u32x4*)(pr + NBG + c8 * 8);
            o0[0] = bflo(av.x) * sigmoid_fast(bflo(gv.x)); o0[1] = bfhi(av.x) * sigmoid_fast(bfhi(gv.x)); o0[2] = bflo(av.y) * sigmoid_fast(bflo(gv.y)); o0[3] = bfhi(av.y) * sigmoid_fast(bfhi(gv.y));
            o1[0] = bflo(av.z) * sigmoid_fast(bflo(gv.z)); o1[1] = bfhi(av.z) * sigmoid_fast(bfhi(gv.z)); o1[2] = bflo(av.w) * sigmoid_fast(bflo(gv.w)); o1[3] = bfhi(av.w) * sigmoid_fast(bfhi(gv.w));
        }
        *(LAS f32x4*)(GL + r * 256 + c8 * 8) = o0; *(LAS f32x4*)(GL + r * 256 + c8 * 8 + 4) = o1;
    }
    __syncthreads();
    {
        const int c = tid & 255, half = tid >> 8;
        float wv[31];
#pragma unroll
        for (int jj = 0; jj < 31; ++jj) wv[jj] = IN_F(I_CONVW)[((size_t)l * 31 + jj) * 256 + c];
        const float cb = IN_F(I_CONVB)[l * 256 + c];
        float yv[32];
#pragma unroll
        for (int ch = 0; ch < 8; ++ch) {
            const int tt = half * 32 + ch * 4;
            float x[34];
#pragma unroll
            for (int m2 = 0; m2 < 34; ++m2) x[m2] = GL[(tt + m2) * 256 + c];
#pragma unroll
            for (int i = 0; i < 4; ++i) {
                float y = cb;
#pragma unroll
                for (int jj = 0; jj < 31; ++jj) y += x[i + jj] * wv[jj];
                yv[ch * 4 + i] = y;
            }
        }
        __syncthreads();
#pragma unroll
        for (int i = 0; i < 32; ++i) YB[(half * 32 + i) * 260 + c] = yv[i];
    }
    __syncthreads();
    {
        const int t = tid >> 3, part = tid & 7;
        float y[32]; float s1 = 0.f;
#pragma unroll
        for (int i = 0; i < 8; ++i) { const f32x4 v = *(const LAS f32x4*)(YB + t * 260 + part * 32 + 4 * i); y[4 * i] = v[0]; y[4 * i + 1] = v[1]; y[4 * i + 2] = v[2]; y[4 * i + 3] = v[3]; s1 += (v[0] + v[1]) + (v[2] + v[3]); }
        s1 += dpp_f<0xB1>(s1);
        const float mu = s1 * (1.0f / 64.0f);
        float s2 = 0.f;
#pragma unroll
        for (int i = 0; i < 32; ++i) { y[i] -= mu; s2 += y[i] * y[i]; }
        s2 += dpp_f<0xB1>(s2);
        const float rs = rsqrtf(s2 * (1.0f / 64.0f) + EPS);
        const float* lng = IN_F(I_CLNG) + l * 256 + part * 32; const float* lnb = IN_F(I_CLNB) + l * 256 + part * 32;
#pragma unroll
        for (int i = 0; i < 4; ++i) {
            float o[8];
#pragma unroll
            for (int e = 0; e < 8; ++e) o[e] = silu_f(y[8 * i + e] * rs * lng[8 * i + e] + lnb[8 * i + e]);
            u32x4 w; w.x = cvt_pk_bf16(o[0], o[1]); w.y = cvt_pk_bf16(o[2], o[3]); w.z = cvt_pk_bf16(o[4], o[5]); w.w = cvt_pk_bf16(o[6], o[7]);
            *(LAS u32x4*)(CA + t * 264 + part * 32 + 8 * i) = w;
        }
    }
    __syncthreads();
    {
        const int fr = lane & 15, fq = lane >> 4;
        const bf16_t* PW = (const bf16_t*)(ws + WS_PWT) + (size_t)l * 65536;
        f32x4 acc[4][2];
#pragma unroll
        for (int mi = 0; mi < 4; ++mi)
#pragma unroll
            for (int ni = 0; ni < 2; ++ni) acc[mi][ni] = (f32x4){0.f, 0.f, 0.f, 0.f};
#pragma unroll 2
        for (int ks = 0; ks < 8; ++ks) {
            bf16x8 Bf[2];
#pragma unroll
            for (int ni = 0; ni < 2; ++ni) Bf[ni] = *(const bf16x8*)(PW + (size_t)(32 * wid + 16 * ni + fr) * 256 + 32 * ks + 8 * fq);
#pragma unroll
            for (int mi = 0; mi < 4; ++mi) { const bf16x8 Af = *(const LAS bf16x8*)(CA + (16 * mi + fr) * 264 + 32 * ks + 8 * fq);
#pragma unroll
                for (int ni = 0; ni < 2; ++ni) acc[mi][ni] = mfma16(Af, Bf[ni], acc[mi][ni]); }
        }
        const float* pwb = IN_F(I_PWB) + l * 256;
#pragma unroll
        for (int ni = 0; ni < 2; ++ni) { const int n = 32 * wid + 16 * ni + fr; const float bb = pwb[n];
#pragma unroll
            for (int mi = 0; mi < 4; ++mi)
#pragma unroll
                for (int r = 0; r < 4; ++r) YB[(16 * mi + 4 * fq + r) * 260 + n] = acc[mi][ni][r] + bb; }
    }
    __syncthreads();
    rows_rms_store(YB, IN_F(I_ONORM) + l * D + 256, (bf16_t*)(ws + WS_MIXB), tok0, 256, wid, lane);
    __syncthreads();
}

__device__ __forceinline__ void item_sgu(const Args& a, int l, int ch, LAS unsigned char* lds) {
    KArgs* ka = kargs();
    const int tid = opaque_tid(), wid = __builtin_amdgcn_readfirstlane(tid >> 6), lane = tid & 63;
    unsigned char* ws = ka->ws;
    const bf16_t* proj = (const bf16_t*)(ws + WS_PROJ);
    LAS bf16_t* VS = (LAS bf16_t*)lds;
    LAS bf16_t* OB = (LAS bf16_t*)(lds + 69632);
    const int tok0 = ch * 128;
    {
        const f32x4 lg = *(const f32x4*)(IN_F(I_SLNG) + l * 256 + 4 * lane), lb = *(const f32x4*)(IN_F(I_SLNB) + l * 256 + 4 * lane);
#pragma unroll 8
        for (int i = 0; i < 16; ++i) {
            const int s = 16 * wid + i;
            const u32x2 vv = *(const u32x2*)(proj + (size_t)(tok0 + s) * NP + NDV + 4 * lane);
            const float v0 = bflo(vv.x), v1 = bfhi(vv.x), v2 = bflo(vv.y), v3 = bfhi(vv.y);
            const float mu = wave_sum((v0 + v1) + (v2 + v3)) * (1.0f / 256.0f);
            const float d0 = v0 - mu, d1 = v1 - mu, d2 = v2 - mu, d3 = v3 - mu;
            const float rs = rsqrtf(wave_sum((d0 * d0 + d1 * d1) + (d2 * d2 + d3 * d3)) * (1.0f / 256.0f) + EPS);
            u32x2 w; w.x = cvt_pk_bf16(d0 * rs * lg[0] + lb[0], d1 * rs * lg[1] + lb[1]); w.y = cvt_pk_bf16(d2 * rs * lg[2] + lb[2], d3 * rs * lg[3] + lb[3]);
            *(LAS u32x2*)(VS + s * 260 + 4 * lane) = w;
        }
    }
    __syncthreads();
    {
        const int h = wid >> 1, np = wid & 1, fr = lane & 15, fq = lane >> 4;
        const bf16_t* W = (const bf16_t*)(ws + WS_SGUW) + (size_t)(l * 4 + h) * 128 * 128;
        const float* sb = IN_F(I_SGUB) + (l * 4 + h) * 128;
        bf16x8 Bf[4][2];
#pragma unroll
        for (int ks = 0; ks < 4; ++ks)
#pragma unroll
            for (int ni = 0; ni < 2; ++ni) {
                unsigned short e[8];
#pragma unroll
                for (int jj = 0; jj < 8; ++jj) e[jj] = VS[(32 * ks + 8 * fq + jj) * 260 + h * 64 + 32 * np + 16 * ni + fr];
                u32x4 w; w.x = e[0] | ((unsigned)e[1] << 16); w.y = e[2] | ((unsigned)e[3] << 16); w.z = e[4] | ((unsigned)e[5] << 16); w.w = e[6] | ((unsigned)e[7] << 16);
                Bf[ks][ni] = __builtin_bit_cast(bf16x8, w);
            }
#pragma unroll
        for (int mi = 0; mi < 8; ++mi) {
            f32x4 acc[2] = {(f32x4){0.f, 0.f, 0.f, 0.f}, (f32x4){0.f, 0.f, 0.f, 0.f}};
#pragma unroll
            for (int ks = 0; ks <= (mi >> 1); ++ks) {
                const bf16x8 Af = *(const bf16x8*)(W + (size_t)(16 * mi + fr) * 128 + 32 * ks + 8 * fq);
#pragma unroll
                for (int ni = 0; ni < 2; ++ni) acc[ni] = mfma16(Af, Bf[ks][ni], acc[ni]);
            }
#pragma unroll
            for (int ni = 0; ni < 2; ++ni)
#pragma unroll
                for (int r = 0; r < 4; ++r) { const int t = 16 * mi + 4 * fq + r; OB[t * 264 + h * 64 + 32 * np + 16 * ni + fr] = f2bf(acc[ni][r] + sb[t]); }
        }
    }
    __syncthreads();
    {
        const f32x4 gv = *(const f32x4*)(IN_F(I_ONORM) + l * D + 768 + 4 * lane);
        bf16_t* mixb = (bf16_t*)(ws + WS_MIXB);
#pragma unroll 8
        for (int i = 0; i < 16; ++i) {
            const int t = 16 * wid + i;
            const u32x2 mv = *(const LAS u32x2*)(OB + t * 264 + 4 * lane);
            const u32x2 uv = *(const u32x2*)(proj + (size_t)(tok0 + t) * NP + NDU + 4 * lane);
            const float o0 = bflo(uv.x) * bflo(mv.x), o1 = bfhi(uv.x) * bfhi(mv.x), o2 = bflo(uv.y) * bflo(mv.y), o3 = bfhi(uv.y) * bfhi(mv.y);
            const float r = rsqrtf(wave_sum((o0 * o0 + o1 * o1) + (o2 * o2 + o3 * o3)) * (1.0f / 256.0f) + EPS);
            u32x2 w; w.x = cvt_pk_bf16(o0 * r * gv[0], o1 * r * gv[1]); w.y = cvt_pk_bf16(o2 * r * gv[2], o3 * r * gv[3]);
            *(u32x2*)(mixb + (size_t)(tok0 + t) * D + 768 + 4 * lane) = w;
        }
    }
    __syncthreads();
}

__device__ __forceinline__ void item_prepk(const Args& a, int l, int tile, LAS unsigned char* lds) {
    KArgs* ka = kargs();
    const int tid = opaque_tid(), wid = __builtin_amdgcn_readfirstlane(tid >> 6), lane = tid & 63;
    unsigned char* ws = ka->ws;
    const bf16_t* proj = (const bf16_t*)(ws + WS_PROJ);
    LAS bf16_t* VS = (LAS bf16_t*)lds;
    bf16_t* KN = (bf16_t*)(ws + WS_KN); bf16_t* VTg = (bf16_t*)(ws + WS_VT); bf16_t* IKR = (bf16_t*)(ws + WS_IKR);
    const float* ropeA = (const float*)(ws + WS_ROPEA); const float* ropeI = (const float*)(ws + WS_ROPEI);
    const int tok0 = tile * 64, b = tok0 / S, s0 = tok0 % S;
    const int li = lane & 15, head = lane >> 4;
    const f32x4 kg = *(const f32x4*)(IN_F(I_KN) + l * 64 + 4 * li);
#pragma unroll 4
    for (int i = 0; i < 8; ++i) {
        const int tl = 8 * wid + i, tok = tok0 + tl, s = s0 + tl;
        const bf16_t* pr = proj + (size_t)tok * NP;
        const u32x2 kv = *(const u32x2*)(pr + NK + 4 * lane);
        float k0 = bflo(kv.x), k1 = bfhi(kv.x), k2 = bflo(kv.y), k3 = bfhi(kv.y);
        float ss = (k0 * k0 + k1 * k1) + (k2 * k2 + k3 * k3);
        ss = row_sum16(ss);
        const float r = rsqrtf(ss * (1.0f / 64.0f) + EPS);
        k0 *= r * kg[0]; k1 *= r * kg[1]; k2 *= r * kg[2]; k3 *= r * kg[3];
        {
            const float p0 = __shfl_xor(k0, 2), p1 = __shfl_xor(k1, 2), p2 = __shfl_xor(k2, 2), p3 = __shfl_xor(k3, 2);
            if (li < 4) {
                const int dd = 4 * (li & 1);
                const f32x4 cs = *(const f32x4*)(ropeA + (size_t)tok * 16 + dd), sn = *(const f32x4*)(ropeA + (size_t)tok * 16 + 8 + dd);
                if (li < 2) { k0 = k0 * cs[0] - p0 * sn[0]; k1 = k1 * cs[1] - p1 * sn[1]; k2 = k2 * cs[2] - p2 * sn[2]; k3 = k3 * cs[3] - p3 * sn[3]; }
                else        { k0 = k0 * cs[0] + p0 * sn[0]; k1 = k1 * cs[1] + p1 * sn[1]; k2 = k2 * cs[2] + p2 * sn[2]; k3 = k3 * cs[3] + p3 * sn[3]; }
            }
        }
        u32x2 ko; ko.x = cvt_pk_bf16(k0, k1); ko.y = cvt_pk_bf16(k2, k3);
        *(u32x2*)(KN + ((size_t)((b * 4 + head) * 128 + (s >> 5)) * 32 + (s & 31)) * 64 + 4 * li) = ko;
        *(LAS u32x2*)(VS + tl * 264 + 4 * lane) = *(const u32x2*)(pr + NV + 4 * lane);
        if (lane < 8) {
            const u32x2 iv = *(const u32x2*)(pr + NIK + 4 * lane);
            float x0 = bflo(iv.x), x1 = bfhi(iv.x), x2 = bflo(iv.y), x3 = bfhi(iv.y);
            const float q0 = __shfl_xor(x0, 1), q1 = __shfl_xor(x1, 1), q2 = __shfl_xor(x2, 1), q3 = __shfl_xor(x3, 1);
            if (lane < 2) {
                const f32x4 cs = *(const f32x4*)(ropeI + (size_t)tok * 8), sn = *(const f32x4*)(ropeI + (size_t)tok * 8 + 4);
                if (lane == 0) { x0 = x0 * cs[0] - q0 * sn[0]; x1 = x1 * cs[1] - q1 * sn[1]; x2 = x2 * cs[2] - q2 * sn[2]; x3 = x3 * cs[3] - q3 * sn[3]; }
                else           { x0 = x0 * cs[0] + q0 * sn[0]; x1 = x1 * cs[1] + q1 * sn[1]; x2 = x2 * cs[2] + q2 * sn[2]; x3 = x3 * cs[3] + q3 * sn[3]; }
            }
            u32x2 io; io.x = cvt_pk_bf16(x0, x1); io.y = cvt_pk_bf16(x2, x3);
            *(u32x2*)(IKR + (size_t)tok * 32 + 4 * lane) = io;
        }
    }
    __syncthreads();
#pragma unroll
    for (int i = 0; i < 4; ++i) {
        const int p = tid + NTHR * i;
        const int h = p >> 9, ktl = (p >> 8) & 1, d = (p >> 2) & 63, part = p & 3;
        unsigned short e[8];
#pragma unroll
        for (int jj = 0; jj < 8; ++jj) { const int key = 4 * part + (jj & 3) + 16 * (jj >> 2); e[jj] = VS[(ktl * 32 + key) * 264 + h * 64 + d]; }
        u32x4 w; w.x = e[0] | ((unsigned)e[1] << 16); w.y = e[2] | ((unsigned)e[3] << 16); w.z = e[4] | ((unsigned)e[5] << 16); w.w = e[6] | ((unsigned)e[7] << 16);
        *(u32x4*)(VTg + ((size_t)((b * 4 + h) * 128 + (s0 >> 5) + ktl) * 64 + d) * 32 + 8 * part) = w;
    }
    __syncthreads();
}

__device__ __forceinline__ void phase_mix1(const Args& a, int l, LAS unsigned char* lds, int vcu, int G, int bx) {
    if (G == 256) {
        if (bx < 64) { item_conv(a, l, bx, lds); item_pool(a, l, bx, lds); }
        else {
            const int w = bx - 64;
            if (w < 128) item_sgu(a, l, w, lds);
            item_prepk(a, l, w, lds);
            item_conv(a, l, 64 + w, lds);
            if (w >= 128) item_prepk(a, l, 192 + (w - 128), lds);
            item_pool(a, l, 64 + w, lds);
        }
        return;
    }
    for (int it = vcu; it < 896; it += G) {
        if (it < 128) item_sgu(a, l, it, lds);
        else if (it < 384) item_conv(a, l, it - 128, lds);
        else if (it < 640) item_pool(a, l, it - 384, lds);
        else item_prepk(a, l, it - 640, lds);
    }
}
__device__ __forceinline__ f32x16 mfma32(const bf16x8 a, const bf16x8 b, const f32x16 c) { return __builtin_amdgcn_mfma_f32_32x32x16_bf16(a, b, c, 0, 0, 0); }
typedef float f32x2 __attribute__((ext_vector_type(2)));

__device__ __forceinline__ void a1_scores(const bf16x8 A0, const bf16x8 A1, const bf16x8 (&Bq)[4][2], const float (&cl)[4], f32x2 (&sc)[8]) {
    f32x16 d[4];
#pragma unroll
    for (int h = 0; h < 4; ++h) {
#pragma unroll
        for (int r = 0; r < 16; ++r) d[h][r] = 0.f;
        d[h] = mfma32(A0, Bq[h][0], d[h]); d[h] = mfma32(A1, Bq[h][1], d[h]);
    }
#pragma unroll
    for (int p = 0; p < 8; ++p) {
        f32x2 m[4];
#pragma unroll
        for (int h = 0; h < 4; ++h) { m[h][0] = __builtin_amdgcn_fmed3f(d[h][2 * p], 0.0f, cl[h]); m[h][1] = __builtin_amdgcn_fmed3f(d[h][2 * p + 1], 0.0f, cl[h]); }
        sc[p] = (m[0] + m[1]) + (m[2] + m[3]);
    }
}

#define A1_PRELOAD(rA) { const int ntw_ = (nkt - wid + 7) >> 3; \
    _Pragma("unroll") for (int u_ = 0; u_ < 4; ++u_) { rA[u_][0] = Bq[0][0]; rA[u_][1] = Bq[0][0]; if (u_ < ntw_) { const size_t o_ = (size_t)(wid + 8 * u_) * 1024; rA[u_][0] = *(const bf16x8*)(ikl + o_); rA[u_][1] = *(const bf16x8*)(ikl + o_ + 16); } } }
#define A1_STREAM_BEGIN(rA) { const int ntw_ = (nkt - wid + 7) >> 3; \
    for (int i_ = 0; i_ < ntw_; i_ += 4) { \
        _Pragma("unroll") for (int u_ = 0; u_ < 4; ++u_) { if (i_ + u_ < ntw_) { \
            const bf16x8 cA0 = rA[u_][0], cA1 = rA[u_][1]; const int kt = wid + 8 * (i_ + u_); \
            if (i_ + u_ + 4 < ntw_) { const size_t o_ = (size_t)(kt + 32) * 1024; rA[u_][0] = *(const bf16x8*)(ikl + o_); rA[u_][1] = *(const bf16x8*)(ikl + o_ + 16); }
#define A1_STREAM_END } } } }

template <int KIND>
__device__ __forceinline__ void a1_pass(const bf16_t* ikl, int nkt, int wid, const bf16x8 (&Bq)[4][2], const float (&cl)[4], LAS unsigned char* histb, unsigned q4, unsigned cadd, bf16x8 (&rA)[4][2]) {
    A1_STREAM_BEGIN(rA)
        f32x2 sc[8];
        a1_scores(cA0, cA1, Bq, cl, sc);
#pragma unroll
        for (int r = 0; r < 16; ++r) {
            const unsigned u = __float_as_uint(sc[r >> 1][r & 1]);
            unsigned addr;
            if (KIND == 0) addr = (((u + 0x8000u) >> 17) & 0x7f80u) | q4;
            else { unsigned dg = (u + cadd) >> 16; dg = dg < 256u ? dg : 256u; addr = (dg << 7) + q4; }
            __hip_atomic_fetch_add((LAS unsigned*)(histb + addr), 1u, __ATOMIC_RELAXED, __HIP_MEMORY_SCOPE_WORKGROUP);
        }
    A1_STREAM_END
}

template <int LEVEL>
__device__ __forceinline__ void a1_scan(LAS unsigned* hist, LAS unsigned* psum, LAS unsigned* qst, int tid) {
    const int sq = tid & 31, part = tid >> 5;
    const unsigned need = qst[32 + sq], p1 = qst[sq];
    const bool neg = (p1 & 0x80u) != 0u;
#define A1_RAWROW(bn) (LEVEL == 0 ? ((bn) >= 128 ? (bn) - 128 : 255 - (bn)) : (neg ? 255 - (bn) : (bn)))
    unsigned cv[16]; unsigned local = 0u;
#pragma unroll
    for (int bb = 0; bb < 16; ++bb) { cv[bb] = hist[A1_RAWROW(16 * part + bb) * 32 + sq]; local += cv[bb]; }
    psum[part * 32 + sq] = local;
    __syncthreads();
    unsigned above = 0u;
#pragma unroll
    for (int pp = 1; pp < 16; ++pp) above += (part + pp < 16) ? psum[(part + pp) * 32 + sq] : 0u;
    if (above < need && above + local >= need) {
        unsigned run = above, fb = 0u, fr = 0u, fc = 0u; bool found = false;
#pragma unroll
        for (int bb = 15; bb >= 0; --bb) {
            const bool hit = !found && (run + cv[bb] >= need);
            fb = hit ? (unsigned)bb : fb; fr = hit ? run : fr; fc = hit ? cv[bb] : fc; found = found || hit;
            run += cv[bb];
        }
        const unsigned raw = (unsigned)A1_RAWROW(16 * part + (int)fb);
        if (LEVEL == 0) { qst[sq] = raw; qst[32 + sq] = need - fr; }
        else { qst[sq] = (p1 << 8) | raw; qst[32 + sq] = need - fr; qst[64 + sq] = fc; }
    }
#undef A1_RAWROW
}

__device__ __forceinline__ void a1_cmp2(unsigned& gt, unsigned& ge, float s0, float s1, float tg, float te) {
#ifdef A1_NOASM
    gt = (gt << 1) | (s0 >= tg ? 1u : 0u); ge = (ge << 1) | (s0 >= te ? 1u : 0u);
    gt = (gt << 1) | (s1 >= tg ? 1u : 0u); ge = (ge << 1) | (s1 >= te ? 1u : 0u);
#else
    unsigned long long m1, m2, m3;
    asm("v_cmp_ge_f32 vcc, %[s0], %[tg]\n\t"
        "v_cmp_ge_f32 %[m1], %[s0], %[te]\n\t"
        "v_cmp_ge_f32 %[m2], %[s1], %[tg]\n\t"
        "v_cmp_ge_f32 %[m3], %[s1], %[te]\n\t"
        "v_addc_co_u32 %[g], vcc, %[g], %[g], vcc\n\t"
        "v_addc_co_u32 %[e], %[m1], %[e], %[e], %[m1]\n\t"
        "v_addc_co_u32 %[g], %[m2], %[g], %[g], %[m2]\n\t"
        "v_addc_co_u32 %[e], %[m3], %[e], %[e], %[m3]"
        : [g] "+v"(gt), [e] "+v"(ge), [m1] "=&s"(m1), [m2] "=&s"(m2), [m3] "=&s"(m3)
        : [s0] "v"(s0), [s1] "v"(s1), [tg] "v"(tg), [te] "v"(te)
        : "vcc");
#endif
}
__device__ __forceinline__ unsigned a1_spread(unsigned x) { return (x & 0xfu) | ((x & 0xf0u) << 4) | ((x & 0xf00u) << 8) | ((x & 0xf000u) << 12); }

constexpr int A1_HISTA = 0, A1_HISTB = 257 * 32, A1_PSUM = 2 * 257 * 32, A1_QST = A1_PSUM + 16 * 32, A1_MBUF = A1_QST + 128, A1_TBUF = A1_MBUF + 32 * 128;
__device__ __forceinline__ void a1_tile(const Args& a, int l, int b, int j, LAS unsigned char* lds) {
    KArgs* ka = kargs();
    const int tid = opaque_tid(), wid = __builtin_amdgcn_readfirstlane(tid >> 6), lane = tid & 63, q = lane & 31, hh = lane >> 5;
    unsigned char* ws = ka->ws;
    const bf16_t* proj = (const bf16_t*)(ws + WS_PROJ);
    const bf16_t* ikr = (const bf16_t*)(ws + WS_IKR) + (size_t)b * S * 32;
    const bf16_t* ikl = ikr + (lane & 31) * 32 + 8 * (lane >> 5);
    unsigned* maskg = (unsigned*)(ws + WS_MASK);
    LAS unsigned* L = (LAS unsigned*)lds;
    LAS unsigned* psum = L + A1_PSUM; LAS unsigned* qst = L + A1_QST; LAS unsigned* mbuf = L + A1_MBUF; LAS unsigned* tbuf = L + A1_TBUF;
    const int t0 = j * 32, n = (t0 / 64 + 1) * 64, nkt = n / 32, nw = ((t0 / 128) + 1) * 4;
    if (n <= 256) {
        for (int i = tid; i < 32 * nw; i += NTHR) { const int qq = i / nw, w = i % nw; maskg[(size_t)(b * S + t0 + qq) * 128 + w] = (w < nkt) ? 0xffffffffu : 0u; }
        return;
    }
    bf16x8 Bq[4][2]; float cl[4];
    {
        const int tok = b * S + t0 + q;
        const bf16_t* pr = proj + (size_t)tok * NP;
        const f32x4 cs = *(const f32x4*)((const float*)(ws + WS_ROPEI) + (size_t)tok * 8), sn = *(const f32x4*)((const float*)(ws + WS_ROPEI) + (size_t)tok * 8 + 4);
#pragma unroll
        for (int h = 0; h < 4; ++h) {
            const float wsc = bf2f(pr[NIW + h]) * (0.5f * 0.17677669529663687f);
            cl[h] = (wsc > 0.f) ? INFINITY : -INFINITY;
#pragma unroll
            for (int ks = 0; ks < 2; ++ks) {
                const u32x4 raw = *(const u32x4*)(pr + NIQ + h * 32 + 16 * ks + 8 * hh);
                float v[8] = {bflo(raw.x), bfhi(raw.x), bflo(raw.y), bfhi(raw.y), bflo(raw.z), bfhi(raw.z), bflo(raw.w), bfhi(raw.w)};
                if (ks == 0 && hh == 0) {
#pragma unroll
                    for (int i = 0; i < 4; ++i) { const float x1 = v[i], x2 = v[i + 4]; v[i] = x1 * cs[i] - x2 * sn[i]; v[i + 4] = x2 * cs[i] + x1 * sn[i]; }
                }
                u32x4 pk; pk.x = cvt_pk_bf16(v[0] * wsc, v[1] * wsc); pk.y = cvt_pk_bf16(v[2] * wsc, v[3] * wsc); pk.z = cvt_pk_bf16(v[4] * wsc, v[5] * wsc); pk.w = cvt_pk_bf16(v[6] * wsc, v[7] * wsc);
                Bq[h][ks] = __builtin_bit_cast(bf16x8, pk);
            }
        }
    }
    bf16x8 rA[4][2];
    A1_PRELOAD(rA);
    { LAS u32x4* hz = (LAS u32x4*)(L + A1_HISTA); for (int i = tid; i < 2 * 257 * 32 / 4; i += NTHR) hz[i] = (u32x4){0u, 0u, 0u, 0u}; }
    if (tid < 32) { qst[tid] = 0u; qst[32 + tid] = 256u; qst[64 + tid] = 0u; }
    __syncthreads();
    const unsigned q4 = (unsigned)q * 4u;
    a1_pass<0>(ikl, nkt, wid, Bq, cl, (LAS unsigned char*)(L + A1_HISTA), q4, 0u, rA);
    A1_PRELOAD(rA);
    __syncthreads();
    a1_scan<0>(L + A1_HISTA, psum, qst, tid);
    __syncthreads();
    a1_pass<1>(ikl, nkt, wid, Bq, cl, (LAS unsigned char*)(L + A1_HISTB), q4, 0x8000u - (qst[q] << 24), rA);
    A1_PRELOAD(rA);
    __syncthreads();
    a1_scan<1>(L + A1_HISTB, psum, qst, tid);
    __syncthreads();
    {
        const unsigned T = qst[q], mag = T & 0x7fffu;
        unsigned bg, be;
        if ((T & 0x8000u) == 0u) { be = mag ? (mag << 16) - 0x8000u : 0u; bg = ((mag + 1u) << 16) - 0x8000u; }
        else { be = 0x80000000u | (((mag + 1u) << 16) - 0x8001u); bg = mag ? (0x80000000u | ((mag << 16) - 0x8001u)) : 0u; }
        const float tg = __uint_as_float(bg), te = __uint_as_float(be);
        A1_STREAM_BEGIN(rA)
            f32x2 sc[8];
            a1_scores(cA0, cA1, Bq, cl, sc);
            unsigned gt = 0u, ge = 0u;
#pragma unroll
            for (int p = 7; p >= 0; --p) a1_cmp2(gt, ge, sc[p][1], sc[p][0], tg, te);
            unsigned wb = a1_spread(gt & 0xffffu) << (4 * hh), eb = a1_spread(ge & 0xffffu) << (4 * hh);
            wb |= (unsigned)__shfl_xor((int)wb, 32); eb |= (unsigned)__shfl_xor((int)eb, 32);
            if (hh == 0) { mbuf[q * 128 + kt] = wb; tbuf[q * 128 + kt] = eb & ~wb; }
        A1_STREAM_END
    }
    __syncthreads();
    {
        const int qq = tid >> 4, part = tid & 15;
        const unsigned need = qst[32 + qq];
        const u32x4 ta = *(const LAS u32x4*)(tbuf + qq * 128 + part * 8), tb = *(const LAS u32x4*)(tbuf + qq * 128 + part * 8 + 4);
        const u32x4 ma = *(const LAS u32x4*)(mbuf + qq * 128 + part * 8), mb = *(const LAS u32x4*)(mbuf + qq * 128 + part * 8 + 4);
        unsigned t[8] = {ta.x, ta.y, ta.z, ta.w, tb.x, tb.y, tb.z, tb.w}, m[8] = {ma.x, ma.y, ma.z, ma.w, mb.x, mb.y, mb.z, mb.w};
        unsigned c = 0u;
#pragma unroll
        for (int i = 0; i < 8; ++i) { if (part * 8 + i >= nkt) { t[i] = 0u; m[i] = 0u; } c += (unsigned)__builtin_popcount(t[i]); }
        unsigned inc = c;
#pragma unroll
        for (int dd = 1; dd < 16; dd <<= 1) { const unsigned v = (unsigned)__shfl_up((int)inc, dd, 16); if (part >= dd) inc += v; }
        int rem = (int)need - (int)(inc - c);
#pragma unroll
        for (int i = 0; i < 8; ++i) {
            const int ci = __builtin_popcount(t[i]);
            unsigned keep = 0u;
            if (rem >= ci) keep = t[i];
            else if (rem > 0) { unsigned tt = t[i]; for (int k = rem; k > 0; --k) { const unsigned low = tt & (0u - tt); keep |= low; tt ^= low; } }
            m[i] |= keep; rem -= ci;
        }
        unsigned* mg = maskg + (size_t)(b * S + t0 + qq) * 128 + part * 8;
        if (part * 8 < nw) *(u32x4*)mg = (u32x4){m[0], m[1], m[2], m[3]};
        if (part * 8 + 4 < nw) *(u32x4*)(mg + 4) = (u32x4){m[4], m[5], m[6], m[7]};
    }
    __syncthreads();
}
__device__ __forceinline__ void phase_a1(const Args& a, int l, LAS unsigned char* lds, int vcu, int G) {
    KArgs* ka = kargs();
    for (int it = vcu; it < 256; it += G) { const int b = it >> 6, jj = it & 63; a1_tile(a, l, b, 127 - jj, lds); a1_tile(a, l, b, jj, lds); }
}

__device__ __forceinline__ void a2_unit(const Args& a, int l, int b, int h, int blk, LAS unsigned char* lds) {
    KArgs* ka = kargs();
    const int tid = opaque_tid(), wid = __builtin_amdgcn_readfirstlane(tid >> 6), lane = tid & 63, fr = lane & 15, kq = lane >> 4;
    unsigned char* ws = ka->ws;
    const bf16_t* proj = (const bf16_t*)(ws + WS_PROJ);
    const char* KNb = (const char*)(ws + WS_KN) + (size_t)(b * 4 + h) * 128 * 4096;
    const char* VTb = (const char*)(ws + WS_VT) + (size_t)(b * 4 + h) * 128 * 4096;
    LAS unsigned char* Kb = lds;
    LAS unsigned char* Vb = lds + 32768;
    LAS float* Ob = (LAS float*)(lds + 65536) + wid * (16 * 68);
    const int nsteps = 2 * (blk + 1);
    const int tokq = b * S + blk * 128 + wid * 16 + fr;
    bf16x8 Qb[2]; float C2;
    {
        const float* qg = IN_F(I_QN) + l * 64; const float* kg = IN_F(I_KN) + l * 64;
        float gq = 0.f, gk = 0.f;
        for (int i = 0; i < 64; ++i) { gq = fmaxf(gq, fabsf(qg[i])); gk = fmaxf(gk, fabsf(kg[i])); }
        C2 = 8.0f * gq * gk * 1.4426950408889634f;
        const bf16_t* pr = proj + (size_t)tokq * NP + NQ + h * 64;
        float v[2][8]; float ss = 0.f;
#pragma unroll
        for (int ks = 0; ks < 2; ++ks) { const u32x4 raw = *(const u32x4*)(pr + 32 * ks + 8 * kq);
            v[ks][0] = bflo(raw.x); v[ks][1] = bfhi(raw.x); v[ks][2] = bflo(raw.y); v[ks][3] = bfhi(raw.y); v[ks][4] = bflo(raw.z); v[ks][5] = bfhi(raw.z); v[ks][6] = bflo(raw.w); v[ks][7] = bfhi(raw.w);
#pragma unroll
            for (int i = 0; i < 8; ++i) ss += v[ks][i] * v[ks][i]; }
        ss += __shfl_xor(ss, 16); ss += __shfl_xor(ss, 32);
        const float r = rsqrtf(ss * (1.0f / 64.0f) + EPS);
#pragma unroll
        for (int ks = 0; ks < 2; ++ks)
#pragma unroll
            for (int i = 0; i < 8; ++i) v[ks][i] *= r * qg[32 * ks + 8 * kq + i];
        {
            const float* ra = (const float*)(ws + WS_ROPEA) + (size_t)tokq * 16;
#pragma unroll
            for (int i = 0; i < 8; ++i) { const float pv = __shfl_xor(v[0][i], 16); const float c = ra[i], s = ra[8 + i];
                if (kq == 0) v[0][i] = v[0][i] * c - pv * s; else if (kq == 1) v[0][i] = v[0][i] * c + pv * s; }
        }
        const float qs = 0.125f * 1.4426950408889634f;
#pragma unroll
        for (int ks = 0; ks < 2; ++ks) { u32x4 pk; pk.x = cvt_pk_bf16(v[ks][0] * qs, v[ks][1] * qs); pk.y = cvt_pk_bf16(v[ks][2] * qs, v[ks][3] * qs); pk.z = cvt_pk_bf16(v[ks][4] * qs, v[ks][5] * qs); pk.w = cvt_pk_bf16(v[ks][6] * qs, v[ks][7] * qs);
            Qb[ks] = __builtin_bit_cast(bf16x8, pk); }
    }
    const unsigned* mrow = (const unsigned*)(ws + WS_MASK) + (size_t)tokq * 128;
    f32x4 O[4];
#pragma unroll
    for (int dt = 0; dt < 4; ++dt) O[dt] = (f32x4){0.f, 0.f, 0.f, 0.f};
    f32x4 Ls = (f32x4){0.f, 0.f, 0.f, 0.f};
    const unsigned bpos = 4u * (unsigned)kq;
    const bf16x8 ones8 = __builtin_bit_cast(bf16x8, (u32x4){0x3f803f80u, 0x3f803f80u, 0x3f803f80u, 0x3f803f80u});
    const int kkey = tid >> 3, kch = tid & 7, vsub = tid >> 8, vd = (tid >> 2) & 63, vch = tid & 3;
    const int klds = kkey * 128 + ((kch ^ (kkey & 7)) * 16), vlds = vsub * 4096 + vd * 64 + ((vch ^ ((vd >> 2) & 3)) * 16);
    u32x4 kr0, kr1, kr2, kr3, vr0, vr1, vr2, vr3; u32x2 mw0, mw1, mw2, mw3;
#define A2_LOAD(j, st_) do { kr##j = *(const u32x4*)(KNb + (size_t)(st_) * 8192 + (size_t)tid * 16); vr##j = *(const u32x4*)(VTb + (size_t)(st_) * 8192 + (size_t)tid * 16); mw##j = *(const u32x2*)(mrow + 2 * (st_)); } while (0)
    A2_LOAD(0, 0); A2_LOAD(1, 1);
    if (nsteps > 2) { A2_LOAD(2, 2); A2_LOAD(3, 3); } else { kr2 = kr0; vr2 = vr0; mw2 = mw0; kr3 = kr0; vr3 = vr0; mw3 = mw0; }
    __syncthreads();
#define A2_HALF(Kc, Vc, mcur) do { \
        _Pragma("unroll") for (int sub = 0; sub < 2; ++sub) { \
            const unsigned m = sub ? (mcur).y : (mcur).x; \
            f32x4 Sx[2]; \
            _Pragma("unroll") for (int tl = 0; tl < 2; ++tl) { \
                const int key = 32 * sub + 16 * tl + fr; \
                const bf16x8 A0 = *(const LAS bf16x8*)((Kc) + key * 128 + (((0 + kq) ^ (key & 7)) * 16)); \
                const bf16x8 A1 = *(const LAS bf16x8*)((Kc) + key * 128 + (((4 + kq) ^ (key & 7)) * 16)); \
                f32x4 z = (f32x4){-C2, -C2, -C2, -C2};     \
                z = mfma16(A0, Qb[0], z); Sx[tl] = mfma16(A1, Qb[1], z); \
            } \
            float p[8]; \
            _Pragma("unroll") for (int r = 0; r < 4; ++r) { \
                const float e0 = __builtin_amdgcn_exp2f(Sx[0][r]), e1 = __builtin_amdgcn_exp2f(Sx[1][r]); \
                p[r] = __uint_as_float(__float_as_uint(e0) & (unsigned)__builtin_amdgcn_sbfe((int)m, bpos + r, 1)); \
                p[4 + r] = __uint_as_float(__float_as_uint(e1) & (unsigned)__builtin_amdgcn_sbfe((int)m, bpos + 16 + r, 1)); \
            } \
            u32x4 pk; pk.x = cvt_pk_bf16(p[0], p[1]); pk.y = cvt_pk_bf16(p[2], p[3]); pk.z = cvt_pk_bf16(p[4], p[5]); pk.w = cvt_pk_bf16(p[6], p[7]); \
            const bf16x8 Pf = __builtin_bit_cast(bf16x8, pk); \
            _Pragma("unroll") for (int dt = 0; dt < 4; ++dt) { const int d = 16 * dt + fr; \
                const bf16x8 Av = *(const LAS bf16x8*)((Vc) + sub * 4096 + d * 64 + ((kq ^ ((d >> 2) & 3)) * 16)); \
                O[dt] = mfma16(Av, Pf, O[dt]); } \
            Ls = mfma16(ones8, Pf, Ls);     \
        } } while (0)
#define A2_STEP2(ja, jb, s2_) do { \
        LAS unsigned char* Kc2 = Kb + ((s2_) & 1) * 16384; LAS unsigned char* Vc2 = Vb + ((s2_) & 1) * 16384; \
        *(LAS u32x4*)(Kc2 + klds) = kr##ja; *(LAS u32x4*)(Vc2 + vlds) = vr##ja; *(LAS u32x4*)(Kc2 + 8192 + klds) = kr##jb; *(LAS u32x4*)(Vc2 + 8192 + vlds) = vr##jb; \
        const u32x2 mcA = mw##ja, mcB = mw##jb; \
        __syncthreads(); \
        if (2 * (s2_) + 4 < nsteps) A2_LOAD(ja, 2 * (s2_) + 4); \
        if (2 * (s2_) + 5 < nsteps) A2_LOAD(jb, 2 * (s2_) + 5); \
        A2_HALF(Kc2, Vc2, mcA); A2_HALF(Kc2 + 8192, Vc2 + 8192, mcB); \
    } while (0)
    for (int s2 = 0; 2 * s2 < nsteps; s2 += 2) {
        A2_STEP2(0, 1, s2);
        if (2 * (s2 + 1) < nsteps) A2_STEP2(2, 3, s2 + 1);
    }
#undef A2_STEP2
#undef A2_HALF
#undef A2_LOAD
    const float inv = 1.0f / Ls[0];
#pragma unroll
    for (int dt = 0; dt < 4; ++dt)
#pragma unroll
        for (int r = 0; r < 4; ++r) Ob[fr * 68 + 16 * dt + 4 * kq + r] = O[dt][r] * inv;
    __syncthreads();
    {
        const int qq = lane >> 2, dp = (lane & 3) * 16;
        const LAS float* src = Ob + qq * 68 + dp;
        float f[16]; float sq = 0.f;
#pragma unroll
        for (int i = 0; i < 4; ++i) { const f32x4 t = *(const LAS f32x4*)(src + 4 * i); f[4 * i] = t[0]; f[4 * i + 1] = t[1]; f[4 * i + 2] = t[2]; f[4 * i + 3] = t[3]; sq += (t[0] * t[0] + t[1] * t[1]) + (t[2] * t[2] + t[3] * t[3]); }
        u32x4 w0, w1; w0.x = cvt_pk_bf16(f[0], f[1]); w0.y = cvt_pk_bf16(f[2], f[3]); w0.z = cvt_pk_bf16(f[4], f[5]); w0.w = cvt_pk_bf16(f[6], f[7]);
        w1.x = cvt_pk_bf16(f[8], f[9]); w1.y = cvt_pk_bf16(f[10], f[11]); w1.z = cvt_pk_bf16(f[12], f[13]); w1.w = cvt_pk_bf16(f[14], f[15]);
        const int tok = b * S + blk * 128 + wid * 16 + qq;
        bf16_t* op = (bf16_t*)(ws + WS_MIXB) + (size_t)tok * D + h * 64 + dp;
        *(u32x4*)op = w0; *(u32x4*)(op + 8) = w1;
        sq += dpp_f<0xB1>(sq); sq += dpp_f<0x4E>(sq);
        if ((lane & 3) == 0) ((float*)(ws + WS_SSQ))[((size_t)l * NTOK + tok) * 4 + h] = sq;
    }
    __syncthreads();
}
__device__ __forceinline__ void phase_a2(const Args& a, int l, LAS unsigned char* lds, int vcu, int G) {
    KArgs* ka = kargs();
    for (int it = vcu; it < 256; it += G) { const int b = it >> 6, h = (it >> 4) & 3, jj = it & 15; a2_unit(a, l, b, h, 31 - jj, lds); a2_unit(a, l, b, h, jj, lds); }
}
__global__ void __launch_bounds__(NTHR, 2) mk_fwd(Args a) {
    extern __shared__ __attribute__((aligned(16))) unsigned char lds_raw[];
    LAS unsigned char* lds = (LAS unsigned char*)lds_raw;
    const int tid = threadIdx.x, G = gridDim.x, bx = blockIdx.x;
    const int vcu = (G % 8 == 0) ? (bx % 8) * (G / 8) + bx / 8 : bx;
    if (tid < 64) ((LAS unsigned*)(lds + LDS_MISC))[tid] = 0u;
    __syncthreads();
    XcdBarrier bar; bar.bar = (unsigned*)(a.ws + WS_BAR); bar.x = 0; bar.st = nullptr;
    if (a.fused) bar = xcd_barrier_post((unsigned*)(a.ws + WS_BAR), (volatile LAS unsigned*)(lds + LDS_MISC + MISC_BAR));
#define GRID_BAR() do { if (a.fused) xcd_barrier(bar); } while (0)
#ifdef ONLY_PH
#define IN(k) ((k) == ONLY_PH && a.ph_lo <= (k) && (k) < a.ph_hi)
#else
#define IN(k) (a.ph_lo <= (k) && (k) < a.ph_hi)
#endif
    if (IN(PH_PRO)) { phase_prologue(a, lds, vcu, G); GRID_BAR(); }
    if (IN(PH_NORM0)) { KArgs* ka = kargs(); unsigned char* ws = ka->ws; float* modp = (float*)(ws + WS_MOD); phase_norm(IN_F(I_X), IN_F(I_NORM1), modp, modp + 1024, (bf16_t*)(ws + WS_HA), vcu, G); phase_rbias(a, lds, vcu, G); GRID_BAR(); }
    for (int l = a.l_lo; l < a.l_hi; ++l) {
        if (IN(PH_G1)) {
            KArgs* ka = kargs(); unsigned char* ws = ka->ws;
            pg8::DenseOrder S; S.init((const bf16_t*)(ws + WS_HA), (const bf16_t*)(ws + WS_WINT) + (size_t)l * NP * D, NTOK, (G == 256) ? NP - 256 : NP, D, G, bx);
            pg8::EpiBf16 E{(bf16_t*)(ws + WS_PROJ), NP};
            pg8::gemm_phase(lds, S, E);
            GRID_BAR();
        }
        if (IN(PH_MIX)) {
            if (G == 256 && bx < 64) {
                KArgs* ka = kargs(); unsigned char* ws = ka->ws;
                pg8::DenseOrder S; S.init((const bf16_t*)(ws + WS_HA), (const bf16_t*)(ws + WS_WINT) + (size_t)l * NP * D + (size_t)(NP - 256) * D, NTOK, 256, D, 64, bx);
                pg8::EpiBf16 E{(bf16_t*)(ws + WS_PROJ) + (NP - 256), NP};
                pg8::gemm_phase(lds, S, E);
            }
            phase_mix1(a, l, lds, vcu, G, bx); GRID_BAR();
        }
        if (IN(PH_A1)) { phase_a1(a, l, lds, vcu, G); GRID_BAR(); }
        if (IN(PH_A2)) { phase_a2(a, l, lds, vcu, G); GRID_BAR(); }
        if (IN(PH_G2)) {
            KArgs* ka = kargs(); unsigned char* ws = ka->ws; const float* xin = IN_F(I_X); const bf16_t* xinb = (l == 0) ? (const bf16_t*)nullptr : (const bf16_t*)(ws + WS_X1) + (size_t)NTOK * D; const float* mod = (const float*)(ws + WS_MOD) + (size_t)l * 4 * 6144;
            pg8::DenseOrder S; S.init((const bf16_t*)(ws + WS_MIXB), (const bf16_t*)(ws + WS_WOUTT) + (size_t)l * D * D, NTOK, D, D, G, bx);
            pg8::EpiResid E{xin, xinb, (bf16_t*)(ws + WS_X1), mod + 2048, (const float*)(ws + WS_SSQ) + (size_t)l * NTOK * 4};
            pg8::gemm_phase<pg8::EpiResid, pg8::DenseOrder, true>(lds, S, E);
            GRID_BAR();
        }
        if (IN(PH_ROUTE)) { phase_route(a, l, lds, vcu, G); GRID_BAR(); }
        if (IN(PH_UP)) {
            KArgs* ka = kargs(); unsigned char* ws = ka->ws;
            moe_cum(a, l, lds);
            pg8::MoeOrder<true> S; S.A = (const bf16_t*)(ws + WS_HA); S.Bt = (const bf16_t*)(ws + WS_WGUT) + (size_t)l * NE * 1024 * 1024; S.K = D; S.bstride = (size_t)1024 * 1024;
            S.list = (const int*)(ws + WS_LIST); S.cum = (const LAS int*)(lds + LDS_MISC + MISC_CUM); S.cnts = (const LAS int*)(lds + LDS_MISC + MISC_CNT); S.G = G; S.c = vcu; S.nun = S.cum[32] * 4;
            S.flag = (int*)(ws + WS_FLAG) + l * 160 * 8;
            pg8::EpiHid E{(bf16_t*)(ws + WS_HID)};
            pg8::gemm_phase(lds, S, E);
        }
        if (IN(PH_DOWN)) {
            KArgs* ka = kargs(); unsigned char* ws = ka->ws;
            moe_cum(a, l, lds);
            pg8::MoeOrder<false> S; S.A = (const bf16_t*)(ws + WS_HID); S.Bt = (const bf16_t*)(ws + WS_WDT) + (size_t)l * NE * 1024 * 512; S.K = F; S.bstride = (size_t)1024 * 512;
            S.list = nullptr; S.cum = (const LAS int*)(lds + LDS_MISC + MISC_CUM); S.cnts = (const LAS int*)(lds + LDS_MISC + MISC_CNT); S.G = G; S.c = G - 1 - vcu; S.nun = S.cum[32] * 4;
            S.flag = (int*)(ws + WS_FLAG) + l * 160 * 8;
            pg8::EpiDown E{(bf16_t*)(ws + WS_Y), (const float*)(ws + WS_LGATE)};
            pg8::gemm_phase(lds, S, E);
            GRID_BAR();
        }
        if (IN(PH_COMB)) { phase_combine(a, l, lds, vcu, G); GRID_BAR(); }
    }
#undef IN
#undef GRID_BAR
}


static void launch_ph(const Args& base, int grid, int l_lo, int l_hi, int ph_lo, int ph_hi, int fused, hipStream_t stream) {
    Args a = base; a.l_lo = l_lo; a.l_hi = l_hi; a.ph_lo = ph_lo; a.ph_hi = ph_hi; a.fused = fused; a.pad = 0;
    hipLaunchKernelGGL(mk_fwd, dim3(grid), dim3(NTHR), LDS_BYTES, stream, a);
}

extern "C" void kernel_launch(void* const* d_in, const int* in_sizes, int n_in, void* d_out, int out_size, void* d_ws, size_t ws_size, hipStream_t stream) {
    static int grid = 0;
    if (grid == 0) {
        int dev = 0, cus = 0;
        if (hipGetDevice(&dev) != hipSuccess || hipDeviceGetAttribute(&cus, hipDeviceAttributeMultiprocessorCount, dev) != hipSuccess) { grid = -1; return; }
        if (hipFuncSetAttribute((const void*)mk_fwd, hipFuncAttributeMaxDynamicSharedMemorySize, LDS_BYTES) != hipSuccess) { fprintf(stderr, "hipFuncSetAttribute failed\n"); grid = -1; return; }
        (void)hipGetLastError();
        grid = cus;
    }
    if (grid < 0) return;
    unsigned char* ws = (unsigned char*)d_ws;
    (void)hipMemsetAsync(ws, 0, WS_ZERO_BYTES, stream);
    Args a{};
    for (int i = 0; i < 32; ++i) a.in[i] = d_in[i];
    a.out = (float*)d_out; a.ws = ws;
#ifdef MK_MULTI
    launch_ph(a, grid, 0, 0, PH_PRO, PH_PRO + 1, 0, stream);
#ifdef MK_REP
    if (MK_REP == PH_PRO) launch_ph(a, grid, 0, 0, PH_PRO, PH_PRO + 1, 0, stream);
#endif
    launch_ph(a, grid, 0, 0, PH_NORM0, PH_NORM0 + 1, 0, stream);
#ifdef MK_REP
    if (MK_REP == PH_NORM0) launch_ph(a, grid, 0, 0, PH_NORM0, PH_NORM0 + 1, 0, stream);
#endif
    for (int l = 0; l < L; ++l)
        for (int ph = PH_G1; ph < PH_END; ++ph) {
            launch_ph(a, grid, l, l + 1, ph, ph + 1, 0, stream);
#ifdef MK_REP
            if (ph == MK_REP) launch_ph(a, grid, l, l + 1, ph, ph + 1, 0, stream);
#endif
        }
#else
    launch_ph(a, grid, 0, L, PH_PRO, PH_END, 1, stream);
#endif
}
```

```cpp
#include <hip/hip_runtime.h>
#include <stdint.h>
#include <stdio.h>

#define LAS __attribute__((address_space(3)))
typedef unsigned short bf16_t;
typedef short bf16x8 __attribute__((ext_vector_type(8)));
typedef float f32x4 __attribute__((ext_vector_type(4)));
typedef float f32x16 __attribute__((ext_vector_type(16)));
typedef unsigned u32x4 __attribute__((ext_vector_type(4)));
typedef unsigned u32x2 __attribute__((ext_vector_type(2)));

constexpr int Bn = 4, S = 4096, D = 1024, L = 2, NTOK = Bn * S, DIN = 2212, F = 512, NE = 32;
constexpr int NP = 2304;
constexpr int NK = 0, NV = 256, NIQ = 512, NIK = 640, NIW = 672, NBA = 768, NBG = 1024, NC = 1280, NDU = 1536, NDV = 1792, NQ = 2048;
constexpr float EPS = 1e-6f;
constexpr int NTHR = 512;
constexpr int SLOTS = 40960;

constexpr int LDS_BYTES = 163840, LDS_MISC = 147456;
constexpr int MISC_BAR = 0;
constexpr int MISC_CUM = 64;
constexpr int MISC_CNT = 64 + 160;

constexpr size_t al256c(size_t v) { return (v + 255) & ~(size_t)255; }
constexpr size_t WS_BAR = 0;
constexpr size_t WS_CNT = 16384;
constexpr size_t WS_FLAG = 16384 + 16384;
constexpr size_t WS_ZERO_BYTES = 16384 + 32768;
constexpr size_t WS_MOD = WS_ZERO_BYTES;
constexpr size_t WS_ROPEA = WS_MOD + al256c((size_t)L * 4 * 6144 * 4);
constexpr size_t WS_ROPEI = WS_ROPEA + al256c((size_t)NTOK * 16 * 4);
constexpr size_t WS_LIST = WS_ROPEI + al256c((size_t)NTOK * 8 * 4);
constexpr size_t WS_LGATE = WS_LIST + al256c((size_t)NE * NTOK * 4);
constexpr size_t WS_TOKINFO = WS_LGATE + al256c((size_t)NE * NTOK * 4);
constexpr size_t WS_SGUW = WS_TOKINFO + al256c((size_t)NTOK * 16);
constexpr size_t WS_POOLT = WS_SGUW + al256c((size_t)L * 4 * 128 * 128 * 2);
constexpr size_t WS_WHL = WS_POOLT + al256c((size_t)L * 4 * 64 * 64 * 2);
constexpr size_t WS_RBIAS = WS_WHL + al256c((size_t)L * 2 * 48 * 1024 * 2);
constexpr size_t WS_SSQ = WS_RBIAS + al256c((size_t)L * 4 * 32 * 48 * 4);
constexpr size_t WS_WINT = WS_SSQ + al256c((size_t)L * NTOK * 4 * 4);
constexpr size_t WS_WOUTT = WS_WINT + al256c((size_t)L * NP * D * 2);
constexpr size_t WS_PWT = WS_WOUTT + al256c((size_t)L * D * D * 2);
constexpr size_t WS_WGUT = WS_PWT + al256c((size_t)L * 256 * 256 * 2);
constexpr size_t WS_WDT = WS_WGUT + al256c((size_t)L * NE * 1024 * 1024 * 2);
constexpr size_t WS_HA = WS_WDT + al256c((size_t)L * NE * 1024 * 512 * 2);
constexpr size_t WS_X1 = WS_HA + al256c((size_t)NTOK * D * 2);
constexpr size_t WS_R = WS_X1 + al256c((size_t)NTOK * D * 4);
constexpr size_t WS_PROJ = WS_R;
constexpr size_t WS_R2 = WS_PROJ + al256c((size_t)NTOK * NP * 2);
constexpr size_t WS_HID = WS_R;
constexpr size_t WS_Y = WS_HID + al256c((size_t)SLOTS * F * 2);

__device__ __forceinline__ unsigned cvt_pk_bf16(float lo, float hi) { unsigned r; asm volatile("v_cvt_pk_bf16_f32 %0, %1, %2" : "=v"(r) : "v"(lo), "v"(hi)); return r; }
__device__ __forceinline__ float bf2f(bf16_t v) { return __uint_as_float(((unsigned)v) << 16); }
__device__ __forceinline__ float bflo(unsigned w) { return __uint_as_float(w << 16); }
__device__ __forceinline__ float bfhi(unsigned w) { return __uint_as_float(w & 0xffff0000u); }
template <int CTRL> __device__ __forceinline__ float dpp_f(float v) { return __builtin_bit_cast(float, __builtin_amdgcn_update_dpp(0, __builtin_bit_cast(int, v), CTRL, 0xF, 0xF, true)); }
__device__ __forceinline__ float row_sum16(float v) {
    v += dpp_f<0xB1>(v);
    v += dpp_f<0x4E>(v);
    v += dpp_f<0x141>(v);
    v += dpp_f<0x140>(v);
    return v;
}
__device__ __forceinline__ float wave_sum(float v) {
    v = row_sum16(v);
    const float r0 = __builtin_bit_cast(float, __builtin_amdgcn_readlane(__builtin_bit_cast(int, v), 0)), r1 = __builtin_bit_cast(float, __builtin_amdgcn_readlane(__builtin_bit_cast(int, v), 16));
    const float r2 = __builtin_bit_cast(float, __builtin_amdgcn_readlane(__builtin_bit_cast(int, v), 32)), r3 = __builtin_bit_cast(float, __builtin_amdgcn_readlane(__builtin_bit_cast(int, v), 48));
    return (r0 + r1) + (r2 + r3);
}
__device__ __forceinline__ float wave_max(float v) {
#pragma unroll
    for (int o = 32; o >= 1; o >>= 1) v = fmaxf(v, __shfl_xor(v, o));
    return v;
}
__device__ __forceinline__ float silu_f(float v) { return v / (1.0f + expf(-v)); }
__device__ __forceinline__ float silu_fast(float v) { return v * __builtin_amdgcn_rcpf(1.0f + __expf(-v)); }
__device__ __forceinline__ float sigmoid_f(float v) { return 1.0f / (1.0f + expf(-v)); }
__device__ __forceinline__ float sigmoid_fast(float v) { return __builtin_amdgcn_rcpf(1.0f + __expf(-v)); }
__device__ __forceinline__ int opaque_tid() { int t = threadIdx.x; asm volatile("" : "+v"(t)); return t; }
__device__ __forceinline__ int ld_agent(const int* p) { return __hip_atomic_load(p, __ATOMIC_RELAXED, __HIP_MEMORY_SCOPE_AGENT); }

#define XB_TMO      128
#define XB_XCNT(j)  (256  + 64 * (j))
#define XB_XSUB(j)  (1280 + 64 * (j))
#define XB_XGEN(j)  (2304 + 64 * (j))
#define XB_TOP      3328
#define XB_TOPGEN   3392
#define XCD_BAR_WORDS 3456
#define XB_SPIN_CAP (1u << 18)
__device__ __forceinline__ unsigned xb_ld(unsigned* p)              { return __hip_atomic_load(p, __ATOMIC_RELAXED, __HIP_MEMORY_SCOPE_AGENT); }
__device__ __forceinline__ unsigned xb_add(unsigned* p, unsigned v) { return __hip_atomic_fetch_add(p, v, __ATOMIC_RELAXED, __HIP_MEMORY_SCOPE_AGENT); }
__device__ __forceinline__ unsigned xb_xcc_id() { return (unsigned)__builtin_amdgcn_s_getreg((3 << 11) | 20) & 0xFu; }
#define XB_SPIN(cond, bar) do { unsigned _sp = 0; while (cond) { __builtin_amdgcn_s_sleep(1); \
    if ((++_sp & 255u) == 0u) { if (xb_ld(&(bar)[XB_TMO])) break; if (_sp > XB_SPIN_CAP) { atomicAdd(&(bar)[XB_TMO], 1u); break; } } } } while (0)
struct XcdBarrier { unsigned* bar; unsigned x; volatile LAS unsigned* st; };
__device__ __forceinline__ XcdBarrier xcd_barrier_post(unsigned* bar, volatile LAS unsigned* st) {
    XcdBarrier b; b.bar = bar; b.x = xb_xcc_id(); b.st = st;
    if (threadIdx.x == 0) (void)xb_add(&bar[XB_XCNT(b.x)], 1u);
    return b;
}
__device__ __forceinline__ void xcd_barrier_complete(unsigned* bar, unsigned x, unsigned& nloc, unsigned& nx) {
    const unsigned G = gridDim.x * gridDim.y * gridDim.z;
    unsigned sum, cnt, mine, sp = 0u;
    for (;;) {
        sum = 0u; cnt = 0u; mine = 0u;
#pragma unroll
        for (unsigned j = 0; j < 16; ++j) { const unsigned c = xb_ld(&bar[XB_XCNT(j)]); sum += c; cnt += (c > 0u) ? 1u : 0u; mine = (j == x) ? c : mine; }
        if (sum == G) break;
        __builtin_amdgcn_s_sleep(1);
        if ((++sp & 255u) == 0u) { if (xb_ld(&bar[XB_TMO])) break; if (sp > XB_SPIN_CAP) { atomicAdd(&bar[XB_TMO], 1u); break; } }
    }
    nloc = mine > 0u ? mine : 1u; nx = cnt > 0u ? cnt : 1u;
}
__device__ __forceinline__ void xcd_barrier(const XcdBarrier& b) {
    asm volatile("s_waitcnt vmcnt(0)" ::: "memory");
    __syncthreads();
    if (threadIdx.x == 0) {
        unsigned* bar = b.bar;
        __builtin_amdgcn_s_waitcnt(0);
        unsigned nloc = b.st[0], nx = b.st[1];
        if (nloc == 0u) { xcd_barrier_complete(bar, b.x, nloc, nx); b.st[0] = nloc; b.st[1] = nx; }
        const unsigned old = xb_add(&bar[XB_XSUB(b.x)], 1u);
        const unsigned gen = old / nloc;
        if (old + 1u == (gen + 1u) * nloc) {
            __builtin_amdgcn_fence(__ATOMIC_RELEASE, "agent");
            asm volatile("s_waitcnt vmcnt(0)" ::: "memory");
            const unsigned og = xb_add(&bar[XB_TOP], 1u);
            const unsigned tg = og / nx;
            if (og + 1u == (tg + 1u) * nx) xb_add(&bar[XB_TOPGEN], 1u);
            else XB_SPIN(xb_ld(&bar[XB_TOPGEN]) == tg, bar);
            __builtin_amdgcn_fence(__ATOMIC_ACQUIRE, "agent");
            xb_add(&bar[XB_XGEN(b.x)], 1u);
            asm volatile("s_waitcnt vmcnt(0)" ::: "memory");
        } else {
            XB_SPIN(xb_ld(&bar[XB_XGEN(b.x)]) == gen, bar);
            __builtin_amdgcn_fence(__ATOMIC_ACQUIRE, "agent");
            asm volatile("s_waitcnt vmcnt(0)" ::: "memory");
        }
    }
    __syncthreads();
}

namespace pg8 {
constexpr int BM = 256, BK = 64, HALF = 128, HTB = HALF * BK * 2, STAGE_BYTES = 8 * HTB, NXCD = 8, WGM = 8;
__host__ __device__ __forceinline__ int lds_byte(int r, int c) { const int st = (r >> 4) * 2 + (c >> 5), rr = r & 15, cc = c & 31, ob = rr * 64 + cc * 2; return st * 1024 + (ob ^ (((ob >> 9) & 1) << 5)); }
__host__ __device__ __forceinline__ void stage_rc(int b, int& R, int& C) { const int st = b / 1024, sb = b % 1024, swz = sb ^ (((sb >> 9) & 1) << 5); R = (st >> 1) * 16 + swz / 64; C = (st & 1) * 32 + (swz % 64) / 2; }
__host__ __device__ __forceinline__ int perm32(int rho) { const int n = rho >> 4, i = rho & 15; return 8 * (i >> 2) + 4 * n + (i & 3); }

struct Unit { int pm, pn, e, mt, cnt; };

struct DenseOrder {
    static constexpr int SYNC = 0;
    const bf16_t* A; const bf16_t* Bt; int K;
    int nM, nN, nwg, G, c;
    __device__ void init(const bf16_t* A_, const bf16_t* Bt_, int M, int N, int K_, int G_, int c_) { A = A_; Bt = Bt_; K = K_; nM = M / BM; nN = N / BM; nwg = nM * nN; G = G_; c = c_; }
    __device__ bool next(int i, Unit& u) const {
        const long Lx = (long)i * G + c; if (Lx >= nwg) return false;
        int wgid = (int)Lx; { const int q = nwg / NXCD, r = nwg % NXCD, xcd = wgid % NXCD, off = wgid / NXCD; wgid = (xcd < r ? xcd * (q + 1) : r * (q + 1) + (xcd - r) * q) + off; }
        const int nig = WGM * nN, gid = wgid / nig, fm = gid * WGM, gsz = (nM - fm) < WGM ? (nM - fm) : WGM;
        u.pm = fm + ((wgid % nig) % gsz); u.pn = (wgid % nig) / gsz; u.e = 0; u.mt = 0; u.cnt = 0; return true;
    }
    __device__ __forceinline__ const char* a_base(const Unit& u) const { return (const char*)A + (size_t)u.pm * BM * K * 2; }
    __device__ __forceinline__ unsigned a_voff(const Unit&, int row, int C) const { return (unsigned)(row * K + C) * 2u; }
    __device__ __forceinline__ const char* b_base(const Unit& u) const { return (const char*)Bt + (size_t)u.pn * BM * K * 2; }
};
template <bool gather> struct MoeOrder {
    static constexpr int SYNC = gather ? 1 : 2;
    int* flag;
    const bf16_t* A; const bf16_t* Bt; int K; size_t bstride;
    const int* list;
    const LAS int* cum; const LAS int* cnts;
    int G, c, nun;
    __device__ bool next(int i, Unit& u) const {
        const int Lx = i * G + c; if (Lx >= nun) return false;
        const int t = Lx >> 2; u.pn = Lx & 3; u.pm = t;
        int e = 0;
#pragma unroll 1
        for (int j = 1; j < NE; ++j) e += (cum[j] <= t) ? 1 : 0;
        u.e = e; u.mt = t - cum[e]; u.cnt = cnts[e]; return true;
    }
    __device__ __forceinline__ const char* a_base(const Unit& u) const { return gather ? (const char*)A : (const char*)A + (size_t)u.pm * BM * K * 2; }
    __device__ __forceinline__ unsigned a_voff(const Unit& u, int row, int C) const {
        if (gather) { const int pos = u.mt * BM + row; const int tok = (pos < u.cnt) ? list[(size_t)u.e * NTOK + pos] : 0; return (unsigned)(tok * K + C) * 2u; }
        return (unsigned)(row * K + C) * 2u;
    }
    __device__ __forceinline__ const char* b_base(const Unit& u) const { return (const char*)(Bt + (size_t)u.e * bstride) + (size_t)u.pn * BM * K * 2; }
};

struct EpiBf16 {
    static constexpr bool PERM = true;
    bf16_t* O; int ldc;
    __device__ __forceinline__ void operator()(const f32x4 (&acc)[2][2][4][2], const Unit& u, int wr, int wc, int fr, int fq) const {
        const int row0 = u.pm * BM + wr * 64 + fr, col0 = u.pn * BM + wc * 32 + 8 * fq;
#pragma unroll
        for (int ai = 0; ai < 2; ++ai)
#pragma unroll
            for (int m = 0; m < 4; ++m) { bf16_t* rowp = O + (size_t)(row0 + ai * HALF + m * 16) * ldc + col0;
#pragma unroll
                for (int bj = 0; bj < 2; ++bj) { const f32x4 v0 = acc[ai][bj][m][0], v1 = acc[ai][bj][m][1];
                    u32x4 w; w.x = cvt_pk_bf16(v0[0], v0[1]); w.y = cvt_pk_bf16(v0[2], v0[3]); w.z = cvt_pk_bf16(v1[0], v1[1]); w.w = cvt_pk_bf16(v1[2], v1[3]);
                    *(u32x4*)(rowp + bj * HALF) = w; } }
    }
};
struct EpiResid {
    static constexpr bool PERM = true;
    const float* X; const bf16_t* Xb; bf16_t* C; const float* gate;
    const float* ssq;
    __device__ __forceinline__ void rowscale(f32x4 (&acc)[2][2][4][2], const Unit& u, int wr, int fr) const {
        int rbase = u.pm * BM + wr * 64 + fr;
        asm volatile("" : "+v"(rbase));
#pragma unroll
        for (int ai = 0; ai < 2; ++ai)
#pragma unroll
            for (int m = 0; m < 4; ++m) { const f32x4 sv = *(const f32x4*)(ssq + (size_t)(rbase + ai * HALF + m * 16) * 4); const float r = rsqrtf(((sv[0] + sv[1]) + (sv[2] + sv[3])) * (1.0f / 256.0f) + EPS);
#pragma unroll
                for (int bj = 0; bj < 2; ++bj)
#pragma unroll
                    for (int n = 0; n < 2; ++n) acc[ai][bj][m][n] *= r; }
    }
    __device__ __forceinline__ void operator()(const f32x4 (&acc)[2][2][4][2], const Unit& u, int wr, int wc, int fr, int fq) const {
        const int row0 = u.pm * BM + wr * 64 + fr, col0 = u.pn * BM + wc * 32 + 8 * fq;
        const float* gp = gate + (size_t)((u.pm * BM) / S) * 6144 + col0;
        f32x4 gv[2][2];
#pragma unroll
        for (int bj = 0; bj < 2; ++bj)
#pragma unroll
            for (int n = 0; n < 2; ++n) gv[bj][n] = *(const f32x4*)(gp + bj * HALF + n * 4);
#pragma unroll
        for (int ai = 0; ai < 2; ++ai)
#pragma unroll
            for (int m = 0; m < 4; ++m) { const size_t off = (size_t)(row0 + ai * HALF + m * 16) * D + col0;
#pragma unroll
                for (int bj = 0; bj < 2; ++bj) {
                    f32x4 x0, x1v;
                    if (Xb) { const u32x4 xw = *(const u32x4*)(Xb + off + bj * HALF); x0 = (f32x4){bflo(xw.x), bfhi(xw.x), bflo(xw.y), bfhi(xw.y)}; x1v = (f32x4){bflo(xw.z), bfhi(xw.z), bflo(xw.w), bfhi(xw.w)}; }
                    else { x0 = *(const f32x4*)(X + off + bj * HALF); x1v = *(const f32x4*)(X + off + bj * HALF + 4); }
                    const f32x4 o0 = x0 + gv[bj][0] * acc[ai][bj][m][0], o1 = x1v + gv[bj][1] * acc[ai][bj][m][1];
                    u32x4 w; w.x = cvt_pk_bf16(o0[0], o0[1]); w.y = cvt_pk_bf16(o0[2], o0[3]); w.z = cvt_pk_bf16(o1[0], o1[1]); w.w = cvt_pk_bf16(o1[2], o1[3]);
                    *(u32x4*)(C + off + bj * HALF) = w; }
                asm volatile("" ::: "memory"); }
    }
};
__device__ __forceinline__ void store_wt16(void* ptr, u32x4 w) { asm volatile("global_store_dwordx4 %0, %1, off sc1\n\ts_nop 1" :: "v"(ptr), "v"(w) : "memory"); }
__device__ __forceinline__ void flag_wait(const int* flag, int want) {
    while (__hip_atomic_load(flag, __ATOMIC_RELAXED, __HIP_MEMORY_SCOPE_AGENT) < want) __builtin_amdgcn_s_sleep(1);
    __builtin_amdgcn_fence(__ATOMIC_ACQUIRE, "agent");
    asm volatile("s_waitcnt vmcnt(0)" ::: "memory");
}
struct EpiHid {
    static constexpr bool PERM = true;
    bf16_t* H;
    __device__ __forceinline__ void operator()(const f32x4 (&acc)[2][2][4][2], const Unit& u, int wr, int wc, int fr, int fq) const {
        const int row0 = u.pm * BM + wr * 64 + fr, col0 = u.pn * HALF + wc * 32 + 8 * fq;
#pragma unroll
        for (int ai = 0; ai < 2; ++ai)
#pragma unroll
            for (int m = 0; m < 4; ++m) { float h[8];
#pragma unroll
                for (int n = 0; n < 2; ++n)
#pragma unroll
                    for (int j = 0; j < 4; ++j) h[n * 4 + j] = silu_fast(acc[ai][0][m][n][j]) * acc[ai][1][m][n][j];
                u32x4 w; w.x = cvt_pk_bf16(h[0], h[1]); w.y = cvt_pk_bf16(h[2], h[3]); w.z = cvt_pk_bf16(h[4], h[5]); w.w = cvt_pk_bf16(h[6], h[7]);
                store_wt16(H + (size_t)(row0 + ai * HALF + m * 16) * F + col0, w); }
    }
};
struct EpiDown {
    static constexpr bool PERM = true;
    bf16_t* Y; const float* lgate;
    __device__ __forceinline__ void operator()(const f32x4 (&acc)[2][2][4][2], const Unit& u, int wr, int wc, int fr, int fq) const {
        const int rl0 = wr * 64 + fr, col0 = u.pn * BM + wc * 32 + 8 * fq;
        const float* gp = lgate + (size_t)u.e * NTOK + u.mt * BM;
#pragma unroll
        for (int ai = 0; ai < 2; ++ai)
#pragma unroll
            for (int m = 0; m < 4; ++m) { const int rl = rl0 + ai * HALF + m * 16; const float g = (u.mt * BM + rl < u.cnt) ? gp[rl] : 0.f;
                bf16_t* rowp = Y + (size_t)(u.pm * BM + rl) * D + col0;
#pragma unroll
                for (int bj = 0; bj < 2; ++bj) { const f32x4 v0 = acc[ai][bj][m][0] * g, v1 = acc[ai][bj][m][1] * g;
                    u32x4 w; w.x = cvt_pk_bf16(v0[0], v0[1]); w.y = cvt_pk_bf16(v0[2], v0[3]); w.z = cvt_pk_bf16(v1[0], v1[1]); w.w = cvt_pk_bf16(v1[2], v1[3]);
                    *(u32x4*)(rowp + bj * HALF) = w; } }
    }
};

template <class Epi, class Sched, bool RSC = false>
__device__ __forceinline__ void gemm_phase(LAS unsigned char* lds, const Sched& S, const Epi& E) {
    const int tid = opaque_tid(), wid = __builtin_amdgcn_readfirstlane(tid >> 6), lane = tid & 63, wr = wid >> 2, wc = wid & 3, fr = lane & 15, fq = lane >> 4;
    const int K = S.K, nt = K / BK;
    int Rr[2], Cc[2]; unsigned voffB[2];
#pragma unroll
    for (int i = 0; i < 2; ++i) { stage_rc(tid * 16 + i * 8192, Rr[i], Cc[i]); const int Rb = Epi::PERM ? ((Rr[i] & ~31) + perm32(Rr[i] & 31)) : Rr[i]; voffB[i] = (unsigned)(Rb * K + Cc[i]) * 2u; }
    const size_t kstep = (size_t)(BK * 2);
    const size_t hstep = (size_t)HALF * K * 2;
    const unsigned ldsw = (unsigned)wid * 1024u;
    const int aoff = lds_byte(wr * 64 + fr, fq * 8), boff = lds_byte(wc * 32 + fr, fq * 8);
#define PG8_SA(b, h) (((b) * 2 + (h)) * HTB)
#define PG8_SB(b, h) ((4 + (b) * 2 + (h)) * HTB)
#define PG8_STAGE(bufoff, gbase, voff) do { _Pragma("unroll") for (int _i = 0; _i < 2; ++_i) \
        __builtin_amdgcn_global_load_lds((const unsigned*)((const char*)(gbase) + (voff)[_i]), (LAS unsigned*)(lds + (bufoff) + ldsw + _i * 8192), 16, 0, 0); } while (0)
#define PG8_LDA(dst, b, h) do { _Pragma("unroll") for (int m = 0; m < 4; ++m) _Pragma("unroll") for (int k = 0; k < 2; ++k) dst[m][k] = *(const LAS bf16x8*)(lds + PG8_SA(b, h) + aoff + m * 2048 + k * 1024); } while (0)
#define PG8_LDB(dst, b, h) do { _Pragma("unroll") for (int n = 0; n < 2; ++n) _Pragma("unroll") for (int k = 0; k < 2; ++k) dst[n][k] = *(const LAS bf16x8*)(lds + PG8_SB(b, h) + boff + n * 2048 + k * 1024); } while (0)
#define PG8_MMA(ai, bj, At, Bt) do { __builtin_amdgcn_s_setprio(1); _Pragma("unroll") for (int m = 0; m < 4; ++m) _Pragma("unroll") for (int n = 0; n < 2; ++n) _Pragma("unroll") for (int k = 0; k < 2; ++k) \
        acc[ai][bj][m][n] = __builtin_amdgcn_mfma_f32_16x16x32_bf16(Bt[n][k], At[m][k], acc[ai][bj][m][n], 0, 0, 0); __builtin_amdgcn_s_setprio(0); } while (0)
#define PG8_WAIT_V(n) asm volatile("s_waitcnt vmcnt(" #n ")" ::: "memory")
#define PG8_WAIT_L(n) asm volatile("s_waitcnt lgkmcnt(" #n ")" ::: "memory")
#define PG8_BAR __builtin_amdgcn_s_barrier()
#define PG8_SCHED __builtin_amdgcn_sched_barrier(0)
    Unit cur, nxt; int ui = 0;
    if (!S.next(0, cur)) return;
    if constexpr (Sched::SYNC == 2) { if (wid == 0) flag_wait(S.flag + cur.pm * 8, 4); __builtin_amdgcn_s_barrier(); }
    f32x4 acc[2][2][4][2];
#pragma unroll
    for (int a = 0; a < 2; ++a)
#pragma unroll
        for (int b = 0; b < 2; ++b)
#pragma unroll
            for (int m = 0; m < 4; ++m)
#pragma unroll
                for (int n = 0; n < 2; ++n) acc[a][b][m][n] = (f32x4){0.f, 0.f, 0.f, 0.f};
    bf16x8 At[4][2], B0[2][2], B1[2][2];
    unsigned vA0[2], vA1[2], vN0[2], vN1[2];
#pragma unroll
    for (int i = 0; i < 2; ++i) { vA0[i] = S.a_voff(cur, Rr[i], Cc[i]); vA1[i] = S.a_voff(cur, HALF + Rr[i], Cc[i]); }
    const char* cA = S.a_base(cur); const char* cB = S.b_base(cur);
    PG8_STAGE(PG8_SB(0, 0), cB, voffB); PG8_STAGE(PG8_SB(0, 1), cB + hstep, voffB); PG8_STAGE(PG8_SA(0, 0), cA, vA0); PG8_STAGE(PG8_SA(0, 1), cA, vA1);
    if (wr == 1) PG8_BAR;
    PG8_WAIT_V(2); PG8_BAR;
    PG8_STAGE(PG8_SB(1, 0), cB + kstep, voffB); PG8_STAGE(PG8_SA(1, 0), cA + kstep, vA0); PG8_STAGE(PG8_SB(1, 1), cB + hstep + kstep, voffB);
    PG8_WAIT_V(6); PG8_BAR;
    for (;;) {
        const bool has_next = S.next(ui + 1, nxt);
        const char* nA = has_next ? S.a_base(nxt) : cA; const char* nB = has_next ? S.b_base(nxt) : cB;
#pragma unroll
        for (int i = 0; i < 2; ++i) { vN0[i] = has_next ? S.a_voff(nxt, Rr[i], Cc[i]) : vA0[i]; vN1[i] = has_next ? S.a_voff(nxt, HALF + Rr[i], Cc[i]) : vA1[i]; }
        for (int t = 0; t < nt; t += 2) {
            const bool last = (t == nt - 2);
            if constexpr (Sched::SYNC == 2) { if (last && has_next && wid == 0) flag_wait(S.flag + nxt.pm * 8, 4); }
            if constexpr (RSC) { if (t == 4) E.rowscale(acc, cur, wr, fr); }
            const char* a1 = cA + (size_t)(t + 1) * kstep;
            const char* a2 = last ? nA : cA + (size_t)(t + 2) * kstep; const char* b2 = last ? nB : cB + (size_t)(t + 2) * kstep;
            const char* a3 = a2 + kstep; const char* b3 = b2 + kstep;
            unsigned w0[2], w1[2];
#pragma unroll
            for (int i = 0; i < 2; ++i) { w0[i] = last ? vN0[i] : vA0[i]; w1[i] = last ? vN1[i] : vA1[i]; }
            PG8_LDB(B0, 0, 0); PG8_LDB(B1, 0, 1); PG8_SCHED; PG8_LDA(At, 0, 0); PG8_STAGE(PG8_SA(1, 1), a1, vA1);
            PG8_WAIT_V(8); PG8_WAIT_L(0); PG8_BAR; PG8_MMA(0, 0, At, B0); PG8_MMA(0, 1, At, B1); PG8_BAR; PG8_SCHED;
            PG8_LDA(At, 0, 1); PG8_STAGE(PG8_SB(0, 0), b2, voffB); PG8_STAGE(PG8_SB(0, 1), b2 + hstep, voffB); PG8_STAGE(PG8_SA(0, 0), a2, w0);
            PG8_WAIT_V(8); PG8_WAIT_L(0); PG8_BAR; PG8_MMA(1, 0, At, B0); PG8_MMA(1, 1, At, B1); PG8_BAR; PG8_SCHED;
            PG8_LDB(B0, 1, 0); PG8_LDB(B1, 1, 1); PG8_SCHED; PG8_LDA(At, 1, 0); PG8_STAGE(PG8_SA(0, 1), a2, w1);
            PG8_WAIT_V(8); PG8_WAIT_L(0); PG8_BAR; PG8_MMA(0, 0, At, B0); PG8_MMA(0, 1, At, B1); PG8_BAR; PG8_SCHED;
            PG8_LDA(At, 1, 1); PG8_STAGE(PG8_SB(1, 0), b3, voffB); PG8_STAGE(PG8_SB(1, 1), b3 + hstep, voffB); PG8_STAGE(PG8_SA(1, 0), a3, w0);
            PG8_WAIT_V(8); PG8_WAIT_L(0); PG8_BAR; PG8_MMA(1, 0, At, B0); PG8_MMA(1, 1, At, B1); PG8_BAR; PG8_SCHED;
        }
        if (wr == 0) PG8_BAR;
        E(acc, cur, wr, wc, fr, fq);
        if constexpr (Sched::SYNC == 1) { PG8_WAIT_V(0); PG8_BAR; if (tid == 0) __hip_atomic_fetch_add(S.flag + cur.pm * 8, 1, __ATOMIC_RELAXED, __HIP_MEMORY_SCOPE_AGENT); }
        if (!has_next) break;
#pragma unroll
        for (int a = 0; a < 2; ++a)
#pragma unroll
            for (int b = 0; b < 2; ++b)
#pragma unroll
                for (int m = 0; m < 4; ++m)
#pragma unroll
                    for (int n = 0; n < 2; ++n) acc[a][b][m][n] = (f32x4){0.f, 0.f, 0.f, 0.f};
        cur = nxt; cA = nA; cB = nB; ++ui;
#pragma unroll
        for (int i = 0; i < 2; ++i) { vA0[i] = vN0[i]; vA1[i] = vN1[i]; }
        if (wr == 1) PG8_BAR;
    }
    PG8_WAIT_V(0);
    PG8_BAR;
#undef PG8_SA
#undef PG8_SB
#undef PG8_STAGE
#undef PG8_LDA
#undef PG8_LDB
#undef PG8_MMA
#undef PG8_WAIT_V
#undef PG8_WAIT_L
#undef PG8_BAR
#undef PG8_SCHED
}
}
struct Args { const void* in[32]; float* out; unsigned char* ws; int l_lo, l_hi, ph_lo, ph_hi, fused, pad; };
enum { PH_PRO = 0, PH_NORM0 = 1, PH_G1 = 2, PH_MIX = 3, PH_A1 = 4, PH_A2 = 5, PH_AN = 6, PH_G2 = 7, PH_ROUTE = 8, PH_UP = 9, PH_DOWN = 10, PH_COMB = 11, PH_END = 12 };

typedef const Args __attribute__((address_space(4))) KArgs;
__device__ __forceinline__ KArgs* kargs() { KArgs* p = (KArgs*)__builtin_amdgcn_kernarg_segment_ptr(); asm volatile("" : "+s"(p)); return p; }
#define IN_F(i) ((const float*)ka->in[i])
enum { I_X = 0, I_C, I_POS, I_WADA, I_BADA, I_NORM1, I_WIN, I_QN, I_KN, I_CONVW, I_CONVB, I_CLNG, I_CLNB, I_PWW, I_PWB, I_POOLW, I_POOLB, I_POOLS, I_SLNG, I_SLNB, I_SGUW, I_SGUB,
       I_ONORM, I_WOUT, I_NORM2, I_WRG, I_BRG, I_WRE, I_BRE, I_WG, I_WU, I_WD };

__device__ __forceinline__ void sincos_d(double a, double& s, double& c) {
    const double k = rint(a * 0.63661977236758134308);
    const double r = (a - k * 1.57079632679489655800) - k * 6.123233995736766036e-17;
    const double r2 = r * r;
    const double sp = r * (1.0 + r2 * (-1.0 / 6 + r2 * (1.0 / 120 + r2 * (-1.0 / 5040 + r2 * (1.0 / 362880 + r2 * (-1.0 / 39916800 + r2 * (1.0 / 6227020800.0)))))));
    const double cp = 1.0 + r2 * (-0.5 + r2 * (1.0 / 24 + r2 * (-1.0 / 720 + r2 * (1.0 / 40320 + r2 * (-1.0 / 3628800 + r2 * (1.0 / 479001600.0 + r2 * (-1.0 / 87178291200.0)))))));
    const int q = ((int)k) & 3;
    if (q == 0) { s = sp; c = cp; } else if (q == 1) { s = cp; c = -sp; } else if (q == 2) { s = -sp; c = -cp; } else { s = -cp; c = sp; }
}

__device__ __forceinline__ bf16_t f2bf_(float f) { return (bf16_t)(cvt_pk_bf16(f, 0.f) & 0xffffu); }
struct TItem { const float* src; int ld; int ncol; bf16_t* dst; int ldd; const float* rsc; };
constexpr int NT_WIN = L * 36 * 4, NT_WOUT = L * 16 * 4, NT_PW = L * 4, NT_WGU = L * NE * 16 * 4, NT_WD = L * NE * 16 * 2;
constexpr int NT_ALL = NT_WIN + NT_WOUT + NT_PW + NT_WGU + NT_WD;
__device__ __forceinline__ void decode_titem(int it, const Args& a, TItem& t) {
    KArgs* ka = kargs();
    unsigned char* ws = ka->ws;
    t.rsc = nullptr;
    if (it < NT_WIN) {
        const int l = it / 144, r = it % 144, n0 = (r >> 2) * 64, k0 = (r & 3) * 256;
        const int c0 = n0 < 768 ? n0 + 256 : (n0 < 2048 ? n0 + 164 : n0 - 2048);
        t.ncol = (n0 < 768) ? ((n0 + 64 <= 676) ? 64 : (n0 < 676 ? 676 - n0 : 0)) : 64;
        t.src = IN_F(I_WIN) + ((size_t)l * D + k0) * DIN + c0; t.ld = DIN;
        t.dst = (bf16_t*)(ws + WS_WINT) + ((size_t)l * NP + n0) * D + k0; t.ldd = D; return;
    }
    it -= NT_WIN;
    if (it < NT_WOUT) {
        const int l = it / 64, r = it % 64, n0 = (r >> 2) * 64, k0 = (r & 3) * 256;
        t.ncol = 64; t.src = IN_F(I_WOUT) + ((size_t)l * D + k0) * D + n0; t.ld = D; t.rsc = (k0 == 0) ? IN_F(I_ONORM) + l * D : nullptr;
        t.dst = (bf16_t*)(ws + WS_WOUTT) + ((size_t)l * D + n0) * D + k0; t.ldd = D; return;
    }
    it -= NT_WOUT;
    if (it < NT_PW) {
        const int l = it / 4, n0 = (it & 3) * 64;
        t.ncol = 64; t.src = IN_F(I_PWW) + (size_t)l * 65536 + n0; t.ld = 256;
        t.dst = (bf16_t*)(ws + WS_PWT) + ((size_t)l * 256 + n0) * 256; t.ldd = 256; return;
    }
    it -= NT_PW;
    if (it < NT_WGU) {
        const int le = it / 64, r = it % 64, n0 = (r >> 2) * 64, k0 = (r & 3) * 256;
        const int pn = n0 >> 8, rr = n0 & 255;
        const float* W = (rr < 128) ? IN_F(I_WG) : IN_F(I_WU);
        t.ncol = 64; t.src = W + ((size_t)le * D + k0) * F + pn * 128 + (rr & 127); t.ld = F;
        t.dst = (bf16_t*)(ws + WS_WGUT) + ((size_t)le * 1024 + n0) * D + k0; t.ldd = D; return;
    }
    it -= NT_WGU;
    {
        const int le = it / 32, r = it % 32, n0 = (r >> 1) * 64, k0 = (r & 1) * 256;
        t.ncol = 64; t.src = IN_F(I_WD) + ((size_t)le * F + k0) * D + n0; t.ld = D;
        t.dst = (bf16_t*)(ws + WS_WDT) + ((size_t)le * D + n0) * F + k0; t.ldd = F;
    }
}
__device__ __forceinline__ void titem_load(const TItem& t, int tid, float4 (&v)[8]) {
    const int c4 = tid & 15, r0 = tid >> 4;
#pragma unroll
    for (int i = 0; i < 8; ++i) v[i] = (c4 * 4 < t.ncol) ? *(const float4*)(t.src + (size_t)(r0 + 32 * i) * t.ld + c4 * 4) : make_float4(0.f, 0.f, 0.f, 0.f);
    if (t.rsc) {
#pragma unroll
        for (int i = 0; i < 8; ++i) { const float s = t.rsc[r0 + 32 * i]; v[i].x *= s; v[i].y *= s; v[i].z *= s; v[i].w *= s; }
    }
}
__device__ __forceinline__ void phase_prologue(const Args& a, LAS unsigned char* lds, int vcu, int G) {
    KArgs* ka = kargs();
    const int tid = opaque_tid(), wid = __builtin_amdgcn_readfirstlane(tid >> 6), lane = tid & 63;
    LAS float* T = (LAS float*)lds;
    LAS float* cs = (LAS float*)(lds + 66560);
    LAS float* red = (LAS float*)(lds + 66560 + 16384);
    unsigned char* ws = ka->ws;
    if (vcu < 192) {
        for (int i = tid; i < 4096; i += NTHR) cs[i] = silu_f(IN_F(I_C)[i]);
        __syncthreads();
        for (int it = vcu; it < 192; it += G) {
            const int l = it / 96, j0 = (it % 96) * 64;
            const float* wp = IN_F(I_WADA) + ((size_t)l * D + wid * 128) * 6144 + j0 + lane;
            float a0 = 0.f, a1 = 0.f, a2 = 0.f, a3 = 0.f;
#pragma unroll 32
            for (int k = 0; k < 128; ++k) { const float wv = wp[(size_t)k * 6144]; const int kk = wid * 128 + k; a0 += cs[kk] * wv; a1 += cs[1024 + kk] * wv; a2 += cs[2048 + kk] * wv; a3 += cs[3072 + kk] * wv; }
            red[(wid * 4 + 0) * 64 + lane] = a0; red[(wid * 4 + 1) * 64 + lane] = a1; red[(wid * 4 + 2) * 64 + lane] = a2; red[(wid * 4 + 3) * 64 + lane] = a3;
            __syncthreads();
            if (wid < 4) { float s = 0.f;
#pragma unroll
                for (int w = 0; w < 8; ++w) s += red[(w * 4 + wid) * 64 + lane];
                ((float*)(ws + WS_MOD))[((size_t)l * 4 + wid) * 6144 + j0 + lane] = s + IN_F(I_BADA)[l * 6144 + j0 + lane]; }
            __syncthreads();
        }
    }
    for (int i = vcu * NTHR + tid; i < NTOK; i += G * NTHR) {
        const float invA[8] = {1.0f, 0.1939227432012558f, 0.03760603070259094f, 0.007292664609849453f, 0.0014142135623842478f, 0.00027424818836152554f, 5.318296098266728e-05f, 1.0313386155758053e-05f};
        const float invI[4] = {1.0f, 0.03760603070259094f, 0.0014142135623842478f, 5.318296098266728e-05f};
        const float p = (float)((const int*)ka->in[I_POS])[i];
        float* ra = (float*)(ws + WS_ROPEA) + (size_t)i * 16; float* ri = (float*)(ws + WS_ROPEI) + (size_t)i * 8;
#pragma unroll
        for (int j = 0; j < 8; ++j) { const float ang = p * invA[j]; double s, c; sincos_d((double)ang, s, c); ra[j] = (float)c; ra[8 + j] = (float)s; }
#pragma unroll
        for (int j = 0; j < 4; ++j) { const float ang = p * invI[j]; double s, c; sincos_d((double)ang, s, c); ri[j] = (float)c; ri[4 + j] = (float)s; }
    }
    for (int i = vcu * NTHR + tid; i < L * 4 * 128 * 128; i += G * NTHR) { const int s = i & 127, t = (i >> 7) & 127; ((bf16_t*)(ws + WS_SGUW))[i] = (bf16_t)(cvt_pk_bf16(s <= t ? IN_F(I_SGUW)[i] : 0.f, 0.f) & 0xffffu); }
    for (int i = vcu * NTHR + tid; i < L * 4 * 64 * 64; i += G * NTHR) { const int c = i & 63, d = (i >> 6) & 63, lg = i >> 12; ((bf16_t*)(ws + WS_POOLT))[i] = (bf16_t)(cvt_pk_bf16(IN_F(I_POOLW)[((size_t)lg * 64 + c) * 64 + d], 0.f) & 0xffffu); }
    for (int i = vcu * NTHR + tid; i < L * 48 * 1024; i += G * NTHR) {
        const int k = i & 1023, n = (i >> 10) % 48, lg = i / (48 * 1024);
        const float w = (n < 4) ? IN_F(I_WRG)[((size_t)lg * D + k) * 4 + n] : (n < 36) ? IN_F(I_WRE)[((size_t)lg * D + k) * 32 + (n - 4)] : 0.f;
        const unsigned hi = cvt_pk_bf16(w, 0.f) & 0xffffu; const float lo = w - __uint_as_float(hi << 16);
        bf16_t* dst = (bf16_t*)(ws + WS_WHL) + (size_t)lg * 2 * 48 * 1024 + (size_t)n * 1024 + k;
        dst[0] = (bf16_t)hi; dst[48 * 1024] = f2bf_(lo);
    }
    int* qctr = (int*)(ws + WS_FLAG + 12288);
    LAS int* qn = (LAS int*)(lds + LDS_MISC + 512);
    int pend = 0;
    if (tid == 0) { qn[0] = __hip_atomic_fetch_add(qctr, 1, __ATOMIC_RELAXED, __HIP_MEMORY_SCOPE_AGENT); pend = __hip_atomic_fetch_add(qctr, 1, __ATOMIC_RELAXED, __HIP_MEMORY_SCOPE_AGENT); }
    __syncthreads();
    int it = qn[0];
    bool have = it < NT_ALL;
    TItem cur; cur.src = nullptr; cur.ld = 0; cur.ncol = 0; cur.dst = nullptr; cur.ldd = 0; cur.rsc = nullptr;
    float4 v[8];
    if (have) { decode_titem(it, a, cur); titem_load(cur, tid, v); }
    int par = 1;
    while (have) {
        { const int c4 = tid & 15, r0 = tid >> 4;
#pragma unroll
          for (int i = 0; i < 8; ++i) { LAS float* tp = T + (r0 + 32 * i) * 65 + c4 * 4; tp[0] = v[i].x; tp[1] = v[i].y; tp[2] = v[i].z; tp[3] = v[i].w; } }
        if (tid == 0) qn[par] = pend;
        __syncthreads();
        const int itn = qn[par]; const bool hn = itn < NT_ALL; TItem nx = cur;
        if (tid == 0 && hn) pend = __hip_atomic_fetch_add(qctr, 1, __ATOMIC_RELAXED, __HIP_MEMORY_SCOPE_AGENT);
        if (hn) { decode_titem(itn, a, nx); titem_load(nx, tid, v); }
        { const int n = tid >> 3, kq = tid & 7;
#pragma unroll
          for (int j = 0; j < 4; ++j) { const int kc = j * 8 + kq; float f[8];
#pragma unroll
              for (int jj = 0; jj < 8; ++jj) f[jj] = T[(kc * 8 + jj) * 65 + n];
              u32x4 w; w.x = cvt_pk_bf16(f[0], f[1]); w.y = cvt_pk_bf16(f[2], f[3]); w.z = cvt_pk_bf16(f[4], f[5]); w.w = cvt_pk_bf16(f[6], f[7]);
              *(u32x4*)(cur.dst + (size_t)n * cur.ldd + kc * 8) = w; } }
        __syncthreads();
        cur = nx; it = itn; have = hn; par ^= 1;
    }
}

__device__ __forceinline__ void phase_norm(const float* __restrict__ xin, const float* g, const float* shift, const float* scale, bf16_t* __restrict__ out, int vcu, int G) {
    const int tid = opaque_tid(), wid = __builtin_amdgcn_readfirstlane(tid >> 6), lane = tid & 63;
    for (int rb = vcu * 8 + wid; rb < NTOK / 8; rb += G * 8) {
        const int row0 = rb * 8, b = row0 / S;
        float4 A[4], C[4];
#pragma unroll
        for (int i = 0; i < 4; ++i) { const int k = 256 * i + 4 * lane; const float4 gv = *(const float4*)(g + k), sc = *(const float4*)(scale + (size_t)b * 6144 + k); C[i] = *(const float4*)(shift + (size_t)b * 6144 + k);
            A[i] = make_float4(gv.x * (1.f + sc.x), gv.y * (1.f + sc.y), gv.z * (1.f + sc.z), gv.w * (1.f + sc.w)); }
#pragma unroll 4
        for (int rr = 0; rr < 8; ++rr) {
            const size_t ro = (size_t)(row0 + rr) * D;
            float4 x[4]; float ss = 0.f;
#pragma unroll
            for (int i = 0; i < 4; ++i) { x[i] = *(const float4*)(xin + ro + 256 * i + 4 * lane); ss += x[i].x * x[i].x + x[i].y * x[i].y + x[i].z * x[i].z + x[i].w * x[i].w; }
            const float r = rsqrtf(wave_sum(ss) * (1.0f / D) + EPS);
#pragma unroll
            for (int i = 0; i < 4; ++i) { u32x2 w; w.x = cvt_pk_bf16(x[i].x * r * A[i].x + C[i].x, x[i].y * r * A[i].y + C[i].y); w.y = cvt_pk_bf16(x[i].z * r * A[i].z + C[i].z, x[i].w * r * A[i].w + C[i].w);
                *(u32x2*)(out + ro + 256 * i + 4 * lane) = w; }
        }
    }
}

__device__ __forceinline__ f32x4 mfma16r(const bf16x8 a, const bf16x8 b, const f32x4 c) { return __builtin_amdgcn_mfma_f32_16x16x32_bf16(a, b, c, 0, 0, 0); }
__device__ __forceinline__ void phase_rbias(const Args& a, LAS unsigned char* lds, int vcu, int G) {
    KArgs* ka = kargs();
    const int tid = opaque_tid();
    LAS float* red = (LAS float*)lds;
    for (int v = vcu; v < 256; v += G) {
        const int lb = v & 7, sl = v >> 3, l = lb >> 2, b = lb & 3, n = tid & 63, kp = tid >> 6;
        const float* sh = (const float*)(ka->ws + WS_MOD) + ((size_t)l * 4 + b) * 6144 + 3072;
        float s = 0.f;
        if (n < 36) {
#pragma unroll
            for (int i = 0; i < 4; ++i) { const int k = sl * 32 + kp * 4 + i; s += sh[k] * ((n < 4) ? IN_F(I_WRG)[((size_t)l * D + k) * 4 + n] : IN_F(I_WRE)[((size_t)l * D + k) * 32 + (n - 4)]); }
        }
        red[kp * 64 + n] = s;
        __syncthreads();
        if (tid < 48) { float t = 0.f;
            if (tid < 36) { for (int w = 0; w < 8; ++w) t += red[w * 64 + tid]; }
            ((float*)(ka->ws + WS_RBIAS))[((size_t)lb * 32 + sl) * 48 + tid] = t; }
        __syncthreads();
    }
}

__device__ __forceinline__ void phase_route(const Args& a, int l, LAS unsigned char* lds, int vcu, int G) {
    KArgs* ka = kargs();
    const int tid = opaque_tid(), wid = __builtin_amdgcn_readfirstlane(tid >> 6), lane = tid & 63, fr = lane & 15, kq = lane >> 4;
    unsigned char* ws = ka->ws;
    const bf16_t* x1 = (const bf16_t*)(ws + WS_X1);
    const float* mod = (const float*)(ws + WS_MOD) + (size_t)l * 4 * 6144;
    const float* g = IN_F(I_NORM2) + l * D; const float* shift = mod + 3072; const float* scale = mod + 4096;
    bf16_t* out = (bf16_t*)(ws + WS_HA);
    int* counts = (int*)(ws + WS_CNT) + l * NE * 64; int* list = (int*)(ws + WS_LIST); float* lgate = (float*)(ws + WS_LGATE); int* tokinfo = (int*)(ws + WS_TOKINFO);
    LAS int* lcnt = (LAS int*)(lds + LDS_MISC + 1024); LAS int* lbase = lcnt + 32; LAS int* rte = lbase + 32; LAS int* rtp = rte + 128; LAS int* rtt = rtp + 128; LAS float* rtg = (LAS float*)(rtt + 128);
    LAS float* part = (LAS float*)lds;
    LAS float* ssp = part + 8 * 16 * 48;
    LAS float* lgt = ssp + 8 * 16;
    LAS float* rrow = lgt + 16 * 48;
    const bf16_t* wh = (const bf16_t*)(ws + WS_WHL) + (size_t)l * 2 * 48 * 1024 + (size_t)fr * 1024 + 128 * wid + 8 * kq;
    LAS float* rb = (LAS float*)(lds + LDS_MISC + 8192);
    for (int r0 = vcu * 64; r0 < NTOK; r0 += G * 64) {
        const int b = r0 / S;
        if (tid < 48) { const float* rp = (const float*)(ws + WS_RBIAS) + ((size_t)(l * 4 + b) * 32) * 48 + tid; float t = 0.f;
            for (int sl = 0; sl < 32; ++sl) t += rp[sl * 48];
            if (tid < 36) t += (tid < 4) ? IN_F(I_BRG)[l * 4 + tid] : IN_F(I_BRE)[l * 32 + tid - 4];
            rb[tid] = t; }
        if (tid < 32) lcnt[tid] = 0;
#pragma unroll 1
        for (int q4 = 0; q4 < 4; ++q4) {
            float t[4][8];
            f32x4 acc[3];
#pragma unroll
            for (int nt = 0; nt < 3; ++nt) acc[nt] = (f32x4){0.f, 0.f, 0.f, 0.f};
            float ss = 0.f;
            const int row = r0 + 16 * q4 + fr;
#pragma unroll
            for (int ks = 0; ks < 4; ++ks) {
                const int k0 = 128 * wid + 32 * ks + 8 * kq;
                const f32x4 g0 = *(const f32x4*)(g + k0), g1 = *(const f32x4*)(g + k0 + 4), s0 = *(const f32x4*)(scale + (size_t)b * 6144 + k0), s1 = *(const f32x4*)(scale + (size_t)b * 6144 + k0 + 4);
                const float Ac[8] = {g0[0] * (1.f + s0[0]), g0[1] * (1.f + s0[1]), g0[2] * (1.f + s0[2]), g0[3] * (1.f + s0[3]), g1[0] * (1.f + s1[0]), g1[1] * (1.f + s1[1]), g1[2] * (1.f + s1[2]), g1[3] * (1.f + s1[3])};
                const u32x4 xw = *(const u32x4*)(x1 + (size_t)row * D + k0);
                const float v[8] = {bflo(xw.x), bfhi(xw.x), bflo(xw.y), bfhi(xw.y), bflo(xw.z), bfhi(xw.z), bflo(xw.w), bfhi(xw.w)};
                unsigned ph[4], pl[4];
#pragma unroll
                for (int j = 0; j < 8; ++j) { ss += v[j] * v[j]; t[ks][j] = v[j] * Ac[j]; }
#pragma unroll
                for (int j = 0; j < 4; ++j) { ph[j] = cvt_pk_bf16(t[ks][2 * j], t[ks][2 * j + 1]); pl[j] = cvt_pk_bf16(t[ks][2 * j] - bflo(ph[j]), t[ks][2 * j + 1] - bfhi(ph[j])); }
                const bf16x8 Ah = __builtin_bit_cast(bf16x8, (u32x4){ph[0], ph[1], ph[2], ph[3]}), Al = __builtin_bit_cast(bf16x8, (u32x4){pl[0], pl[1], pl[2], pl[3]});
#pragma unroll
                for (int nt = 0; nt < 3; ++nt) {
                    const bf16x8 Bh = *(const bf16x8*)(wh + (size_t)(16 * nt) * 1024 + 32 * ks), Bl = *(const bf16x8*)(wh + 48 * 1024 + (size_t)(16 * nt) * 1024 + 32 * ks);
                    acc[nt] = mfma16r(Ah, Bh, acc[nt]); acc[nt] = mfma16r(Al, Bh, acc[nt]); acc[nt] = mfma16r(Ah, Bl, acc[nt]);
                }
            }
            ss += __shfl_xor(ss, 16); ss += __shfl_xor(ss, 32);
            if (kq == 0) ssp[wid * 16 + fr] = ss;
#pragma unroll
            for (int nt = 0; nt < 3; ++nt)
#pragma unroll
                for (int r = 0; r < 4; ++r) part[(wid * 16 + 4 * kq + r) * 48 + 16 * nt + fr] = acc[nt][r];
            __syncthreads();
            for (int i = tid; i < 16 * 48; i += NTHR) { float s = 0.f;
#pragma unroll
                for (int w = 0; w < 8; ++w) s += part[w * 16 * 48 + i];
                lgt[i] = s; }
            if (tid < 16) { float s = 0.f;
#pragma unroll
                for (int w = 0; w < 8; ++w) s += ssp[w * 16 + tid];
                rrow[tid] = rsqrtf(s * (1.0f / D) + EPS); }
            __syncthreads();
            if (tid < 16) {
                const int tok = r0 + 16 * q4 + tid; const float r = rrow[tid];
                float ag[4];
#pragma unroll
                for (int j = 0; j < 4; ++j) ag[j] = r * lgt[tid * 48 + j] + rb[j];
                int gi = 0; float gm = ag[0];
#pragma unroll
                for (int j = 1; j < 4; ++j) if (ag[j] > gm) { gm = ag[j]; gi = j; }
                float den = 0.f;
#pragma unroll
                for (int j = 0; j < 4; ++j) den += expf(ag[j] - gm);
                const float p_sel = 1.0f / den;
                float el[8];
#pragma unroll
                for (int j = 0; j < 8; ++j) el[j] = r * lgt[tid * 48 + 4 + gi * 8 + j] + rb[4 + gi * 8 + j];
                int j0 = 0; float v0 = el[0];
#pragma unroll
                for (int j = 1; j < 8; ++j) if (el[j] > v0) { v0 = el[j]; j0 = j; }
                int j1 = 0; float v1 = -INFINITY;
#pragma unroll
                for (int j = 0; j < 8; ++j) if (j != j0 && el[j] > v1) { v1 = el[j]; j1 = j; }
                const float e1 = expf(v1 - v0);
                const float g0 = p_sel / (1.0f + e1), g1 = p_sel * e1 / (1.0f + e1);
                const int ex0 = gi * 8 + j0, ex1 = gi * 8 + j1, ai = (16 * q4 + tid) * 2;
                const int p0 = __hip_atomic_fetch_add(lcnt + ex0, 1, __ATOMIC_RELAXED, __HIP_MEMORY_SCOPE_WORKGROUP), p1 = __hip_atomic_fetch_add(lcnt + ex1, 1, __ATOMIC_RELAXED, __HIP_MEMORY_SCOPE_WORKGROUP);
                rte[ai] = ex0; rtp[ai] = p0; rtt[ai] = tok; rtg[ai] = g0;
                rte[ai + 1] = ex1; rtp[ai + 1] = p1; rtt[ai + 1] = tok; rtg[ai + 1] = g1;
            }
            {
                const float r = rrow[fr];
                bf16_t* op = out + (size_t)row * D + 128 * wid + 8 * kq;
#pragma unroll
                for (int ks = 0; ks < 4; ++ks) {
                    const float* cp = shift + (size_t)b * 6144 + 128 * wid + 32 * ks + 8 * kq;
                    const f32x4 c0 = *(const f32x4*)cp, c1 = *(const f32x4*)(cp + 4);
                    u32x4 w; w.x = cvt_pk_bf16(t[ks][0] * r + c0[0], t[ks][1] * r + c0[1]); w.y = cvt_pk_bf16(t[ks][2] * r + c0[2], t[ks][3] * r + c0[3]);
                    w.z = cvt_pk_bf16(t[ks][4] * r + c1[0], t[ks][5] * r + c1[1]); w.w = cvt_pk_bf16(t[ks][6] * r + c1[2], t[ks][7] * r + c1[3]);
                    *(u32x4*)(op + 32 * ks) = w;
                }
            }
            __syncthreads();
        }
        if (tid < 32) { const int c = lcnt[tid]; lbase[tid] = c ? atomicAdd(&counts[tid * 64], c) : 0; }
        __syncthreads();
        if (tid < 128) { const int e = rte[tid], pos = lbase[e] + rtp[tid], tk = rtt[tid];
            list[(size_t)e * NTOK + pos] = tk; lgate[(size_t)e * NTOK + pos] = rtg[tid];
            tokinfo[tk * 4 + (tid & 1) * 2] = e; tokinfo[tk * 4 + (tid & 1) * 2 + 1] = pos; }
        __syncthreads();
    }
}

__device__ __forceinline__ void moe_cum(const Args& a, int l, LAS unsigned char* lds) {
    KArgs* ka = kargs();
    LAS int* cum = (LAS int*)(lds + LDS_MISC + MISC_CUM); LAS int* cn = (LAS int*)(lds + LDS_MISC + MISC_CNT);
    const int* counts = (const int*)(ka->ws + WS_CNT) + l * NE * 64;
    const int tq = opaque_tid();
    if (tq < 33) { int s = 0; for (int j = 0; j < tq; ++j) s += (ld_agent(counts + j * 64) + 255) >> 8; cum[tq] = s; if (tq < 32) cn[tq] = ld_agent(counts + tq * 64); }
    __syncthreads();
}

__device__ __forceinline__ void phase_combine(const Args& a, int l, LAS unsigned char* lds, int vcu, int G) {
    KArgs* ka = kargs();
    const int tid = opaque_tid(), wid = __builtin_amdgcn_readfirstlane(tid >> 6), lane = tid & 63;
    unsigned char* ws = ka->ws;
    moe_cum(a, l, lds);
    const LAS int* cum = (const LAS int*)(lds + LDS_MISC + MISC_CUM);
    const bf16_t* __restrict__ x1 = (const bf16_t*)(ws + WS_X1);
    bf16_t* __restrict__ xnext = (bf16_t*)(ws + WS_X1) + (size_t)NTOK * D;
    const float* mod = (const float*)(ws + WS_MOD) + (size_t)l * 4 * 6144;
    const float* gate2 = mod + 5120;
    const bf16_t* __restrict__ Y = (const bf16_t*)(ws + WS_Y);
    const int* __restrict__ tokinfo = (const int*)(ws + WS_TOKINFO);
    float* __restrict__ outp = ka->out;
    const bool nextl = (l + 1 < L);
    const float* modn = (const float*)(ws + WS_MOD) + (size_t)(nextl ? l + 1 : l) * 4 * 6144;
    const float* gn = IN_F(I_NORM1) + (nextl ? l + 1 : l) * D;
    bf16_t* __restrict__ hout = (bf16_t*)(ws + WS_HA);
    for (int rb = vcu * 8 + wid; rb < NTOK / 8; rb += G * 8) {
        const int row0 = rb * 8, b = row0 / S;
        float4 A[4], C[4], G2[4];
#pragma unroll
        for (int i = 0; i < 4; ++i) { const int k = 256 * i + 4 * lane; const float4 gv = *(const float4*)(gn + k), sc = *(const float4*)(modn + 1024 + (size_t)b * 6144 + k); C[i] = *(const float4*)(modn + (size_t)b * 6144 + k);
            A[i] = make_float4(gv.x * (1.f + sc.x), gv.y * (1.f + sc.y), gv.z * (1.f + sc.z), gv.w * (1.f + sc.w)); G2[i] = *(const float4*)(gate2 + (size_t)b * 6144 + k); }
#pragma unroll 4
        for (int rr = 0; rr < 8; ++rr) {
            const int tok = row0 + rr; const size_t ro = (size_t)tok * D;
            const int4 ti = *(const int4*)(tokinfo + tok * 4);
            const size_t s0 = (size_t)(cum[ti.x] * 256 + ti.y) * D, s1 = (size_t)(cum[ti.z] * 256 + ti.w) * D;
            float4 xo[4]; float ss = 0.f;
#pragma unroll
            for (int i = 0; i < 4; ++i) { const int k = 256 * i + 4 * lane; const u32x2 xw = *(const u32x2*)(x1 + ro + k); const float4 xv = make_float4(bflo(xw.x), bfhi(xw.x), bflo(xw.y), bfhi(xw.y)); const u32x2 y0 = *(const u32x2*)(Y + s0 + k), y1 = *(const u32x2*)(Y + s1 + k);
                xo[i].x = xv.x + G2[i].x * (bflo(y0.x) + bflo(y1.x)); xo[i].y = xv.y + G2[i].y * (bfhi(y0.x) + bfhi(y1.x)); xo[i].z = xv.z + G2[i].z * (bflo(y0.y) + bflo(y1.y)); xo[i].w = xv.w + G2[i].w * (bfhi(y0.y) + bfhi(y1.y));
                if (nextl) { u32x2 xb; xb.x = cvt_pk_bf16(xo[i].x, xo[i].y); xb.y = cvt_pk_bf16(xo[i].z, xo[i].w); *(u32x2*)(xnext + ro + k) = xb; } else *(float4*)(outp + ro + k) = xo[i];
                ss += xo[i].x * xo[i].x + xo[i].y * xo[i].y + xo[i].z * xo[i].z + xo[i].w * xo[i].w; }
            if (nextl) {
                const float r = rsqrtf(wave_sum(ss) * (1.0f / D) + EPS);
#pragma unroll
                for (int i = 0; i < 4; ++i) { u32x2 w; w.x = cvt_pk_bf16(xo[i].x * r * A[i].x + C[i].x, xo[i].y * r * A[i].y + C[i].y); w.y = cvt_pk_bf16(xo[i].z * r * A[i].z + C[i].z, xo[i].w * r * A[i].w + C[i].w);
                    *(u32x2*)(hout + ro + 256 * i + 4 * lane) = w; }
            }
        }
    }
}
constexpr size_t WS_KN = WS_R2;
constexpr size_t WS_VT = WS_KN + al256c((size_t)NTOK * 256 * 2);
constexpr size_t WS_IKR = WS_VT + al256c((size_t)NTOK * 256 * 2);
constexpr size_t WS_MASK = WS_IKR + al256c((size_t)NTOK * 32 * 2);
constexpr size_t WS_OA = WS_MASK + al256c((size_t)NTOK * 128 * 4);
constexpr size_t WS_R3 = WS_OA + al256c((size_t)NTOK * 256 * 2);
constexpr size_t WS_MIXB = (WS_R3 > WS_Y + (size_t)SLOTS * D * 2 ? WS_R3 : WS_Y + al256c((size_t)SLOTS * D * 2));

__device__ __forceinline__ f32x4 mfma16(const bf16x8 a, const bf16x8 b, const f32x4 c) { return __builtin_amdgcn_mfma_f32_16x16x32_bf16(a, b, c, 0, 0, 0); }
__device__ __forceinline__ bf16_t f2bf(float f) { return (bf16_t)(cvt_pk_bf16(f, 0.f) & 0xffffu); }

__device__ __forceinline__ void rows_rms_store(const LAS float* YB, const float* gain, bf16_t* mixb, int tok0, int col0, int wid, int lane) {
    const f32x4 gv = *(const f32x4*)(gain + 4 * lane);
#pragma unroll 2
    for (int rr = 0; rr < 8; ++rr) {
        const int t = 8 * wid + rr;
        const f32x4 y = *(const LAS f32x4*)(YB + t * 260 + 4 * lane);
        const float ss = wave_sum(y[0] * y[0] + y[1] * y[1] + y[2] * y[2] + y[3] * y[3]);
        const float r = rsqrtf(ss * (1.0f / 256.0f) + EPS);
        u32x2 w; w.x = cvt_pk_bf16(y[0] * r * gv[0], y[1] * r * gv[1]); w.y = cvt_pk_bf16(y[2] * r * gv[2], y[3] * r * gv[3]);
        *(u32x2*)(mixb + (size_t)(tok0 + t) * D + col0 + 4 * lane) = w;
    }
}

__device__ __forceinline__ void item_pool(const Args& a, int l, int tile, LAS unsigned char* lds) {
    KArgs* ka = kargs();
    const int tid = opaque_tid(), wid = __builtin_amdgcn_readfirstlane(tid >> 6), lane = tid & 63;
    unsigned char* ws = ka->ws;
    const bf16_t* proj = (const bf16_t*)(ws + WS_PROJ);
    LAS bf16_t* P = (LAS bf16_t*)lds;
    LAS bf16_t* PA = (LAS bf16_t*)(lds + 40960);
    LAS float* YB = (LAS float*)(lds + 40960 + 33792);
    const int tok0 = tile * 64, b = tok0 / S, t0 = tok0 % S;
#pragma unroll
    for (int p = tid; p < 79 * 32; p += NTHR) {
        const int r = p >> 5, c8 = p & 31, t = t0 - 15 + r;
        u32x4 v = (u32x4){0u, 0u, 0u, 0u};
        if (t >= 0) v = *(const u32x4*)(proj + (size_t)(b * S + t) * NP + NC + c8 * 8);
        *(LAS u32x4*)(P + r * 256 + c8 * 8) = v;
    }
    __syncthreads();
    {
        const int c = tid & 255, half = tid >> 8, g = c >> 6, w = 2 << g, tt0 = half * 32;
        float run = 0.f;
        for (int jj = 1; jj < w; ++jj) run += bf2f(P[(15 + tt0 - jj) * 256 + c]);
        for (int i = 0; i < 32; ++i) {
            const int tt = tt0 + i, r = 15 + tt;
            const float pv = bf2f(P[r * 256 + c]);
            run += pv;
            const int tabs = t0 + tt, nn = (tabs + 1 < w) ? (tabs + 1) : w;
            PA[tt * 264 + c] = f2bf(run / (float)nn - pv);
            run -= bf2f(P[(r - w + 1) * 256 + c]);
        }
    }
    __syncthreads();
    {
        const int g = wid >> 1, mh = wid & 1, fr = lane & 15, fq = lane >> 4;
        const bf16_t* PT = (const bf16_t*)(ws + WS_POOLT) + (size_t)(l * 4 + g) * 64 * 64;
        f32x4 acc[2][4];
#pragma unroll
        for (int mi = 0; mi < 2; ++mi)
#pragma unroll
            for (int ni = 0; ni < 4; ++ni) acc[mi][ni] = (f32x4){0.f, 0.f, 0.f, 0.f};
#pragma unroll
        for (int ks = 0; ks < 2; ++ks) {
            bf16x8 A[2];
#pragma unroll
            for (int mi = 0; mi < 2; ++mi) A[mi] = *(const LAS bf16x8*)(PA + (16 * (2 * mh + mi) + fr) * 264 + g * 64 + 32 * ks + 8 * fq);
#pragma unroll
            for (int ni = 0; ni < 4; ++ni) { const bf16x8 Bf = *(const bf16x8*)(PT + (16 * ni + fr) * 64 + 32 * ks + 8 * fq);
#pragma unroll
                for (int mi = 0; mi < 2; ++mi) acc[mi][ni] = mfma16(A[mi], Bf, acc[mi][ni]); }
        }
        const float* pb = IN_F(I_POOLB) + l * 256; const float* ps = IN_F(I_POOLS) + l * 256;
#pragma unroll
        for (int ni = 0; ni < 4; ++ni) { const int d = g * 64 + 16 * ni + fr; const float bb = pb[d], sc = ps[d];
#pragma unroll
            for (int mi = 0; mi < 2; ++mi)
#pragma unroll
                for (int r = 0; r < 4; ++r) YB[(16 * (2 * mh + mi) + 4 * fq + r) * 260 + d] = (acc[mi][ni][r] + bb) * sc; }
    }
    __syncthreads();
    rows_rms_store(YB, IN_F(I_ONORM) + l * D + 512, (bf16_t*)(ws + WS_MIXB), tok0, 512, wid, lane);
    __syncthreads();
}

__device__ __forceinline__ void item_conv(const Args& a, int l, int tile, LAS unsigned char* lds) {
    KArgs* ka = kargs();
    const int tid = opaque_tid(), wid = __builtin_amdgcn_readfirstlane(tid >> 6), lane = tid & 63;
    unsigned char* ws = ka->ws;
    const bf16_t* proj = (const bf16_t*)(ws + WS_PROJ);
    LAS float* GL = (LAS float*)lds;
    LAS bf16_t* CA = (LAS bf16_t*)(lds + 96256);
    LAS float* YB = (LAS float*)lds;
    const int tok0 = tile * 64, b = tok0 / S, t0 = tok0 % S;
#pragma unroll
    for (int p = tid; p < 94 * 32; p += NTHR) {
        const int r = p >> 5, c8 = p & 31, t = t0 - 30 + r;
        f32x4 o0 = (f32x4){0.f, 0.f, 0.f, 0.f}, o1 = o0;
        if (t >= 0) {
            const bf16_t* pr = proj + (size_t)(b * S + t) * NP;
            const u32x4 av = *(const u32x4*)(pr + NBA + c8 * 8), gv = *(const u32x4*)(pr + NBG + c8 * 8);
            o0[0] = bflo(av.x) * sigmoid_fast(bflo(gv.x)); o0[1] = bfhi(av.x) * sigmoid_fast(bfhi(gv.x)); o0[2] = bflo(av.y) * sigmoid_fast(bflo(gv.y)); o0[3] = bfhi(av.y) * sigmoid_fast(bfhi(gv.y));
            o1[0] = bflo(av.z) * sigmoid_fast(bflo(gv.z)); o1[1] = bfhi(av.z) * sigmoid_fast(bfhi(gv.z)); o1[2] = bflo(av.w) * sigmoid_fast(bflo(gv.w)); o1[3] = bfhi(av.w) * sigmoid_fast(bfhi(gv.w));
        }
        *(LAS f32x4*)(GL + r * 256 + c8 * 8) = o0; *(LAS f32x4*)(GL + r * 256 + c8 * 8 + 4) = o1;
    }
    __syncthreads();
    {
        const int c = tid & 255, half = tid >> 8;
        float wv[31];
#pragma unroll
        for (int jj = 0; jj < 31; ++jj) wv[jj] = IN_F(I_CONVW)[((size_t)l * 31 + jj) * 256 + c];
        const float cb = IN_F(I_CONVB)[l * 256 + c];
        float yv[32];
#pragma unroll
        for (int ch = 0; ch < 8; ++ch) {
            const int tt = half * 32 + ch * 4;
            float x[34];
#pragma unroll
            for (int m2 = 0; m2 < 34; ++m2) x[m2] = GL[(tt + m2) * 256 + c];
#pragma unroll
            for (int i = 0; i < 4; ++i) {
                float y = cb;
#pragma unroll
                for (int jj = 0; jj < 31; ++jj) y += x[i + jj] * wv[jj];
                yv[ch * 4 + i] = y;
            }
        }
        __syncthreads();
#pragma unroll
        for (int i = 0; i < 32; ++i) YB[(half * 32 + i) * 260 + c] = yv[i];
    }
    __syncthreads();
    {
        const int t = tid >> 3, part = tid & 7;
        float y[32]; float s1 = 0.f;
#pragma unroll
        for (int i = 0; i < 8; ++i) { const f32x4 v = *(const LAS f32x4*)(YB + t * 260 + part * 32 + 4 * i); y[4 * i] = v[0]; y[4 * i + 1] = v[1]; y[4 * i + 2] = v[2]; y[4 * i + 3] = v[3]; s1 += (v[0] + v[1]) + (v[2] + v[3]); }
        s1 += dpp_f<0xB1>(s1);
        const float mu = s1 * (1.0f / 64.0f);
        float s2 = 0.f;
#pragma unroll
        for (int i = 0; i < 32; ++i) { y[i] -= mu; s2 += y[i] * y[i]; }
        s2 += dpp_f<0xB1>(s2);
        const float rs = rsqrtf(s2 * (1.0f / 64.0f) + EPS);
        const float* lng = IN_F(I_CLNG) + l * 256 + part * 32; const float* lnb = IN_F(I_CLNB) + l * 256 + part * 32;
#pragma unroll
        for (int i = 0; i < 4; ++i) {
            float o[8];
#pragma unroll
            for (int e = 0; e < 8; ++e) o[e] = silu_f(y[8 * i + e] * rs * lng[8 * i + e] + lnb[8 * i + e]);
            u32x4 w; w.x = cvt_pk_bf16(o[0], o[1]); w.y = cvt_pk_bf16(o[2], o[3]); w.z = cvt_pk_bf16(o[4], o[5]); w.w = cvt_pk_bf16(o[6], o[7]);
            *(LAS u32x4*)(CA + t * 264 + part * 32 + 8 * i) = w;
        }
    }
    __syncthreads();
    {
        const int fr = lane & 15, fq = lane >> 4;
        const bf16_t* PW = (const bf16_t*)(ws + WS_PWT) + (size_t)l * 65536;
        f32x4 acc[4][2];
#pragma unroll
        for (int mi = 0; mi < 4; ++mi)
#pragma unroll
            for (int ni = 0; ni < 2; ++ni) acc[mi][ni] = (f32x4){0.f, 0.f, 0.f, 0.f};
#pragma unroll 2
        for (int ks = 0; ks < 8; ++ks) {
            bf16x8 Bf[2];
#pragma unroll
            for (int ni = 0; ni < 2; ++ni) Bf[ni] = *(const bf16x8*)(PW + (size_t)(32 * wid + 16 * ni + fr) * 256 + 32 * ks + 8 * fq);
#pragma unroll
            for (int mi = 0; mi < 4; ++mi) { const bf16x8 Af = *(const LAS bf16x8*)(CA + (16 * mi + fr) * 264 + 32 * ks + 8 * fq);
#pragma unroll
                for (int ni = 0; ni < 2; ++ni) acc[mi][ni] = mfma16(Af, Bf[ni], acc[mi][ni]); }
        }
        const float* pwb = IN_F(I_PWB) + l * 256;
#pragma unroll
        for (int ni = 0; ni < 2; ++ni) { const int n = 32 * wid + 16 * ni + fr; const float bb = pwb[n];
#pragma unroll
            for (int mi = 0; mi < 4; ++mi)
#pragma unroll
                for (int r = 0; r < 4; ++r) YB[(16 * mi + 4 * fq + r) * 260 + n] = acc[mi][ni][r] + bb; }
    }
    __syncthreads();
    rows_rms_store(YB, IN_F(I_ONORM) + l * D + 256, (bf16_t*)(ws + WS_MIXB), tok0, 256, wid, lane);
    __syncthreads();
}

__device__ __forceinline__ void item_sgu(const Args& a, int l, int ch, LAS unsigned char* lds) {
    KArgs* ka = kargs();
    const int tid = opaque_tid(), wid = __builtin_amdgcn_readfirstlane(tid >> 6), lane = tid & 63;
    unsigned char* ws = ka->ws;
    const bf16_t* proj = (const bf16_t*)(ws + WS_PROJ);
    LAS bf16_t* VS = (LAS bf16_t*)lds;
    LAS bf16_t* OB = (LAS bf16_t*)(lds + 69632);
    const int tok0 = ch * 128;
    {
        const f32x4 lg = *(const f32x4*)(IN_F(I_SLNG) + l * 256 + 4 * lane), lb = *(const f32x4*)(IN_F(I_SLNB) + l * 256 + 4 * lane);
#pragma unroll 8
        for (int i = 0; i < 16; ++i) {
            const int s = 16 * wid + i;
            const u32x2 vv = *(const u32x2*)(proj + (size_t)(tok0 + s) * NP + NDV + 4 * lane);
            const float v0 = bflo(vv.x), v1 = bfhi(vv.x), v2 = bflo(vv.y), v3 = bfhi(vv.y);
            const float mu = wave_sum((v0 + v1) + (v2 + v3)) * (1.0f / 256.0f);
            const float d0 = v0 - mu, d1 = v1 - mu, d2 = v2 - mu, d3 = v3 - mu;
            const float rs = rsqrtf(wave_sum((d0 * d0 + d1 * d1) + (d2 * d2 + d3 * d3)) * (1.0f / 256.0f) + EPS);
            u32x2 w; w.x = cvt_pk_bf16(d0 * rs * lg[0] + lb[0], d1 * rs * lg[1] + lb[1]); w.y = cvt_pk_bf16(d2 * rs * lg[2] + lb[2], d3 * rs * lg[3] + lb[3]);
            *(LAS u32x2*)(VS + s * 260 + 4 * lane) = w;
        }
    }
    __syncthreads();
    {
        const int h = wid >> 1, np = wid & 1, fr = lane & 15, fq = lane >> 4;
        const bf16_t* W = (const bf16_t*)(ws + WS_SGUW) + (size_t)(l * 4 + h) * 128 * 128;
        const float* sb = IN_F(I_SGUB) + (l * 4 + h) * 128;
        bf16x8 Bf[4][2];
#pragma unroll
        for (int ks = 0; ks < 4; ++ks)
#pragma unroll
            for (int ni = 0; ni < 2; ++ni) {
                unsigned short e[8];
#pragma unroll
                for (int jj = 0; jj < 8; ++jj) e[jj] = VS[(32 * ks + 8 * fq + jj) * 260 + h * 64 + 32 * np + 16 * ni + fr];
                u32x4 w; w.x = e[0] | ((unsigned)e[1] << 16); w.y = e[2] | ((unsigned)e[3] << 16); w.z = e[4] | ((unsigned)e[5] << 16); w.w = e[6] | ((unsigned)e[7] << 16);
                Bf[ks][ni] = __builtin_bit_cast(bf16x8, w);
            }
#pragma unroll
        for (int mi = 0; mi < 8; ++mi) {
            f32x4 acc[2] = {(f32x4){0.f, 0.f, 0.f, 0.f}, (f32x4){0.f, 0.f, 0.f, 0.f}};
#pragma unroll
            for (int ks = 0; ks <= (mi >> 1); ++ks) {
                const bf16x8 Af = *(const bf16x8*)(W + (size_t)(16 * mi + fr) * 128 + 32 * ks + 8 * fq);
#pragma unroll
                for (int ni = 0; ni < 2; ++ni) acc[ni] = mfma16(Af, Bf[ks][ni], acc[ni]);
            }
#pragma unroll
            for (int ni = 0; ni < 2; ++ni)
#pragma unroll
                for (int r = 0; r < 4; ++r) { const int t = 16 * mi + 4 * fq + r; OB[t * 264 + h * 64 + 32 * np + 16 * ni + fr] = f2bf(acc[ni][r] + sb[t]); }
        }
    }
    __syncthreads();
    {
        const f32x4 gv = *(const f32x4*)(IN_F(I_ONORM) + l * D + 768 + 4 * lane);
        bf16_t* mixb = (bf16_t*)(ws + WS_MIXB);
#pragma unroll 8
        for (int i = 0; i < 16; ++i) {
            const int t = 16 * wid + i;
            const u32x2 mv = *(const LAS u32x2*)(OB + t * 264 + 4 * lane);
            const u32x2 uv = *(const u32x2*)(proj + (size_t)(tok0 + t) * NP + NDU + 4 * lane);
            const float o0 = bflo(uv.x) * bflo(mv.x), o1 = bfhi(uv.x) * bfhi(mv.x), o2 = bflo(uv.y) * bflo(mv.y), o3 = bfhi(uv.y) * bfhi(mv.y);
            const float r = rsqrtf(wave_sum((o0 * o0 + o1 * o1) + (o2 * o2 + o3 * o3)) * (1.0f / 256.0f) + EPS);
            u32x2 w; w.x = cvt_pk_bf16(o0 * r * gv[0], o1 * r * gv[1]); w.y = cvt_pk_bf16(o2 * r * gv[2], o3 * r * gv[3]);
            *(u32x2*)(mixb + (size_t)(tok0 + t) * D + 768 + 4 * lane) = w;
        }
    }
    __syncthreads();
}

__device__ __forceinline__ void item_prepk(const Args& a, int l, int tile, LAS unsigned char* lds) {
    KArgs* ka = kargs();
    const int tid = opaque_tid(), wid = __builtin_amdgcn_readfirstlane(tid >> 6), lane = tid & 63;
    unsigned char* ws = ka->ws;
    const bf16_t* proj = (const bf16_t*)(ws + WS_PROJ);
    LAS bf16_t* VS = (LAS bf16_t*)lds;
    bf16_t* KN = (bf16_t*)(ws + WS_KN); bf16_t* VTg = (bf16_t*)(ws + WS_VT); bf16_t* IKR = (bf16_t*)(ws + WS_IKR);
    const float* ropeA = (const float*)(ws + WS_ROPEA); const float* ropeI = (const float*)(ws + WS_ROPEI);
    const int tok0 = tile * 64, b = tok0 / S, s0 = tok0 % S;
    const int li = lane & 15, head = lane >> 4;
    const f32x4 kg = *(const f32x4*)(IN_F(I_KN) + l * 64 + 4 * li);
#pragma unroll 4
    for (int i = 0; i < 8; ++i) {
        const int tl = 8 * wid + i, tok = tok0 + tl, s = s0 + tl;
        const bf16_t* pr = proj + (size_t)tok * NP;
        const u32x2 kv = *(const u32x2*)(pr + NK + 4 * lane);
        float k0 = bflo(kv.x), k1 = bfhi(kv.x), k2 = bflo(kv.y), k3 = bfhi(kv.y);
        float ss = (k0 * k0 + k1 * k1) + (k2 * k2 + k3 * k3);
        ss = row_sum16(ss);
        const float r = rsqrtf(ss * (1.0f / 64.0f) + EPS);
        k0 *= r * kg[0]; k1 *= r * kg[1]; k2 *= r * kg[2]; k3 *= r * kg[3];
        {
            const float p0 = __shfl_xor(k0, 2), p1 = __shfl_xor(k1, 2), p2 = __shfl_xor(k2, 2), p3 = __shfl_xor(k3, 2);
            if (li < 4) {
                const int dd = 4 * (li & 1);
                const f32x4 cs = *(const f32x4*)(ropeA + (size_t)tok * 16 + dd), sn = *(const f32x4*)(ropeA + (size_t)tok * 16 + 8 + dd);
                if (li < 2) { k0 = k0 * cs[0] - p0 * sn[0]; k1 = k1 * cs[1] - p1 * sn[1]; k2 = k2 * cs[2] - p2 * sn[2]; k3 = k3 * cs[3] - p3 * sn[3]; }
                else        { k0 = k0 * cs[0] + p0 * sn[0]; k1 = k1 * cs[1] + p1 * sn[1]; k2 = k2 * cs[2] + p2 * sn[2]; k3 = k3 * cs[3] + p3 * sn[3]; }
            }
        }
        u32x2 ko; ko.x = cvt_pk_bf16(k0, k1); ko.y = cvt_pk_bf16(k2, k3);
        *(u32x2*)(KN + ((size_t)((b * 4 + head) * 128 + (s >> 5)) * 32 + (s & 31)) * 64 + 4 * li) = ko;
        *(LAS u32x2*)(VS + tl * 264 + 4 * lane) = *(const u32x2*)(pr + NV + 4 * lane);
        if (lane < 8) {
            const u32x2 iv = *(const u32x2*)(pr + NIK + 4 * lane);
            float x0 = bflo(iv.x), x1 = bfhi(iv.x), x2 = bflo(iv.y), x3 = bfhi(iv.y);
            const float q0 = __shfl_xor(x0, 1), q1 = __shfl_xor(x1, 1), q2 = __shfl_xor(x2, 1), q3 = __shfl_xor(x3, 1);
            if (lane < 2) {
                const f32x4 cs = *(const f32x4*)(ropeI + (size_t)tok * 8), sn = *(const f32x4*)(ropeI + (size_t)tok * 8 + 4);
                if (lane == 0) { x0 = x0 * cs[0] - q0 * sn[0]; x1 = x1 * cs[1] - q1 * sn[1]; x2 = x2 * cs[2] - q2 * sn[2]; x3 = x3 * cs[3] - q3 * sn[3]; }
                else           { x0 = x0 * cs[0] + q0 * sn[0]; x1 = x1 * cs[1] + q1 * sn[1]; x2 = x2 * cs[2] + q2 * sn[2]; x3 = x3 * cs[3] + q3 * sn[3]; }
            }
            u32x2 io; io.x = cvt_pk_bf16(x0, x1); io.y = cvt_pk_bf16(x2, x3);
            *(u32x2*)(IKR + (size_t)tok * 32 + 4 * lane) = io;
        }
    }
    __syncthreads();
#pragma unroll
    for (int i = 0; i < 4; ++i) {
        const int p = tid + NTHR * i;
        const int h = p >> 9, ktl = (p >> 8) & 1, d = (p >> 2) & 63, part = p & 3;
        unsigned short e[8];
#pragma unroll
        for (int jj = 0; jj < 8; ++jj) { const int key = 4 * part + (jj & 3) + 16 * (jj >> 2); e[jj] = VS[(ktl * 32 + key) * 264 + h * 64 + d]; }
        u32x4 w; w.x = e[0] | ((unsigned)e[1] << 16); w.y = e[2] | ((unsigned)e[3] << 16); w.z = e[4] | ((unsigned)e[5] << 16); w.w = e[6] | ((unsigned)e[7] << 16);
        *(u32x4*)(VTg + ((size_t)((b * 4 + h) * 128 + (s0 >> 5) + ktl) * 64 + d) * 32 + 8 * part) = w;
    }
    __syncthreads();
}

__device__ __forceinline__ void phase_mix1(const Args& a, int l, LAS unsigned char* lds, int vcu, int G, int bx) {
    if (G == 256) {
        if (bx < 64) { item_conv(a, l, bx, lds); item_pool(a, l, bx, lds); }
        else {
            const int w = bx - 64;
            if (w < 128) item_sgu(a, l, w, lds);
            item_prepk(a, l, w, lds);
            item_conv(a, l, 64 + w, lds);
            if (w >= 128) item_prepk(a, l, 192 + (w - 128), lds);
            item_pool(a, l, 64 + w, lds);
        }
        return;
    }
    for (int it = vcu; it < 896; it += G) {
        if (it < 128) item_sgu(a, l, it, lds);
        else if (it < 384) item_conv(a, l, it - 128, lds);
        else if (it < 640) item_pool(a, l, it - 384, lds);
        else item_prepk(a, l, it - 640, lds);
    }
}
__device__ __forceinline__ f32x16 mfma32(const bf16x8 a, const bf16x8 b, const f32x16 c) { return __builtin_amdgcn_mfma_f32_32x32x16_bf16(a, b, c, 0, 0, 0); }
typedef float f32x2 __attribute__((ext_vector_type(2)));

__device__ __forceinline__ void a1_scores(const bf16x8 A0, const bf16x8 A1, const bf16x8 (&Bq)[4][2], const float (&cl)[4], f32x2 (&sc)[8]) {
    f32x16 d[4];
#pragma unroll
    for (int h = 0; h < 4; ++h) {
#pragma unroll
        for (int r = 0; r < 16; ++r) d[h][r] = 0.f;
        d[h] = mfma32(A0, Bq[h][0], d[h]); d[h] = mfma32(A1, Bq[h][1], d[h]);
    }
#pragma unroll
    for (int p = 0; p < 8; ++p) {
        f32x2 m[4];
#pragma unroll
        for (int h = 0; h < 4; ++h) { m[h][0] = __builtin_amdgcn_fmed3f(d[h][2 * p], 0.0f, cl[h]); m[h][1] = __builtin_amdgcn_fmed3f(d[h][2 * p + 1], 0.0f, cl[h]); }
        sc[p] = (m[0] + m[1]) + (m[2] + m[3]);
    }
}

#define A1_PRELOAD(rA) { const int ntw_ = (nkt - wid + 7) >> 3; \
    _Pragma("unroll") for (int u_ = 0; u_ < 4; ++u_) { rA[u_][0] = Bq[0][0]; rA[u_][1] = Bq[0][0]; if (u_ < ntw_) { const size_t o_ = (size_t)(wid + 8 * u_) * 1024; rA[u_][0] = *(const bf16x8*)(ikl + o_); rA[u_][1] = *(const bf16x8*)(ikl + o_ + 16); } } }
#define A1_STREAM_BEGIN(rA) { const int ntw_ = (nkt - wid + 7) >> 3; \
    for (int i_ = 0; i_ < ntw_; i_ += 4) { \
        _Pragma("unroll") for (int u_ = 0; u_ < 4; ++u_) { if (i_ + u_ < ntw_) { \
            const bf16x8 cA0 = rA[u_][0], cA1 = rA[u_][1]; const int kt = wid + 8 * (i_ + u_); \
            if (i_ + u_ + 4 < ntw_) { const size_t o_ = (size_t)(kt + 32) * 1024; rA[u_][0] = *(const bf16x8*)(ikl + o_); rA[u_][1] = *(const bf16x8*)(ikl + o_ + 16); }
#define A1_STREAM_END } } } }

template <int KIND>
__device__ __forceinline__ void a1_pass(const bf16_t* ikl, int nkt, int wid, const bf16x8 (&Bq)[4][2], const float (&cl)[4], LAS unsigned char* histb, unsigned q4, unsigned cadd, bf16x8 (&rA)[4][2]) {
    A1_STREAM_BEGIN(rA)
        f32x2 sc[8];
        a1_scores(cA0, cA1, Bq, cl, sc);
#pragma unroll
        for (int r = 0; r < 16; ++r) {
            const unsigned u = __float_as_uint(sc[r >> 1][r & 1]);
            unsigned addr;
            if (KIND == 0) addr = (((u + 0x8000u) >> 17) & 0x7f80u) | q4;
            else { unsigned dg = (u + cadd) >> 16; dg = dg < 256u ? dg : 256u; addr = (dg << 7) + q4; }
            __hip_atomic_fetch_add((LAS unsigned*)(histb + addr), 1u, __ATOMIC_RELAXED, __HIP_MEMORY_SCOPE_WORKGROUP);
        }
    A1_STREAM_END
}

template <int LEVEL>
__device__ __forceinline__ void a1_scan(LAS unsigned* hist, LAS unsigned* psum, LAS unsigned* qst, int tid) {
    const int sq = tid & 31, part = tid >> 5;
    const unsigned need = qst[32 + sq], p1 = qst[sq];
    const bool neg = (p1 & 0x80u) != 0u;
#define A1_RAWROW(bn) (LEVEL == 0 ? ((bn) >= 128 ? (bn) - 128 : 255 - (bn)) : (neg ? 255 - (bn) : (bn)))
    unsigned cv[16]; unsigned local = 0u;
#pragma unroll
    for (int bb = 0; bb < 16; ++bb) { cv[bb] = hist[A1_RAWROW(16 * part + bb) * 32 + sq]; local += cv[bb]; }
    psum[part * 32 + sq] = local;
    __syncthreads();
    unsigned above = 0u;
#pragma unroll
    for (int pp = 1; pp < 16; ++pp) above += (part + pp < 16) ? psum[(part + pp) * 32 + sq] : 0u;
    if (above < need && above + local >= need) {
        unsigned run = above, fb = 0u, fr = 0u, fc = 0u; bool found = false;
#pragma unroll
        for (int bb = 15; bb >= 0; --bb) {
            const bool hit = !found && (run + cv[bb] >= need);
            fb = hit ? (unsigned)bb : fb; fr = hit ? run : fr; fc = hit ? cv[bb] : fc; found = found || hit;
            run += cv[bb];
        }
        const unsigned raw = (unsigned)A1_RAWROW(16 * part + (int)fb);
        if (LEVEL == 0) { qst[sq] = raw; qst[32 + sq] = need - fr; }
        else { qst[sq] = (p1 << 8) | raw; qst[32 + sq] = need - fr; qst[64 + sq] = fc; }
    }
#undef A1_RAWROW
}

__device__ __forceinline__ void a1_cmp2(unsigned& gt, unsigned& ge, float s0, float s1, float tg, float te) {
#ifdef A1_NOASM
    gt = (gt << 1) | (s0 >= tg ? 1u : 0u); ge = (ge << 1) | (s0 >= te ? 1u : 0u);
    gt = (gt << 1) | (s1 >= tg ? 1u : 0u); ge = (ge << 1) | (s1 >= te ? 1u : 0u);
#else
    unsigned long long m1, m2, m3;
    asm("v_cmp_ge_f32 vcc, %[s0], %[tg]\n\t"
        "v_cmp_ge_f32 %[m1], %[s0], %[te]\n\t"
        "v_cmp_ge_f32 %[m2], %[s1], %[tg]\n\t"
        "v_cmp_ge_f32 %[m3], %[s1], %[te]\n\t"
        "v_addc_co_u32 %[g], vcc, %[g], %[g], vcc\n\t"
        "v_addc_co_u32 %[e], %[m1], %[e], %[e], %[m1]\n\t"
        "v_addc_co_u32 %[g], %[m2], %[g], %[g], %[m2]\n\t"
        "v_addc_co_u32 %[e], %[m3], %[e], %[e], %[m3]"
        : [g] "+v"(gt), [e] "+v"(ge), [m1] "=&s"(m1), [m2] "=&s"(m2), [m3] "=&s"(m3)
        : [s0] "v"(s0), [s1] "v"(s1), [tg] "v"(tg), [te] "v"(te)
        : "vcc");
#endif
}
__device__ __forceinline__ unsigned a1_spread(unsigned x) { return (x & 0xfu) | ((x & 0xf0u) << 4) | ((x & 0xf00u) << 8) | ((x & 0xf000u) << 12); }

constexpr int A1_HISTA = 0, A1_HISTB = 257 * 32, A1_PSUM = 2 * 257 * 32, A1_QST = A1_PSUM + 16 * 32, A1_MBUF = A1_QST + 128, A1_TBUF = A1_MBUF + 32 * 128;
__device__ __forceinline__ void a1_tile(const Args& a, int l, int b, int j, LAS unsigned char* lds) {
    KArgs* ka = kargs();
    const int tid = opaque_tid(), wid = __builtin_amdgcn_readfirstlane(tid >> 6), lane = tid & 63, q = lane & 31, hh = lane >> 5;
    unsigned char* ws = ka->ws;
    const bf16_t* proj = (const bf16_t*)(ws + WS_PROJ);
    const bf16_t* ikr = (const bf16_t*)(ws + WS_IKR) + (size_t)b * S * 32;
    const bf16_t* ikl = ikr + (lane & 31) * 32 + 8 * (lane >> 5);
    unsigned* maskg = (unsigned*)(ws + WS_MASK);
    LAS unsigned* L = (LAS unsigned*)lds;
    LAS unsigned* psum = L + A1_PSUM; LAS unsigned* qst = L + A1_QST; LAS unsigned* mbuf = L + A1_MBUF; LAS unsigned* tbuf = L + A1_TBUF;
    const int t0 = j * 32, n = (t0 / 64 + 1) * 64, nkt = n / 32, nw = ((t0 / 128) + 1) * 4;
    if (n <= 256) {
        for (int i = tid; i < 32 * nw; i += NTHR) { const int qq = i / nw, w = i % nw; maskg[(size_t)(b * S + t0 + qq) * 128 + w] = (w < nkt) ? 0xffffffffu : 0u; }
        return;
    }
    bf16x8 Bq[4][2]; float cl[4];
    {
        const int tok = b * S + t0 + q;
        const bf16_t* pr = proj + (size_t)tok * NP;
        const f32x4 cs = *(const f32x4*)((const float*)(ws + WS_ROPEI) + (size_t)tok * 8), sn = *(const f32x4*)((const float*)(ws + WS_ROPEI) + (size_t)tok * 8 + 4);
#pragma unroll
        for (int h = 0; h < 4; ++h) {
            const float wsc = bf2f(pr[NIW + h]) * (0.5f * 0.17677669529663687f);
            cl[h] = (wsc > 0.f) ? INFINITY : -INFINITY;
#pragma unroll
            for (int ks = 0; ks < 2; ++ks) {
                const u32x4 raw = *(const u32x4*)(pr + NIQ + h * 32 + 16 * ks + 8 * hh);
                float v[8] = {bflo(raw.x), bfhi(raw.x), bflo(raw.y), bfhi(raw.y), bflo(raw.z), bfhi(raw.z), bflo(raw.w), bfhi(raw.w)};
                if (ks == 0 && hh == 0) {
#pragma unroll
                    for (int i = 0; i < 4; ++i) { const float x1 = v[i], x2 = v[i + 4]; v[i] = x1 * cs[i] - x2 * sn[i]; v[i + 4] = x2 * cs[i] + x1 * sn[i]; }
                }
                u32x4 pk; pk.x = cvt_pk_bf16(v[0] * wsc, v[1] * wsc); pk.y = cvt_pk_bf16(v[2] * wsc, v[3] * wsc); pk.z = cvt_pk_bf16(v[4] * wsc, v[5] * wsc); pk.w = cvt_pk_bf16(v[6] * wsc, v[7] * wsc);
                Bq[h][ks] = __builtin_bit_cast(bf16x8, pk);
            }
        }
    }
    bf16x8 rA[4][2];
    A1_PRELOAD(rA);
    { LAS u32x4* hz = (LAS u32x4*)(L + A1_HISTA); for (int i = tid; i < 2 * 257 * 32 / 4; i += NTHR) hz[i] = (u32x4){0u, 0u, 0u, 0u}; }
    if (tid < 32) { qst[tid] = 0u; qst[32 + tid] = 256u; qst[64 + tid] = 0u; }
    __syncthreads();
    const unsigned q4 = (unsigned)q * 4u;
    a1_pass<0>(ikl, nkt, wid, Bq, cl, (LAS unsigned char*)(L + A1_HISTA), q4, 0u, rA);
    A1_PRELOAD(rA);
    __syncthreads();
    a1_scan<0>(L + A1_HISTA, psum, qst, tid);
    __syncthreads();
    a1_pass<1>(ikl, nkt, wid, Bq, cl, (LAS unsigned char*)(L + A1_HISTB), q4, 0x8000u - (qst[q] << 24), rA);
    A1_PRELOAD(rA);
    __syncthreads();
    a1_scan<1>(L + A1_HISTB, psum, qst, tid);
    __syncthreads();
    {
        const unsigned T = qst[q], mag = T & 0x7fffu;
        unsigned bg, be;
        if ((T & 0x8000u) == 0u) { be = mag ? (mag << 16) - 0x8000u : 0u; bg = ((mag + 1u) << 16) - 0x8000u; }
        else { be = 0x80000000u | (((mag + 1u) << 16) - 0x8001u); bg = mag ? (0x80000000u | ((mag << 16) - 0x8001u)) : 0u; }
        const float tg = __uint_as_float(bg), te = __uint_as_float(be);
        A1_STREAM_BEGIN(rA)
            f32x2 sc[8];
            a1_scores(cA0, cA1, Bq, cl, sc);
            unsigned gt = 0u, ge = 0u;
#pragma unroll
            for (int p = 7; p >= 0; --p) a1_cmp2(gt, ge, sc[p][1], sc[p][0], tg, te);
            unsigned wb = a1_spread(gt & 0xffffu) << (4 * hh), eb = a1_spread(ge & 0xffffu) << (4 * hh);
            wb |= (unsigned)__shfl_xor((int)wb, 32); eb |= (unsigned)__shfl_xor((int)eb, 32);
            if (hh == 0) { mbuf[q * 128 + kt] = wb; tbuf[q * 128 + kt] = eb & ~wb; }
        A1_STREAM_END
    }
    __syncthreads();
    {
        const int qq = tid >> 4, part = tid & 15;
        const unsigned need = qst[32 + qq];
        const u32x4 ta = *(const LAS u32x4*)(tbuf + qq * 128 + part * 8), tb = *(const LAS u32x4*)(tbuf + qq * 128 + part * 8 + 4);
        const u32x4 ma = *(const LAS u32x4*)(mbuf + qq * 128 + part * 8), mb = *(const LAS u32x4*)(mbuf + qq * 128 + part * 8 + 4);
        unsigned t[8] = {ta.x, ta.y, ta.z, ta.w, tb.x, tb.y, tb.z, tb.w}, m[8] = {ma.x, ma.y, ma.z, ma.w, mb.x, mb.y, mb.z, mb.w};
        unsigned c = 0u;
#pragma unroll
        for (int i = 0; i < 8; ++i) { if (part * 8 + i >= nkt) { t[i] = 0u; m[i] = 0u; } c += (unsigned)__builtin_popcount(t[i]); }
        unsigned inc = c;
#pragma unroll
        for (int dd = 1; dd < 16; dd <<= 1) { const unsigned v = (unsigned)__shfl_up((int)inc, dd, 16); if (part >= dd) inc += v; }
        int rem = (int)need - (int)(inc - c);
#pragma unroll
        for (int i = 0; i < 8; ++i) {
            const int ci = __builtin_popcount(t[i]);
            unsigned keep = 0u;
            if (rem >= ci) keep = t[i];
            else if (rem > 0) { unsigned tt = t[i]; for (int k = rem; k > 0; --k) { const unsigned low = tt & (0u - tt); keep |= low; tt ^= low; } }
            m[i] |= keep; rem -= ci;
        }
        unsigned* mg = maskg + (size_t)(b * S + t0 + qq) * 128 + part * 8;
        if (part * 8 < nw) *(u32x4*)mg = (u32x4){m[0], m[1], m[2], m[3]};
        if (part * 8 + 4 < nw) *(u32x4*)(mg + 4) = (u32x4){m[4], m[5], m[6], m[7]};
    }
    __syncthreads();
}
__device__ __forceinline__ void phase_a1(const Args& a, int l, LAS unsigned char* lds, int vcu, int G) {
    KArgs* ka = kargs();
    for (int it = vcu; it < 256; it += G) { const int b = it >> 6, jj = it & 63; a1_tile(a, l, b, 127 - jj, lds); a1_tile(a, l, b, jj, lds); }
}

__device__ __forceinline__ void a2_unit(const Args& a, int l, int b, int h, int blk, LAS unsigned char* lds) {
    KArgs* ka = kargs();
    const int tid = opaque_tid(), wid = __builtin_amdgcn_readfirstlane(tid >> 6), lane = tid & 63, fr = lane & 15, kq = lane >> 4;
    const int half = wid >> 2, w4 = wid & 3;
    unsigned char* ws = ka->ws;
    const bf16_t* proj = (const bf16_t*)(ws + WS_PROJ);
    const char* KNb = (const char*)(ws + WS_KN) + (size_t)(b * 4 + h) * 128 * 4096;
    const char* VTb = (const char*)(ws + WS_VT) + (size_t)(b * 4 + h) * 128 * 4096;
    LAS unsigned char* Kb = lds;
    LAS unsigned char* Vb = lds + 32768;
    LAS float* Pb = (LAS float*)(lds + 65536);
    LAS float* Lb = Pb + 128 * 68;
    const int nsteps = 2 * (blk + 1);
    const int tokq0 = b * S + blk * 128 + w4 * 32 + fr;
    bf16x8 Qb[2][2]; float C2;
    {
        const float* qg = IN_F(I_QN) + l * 64; const float* kg = IN_F(I_KN) + l * 64;
        float gq = 0.f, gk = 0.f;
        for (int i = 0; i < 64; ++i) { gq = fmaxf(gq, fabsf(qg[i])); gk = fmaxf(gk, fabsf(kg[i])); }
        C2 = 8.0f * gq * gk * 1.4426950408889634f;
#pragma unroll
        for (int g = 0; g < 2; ++g) {
            const int tokq = tokq0 + 16 * g;
            const bf16_t* pr = proj + (size_t)tokq * NP + NQ + h * 64;
            float v[2][8]; float ss = 0.f;
#pragma unroll
            for (int ks = 0; ks < 2; ++ks) { const u32x4 raw = *(const u32x4*)(pr + 32 * ks + 8 * kq);
                v[ks][0] = bflo(raw.x); v[ks][1] = bfhi(raw.x); v[ks][2] = bflo(raw.y); v[ks][3] = bfhi(raw.y); v[ks][4] = bflo(raw.z); v[ks][5] = bfhi(raw.z); v[ks][6] = bflo(raw.w); v[ks][7] = bfhi(raw.w);
#pragma unroll
                for (int i = 0; i < 8; ++i) ss += v[ks][i] * v[ks][i]; }
            ss += __shfl_xor(ss, 16); ss += __shfl_xor(ss, 32);
            const float r = rsqrtf(ss * (1.0f / 64.0f) + EPS);
#pragma unroll
            for (int ks = 0; ks < 2; ++ks)
#pragma unroll
                for (int i = 0; i < 8; ++i) v[ks][i] *= r * qg[32 * ks + 8 * kq + i];
            {
                const float* ra = (const float*)(ws + WS_ROPEA) + (size_t)tokq * 16;
#pragma unroll
                for (int i = 0; i < 8; ++i) { const float pv = __shfl_xor(v[0][i], 16); const float c = ra[i], sn = ra[8 + i];
                    if (kq == 0) v[0][i] = v[0][i] * c - pv * sn; else if (kq == 1) v[0][i] = v[0][i] * c + pv * sn; }
            }
            const float qs = 0.125f * 1.4426950408889634f;
#pragma unroll
            for (int ks = 0; ks < 2; ++ks) { u32x4 pk; pk.x = cvt_pk_bf16(v[ks][0] * qs, v[ks][1] * qs); pk.y = cvt_pk_bf16(v[ks][2] * qs, v[ks][3] * qs); pk.z = cvt_pk_bf16(v[ks][4] * qs, v[ks][5] * qs); pk.w = cvt_pk_bf16(v[ks][6] * qs, v[ks][7] * qs);
                Qb[g][ks] = __builtin_bit_cast(bf16x8, pk); }
        }
    }
    const unsigned* mrow0 = (const unsigned*)(ws + WS_MASK) + (size_t)tokq0 * 128 + 2 * half;
    const unsigned* mrow1 = mrow0 + 16 * 128;
    f32x4 O[2][4], Ls[2];
#pragma unroll
    for (int g = 0; g < 2; ++g) { Ls[g] = (f32x4){0.f, 0.f, 0.f, 0.f};
#pragma unroll
        for (int dt = 0; dt < 4; ++dt) O[g][dt] = (f32x4){0.f, 0.f, 0.f, 0.f}; }
    const unsigned bpos = 4u * (unsigned)kq;
    const bf16x8 ones8 = __builtin_bit_cast(bf16x8, (u32x4){0x3f803f80u, 0x3f803f80u, 0x3f803f80u, 0x3f803f80u});
    const int kkey = tid >> 3, kch = tid & 7, vsub = tid >> 8, vd = (tid >> 2) & 63, vch = tid & 3;
    const int klds = kkey * 128 + ((kch ^ (kkey & 7)) * 16), vlds = vsub * 4096 + vd * 64 + ((vch ^ ((vd >> 2) & 3)) * 16);
    u32x4 kr0, kr1, kr2, kr3, vr0, vr1, vr2, vr3; u32x2 mP0, mP1, mQ0, mQ1;
#define A2_LOAD(j, st_) do { kr##j = *(const u32x4*)(KNb + (size_t)(st_) * 8192 + (size_t)tid * 16); vr##j = *(const u32x4*)(VTb + (size_t)(st_) * 8192 + (size_t)tid * 16); } while (0)
#define A2_LOADM(X, s2_) do { m##X##0 = *(const u32x2*)(mrow0 + 4 * (s2_)); m##X##1 = *(const u32x2*)(mrow1 + 4 * (s2_)); } while (0)
    A2_LOAD(0, 0); A2_LOAD(1, 1); A2_LOADM(P, 0);
    if (nsteps > 2) { A2_LOAD(2, 2); A2_LOAD(3, 3); A2_LOADM(Q, 1); } else { kr2 = kr0; vr2 = vr0; kr3 = kr0; vr3 = vr0; mQ0 = mP0; mQ1 = mP1; }
    __syncthreads();
#define A2_HALF(Kc, Vc, mc0, mc1) do { \
        _Pragma("unroll") for (int sub = 0; sub < 2; ++sub) { \
            const unsigned m0 = sub ? (mc0).y : (mc0).x, m1 = sub ? (mc1).y : (mc1).x; \
            f32x4 Sx[2][2]; \
            _Pragma("unroll") for (int tl = 0; tl < 2; ++tl) { \
                const int key = 32 * sub + 16 * tl + fr; \
                const bf16x8 A0 = *(const LAS bf16x8*)((Kc) + key * 128 + (((0 + kq) ^ (key & 7)) * 16)); \
                const bf16x8 A1 = *(const LAS bf16x8*)((Kc) + key * 128 + (((4 + kq) ^ (key & 7)) * 16)); \
                _Pragma("unroll") for (int g = 0; g < 2; ++g) { \
                    f32x4 z = (f32x4){-C2, -C2, -C2, -C2};     \
                    z = mfma16(A0, Qb[g][0], z); Sx[g][tl] = mfma16(A1, Qb[g][1], z); } \
            } \
            bf16x8 Pf[2]; \
            _Pragma("unroll") for (int g = 0; g < 2; ++g) { \
                const unsigned m = g ? m1 : m0; float p[8]; \
                _Pragma("unroll") for (int r = 0; r < 4; ++r) { \
                    const float e0 = __builtin_amdgcn_exp2f(Sx[g][0][r]), e1 = __builtin_amdgcn_exp2f(Sx[g][1][r]); \
                    p[r] = __uint_as_float(__float_as_uint(e0) & (unsigned)__builtin_amdgcn_sbfe((int)m, bpos + r, 1)); \
                    p[4 + r] = __uint_as_float(__float_as_uint(e1) & (unsigned)__builtin_amdgcn_sbfe((int)m, bpos + 16 + r, 1)); \
                } \
                u32x4 pk; pk.x = cvt_pk_bf16(p[0], p[1]); pk.y = cvt_pk_bf16(p[2], p[3]); pk.z = cvt_pk_bf16(p[4], p[5]); pk.w = cvt_pk_bf16(p[6], p[7]); \
                Pf[g] = __builtin_bit_cast(bf16x8, pk); } \
            _Pragma("unroll") for (int dt = 0; dt < 4; ++dt) { const int d = 16 * dt + fr; \
                const bf16x8 Av = *(const LAS bf16x8*)((Vc) + sub * 4096 + d * 64 + ((kq ^ ((d >> 2) & 3)) * 16)); \
                O[0][dt] = mfma16(Av, Pf[0], O[0][dt]); O[1][dt] = mfma16(Av, Pf[1], O[1][dt]); } \
            Ls[0] = mfma16(ones8, Pf[0], Ls[0]); Ls[1] = mfma16(ones8, Pf[1], Ls[1]);     \
        } } while (0)
#define A2_STEP2(ja, jb, X, s2_) do { \
        LAS unsigned char* Kc2 = Kb + ((s2_) & 1) * 16384; LAS unsigned char* Vc2 = Vb + ((s2_) & 1) * 16384; \
        *(LAS u32x4*)(Kc2 + klds) = kr##ja; *(LAS u32x4*)(Vc2 + vlds) = vr##ja; *(LAS u32x4*)(Kc2 + 8192 + klds) = kr##jb; *(LAS u32x4*)(Vc2 + 8192 + vlds) = vr##jb; \
        const u32x2 mcA = m##X##0, mcB = m##X##1; \
        __syncthreads(); \
        if (2 * (s2_) + 4 < nsteps) { A2_LOAD(ja, 2 * (s2_) + 4); A2_LOAD(jb, 2 * (s2_) + 5); A2_LOADM(X, (s2_) + 2); } \
        A2_HALF(Kc2 + half * 8192, Vc2 + half * 8192, mcA, mcB); \
    } while (0)
    for (int s2 = 0; 2 * s2 < nsteps; s2 += 2) {
        A2_STEP2(0, 1, P, s2);
        if (2 * (s2 + 1) < nsteps) A2_STEP2(2, 3, Q, s2 + 1);
    }
#undef A2_STEP2
#undef A2_HALF
#undef A2_LOAD
#undef A2_LOADM
    if (half == 1) {
#pragma unroll
        for (int g = 0; g < 2; ++g) { const int row = w4 * 32 + g * 16 + fr;
#pragma unroll
            for (int dt = 0; dt < 4; ++dt) *(LAS f32x4*)(Pb + row * 68 + 16 * dt + 4 * kq) = O[g][dt];
            if (kq == 0) Lb[row] = Ls[g][0]; }
    }
    __syncthreads();
    if (half == 0) {
#pragma unroll
        for (int g = 0; g < 2; ++g) { const int row = w4 * 32 + g * 16 + fr;
            const float inv = 1.0f / (Ls[g][0] + Lb[row]);
#pragma unroll
            for (int dt = 0; dt < 4; ++dt) { const f32x4 o = *(const LAS f32x4*)(Pb + row * 68 + 16 * dt + 4 * kq); *(LAS f32x4*)(Pb + row * 68 + 16 * dt + 4 * kq) = (O[g][dt] + o) * inv; } }
    }
    __syncthreads();
    {
        const int qq = lane >> 2, dp = (lane & 3) * 16;
        const LAS float* src = Pb + (wid * 16 + qq) * 68 + dp;
        float f[16]; float sq = 0.f;
#pragma unroll
        for (int i = 0; i < 4; ++i) { const f32x4 t = *(const LAS f32x4*)(src + 4 * i); f[4 * i] = t[0]; f[4 * i + 1] = t[1]; f[4 * i + 2] = t[2]; f[4 * i + 3] = t[3]; sq += (t[0] * t[0] + t[1] * t[1]) + (t[2] * t[2] + t[3] * t[3]); }
        u32x4 w0, w1; w0.x = cvt_pk_bf16(f[0], f[1]); w0.y = cvt_pk_bf16(f[2], f[3]); w0.z = cvt_pk_bf16(f[4], f[5]); w0.w = cvt_pk_bf16(f[6], f[7]);
        w1.x = cvt_pk_bf16(f[8], f[9]); w1.y = cvt_pk_bf16(f[10], f[11]); w1.z = cvt_pk_bf16(f[12], f[13]); w1.w = cvt_pk_bf16(f[14], f[15]);
        const int tok = b * S + blk * 128 + wid * 16 + qq;
        bf16_t* op = (bf16_t*)(ws + WS_MIXB) + (size_t)tok * D + h * 64 + dp;
        *(u32x4*)op = w0; *(u32x4*)(op + 8) = w1;
        sq += dpp_f<0xB1>(sq); sq += dpp_f<0x4E>(sq);
        if ((lane & 3) == 0) ((float*)(ws + WS_SSQ))[((size_t)l * NTOK + tok) * 4 + h] = sq;
    }
    __syncthreads();
}
__device__ __forceinline__ void phase_a2(const Args& a, int l, LAS unsigned char* lds, int vcu, int G) {
    KArgs* ka = kargs();
    for (int it = vcu; it < 256; it += G) { const int b = it >> 6, h = (it >> 4) & 3, jj = it & 15; a2_unit(a, l, b, h, 31 - jj, lds); a2_unit(a, l, b, h, jj, lds); }
}
__global__ void __launch_bounds__(NTHR, 2) mk_fwd(Args a) {
    extern __shared__ __attribute__((aligned(16))) unsigned char lds_raw[];
    LAS unsigned char* lds = (LAS unsigned char*)lds_raw;
    const int tid = threadIdx.x, G = gridDim.x, bx = blockIdx.x;
    const int vcu = (G % 8 == 0) ? (bx % 8) * (G / 8) + bx / 8 : bx;
    if (tid < 64) ((LAS unsigned*)(lds + LDS_MISC))[tid] = 0u;
    __syncthreads();
    XcdBarrier bar; bar.bar = (unsigned*)(a.ws + WS_BAR); bar.x = 0; bar.st = nullptr;
    if (a.fused) bar = xcd_barrier_post((unsigned*)(a.ws + WS_BAR), (volatile LAS unsigned*)(lds + LDS_MISC + MISC_BAR));
#define GRID_BAR() do { if (a.fused) xcd_barrier(bar); } while (0)
#ifdef ONLY_PH
#define IN(k) ((k) == ONLY_PH && a.ph_lo <= (k) && (k) < a.ph_hi)
#else
#define IN(k) (a.ph_lo <= (k) && (k) < a.ph_hi)
#endif
    if (IN(PH_PRO)) { phase_prologue(a, lds, vcu, G); GRID_BAR(); }
    if (IN(PH_NORM0)) { KArgs* ka = kargs(); unsigned char* ws = ka->ws; float* modp = (float*)(ws + WS_MOD); phase_norm(IN_F(I_X), IN_F(I_NORM1), modp, modp + 1024, (bf16_t*)(ws + WS_HA), vcu, G); phase_rbias(a, lds, vcu, G); GRID_BAR(); }
    for (int l = a.l_lo; l < a.l_hi; ++l) {
        if (IN(PH_G1)) {
            KArgs* ka = kargs(); unsigned char* ws = ka->ws;
            pg8::DenseOrder S; S.init((const bf16_t*)(ws + WS_HA), (const bf16_t*)(ws + WS_WINT) + (size_t)l * NP * D, NTOK, (G == 256) ? NP - 256 : NP, D, G, bx);
            pg8::EpiBf16 E{(bf16_t*)(ws + WS_PROJ), NP};
            pg8::gemm_phase(lds, S, E);
            GRID_BAR();
        }
        if (IN(PH_MIX)) {
            if (G == 256 && bx < 64) {
                KArgs* ka = kargs(); unsigned char* ws = ka->ws;
                pg8::DenseOrder S; S.init((const bf16_t*)(ws + WS_HA), (const bf16_t*)(ws + WS_WINT) + (size_t)l * NP * D + (size_t)(NP - 256) * D, NTOK, 256, D, 64, bx);
                pg8::EpiBf16 E{(bf16_t*)(ws + WS_PROJ) + (NP - 256), NP};
                pg8::gemm_phase(lds, S, E);
            }
            phase_mix1(a, l, lds, vcu, G, bx); GRID_BAR();
        }
        if (IN(PH_A1)) { phase_a1(a, l, lds, vcu, G); GRID_BAR(); }
        if (IN(PH_A2)) { phase_a2(a, l, lds, vcu, G); GRID_BAR(); }
        if (IN(PH_G2)) {
            KArgs* ka = kargs(); unsigned char* ws = ka->ws; const float* xin = IN_F(I_X); const bf16_t* xinb = (l == 0) ? (const bf16_t*)nullptr : (const bf16_t*)(ws + WS_X1) + (size_t)NTOK * D; const float* mod = (const float*)(ws + WS_MOD) + (size_t)l * 4 * 6144;
            pg8::DenseOrder S; S.init((const bf16_t*)(ws + WS_MIXB), (const bf16_t*)(ws + WS_WOUTT) + (size_t)l * D * D, NTOK, D, D, G, bx);
            pg8::EpiResid E{xin, xinb, (bf16_t*)(ws + WS_X1), mod + 2048, (const float*)(ws + WS_SSQ) + (size_t)l * NTOK * 4};
            pg8::gemm_phase<pg8::EpiResid, pg8::DenseOrder, true>(lds, S, E);
            GRID_BAR();
        }
        if (IN(PH_ROUTE)) { phase_route(a, l, lds, vcu, G); GRID_BAR(); }
        if (IN(PH_UP)) {
            KArgs* ka = kargs(); unsigned char* ws = ka->ws;
            moe_cum(a, l, lds);
            pg8::MoeOrder<true> S; S.A = (const bf16_t*)(ws + WS_HA); S.Bt = (const bf16_t*)(ws + WS_WGUT) + (size_t)l * NE * 1024 * 1024; S.K = D; S.bstride = (size_t)1024 * 1024;
            S.list = (const int*)(ws + WS_LIST); S.cum = (const LAS int*)(lds + LDS_MISC + MISC_CUM); S.cnts = (const LAS int*)(lds + LDS_MISC + MISC_CNT); S.G = G; S.c = vcu; S.nun = S.cum[32] * 4;
            S.flag = (int*)(ws + WS_FLAG) + l * 160 * 8;
            pg8::EpiHid E{(bf16_t*)(ws + WS_HID)};
            pg8::gemm_phase(lds, S, E);
        }
        if (IN(PH_DOWN)) {
            KArgs* ka = kargs(); unsigned char* ws = ka->ws;
            moe_cum(a, l, lds);
            pg8::MoeOrder<false> S; S.A = (const bf16_t*)(ws + WS_HID); S.Bt = (const bf16_t*)(ws + WS_WDT) + (size_t)l * NE * 1024 * 512; S.K = F; S.bstride = (size_t)1024 * 512;
            S.list = nullptr; S.cum = (const LAS int*)(lds + LDS_MISC + MISC_CUM); S.cnts = (const LAS int*)(lds + LDS_MISC + MISC_CNT); S.G = G; S.c = G - 1 - vcu; S.nun = S.cum[32] * 4;
            S.flag = (int*)(ws + WS_FLAG) + l * 160 * 8;
            pg8::EpiDown E{(bf16_t*)(ws + WS_Y), (const float*)(ws + WS_LGATE)};
            pg8::gemm_phase(lds, S, E);
            GRID_BAR();
        }
        if (IN(PH_COMB)) { phase_combine(a, l, lds, vcu, G); GRID_BAR(); }
    }
#undef IN
#undef GRID_BAR
}


static void launch_ph(const Args& base, int grid, int l_lo, int l_hi, int ph_lo, int ph_hi, int fused, hipStream_t stream) {
    Args a = base; a.l_lo = l_lo; a.l_hi = l_hi; a.ph_lo = ph_lo; a.ph_hi = ph_hi; a.fused = fused; a.pad = 0;
    hipLaunchKernelGGL(mk_fwd, dim3(grid), dim3(NTHR), LDS_BYTES, stream, a);
}

extern "C" void kernel_launch(void* const* d_in, const int* in_sizes, int n_in, void* d_out, int out_size, void* d_ws, size_t ws_size, hipStream_t stream) {
    static int grid = 0;
    if (grid == 0) {
        int dev = 0, cus = 0;
        if (hipGetDevice(&dev) != hipSuccess || hipDeviceGetAttribute(&cus, hipDeviceAttributeMultiprocessorCount, dev) != hipSuccess) { grid = -1; return; }
        if (hipFuncSetAttribute((const void*)mk_fwd, hipFuncAttributeMaxDynamicSharedMemorySize, LDS_BYTES) != hipSuccess) { fprintf(stderr, "hipFuncSetAttribute failed\n"); grid = -1; return; }
        (void)hipGetLastError();
        grid = cus;
    }
    if (grid < 0) return;
    unsigned char* ws = (unsigned char*)d_ws;
    (void)hipMemsetAsync(ws, 0, WS_ZERO_BYTES, stream);
    Args a{};
    for (int i = 0; i < 32; ++i) a.in[i] = d_in[i];
    a.out = (float*)d_out; a.ws = ws;
#ifdef MK_MULTI
    launch_ph(a, grid, 0, 0, PH_PRO, PH_PRO + 1, 0, stream);
#ifdef MK_REP
    if (MK_REP == PH_PRO) launch_ph(a, grid, 0, 0, PH_PRO, PH_PRO + 1, 0, stream);
#endif
    launch_ph(a, grid, 0, 0, PH_NORM0, PH_NORM0 + 1, 0, stream);
#ifdef MK_REP
    if (MK_REP == PH_NORM0) launch_ph(a, grid, 0, 0, PH_NORM0, PH_NORM0 + 1, 0, stream);
#endif
    for (int l = 0; l < L; ++l)
        for (int ph = PH_G1; ph < PH_END; ++ph) {
            launch_ph(a, grid, l, l + 1, ph, ph + 1, 0, stream);
#ifdef MK_REP
            if (ph == MK_REP) launch_ph(a, grid, l, l + 1, ph, ph + 1, 0, stream);
#endif
        }
#else
    launch_ph(a, grid, 0, L, PH_PRO, PH_END, 1, stream);
#endif
}
```

```cpp
#include <hip/hip_runtime.h>
#include <stdint.h>
#include <stdio.h>

#define LAS __attribute__((address_space(3)))
typedef unsigned short bf16_t;
typedef short bf16x8 __attribute__((ext_vector_type(8)));
typedef float f32x4 __attribute__((ext_vector_type(4)));
typedef float f32x16 __attribute__((ext_vector_type(16)));
typedef unsigned u32x4 __attribute__((ext_vector_type(4)));
typedef unsigned u32x2 __attribute__((ext_vector_type(2)));

constexpr int Bn = 4, S = 4096, D = 1024, L = 2, NTOK = Bn * S, DIN = 2212, F = 512, NE = 32;
constexpr int NP = 2304;
constexpr int NK = 0, NV = 256, NIQ = 512, NIK = 640, NIW = 672, NBA = 768, NBG = 1024, NC = 1280, NDU = 1536, NDV = 1792, NQ = 2048;
constexpr float EPS = 1e-6f;
constexpr int NTHR = 512;
constexpr int SLOTS = 40960;

constexpr int LDS_BYTES = 163840, LDS_MISC = 147456;
constexpr int MISC_BAR = 0;
constexpr int MISC_CUM = 64;
constexpr int MISC_CNT = 64 + 160;

constexpr size_t al256c(size_t v) { return (v + 255) & ~(size_t)255; }
constexpr size_t WS_BAR = 0;
constexpr size_t WS_CNT = 16384;
constexpr size_t WS_FLAG = 16384 + 16384;
constexpr size_t WS_ZERO_BYTES = 16384 + 32768;
constexpr size_t WS_MOD = WS_ZERO_BYTES;
constexpr size_t WS_ROPEA = WS_MOD + al256c((size_t)L * 4 * 6144 * 4);
constexpr size_t WS_ROPEI = WS_ROPEA + al256c((size_t)NTOK * 16 * 4);
constexpr size_t WS_LIST = WS_ROPEI + al256c((size_t)NTOK * 8 * 4);
constexpr size_t WS_LGATE = WS_LIST + al256c((size_t)NE * NTOK * 4);
constexpr size_t WS_TOKINFO = WS_LGATE + al256c((size_t)NE * NTOK * 4);
constexpr size_t WS_SGUW = WS_TOKINFO + al256c((size_t)NTOK * 16);
constexpr size_t WS_POOLT = WS_SGUW + al256c((size_t)L * 4 * 128 * 128 * 2);
constexpr size_t WS_WHL = WS_POOLT + al256c((size_t)L * 4 * 64 * 64 * 2);
constexpr size_t WS_RBIAS = WS_WHL + al256c((size_t)L * 2 * 48 * 1024 * 2);
constexpr size_t WS_SSQ = WS_RBIAS + al256c((size_t)L * 4 * 32 * 48 * 4);
constexpr size_t WS_WINT = WS_SSQ + al256c((size_t)L * NTOK * 4 * 4);
constexpr size_t WS_WOUTT = WS_WINT + al256c((size_t)L * NP * D * 2);
constexpr size_t WS_PWT = WS_WOUTT + al256c((size_t)L * D * D * 2);
constexpr size_t WS_WGUT = WS_PWT + al256c((size_t)L * 256 * 256 * 2);
constexpr size_t WS_WDT = WS_WGUT + al256c((size_t)L * NE * 1024 * 1024 * 2);
constexpr size_t WS_HA = WS_WDT + al256c((size_t)L * NE * 1024 * 512 * 2);
constexpr size_t WS_X1 = WS_HA + al256c((size_t)NTOK * D * 2);
constexpr size_t WS_R = WS_X1 + al256c((size_t)NTOK * D * 4);
constexpr size_t WS_PROJ = WS_R;
constexpr size_t WS_R2 = WS_PROJ + al256c((size_t)NTOK * NP * 2);
constexpr size_t WS_HID = WS_R;
constexpr size_t WS_Y = WS_HID + al256c((size_t)SLOTS * F * 2);

__device__ __forceinline__ void lds_barrier() { asm volatile("s_waitcnt lgkmcnt(0)\n\ts_barrier" ::: "memory"); }
__device__ __forceinline__ unsigned cvt_pk_bf16(float lo, float hi) { unsigned r; asm volatile("v_cvt_pk_bf16_f32 %0, %1, %2" : "=v"(r) : "v"(lo), "v"(hi)); return r; }
__device__ __forceinline__ float bf2f(bf16_t v) { return __uint_as_float(((unsigned)v) << 16); }
__device__ __forceinline__ float bflo(unsigned w) { return __uint_as_float(w << 16); }
__device__ __forceinline__ float bfhi(unsigned w) { return __uint_as_float(w & 0xffff0000u); }
template <int CTRL> __device__ __forceinline__ float dpp_f(float v) { return __builtin_bit_cast(float, __builtin_amdgcn_update_dpp(0, __builtin_bit_cast(int, v), CTRL, 0xF, 0xF, true)); }
__device__ __forceinline__ float row_sum16(float v) {
    v += dpp_f<0xB1>(v);
    v += dpp_f<0x4E>(v);
    v += dpp_f<0x141>(v);
    v += dpp_f<0x140>(v);
    return v;
}
__device__ __forceinline__ float wave_sum(float v) {
    v = row_sum16(v);
    const float r0 = __builtin_bit_cast(float, __builtin_amdgcn_readlane(__builtin_bit_cast(int, v), 0)), r1 = __builtin_bit_cast(float, __builtin_amdgcn_readlane(__builtin_bit_cast(int, v), 16));
    const float r2 = __builtin_bit_cast(float, __builtin_amdgcn_readlane(__builtin_bit_cast(int, v), 32)), r3 = __builtin_bit_cast(float, __builtin_amdgcn_readlane(__builtin_bit_cast(int, v), 48));
    return (r0 + r1) + (r2 + r3);
}
__device__ __forceinline__ float wave_max(float v) {
#pragma unroll
    for (int o = 32; o >= 1; o >>= 1) v = fmaxf(v, __shfl_xor(v, o));
    return v;
}
__device__ __forceinline__ float silu_f(float v) { return v / (1.0f + expf(-v)); }
__device__ __forceinline__ float silu_fast(float v) { return v * __builtin_amdgcn_rcpf(1.0f + __expf(-v)); }
__device__ __forceinline__ float sigmoid_f(float v) { return 1.0f / (1.0f + expf(-v)); }
__device__ __forceinline__ float sigmoid_fast(float v) { return __builtin_amdgcn_rcpf(1.0f + __expf(-v)); }
__device__ __forceinline__ int opaque_tid() { int t = threadIdx.x; asm volatile("" : "+v"(t)); return t; }
__device__ __forceinline__ int ld_agent(const int* p) { return __hip_atomic_load(p, __ATOMIC_RELAXED, __HIP_MEMORY_SCOPE_AGENT); }

#define XB_TMO      128
#define XB_XCNT(j)  (256  + 64 * (j))
#define XB_XSUB(j)  (1280 + 64 * (j))
#define XB_XGEN(j)  (2304 + 64 * (j))
#define XB_TOP      3328
#define XB_TOPGEN   3392
#define XCD_BAR_WORDS 3456
#define XB_SPIN_CAP (1u << 18)
__device__ __forceinline__ unsigned xb_ld(unsigned* p)              { return __hip_atomic_load(p, __ATOMIC_RELAXED, __HIP_MEMORY_SCOPE_AGENT); }
__device__ __forceinline__ unsigned xb_add(unsigned* p, unsigned v) { return __hip_atomic_fetch_add(p, v, __ATOMIC_RELAXED, __HIP_MEMORY_SCOPE_AGENT); }
__device__ __forceinline__ unsigned xb_xcc_id() { return (unsigned)__builtin_amdgcn_s_getreg((3 << 11) | 20) & 0xFu; }
#define XB_SPIN(cond, bar) do { unsigned _sp = 0; while (cond) { __builtin_amdgcn_s_sleep(1); \
    if ((++_sp & 255u) == 0u) { if (xb_ld(&(bar)[XB_TMO])) break; if (_sp > XB_SPIN_CAP) { atomicAdd(&(bar)[XB_TMO], 1u); break; } } } } while (0)
struct XcdBarrier { unsigned* bar; unsigned x; volatile LAS unsigned* st; };
__device__ __forceinline__ XcdBarrier xcd_barrier_post(unsigned* bar, volatile LAS unsigned* st) {
    XcdBarrier b; b.bar = bar; b.x = xb_xcc_id(); b.st = st;
    if (threadIdx.x == 0) (void)xb_add(&bar[XB_XCNT(b.x)], 1u);
    return b;
}
__device__ __forceinline__ void xcd_barrier_complete(unsigned* bar, unsigned x, unsigned& nloc, unsigned& nx) {
    const unsigned G = gridDim.x * gridDim.y * gridDim.z;
    unsigned sum, cnt, mine, sp = 0u;
    for (;;) {
        sum = 0u; cnt = 0u; mine = 0u;
#pragma unroll
        for (unsigned j = 0; j < 16; ++j) { const unsigned c = xb_ld(&bar[XB_XCNT(j)]); sum += c; cnt += (c > 0u) ? 1u : 0u; mine = (j == x) ? c : mine; }
        if (sum == G) break;
        __builtin_amdgcn_s_sleep(1);
        if ((++sp & 255u) == 0u) { if (xb_ld(&bar[XB_TMO])) break; if (sp > XB_SPIN_CAP) { atomicAdd(&bar[XB_TMO], 1u); break; } }
    }
    nloc = mine > 0u ? mine : 1u; nx = cnt > 0u ? cnt : 1u;
}
__device__ __forceinline__ void xcd_barrier(const XcdBarrier& b) {
    asm volatile("s_waitcnt vmcnt(0)" ::: "memory");
    __syncthreads();
    if (threadIdx.x == 0) {
        unsigned* bar = b.bar;
        __builtin_amdgcn_s_waitcnt(0);
        unsigned nloc = b.st[0], nx = b.st[1];
        if (nloc == 0u) { xcd_barrier_complete(bar, b.x, nloc, nx); b.st[0] = nloc; b.st[1] = nx; }
        const unsigned old = xb_add(&bar[XB_XSUB(b.x)], 1u);
        const unsigned gen = old / nloc;
        if (old + 1u == (gen + 1u) * nloc) {
            __builtin_amdgcn_fence(__ATOMIC_RELEASE, "agent");
            asm volatile("s_waitcnt vmcnt(0)" ::: "memory");
            const unsigned og = xb_add(&bar[XB_TOP], 1u);
            const unsigned tg = og / nx;
            if (og + 1u == (tg + 1u) * nx) xb_add(&bar[XB_TOPGEN], 1u);
            else XB_SPIN(xb_ld(&bar[XB_TOPGEN]) == tg, bar);
            __builtin_amdgcn_fence(__ATOMIC_ACQUIRE, "agent");
            xb_add(&bar[XB_XGEN(b.x)], 1u);
            asm volatile("s_waitcnt vmcnt(0)" ::: "memory");
        } else {
            XB_SPIN(xb_ld(&bar[XB_XGEN(b.x)]) == gen, bar);
            __builtin_amdgcn_fence(__ATOMIC_ACQUIRE, "agent");
            asm volatile("s_waitcnt vmcnt(0)" ::: "memory");
        }
    }
    __syncthreads();
}

template <class PF> __device__ __forceinline__ void xcd_barrier_pf(const XcdBarrier& b, PF&& pf) {
    asm volatile("s_waitcnt vmcnt(0) lgkmcnt(0)\n\ts_barrier" ::: "memory");
    unsigned old = 0u, nloc = 1u, nx = 1u;
    if (threadIdx.x == 0) {
        unsigned* bar = b.bar;
        nloc = b.st[0]; nx = b.st[1];
        if (nloc == 0u) { xcd_barrier_complete(bar, b.x, nloc, nx); b.st[0] = nloc; b.st[1] = nx; }
        old = xb_add(&bar[XB_XSUB(b.x)], 1u);
    }
    pf();
    if (threadIdx.x == 0) {
        unsigned* bar = b.bar;
        const unsigned gen = old / nloc;
        if (old + 1u == (gen + 1u) * nloc) {
            __builtin_amdgcn_fence(__ATOMIC_RELEASE, "agent");
            asm volatile("s_waitcnt vmcnt(0)" ::: "memory");
            const unsigned og = xb_add(&bar[XB_TOP], 1u);
            const unsigned tg = og / nx;
            if (og + 1u == (tg + 1u) * nx) xb_add(&bar[XB_TOPGEN], 1u);
            else XB_SPIN(xb_ld(&bar[XB_TOPGEN]) == tg, bar);
            __builtin_amdgcn_fence(__ATOMIC_ACQUIRE, "agent");
            xb_add(&bar[XB_XGEN(b.x)], 1u);
            asm volatile("s_waitcnt vmcnt(0)" ::: "memory");
        } else {
            XB_SPIN(xb_ld(&bar[XB_XGEN(b.x)]) == gen, bar);
            __builtin_amdgcn_fence(__ATOMIC_ACQUIRE, "agent");
            asm volatile("s_waitcnt vmcnt(0)" ::: "memory");
        }
    }
    __syncthreads();
}

__device__ __forceinline__ void xcd_barrier_arrive(const XcdBarrier& b) {
    asm volatile("s_waitcnt vmcnt(0) lgkmcnt(0)\n\ts_barrier" ::: "memory");
    if (threadIdx.x == 0) {
        unsigned* bar = b.bar;
        unsigned nloc = b.st[0], nx = b.st[1];
        if (nloc == 0u) { xcd_barrier_complete(bar, b.x, nloc, nx); b.st[0] = nloc; b.st[1] = nx; }
        const unsigned old = xb_add(&bar[XB_XSUB(b.x)], 1u);
        const unsigned gen = old / nloc;
        if (old + 1u == (gen + 1u) * nloc) {
            __builtin_amdgcn_fence(__ATOMIC_RELEASE, "agent");
            asm volatile("s_waitcnt vmcnt(0)" ::: "memory");
            const unsigned og = xb_add(&bar[XB_TOP], 1u);
            const unsigned tg = og / nx;
            if (og + 1u == (tg + 1u) * nx) xb_add(&bar[XB_TOPGEN], 1u);
            xb_add(&bar[XB_XGEN(b.x)], 1u);
        }
        b.st[2] = gen;
    }
}
__device__ __forceinline__ void xcd_barrier_wait(const XcdBarrier& b) {
    if (threadIdx.x == 0) {
        unsigned* bar = b.bar;
        const unsigned gen = b.st[2];
        XB_SPIN(xb_ld(&bar[XB_TOPGEN]) == gen, bar);
        __builtin_amdgcn_fence(__ATOMIC_ACQUIRE, "agent");
        asm volatile("s_waitcnt vmcnt(0)" ::: "memory");
    }
    __syncthreads();
}

template <class PF> __device__ __forceinline__ void xcd_barrier_work(const XcdBarrier& b, PF&& pf) { xcd_barrier_arrive(b); pf(); xcd_barrier_wait(b); }

namespace pg8 {
constexpr int BM = 256, BK = 64, HALF = 128, HTB = HALF * BK * 2, STAGE_BYTES = 8 * HTB, NXCD = 8, WGM = 8;
__host__ __device__ __forceinline__ int lds_byte(int r, int c) { const int st = (r >> 4) * 2 + (c >> 5), rr = r & 15, cc = c & 31, ob = rr * 64 + cc * 2; return st * 1024 + (ob ^ (((ob >> 9) & 1) << 5)); }
__host__ __device__ __forceinline__ void stage_rc(int b, int& R, int& C) { const int st = b / 1024, sb = b % 1024, swz = sb ^ (((sb >> 9) & 1) << 5); R = (st >> 1) * 16 + swz / 64; C = (st & 1) * 32 + (swz % 64) / 2; }
__host__ __device__ __forceinline__ int perm32(int rho) { const int n = rho >> 4, i = rho & 15; return 8 * (i >> 2) + 4 * n + (i & 3); }

struct Unit { int pm, pn, e, mt, cnt; };

struct DenseOrder {
    static constexpr int SYNC = 0;
    const bf16_t* A; const bf16_t* Bt; int K;
    int nM, nN, nwg, G, c;
    __device__ void init(const bf16_t* A_, const bf16_t* Bt_, int M, int N, int K_, int G_, int c_) { A = A_; Bt = Bt_; K = K_; nM = M / BM; nN = N / BM; nwg = nM * nN; G = G_; c = c_; }
    __device__ bool next(int i, Unit& u) const {
        const long Lx = (long)i * G + c; if (Lx >= nwg) return false;
        int wgid = (int)Lx; { const int q = nwg / NXCD, r = nwg % NXCD, xcd = wgid % NXCD, off = wgid / NXCD; wgid = (xcd < r ? xcd * (q + 1) : r * (q + 1) + (xcd - r) * q) + off; }
        const int nig = WGM * nN, gid = wgid / nig, fm = gid * WGM, gsz = (nM - fm) < WGM ? (nM - fm) : WGM;
        u.pm = fm + ((wgid % nig) % gsz); u.pn = (wgid % nig) / gsz; u.e = 0; u.mt = 0; u.cnt = 0; return true;
    }
    __device__ __forceinline__ const char* a_base(const Unit& u) const { return (const char*)A + (size_t)u.pm * BM * K * 2; }
    __device__ __forceinline__ unsigned a_voff(const Unit&, int row, int C) const { return (unsigned)(row * K + C) * 2u; }
    __device__ __forceinline__ const char* b_base(const Unit& u) const { return (const char*)Bt + (size_t)u.pn * BM * K * 2; }
};
template <bool gather> struct MoeOrder {
    static constexpr int SYNC = gather ? 1 : 2;
    int* flag;
    const bf16_t* A; const bf16_t* Bt; int K; size_t bstride;
    const int* list;
    const LAS int* cum; const LAS int* cnts;
    int G, c, nun;
    __device__ bool next(int i, Unit& u) const {
        int Lx;
        if (gather) Lx = i * G + c;
        else {
            const int rem = nun % G, nl = G - rem;
            if (c >= rem) Lx = ((i + 1) >> 1) * nl + (i >> 1) * G + ((i & 1) ? c : c - rem);
            else Lx = (i + 1) * nl + i * G + c;
        }
        if (Lx >= nun) return false;
        const int t = Lx >> 2; u.pn = Lx & 3; u.pm = t;
        int e = -1;
        typedef int i32x4_ __attribute__((ext_vector_type(4)));
        const LAS i32x4_* c4 = (const LAS i32x4_*)cum;
#pragma unroll
        for (int j4 = 0; j4 < NE / 4; ++j4) { const i32x4_ v = c4[j4]; e += ((v.x <= t) ? 1 : 0) + ((v.y <= t) ? 1 : 0) + ((v.z <= t) ? 1 : 0) + ((v.w <= t) ? 1 : 0); }
        u.e = e; u.mt = t - cum[e]; u.cnt = cnts[e]; return true;
    }
    __device__ __forceinline__ const char* a_base(const Unit& u) const { return gather ? (const char*)A : (const char*)A + (size_t)u.pm * BM * K * 2; }
    __device__ __forceinline__ unsigned a_voff(const Unit& u, int row, int C) const {
        if (gather) { const int pos = u.mt * BM + row; const int tok = (pos < u.cnt) ? list[(size_t)u.e * NTOK + pos] : 0; return (unsigned)(tok * K + C) * 2u; }
        return (unsigned)(row * K + C) * 2u;
    }
    __device__ __forceinline__ const char* b_base(const Unit& u) const { return (const char*)(Bt + (size_t)u.e * bstride) + (size_t)u.pn * BM * K * 2; }
};

struct EpiBf16 {
    static constexpr bool PERM = true;
    bf16_t* O; int ldc;
    __device__ __forceinline__ void operator()(const f32x4 (&acc)[2][2][4][2], const Unit& u, int wr, int wc, int fr, int fq) const {
        const int row0 = u.pm * BM + wr * 64 + fr, col0 = u.pn * BM + wc * 32 + 8 * fq;
#pragma unroll
        for (int ai = 0; ai < 2; ++ai)
#pragma unroll
            for (int m = 0; m < 4; ++m) { bf16_t* rowp = O + (size_t)(row0 + ai * HALF + m * 16) * ldc + col0;
#pragma unroll
                for (int bj = 0; bj < 2; ++bj) { const f32x4 v0 = acc[ai][bj][m][0], v1 = acc[ai][bj][m][1];
                    u32x4 w; w.x = cvt_pk_bf16(v0[0], v0[1]); w.y = cvt_pk_bf16(v0[2], v0[3]); w.z = cvt_pk_bf16(v1[0], v1[1]); w.w = cvt_pk_bf16(v1[2], v1[3]);
                    *(u32x4*)(rowp + bj * HALF) = w; } }
    }
};
struct EpiResid {
    static constexpr bool PERM = true;
    const float* X; const bf16_t* Xb; bf16_t* C; const float* gate;
    const float* ssq;
    __device__ __forceinline__ void rowscale(f32x4 (&acc)[2][2][4][2], const Unit& u, int wr, int fr) const {
        int rbase = u.pm * BM + wr * 64 + fr;
        asm volatile("" : "+v"(rbase));
        f32x4 sv[2][4];
#pragma unroll
        for (int ai = 0; ai < 2; ++ai)
#pragma unroll
            for (int m = 0; m < 4; ++m) sv[ai][m] = *(const f32x4*)(ssq + (size_t)(rbase + ai * HALF + m * 16) * 4);
        __builtin_amdgcn_sched_barrier(0);
#pragma unroll
        for (int ai = 0; ai < 2; ++ai)
#pragma unroll
            for (int m = 0; m < 4; ++m) { const float r = rsqrtf(((sv[ai][m][0] + sv[ai][m][1]) + (sv[ai][m][2] + sv[ai][m][3])) * (1.0f / 256.0f) + EPS);
#pragma unroll
                for (int bj = 0; bj < 2; ++bj)
#pragma unroll
                    for (int n = 0; n < 2; ++n) acc[ai][bj][m][n] *= r; }
    }
    __device__ __forceinline__ void operator()(const f32x4 (&acc)[2][2][4][2], const Unit& u, int wr, int wc, int fr, int fq) const {
        const int row0 = u.pm * BM + wr * 64 + fr, col0 = u.pn * BM + wc * 32 + 8 * fq;
        const float* gp = gate + (size_t)((u.pm * BM) / S) * 6144 + col0;
        f32x4 gv[2][2];
#pragma unroll
        for (int bj = 0; bj < 2; ++bj)
#pragma unroll
            for (int n = 0; n < 2; ++n) gv[bj][n] = *(const f32x4*)(gp + bj * HALF + n * 4);
#pragma unroll
        for (int ai = 0; ai < 2; ++ai) {
            if (Xb) {
                u32x4 xw[4][2];
#pragma unroll
                for (int m = 0; m < 4; ++m)
#pragma unroll
                    for (int bj = 0; bj < 2; ++bj) xw[m][bj] = *(const u32x4*)(Xb + (size_t)(row0 + ai * HALF + m * 16) * D + col0 + bj * HALF);
                __builtin_amdgcn_sched_barrier(0);
#pragma unroll
                for (int m = 0; m < 4; ++m) { const size_t off = (size_t)(row0 + ai * HALF + m * 16) * D + col0;
#pragma unroll
                    for (int bj = 0; bj < 2; ++bj) {
                        const f32x4 x0 = (f32x4){bflo(xw[m][bj].x), bfhi(xw[m][bj].x), bflo(xw[m][bj].y), bfhi(xw[m][bj].y)}, x1v = (f32x4){bflo(xw[m][bj].z), bfhi(xw[m][bj].z), bflo(xw[m][bj].w), bfhi(xw[m][bj].w)};
                        const f32x4 o0 = x0 + gv[bj][0] * acc[ai][bj][m][0], o1 = x1v + gv[bj][1] * acc[ai][bj][m][1];
                        u32x4 w; w.x = cvt_pk_bf16(o0[0], o0[1]); w.y = cvt_pk_bf16(o0[2], o0[3]); w.z = cvt_pk_bf16(o1[0], o1[1]); w.w = cvt_pk_bf16(o1[2], o1[3]);
                        *(u32x4*)(C + off + bj * HALF) = w; } }
            } else {
#pragma unroll
                for (int mh = 0; mh < 2; ++mh) {
                    f32x4 xf[2][2][2];
#pragma unroll
                    for (int m2 = 0; m2 < 2; ++m2)
#pragma unroll
                        for (int bj = 0; bj < 2; ++bj) { const float* xp = X + (size_t)(row0 + ai * HALF + (2 * mh + m2) * 16) * D + col0 + bj * HALF; xf[m2][bj][0] = *(const f32x4*)xp; xf[m2][bj][1] = *(const f32x4*)(xp + 4); }
                    __builtin_amdgcn_sched_barrier(0);
#pragma unroll
                    for (int m2 = 0; m2 < 2; ++m2) { const int m = 2 * mh + m2; const size_t off = (size_t)(row0 + ai * HALF + m * 16) * D + col0;
#pragma unroll
                        for (int bj = 0; bj < 2; ++bj) {
                            const f32x4 o0 = xf[m2][bj][0] + gv[bj][0] * acc[ai][bj][m][0], o1 = xf[m2][bj][1] + gv[bj][1] * acc[ai][bj][m][1];
                            u32x4 w; w.x = cvt_pk_bf16(o0[0], o0[1]); w.y = cvt_pk_bf16(o0[2], o0[3]); w.z = cvt_pk_bf16(o1[0], o1[1]); w.w = cvt_pk_bf16(o1[2], o1[3]);
                            *(u32x4*)(C + off + bj * HALF) = w; } }
                    asm volatile("" ::: "memory");
                }
            }
            asm volatile("" ::: "memory");
        }
    }
};
__device__ __forceinline__ void store_wt16(void* ptr, u32x4 w) { asm volatile("global_store_dwordx4 %0, %1, off sc1\n\ts_nop 1" :: "v"(ptr), "v"(w) : "memory"); }
__device__ __forceinline__ void flag_wait(const int* flag, int want) {
    while (__hip_atomic_load(flag, __ATOMIC_RELAXED, __HIP_MEMORY_SCOPE_AGENT) < want) __builtin_amdgcn_s_sleep(1);
    __builtin_amdgcn_fence(__ATOMIC_ACQUIRE, "agent");
    asm volatile("s_waitcnt vmcnt(0)" ::: "memory");
}
struct EpiHid {
    static constexpr bool PERM = true;
    bf16_t* H;
    __device__ __forceinline__ void operator()(const f32x4 (&acc)[2][2][4][2], const Unit& u, int wr, int wc, int fr, int fq) const {
        const int row0 = u.pm * BM + wr * 64 + fr, col0 = u.pn * HALF + wc * 32 + 8 * fq;
#pragma unroll
        for (int ai = 0; ai < 2; ++ai)
#pragma unroll
            for (int m = 0; m < 4; ++m) { float h[8];
#pragma unroll
                for (int n = 0; n < 2; ++n)
#pragma unroll
                    for (int j = 0; j < 4; ++j) h[n * 4 + j] = silu_fast(acc[ai][0][m][n][j]) * acc[ai][1][m][n][j];
                u32x4 w; w.x = cvt_pk_bf16(h[0], h[1]); w.y = cvt_pk_bf16(h[2], h[3]); w.z = cvt_pk_bf16(h[4], h[5]); w.w = cvt_pk_bf16(h[6], h[7]);
                store_wt16(H + (size_t)(row0 + ai * HALF + m * 16) * F + col0, w); }
    }
};
struct EpiDown {
    static constexpr bool PERM = true;
    bf16_t* Y; const float* lgate;
    __device__ __forceinline__ void operator()(const f32x4 (&acc)[2][2][4][2], const Unit& u, int wr, int wc, int fr, int fq) const {
        const int rl0 = wr * 64 + fr, col0 = u.pn * BM + wc * 32 + 8 * fq;
        const float* gp = lgate + (size_t)u.e * NTOK + u.mt * BM;
        float gq[2][4];
#pragma unroll
        for (int ai = 0; ai < 2; ++ai)
#pragma unroll
            for (int m = 0; m < 4; ++m) { const int rl = rl0 + ai * HALF + m * 16; gq[ai][m] = gp[(u.mt * BM + rl < u.cnt) ? rl : 0]; }
        __builtin_amdgcn_sched_barrier(0);
#pragma unroll
        for (int ai = 0; ai < 2; ++ai)
#pragma unroll
            for (int m = 0; m < 4; ++m) { const int rl = rl0 + ai * HALF + m * 16; const float g = (u.mt * BM + rl < u.cnt) ? gq[ai][m] : 0.f;
                bf16_t* rowp = Y + (size_t)(u.pm * BM + rl) * D + col0;
#pragma unroll
                for (int bj = 0; bj < 2; ++bj) { const f32x4 v0 = acc[ai][bj][m][0] * g, v1 = acc[ai][bj][m][1] * g;
                    u32x4 w; w.x = cvt_pk_bf16(v0[0], v0[1]); w.y = cvt_pk_bf16(v0[2], v0[3]); w.z = cvt_pk_bf16(v1[0], v1[1]); w.w = cvt_pk_bf16(v1[2], v1[3]);
                    *(u32x4*)(rowp + bj * HALF) = w; } }
    }
};

template <class Epi, class Sched, bool RSC = false>
__device__ __forceinline__ void gemm_phase(LAS unsigned char* lds, const Sched& S, const Epi& E) {
    const int tid = opaque_tid(), wid = __builtin_amdgcn_readfirstlane(tid >> 6), lane = tid & 63, wr = wid >> 2, wc = wid & 3, fr = lane & 15, fq = lane >> 4;
    const int K = S.K, nt = K / BK;
    int Rr[2], Cc[2]; unsigned voffB[2];
#pragma unroll
    for (int i = 0; i < 2; ++i) { stage_rc(tid * 16 + i * 8192, Rr[i], Cc[i]); const int Rb = Epi::PERM ? ((Rr[i] & ~31) + perm32(Rr[i] & 31)) : Rr[i]; voffB[i] = (unsigned)(Rb * K + Cc[i]) * 2u; }
    const size_t kstep = (size_t)(BK * 2);
    const size_t hstep = (size_t)HALF * K * 2;
    const unsigned ldsw = (unsigned)wid * 1024u;
    const int aoff = lds_byte(wr * 64 + fr, fq * 8), boff = lds_byte(wc * 32 + fr, fq * 8);
#define PG8_SA(b, h) (((b) * 2 + (h)) * HTB)
#define PG8_SB(b, h) ((4 + (b) * 2 + (h)) * HTB)
#define PG8_STAGE(bufoff, gbase, voff) do { _Pragma("unroll") for (int _i = 0; _i < 2; ++_i) \
        __builtin_amdgcn_global_load_lds((const unsigned*)((const char*)(gbase) + (voff)[_i]), (LAS unsigned*)(lds + (bufoff) + ldsw + _i * 8192), 16, 0, 0); } while (0)
#define PG8_LDA(dst, b, h) do { _Pragma("unroll") for (int m = 0; m < 4; ++m) _Pragma("unroll") for (int k = 0; k < 2; ++k) dst[m][k] = *(const LAS bf16x8*)(lds + PG8_SA(b, h) + aoff + m * 2048 + k * 1024); } while (0)
#define PG8_LDB(dst, b, h) do { _Pragma("unroll") for (int n = 0; n < 2; ++n) _Pragma("unroll") for (int k = 0; k < 2; ++k) dst[n][k] = *(const LAS bf16x8*)(lds + PG8_SB(b, h) + boff + n * 2048 + k * 1024); } while (0)
#define PG8_MMA(ai, bj, At, Bt) do { __builtin_amdgcn_s_setprio(1); _Pragma("unroll") for (int m = 0; m < 4; ++m) _Pragma("unroll") for (int n = 0; n < 2; ++n) _Pragma("unroll") for (int k = 0; k < 2; ++k) \
        acc[ai][bj][m][n] = __builtin_amdgcn_mfma_f32_16x16x32_bf16(Bt[n][k], At[m][k], acc[ai][bj][m][n], 0, 0, 0); __builtin_amdgcn_s_setprio(0); } while (0)
#define PG8_WAIT_V(n) asm volatile("s_waitcnt vmcnt(" #n ")" ::: "memory")
#define PG8_WAIT_L(n) asm volatile("s_waitcnt lgkmcnt(" #n ")" ::: "memory")
#define PG8_BAR __builtin_amdgcn_s_barrier()
#define PG8_SCHED __builtin_amdgcn_sched_barrier(0)
    Unit cur, nxt; int ui = 0;
    if (!S.next(0, cur)) return;
    if constexpr (Sched::SYNC == 2) { if (wid == 0) flag_wait(S.flag + cur.pm * 8, 4); __builtin_amdgcn_s_barrier(); }
    f32x4 acc[2][2][4][2];
#pragma unroll
    for (int a = 0; a < 2; ++a)
#pragma unroll
        for (int b = 0; b < 2; ++b)
#pragma unroll
            for (int m = 0; m < 4; ++m)
#pragma unroll
                for (int n = 0; n < 2; ++n) acc[a][b][m][n] = (f32x4){0.f, 0.f, 0.f, 0.f};
    bf16x8 At[4][2], B0[2][2], B1[2][2];
    unsigned vA0[2], vA1[2], vN0[2], vN1[2];
#pragma unroll
    for (int i = 0; i < 2; ++i) { vA0[i] = S.a_voff(cur, Rr[i], Cc[i]); vA1[i] = S.a_voff(cur, HALF + Rr[i], Cc[i]); }
    const char* cA = S.a_base(cur); const char* cB = S.b_base(cur);
    PG8_STAGE(PG8_SB(0, 0), cB, voffB); PG8_STAGE(PG8_SB(0, 1), cB + hstep, voffB); PG8_STAGE(PG8_SA(0, 0), cA, vA0); PG8_STAGE(PG8_SA(0, 1), cA, vA1);
    if (wr == 1) PG8_BAR;
    PG8_WAIT_V(2); PG8_BAR;
    PG8_STAGE(PG8_SB(1, 0), cB + kstep, voffB); PG8_STAGE(PG8_SA(1, 0), cA + kstep, vA0); PG8_STAGE(PG8_SB(1, 1), cB + hstep + kstep, voffB);
    PG8_WAIT_V(6); PG8_BAR;
    for (;;) {
        const bool has_next = S.next(ui + 1, nxt);
        const char* nA = has_next ? S.a_base(nxt) : cA; const char* nB = has_next ? S.b_base(nxt) : cB;
#pragma unroll
        for (int i = 0; i < 2; ++i) { vN0[i] = has_next ? S.a_voff(nxt, Rr[i], Cc[i]) : vA0[i]; vN1[i] = has_next ? S.a_voff(nxt, HALF + Rr[i], Cc[i]) : vA1[i]; }
        for (int t = 0; t < nt; t += 2) {
            const bool last = (t == nt - 2);
            if constexpr (Sched::SYNC == 2) { if (last && has_next && wid == 0) flag_wait(S.flag + nxt.pm * 8, 4); }
            if constexpr (RSC) { if (t == 4) E.rowscale(acc, cur, wr, fr); }
            const char* a1 = cA + (size_t)(t + 1) * kstep;
            const char* a2 = last ? nA : cA + (size_t)(t + 2) * kstep; const char* b2 = last ? nB : cB + (size_t)(t + 2) * kstep;
            const char* a3 = a2 + kstep; const char* b3 = b2 + kstep;
            unsigned w0[2], w1[2];
#pragma unroll
            for (int i = 0; i < 2; ++i) { w0[i] = last ? vN0[i] : vA0[i]; w1[i] = last ? vN1[i] : vA1[i]; }
            PG8_LDB(B0, 0, 0); PG8_LDB(B1, 0, 1); PG8_SCHED; PG8_LDA(At, 0, 0); PG8_STAGE(PG8_SA(1, 1), a1, vA1);
            PG8_WAIT_V(8); PG8_WAIT_L(0); PG8_BAR; PG8_MMA(0, 0, At, B0); PG8_MMA(0, 1, At, B1); PG8_BAR; PG8_SCHED;
            PG8_LDA(At, 0, 1); PG8_STAGE(PG8_SB(0, 0), b2, voffB); PG8_STAGE(PG8_SB(0, 1), b2 + hstep, voffB); PG8_STAGE(PG8_SA(0, 0), a2, w0);
            PG8_WAIT_V(8); PG8_WAIT_L(0); PG8_BAR; PG8_MMA(1, 0, At, B0); PG8_MMA(1, 1, At, B1); PG8_BAR; PG8_SCHED;
            PG8_LDB(B0, 1, 0); PG8_LDB(B1, 1, 1); PG8_SCHED; PG8_LDA(At, 1, 0); PG8_STAGE(PG8_SA(0, 1), a2, w1);
            PG8_WAIT_V(8); PG8_WAIT_L(0); PG8_BAR; PG8_MMA(0, 0, At, B0); PG8_MMA(0, 1, At, B1); PG8_BAR; PG8_SCHED;
            PG8_LDA(At, 1, 1); PG8_STAGE(PG8_SB(1, 0), b3, voffB); PG8_STAGE(PG8_SB(1, 1), b3 + hstep, voffB); PG8_STAGE(PG8_SA(1, 0), a3, w0);
            PG8_WAIT_V(8); PG8_WAIT_L(0); PG8_BAR; PG8_MMA(1, 0, At, B0); PG8_MMA(1, 1, At, B1); PG8_BAR; PG8_SCHED;
        }
        if (wr == 0) PG8_BAR;
        E(acc, cur, wr, wc, fr, fq);
        if constexpr (Sched::SYNC == 1) { PG8_WAIT_V(0); PG8_BAR; if (tid == 0) __hip_atomic_fetch_add(S.flag + cur.pm * 8, 1, __ATOMIC_RELAXED, __HIP_MEMORY_SCOPE_AGENT); }
        if (!has_next) break;
#pragma unroll
        for (int a = 0; a < 2; ++a)
#pragma unroll
            for (int b = 0; b < 2; ++b)
#pragma unroll
                for (int m = 0; m < 4; ++m)
#pragma unroll
                    for (int n = 0; n < 2; ++n) acc[a][b][m][n] = (f32x4){0.f, 0.f, 0.f, 0.f};
        cur = nxt; cA = nA; cB = nB; ++ui;
#pragma unroll
        for (int i = 0; i < 2; ++i) { vA0[i] = vN0[i]; vA1[i] = vN1[i]; }
        if (wr == 1) PG8_BAR;
    }
    PG8_WAIT_V(0);
    PG8_BAR;
#undef PG8_SA
#undef PG8_SB
#undef PG8_STAGE
#undef PG8_LDA
#undef PG8_LDB
#undef PG8_MMA
#undef PG8_WAIT_V
#undef PG8_WAIT_L
#undef PG8_BAR
#undef PG8_SCHED
}
}
struct Args { const void* in[32]; float* out; unsigned char* ws; int l_lo, l_hi, ph_lo, ph_hi, fused, pad; };
enum { PH_PRO = 0, PH_NORM0 = 1, PH_G1 = 2, PH_MIX = 3, PH_A1 = 4, PH_A2 = 5, PH_AN = 6, PH_G2 = 7, PH_ROUTE = 8, PH_UP = 9, PH_DOWN = 10, PH_COMB = 11, PH_END = 12 };

typedef const Args __attribute__((address_space(4))) KArgs;
__device__ __forceinline__ KArgs* kargs() { KArgs* p = (KArgs*)__builtin_amdgcn_kernarg_segment_ptr(); asm volatile("" : "+s"(p)); return p; }
#define IN_F(i) ((const float*)ka->in[i])
enum { I_X = 0, I_C, I_POS, I_WADA, I_BADA, I_NORM1, I_WIN, I_QN, I_KN, I_CONVW, I_CONVB, I_CLNG, I_CLNB, I_PWW, I_PWB, I_POOLW, I_POOLB, I_POOLS, I_SLNG, I_SLNB, I_SGUW, I_SGUB,
       I_ONORM, I_WOUT, I_NORM2, I_WRG, I_BRG, I_WRE, I_BRE, I_WG, I_WU, I_WD };

__device__ __forceinline__ void sincos_d(double a, double& s, double& c) {
    const double k = rint(a * 0.63661977236758134308);
    const double r = (a - k * 1.57079632679489655800) - k * 6.123233995736766036e-17;
    const double r2 = r * r;
    const double sp = r * (1.0 + r2 * (-1.0 / 6 + r2 * (1.0 / 120 + r2 * (-1.0 / 5040 + r2 * (1.0 / 362880 + r2 * (-1.0 / 39916800 + r2 * (1.0 / 6227020800.0)))))));
    const double cp = 1.0 + r2 * (-0.5 + r2 * (1.0 / 24 + r2 * (-1.0 / 720 + r2 * (1.0 / 40320 + r2 * (-1.0 / 3628800 + r2 * (1.0 / 479001600.0 + r2 * (-1.0 / 87178291200.0)))))));
    const int q = ((int)k) & 3;
    if (q == 0) { s = sp; c = cp; } else if (q == 1) { s = cp; c = -sp; } else if (q == 2) { s = -sp; c = -cp; } else { s = -cp; c = sp; }
}

__device__ __forceinline__ bf16_t f2bf_(float f) { return (bf16_t)(cvt_pk_bf16(f, 0.f) & 0xffffu); }
struct TItem { const float* src; int ld; int ncol; bf16_t* dst; int ldd; const float* rsc; };
constexpr int NT_WIN = L * 36 * 4, NT_WOUT = L * 16 * 4, NT_PW = L * 4, NT_WGU = L * NE * 16 * 4, NT_WD = L * NE * 16 * 2;
constexpr int NT_ALL = NT_WIN + NT_WOUT + NT_PW + NT_WGU + NT_WD;
__device__ __forceinline__ void decode_titem(int it, const Args& a, TItem& t) {
    KArgs* ka = kargs();
    unsigned char* ws = ka->ws;
    t.rsc = nullptr;
    if (it < NT_WIN) {
        const int l = it / 144, r = it % 144, n0 = (r >> 2) * 64, k0 = (r & 3) * 256;
        const int c0 = n0 < 768 ? n0 + 256 : (n0 < 2048 ? n0 + 164 : n0 - 2048);
        t.ncol = (n0 < 768) ? ((n0 + 64 <= 676) ? 64 : (n0 < 676 ? 676 - n0 : 0)) : 64;
        t.src = IN_F(I_WIN) + ((size_t)l * D + k0) * DIN + c0; t.ld = DIN;
        t.dst = (bf16_t*)(ws + WS_WINT) + ((size_t)l * NP + n0) * D + k0; t.ldd = D; return;
    }
    it -= NT_WIN;
    if (it < NT_WOUT) {
        const int l = it / 64, r = it % 64, n0 = (r >> 2) * 64, k0 = (r & 3) * 256;
        t.ncol = 64; t.src = IN_F(I_WOUT) + ((size_t)l * D + k0) * D + n0; t.ld = D; t.rsc = (k0 == 0) ? IN_F(I_ONORM) + l * D : nullptr;
        t.dst = (bf16_t*)(ws + WS_WOUTT) + ((size_t)l * D + n0) * D + k0; t.ldd = D; return;
    }
    it -= NT_WOUT;
    if (it < NT_PW) {
        const int l = it / 4, n0 = (it & 3) * 64;
        t.ncol = 64; t.src = IN_F(I_PWW) + (size_t)l * 65536 + n0; t.ld = 256;
        t.dst = (bf16_t*)(ws + WS_PWT) + ((size_t)l * 256 + n0) * 256; t.ldd = 256; return;
    }
    it -= NT_PW;
    if (it < NT_WGU) {
        const int le = it / 64, r = it % 64, n0 = (r >> 2) * 64, k0 = (r & 3) * 256;
        const int pn = n0 >> 8, rr = n0 & 255;
        const float* W = (rr < 128) ? IN_F(I_WG) : IN_F(I_WU);
        t.ncol = 64; t.src = W + ((size_t)le * D + k0) * F + pn * 128 + (rr & 127); t.ld = F;
        t.dst = (bf16_t*)(ws + WS_WGUT) + ((size_t)le * 1024 + n0) * D + k0; t.ldd = D; return;
    }
    it -= NT_WGU;
    {
        const int le = it / 32, r = it % 32, n0 = (r >> 1) * 64, k0 = (r & 1) * 256;
        t.ncol = 64; t.src = IN_F(I_WD) + ((size_t)le * F + k0) * D + n0; t.ld = D;
        t.dst = (bf16_t*)(ws + WS_WDT) + ((size_t)le * D + n0) * F + k0; t.ldd = F;
    }
}
__device__ __forceinline__ void titem_load(const TItem& t, int tid, float4 (&v)[8]) {
    const int c4 = tid & 15, r0 = tid >> 4;
#pragma unroll
    for (int i = 0; i < 8; ++i) v[i] = (c4 * 4 < t.ncol) ? *(const float4*)(t.src + (size_t)(r0 + 32 * i) * t.ld + c4 * 4) : make_float4(0.f, 0.f, 0.f, 0.f);
    if (t.rsc) {
#pragma unroll
        for (int i = 0; i < 8; ++i) { const float s = t.rsc[r0 + 32 * i]; v[i].x *= s; v[i].y *= s; v[i].z *= s; v[i].w *= s; }
    }
}
__device__ __forceinline__ void phase_prologue(const Args& a, LAS unsigned char* lds, int vcu, int G) {
    KArgs* ka = kargs();
    const int tid = opaque_tid(), wid = __builtin_amdgcn_readfirstlane(tid >> 6), lane = tid & 63;
    LAS float* T = (LAS float*)lds;
    LAS float* cs = (LAS float*)(lds + 66560);
    LAS float* red = (LAS float*)(lds + 66560 + 16384);
    unsigned char* ws = ka->ws;
    if (vcu < 192) {
        { float cv[8];
#pragma unroll
          for (int i = 0; i < 8; ++i) cv[i] = IN_F(I_C)[tid + NTHR * i];
          __builtin_amdgcn_sched_barrier(0);
#pragma unroll
          for (int i = 0; i < 8; ++i) cs[tid + NTHR * i] = silu_f(cv[i]); }
        __syncthreads();
        for (int it = vcu; it < 192; it += G) {
            const int l = it / 96, j0 = (it % 96) * 64;
            const float* wp = IN_F(I_WADA) + ((size_t)l * D + wid * 128) * 6144 + j0 + lane;
            float a0 = 0.f, a1 = 0.f, a2 = 0.f, a3 = 0.f;
#pragma unroll 32
            for (int k = 0; k < 128; ++k) { const float wv = wp[(size_t)k * 6144]; const int kk = wid * 128 + k; a0 += cs[kk] * wv; a1 += cs[1024 + kk] * wv; a2 += cs[2048 + kk] * wv; a3 += cs[3072 + kk] * wv; }
            red[(wid * 4 + 0) * 64 + lane] = a0; red[(wid * 4 + 1) * 64 + lane] = a1; red[(wid * 4 + 2) * 64 + lane] = a2; red[(wid * 4 + 3) * 64 + lane] = a3;
            __syncthreads();
            if (wid < 4) { float s = 0.f;
#pragma unroll
                for (int w = 0; w < 8; ++w) s += red[(w * 4 + wid) * 64 + lane];
                ((float*)(ws + WS_MOD))[((size_t)l * 4 + wid) * 6144 + j0 + lane] = s + IN_F(I_BADA)[l * 6144 + j0 + lane]; }
            __syncthreads();
        }
    }
    if (vcu == G - 1 && tid < L) {
        const float* qg = IN_F(I_QN) + tid * 64; const float* kg = IN_F(I_KN) + tid * 64;
        float gq = 0.f, gk = 0.f;
        for (int i = 0; i < 64; ++i) { gq = fmaxf(gq, fabsf(qg[i])); gk = fmaxf(gk, fabsf(kg[i])); }
        ((float*)(ws + WS_FLAG + 14336))[tid] = 8.0f * gq * gk * 1.4426950408889634f;
    }
    for (int i = vcu * NTHR + tid; i < NTOK; i += G * NTHR) {
        const float invA[8] = {1.0f, 0.1939227432012558f, 0.03760603070259094f, 0.007292664609849453f, 0.0014142135623842478f, 0.00027424818836152554f, 5.318296098266728e-05f, 1.0313386155758053e-05f};
        const float invI[4] = {1.0f, 0.03760603070259094f, 0.0014142135623842478f, 5.318296098266728e-05f};
        const float p = (float)((const int*)ka->in[I_POS])[i];
        float* ra = (float*)(ws + WS_ROPEA) + (size_t)i * 16; float* ri = (float*)(ws + WS_ROPEI) + (size_t)i * 8;
#pragma unroll
        for (int j = 0; j < 8; ++j) { const float ang = p * invA[j]; double s, c; sincos_d((double)ang, s, c); ra[j] = (float)c; ra[8 + j] = (float)s; }
#pragma unroll
        for (int j = 0; j < 4; ++j) { const float ang = p * invI[j]; double s, c; sincos_d((double)ang, s, c); ri[j] = (float)c; ri[4 + j] = (float)s; }
    }
    for (int i = vcu * NTHR + tid; i < L * 4 * 128 * 128; i += G * NTHR) { const int s = i & 127, t = (i >> 7) & 127; ((bf16_t*)(ws + WS_SGUW))[i] = (bf16_t)(cvt_pk_bf16(s <= t ? IN_F(I_SGUW)[i] : 0.f, 0.f) & 0xffffu); }
    for (int i = vcu * NTHR + tid; i < L * 4 * 64 * 64; i += G * NTHR) { const int c = i & 63, d = (i >> 6) & 63, lg = i >> 12; ((bf16_t*)(ws + WS_POOLT))[i] = (bf16_t)(cvt_pk_bf16(IN_F(I_POOLW)[((size_t)lg * 64 + c) * 64 + d], 0.f) & 0xffffu); }
    for (int i = vcu * NTHR + tid; i < L * 48 * 1024; i += G * NTHR) {
        const int k = i & 1023, n = (i >> 10) % 48, lg = i / (48 * 1024);
        const float w = (n < 4) ? IN_F(I_WRG)[((size_t)lg * D + k) * 4 + n] : (n < 36) ? IN_F(I_WRE)[((size_t)lg * D + k) * 32 + (n - 4)] : 0.f;
        const unsigned hi = cvt_pk_bf16(w, 0.f) & 0xffffu; const float lo = w - __uint_as_float(hi << 16);
        bf16_t* dst = (bf16_t*)(ws + WS_WHL) + (size_t)lg * 2 * 48 * 1024 + (size_t)n * 1024 + k;
        dst[0] = (bf16_t)hi; dst[48 * 1024] = f2bf_(lo);
    }
    int* qctr = (int*)(ws + WS_FLAG + 12288);
    LAS int* qn = (LAS int*)(lds + LDS_MISC + 512);
    int pend = 0;
    if (tid == 0) { qn[0] = __hip_atomic_fetch_add(qctr, 1, __ATOMIC_RELAXED, __HIP_MEMORY_SCOPE_AGENT); pend = __hip_atomic_fetch_add(qctr, 1, __ATOMIC_RELAXED, __HIP_MEMORY_SCOPE_AGENT); }
    __syncthreads();
    int it = qn[0];
    bool have = it < NT_ALL;
    TItem cur; cur.src = nullptr; cur.ld = 0; cur.ncol = 0; cur.dst = nullptr; cur.ldd = 0; cur.rsc = nullptr;
    float4 v[8];
    if (have) { decode_titem(it, a, cur); titem_load(cur, tid, v); }
    int par = 1;
    while (have) {
        { const int c4 = tid & 15, r0 = tid >> 4;
#pragma unroll
          for (int i = 0; i < 8; ++i) { LAS float* tp = T + (r0 + 32 * i) * 65 + c4 * 4; tp[0] = v[i].x; tp[1] = v[i].y; tp[2] = v[i].z; tp[3] = v[i].w; } }
        if (tid == 0) qn[par] = pend;
        __syncthreads();
        const int itn = qn[par]; const bool hn = itn < NT_ALL; TItem nx = cur;
        if (tid == 0 && hn) pend = __hip_atomic_fetch_add(qctr, 1, __ATOMIC_RELAXED, __HIP_MEMORY_SCOPE_AGENT);
        if (hn) { decode_titem(itn, a, nx); titem_load(nx, tid, v); }
        { const int n = tid >> 3, kq = tid & 7;
#pragma unroll
          for (int j = 0; j < 4; ++j) { const int kc = j * 8 + kq; float f[8];
#pragma unroll
              for (int jj = 0; jj < 8; ++jj) f[jj] = T[(kc * 8 + jj) * 65 + n];
              u32x4 w; w.x = cvt_pk_bf16(f[0], f[1]); w.y = cvt_pk_bf16(f[2], f[3]); w.z = cvt_pk_bf16(f[4], f[5]); w.w = cvt_pk_bf16(f[6], f[7]);
              *(u32x4*)(cur.dst + (size_t)n * cur.ldd + kc * 8) = w; } }
        __syncthreads();
        cur = nx; it = itn; have = hn; par ^= 1;
    }
}

__device__ __forceinline__ void phase_norm(const float* __restrict__ xin, const float* g, const float* shift, const float* scale, bf16_t* __restrict__ out, int vcu, int G, const bool gb, const XcdBarrier bar) {
    const int tid = opaque_tid(), wid = __builtin_amdgcn_readfirstlane(tid >> 6), lane = tid & 63;
    const bool inl = gb && (G * 64 == NTOK);
    if (gb && !inl) xcd_barrier(bar);
    for (int rb = vcu * 8 + wid; rb < NTOK / 8; rb += G * 8) {
        const int row0 = rb * 8, b = row0 / S;
        float4 A[4], C[4], gvv[4], scv[4], xr0[4][4];
        auto pf = [&]() {
#pragma unroll
            for (int i = 0; i < 4; ++i) gvv[i] = *(const float4*)(g + 256 * i + 4 * lane);
#pragma unroll
            for (int r4 = 0; r4 < 4; ++r4)
#pragma unroll
                for (int i = 0; i < 4; ++i) xr0[r4][i] = *(const float4*)(xin + (size_t)(row0 + r4) * D + 256 * i + 4 * lane);
        };
        if (inl) xcd_barrier_work(bar, pf); else pf();
#pragma unroll
        for (int i = 0; i < 4; ++i) { const int k = 256 * i + 4 * lane; scv[i] = *(const float4*)(scale + (size_t)b * 6144 + k); C[i] = *(const float4*)(shift + (size_t)b * 6144 + k); }
        __builtin_amdgcn_sched_barrier(0);
#pragma unroll
        for (int i = 0; i < 4; ++i) { const float4 gv = gvv[i], sc = scv[i]; A[i] = make_float4(gv.x * (1.f + sc.x), gv.y * (1.f + sc.y), gv.z * (1.f + sc.z), gv.w * (1.f + sc.w)); }
#pragma unroll
        for (int hb = 0; hb < 2; ++hb) {
        float4 xr[4][4];
#pragma unroll
        for (int r4 = 0; r4 < 4; ++r4)
#pragma unroll
            for (int i = 0; i < 4; ++i) { if (hb == 0) xr[r4][i] = xr0[r4][i]; else xr[r4][i] = *(const float4*)(xin + (size_t)(row0 + 4 * hb + r4) * D + 256 * i + 4 * lane); }
        __builtin_amdgcn_sched_barrier(0);
#pragma unroll
        for (int r4 = 0; r4 < 4; ++r4) {
            const int rr = 4 * hb + r4;
            const size_t ro = (size_t)(row0 + rr) * D;
            float4 x[4]; float ss = 0.f;
#pragma unroll
            for (int i = 0; i < 4; ++i) { x[i] = xr[r4][i]; ss += x[i].x * x[i].x + x[i].y * x[i].y + x[i].z * x[i].z + x[i].w * x[i].w; }
            const float r = rsqrtf(wave_sum(ss) * (1.0f / D) + EPS);
#pragma unroll
            for (int i = 0; i < 4; ++i) { u32x2 w; w.x = cvt_pk_bf16(x[i].x * r * A[i].x + C[i].x, x[i].y * r * A[i].y + C[i].y); w.y = cvt_pk_bf16(x[i].z * r * A[i].z + C[i].z, x[i].w * r * A[i].w + C[i].w);
                *(u32x2*)(out + ro + 256 * i + 4 * lane) = w; }
        }
        }
    }
}

__device__ __forceinline__ f32x4 mfma16r(const bf16x8 a, const bf16x8 b, const f32x4 c) { return __builtin_amdgcn_mfma_f32_16x16x32_bf16(a, b, c, 0, 0, 0); }
__device__ __forceinline__ void phase_rbias(const Args& a, LAS unsigned char* lds, int vcu, int G) {
    KArgs* ka = kargs();
    const int tid = opaque_tid();
    LAS float* red = (LAS float*)lds;
    for (int v = vcu; v < 256; v += G) {
        const int lb = v & 7, sl = v >> 3, l = lb >> 2, b = lb & 3, n = tid & 63, kp = tid >> 6;
        const float* sh = (const float*)(ka->ws + WS_MOD) + ((size_t)l * 4 + b) * 6144 + 3072;
        float s = 0.f;
        if (n < 36) {
#pragma unroll
            for (int i = 0; i < 4; ++i) { const int k = sl * 32 + kp * 4 + i; s += sh[k] * ((n < 4) ? IN_F(I_WRG)[((size_t)l * D + k) * 4 + n] : IN_F(I_WRE)[((size_t)l * D + k) * 32 + (n - 4)]); }
        }
        red[kp * 64 + n] = s;
        __syncthreads();
        if (tid < 48) { float t = 0.f;
            if (tid < 36) { for (int w = 0; w < 8; ++w) t += red[w * 64 + tid]; }
            ((float*)(ka->ws + WS_RBIAS))[((size_t)lb * 32 + sl) * 48 + tid] = t; }
        __syncthreads();
    }
}

__device__ __forceinline__ void phase_route(const Args& a, int l, LAS unsigned char* lds, int vcu, int G, const bool gb, const XcdBarrier bar) {
    KArgs* ka = kargs();
    const int tid = opaque_tid(), wid = __builtin_amdgcn_readfirstlane(tid >> 6), lane = tid & 63, fr = lane & 15, kq = lane >> 4;
    unsigned char* ws = ka->ws;
    const bf16_t* x1 = (const bf16_t*)(ws + WS_X1);
    const float* mod = (const float*)(ws + WS_MOD) + (size_t)l * 4 * 6144;
    const float* g = IN_F(I_NORM2) + l * D; const float* shift = mod + 3072; const float* scale = mod + 4096;
    bf16_t* out = (bf16_t*)(ws + WS_HA);
    int* counts = (int*)(ws + WS_CNT) + l * NE * 64; int* list = (int*)(ws + WS_LIST); float* lgate = (float*)(ws + WS_LGATE); int* tokinfo = (int*)(ws + WS_TOKINFO);
    LAS int* lcnt = (LAS int*)(lds + LDS_MISC + 1024); LAS int* lbase = lcnt + 32; LAS int* rte = lbase + 32; LAS int* rtp = rte + 128; LAS int* rtt = rtp + 128; LAS float* rtg = (LAS float*)(rtt + 128);
    LAS float* part = (LAS float*)lds;
    LAS float* ssp = part + 8 * 64 * 48;
    LAS float* lgt = ssp + 8 * 64;
    LAS float* rrow = lgt + 64 * 48;
    const bf16_t* wh = (const bf16_t*)(ws + WS_WHL) + (size_t)l * 2 * 48 * 1024 + (size_t)fr * 1024 + 128 * wid + 8 * kq;
    LAS float* rb = (LAS float*)(lds + LDS_MISC + 8192);
    const bool inl = gb && (G * 64 == NTOK);
    if (gb && !inl) xcd_barrier(bar);
    for (int r0 = vcu * 64; r0 < NTOK; r0 += G * 64) {
        const int b = r0 / S;
        f32x4 gl[4][2], sl[4][2];
        auto pf = [&]() {
            if (tid < 48) { const float* rp = (const float*)(ws + WS_RBIAS) + ((size_t)(l * 4 + b) * 32) * 48 + tid; float t = 0.f;
                float pv[32];
#pragma unroll
                for (int s_ = 0; s_ < 32; ++s_) pv[s_] = rp[s_ * 48];
                __builtin_amdgcn_sched_barrier(0);
#pragma unroll
                for (int s_ = 0; s_ < 32; ++s_) t += pv[s_];
                if (tid < 36) t += (tid < 4) ? IN_F(I_BRG)[l * 4 + tid] : IN_F(I_BRE)[l * 32 + tid - 4];
                rb[tid] = t; }
            if (tid < 32) lcnt[tid] = 0;
#pragma unroll
            for (int ks = 0; ks < 4; ++ks) {
                const int k0 = 128 * wid + 32 * ks + 8 * kq;
                gl[ks][0] = *(const f32x4*)(g + k0); gl[ks][1] = *(const f32x4*)(g + k0 + 4); sl[ks][0] = *(const f32x4*)(scale + (size_t)b * 6144 + k0); sl[ks][1] = *(const f32x4*)(scale + (size_t)b * 6144 + k0 + 4);
            }
        };
        auto load_ac = [&](float (&Ac)[4][8]) {
#pragma unroll
            for (int ks = 0; ks < 4; ++ks)
#pragma unroll
                for (int j = 0; j < 8; ++j) Ac[ks][j] = gl[ks][j >> 2][j & 3] * (1.f + sl[ks][j >> 2][j & 3]);
        };
        {
            bf16x8 Bhf[4][3], Blf[4][3];
            auto pfw = [&]() {
                pf();
                __builtin_amdgcn_sched_barrier(0);
                float Ac[4][8]; load_ac(Ac);
#pragma unroll
                for (int ks = 0; ks < 4; ++ks)
#pragma unroll
                    for (int nt = 0; nt < 3; ++nt) {
                        const u32x4 bh = *(const u32x4*)(wh + (size_t)(16 * nt) * 1024 + 32 * ks), bl = *(const u32x4*)(wh + 48 * 1024 + (size_t)(16 * nt) * 1024 + 32 * ks);
                        const float w[8] = {(bflo(bh.x) + bflo(bl.x)) * Ac[ks][0], (bfhi(bh.x) + bfhi(bl.x)) * Ac[ks][1], (bflo(bh.y) + bflo(bl.y)) * Ac[ks][2], (bfhi(bh.y) + bfhi(bl.y)) * Ac[ks][3],
                                            (bflo(bh.z) + bflo(bl.z)) * Ac[ks][4], (bfhi(bh.z) + bfhi(bl.z)) * Ac[ks][5], (bflo(bh.w) + bflo(bl.w)) * Ac[ks][6], (bfhi(bh.w) + bfhi(bl.w)) * Ac[ks][7]};
                        unsigned ph[4], pl[4];
#pragma unroll
                        for (int j = 0; j < 4; ++j) { ph[j] = cvt_pk_bf16(w[2 * j], w[2 * j + 1]); pl[j] = cvt_pk_bf16(w[2 * j] - bflo(ph[j]), w[2 * j + 1] - bfhi(ph[j])); }
                        Bhf[ks][nt] = __builtin_bit_cast(bf16x8, (u32x4){ph[0], ph[1], ph[2], ph[3]}); Blf[ks][nt] = __builtin_bit_cast(bf16x8, (u32x4){pl[0], pl[1], pl[2], pl[3]});
                    }
            };
            if (inl) xcd_barrier_work(bar, pfw); else pfw();
            u32x4 xq[4], xn[4];
#pragma unroll
            for (int ks = 0; ks < 4; ++ks) { xq[ks] = *(const u32x4*)(x1 + (size_t)(r0 + fr) * D + 128 * wid + 32 * ks + 8 * kq); xn[ks] = xq[ks]; }
#pragma unroll 1
            for (int q4 = 0; q4 < 4; ++q4) {
                f32x4 acc[3];
#pragma unroll
                for (int nt = 0; nt < 3; ++nt) acc[nt] = (f32x4){0.f, 0.f, 0.f, 0.f};
                float ss = 0.f;
                if (q4 < 3) {
#pragma unroll
                    for (int ks = 0; ks < 4; ++ks) xn[ks] = *(const u32x4*)(x1 + (size_t)(r0 + 16 * (q4 + 1) + fr) * D + 128 * wid + 32 * ks + 8 * kq);
                }
                __builtin_amdgcn_sched_barrier(0);
#pragma unroll
                for (int ks = 0; ks < 4; ++ks) {
                    const u32x4 xw = xq[ks];
                    const float v[8] = {bflo(xw.x), bfhi(xw.x), bflo(xw.y), bfhi(xw.y), bflo(xw.z), bfhi(xw.z), bflo(xw.w), bfhi(xw.w)};
#pragma unroll
                    for (int j = 0; j < 8; ++j) ss += v[j] * v[j];
                    const bf16x8 Ax = __builtin_bit_cast(bf16x8, xw);
#pragma unroll
                    for (int nt = 0; nt < 3; ++nt) { acc[nt] = mfma16r(Ax, Bhf[ks][nt], acc[nt]); acc[nt] = mfma16r(Ax, Blf[ks][nt], acc[nt]); }
                }
                ss += __shfl_xor(ss, 16); ss += __shfl_xor(ss, 32);
                if (kq == 0) ssp[wid * 64 + 16 * q4 + fr] = ss;
#pragma unroll
                for (int nt = 0; nt < 3; ++nt)
#pragma unroll
                    for (int r = 0; r < 4; ++r) part[(wid * 64 + 16 * q4 + 4 * kq + r) * 48 + 16 * nt + fr] = acc[nt][r];
#pragma unroll
                for (int ks = 0; ks < 4; ++ks) xq[ks] = xn[ks];
            }
        }
        __syncthreads();
        for (int i = tid; i < 64 * 48; i += NTHR) { float s = 0.f;
#pragma unroll
            for (int w = 0; w < 8; ++w) s += part[w * 64 * 48 + i];
            lgt[i] = s; }
        if (tid < 64) { float s = 0.f;
#pragma unroll
            for (int w = 0; w < 8; ++w) s += ssp[w * 64 + tid];
            rrow[tid] = rsqrtf(s * (1.0f / D) + EPS); }
        __syncthreads();
        {
            f32x4 gq_[2][2], sq_[2][2], cq_[2][2];
#pragma unroll
            for (int hs = 0; hs < 2; ++hs) { const int c0 = 8 * (lane + 64 * hs);
#pragma unroll
                for (int e = 0; e < 2; ++e) { gq_[hs][e] = *(const f32x4*)(g + c0 + 4 * e); sq_[hs][e] = *(const f32x4*)(scale + (size_t)b * 6144 + c0 + 4 * e); cq_[hs][e] = *(const f32x4*)(shift + (size_t)b * 6144 + c0 + 4 * e); } }
            u32x4 xv[16];
#pragma unroll
            for (int i = 0; i < 16; ++i) xv[i] = *(const u32x4*)(x1 + (size_t)(r0 + 8 * wid + (i >> 1)) * D + 8 * (lane + 64 * (i & 1)));
            __builtin_amdgcn_sched_barrier(0);
            float Aq[2][8];
#pragma unroll
            for (int hs = 0; hs < 2; ++hs)
#pragma unroll
                for (int j = 0; j < 8; ++j) Aq[hs][j] = gq_[hs][j >> 2][j & 3] * (1.f + sq_[hs][j >> 2][j & 3]);
#pragma unroll
            for (int i = 0; i < 16; ++i) {
                const int hs = i & 1; const float r = rrow[8 * wid + (i >> 1)];
                const u32x4 xw = xv[i]; const f32x4 c0 = cq_[hs][0], c1 = cq_[hs][1];
                u32x4 w;
                w.x = cvt_pk_bf16(bflo(xw.x) * Aq[hs][0] * r + c0[0], bfhi(xw.x) * Aq[hs][1] * r + c0[1]); w.y = cvt_pk_bf16(bflo(xw.y) * Aq[hs][2] * r + c0[2], bfhi(xw.y) * Aq[hs][3] * r + c0[3]);
                w.z = cvt_pk_bf16(bflo(xw.z) * Aq[hs][4] * r + c1[0], bfhi(xw.z) * Aq[hs][5] * r + c1[1]); w.w = cvt_pk_bf16(bflo(xw.w) * Aq[hs][6] * r + c1[2], bfhi(xw.w) * Aq[hs][7] * r + c1[3]);
                *(u32x4*)(out + (size_t)(r0 + 8 * wid + (i >> 1)) * D + 8 * (lane + 64 * hs)) = w;
            }
        }
        if (const int tr = opaque_tid(); tr < 64) {
            const int tid = tr; const int tok = r0 + tid; const float r = rrow[tid];
            float ag[4];
#pragma unroll
            for (int j = 0; j < 4; ++j) ag[j] = r * lgt[tid * 48 + j] + rb[j];
            int gi = 0; float gm = ag[0];
#pragma unroll
            for (int j = 1; j < 4; ++j) if (ag[j] > gm) { gm = ag[j]; gi = j; }
            float den = 0.f;
#pragma unroll
            for (int j = 0; j < 4; ++j) den += expf(ag[j] - gm);
            const float p_sel = 1.0f / den;
            float el[8];
#pragma unroll
            for (int j = 0; j < 8; ++j) el[j] = r * lgt[tid * 48 + 4 + gi * 8 + j] + rb[4 + gi * 8 + j];
            int j0 = 0; float v0 = el[0];
#pragma unroll
            for (int j = 1; j < 8; ++j) if (el[j] > v0) { v0 = el[j]; j0 = j; }
            int j1 = 0; float v1 = -INFINITY;
#pragma unroll
            for (int j = 0; j < 8; ++j) if (j != j0 && el[j] > v1) { v1 = el[j]; j1 = j; }
            const float e1 = expf(v1 - v0);
            const float g0 = p_sel / (1.0f + e1), g1 = p_sel * e1 / (1.0f + e1);
            const int ex0 = gi * 8 + j0, ex1 = gi * 8 + j1, ai = tid * 2;
            const int p0 = __hip_atomic_fetch_add(lcnt + ex0, 1, __ATOMIC_RELAXED, __HIP_MEMORY_SCOPE_WORKGROUP), p1 = __hip_atomic_fetch_add(lcnt + ex1, 1, __ATOMIC_RELAXED, __HIP_MEMORY_SCOPE_WORKGROUP);
            rte[ai] = ex0; rtp[ai] = p0; rtt[ai] = tok; rtg[ai] = g0;
            rte[ai + 1] = ex1; rtp[ai + 1] = p1; rtt[ai + 1] = tok; rtg[ai + 1] = g1;
        }
        __syncthreads();
        if (tid < 32) { const int c = lcnt[tid]; lbase[tid] = c ? atomicAdd(&counts[tid * 64], c) : 0; }
        __syncthreads();
        if (tid < 128) { const int e = rte[tid], pos = lbase[e] + rtp[tid], tk = rtt[tid];
            list[(size_t)e * NTOK + pos] = tk; lgate[(size_t)e * NTOK + pos] = rtg[tid];
            tokinfo[tk * 4 + (tid & 1) * 2] = e; tokinfo[tk * 4 + (tid & 1) * 2 + 1] = pos; }
        __syncthreads();
    }
}

__device__ __forceinline__ void moe_cum(const Args& a, int l, LAS unsigned char* lds) {
    KArgs* ka = kargs();
    LAS int* cum = (LAS int*)(lds + LDS_MISC + MISC_CUM); LAS int* cn = (LAS int*)(lds + LDS_MISC + MISC_CNT);
    const int* counts = (const int*)(ka->ws + WS_CNT) + l * NE * 64;
    const int tq = opaque_tid();
    if (tq < 64) {
        const int c = (tq < 32) ? ld_agent(counts + tq * 64) : 0;
        int inc = (c + 255) >> 8;
#pragma unroll
        for (int d = 1; d < 32; d <<= 1) { const int v = __shfl_up(inc, d, 64); if (tq >= d) inc += v; }
        if (tq < 32) { cn[tq] = c; cum[tq + 1] = inc; }
        if (tq == 0) cum[0] = 0;
    }
    __syncthreads();
}

__device__ __forceinline__ void phase_combine(const Args& a, int l, LAS unsigned char* lds, int vcu, int G, const bool gb, const XcdBarrier bar) {
    KArgs* ka = kargs();
    const int tid = opaque_tid(), wid = __builtin_amdgcn_readfirstlane(tid >> 6), lane = tid & 63;
    unsigned char* ws = ka->ws;
    const bool inl = gb && (G * 64 == NTOK);
    if (gb && !inl) xcd_barrier(bar);
    if (!inl) moe_cum(a, l, lds);
    const LAS int* cum = (const LAS int*)(lds + LDS_MISC + MISC_CUM);
    const bf16_t* __restrict__ x1 = (const bf16_t*)(ws + WS_X1);
    bf16_t* __restrict__ xnext = (bf16_t*)(ws + WS_X1) + (size_t)NTOK * D;
    const float* mod = (const float*)(ws + WS_MOD) + (size_t)l * 4 * 6144;
    const float* gate2 = mod + 5120;
    const bf16_t* __restrict__ Y = (const bf16_t*)(ws + WS_Y);
    const int* __restrict__ tokinfo = (const int*)(ws + WS_TOKINFO);
    float* __restrict__ outp = ka->out;
    const bool nextl = (l + 1 < L);
    const float* modn = (const float*)(ws + WS_MOD) + (size_t)(nextl ? l + 1 : l) * 4 * 6144;
    const float* gn = IN_F(I_NORM1) + (nextl ? l + 1 : l) * D;
    bf16_t* __restrict__ hout = (bf16_t*)(ws + WS_HA);
    for (int rb = vcu * 8 + wid; rb < NTOK / 8; rb += G * 8) {
        const int row0 = rb * 8, b = row0 / S;
        float4 A[4], C[4], G2[4], gvv[4], scv[4];
        int4 ti[8]; u32x2 xr0[4][4];
        auto pf = [&]() {
#pragma unroll
            for (int i = 0; i < 4; ++i) { const int k = 256 * i + 4 * lane; gvv[i] = *(const float4*)(gn + k); scv[i] = *(const float4*)(modn + 1024 + (size_t)b * 6144 + k); C[i] = *(const float4*)(modn + (size_t)b * 6144 + k);
                G2[i] = *(const float4*)(gate2 + (size_t)b * 6144 + k); }
#pragma unroll
            for (int rr = 0; rr < 8; ++rr) ti[rr] = *(const int4*)(tokinfo + (row0 + rr) * 4);
#pragma unroll
            for (int r4 = 0; r4 < 4; ++r4)
#pragma unroll
                for (int i = 0; i < 4; ++i) xr0[r4][i] = *(const u32x2*)(x1 + (size_t)(row0 + r4) * D + 256 * i + 4 * lane);
        };
        if (inl) xcd_barrier_work(bar, pf); else pf();
        __builtin_amdgcn_sched_barrier(0);
#pragma unroll
        for (int i = 0; i < 4; ++i) { const float4 gv = gvv[i], sc = scv[i]; A[i] = make_float4(gv.x * (1.f + sc.x), gv.y * (1.f + sc.y), gv.z * (1.f + sc.z), gv.w * (1.f + sc.w)); }
#pragma unroll
        for (int hb = 0; hb < 2; ++hb) {
            u32x2 xr[4][4], y0r[4][4], y1r[4][4];
#pragma unroll
            for (int r4 = 0; r4 < 4; ++r4) {
                const int rr = 4 * hb + r4; const size_t ro = (size_t)(row0 + rr) * D;
                const size_t s0 = (size_t)(cum[ti[rr].x] * 256 + ti[rr].y) * D, s1 = (size_t)(cum[ti[rr].z] * 256 + ti[rr].w) * D;
#pragma unroll
                for (int i = 0; i < 4; ++i) { const int k = 256 * i + 4 * lane; if (hb == 0) xr[r4][i] = xr0[r4][i]; else xr[r4][i] = *(const u32x2*)(x1 + ro + k); y0r[r4][i] = *(const u32x2*)(Y + s0 + k); y1r[r4][i] = *(const u32x2*)(Y + s1 + k); }
            }
            __builtin_amdgcn_sched_barrier(0);
#pragma unroll
            for (int r4 = 0; r4 < 4; ++r4) {
                const int rr = 4 * hb + r4; const size_t ro = (size_t)(row0 + rr) * D;
                float4 xo[4]; float ss = 0.f;
#pragma unroll
                for (int i = 0; i < 4; ++i) { const int k = 256 * i + 4 * lane; const u32x2 xw = xr[r4][i]; const float4 xv = make_float4(bflo(xw.x), bfhi(xw.x), bflo(xw.y), bfhi(xw.y)); const u32x2 y0 = y0r[r4][i], y1 = y1r[r4][i];
                    xo[i].x = xv.x + G2[i].x * (bflo(y0.x) + bflo(y1.x)); xo[i].y = xv.y + G2[i].y * (bfhi(y0.x) + bfhi(y1.x)); xo[i].z = xv.z + G2[i].z * (bflo(y0.y) + bflo(y1.y)); xo[i].w = xv.w + G2[i].w * (bfhi(y0.y) + bfhi(y1.y));
                    if (nextl) { u32x2 xb; xb.x = cvt_pk_bf16(xo[i].x, xo[i].y); xb.y = cvt_pk_bf16(xo[i].z, xo[i].w); *(u32x2*)(xnext + ro + k) = xb; } else *(float4*)(outp + ro + k) = xo[i];
                    ss += xo[i].x * xo[i].x + xo[i].y * xo[i].y + xo[i].z * xo[i].z + xo[i].w * xo[i].w; }
                if (nextl) {
                    const float r = rsqrtf(wave_sum(ss) * (1.0f / D) + EPS);
#pragma unroll
                    for (int i = 0; i < 4; ++i) { u32x2 w; w.x = cvt_pk_bf16(xo[i].x * r * A[i].x + C[i].x, xo[i].y * r * A[i].y + C[i].y); w.y = cvt_pk_bf16(xo[i].z * r * A[i].z + C[i].z, xo[i].w * r * A[i].w + C[i].w);
                        *(u32x2*)(hout + ro + 256 * i + 4 * lane) = w; }
                }
            }
        }
    }
}
constexpr size_t WS_KN = WS_R2;
constexpr size_t WS_VT = WS_KN + al256c((size_t)NTOK * 256 * 2);
constexpr size_t WS_IKR = WS_VT + al256c((size_t)NTOK * 256 * 2);
constexpr size_t WS_MASK = WS_IKR + al256c((size_t)NTOK * 32 * 2);
constexpr size_t WS_OA = WS_MASK + al256c((size_t)NTOK * 128 * 4);
constexpr size_t WS_R3 = WS_OA + al256c((size_t)NTOK * 256 * 2);
constexpr size_t WS_MIXB = (WS_R3 > WS_Y + (size_t)SLOTS * D * 2 ? WS_R3 : WS_Y + al256c((size_t)SLOTS * D * 2));

__device__ __forceinline__ f32x4 mfma16(const bf16x8 a, const bf16x8 b, const f32x4 c) { return __builtin_amdgcn_mfma_f32_16x16x32_bf16(a, b, c, 0, 0, 0); }
__device__ __forceinline__ bf16_t f2bf(float f) { return (bf16_t)(cvt_pk_bf16(f, 0.f) & 0xffffu); }

__device__ __forceinline__ void rows_rms_store(const LAS float* YB, const f32x4 gv, bf16_t* mixb, int tok0, int col0, int wid, int lane) {
#pragma unroll
    for (int rr = 0; rr < 8; ++rr) {
        const int t = 8 * wid + rr;
        const f32x4 y = *(const LAS f32x4*)(YB + t * 260 + 4 * lane);
        const float ss = wave_sum(y[0] * y[0] + y[1] * y[1] + y[2] * y[2] + y[3] * y[3]);
        const float r = rsqrtf(ss * (1.0f / 256.0f) + EPS);
        u32x2 w; w.x = cvt_pk_bf16(y[0] * r * gv[0], y[1] * r * gv[1]); w.y = cvt_pk_bf16(y[2] * r * gv[2], y[3] * r * gv[3]);
        *(u32x2*)(mixb + (size_t)(tok0 + t) * D + col0 + 4 * lane) = w;
    }
}

template <int W>
__device__ __forceinline__ void pool_runs(const LAS bf16_t* P, LAS bf16_t* PA, int c, int tt0, int t0) {
    float pv[32 + W - 1];
#pragma unroll
    for (int i = 0; i < 32 + W - 1; ++i) pv[i] = bf2f(P[(15 + tt0 - (W - 1) + i) * 256 + c]);
    __builtin_amdgcn_sched_barrier(0);
    float run = 0.f;
#pragma unroll
    for (int jj = 0; jj < W - 1; ++jj) run += pv[jj];
#pragma unroll
    for (int i = 0; i < 32; ++i) {
        const float x = pv[W - 1 + i];
        run += x;
        const int tabs = t0 + tt0 + i;
        const float rinv = (tabs + 1 < W) ? __builtin_amdgcn_rcpf((float)(tabs + 1)) : (1.0f / W);
        PA[(tt0 + i) * 264 + c] = f2bf(run * rinv - x);
        run -= pv[i];
    }
}

__device__ __forceinline__ void item_pool(const Args& a, int l, int tile, LAS unsigned char* lds) {
    KArgs* ka = kargs();
    const int tid = opaque_tid(), wid = __builtin_amdgcn_readfirstlane(tid >> 6), lane = tid & 63;
    unsigned char* ws = ka->ws;
    const bf16_t* proj = (const bf16_t*)(ws + WS_PROJ);
    LAS bf16_t* P = (LAS bf16_t*)lds;
    LAS bf16_t* PA = (LAS bf16_t*)(lds + 40960);
    LAS float* YB = (LAS float*)(lds + 40960 + 33792);
    const int tok0 = tile * 64, b = tok0 / S, t0 = tok0 % S;
    bf16x8 PTf[2][4]; float pbv[4], psv[4];
    const f32x4 ogv = *(const f32x4*)(IN_F(I_ONORM) + l * D + 512 + 4 * lane);
    {
        const int g_ = wid >> 1, fr_ = lane & 15, fq_ = lane >> 4;
        const bf16_t* PT = (const bf16_t*)(ws + WS_POOLT) + (size_t)(l * 4 + g_) * 64 * 64;
        const float* pb = IN_F(I_POOLB) + l * 256; const float* ps = IN_F(I_POOLS) + l * 256;
#pragma unroll
        for (int ni = 0; ni < 4; ++ni) { pbv[ni] = pb[g_ * 64 + 16 * ni + fr_]; psv[ni] = ps[g_ * 64 + 16 * ni + fr_];
#pragma unroll
            for (int ks = 0; ks < 2; ++ks) PTf[ks][ni] = *(const bf16x8*)(PT + (16 * ni + fr_) * 64 + 32 * ks + 8 * fq_); }
    }
    {
        u32x4 pv[5];
#pragma unroll
        for (int i = 0; i < 5; ++i) { const int p = tid + NTHR * i, r = (p >> 5) < 79 ? (p >> 5) : 78, c8 = p & 31, t = t0 - 15 + r;
            pv[i] = *(const u32x4*)(proj + (size_t)(b * S + (t >= 0 ? t : 0)) * NP + NC + c8 * 8); }
        __builtin_amdgcn_sched_barrier(0);
#pragma unroll
        for (int i = 0; i < 5; ++i) { const int p = tid + NTHR * i, r = p >> 5, c8 = p & 31, t = t0 - 15 + r;
            if (r < 79) *(LAS u32x4*)(P + r * 256 + c8 * 8) = (t >= 0) ? pv[i] : (u32x4){0u, 0u, 0u, 0u}; }
    }
    lds_barrier();
    {
        const int c = tid & 255, half = tid >> 8, g = __builtin_amdgcn_readfirstlane(c >> 6), tt0 = half * 32;
        if (g == 0) pool_runs<2>(P, PA, c, tt0, t0); else if (g == 1) pool_runs<4>(P, PA, c, tt0, t0); else if (g == 2) pool_runs<8>(P, PA, c, tt0, t0); else pool_runs<16>(P, PA, c, tt0, t0);
    }
    lds_barrier();
    {
        const int g = wid >> 1, mh = wid & 1, fr = lane & 15, fq = lane >> 4;
        f32x4 acc[2][4];
#pragma unroll
        for (int mi = 0; mi < 2; ++mi)
#pragma unroll
            for (int ni = 0; ni < 4; ++ni) acc[mi][ni] = (f32x4){0.f, 0.f, 0.f, 0.f};
        bf16x8 A[2][2];
#pragma unroll
        for (int ks = 0; ks < 2; ++ks)
#pragma unroll
            for (int mi = 0; mi < 2; ++mi) A[ks][mi] = *(const LAS bf16x8*)(PA + (16 * (2 * mh + mi) + fr) * 264 + g * 64 + 32 * ks + 8 * fq);
#pragma unroll
        for (int ks = 0; ks < 2; ++ks)
#pragma unroll
            for (int ni = 0; ni < 4; ++ni)
#pragma unroll
                for (int mi = 0; mi < 2; ++mi) acc[mi][ni] = mfma16(A[ks][mi], PTf[ks][ni], acc[mi][ni]);
#pragma unroll
        for (int ni = 0; ni < 4; ++ni) { const int d = g * 64 + 16 * ni + fr; const float bb = pbv[ni], sc = psv[ni];
#pragma unroll
            for (int mi = 0; mi < 2; ++mi)
#pragma unroll
                for (int r = 0; r < 4; ++r) YB[(16 * (2 * mh + mi) + 4 * fq + r) * 260 + d] = (acc[mi][ni][r] + bb) * sc; }
    }
    lds_barrier();
    rows_rms_store(YB, ogv, (bf16_t*)(ws + WS_MIXB), tok0, 512, wid, lane);
    lds_barrier();
}

__device__ __forceinline__ void item_conv(const Args& a, int l, int tile, LAS unsigned char* lds) {
    KArgs* ka = kargs();
    const int tid = opaque_tid(), wid = __builtin_amdgcn_readfirstlane(tid >> 6), lane = tid & 63;
    unsigned char* ws = ka->ws;
    const bf16_t* proj = (const bf16_t*)(ws + WS_PROJ);
    LAS float* GL = (LAS float*)lds;
    LAS bf16_t* CA = (LAS bf16_t*)(lds + 96256);
    LAS float* YB = (LAS float*)lds;
    const int tok0 = tile * 64, b = tok0 / S, t0 = tok0 % S;
    bf16x8 PWf[8][2];
    {
        const int fr_ = lane & 15, fq_ = lane >> 4;
        const bf16_t* PW = (const bf16_t*)(ws + WS_PWT) + (size_t)l * 65536;
#pragma unroll
        for (int ks = 0; ks < 8; ++ks)
#pragma unroll
            for (int ni = 0; ni < 2; ++ni) PWf[ks][ni] = *(const bf16x8*)(PW + (size_t)(32 * wid + 16 * ni + fr_) * 256 + 32 * ks + 8 * fq_);
    }
    const f32x4 ogv = *(const f32x4*)(IN_F(I_ONORM) + l * D + 256 + 4 * lane);
    const float cb = IN_F(I_CONVB)[l * 256 + (tid & 255)];
    float pwbv[2];
#pragma unroll
    for (int ni = 0; ni < 2; ++ni) pwbv[ni] = IN_F(I_PWB)[l * 256 + 32 * wid + 16 * ni + (lane & 15)];
    LAS float* LNP = (LAS float*)(lds + 96256 + 33792);
    const float lnp = (tid < 256) ? IN_F(I_CLNG)[l * 256 + tid] : IN_F(I_CLNB)[l * 256 + tid - 256];
    float wv[31];
    {
        const int c_ = tid & 255;
#pragma unroll
        for (int jj = 0; jj < 31; ++jj) wv[jj] = IN_F(I_CONVW)[((size_t)l * 31 + jj) * 256 + c_];
    }
    u32x4 avr[6], gvr[6];
#pragma unroll
    for (int i = 0; i < 6; ++i) { const int p = tid + NTHR * i, r = (p >> 5) < 94 ? (p >> 5) : 93, c8 = p & 31, t = t0 - 30 + r;
        const bf16_t* pr = proj + (size_t)(b * S + (t >= 0 ? t : 0)) * NP;
        avr[i] = *(const u32x4*)(pr + NBA + c8 * 8); gvr[i] = *(const u32x4*)(pr + NBG + c8 * 8); }
    __builtin_amdgcn_sched_barrier(0);
#pragma unroll
    for (int i = 0; i < 6; ++i) {
        const int p = tid + NTHR * i;
        if (p >= 94 * 32) break;
        const int r = p >> 5, c8 = p & 31, t = t0 - 30 + r;
        f32x4 o0 = (f32x4){0.f, 0.f, 0.f, 0.f}, o1 = o0;
        if (t >= 0) {
            const u32x4 av = avr[i], gv = gvr[i];
            o0[0] = bflo(av.x) * sigmoid_fast(bflo(gv.x)); o0[1] = bfhi(av.x) * sigmoid_fast(bfhi(gv.x)); o0[2] = bflo(av.y) * sigmoid_fast(bflo(gv.y)); o0[3] = bfhi(av.y) * sigmoid_fast(bfhi(gv.y));
            o1[0] = bflo(av.z) * sigmoid_fast(bflo(gv.z)); o1[1] = bfhi(av.z) * sigmoid_fast(bfhi(gv.z)); o1[2] = bflo(av.w) * sigmoid_fast(bflo(gv.w)); o1[3] = bfhi(av.w) * sigmoid_fast(bfhi(gv.w));
        }
        *(LAS f32x4*)(GL + r * 256 + c8 * 8) = o0; *(LAS f32x4*)(GL + r * 256 + c8 * 8 + 4) = o1;
    }
    LNP[tid] = lnp;
    lds_barrier();
    {
        const int c = tid & 255, half = tid >> 8;
        float yv[32];
#pragma unroll
        for (int ch = 0; ch < 8; ++ch) {
            const int tt = half * 32 + ch * 4;
            float x[34];
#pragma unroll
            for (int m2 = 0; m2 < 34; ++m2) x[m2] = GL[(tt + m2) * 256 + c];
#pragma unroll
            for (int i = 0; i < 4; ++i) {
                float y = cb;
#pragma unroll
                for (int jj = 0; jj < 31; ++jj) y += x[i + jj] * wv[jj];
                yv[ch * 4 + i] = y;
            }
        }
        lds_barrier();
#pragma unroll
        for (int i = 0; i < 32; ++i) YB[(half * 32 + i) * 260 + c] = yv[i];
    }
    lds_barrier();
    {
        const int t = tid >> 3, part = tid & 7;
        f32x4 lngv[8], lnbv[8];
#pragma unroll
        for (int i = 0; i < 8; ++i) { lngv[i] = *(const LAS f32x4*)(LNP + part * 4 + 32 * i); lnbv[i] = *(const LAS f32x4*)(LNP + 256 + part * 4 + 32 * i); }
        f32x4 y[8]; float s1[4] = {0.f, 0.f, 0.f, 0.f};
#pragma unroll
        for (int i = 0; i < 8; ++i) { y[i] = *(const LAS f32x4*)(YB + t * 260 + part * 4 + 32 * i); s1[i >> 1] += (y[i][0] + y[i][1]) + (y[i][2] + y[i][3]); }
        float mu[4], rs[4], s2[4];
#pragma unroll
        for (int g = 0; g < 4; ++g) { float v = s1[g]; v += dpp_f<0xB1>(v); v += dpp_f<0x4E>(v); v += dpp_f<0x141>(v); mu[g] = v * (1.0f / 64.0f); s2[g] = 0.f; }
#pragma unroll
        for (int i = 0; i < 8; ++i)
#pragma unroll
            for (int e = 0; e < 4; ++e) { y[i][e] -= mu[i >> 1]; s2[i >> 1] += y[i][e] * y[i][e]; }
#pragma unroll
        for (int g = 0; g < 4; ++g) { float v = s2[g]; v += dpp_f<0xB1>(v); v += dpp_f<0x4E>(v); v += dpp_f<0x141>(v); rs[g] = rsqrtf(v * (1.0f / 64.0f) + EPS); }
#pragma unroll
        for (int i = 0; i < 8; ++i) {
            float o[4];
#pragma unroll
            for (int e = 0; e < 4; ++e) o[e] = silu_fast(y[i][e] * rs[i >> 1] * lngv[i][e] + lnbv[i][e]);
            u32x2 w; w.x = cvt_pk_bf16(o[0], o[1]); w.y = cvt_pk_bf16(o[2], o[3]);
            *(LAS u32x2*)(CA + t * 264 + part * 4 + 32 * i) = w;
        }
    }
    lds_barrier();
    {
        const int fr = lane & 15, fq = lane >> 4;
        f32x4 acc[4][2];
#pragma unroll
        for (int mi = 0; mi < 4; ++mi)
#pragma unroll
            for (int ni = 0; ni < 2; ++ni) acc[mi][ni] = (f32x4){0.f, 0.f, 0.f, 0.f};
#pragma unroll
        for (int kh = 0; kh < 2; ++kh) {
            bf16x8 Af[4][4];
#pragma unroll
            for (int k4 = 0; k4 < 4; ++k4)
#pragma unroll
                for (int mi = 0; mi < 4; ++mi) Af[k4][mi] = *(const LAS bf16x8*)(CA + (16 * mi + fr) * 264 + 32 * (4 * kh + k4) + 8 * fq);
            __builtin_amdgcn_sched_barrier(0);
#pragma unroll
            for (int k4 = 0; k4 < 4; ++k4)
#pragma unroll
                for (int mi = 0; mi < 4; ++mi)
#pragma unroll
                    for (int ni = 0; ni < 2; ++ni) acc[mi][ni] = mfma16(Af[k4][mi], PWf[4 * kh + k4][ni], acc[mi][ni]);
        }
#pragma unroll
        for (int ni = 0; ni < 2; ++ni) { const int n = 32 * wid + 16 * ni + fr; const float bb = pwbv[ni];
#pragma unroll
            for (int mi = 0; mi < 4; ++mi)
#pragma unroll
                for (int r = 0; r < 4; ++r) YB[(16 * mi + 4 * fq + r) * 260 + n] = acc[mi][ni][r] + bb; }
    }
    lds_barrier();
    rows_rms_store(YB, ogv, (bf16_t*)(ws + WS_MIXB), tok0, 256, wid, lane);
    lds_barrier();
}

__device__ __forceinline__ void item_sgu(const Args& a, int l, int ch, LAS unsigned char* lds) {
    KArgs* ka = kargs();
    const int tid = opaque_tid(), wid = __builtin_amdgcn_readfirstlane(tid >> 6), lane = tid & 63;
    unsigned char* ws = ka->ws;
    const bf16_t* proj = (const bf16_t*)(ws + WS_PROJ);
    LAS bf16_t* VS = (LAS bf16_t*)lds;
    LAS bf16_t* OB = (LAS bf16_t*)(lds + 69632);
    const int tok0 = ch * 128;
    const f32x4 ogv = *(const f32x4*)(IN_F(I_ONORM) + l * D + 768 + 4 * lane);
    u32x2 uvr[16];
#pragma unroll
    for (int i = 0; i < 16; ++i) uvr[i] = *(const u32x2*)(proj + (size_t)(tok0 + 16 * wid + i) * NP + NDU + 4 * lane);
    {
        const f32x4 lg = *(const f32x4*)(IN_F(I_SLNG) + l * 256 + 4 * lane), lb = *(const f32x4*)(IN_F(I_SLNB) + l * 256 + 4 * lane);
        u32x2 vvr[16];
#pragma unroll
        for (int i = 0; i < 16; ++i) vvr[i] = *(const u32x2*)(proj + (size_t)(tok0 + 16 * wid + i) * NP + NDV + 4 * lane);
        __builtin_amdgcn_sched_barrier(0);
#pragma unroll
        for (int i = 0; i < 16; ++i) {
            const int s = 16 * wid + i;
            const u32x2 vv = vvr[i];
            const float v0 = bflo(vv.x), v1 = bfhi(vv.x), v2 = bflo(vv.y), v3 = bfhi(vv.y);
            const float mu = wave_sum((v0 + v1) + (v2 + v3)) * (1.0f / 256.0f);
            const float d0 = v0 - mu, d1 = v1 - mu, d2 = v2 - mu, d3 = v3 - mu;
            const float rs = rsqrtf(wave_sum((d0 * d0 + d1 * d1) + (d2 * d2 + d3 * d3)) * (1.0f / 256.0f) + EPS);
            u32x2 w; w.x = cvt_pk_bf16(d0 * rs * lg[0] + lb[0], d1 * rs * lg[1] + lb[1]); w.y = cvt_pk_bf16(d2 * rs * lg[2] + lb[2], d3 * rs * lg[3] + lb[3]);
            *(LAS u32x2*)(VS + s * 260 + 4 * lane) = w;
        }
    }
    lds_barrier();
    {
        const int h = wid >> 1, np = wid & 1, fr = lane & 15, fq = lane >> 4;
        const bf16_t* W = (const bf16_t*)(ws + WS_SGUW) + (size_t)(l * 4 + h) * 128 * 128;
        const float* sb = IN_F(I_SGUB) + (l * 4 + h) * 128;
        bf16x8 Wf[8][4]; f32x4 sbv[8];
#pragma unroll
        for (int mi = 0; mi < 8; ++mi) { sbv[mi] = *(const f32x4*)(sb + 16 * mi + 4 * fq);
#pragma unroll
            for (int ks = 0; ks <= (mi >> 1); ++ks) Wf[mi][ks] = *(const bf16x8*)(W + (size_t)(16 * mi + fr) * 128 + 32 * ks + 8 * fq); }
        bf16x8 Bf[4][2];
#pragma unroll
        for (int ks = 0; ks < 4; ++ks)
#pragma unroll
            for (int ni = 0; ni < 2; ++ni) {
                unsigned short e[8];
#pragma unroll
                for (int jj = 0; jj < 8; ++jj) e[jj] = VS[(32 * ks + 8 * fq + jj) * 260 + h * 64 + 32 * np + 16 * ni + fr];
                u32x4 w; w.x = e[0] | ((unsigned)e[1] << 16); w.y = e[2] | ((unsigned)e[3] << 16); w.z = e[4] | ((unsigned)e[5] << 16); w.w = e[6] | ((unsigned)e[7] << 16);
                Bf[ks][ni] = __builtin_bit_cast(bf16x8, w);
            }
        __builtin_amdgcn_sched_barrier(0);
#pragma unroll
        for (int mi = 0; mi < 8; ++mi) {
            f32x4 acc[2] = {(f32x4){0.f, 0.f, 0.f, 0.f}, (f32x4){0.f, 0.f, 0.f, 0.f}};
#pragma unroll
            for (int ks = 0; ks <= (mi >> 1); ++ks) {
#pragma unroll
                for (int ni = 0; ni < 2; ++ni) acc[ni] = mfma16(Wf[mi][ks], Bf[ks][ni], acc[ni]);
            }
#pragma unroll
            for (int ni = 0; ni < 2; ++ni)
#pragma unroll
                for (int r = 0; r < 4; ++r) { const int t = 16 * mi + 4 * fq + r; OB[t * 264 + h * 64 + 32 * np + 16 * ni + fr] = f2bf(acc[ni][r] + sbv[mi][r]); }
        }
    }
    lds_barrier();
    {
        const f32x4 gv = ogv;
        bf16_t* mixb = (bf16_t*)(ws + WS_MIXB);
#pragma unroll
        for (int i = 0; i < 16; ++i) {
            const int t = 16 * wid + i;
            const u32x2 mv = *(const LAS u32x2*)(OB + t * 264 + 4 * lane);
            const u32x2 uv = uvr[i];
            const float o0 = bflo(uv.x) * bflo(mv.x), o1 = bfhi(uv.x) * bfhi(mv.x), o2 = bflo(uv.y) * bflo(mv.y), o3 = bfhi(uv.y) * bfhi(mv.y);
            const float r = rsqrtf(wave_sum((o0 * o0 + o1 * o1) + (o2 * o2 + o3 * o3)) * (1.0f / 256.0f) + EPS);
            u32x2 w; w.x = cvt_pk_bf16(o0 * r * gv[0], o1 * r * gv[1]); w.y = cvt_pk_bf16(o2 * r * gv[2], o3 * r * gv[3]);
            *(u32x2*)(mixb + (size_t)(tok0 + t) * D + 768 + 4 * lane) = w;
        }
    }
    lds_barrier();
}

__device__ __forceinline__ void item_prepk(const Args& a, int l, int tile, LAS unsigned char* lds) {
    KArgs* ka = kargs();
    const int tid = opaque_tid(), wid = __builtin_amdgcn_readfirstlane(tid >> 6), lane = tid & 63;
    unsigned char* ws = ka->ws;
    const bf16_t* proj = (const bf16_t*)(ws + WS_PROJ);
    LAS bf16_t* VS = (LAS bf16_t*)lds;
    bf16_t* KN = (bf16_t*)(ws + WS_KN); bf16_t* VTg = (bf16_t*)(ws + WS_VT); bf16_t* IKR = (bf16_t*)(ws + WS_IKR);
    const float* ropeA = (const float*)(ws + WS_ROPEA); const float* ropeI = (const float*)(ws + WS_ROPEI);
    const int tok0 = tile * 64, b = tok0 / S, s0 = tok0 % S;
    const int li = lane & 15, head = lane >> 4;
    const f32x4 kg = *(const f32x4*)(IN_F(I_KN) + l * 64 + 4 * li);
#pragma unroll 1
    for (int i0 = 0; i0 < 8; i0 += 4) {
        u32x2 kvr[4], vvr[4], ivr[4]; f32x4 csA[4], snA[4], csI[4], snI[4];
#pragma unroll
        for (int u = 0; u < 4; ++u) {
            const int tok = tok0 + 8 * wid + i0 + u;
            const bf16_t* pr = proj + (size_t)tok * NP;
            kvr[u] = *(const u32x2*)(pr + NK + 4 * lane);
            vvr[u] = *(const u32x2*)(pr + NV + 4 * lane);
            ivr[u] = *(const u32x2*)(pr + NIK + 4 * (lane & 7));
            const int dd = 4 * (li & 1);
            csA[u] = *(const f32x4*)(ropeA + (size_t)tok * 16 + dd); snA[u] = *(const f32x4*)(ropeA + (size_t)tok * 16 + 8 + dd);
            csI[u] = *(const f32x4*)(ropeI + (size_t)tok * 8); snI[u] = *(const f32x4*)(ropeI + (size_t)tok * 8 + 4);
        }
        __builtin_amdgcn_sched_barrier(0);
#pragma unroll
        for (int u = 0; u < 4; ++u) {
            const int tl = 8 * wid + i0 + u, tok = tok0 + tl, s = s0 + tl;
            const u32x2 kv = kvr[u];
            float k0 = bflo(kv.x), k1 = bfhi(kv.x), k2 = bflo(kv.y), k3 = bfhi(kv.y);
            float ss = (k0 * k0 + k1 * k1) + (k2 * k2 + k3 * k3);
            ss = row_sum16(ss);
            const float r = rsqrtf(ss * (1.0f / 64.0f) + EPS);
            k0 *= r * kg[0]; k1 *= r * kg[1]; k2 *= r * kg[2]; k3 *= r * kg[3];
            {
                const float p0 = __shfl_xor(k0, 2), p1 = __shfl_xor(k1, 2), p2 = __shfl_xor(k2, 2), p3 = __shfl_xor(k3, 2);
                const f32x4 cs = csA[u], sn = snA[u];
                if (li < 2) { k0 = k0 * cs[0] - p0 * sn[0]; k1 = k1 * cs[1] - p1 * sn[1]; k2 = k2 * cs[2] - p2 * sn[2]; k3 = k3 * cs[3] - p3 * sn[3]; }
                else if (li < 4) { k0 = k0 * cs[0] + p0 * sn[0]; k1 = k1 * cs[1] + p1 * sn[1]; k2 = k2 * cs[2] + p2 * sn[2]; k3 = k3 * cs[3] + p3 * sn[3]; }
            }
            u32x2 ko; ko.x = cvt_pk_bf16(k0, k1); ko.y = cvt_pk_bf16(k2, k3);
            *(u32x2*)(KN + ((size_t)((b * 4 + head) * 128 + (s >> 5)) * 32 + (s & 31)) * 64 + 4 * li) = ko;
            *(LAS u32x2*)(VS + tl * 264 + 4 * lane) = vvr[u];
            {
                const u32x2 iv = ivr[u];
                float x0 = bflo(iv.x), x1 = bfhi(iv.x), x2 = bflo(iv.y), x3 = bfhi(iv.y);
                const float q0 = __shfl_xor(x0, 1), q1 = __shfl_xor(x1, 1), q2 = __shfl_xor(x2, 1), q3 = __shfl_xor(x3, 1);
                const f32x4 cs = csI[u], sn = snI[u];
                if (lane == 0) { x0 = x0 * cs[0] - q0 * sn[0]; x1 = x1 * cs[1] - q1 * sn[1]; x2 = x2 * cs[2] - q2 * sn[2]; x3 = x3 * cs[3] - q3 * sn[3]; }
                else if (lane == 1) { x0 = x0 * cs[0] + q0 * sn[0]; x1 = x1 * cs[1] + q1 * sn[1]; x2 = x2 * cs[2] + q2 * sn[2]; x3 = x3 * cs[3] + q3 * sn[3]; }
                u32x2 io; io.x = cvt_pk_bf16(x0, x1); io.y = cvt_pk_bf16(x2, x3);
                if (lane < 8) *(u32x2*)(IKR + (size_t)tok * 32 + 4 * lane) = io;
            }
        }
    }
    lds_barrier();
#pragma unroll
    for (int i = 0; i < 4; ++i) {
        const int p = tid + NTHR * i;
        const int h = p >> 9, ktl = (p >> 8) & 1, d = (p >> 2) & 63, part = p & 3;
        unsigned short e[8];
#pragma unroll
        for (int jj = 0; jj < 8; ++jj) { const int key = 4 * part + (jj & 3) + 16 * (jj >> 2); e[jj] = VS[(ktl * 32 + key) * 264 + h * 64 + d]; }
        u32x4 w; w.x = e[0] | ((unsigned)e[1] << 16); w.y = e[2] | ((unsigned)e[3] << 16); w.z = e[4] | ((unsigned)e[5] << 16); w.w = e[6] | ((unsigned)e[7] << 16);
        *(u32x4*)(VTg + ((size_t)((b * 4 + h) * 128 + (s0 >> 5) + ktl) * 64 + d) * 32 + 8 * part) = w;
    }
    lds_barrier();
}

__device__ __forceinline__ void phase_mix1(const Args& a, int l, LAS unsigned char* lds, int vcu, int G, int bx) {
    if (G == 256) {
        if (bx < 64) { item_conv(a, l, bx, lds); }
        else {
            const int w = bx - 64;
            if (w < 128) item_sgu(a, l, w, lds);
            item_prepk(a, l, w, lds);
            item_conv(a, l, 64 + w, lds);
            if (w >= 128) { item_prepk(a, l, 192 + (w - 128), lds); item_pool(a, l, w - 128, lds); }
            item_pool(a, l, 64 + w, lds);
        }
        return;
    }
    for (int it = vcu; it < 896; it += G) {
        if (it < 128) item_sgu(a, l, it, lds);
        else if (it < 384) item_conv(a, l, it - 128, lds);
        else if (it < 640) item_pool(a, l, it - 384, lds);
        else item_prepk(a, l, it - 640, lds);
    }
}
__device__ __forceinline__ f32x16 mfma32(const bf16x8 a, const bf16x8 b, const f32x16 c) { return __builtin_amdgcn_mfma_f32_32x32x16_bf16(a, b, c, 0, 0, 0); }
typedef float f32x2 __attribute__((ext_vector_type(2)));

__device__ __forceinline__ void a1_scores(const bf16x8 A0, const bf16x8 A1, const bf16x8 (&Bq)[4][2], const float (&cl)[4], f32x2 (&sc)[8]) {
    f32x16 d[4];
#pragma unroll
    for (int h = 0; h < 4; ++h) {
#pragma unroll
        for (int r = 0; r < 16; ++r) d[h][r] = 0.f;
        d[h] = mfma32(A0, Bq[h][0], d[h]); d[h] = mfma32(A1, Bq[h][1], d[h]);
    }
#pragma unroll
    for (int p = 0; p < 8; ++p) {
        f32x2 m[4];
#pragma unroll
        for (int h = 0; h < 4; ++h) { m[h][0] = __builtin_amdgcn_fmed3f(d[h][2 * p], 0.0f, cl[h]); m[h][1] = __builtin_amdgcn_fmed3f(d[h][2 * p + 1], 0.0f, cl[h]); }
        sc[p] = (m[0] + m[1]) + (m[2] + m[3]);
    }
}

#define A1_PRELOAD(rA) { const int ntw_ = (nkt - wid + 7) >> 3; \
    _Pragma("unroll") for (int u_ = 0; u_ < 4; ++u_) { rA[u_][0] = Bq[0][0]; rA[u_][1] = Bq[0][0]; if (u_ < ntw_) { const size_t o_ = (size_t)(wid + 8 * u_) * 1024; rA[u_][0] = *(const bf16x8*)(ikl + o_); rA[u_][1] = *(const bf16x8*)(ikl + o_ + 16); } } }
#define A1_STREAM_BEGIN(rA) { const int ntw_ = (nkt - wid + 7) >> 3; \
    for (int i_ = 0; i_ < ntw_; i_ += 4) { \
        _Pragma("unroll") for (int u_ = 0; u_ < 4; ++u_) { if (i_ + u_ < ntw_) { \
            const bf16x8 cA0 = rA[u_][0], cA1 = rA[u_][1]; const int kt = wid + 8 * (i_ + u_); \
            if (i_ + u_ + 4 < ntw_) { const size_t o_ = (size_t)(kt + 32) * 1024; rA[u_][0] = *(const bf16x8*)(ikl + o_); rA[u_][1] = *(const bf16x8*)(ikl + o_ + 16); }
#define A1_STREAM_END } } } }

template <int KIND>
__device__ __forceinline__ void a1_pass(const bf16_t* ikl, int nkt, int wid, const bf16x8 (&Bq)[4][2], const float (&cl)[4], LAS unsigned char* histb, unsigned q4, unsigned cadd, bf16x8 (&rA)[4][2]) {
    A1_STREAM_BEGIN(rA)
        f32x2 sc[8];
        a1_scores(cA0, cA1, Bq, cl, sc);
#pragma unroll
        for (int r = 0; r < 16; ++r) {
            const unsigned u = __float_as_uint(sc[r >> 1][r & 1]);
            unsigned addr;
            if (KIND == 0) addr = (((u + 0x8000u) >> 17) & 0x7f80u) | q4;
            else { unsigned dg = (u + cadd) >> 16; dg = dg < 256u ? dg : 256u; addr = (dg << 7) + q4; }
            __hip_atomic_fetch_add((LAS unsigned*)(histb + addr), 1u, __ATOMIC_RELAXED, __HIP_MEMORY_SCOPE_WORKGROUP);
        }
    A1_STREAM_END
}

template <int LEVEL>
__device__ __forceinline__ void a1_scan(LAS unsigned* hist, LAS unsigned* psum, LAS unsigned* qst, int tid) {
    const int sq = tid & 31, part = tid >> 5;
    const unsigned need = qst[32 + sq], p1 = qst[sq];
    const bool neg = (p1 & 0x80u) != 0u;
#define A1_RAWROW(bn) (LEVEL == 0 ? ((bn) >= 128 ? (bn) - 128 : 255 - (bn)) : (neg ? 255 - (bn) : (bn)))
    unsigned cv[16]; unsigned local = 0u;
#pragma unroll
    for (int bb = 0; bb < 16; ++bb) { cv[bb] = hist[A1_RAWROW(16 * part + bb) * 32 + sq]; local += cv[bb]; }
    psum[part * 32 + sq] = local;
    __syncthreads();
    unsigned above = 0u;
#pragma unroll
    for (int pp = 1; pp < 16; ++pp) above += (part + pp < 16) ? psum[(part + pp) * 32 + sq] : 0u;
    if (above < need && above + local >= need) {
        unsigned run = above, fb = 0u, fr = 0u, fc = 0u; bool found = false;
#pragma unroll
        for (int bb = 15; bb >= 0; --bb) {
            const bool hit = !found && (run + cv[bb] >= need);
            fb = hit ? (unsigned)bb : fb; fr = hit ? run : fr; fc = hit ? cv[bb] : fc; found = found || hit;
            run += cv[bb];
        }
        const unsigned raw = (unsigned)A1_RAWROW(16 * part + (int)fb);
        if (LEVEL == 0) { qst[sq] = raw; qst[32 + sq] = need - fr; }
        else { qst[sq] = (p1 << 8) | raw; qst[32 + sq] = need - fr; qst[64 + sq] = fc; }
    }
#undef A1_RAWROW
}

__device__ __forceinline__ void a1_cmp2(unsigned& gt, unsigned& ge, float s0, float s1, float tg, float te) {
#ifdef A1_NOASM
    gt = (gt << 1) | (s0 >= tg ? 1u : 0u); ge = (ge << 1) | (s0 >= te ? 1u : 0u);
    gt = (gt << 1) | (s1 >= tg ? 1u : 0u); ge = (ge << 1) | (s1 >= te ? 1u : 0u);
#else
    unsigned long long m1, m2, m3;
    asm("v_cmp_ge_f32 vcc, %[s0], %[tg]\n\t"
        "v_cmp_ge_f32 %[m1], %[s0], %[te]\n\t"
        "v_cmp_ge_f32 %[m2], %[s1], %[tg]\n\t"
        "v_cmp_ge_f32 %[m3], %[s1], %[te]\n\t"
        "v_addc_co_u32 %[g], vcc, %[g], %[g], vcc\n\t"
        "v_addc_co_u32 %[e], %[m1], %[e], %[e], %[m1]\n\t"
        "v_addc_co_u32 %[g], %[m2], %[g], %[g], %[m2]\n\t"
        "v_addc_co_u32 %[e], %[m3], %[e], %[e], %[m3]"
        : [g] "+v"(gt), [e] "+v"(ge), [m1] "=&s"(m1), [m2] "=&s"(m2), [m3] "=&s"(m3)
        : [s0] "v"(s0), [s1] "v"(s1), [tg] "v"(tg), [te] "v"(te)
        : "vcc");
#endif
}
__device__ __forceinline__ unsigned a1_spread(unsigned x) { return (x & 0xfu) | ((x & 0xf0u) << 4) | ((x & 0xf00u) << 8) | ((x & 0xf000u) << 12); }

constexpr int A1_HISTA = 0, A1_HISTB = 257 * 32, A1_PSUM = 2 * 257 * 32, A1_QST = A1_PSUM + 16 * 32, A1_MBUF = A1_QST + 128, A1_TBUF = A1_MBUF + 32 * 128;
__device__ __forceinline__ void a1_tile(const Args& a, int l, int b, int j, LAS unsigned char* lds, const bool gbar, const XcdBarrier bar) {
    KArgs* ka = kargs();
    const int tid = opaque_tid(), wid = __builtin_amdgcn_readfirstlane(tid >> 6), lane = tid & 63, q = lane & 31, hh = lane >> 5;
    unsigned char* ws = ka->ws;
    const bf16_t* proj = (const bf16_t*)(ws + WS_PROJ);
    const bf16_t* ikr = (const bf16_t*)(ws + WS_IKR) + (size_t)b * S * 32;
    const bf16_t* ikl = ikr + (lane & 31) * 32 + 8 * (lane >> 5);
    unsigned* maskg = (unsigned*)(ws + WS_MASK);
    LAS unsigned* L = (LAS unsigned*)lds;
    LAS unsigned* psum = L + A1_PSUM; LAS unsigned* qst = L + A1_QST; LAS unsigned* mbuf = L + A1_MBUF; LAS unsigned* tbuf = L + A1_TBUF;
    const int t0 = j * 32, n = (t0 / 64 + 1) * 64, nkt = n / 32, nw = ((t0 / 128) + 1) * 4;
    if (n <= 256) {
        if (gbar) xcd_barrier(bar);
        for (int i = tid; i < 32 * nw; i += NTHR) { const int qq = i / nw, w = i % nw; maskg[(size_t)(b * S + t0 + qq) * 128 + w] = (w < nkt) ? 0xffffffffu : 0u; }
        return;
    }
    bf16x8 Bq[4][2]; float cl[4];
    {
        const int tok = b * S + t0 + q;
        const bf16_t* pr = proj + (size_t)tok * NP;
        f32x4 cs, sn; u32x2 iwr;
        u32x4 rawq[4][2];
        auto pf = [&]() {
            cs = *(const f32x4*)((const float*)(ws + WS_ROPEI) + (size_t)tok * 8); sn = *(const f32x4*)((const float*)(ws + WS_ROPEI) + (size_t)tok * 8 + 4);
            iwr = *(const u32x2*)(pr + NIW);
#pragma unroll
            for (int h = 0; h < 4; ++h)
#pragma unroll
                for (int ks = 0; ks < 2; ++ks) rawq[h][ks] = *(const u32x4*)(pr + NIQ + h * 32 + 16 * ks + 8 * hh);
        };
        if (gbar) xcd_barrier_work(bar, pf); else pf();
        __builtin_amdgcn_sched_barrier(0);
        const float iwf[4] = {bflo(iwr.x), bfhi(iwr.x), bflo(iwr.y), bfhi(iwr.y)};
#pragma unroll
        for (int h = 0; h < 4; ++h) {
            const float wsc = iwf[h] * (0.5f * 0.17677669529663687f);
            cl[h] = (wsc > 0.f) ? INFINITY : -INFINITY;
#pragma unroll
            for (int ks = 0; ks < 2; ++ks) {
                const u32x4 raw = rawq[h][ks];
                float v[8] = {bflo(raw.x), bfhi(raw.x), bflo(raw.y), bfhi(raw.y), bflo(raw.z), bfhi(raw.z), bflo(raw.w), bfhi(raw.w)};
                if (ks == 0) {
#pragma unroll
                    for (int i = 0; i < 4; ++i) { const float x1 = v[i], x2 = v[i + 4]; const float r1 = x1 * cs[i] - x2 * sn[i], r2 = x2 * cs[i] + x1 * sn[i]; v[i] = (hh == 0) ? r1 : x1; v[i + 4] = (hh == 0) ? r2 : x2; }
                }
                u32x4 pk; pk.x = cvt_pk_bf16(v[0] * wsc, v[1] * wsc); pk.y = cvt_pk_bf16(v[2] * wsc, v[3] * wsc); pk.z = cvt_pk_bf16(v[4] * wsc, v[5] * wsc); pk.w = cvt_pk_bf16(v[6] * wsc, v[7] * wsc);
                Bq[h][ks] = __builtin_bit_cast(bf16x8, pk);
            }
        }
    }
    bf16x8 rA[4][2];
    A1_PRELOAD(rA);
    { LAS u32x4* hz = (LAS u32x4*)(L + A1_HISTA); u32x4 zz = (u32x4){0u, 0u, 0u, 0u}; asm volatile("" : "+v"(zz)); for (int i = tid; i < 2 * 257 * 32 / 4; i += NTHR) hz[i] = zz; }
    if (tid < 32) { qst[tid] = 0u; qst[32 + tid] = 256u; qst[64 + tid] = 0u; }
    __syncthreads();
    const unsigned q4 = (unsigned)q * 4u;
    a1_pass<0>(ikl, nkt, wid, Bq, cl, (LAS unsigned char*)(L + A1_HISTA), q4, 0u, rA);
    A1_PRELOAD(rA);
    __syncthreads();
    a1_scan<0>(L + A1_HISTA, psum, qst, tid);
    __syncthreads();
    a1_pass<1>(ikl, nkt, wid, Bq, cl, (LAS unsigned char*)(L + A1_HISTB), q4, 0x8000u - (qst[q] << 24), rA);
    A1_PRELOAD(rA);
    __syncthreads();
    a1_scan<1>(L + A1_HISTB, psum, qst, tid);
    __syncthreads();
    {
        const unsigned T = qst[q], mag = T & 0x7fffu;
        unsigned bg, be;
        if ((T & 0x8000u) == 0u) { be = mag ? (mag << 16) - 0x8000u : 0u; bg = ((mag + 1u) << 16) - 0x8000u; }
        else { be = 0x80000000u | (((mag + 1u) << 16) - 0x8001u); bg = mag ? (0x80000000u | ((mag << 16) - 0x8001u)) : 0u; }
        const float tg = __uint_as_float(bg), te = __uint_as_float(be);
        A1_STREAM_BEGIN(rA)
            f32x2 sc[8];
            a1_scores(cA0, cA1, Bq, cl, sc);
            unsigned gt = 0u, ge = 0u;
#pragma unroll
            for (int p = 7; p >= 0; --p) a1_cmp2(gt, ge, sc[p][1], sc[p][0], tg, te);
            unsigned wb = a1_spread(gt & 0xffffu) << (4 * hh), eb = a1_spread(ge & 0xffffu) << (4 * hh);
            wb |= (unsigned)__shfl_xor((int)wb, 32); eb |= (unsigned)__shfl_xor((int)eb, 32);
            if (hh == 0) { mbuf[q * 128 + kt] = wb; tbuf[q * 128 + kt] = eb & ~wb; }
        A1_STREAM_END
    }
    __syncthreads();
    {
        const int qq = tid >> 4, part = tid & 15;
        const unsigned need = qst[32 + qq];
        const u32x4 ta = *(const LAS u32x4*)(tbuf + qq * 128 + part * 8), tb = *(const LAS u32x4*)(tbuf + qq * 128 + part * 8 + 4);
        const u32x4 ma = *(const LAS u32x4*)(mbuf + qq * 128 + part * 8), mb = *(const LAS u32x4*)(mbuf + qq * 128 + part * 8 + 4);
        unsigned t[8] = {ta.x, ta.y, ta.z, ta.w, tb.x, tb.y, tb.z, tb.w}, m[8] = {ma.x, ma.y, ma.z, ma.w, mb.x, mb.y, mb.z, mb.w};
        unsigned c = 0u;
#pragma unroll
        for (int i = 0; i < 8; ++i) { if (part * 8 + i >= nkt) { t[i] = 0u; m[i] = 0u; } c += (unsigned)__builtin_popcount(t[i]); }
        unsigned inc = c;
#pragma unroll
        for (int dd = 1; dd < 16; dd <<= 1) { const unsigned v = (unsigned)__shfl_up((int)inc, dd, 16); if (part >= dd) inc += v; }
        int rem = (int)need - (int)(inc - c);
#pragma unroll
        for (int i = 0; i < 8; ++i) {
            const int ci = __builtin_popcount(t[i]);
            unsigned keep = 0u;
            if (rem >= ci) keep = t[i];
            else if (rem > 0) { unsigned tt = t[i]; for (int k = rem; k > 0; --k) { const unsigned low = tt & (0u - tt); keep |= low; tt ^= low; } }
            m[i] |= keep; rem -= ci;
        }
        unsigned* mg = maskg + (size_t)(b * S + t0 + qq) * 128 + part * 8;
        if (part * 8 < nw) *(u32x4*)mg = (u32x4){m[0], m[1], m[2], m[3]};
        if (part * 8 + 4 < nw) *(u32x4*)(mg + 4) = (u32x4){m[4], m[5], m[6], m[7]};
    }
    __syncthreads();
}
__device__ __forceinline__ void phase_a1(const Args& a, int l, LAS unsigned char* lds, int vcu, int G, const bool gb, const XcdBarrier bar) {
    KArgs* ka = kargs();
    const bool inl = gb && (G == 256);
    if (gb && !inl) xcd_barrier(bar);
    for (int it = vcu; it < 256; it += G) { const int b = it >> 6, jj = it & 63; a1_tile(a, l, b, 127 - jj, lds, inl, bar); a1_tile(a, l, b, jj, lds, false, bar); }
}

__device__ __forceinline__ void a2_unit(const Args& a, int l, int b, int h, int blk, LAS unsigned char* lds, const bool gbar, const XcdBarrier bar) {
    KArgs* ka = kargs();
    const int tid = opaque_tid(), wid = __builtin_amdgcn_readfirstlane(tid >> 6), lane = tid & 63, fr = lane & 15, kq = lane >> 4;
    const int half = wid >> 2, w4 = wid & 3;
    unsigned char* ws = ka->ws;
    const bf16_t* proj = (const bf16_t*)(ws + WS_PROJ);
    const char* KNb = (const char*)(ws + WS_KN) + (size_t)(b * 4 + h) * 128 * 4096;
    const char* VTb = (const char*)(ws + WS_VT) + (size_t)(b * 4 + h) * 128 * 4096;
    LAS unsigned char* Kb = lds;
    LAS unsigned char* Vb = lds + 32768;
    LAS float* Pb = (LAS float*)(lds + 65536);
    LAS float* Lb = Pb + 128 * 68;
    const int nsteps = 2 * (blk + 1);
    const int tokq0 = b * S + blk * 128 + w4 * 32 + fr;
    bf16x8 Qb[2][2]; float C2;
    {
        const float* qg = IN_F(I_QN) + l * 64;
        C2 = ((const float*)(ws + WS_FLAG + 14336))[l];
        u32x4 rawq[2][2]; f32x4 rav[2][4], qgv[2][2];
        auto pf = [&]() {
#pragma unroll
            for (int ks = 0; ks < 2; ++ks) { qgv[ks][0] = *(const f32x4*)(qg + 32 * ks + 8 * kq); qgv[ks][1] = *(const f32x4*)(qg + 32 * ks + 8 * kq + 4); }
#pragma unroll
            for (int g = 0; g < 2; ++g) {
                const int tokq = tokq0 + 16 * g;
                const bf16_t* pr = proj + (size_t)tokq * NP + NQ + h * 64;
#pragma unroll
                for (int ks = 0; ks < 2; ++ks) rawq[g][ks] = *(const u32x4*)(pr + 32 * ks + 8 * kq);
                const float* ra = (const float*)(ws + WS_ROPEA) + (size_t)tokq * 16;
#pragma unroll
                for (int i = 0; i < 4; ++i) rav[g][i] = *(const f32x4*)(ra + 4 * i);
            }
        };
        if (gbar) xcd_barrier_work(bar, pf); else pf();
        __builtin_amdgcn_sched_barrier(0);
#pragma unroll
        for (int g = 0; g < 2; ++g) {
            float v[2][8]; float ss = 0.f;
#pragma unroll
            for (int ks = 0; ks < 2; ++ks) { const u32x4 raw = rawq[g][ks];
                v[ks][0] = bflo(raw.x); v[ks][1] = bfhi(raw.x); v[ks][2] = bflo(raw.y); v[ks][3] = bfhi(raw.y); v[ks][4] = bflo(raw.z); v[ks][5] = bfhi(raw.z); v[ks][6] = bflo(raw.w); v[ks][7] = bfhi(raw.w);
#pragma unroll
                for (int i = 0; i < 8; ++i) ss += v[ks][i] * v[ks][i]; }
            ss += __shfl_xor(ss, 16); ss += __shfl_xor(ss, 32);
            const float r = rsqrtf(ss * (1.0f / 64.0f) + EPS);
#pragma unroll
            for (int ks = 0; ks < 2; ++ks)
#pragma unroll
                for (int i = 0; i < 8; ++i) v[ks][i] *= r * qgv[ks][i >> 2][i & 3];
            {
#pragma unroll
                for (int i = 0; i < 8; ++i) { const float pv = __shfl_xor(v[0][i], 16); const float c = rav[g][i >> 2][i & 3], sn = rav[g][2 + (i >> 2)][i & 3];
                    if (kq == 0) v[0][i] = v[0][i] * c - pv * sn; else if (kq == 1) v[0][i] = v[0][i] * c + pv * sn; }
            }
            const float qs = 0.125f * 1.4426950408889634f;
#pragma unroll
            for (int ks = 0; ks < 2; ++ks) { u32x4 pk; pk.x = cvt_pk_bf16(v[ks][0] * qs, v[ks][1] * qs); pk.y = cvt_pk_bf16(v[ks][2] * qs, v[ks][3] * qs); pk.z = cvt_pk_bf16(v[ks][4] * qs, v[ks][5] * qs); pk.w = cvt_pk_bf16(v[ks][6] * qs, v[ks][7] * qs);
                Qb[g][ks] = __builtin_bit_cast(bf16x8, pk); }
        }
    }
    const unsigned* mrow0 = (const unsigned*)(ws + WS_MASK) + (size_t)tokq0 * 128 + 2 * half;
    const unsigned* mrow1 = mrow0 + 16 * 128;
    f32x4 O[2][4], Ls[2];
#pragma unroll
    for (int g = 0; g < 2; ++g) { Ls[g] = (f32x4){0.f, 0.f, 0.f, 0.f};
#pragma unroll
        for (int dt = 0; dt < 4; ++dt) O[g][dt] = (f32x4){0.f, 0.f, 0.f, 0.f}; }
    const unsigned bpos = 4u * (unsigned)kq;
    const bf16x8 ones8 = __builtin_bit_cast(bf16x8, (u32x4){0x3f803f80u, 0x3f803f80u, 0x3f803f80u, 0x3f803f80u});
    const int kkey = tid >> 3, kch = tid & 7, vsub = tid >> 8, vd = (tid >> 2) & 63, vch = tid & 3;
    const int klds = kkey * 128 + ((kch ^ (kkey & 7)) * 16), vlds = vsub * 4096 + vd * 64 + ((vch ^ ((vd >> 2) & 3)) * 16);
    u32x4 kr0, kr1, kr2, kr3, vr0, vr1, vr2, vr3; u32x2 mP0, mP1, mQ0, mQ1;
#define A2_LOAD(j, st_) do { kr##j = *(const u32x4*)(KNb + (size_t)(st_) * 8192 + (size_t)tid * 16); vr##j = *(const u32x4*)(VTb + (size_t)(st_) * 8192 + (size_t)tid * 16); } while (0)
#define A2_LOADM(X, s2_) do { m##X##0 = *(const u32x2*)(mrow0 + 4 * (s2_)); m##X##1 = *(const u32x2*)(mrow1 + 4 * (s2_)); } while (0)
    A2_LOAD(0, 0); A2_LOAD(1, 1); A2_LOADM(P, 0);
    if (nsteps > 2) { A2_LOAD(2, 2); A2_LOAD(3, 3); A2_LOADM(Q, 1); } else { kr2 = kr0; vr2 = vr0; kr3 = kr0; vr3 = vr0; mQ0 = mP0; mQ1 = mP1; }
    __syncthreads();
#define A2_HALF(Kc, Vc, mc0, mc1) do { \
        bf16x8 KA[2][2][2], VA[2][4]; \
          \
        _Pragma("unroll") for (int sub = 0; sub < 2; ++sub) \
            _Pragma("unroll") for (int tl = 0; tl < 2; ++tl) { const int key = 32 * sub + 16 * tl + fr; \
                KA[sub][tl][0] = *(const LAS bf16x8*)((Kc) + key * 128 + (((0 + kq) ^ (key & 7)) * 16)); \
                KA[sub][tl][1] = *(const LAS bf16x8*)((Kc) + key * 128 + (((4 + kq) ^ (key & 7)) * 16)); } \
        _Pragma("unroll") for (int sub = 0; sub < 2; ++sub) \
            _Pragma("unroll") for (int dt = 0; dt < 4; ++dt) { const int d = 16 * dt + fr; \
                VA[sub][dt] = *(const LAS bf16x8*)((Vc) + sub * 4096 + d * 64 + ((kq ^ ((d >> 2) & 3)) * 16)); } \
        __builtin_amdgcn_sched_barrier(0); \
          \
        f32x4 Sx[2][2][2]; \
        _Pragma("unroll") for (int sub = 0; sub < 2; ++sub) \
            _Pragma("unroll") for (int tl = 0; tl < 2; ++tl) \
                _Pragma("unroll") for (int g = 0; g < 2; ++g) { \
                    f32x4 z = (f32x4){-C2, -C2, -C2, -C2};     \
                    z = mfma16(KA[sub][tl][0], Qb[g][0], z); Sx[sub][g][tl] = mfma16(KA[sub][tl][1], Qb[g][1], z); } \
        __builtin_amdgcn_sched_barrier(0); \
        _Pragma("unroll") for (int sub = 0; sub < 2; ++sub) { \
            const unsigned m0 = sub ? (mc0).y : (mc0).x, m1 = sub ? (mc1).y : (mc1).x; \
            bf16x8 Pf[2]; \
            _Pragma("unroll") for (int g = 0; g < 2; ++g) { \
                const unsigned m = g ? m1 : m0; float p[8]; \
                _Pragma("unroll") for (int r = 0; r < 4; ++r) { \
                    const float e0 = __builtin_amdgcn_exp2f(Sx[sub][g][0][r]), e1 = __builtin_amdgcn_exp2f(Sx[sub][g][1][r]); \
                    p[r] = __uint_as_float(__float_as_uint(e0) & (unsigned)__builtin_amdgcn_sbfe((int)m, bpos + r, 1)); \
                    p[4 + r] = __uint_as_float(__float_as_uint(e1) & (unsigned)__builtin_amdgcn_sbfe((int)m, bpos + 16 + r, 1)); \
                } \
                u32x4 pk; pk.x = cvt_pk_bf16(p[0], p[1]); pk.y = cvt_pk_bf16(p[2], p[3]); pk.z = cvt_pk_bf16(p[4], p[5]); pk.w = cvt_pk_bf16(p[6], p[7]); \
                Pf[g] = __builtin_bit_cast(bf16x8, pk); } \
            __builtin_amdgcn_sched_barrier(0); \
            _Pragma("unroll") for (int dt = 0; dt < 4; ++dt) { \
                O[0][dt] = mfma16(VA[sub][dt], Pf[0], O[0][dt]); O[1][dt] = mfma16(VA[sub][dt], Pf[1], O[1][dt]); } \
            Ls[0] = mfma16(ones8, Pf[0], Ls[0]); Ls[1] = mfma16(ones8, Pf[1], Ls[1]);     \
            __builtin_amdgcn_sched_barrier(0); \
        } } while (0)
#define A2_STEP2(ja, jb, X, s2_) do { \
        LAS unsigned char* Kc2 = Kb + ((s2_) & 1) * 16384; LAS unsigned char* Vc2 = Vb + ((s2_) & 1) * 16384; \
        *(LAS u32x4*)(Kc2 + klds) = kr##ja; *(LAS u32x4*)(Vc2 + vlds) = vr##ja; *(LAS u32x4*)(Kc2 + 8192 + klds) = kr##jb; *(LAS u32x4*)(Vc2 + 8192 + vlds) = vr##jb; \
        const u32x2 mcA = m##X##0, mcB = m##X##1; \
        __syncthreads(); \
        if (2 * (s2_) + 4 < nsteps) { A2_LOAD(ja, 2 * (s2_) + 4); A2_LOAD(jb, 2 * (s2_) + 5); A2_LOADM(X, (s2_) + 2); } \
        A2_HALF(Kc2 + half * 8192, Vc2 + half * 8192, mcA, mcB); \
    } while (0)
    for (int s2 = 0; 2 * s2 < nsteps; s2 += 2) {
        A2_STEP2(0, 1, P, s2);
        if (2 * (s2 + 1) < nsteps) A2_STEP2(2, 3, Q, s2 + 1);
    }
#undef A2_STEP2
#undef A2_HALF
#undef A2_LOAD
#undef A2_LOADM
    if (half == 1) {
#pragma unroll
        for (int g = 0; g < 2; ++g) { const int row = w4 * 32 + g * 16 + fr;
#pragma unroll
            for (int dt = 0; dt < 4; ++dt) *(LAS f32x4*)(Pb + row * 68 + 16 * dt + 4 * kq) = O[g][dt];
            if (kq == 0) Lb[row] = Ls[g][0]; }
    }
    __syncthreads();
    if (half == 0) {
#pragma unroll
        for (int g = 0; g < 2; ++g) { const int row = w4 * 32 + g * 16 + fr;
            const float inv = 1.0f / (Ls[g][0] + Lb[row]);
#pragma unroll
            for (int dt = 0; dt < 4; ++dt) { const f32x4 o = *(const LAS f32x4*)(Pb + row * 68 + 16 * dt + 4 * kq); *(LAS f32x4*)(Pb + row * 68 + 16 * dt + 4 * kq) = (O[g][dt] + o) * inv; } }
    }
    __syncthreads();
    {
        const int qq = lane >> 2, dp = (lane & 3) * 16;
        const LAS float* src = Pb + (wid * 16 + qq) * 68 + dp;
        float f[16]; float sq = 0.f;
#pragma unroll
        for (int i = 0; i < 4; ++i) { const f32x4 t = *(const LAS f32x4*)(src + 4 * i); f[4 * i] = t[0]; f[4 * i + 1] = t[1]; f[4 * i + 2] = t[2]; f[4 * i + 3] = t[3]; sq += (t[0] * t[0] + t[1] * t[1]) + (t[2] * t[2] + t[3] * t[3]); }
        u32x4 w0, w1; w0.x = cvt_pk_bf16(f[0], f[1]); w0.y = cvt_pk_bf16(f[2], f[3]); w0.z = cvt_pk_bf16(f[4], f[5]); w0.w = cvt_pk_bf16(f[6], f[7]);
        w1.x = cvt_pk_bf16(f[8], f[9]); w1.y = cvt_pk_bf16(f[10], f[11]); w1.z = cvt_pk_bf16(f[12], f[13]); w1.w = cvt_pk_bf16(f[14], f[15]);
        const int tok = b * S + blk * 128 + wid * 16 + qq;
        bf16_t* op = (bf16_t*)(ws + WS_MIXB) + (size_t)tok * D + h * 64 + dp;
        *(u32x4*)op = w0; *(u32x4*)(op + 8) = w1;
        sq += dpp_f<0xB1>(sq); sq += dpp_f<0x4E>(sq);
        if ((lane & 3) == 0) ((float*)(ws + WS_SSQ))[((size_t)l * NTOK + tok) * 4 + h] = sq;
    }
    __syncthreads();
}
__device__ __forceinline__ void phase_a2(const Args& a, int l, LAS unsigned char* lds, int vcu, int G, const bool gb, const XcdBarrier bar) {
    KArgs* ka = kargs();
    const bool inl = gb && (G == 256);
    if (gb && !inl) xcd_barrier(bar);
    for (int it = vcu; it < 256; it += G) { const int b = it >> 6, h = (it >> 4) & 3, jj = it & 15; a2_unit(a, l, b, h, 31 - jj, lds, inl, bar); a2_unit(a, l, b, h, jj, lds, false, bar); }
}
__global__ void __launch_bounds__(NTHR, 2) mk_fwd(Args a) {
    extern __shared__ __attribute__((aligned(16))) unsigned char lds_raw[];
    LAS unsigned char* lds = (LAS unsigned char*)lds_raw;
    const int tid = threadIdx.x, G = gridDim.x, bx = blockIdx.x;
    const int vcu = (G % 8 == 0) ? (bx % 8) * (G / 8) + bx / 8 : bx;
    if (tid < 64) ((LAS unsigned*)(lds + LDS_MISC))[tid] = 0u;
    __syncthreads();
    XcdBarrier bar; bar.bar = (unsigned*)(a.ws + WS_BAR); bar.x = 0; bar.st = nullptr;
    if (a.fused) bar = xcd_barrier_post((unsigned*)(a.ws + WS_BAR), (volatile LAS unsigned*)(lds + LDS_MISC + MISC_BAR));
#define GRID_BAR() do { if (a.fused) xcd_barrier_work(bar, []() {}); } while (0)
#ifdef ONLY_PH
#define IN(k) ((k) == ONLY_PH && a.ph_lo <= (k) && (k) < a.ph_hi)
#else
#define IN(k) (a.ph_lo <= (k) && (k) < a.ph_hi)
#endif
    if (IN(PH_PRO)) { phase_prologue(a, lds, vcu, G); }
    if (IN(PH_NORM0)) { KArgs* ka = kargs(); unsigned char* ws = ka->ws; float* modp = (float*)(ws + WS_MOD); phase_norm(IN_F(I_X), IN_F(I_NORM1), modp, modp + 1024, (bf16_t*)(ws + WS_HA), vcu, G, a.fused != 0, bar);
        if (a.fused) xcd_barrier_work(bar, [&]() { phase_rbias(a, lds, vcu, G); }); else phase_rbias(a, lds, vcu, G); }
    for (int l = a.l_lo; l < a.l_hi; ++l) {
        if (IN(PH_G1)) {
            KArgs* ka = kargs(); unsigned char* ws = ka->ws;
            pg8::DenseOrder S; S.init((const bf16_t*)(ws + WS_HA), (const bf16_t*)(ws + WS_WINT) + (size_t)l * NP * D, NTOK, (G == 256) ? NP - 256 : NP, D, G, bx);
            pg8::EpiBf16 E{(bf16_t*)(ws + WS_PROJ), NP};
            pg8::gemm_phase(lds, S, E);
            GRID_BAR();
        }
        if (IN(PH_MIX)) {
            if (G == 256 && bx < 64) {
                KArgs* ka = kargs(); unsigned char* ws = ka->ws;
                pg8::DenseOrder S; S.init((const bf16_t*)(ws + WS_HA), (const bf16_t*)(ws + WS_WINT) + (size_t)l * NP * D + (size_t)(NP - 256) * D, NTOK, 256, D, 64, bx);
                pg8::EpiBf16 E{(bf16_t*)(ws + WS_PROJ) + (NP - 256), NP};
                pg8::gemm_phase(lds, S, E);
            }
            phase_mix1(a, l, lds, vcu, G, bx);
        }
        if (IN(PH_A1)) { phase_a1(a, l, lds, vcu, G, a.fused != 0, bar); }
        if (IN(PH_A2)) { phase_a2(a, l, lds, vcu, G, a.fused != 0, bar); GRID_BAR(); }
        if (IN(PH_G2)) {
            KArgs* ka = kargs(); unsigned char* ws = ka->ws; const float* xin = IN_F(I_X); const bf16_t* xinb = (l == 0) ? (const bf16_t*)nullptr : (const bf16_t*)(ws + WS_X1) + (size_t)NTOK * D; const float* mod = (const float*)(ws + WS_MOD) + (size_t)l * 4 * 6144;
            pg8::DenseOrder S; S.init((const bf16_t*)(ws + WS_MIXB), (const bf16_t*)(ws + WS_WOUTT) + (size_t)l * D * D, NTOK, D, D, G, bx);
            pg8::EpiResid E{xin, xinb, (bf16_t*)(ws + WS_X1), mod + 2048, (const float*)(ws + WS_SSQ) + (size_t)l * NTOK * 4};
            pg8::gemm_phase<pg8::EpiResid, pg8::DenseOrder, true>(lds, S, E);
        }
        if (IN(PH_ROUTE)) { phase_route(a, l, lds, vcu, G, a.fused != 0, bar); GRID_BAR(); }
        if (IN(PH_UP)) {
            KArgs* ka = kargs(); unsigned char* ws = ka->ws;
            moe_cum(a, l, lds);
            pg8::MoeOrder<true> S; S.A = (const bf16_t*)(ws + WS_HA); S.Bt = (const bf16_t*)(ws + WS_WGUT) + (size_t)l * NE * 1024 * 1024; S.K = D; S.bstride = (size_t)1024 * 1024;
            S.list = (const int*)(ws + WS_LIST); S.cum = (const LAS int*)(lds + LDS_MISC + MISC_CUM); S.cnts = (const LAS int*)(lds + LDS_MISC + MISC_CNT); S.G = G; S.c = vcu; S.nun = S.cum[32] * 4;
            S.flag = (int*)(ws + WS_FLAG) + l * 160 * 8;
            pg8::EpiHid E{(bf16_t*)(ws + WS_HID)};
            pg8::gemm_phase(lds, S, E);
        }
        if (IN(PH_DOWN)) {
            KArgs* ka = kargs(); unsigned char* ws = ka->ws;
            moe_cum(a, l, lds);
            pg8::MoeOrder<false> S; S.A = (const bf16_t*)(ws + WS_HID); S.Bt = (const bf16_t*)(ws + WS_WDT) + (size_t)l * NE * 1024 * 512; S.K = F; S.bstride = (size_t)1024 * 512;
            S.list = nullptr; S.cum = (const LAS int*)(lds + LDS_MISC + MISC_CUM); S.cnts = (const LAS int*)(lds + LDS_MISC + MISC_CNT); S.G = G; S.c = vcu; S.nun = S.cum[32] * 4;
            S.flag = (int*)(ws + WS_FLAG) + l * 160 * 8;
            pg8::EpiDown E{(bf16_t*)(ws + WS_Y), (const float*)(ws + WS_LGATE)};
            pg8::gemm_phase(lds, S, E);
        }
        if (IN(PH_COMB)) { phase_combine(a, l, lds, vcu, G, a.fused != 0, bar); if (l + 1 < a.l_hi) GRID_BAR(); }
    }
#undef IN
#undef GRID_BAR
}


static void launch_ph(const Args& base, int grid, int l_lo, int l_hi, int ph_lo, int ph_hi, int fused, hipStream_t stream) {
    Args a = base; a.l_lo = l_lo; a.l_hi = l_hi; a.ph_lo = ph_lo; a.ph_hi = ph_hi; a.fused = fused; a.pad = 0;
    hipLaunchKernelGGL(mk_fwd, dim3(grid), dim3(NTHR), LDS_BYTES, stream, a);
}

extern "C" void kernel_launch(void* const* d_in, const int* in_sizes, int n_in, void* d_out, int out_size, void* d_ws, size_t ws_size, hipStream_t stream) {
    static int grid = 0;
    if (grid == 0) {
        int dev = 0, cus = 0;
        if (hipGetDevice(&dev) != hipSuccess || hipDeviceGetAttribute(&cus, hipDeviceAttributeMultiprocessorCount, dev) != hipSuccess) { grid = -1; return; }
        if (hipFuncSetAttribute((const void*)mk_fwd, hipFuncAttributeMaxDynamicSharedMemorySize, LDS_BYTES) != hipSuccess) { fprintf(stderr, "hipFuncSetAttribute failed\n"); grid = -1; return; }
        (void)hipGetLastError();
        grid = cus;
    }
    if (grid < 0) return;
    unsigned char* ws = (unsigned char*)d_ws;
    (void)hipMemsetAsync(ws, 0, WS_ZERO_BYTES, stream);
    Args a{};
    for (int i = 0; i < 32; ++i) a.in[i] = d_in[i];
    a.out = (float*)d_out; a.ws = ws;
#ifdef MK_MULTI
    launch_ph(a, grid, 0, 0, PH_PRO, PH_PRO + 1, 0, stream);
#ifdef MK_REP
    if (MK_REP == PH_PRO) launch_ph(a, grid, 0, 0, PH_PRO, PH_PRO + 1, 0, stream);
#endif
    launch_ph(a, grid, 0, 0, PH_NORM0, PH_NORM0 + 1, 0, stream);
#ifdef MK_REP
    if (MK_REP == PH_NORM0) launch_ph(a, grid, 0, 0, PH_NORM0, PH_NORM0 + 1, 0, stream);
#endif
    for (int l = 0; l < L; ++l)
        for (int ph = PH_G1; ph < PH_END; ++ph) {
            launch_ph(a, grid, l, l + 1, ph, ph + 1, 0, stream);
#ifdef MK_REP
            if (ph == MK_REP) launch_ph(a, grid, l, l + 1, ph, ph + 1, 0, stream);
#endif
        }
#else
    launch_ph(a, grid, 0, L, PH_PRO, PH_END, 1, stream);
#endif
}
```
